# Optimizing an MI355X kernel written in HIP

```python
import math
import jax, jax.numpy as jnp
from jax import lax
import numpy as np

D_MODEL = 1024
BATCH = 4
SEQ = 4096
DEPTH = 4

N_MIXERS = 4
MIXER_WIDTH = D_MODEL // 4
D_MIX = N_MIXERS * MIXER_WIDTH
SGU_HEADS = 4
SGU_CHUNK = 128
S5_GROUP = 16
S5_GROUPS = MIXER_WIDTH // S5_GROUP
S5_STATE = 64
S5_DT_MIN = 1e-3
S5_DT_MAX = 1e-1
LRU_HEADS = 4
LRU_CONV = 4
LRU_C = 8.0
FOX_HEADS = 4
FOX_HEAD_DIM = MIXER_WIDTH // FOX_HEADS
ATTN_BLOCK = 128
D_FF = 4 * D_MODEL
RMS_EPS = 1e-6
D_IN_PROJ = 8 * MIXER_WIDTH + FOX_HEADS

kernel_name = "hybrid_parallel_heads_sgu_s5_rglru_fox"


def rms_norm(x, g):
    xf = x.astype(jnp.float32)
    y = xf * lax.rsqrt(jnp.mean(jnp.square(xf), axis=-1, keepdims=True) + RMS_EPS)
    return (y * g.astype(jnp.float32)).astype(x.dtype)


def group_rms_norm(y, g):
    bsz, seq, _ = y.shape
    yf = y.astype(jnp.float32).reshape(bsz, seq, N_MIXERS, MIXER_WIDTH)
    yf = yf * lax.rsqrt(jnp.mean(jnp.square(yf), axis=-1, keepdims=True) + RMS_EPS)
    return (yf.reshape(bsz, seq, D_MIX) * g.astype(jnp.float32)).astype(y.dtype)


def _linear_combine(e1, e2):
    a1, b1 = e1
    a2, b2 = e2
    return a1 * a2, a2 * b1 + b2


def _complex_linear_combine(e1, e2):
    a1r, a1i, b1r, b1i = e1
    a2r, a2i, b2r, b2i = e2
    ar = a2r * a1r - a2i * a1i
    ai = a2r * a1i + a2i * a1r
    br = a2r * b1r - a2i * b1i + b2r
    bi = a2r * b1i + a2i * b1r + b2i
    return ar, ai, br, bi


def sgu_mixer(u, v, norm_g, w_s, b_s):
    bsz, seq, _ = u.shape
    u = jax.nn.gelu(u)
    v = rms_norm(jax.nn.gelu(v), norm_g)
    mask = jnp.tril(jnp.ones((SGU_CHUNK, SGU_CHUNK), w_s.dtype))
    vh = v.reshape(bsz, seq // SGU_CHUNK, SGU_CHUNK, SGU_HEADS, MIXER_WIDTH // SGU_HEADS)
    mixed = jnp.einsum('hts,bcshd->bcthd', w_s * mask, vh) + b_s.T[None, None, :, :, None]
    return u * mixed.reshape(bsz, seq, MIXER_WIDTH)


def s5_mixer(u, lam_re, lam_im, log_dt, b_re, b_im, c_re, c_im, d, glu_w, glu_b):
    bsz, seq, _ = u.shape
    f32 = jnp.float32
    uf = u.astype(f32)
    lam_re = lam_re.astype(f32)
    lam_im = lam_im.astype(f32)
    dt = jnp.exp(log_dt.astype(f32))[:, None]
    mag = jnp.exp(lam_re * dt)
    abar_re = mag * jnp.cos(lam_im * dt)
    abar_im = mag * jnp.sin(lam_im * dt)
    denom = jnp.square(lam_re) + jnp.square(lam_im)
    num_re = abar_re - 1.0
    num_im = abar_im
    fac_re = (num_re * lam_re + num_im * lam_im) / denom
    fac_im = (num_im * lam_re - num_re * lam_im) / denom
    b_re = b_re.astype(f32)
    b_im = b_im.astype(f32)
    bbar_re = fac_re[..., None] * b_re - fac_im[..., None] * b_im
    bbar_im = fac_re[..., None] * b_im + fac_im[..., None] * b_re
    ug = uf.reshape(bsz, seq, S5_GROUPS, S5_GROUP)
    bu_re = jnp.einsum('blgh,gph->blgp', ug, bbar_re)
    bu_im = jnp.einsum('blgh,gph->blgp', ug, bbar_im)
    a_re = jnp.broadcast_to(abar_re, bu_re.shape)
    a_im = jnp.broadcast_to(abar_im, bu_im.shape)
    _, _, s_re, s_im = lax.associative_scan(
        _complex_linear_combine, (a_re, a_im, bu_re, bu_im), axis=1)
    y = (jnp.einsum('blgp,ghp->blgh', s_re, c_re.astype(f32))
         - jnp.einsum('blgp,ghp->blgh', s_im, c_im.astype(f32)))
    y = y.reshape(bsz, seq, MIXER_WIDTH) + d.astype(f32) * uf
    y = jax.nn.gelu(y)
    y = y * jax.nn.sigmoid(y @ glu_w.astype(f32) + glu_b.astype(f32))
    return y.astype(u.dtype)


def causal_depthwise_conv(x, w, b):
    out = lax.conv_general_dilated(
        x, w[:, None, :], window_strides=(1,), padding=[(LRU_CONV - 1, 0)],
        dimension_numbers=('NWC', 'WIO', 'NWC'), feature_group_count=x.shape[-1])
    return out + b


def rglru_mixer(x, gate, conv_w, conv_b, wa, ba, wx, bx, lam):
    bsz, seq, _ = x.shape
    f32 = jnp.float32
    xc = causal_depthwise_conv(x, conv_w, conv_b)
    xh = xc.reshape(bsz, seq, LRU_HEADS, MIXER_WIDTH // LRU_HEADS)
    r = jax.nn.sigmoid(jnp.einsum('blhi,hij->blhj', xh, wa) + ba).reshape(bsz, seq, MIXER_WIDTH)
    i = jax.nn.sigmoid(jnp.einsum('blhi,hij->blhj', xh, wx) + bx).reshape(bsz, seq, MIXER_WIDTH)
    log_a = -LRU_C * r.astype(f32) * jax.nn.softplus(-lam.astype(f32))
    a = jnp.exp(log_a)
    b = jnp.sqrt(-jnp.expm1(2.0 * log_a)) * (i * xc).astype(f32)
    _, h = lax.associative_scan(_linear_combine, (a, b), axis=1)
    return h.astype(x.dtype) * jax.nn.gelu(gate)


def forgetting_attention(q, k, v, log_f):
    bsz, seq, n_heads, hd = q.shape
    c = jnp.cumsum(log_f, axis=1).transpose(0, 2, 1)
    scale = hd ** -0.5
    neg = jnp.finfo(jnp.float32).min
    out_blocks = []
    for blk in range(seq // ATTN_BLOCK):
        q0, q1 = blk * ATTN_BLOCK, (blk + 1) * ATTN_BLOCK
        s = jnp.einsum('bqhd,bkhd->bhqk', q[:, q0:q1], k[:, :q1],
                       preferred_element_type=jnp.float32) * scale
        s = s + c[:, :, q0:q1, None] - c[:, :, None, :q1]
        q_pos = jnp.arange(q0, q1)[:, None]
        k_pos = jnp.arange(q1)[None, :]
        s = jnp.where(k_pos <= q_pos, s, neg)
        p = jax.nn.softmax(s, axis=-1).astype(v.dtype)
        out_blocks.append(jnp.einsum('bhqk,bkhd->bqhd', p, v[:, :q1]))
    return jnp.concatenate(out_blocks, axis=1)


def fox_mixer(q, k, v, f_logit, b_f):
    bsz, seq, _ = q.shape
    shp = (bsz, seq, FOX_HEADS, FOX_HEAD_DIM)
    log_f = jax.nn.log_sigmoid((f_logit + b_f).astype(jnp.float32))
    o = forgetting_attention(q.reshape(shp), k.reshape(shp), v.reshape(shp), log_f)
    return o.reshape(bsz, seq, MIXER_WIDTH)


def setup_inputs(seed: int = 0) -> dict:
    key = jax.random.key(seed)
    ks = iter(jax.random.split(key, 40))
    f32 = jnp.float32

    def nrm(shape, scale):
        return jax.random.normal(next(ks), shape, f32) * scale

    def gain(shape):
        return 1.0 + 0.02 * jax.random.normal(next(ks), shape, f32)

    L = DEPTH
    W = MIXER_WIDTH
    hd_lru = W // LRU_HEADS
    x = jax.random.normal(next(ks), (BATCH, SEQ, D_MODEL), f32)
    norm1_g = gain((L, D_MODEL))
    w_in = nrm((L, D_MODEL, D_IN_PROJ), D_MODEL ** -0.5)
    sgu_norm_g = gain((L, W))
    sgu_w = nrm((L, SGU_HEADS, SGU_CHUNK, SGU_CHUNK), SGU_CHUNK ** -0.5)
    sgu_b = 1.0 + 0.1 * jax.random.normal(next(ks), (L, SGU_HEADS, SGU_CHUNK), f32)
    s5_lambda_re = -0.5 + 0.01 * jax.random.normal(next(ks), (L, S5_GROUPS, S5_STATE), f32)
    s5_lambda_im = (jnp.pi * jnp.arange(S5_STATE, dtype=f32))[None, None, :] \
        + 0.01 * jax.random.normal(next(ks), (L, S5_GROUPS, S5_STATE), f32)
    s5_log_dt = jax.random.uniform(next(ks), (L, S5_GROUPS), f32,
                                   minval=math.log(S5_DT_MIN), maxval=math.log(S5_DT_MAX))
    s5_b_re = nrm((L, S5_GROUPS, S5_STATE, S5_GROUP), (2.0 * S5_GROUP) ** -0.5)
    s5_b_im = nrm((L, S5_GROUPS, S5_STATE, S5_GROUP), (2.0 * S5_GROUP) ** -0.5)
    s5_c_re = nrm((L, S5_GROUPS, S5_GROUP, S5_STATE), (2.0 * S5_STATE) ** -0.5)
    s5_c_im = nrm((L, S5_GROUPS, S5_GROUP, S5_STATE), (2.0 * S5_STATE) ** -0.5)
    s5_d = nrm((L, W), 0.5)
    s5_glu_w = nrm((L, W, W), W ** -0.5)
    s5_glu_b = nrm((L, W), 0.01)
    lru_conv_w = nrm((L, LRU_CONV, W), LRU_CONV ** -0.5)
    lru_conv_b = nrm((L, W), 0.01)
    lru_wa = nrm((L, LRU_HEADS, hd_lru, hd_lru), hd_lru ** -0.5)
    lru_ba = nrm((L, LRU_HEADS, hd_lru), 0.01)
    lru_wx = nrm((L, LRU_HEADS, hd_lru, hd_lru), hd_lru ** -0.5)
    lru_bx = nrm((L, LRU_HEADS, hd_lru), 0.01)
    a_pow = jax.random.uniform(next(ks), (L, W), f32, minval=0.9, maxval=0.999)
    sig = a_pow ** (1.0 / LRU_C)
    lru_lambda = jnp.log(sig) - jnp.log1p(-sig)
    fox_fgate_b = 2.0 + 0.1 * jax.random.normal(next(ks), (L, FOX_HEADS), f32)
    mix_norm_g = gain((L, D_MIX))
    w_out = nrm((L, D_MIX, D_MODEL), D_MIX ** -0.5)
    norm2_g = gain((L, D_MODEL))
    w_mlp_in = nrm((L, D_MODEL, D_FF), D_MODEL ** -0.5)
    w_mlp_out = nrm((L, D_FF, D_MODEL), D_FF ** -0.5)
    final_g = gain((D_MODEL,))
    return {
        "x": x, "norm1_g": norm1_g, "w_in": w_in,
        "sgu_norm_g": sgu_norm_g, "sgu_w": sgu_w, "sgu_b": sgu_b,
        "s5_lambda_re": s5_lambda_re, "s5_lambda_im": s5_lambda_im, "s5_log_dt": s5_log_dt,
        "s5_b_re": s5_b_re, "s5_b_im": s5_b_im, "s5_c_re": s5_c_re, "s5_c_im": s5_c_im,
        "s5_d": s5_d, "s5_glu_w": s5_glu_w, "s5_glu_b": s5_glu_b,
        "lru_conv_w": lru_conv_w, "lru_conv_b": lru_conv_b, "lru_wa": lru_wa, "lru_ba": lru_ba,
        "lru_wx": lru_wx, "lru_bx": lru_bx, "lru_lambda": lru_lambda,
        "fox_fgate_b": fox_fgate_b,
        "mix_norm_g": mix_norm_g, "w_out": w_out, "norm2_g": norm2_g,
        "w_mlp_in": w_mlp_in, "w_mlp_out": w_mlp_out, "final_g": final_g,
    }


def reference(x, norm1_g, w_in, sgu_norm_g, sgu_w, sgu_b,
              s5_lambda_re, s5_lambda_im, s5_log_dt, s5_b_re, s5_b_im, s5_c_re, s5_c_im,
              s5_d, s5_glu_w, s5_glu_b,
              lru_conv_w, lru_conv_b, lru_wa, lru_ba, lru_wx, lru_bx, lru_lambda,
              fox_fgate_b, mix_norm_g, w_out, norm2_g, w_mlp_in, w_mlp_out, final_g):
    split_points = [MIXER_WIDTH * i for i in range(1, 9)]
    for l in range(DEPTH):
        h = rms_norm(x, norm1_g[l])
        z = h @ w_in[l]
        a_u, a_v, b_in, c_x, c_gate, d_q, d_k, d_v, d_f = jnp.split(z, split_points, axis=-1)
        y_a = sgu_mixer(a_u, a_v, sgu_norm_g[l], sgu_w[l], sgu_b[l])
        y_b = s5_mixer(b_in, s5_lambda_re[l], s5_lambda_im[l], s5_log_dt[l],
                       s5_b_re[l], s5_b_im[l], s5_c_re[l], s5_c_im[l],
                       s5_d[l], s5_glu_w[l], s5_glu_b[l])
        y_c = rglru_mixer(c_x, c_gate, lru_conv_w[l], lru_conv_b[l],
                          lru_wa[l], lru_ba[l], lru_wx[l], lru_bx[l], lru_lambda[l])
        y_d = fox_mixer(d_q, d_k, d_v, d_f, fox_fgate_b[l])
        y = jnp.concatenate([y_a, y_b, y_c, y_d], axis=-1)
        y = group_rms_norm(y, mix_norm_g[l])
        x = x + y @ w_out[l]
        h = rms_norm(x, norm2_g[l])
        x = x + jnp.square(jax.nn.relu(h @ w_mlp_in[l])) @ w_mlp_out[l]
    return rms_norm(x, final_g)
```

```cpp
#include <hip/hip_runtime.h>
#include <hip/hip_cooperative_groups.h>
#include <cstdio>
#include <cstdint>
namespace cg = cooperative_groups;
__device__ __forceinline__ int opaque_tid() { int t = __builtin_amdgcn_workitem_id_x(); asm volatile("" : "+v"(t)); return t; }
namespace pg8 {
#define PG8_LAS __attribute__((address_space(3)))
typedef unsigned short bf16_t;
typedef short bf16x8 __attribute__((ext_vector_type(8)));
typedef float f32x4 __attribute__((ext_vector_type(4)));
typedef unsigned u32x4 __attribute__((ext_vector_type(4)));
constexpr int BM = 256, BK = 64, HALF = 128, HTB = HALF * BK * 2  , STAGE_BYTES = 8 * HTB, NXCD = 8, WGM = 8;

__host__ __device__ __forceinline__ int lds_byte(int r, int c) { const int st = (r >> 4) * 2 + (c >> 5), rr = r & 15, cc = c & 31, ob = rr * 64 + cc * 2; return st * 1024 + (ob ^ (((ob >> 9) & 1) << 5)); }
__host__ __device__ __forceinline__ void stage_rc(int b, int& R, int& C) { const int st = b / 1024, sb = b % 1024, swz = sb ^ (((sb >> 9) & 1) << 5); R = (st >> 1) * 16 + swz / 64; C = (st & 1) * 32 + (swz % 64) / 2; }
__host__ __device__ __forceinline__ int perm32(int rho) { const int n = rho >> 4, i = rho & 15; return 8 * (i >> 2) + 4 * n + (i & 3); }

struct Unit { int pm, pn; };
struct Gemm { const bf16_t* A; const bf16_t* Bt; int M, N, K; };

struct StaticOrder {
    int nM, nN, nwg, G, c;
    __host__ __device__ void init(int M, int N, int G_, int c_) { nM = M / BM; nN = N / BM; nwg = nM * nN; G = G_; c = c_; }
    __host__ __device__ bool next(int i, Unit& u) const {
        const long L = (long)i * G + c; if (L >= nwg) return false;
        int wgid = (int)L; { const int q = nwg / NXCD, r = nwg % NXCD, xcd = wgid % NXCD, off = wgid / NXCD; wgid = (xcd < r ? xcd * (q + 1) : r * (q + 1) + (xcd - r) * q) + off; }
        const int nig = WGM * nN, gid = wgid / nig, fm = gid * WGM, gsz = (nM - fm) < WGM ? (nM - fm) : WGM;
        u.pm = fm + ((wgid % nig) % gsz); u.pn = (wgid % nig) / gsz; return true;
    }
    __device__ __forceinline__ void a_ready(const Unit&) const {}
    __device__ __forceinline__ void done(const Unit&) const {}
};

__device__ __forceinline__ unsigned cvt_pk_bf16(float lo, float hi) { unsigned r; asm volatile("v_cvt_pk_bf16_f32 %0, %1, %2" : "=v"(r) : "v"(lo), "v"(hi)); return r; }
template <class Epi, class Sched, bool ALIGN_EPI = false, bool SP2 = false>
__device__ __forceinline__ void gemm_phase(PG8_LAS unsigned char* lds, const Gemm g, const Sched& S, const Epi& E) {
    const int tid = opaque_tid(), wid = __builtin_amdgcn_readfirstlane(tid >> 6), lane = tid & 63, wr = wid >> 2, wc = wid & 3, fr = lane & 15, fq = lane >> 4;
    const int K = g.K, nt = K / BK;
    unsigned voffA[2], voffB[2];
#pragma unroll
    for (int i = 0; i < 2; ++i) { int R, C; stage_rc(tid * 16 + i * 8192, R, C); const int Rb = Epi::PERM ? ((R & ~31) + perm32(R & 31)) : R;
        voffA[i] = (unsigned)(R * K + C) * 2u; voffB[i] = (unsigned)(Rb * K + C) * 2u; }
    const size_t kstep = (size_t)(BK * 2);
    const size_t hstep = (size_t)HALF * K * 2;
    const size_t tstep = 2 * hstep;
    const unsigned ldsw = (unsigned)wid * 1024u;
    const int aoff = lds_byte(wr * 64 + fr, fq * 8), boff = lds_byte(wc * 32 + fr, fq * 8);
#define PG8_SA(b, h) (((b) * 2 + (h)) * HTB)
#define PG8_SB(b, h) ((4 + (b) * 2 + (h)) * HTB)
#define PG8_STAGE(bufoff, gbase, voff) do { _Pragma("unroll") for (int _i = 0; _i < 2; ++_i) \
        __builtin_amdgcn_global_load_lds((const unsigned*)((const char*)(gbase) + (voff)[_i]), (PG8_LAS unsigned*)(lds + (bufoff) + ldsw + _i * 8192), 16, 0, 0); } while (0)
#define PG8_LDA(dst, b, h) do { _Pragma("unroll") for (int m = 0; m < 4; ++m) _Pragma("unroll") for (int k = 0; k < 2; ++k) dst[m][k] = *(const PG8_LAS bf16x8*)(lds + PG8_SA(b, h) + aoff + m * 2048 + k * 1024); } while (0)
#define PG8_LDB(dst, b, h) do { _Pragma("unroll") for (int n = 0; n < 2; ++n) _Pragma("unroll") for (int k = 0; k < 2; ++k) dst[n][k] = *(const PG8_LAS bf16x8*)(lds + PG8_SB(b, h) + boff + n * 2048 + k * 1024); } while (0)
#define PG8_MMA(ai, bj, At, Bt) do { __builtin_amdgcn_s_setprio(1); _Pragma("unroll") for (int m = 0; m < 4; ++m) _Pragma("unroll") for (int n = 0; n < 2; ++n) _Pragma("unroll") for (int k = 0; k < 2; ++k) \
        acc[ai][bj][m][n] = __builtin_amdgcn_mfma_f32_16x16x32_bf16(Bt[n][k], At[m][k], acc[ai][bj][m][n], 0, 0, 0); __builtin_amdgcn_s_setprio(0); } while (0)
#define PG8_WAIT_V(n) asm volatile("s_waitcnt vmcnt(" #n ")" ::: "memory")
#define PG8_WAIT_L(n) asm volatile("s_waitcnt lgkmcnt(" #n ")" ::: "memory")
#define PG8_BAR __builtin_amdgcn_s_barrier()
#define PG8_SCHED __builtin_amdgcn_sched_barrier(0)
    Unit cur, nxt; int ui = 0;
    if (!S.next(0, cur)) return;
    if constexpr (Epi::KPREP) { Unit pu; for (int i = 0; i < 12 && S.next(i, pu); ++i) E.kprep(pu, lds + STAGE_BYTES + i * 1024, tid); }
    f32x4 acc[2][2][4][2];
#pragma unroll
    for (int a = 0; a < 2; ++a)
#pragma unroll
        for (int b = 0; b < 2; ++b)
#pragma unroll
            for (int m = 0; m < 4; ++m)
#pragma unroll
                for (int n = 0; n < 2; ++n) acc[a][b][m][n] = (f32x4){0.f, 0.f, 0.f, 0.f};
    bf16x8 At[4][2], B0[2][2], B1[2][2];
    const char* cA = (const char*)g.A + (size_t)cur.pm * tstep; const char* cB = (const char*)g.Bt + (size_t)cur.pn * tstep;
    S.a_ready(cur);
    if constexpr (SP2) {
        PG8_STAGE(PG8_SB(0, 0), cB, voffB); PG8_STAGE(PG8_SB(0, 1), cB + hstep, voffB); PG8_STAGE(PG8_SA(0, 0), cA, voffA); PG8_STAGE(PG8_SA(0, 1), cA + hstep, voffA);
        if (wr == 1) PG8_BAR;
        PG8_WAIT_V(2); PG8_BAR;
        PG8_STAGE(PG8_SB(1, 0), cB + kstep, voffB); PG8_STAGE(PG8_SA(1, 0), cA + kstep, voffA); PG8_STAGE(PG8_SB(1, 1), cB + hstep + kstep, voffB);
        PG8_WAIT_V(6); PG8_BAR;
    } else {
        PG8_STAGE(PG8_SB(0, 0), cB, voffB); PG8_STAGE(PG8_SA(0, 0), cA, voffA); PG8_STAGE(PG8_SB(0, 1), cB + hstep, voffB); PG8_STAGE(PG8_SA(0, 1), cA + hstep, voffA);
        if (wr == 1) PG8_BAR;
        PG8_WAIT_V(4); PG8_BAR;
        PG8_STAGE(PG8_SB(1, 0), cB + kstep, voffB); PG8_STAGE(PG8_SA(1, 0), cA + kstep, voffA); PG8_STAGE(PG8_SB(1, 1), cB + hstep + kstep, voffB);
        PG8_WAIT_V(6); PG8_BAR;
    }
    for (;;) {
        const bool has_next = S.next(ui + 1, nxt);
        const char* nA = has_next ? (const char*)g.A + (size_t)nxt.pm * tstep : cA; const char* nB = has_next ? (const char*)g.Bt + (size_t)nxt.pn * tstep : cB;
        for (int t = 0; t < nt; t += 2) {
            const bool last = (t == nt - 2);
            const char* a1 = cA + (size_t)(t + 1) * kstep;
            const char* a2 = last ? nA : cA + (size_t)(t + 2) * kstep; const char* b2 = last ? nB : cB + (size_t)(t + 2) * kstep;
            const char* a3 = a2 + kstep; const char* b3 = b2 + kstep;
            if (last && has_next) S.a_ready(nxt);
            if constexpr (SP2) {
            PG8_LDB(B0, 0, 0); PG8_LDB(B1, 0, 1); PG8_SCHED; PG8_LDA(At, 0, 0); PG8_STAGE(PG8_SA(1, 1), a1 + hstep, voffA);
            PG8_WAIT_V(8); PG8_WAIT_L(0); PG8_BAR; PG8_MMA(0, 0, At, B0); PG8_MMA(0, 1, At, B1); PG8_BAR; PG8_SCHED;
            PG8_LDA(At, 0, 1); PG8_STAGE(PG8_SB(0, 0), b2, voffB); PG8_STAGE(PG8_SB(0, 1), b2 + hstep, voffB); PG8_STAGE(PG8_SA(0, 0), a2, voffA);
            PG8_WAIT_V(8); PG8_WAIT_L(0); PG8_BAR; PG8_MMA(1, 0, At, B0); PG8_MMA(1, 1, At, B1); PG8_BAR; PG8_SCHED;
            PG8_LDB(B0, 1, 0); PG8_LDB(B1, 1, 1); PG8_SCHED; PG8_LDA(At, 1, 0); PG8_STAGE(PG8_SA(0, 1), a2 + hstep, voffA);
            PG8_WAIT_V(8); PG8_WAIT_L(0); PG8_BAR; PG8_MMA(0, 0, At, B0); PG8_MMA(0, 1, At, B1); PG8_BAR; PG8_SCHED;
            PG8_LDA(At, 1, 1); PG8_STAGE(PG8_SB(1, 0), b3, voffB); PG8_STAGE(PG8_SB(1, 1), b3 + hstep, voffB); PG8_STAGE(PG8_SA(1, 0), a3, voffA);
            PG8_WAIT_V(8); PG8_WAIT_L(0); PG8_BAR; PG8_MMA(1, 0, At, B0); PG8_MMA(1, 1, At, B1); PG8_BAR; PG8_SCHED;
            } else {
            PG8_LDB(B0, 0, 0); PG8_SCHED; PG8_LDA(At, 0, 0); PG8_STAGE(PG8_SA(1, 1), a1 + hstep, voffA);
            PG8_WAIT_L(8); PG8_BAR; PG8_WAIT_L(0); PG8_MMA(0, 0, At, B0); PG8_BAR; PG8_SCHED;
            PG8_LDB(B1, 0, 1); PG8_STAGE(PG8_SB(0, 0), b2, voffB);
            PG8_BAR; PG8_WAIT_L(0); PG8_MMA(0, 1, At, B1); PG8_BAR;
            PG8_LDA(At, 0, 1); PG8_STAGE(PG8_SA(0, 0), a2, voffA);
            PG8_BAR; PG8_WAIT_L(0); PG8_MMA(1, 0, At, B0); PG8_BAR; PG8_SCHED;
            PG8_STAGE(PG8_SB(0, 1), b2 + hstep, voffB);
            PG8_WAIT_V(6); PG8_BAR; PG8_MMA(1, 1, At, B1); PG8_BAR;
            PG8_LDB(B0, 1, 0); PG8_SCHED; PG8_LDA(At, 1, 0); PG8_STAGE(PG8_SA(0, 1), a2 + hstep, voffA);
            PG8_WAIT_L(8); PG8_BAR; PG8_WAIT_L(0); PG8_MMA(0, 0, At, B0); PG8_BAR; PG8_SCHED;
            PG8_LDB(B1, 1, 1); PG8_STAGE(PG8_SB(1, 0), b3, voffB);
            PG8_BAR; PG8_WAIT_L(0); PG8_MMA(0, 1, At, B1); PG8_BAR;
            PG8_LDA(At, 1, 1); PG8_STAGE(PG8_SA(1, 0), a3, voffA);
            PG8_BAR; PG8_WAIT_L(0); PG8_MMA(1, 0, At, B0); PG8_BAR; PG8_SCHED;
            PG8_STAGE(PG8_SB(1, 1), b3 + hstep, voffB);
            PG8_WAIT_V(6); PG8_BAR; PG8_MMA(1, 1, At, B1); PG8_BAR;
            }
            if constexpr (Epi::KHOOK) { if (t == 2) E.khook(acc, lds + STAGE_BYTES + ui * 1024, wr, fr); }
        }
        if constexpr (ALIGN_EPI) { if (wr == 0) PG8_BAR; }
        if constexpr (!Epi::AFTER_DRAIN) { E(acc, cur, wr, wc, fr, fq, lds + STAGE_BYTES + ui * 1024); S.done(cur); }
        if (!has_next) break;
#pragma unroll
        for (int a = 0; a < 2; ++a)
#pragma unroll
            for (int b = 0; b < 2; ++b)
#pragma unroll
                for (int m = 0; m < 4; ++m)
#pragma unroll
                    for (int n = 0; n < 2; ++n) acc[a][b][m][n] = (f32x4){0.f, 0.f, 0.f, 0.f};
        cur = nxt; cA = nA; cB = nB; ++ui;
        if constexpr (ALIGN_EPI) { if (wr == 1) PG8_BAR; }
    }
    PG8_WAIT_V(0);
    if constexpr (!ALIGN_EPI) { if (wr == 0) PG8_BAR; }
    PG8_BAR;
    if constexpr (Epi::AFTER_DRAIN) { E.fused(acc, cur, wr, wc, fr, fq, lds, wid, lane); S.done(cur); }
#undef PG8_SA
#undef PG8_SB
#undef PG8_STAGE
#undef PG8_LDA
#undef PG8_LDB
#undef PG8_MMA
#undef PG8_WAIT_V
#undef PG8_WAIT_L
#undef PG8_BAR
#undef PG8_SCHED
}
}

#define LAS __attribute__((address_space(3)))
typedef unsigned short bf16_t;
typedef short bf16x8 __attribute__((ext_vector_type(8)));
typedef short bf16x4 __attribute__((ext_vector_type(4)));
typedef float f32x4 __attribute__((ext_vector_type(4)));
typedef float f32x2 __attribute__((ext_vector_type(2)));
typedef unsigned u32x4 __attribute__((ext_vector_type(4)));
typedef unsigned u32x2 __attribute__((ext_vector_type(2)));

constexpr int NB = 4, SEQ = 4096, DM = 1024, DEPTH = 4, T = NB * SEQ, W = 256, DFF = 4096, NIN = 2052, ZW = 2048;
constexpr int NCH = SEQ / 128;
constexpr float EPS = 1e-6f;
constexpr float LOG2E = 1.4426950408889634f;
constexpr int NTHR = 512;
constexpr int LDS_BYTES = 147456;
constexpr int ZC_AU = 0, ZC_AV = 256, ZC_B = 512, ZC_CX = 768, ZC_CG = 1024, ZC_Q = 1280, ZC_K = 1536, ZC_V = 1792;
constexpr int YC_D = 0, YC_A = 256, YC_B = 512, YC_C = 768;

constexpr size_t MiB = 1u << 20;
constexpr size_t WS_WIN = 0, WS_WOUT = 16 * MiB, WS_WMI = 24 * MiB, WS_WMO = 56 * MiB, WS_R = 88 * MiB, WS_Z = WS_R, WS_Y = WS_R + 64 * MiB, WS_ACT = WS_R,
                 WS_H = 216 * MiB, WS_S = 248 * MiB;
constexpr size_t WS_GLUT = WS_S, WS_WAT = WS_GLUT + 512 * 1024, WS_WXT = WS_WAT + 128 * 1024, WS_BBT = WS_WXT + 128 * 1024, WS_CMT = WS_BBT + 256 * 1024,
                 WS_ABAR = WS_CMT + 256 * 1024, WS_A128 = WS_ABAR + 32 * 1024, WS_WF = WS_A128 + 32 * 1024, WS_LOGF = WS_WF + 64 * 1024, WS_CS = WS_LOGF + 256 * 1024,
                 WS_SSD = WS_CS + 256 * 1024, WS_ELOC = WS_SSD + 256 * 1024, WS_LA = WS_ELOC + 1024 * 1024, WS_LB = WS_LA + 128 * 1024, WS_BAR = WS_LB + 128 * 1024, WS_SS2 = WS_BAR + 16 * 1024, WS_KMAX = WS_SS2 + 1024 * 1024, WS_END = WS_KMAX + 4096;

struct Args {
    const float* in[30]; float* out; unsigned char* ws; int ph_lo, ph_hi;
};


typedef const __attribute__((address_space(4))) unsigned long long* kargp_t;
__device__ __forceinline__ unsigned long long karg_(int i) { kargp_t tab = (kargp_t)__builtin_amdgcn_kernarg_segment_ptr(); asm volatile("" : "+s"(tab)); return tab[i]; }
#define INP(i) ((const float*)karg_(i))
__device__ __forceinline__ unsigned char* ws_() { return (unsigned char*)karg_(31); }
__device__ __forceinline__ float* out_() { return (float*)karg_(30); }
#define PH_LO ((int)(unsigned)(karg_(32) & 0xffffffffull))
#define PH_HI ((int)(unsigned)(karg_(32) >> 32))
__device__ __forceinline__ int bid_() { return blockIdx.x; }
__device__ __forceinline__ int grid_() { return gridDim.x; }
__device__ __forceinline__ float bf2f(bf16_t v) { return __uint_as_float((unsigned)v << 16); }
__device__ __forceinline__ float bfs2f(short v) { return __uint_as_float(((unsigned)(unsigned short)v) << 16); }
typedef __bf16 bf16x2_t __attribute__((ext_vector_type(2)));
__device__ __forceinline__ unsigned pk2(float lo, float hi) { const f32x2 v = {lo, hi}; const bf16x2_t b = __builtin_convertvector(v, bf16x2_t); return __builtin_bit_cast(unsigned, b); }
__device__ __forceinline__ bf16_t f2bf(float f) { return (bf16_t)(pk2(f, 0.f) & 0xffffu); }
__device__ __forceinline__ float gelu_t(float x) { const float y2 = (1.5957691216057308f * LOG2E) * (x + 0.044715f * x * x * x); return x * __builtin_amdgcn_rcpf(1.0f + __builtin_amdgcn_exp2f(-y2)); }
__device__ __forceinline__ float sigm(float x) { return __builtin_amdgcn_rcpf(1.0f + __builtin_amdgcn_exp2f(-LOG2E * x)); }
__device__ __forceinline__ float softplus_f(float x) { return fmaxf(x, 0.f) + log1pf(__expf(-fabsf(x))); }
__device__ __forceinline__ f32x4 mfma16(bf16x8 a, bf16x8 b, f32x4 c) { return __builtin_amdgcn_mfma_f32_16x16x32_bf16(a, b, c, 0, 0, 0); }
__device__ __forceinline__ float quad_sum(float v) {
    { const auto r = __builtin_amdgcn_permlane16_swap(__float_as_uint(v), __float_as_uint(v), false, false); v = __uint_as_float(r[0]) + __uint_as_float(r[1]); }
    { const auto r = __builtin_amdgcn_permlane32_swap(__float_as_uint(v), __float_as_uint(v), false, false); v = __uint_as_float(r[0]) + __uint_as_float(r[1]); }
    return v;
}
template <int CTRL> __device__ __forceinline__ float dpp_mov(float x) { return __uint_as_float((unsigned)__builtin_amdgcn_update_dpp(0, (int)__float_as_uint(x), CTRL, 0xf, 0xf, true)); }
__device__ __forceinline__ float wave_sum(float v) {
    v += dpp_mov<0xB1>(v); v += dpp_mov<0x4E>(v); v += dpp_mov<0x141>(v); v += dpp_mov<0x140>(v);
    return quad_sum(v);
}
__device__ __forceinline__ float wave_max(float v);
__device__ __forceinline__ float quad_max(float v) {
    { const auto r = __builtin_amdgcn_permlane16_swap(__float_as_uint(v), __float_as_uint(v), false, false); v = fmaxf(__uint_as_float(r[0]), __uint_as_float(r[1])); }
    { const auto r = __builtin_amdgcn_permlane32_swap(__float_as_uint(v), __float_as_uint(v), false, false); v = fmaxf(__uint_as_float(r[0]), __uint_as_float(r[1])); }
    return v;
}
__device__ __forceinline__ bf16x8 pack8(const float* v) {
    u32x4 w; w.x = pk2(v[0], v[1]); w.y = pk2(v[2], v[3]); w.z = pk2(v[4], v[5]); w.w = pk2(v[6], v[7]); return __builtin_bit_cast(bf16x8, w);
}
__device__ __forceinline__ bf16x8 zero8() { return (bf16x8){0, 0, 0, 0, 0, 0, 0, 0}; }

__device__ __forceinline__ float wave_max(float v) {
    v = fmaxf(v, dpp_mov<0xB1>(v)); v = fmaxf(v, dpp_mov<0x4E>(v)); v = fmaxf(v, dpp_mov<0x141>(v)); v = fmaxf(v, dpp_mov<0x140>(v));
    return quad_max(v);
}
template <int N> __device__ __forceinline__ float dpp_shr(float x, float ident) {
    return __uint_as_float((unsigned)__builtin_amdgcn_update_dpp((int)__float_as_uint(ident), (int)__float_as_uint(x), 0x110 + N, 0xf, 0xf, false));
}
__device__ __forceinline__ float neg_expm1(float x) {
    const float s = -x * (1.0f + x * (0.5f + x * (0.16666667f + x * (0.041666668f + x * (0.0083333338f + x * 0.0013888889f)))));
    const float e = 1.0f - __builtin_amdgcn_exp2f(LOG2E * x);
    return (x > -0.25f) ? s : e;
}
template <int ACT  , bool ROWS = false> struct EpiStoreBf16 {
    static constexpr bool PERM = true, AFTER_DRAIN = false, KHOOK = false, KPREP = ROWS;
    __device__ __forceinline__ void kprep(const pg8::Unit& u, PG8_LAS unsigned char* tab, int tid) const {
        if (tid < 256) { const float* rp = rowss + (size_t)(u.pm * 256 + tid) * 16; const f32x4 s0 = *(const f32x4*)rp, s1 = *(const f32x4*)(rp + 4), s2 = *(const f32x4*)(rp + 8), s3 = *(const f32x4*)(rp + 12);
            const float tot = ((s0[0] + s0[1]) + (s0[2] + s0[3])) + ((s1[0] + s1[1]) + (s1[2] + s1[3])) + ((s2[0] + s2[1]) + (s2[2] + s2[3])) + ((s3[0] + s3[1]) + (s3[2] + s3[3]));
            ((PG8_LAS float*)tab)[tid] = rsqrtf(tot * (1.0f / DM) + EPS); }
    }
    bf16_t* O; int ldc; const float* rowss;
    __device__ __forceinline__ void operator()(const pg8::f32x4 (&acc)[2][2][4][2], const pg8::Unit& u, int wr, int wc, int fr, int fq, PG8_LAS unsigned char* tab) const {
        const int row0 = u.pm * 256 + wr * 64 + fr, col0 = u.pn * 256 + wc * 32 + 8 * fq;
#pragma unroll
        for (int ai = 0; ai < 2; ++ai)
#pragma unroll
            for (int m = 0; m < 4; ++m) { bf16_t* rowp = O + (size_t)(row0 + ai * 128 + m * 16) * ldc + col0;
                const float rsc = ROWS ? ((const PG8_LAS float*)tab)[wr * 64 + fr + ai * 128 + m * 16] : 1.0f;
#pragma unroll
                for (int bj = 0; bj < 2; ++bj) { pg8::f32x4 v0 = acc[ai][bj][m][0] * rsc, v1 = acc[ai][bj][m][1] * rsc;
                    if (ACT == 1) {
#pragma unroll
                        for (int e = 0; e < 4; ++e) { const float a = fmaxf(v0[e], 0.f), b = fmaxf(v1[e], 0.f); v0[e] = a * a; v1[e] = b * b; } }
                    u32x4 w; w.x = pk2(v0[0], v0[1]); w.y = pk2(v0[2], v0[3]); w.z = pk2(v1[0], v1[1]); w.w = pk2(v1[2], v1[3]);
                    *(u32x4*)(rowp + bj * 128) = w; } }
    }
};
template <bool HOOK, bool NORMOUT> struct EpiRes {
    static constexpr bool PERM = true, AFTER_DRAIN = false, KHOOK = HOOK, KPREP = HOOK;
    bf16_t* xb; int ldc; const float* ssd; float* ss2;
    __device__ __forceinline__ void operator()(const pg8::f32x4 (&acc)[2][2][4][2], const pg8::Unit& u, int wr, int wc, int fr, int fq, PG8_LAS unsigned char* tab) const {
        const int col0 = u.pn * 256 + wc * 32 + 8 * fq;
#pragma unroll
        for (int ai = 0; ai < 2; ++ai)
#pragma unroll
            for (int m = 0; m < 4; ++m) { const int row = u.pm * 256 + ai * 128 + wr * 64 + m * 16 + fr; bf16_t* rowp = xb + (size_t)row * ldc + col0; float sq = 0.f;
#pragma unroll
                for (int bj = 0; bj < 2; ++bj) { const bf16x8 s = *(const bf16x8*)(rowp + bj * 128); float o[8];
#pragma unroll
                    for (int e = 0; e < 4; ++e) { o[e] = bfs2f(s[e]) + acc[ai][bj][m][0][e]; o[4 + e] = bfs2f(s[4 + e]) + acc[ai][bj][m][1][e]; }
                    if (NORMOUT) {
#pragma unroll
                        for (int e = 0; e < 8; ++e) sq += o[e] * o[e]; }
                    *(bf16x8*)(rowp + bj * 128) = pack8(o); }
                if (NORMOUT) { sq = quad_sum(sq); if (fq == 0) ss2[(size_t)row * 16 + u.pn * 4 + wc] = sq; }
                if (m & 1) asm volatile("" ::: "memory"); }
    }
    __device__ __forceinline__ void kprep(const pg8::Unit& u, PG8_LAS unsigned char* tab, int tid) const {
        if (tid < 256) { const f32x4 s4 = *(const f32x4*)(ssd + (size_t)(u.pm * 256 + tid) * 4); ((PG8_LAS float*)tab)[tid] = rsqrtf((s4[0] + s4[1] + s4[2] + s4[3]) * (1.0f / 256.0f) + EPS); }
    }
    __device__ __forceinline__ void khook(pg8::f32x4 (&acc)[2][2][4][2], PG8_LAS unsigned char* tab, int wr, int fr) const {
#pragma unroll
        for (int ai = 0; ai < 2; ++ai)
#pragma unroll
            for (int m = 0; m < 4; ++m) { const float rs = ((const PG8_LAS float*)tab)[ai * 128 + wr * 64 + m * 16 + fr];
#pragma unroll
                for (int bj = 0; bj < 2; ++bj)
#pragma unroll
                    for (int n = 0; n < 2; ++n) acc[ai][bj][m][n] *= rs; }
    }
};

template <int TN> __device__ __forceinline__ void tc_job(unsigned char* lds, const float* src, size_t sb, int ld, int K, int N, int nbatch, bf16_t* dst, const float* gain, int kshift, int rot) {
    LAS float* tile = (LAS float*)lds;
    constexpr int CG = TN / 64, NLD = TN / 32  , NST = TN / 64  ;
    const int tid = opaque_tid(), nk = K / 64, nn = N / TN, ntile = nbatch * nk * nn;
    for (int ti = (int)((bid_() + grid_() - (rot % grid_())) % grid_()); ti < ntile; ti += grid_()) {
        const int b = ti / (nk * nn), rem = ti % (nk * nn), kt = rem / nn, nt = rem % nn;
        const float* s = src + (size_t)b * sb + (size_t)(kt * 64) * ld + nt * TN;
        f32x4 v[NLD];
#pragma unroll
        for (int p = 0; p < NLD; ++p) { const int idx = tid + 512 * p, c16 = idx & 15, kq = (idx >> 4) & 3, rest = idx >> 6, kl = (rest / CG) * 4 + kq, n4 = ((rest % CG) * 16 + c16) * 4;
            v[p] = *(const f32x4*)(s + (size_t)kl * ld + n4);
            if (gain) { const float gg = gain[(size_t)b * K + kt * 64 + kl]; v[p] = v[p] * gg; } }
        __syncthreads();
#pragma unroll
        for (int p = 0; p < NLD; ++p) { const int idx = tid + 512 * p, c16 = idx & 15, kq = (idx >> 4) & 3, rest = idx >> 6, kl = (rest / CG) * 4 + kq, n4 = ((rest % CG) * 16 + c16) * 4;
            tile[kl * (TN + 1) + n4 + 0] = v[p][0]; tile[kl * (TN + 1) + n4 + 1] = v[p][1]; tile[kl * (TN + 1) + n4 + 2] = v[p][2]; tile[kl * (TN + 1) + n4 + 3] = v[p][3]; }
        __syncthreads();
#pragma unroll
        for (int p = 0; p < NST; ++p) { const int idx = tid + 512 * p, nl = idx >> 3, kc = (idx & 7) * 8; float o[8];
#pragma unroll
            for (int e = 0; e < 8; ++e) o[e] = tile[(kc + e) * (TN + 1) + nl];
            const int kd = (kt * 64 + kc + kshift) % K;
            *(bf16x8*)(dst + (size_t)b * N * K + (size_t)(nt * TN + nl) * K + kd) = pack8(o); }
    }
    __syncthreads();
}

__device__ __forceinline__ void prep_phase(const Args& a, unsigned char* lds) {
    unsigned char* ws = ws_();
    tc_job<256>(lds, INP(2), (size_t)DM * NIN, NIN, DM, ZW, DEPTH, (bf16_t*)(ws + WS_WIN), nullptr, 0, 0);
    tc_job<256>(lds, INP(25), (size_t)DM * DM, DM, DM, DM, DEPTH, (bf16_t*)(ws + WS_WOUT), INP(24), 256, 0);
    tc_job<256>(lds, INP(27), (size_t)DM * DFF, DFF, DM, DFF, DEPTH, (bf16_t*)(ws + WS_WMI), INP(26), 0, 0);
    tc_job<256>(lds, INP(28), (size_t)DFF * DM, DM, DFF, DM, DEPTH, (bf16_t*)(ws + WS_WMO), nullptr, 0, 0);
    tc_job<256>(lds, INP(14), (size_t)W * W, W, W, W, DEPTH, (bf16_t*)(ws + WS_GLUT), nullptr, 0, 0);
    tc_job<64>(lds, INP(18), (size_t)64 * 64, 64, 64, 64, DEPTH * 4, (bf16_t*)(ws + WS_WAT), nullptr, 0, 64);
    tc_job<64>(lds, INP(20), (size_t)64 * 64, 64, 64, 64, DEPTH * 4, (bf16_t*)(ws + WS_WXT), nullptr, 0, 96);
    const int gid = bid_() * NTHR + opaque_tid();
    if (gid < DEPTH * 1024) {
        const int l = gid >> 10, gp = gid & 1023, g = gp >> 6, p = gp & 63;
        const float lre = INP(6)[gid], lim = INP(7)[gid], dt = expf(INP(8)[l * 16 + g]);
        const float mag = expf(lre * dt), are = mag * cosf(lim * dt), aim = mag * sinf(lim * dt);
        const float den = lre * lre + lim * lim, nre = are - 1.0f, nim = aim;
        const float fre = (nre * lre + nim * lim) / den, fim = (nim * lre - nre * lim) / den;
        ((f32x2*)(ws + WS_ABAR))[gid] = (f32x2){are, aim};
        float pr = are, pi = aim;
#pragma unroll
        for (int s = 0; s < 7; ++s) { const float nr = pr * pr - pi * pi, ni = 2.0f * pr * pi; pr = nr; pi = ni; }
        ((f32x2*)(ws + WS_A128))[gid] = (f32x2){pr, pi};
        const float* bre = INP(9) + (size_t)gid * 16; const float* bim = INP(10) + (size_t)gid * 16;
        bf16_t* bbt = (bf16_t*)(ws + WS_BBT) + ((size_t)(l * 16 + g) * 128 + 2 * p) * 16;
#pragma unroll
        for (int h = 0; h < 16; ++h) { const float br = bre[h], bi = bim[h]; bbt[h] = f2bf(fre * br - fim * bi); bbt[16 + h] = f2bf(fre * bi + fim * br); }
        bf16_t* cmt = (bf16_t*)(ws + WS_CMT) + (size_t)(l * 16 + g) * 16 * 128;
#pragma unroll
        for (int h = 0; h < 16; ++h) { const size_t ci = ((size_t)(l * 16 + g) * 16 + h) * 64 + p; ((unsigned*)cmt)[(h * 128 + 2 * p) >> 1] = pk2(INP(11)[ci], -INP(12)[ci]); }
        const float* wr = INP(2) + ((size_t)l * DM + gp) * NIN + ZW;
        ((f32x4*)(ws + WS_WF))[gid] = *(const f32x4*)wr;
    }
}

template <bool SRCB, int MODE> __device__ __forceinline__ void norm_phase(const void* xsv, const float* g, bf16_t* hd, bf16_t* xb, float* od, const float* wf, const float* bfg, float* logf) {
    const int lane = opaque_tid() & 63, wid = opaque_tid() >> 6;
    const int gw = bid_() * 8 + wid, nw = grid_() * 8;
    for (int row = gw; row < T; row += nw) {
        f32x4 v[4]; float ss = 0.f;
#pragma unroll
        for (int i = 0; i < 4; ++i) {
            if (SRCB) { const bf16x4 q = *(const bf16x4*)((const bf16_t*)xsv + (size_t)row * DM + i * 256 + lane * 4); v[i] = (f32x4){bfs2f(q[0]), bfs2f(q[1]), bfs2f(q[2]), bfs2f(q[3])}; }
            else { v[i] = *(const f32x4*)((const float*)xsv + (size_t)row * DM + i * 256 + lane * 4);
                if (MODE == 1) { u32x2 w; w.x = pk2(v[i][0], v[i][1]); w.y = pk2(v[i][2], v[i][3]); *(u32x2*)(xb + (size_t)row * DM + i * 256 + lane * 4) = w; } }
            ss += v[i][0] * v[i][0] + v[i][1] * v[i][1] + v[i][2] * v[i][2] + v[i][3] * v[i][3]; }
        ss = wave_sum(ss);
        const float rs = rsqrtf(ss * (1.0f / DM) + EPS);
        float f0 = 0.f, f1 = 0.f, f2 = 0.f, f3 = 0.f;
#pragma unroll
        for (int i = 0; i < 4; ++i) {
            const f32x4 gg = *(const f32x4*)(g + i * 256 + lane * 4); const f32x4 hv = v[i] * rs * gg;
            if (MODE == 2) *(f32x4*)(od + (size_t)row * DM + i * 256 + lane * 4) = hv;
            else { u32x2 w; w.x = pk2(hv[0], hv[1]); w.y = pk2(hv[2], hv[3]); *(u32x2*)(hd + (size_t)row * DM + i * 256 + lane * 4) = w; }
            if (MODE == 1) {
#pragma unroll
                for (int e = 0; e < 4; ++e) { const f32x4 w4 = *(const f32x4*)(wf + (size_t)(i * 256 + lane * 4 + e) * 4); f0 += hv[e] * w4[0]; f1 += hv[e] * w4[1]; f2 += hv[e] * w4[2]; f3 += hv[e] * w4[3]; } }
        }
        if (MODE == 1) {
            f0 = wave_sum(f0); f1 = wave_sum(f1); f2 = wave_sum(f2); f3 = wave_sum(f3);
            if (lane == 0) { f32x4 o; const float fv[4] = {f0 + bfg[0], f1 + bfg[1], f2 + bfg[2], f3 + bfg[3]};
#pragma unroll
                for (int e = 0; e < 4; ++e) o[e] = fminf(fv[e], 0.f) - log1pf(__expf(-fabsf(fv[e])));
                *(f32x4*)(logf + (size_t)row * 4) = o; }
        }
    }
}

__device__ __forceinline__ void cumsum_item(int b, const float* logf, float* cs, unsigned char* lds) {
    LAS float* wt = (LAS float*)lds;
    const int tid = opaque_tid(), lane = tid & 63, wid = tid >> 6;
    f32x4 v[8]; f32x4 run = (f32x4){0.f, 0.f, 0.f, 0.f};
    const float* src = logf + ((size_t)b * SEQ + (size_t)tid * 8) * 4;
#pragma unroll
    for (int e = 0; e < 8; ++e) { run = run + *(const f32x4*)(src + e * 4); v[e] = run; }
    f32x4 inc = run;
#pragma unroll
    for (int d = 1; d < 64; d <<= 1) {
        const int sl = ((lane >= d) ? lane - d : lane) << 2; f32x4 o;
#pragma unroll
        for (int e = 0; e < 4; ++e) o[e] = __uint_as_float((unsigned)__builtin_amdgcn_ds_bpermute(sl, (int)__float_as_uint(inc[e])));
        if (lane >= d) inc = inc + o;
    }
    __syncthreads();
    if (lane == 63) { wt[wid * 4 + 0] = inc[0]; wt[wid * 4 + 1] = inc[1]; wt[wid * 4 + 2] = inc[2]; wt[wid * 4 + 3] = inc[3]; }
    __syncthreads();
    f32x4 off = inc - run;
    for (int w2 = 0; w2 < wid; ++w2) { off[0] += wt[w2 * 4 + 0]; off[1] += wt[w2 * 4 + 1]; off[2] += wt[w2 * 4 + 2]; off[3] += wt[w2 * 4 + 3]; }
    float* dst = cs + ((size_t)b * SEQ + (size_t)tid * 8) * 4;
#pragma unroll
    for (int e = 0; e < 8; ++e) *(f32x4*)(dst + e * 4) = (v[e] + off) * LOG2E;
    __syncthreads();
}

template <int HALF> __device__ __forceinline__ void sgu_item(int l, int b, int c, const Args& a, unsigned char* lds) {
    const bf16_t* z = (const bf16_t*)(ws_() + WS_Z); bf16_t* y = (bf16_t*)(ws_() + WS_Y);
    LAS bf16_t* vnT = (LAS bf16_t*)lds;
    LAS float* ssb = (LAS float*)(lds + 69632);
    const int tid = opaque_tid(), lane = tid & 63, wid = tid >> 6, fr = lane & 15, quad = lane >> 4;
    const size_t t0 = (size_t)b * SEQ + (size_t)c * 128;
    const float* ng = INP(3) + l * W;
    __syncthreads();
    float gch[4];
#pragma unroll
    for (int e = 0; e < 4; ++e) gch[e] = ng[lane + 64 * e];
    constexpr int TPW = HALF ? 16 : 8;
#pragma unroll
    for (int half = 0; half < TPW / 8; ++half) {
        float val[8][4];
#pragma unroll
        for (int i = 0; i < 8; ++i) {
            const bf16_t* zr = z + (t0 + wid * TPW + half * 8 + i) * ZW + ZC_AV; float ss = 0.f;
#pragma unroll
            for (int e = 0; e < 4; ++e) { const float gv = gelu_t(bf2f(zr[lane + 64 * e])); val[i][e] = gv; ss += gv * gv; }
            ss = wave_sum(ss); const float rs = rsqrtf(ss * (1.0f / W) + EPS);
#pragma unroll
            for (int e = 0; e < 4; ++e) val[i][e] *= rs * gch[e];
        }
#pragma unroll
        for (int e = 0; e < 4; ++e) { float t8[8];
#pragma unroll
            for (int i = 0; i < 8; ++i) t8[i] = val[i][e];
            *(LAS bf16x8*)(vnT + (lane + 64 * e) * 136 + wid * TPW + half * 8) = pack8(t8); }
    }
    __syncthreads();
    const int h = wid & 3;
    const float* wsrc = INP(4) + ((size_t)(l * 4 + h) * 128) * 128;
    const float* bsrc = INP(5) + (size_t)(l * 4 + h) * 128;
    float outv[2][4][4];
#pragma unroll
    for (int i = 0; i < 2; ++i) {
        const int mt = HALF * 4 + (wid >> 2) + 2 * i, t = mt * 16 + fr;
        f32x4 acc[4];
#pragma unroll
        for (int nt = 0; nt < 4; ++nt) acc[nt] = (f32x4){0.f, 0.f, 0.f, 0.f};
        f32x4 wl[4][2];
#pragma unroll
        for (int kk = 0; kk < 4; ++kk) { const int k0 = (kk * 32 < (mt + 1) * 16) ? kk * 32 : 0; const float* wp = wsrc + (size_t)t * 128 + k0 + quad * 8; wl[kk][0] = *(const f32x4*)wp; wl[kk][1] = *(const f32x4*)(wp + 4); }
#pragma unroll
        for (int kk = 0; kk < 4; ++kk) {
            const int k0 = kk * 32;
            if (k0 < (mt + 1) * 16) {
                float wv[8] = {wl[kk][0][0], wl[kk][0][1], wl[kk][0][2], wl[kk][0][3], wl[kk][1][0], wl[kk][1][1], wl[kk][1][2], wl[kk][1][3]};
#pragma unroll
                for (int e = 0; e < 8; ++e) if (k0 + quad * 8 + e > t) wv[e] = 0.f;
                const bf16x8 wf = pack8(wv);
#pragma unroll
                for (int nt = 0; nt < 4; ++nt) { const bf16x8 vf = *(const LAS bf16x8*)(vnT + (h * 64 + nt * 16 + fr) * 136 + k0 + quad * 8); acc[nt] = mfma16(vf, wf, acc[nt]); }
            }
        }
        const float bs = bsrc[t]; float ss = 0.f;
#pragma unroll
        for (int nt = 0; nt < 4; ++nt) { const int ch = h * 64 + nt * 16 + quad * 4; const bf16x4 u4 = *(const bf16x4*)(z + (t0 + t) * ZW + ZC_AU + ch);
#pragma unroll
            for (int r = 0; r < 4; ++r) { const float o = gelu_t(bfs2f(u4[r])) * (acc[nt][r] + bs); outv[i][nt][r] = o; ss += o * o; } }
        ss = quad_sum(ss);
        if (quad == 0) ssb[t * 4 + h] = ss;
    }
    __syncthreads();
#pragma unroll
    for (int i = 0; i < 2; ++i) {
        const int mt = HALF * 4 + (wid >> 2) + 2 * i, t = mt * 16 + fr;
        const float rs = rsqrtf((ssb[t * 4 + 0] + ssb[t * 4 + 1] + ssb[t * 4 + 2] + ssb[t * 4 + 3]) * (1.0f / W) + EPS);
#pragma unroll
        for (int nt = 0; nt < 4; ++nt) { const int ch = h * 64 + nt * 16 + quad * 4; u32x2 w; w.x = pk2(outv[i][nt][0] * rs, outv[i][nt][1] * rs); w.y = pk2(outv[i][nt][2] * rs, outv[i][nt][3] * rs);
            *(u32x2*)(y + (t0 + t) * DM + YC_A + ch) = w; }
    }
    __syncthreads();
}

template <int PASS> __device__ __forceinline__ void s5_item(int l, int b, int c, const Args& a, unsigned char* lds) {
    const bf16_t* z = (const bf16_t*)(ws_() + WS_Z); bf16_t* y = (bf16_t*)(ws_() + WS_Y);
    LAS unsigned char* BU = (LAS unsigned char*)lds;
    LAS unsigned* BU32 = (LAS unsigned*)lds;
    LAS bf16_t* Yb = (LAS bf16_t*)(lds + 65792);
    LAS float* ssb = (LAS float*)(lds + 65792 + 67584);
    const int tid = opaque_tid(), lane = tid & 63, wid = tid >> 6, fr = lane & 15, quad = lane >> 4;
    const int sx0 = wid * 128 + lane, sx1 = sx0 + 64;
    const size_t t0 = (size_t)b * SEQ + (size_t)c * 128;
    const f32x2* abar = (const f32x2*)(ws_() + WS_ABAR) + l * 1024;
    f32x2* eloc = (f32x2*)(ws_() + WS_ELOC);
    float ar[2], ai[2], sre[2], sim[2];
#pragma unroll
    for (int q = 0; q < 2; ++q) { const f32x2 ab = abar[q ? sx1 : sx0]; ar[q] = ab[0]; ai[q] = ab[1]; sre[q] = 0.f; sim[q] = 0.f; }
    if (PASS == 2) {
        const f32x2* a128 = (const f32x2*)(ws_() + WS_A128) + l * 1024;
        const f32x2 p0 = a128[sx0], p1 = a128[sx1];
        for (int cc0 = 0; cc0 < c; cc0 += 8) {
            f32x2 e0[8], e1[8];
#pragma unroll
            for (int u = 0; u < 8; ++u) { const int cc = (cc0 + u < c) ? cc0 + u : c - 1; e0[u] = eloc[((size_t)(b * NCH + cc)) * 1024 + sx0]; e1[u] = eloc[((size_t)(b * NCH + cc)) * 1024 + sx1]; }
#pragma unroll
            for (int u = 0; u < 8; ++u) if (cc0 + u < c) {
                const float nr0 = p0[0] * sre[0] - p0[1] * sim[0] + e0[u][0], ni0 = p0[0] * sim[0] + p0[1] * sre[0] + e0[u][1]; sre[0] = nr0; sim[0] = ni0;
                const float nr1 = p1[0] * sre[1] - p1[1] * sim[1] + e1[u][0], ni1 = p1[0] * sim[1] + p1[1] * sre[1] + e1[u][1]; sre[1] = nr1; sim[1] = ni1; }
        }
    }
    bf16x8 bfrag[2][8];
    const bf16_t* bbt = (const bf16_t*)(ws_() + WS_BBT);
#pragma unroll
    for (int gi = 0; gi < 2; ++gi)
#pragma unroll
        for (int j = 0; j < 8; ++j) bfrag[gi][j] = (quad < 2) ? *(const bf16x8*)(bbt + ((size_t)(l * 16 + wid * 2 + gi) * 128 + j * 16 + fr) * 16 + quad * 8) : zero8();
    bf16x8 cfrag[2][4];
    if (PASS == 2) {
        const bf16_t* cmt = (const bf16_t*)(ws_() + WS_CMT);
#pragma unroll
        for (int gi = 0; gi < 2; ++gi)
#pragma unroll
            for (int ks = 0; ks < 4; ++ks) cfrag[gi][ks] = *(const bf16x8*)(cmt + ((size_t)(l * 16 + wid * 2 + gi) * 16 + fr) * 128 + ks * 32 + quad * 8);
    }
    const float* dsk = INP(13) + l * W;
    __syncthreads();
    bf16x8 ufn[2];
#pragma unroll
    for (int gi = 0; gi < 2; ++gi) ufn[gi] = (quad < 2) ? *(const bf16x8*)(z + (t0 + fr) * ZW + ZC_B + (wid * 2 + gi) * 16 + quad * 8) : zero8();
    for (int sc = 0; sc < 8; ++sc) {
        const size_t tr = t0 + sc * 16 + fr;
        bf16x8 ufc[2] = {ufn[0], ufn[1]};
        bf16x4 u4c[2] = {(bf16x4){0, 0, 0, 0}, (bf16x4){0, 0, 0, 0}};
        if (PASS == 2) {
#pragma unroll
            for (int gi = 0; gi < 2; ++gi) u4c[gi] = *(const bf16x4*)(z + tr * ZW + ZC_B + (wid * 2 + gi) * 16 + quad * 4);
        }
        if (sc < 7) {
#pragma unroll
            for (int gi = 0; gi < 2; ++gi) ufn[gi] = (quad < 2) ? *(const bf16x8*)(z + (tr + 16) * ZW + ZC_B + (wid * 2 + gi) * 16 + quad * 8) : zero8();
        }
#pragma unroll
        for (int gi = 0; gi < 2; ++gi) {
            const int g = wid * 2 + gi;
            const bf16x8 uf = ufc[gi];
#pragma unroll
            for (int j = 0; j < 8; ++j) {
                const f32x4 acc = mfma16(bfrag[gi][j], uf, (f32x4){0.f, 0.f, 0.f, 0.f});
                u32x2 w; w.x = pk2(acc[0], acc[1]); w.y = pk2(acc[2], acc[3]);
                *(LAS u32x2*)(BU + fr * 4112 + (g * 64 + j * 8 + quad * 2) * 4) = w;
            }
        }
        asm volatile("s_waitcnt lgkmcnt(0)" ::: "memory");
        {
            unsigned wv[16][2];
#pragma unroll
            for (int tt = 0; tt < 16; ++tt) { wv[tt][0] = BU32[tt * 1028 + sx0]; wv[tt][1] = BU32[tt * 1028 + sx1]; }
#pragma unroll
            for (int tt = 0; tt < 16; ++tt) {
#pragma unroll
                for (int q = 0; q < 2; ++q) {
                    const unsigned w = wv[tt][q];
                    const f32x2 bu2 = {__uint_as_float(w << 16), __uint_as_float(w & 0xffff0000u)};
                    const f32x2 s2 = {sre[q], sim[q]}, sw = {sim[q], sre[q]}, arr = {ar[q], ar[q]}, aii = {-ai[q], ai[q]};
                    const f32x2 n2 = aii * sw + (arr * s2 + bu2);
                    sre[q] = n2[0]; sim[q] = n2[1];
                    if (PASS == 2) wv[tt][q] = pk2(n2[0], n2[1]);
                }
            }
            if (PASS == 2) {
#pragma unroll
                for (int tt = 0; tt < 16; ++tt) { BU32[tt * 1028 + sx0] = wv[tt][0]; BU32[tt * 1028 + sx1] = wv[tt][1]; }
            }
        }
        asm volatile("s_waitcnt lgkmcnt(0)" ::: "memory");
        if (PASS == 2) {
#pragma unroll
            for (int gi = 0; gi < 2; ++gi) {
                const int g = wid * 2 + gi; f32x4 acc = (f32x4){0.f, 0.f, 0.f, 0.f};
#pragma unroll
                for (int ks = 0; ks < 4; ++ks) { const bf16x8 sf = *(const LAS bf16x8*)(BU + fr * 4112 + g * 256 + (ks * 32 + quad * 8) * 2); acc = mfma16(cfrag[gi][ks], sf, acc); }
                const int ch = g * 16 + quad * 4; const bf16x4 u4 = u4c[gi]; const f32x4 d4 = *(const f32x4*)(dsk + ch);
                float o[4];
#pragma unroll
                for (int r = 0; r < 4; ++r) o[r] = gelu_t(acc[r] + d4[r] * bfs2f(u4[r]));
                u32x2 w; w.x = pk2(o[0], o[1]); w.y = pk2(o[2], o[3]);
                *(LAS u32x2*)(Yb + (sc * 16 + fr) * 264 + ch) = w;
            }
        }
    }
    if (PASS == 1) {
#pragma unroll
        for (int q = 0; q < 2; ++q) eloc[((size_t)(b * NCH + c)) * 1024 + (q ? sx1 : sx0)] = (f32x2){sre[q], sim[q]};
    } else {
        __syncthreads();
        const bf16_t* glut = (const bf16_t*)(ws_() + WS_GLUT) + (size_t)l * W * W;
        const float* glub = INP(15) + l * W;
        bf16x8 gfrag[2][8];
#pragma unroll
        for (int ni = 0; ni < 2; ++ni)
#pragma unroll
            for (int ks = 0; ks < 8; ++ks) gfrag[ni][ks] = *(const bf16x8*)(glut + (size_t)((wid * 2 + ni) * 16 + fr) * W + ks * 32 + quad * 8);
        float outv[8][2][4];
#pragma unroll
        for (int mt = 0; mt < 8; ++mt) {
            f32x4 acc0 = (f32x4){0.f, 0.f, 0.f, 0.f}, acc1 = acc0;
#pragma unroll
            for (int ks = 0; ks < 8; ++ks) { const bf16x8 yf = *(const LAS bf16x8*)(Yb + (mt * 16 + fr) * 264 + ks * 32 + quad * 8); acc0 = mfma16(gfrag[0][ks], yf, acc0); acc1 = mfma16(gfrag[1][ks], yf, acc1); }
            float ss = 0.f;
#pragma unroll
            for (int ni = 0; ni < 2; ++ni) { const int n = (wid * 2 + ni) * 16 + quad * 4; const bf16x4 y4 = *(const LAS bf16x4*)(Yb + (mt * 16 + fr) * 264 + n); const f32x4 gb = *(const f32x4*)(glub + n);
#pragma unroll
                for (int r = 0; r < 4; ++r) { const float gt = (ni == 0 ? acc0[r] : acc1[r]) + gb[r]; const float o = bfs2f(y4[r]) * sigm(gt); outv[mt][ni][r] = o; ss += o * o; } }
            ss = quad_sum(ss);
            if (quad == 0) ssb[(mt * 16 + fr) * 8 + wid] = ss;
        }
        __syncthreads();
#pragma unroll
        for (int mt = 0; mt < 8; ++mt) {
            const int t = mt * 16 + fr; float s = 0.f;
#pragma unroll
            for (int w2 = 0; w2 < 8; ++w2) s += ssb[t * 8 + w2];
            const float rs = rsqrtf(s * (1.0f / W) + EPS);
#pragma unroll
            for (int ni = 0; ni < 2; ++ni) { const int n = (wid * 2 + ni) * 16 + quad * 4; u32x2 w; w.x = pk2(outv[mt][ni][0] * rs, outv[mt][ni][1] * rs); w.y = pk2(outv[mt][ni][2] * rs, outv[mt][ni][3] * rs);
                *(u32x2*)(y + (t0 + t) * DM + YC_B + n) = w; }
        }
    }
    __syncthreads();
}

template <int PASS> __device__ __forceinline__ void lru_item(int l, int b, int c, const Args& a, unsigned char* lds) {
    const bf16_t* z = (const bf16_t*)(ws_() + WS_Z); bf16_t* y = (bf16_t*)(ws_() + WS_Y);
    LAS bf16_t* XC = (LAS bf16_t*)lds;
    LAS float* ssb = (LAS float*)(lds + 67584);
    const int tid = opaque_tid(), lane = tid & 63, wid = tid >> 6, fr = lane & 15, quad = lane >> 4;
    const size_t t0 = (size_t)b * SEQ + (size_t)c * 128;
    float* LAp = (float*)(ws_() + WS_LA); float* LBp = (float*)(ws_() + WS_LB);
    __syncthreads();
    {
        const float* cw = INP(16) + (size_t)l * 4 * W; const float* cb = INP(17) + l * W;
#pragma unroll 4
        for (int it = 0; it < 8; ++it) {
            const int p = tid + 512 * it, tok = p >> 5, ch0 = (p & 31) * 8; float acc[8];
            { const f32x4 c0 = *(const f32x4*)(cb + ch0), c1 = *(const f32x4*)(cb + ch0 + 4); acc[0] = c0[0]; acc[1] = c0[1]; acc[2] = c0[2]; acc[3] = c0[3]; acc[4] = c1[0]; acc[5] = c1[1]; acc[6] = c1[2]; acc[7] = c1[3]; }
#pragma unroll
            for (int k = 0; k < 4; ++k) {
                const int tt = tok - 3 + k;
                if (c * 128 + tt >= 0) {
                    const bf16x8 xv = *(const bf16x8*)(z + (size_t)((long)t0 + tt) * ZW + ZC_CX + ch0);
                    const f32x4 w0 = *(const f32x4*)(cw + k * W + ch0), w1 = *(const f32x4*)(cw + k * W + ch0 + 4);
                    acc[0] += w0[0] * bfs2f(xv[0]); acc[1] += w0[1] * bfs2f(xv[1]); acc[2] += w0[2] * bfs2f(xv[2]); acc[3] += w0[3] * bfs2f(xv[3]);
                    acc[4] += w1[0] * bfs2f(xv[4]); acc[5] += w1[1] * bfs2f(xv[5]); acc[6] += w1[2] * bfs2f(xv[6]); acc[7] += w1[3] * bfs2f(xv[7]);
                }
            }
            *(LAS bf16x8*)(XC + tok * 264 + ch0) = pack8(acc);
        }
    }
    __syncthreads();
    const int hh = wid >> 1;
    const bf16_t* wat = (const bf16_t*)(ws_() + WS_WAT) + (size_t)(l * 4 + hh) * 64 * 64;
    const bf16_t* wxt = (const bf16_t*)(ws_() + WS_WXT) + (size_t)(l * 4 + hh) * 64 * 64;
    bf16x8 waf[2][2], wxf[2][2]; float sp8[2][4], bav[2][4], bxv[2][4], H[2][4], Acar[2][4], Bcar[2][4];
#pragma unroll
    for (int ni = 0; ni < 2; ++ni) {
        const int nl = (wid * 2 + ni) * 16 - hh * 64 + fr;
#pragma unroll
        for (int ks = 0; ks < 2; ++ks) { waf[ni][ks] = *(const bf16x8*)(wat + nl * 64 + ks * 32 + quad * 8); wxf[ni][ks] = *(const bf16x8*)(wxt + nl * 64 + ks * 32 + quad * 8); }
#pragma unroll
        for (int r = 0; r < 4; ++r) { const int ch = (wid * 2 + ni) * 16 + quad * 4 + r;
            sp8[ni][r] = 8.0f * softplus_f(-INP(22)[l * W + ch]); bav[ni][r] = INP(19)[l * W + ch]; bxv[ni][r] = INP(21)[l * W + ch];
            H[ni][r] = 0.f; Acar[ni][r] = 1.f; Bcar[ni][r] = 0.f;
        }
    }
    if (PASS == 2 && c > 0) {
#pragma unroll
        for (int ni = 0; ni < 2; ++ni) {
            const size_t ob = (size_t)(b * NCH) * W + (wid * 2 + ni) * 16 + quad * 4;
            const bool v0 = fr < c, v1 = 16 + fr < c;
            f32x4 a0 = (f32x4){1.f, 1.f, 1.f, 1.f}, b0 = (f32x4){0.f, 0.f, 0.f, 0.f}, a1 = a0, b1 = b0;
            if (v0) { a0 = *(const f32x4*)(LAp + ob + (size_t)fr * W); b0 = *(const f32x4*)(LBp + ob + (size_t)fr * W); }
            if (v1) { a1 = *(const f32x4*)(LAp + ob + (size_t)(16 + fr) * W); b1 = *(const f32x4*)(LBp + ob + (size_t)(16 + fr) * W); }
#pragma unroll
            for (int r = 0; r < 4; ++r) {
                float av = a0[r], bb = b0[r], aw = a1[r], bw = b1[r], ap, bp;
                ap = dpp_shr<1>(av, 1.0f); bp = dpp_shr<1>(bb, 0.0f); bb = av * bp + bb; av = av * ap;   ap = dpp_shr<1>(aw, 1.0f); bp = dpp_shr<1>(bw, 0.0f); bw = aw * bp + bw; aw = aw * ap;
                ap = dpp_shr<2>(av, 1.0f); bp = dpp_shr<2>(bb, 0.0f); bb = av * bp + bb; av = av * ap;   ap = dpp_shr<2>(aw, 1.0f); bp = dpp_shr<2>(bw, 0.0f); bw = aw * bp + bw; aw = aw * ap;
                ap = dpp_shr<4>(av, 1.0f); bp = dpp_shr<4>(bb, 0.0f); bb = av * bp + bb; av = av * ap;   ap = dpp_shr<4>(aw, 1.0f); bp = dpp_shr<4>(bw, 0.0f); bw = aw * bp + bw; aw = aw * ap;
                ap = dpp_shr<8>(av, 1.0f); bp = dpp_shr<8>(bb, 0.0f); bb = av * bp + bb; av = av * ap;   ap = dpp_shr<8>(aw, 1.0f); bp = dpp_shr<8>(bw, 0.0f); bw = aw * bp + bw; aw = aw * ap;
                const float B0t = __shfl(bb, 15, 16), A1t = __shfl(aw, 15, 16), B1t = __shfl(bw, 15, 16);
                H[ni][r] = A1t * B0t + B1t;
            }
        }
    }
    LAS bf16_t* Ob = (LAS bf16_t*)(lds + 67584 + 4096);
#pragma unroll 2
    for (int mt = 0; mt < 8; ++mt) {
        bf16x8 xf[2];
#pragma unroll
        for (int ks = 0; ks < 2; ++ks) xf[ks] = *(const LAS bf16x8*)(XC + (mt * 16 + fr) * 264 + hh * 64 + ks * 32 + quad * 8);
        float ss = 0.f;
#pragma unroll
        for (int ni = 0; ni < 2; ++ni) {
            f32x4 accA = (f32x4){0.f, 0.f, 0.f, 0.f}, accX = accA;
#pragma unroll
            for (int ks = 0; ks < 2; ++ks) { accA = mfma16(waf[ni][ks], xf[ks], accA); accX = mfma16(wxf[ni][ks], xf[ks], accX); }
            const int ch0 = (wid * 2 + ni) * 16 + quad * 4;
            const bf16x4 xc4 = *(const LAS bf16x4*)(XC + (mt * 16 + fr) * 264 + ch0);
            bf16x4 g4 = (bf16x4){0, 0, 0, 0};
            if (PASS == 2) g4 = *(const bf16x4*)(z + (t0 + mt * 16 + fr) * ZW + ZC_CG + ch0);
            float ov[4] = {0.f, 0.f, 0.f, 0.f};
#pragma unroll
            for (int r = 0; r < 4; ++r) {
                const float rg = sigm(accA[r] + bav[ni][r]), ig = sigm(accX[r] + bxv[ni][r]);
                const float la = -rg * sp8[ni][r];
                float av = __builtin_amdgcn_exp2f(LOG2E * la), bb = __builtin_amdgcn_sqrtf(fmaxf(neg_expm1(2.0f * la), 0.f)) * (ig * bfs2f(xc4[r]));
                { float ap, bp;
                  ap = dpp_shr<1>(av, 1.0f); bp = dpp_shr<1>(bb, 0.0f); bb = av * bp + bb; av = av * ap;
                  ap = dpp_shr<2>(av, 1.0f); bp = dpp_shr<2>(bb, 0.0f); bb = av * bp + bb; av = av * ap;
                  ap = dpp_shr<4>(av, 1.0f); bp = dpp_shr<4>(bb, 0.0f); bb = av * bp + bb; av = av * ap;
                  ap = dpp_shr<8>(av, 1.0f); bp = dpp_shr<8>(bb, 0.0f); bb = av * bp + bb; av = av * ap; }
                if (PASS == 1) { const float At = __shfl(av, 15, 16), Bt = __shfl(bb, 15, 16); Bcar[ni][r] = At * Bcar[ni][r] + Bt; Acar[ni][r] *= At; }
                else { const float hv = av * H[ni][r] + bb; H[ni][r] = __shfl(hv, 15, 16); const float o = hv * gelu_t(bfs2f(g4[r])); ov[r] = o; ss += o * o; }
            }
            if (PASS == 2) { u32x2 w; w.x = pk2(ov[0], ov[1]); w.y = pk2(ov[2], ov[3]); *(LAS u32x2*)(Ob + (mt * 16 + fr) * 264 + ch0) = w; }
        }
        if (PASS == 2) { ss = quad_sum(ss); if (quad == 0) ssb[(mt * 16 + fr) * 8 + wid] = ss; }
    }
    if (PASS == 1) {
        if (fr == 0) {
#pragma unroll
            for (int ni = 0; ni < 2; ++ni)
#pragma unroll
                for (int r = 0; r < 4; ++r) { const size_t o = ((size_t)(b * NCH + c)) * W + (wid * 2 + ni) * 16 + quad * 4 + r; LAp[o] = Acar[ni][r]; LBp[o] = Bcar[ni][r]; }
        }
        {
            const int tok = tid >> 2, hd = tid & 3; float s2 = 0.f;
#pragma unroll
            for (int j = 0; j < 8; ++j) { const bf16x8 kv = *(const bf16x8*)(z + (t0 + tok) * ZW + ZC_K + hd * 64 + j * 8);
#pragma unroll
                for (int e = 0; e < 8; ++e) { const float f = bfs2f(kv[e]); s2 += f * f; } }
            ssb[tok * 4 + hd] = s2;
            __syncthreads();
            if (tid < 4) { float mxv = 0.f; for (int i = 0; i < 128; ++i) mxv = fmaxf(mxv, ssb[i * 4 + tid]); ((float*)(ws_() + WS_KMAX))[(b * NCH + c) * 4 + tid] = mxv; }
        }
    } else {
        __syncthreads();
#pragma unroll 2
        for (int mt = 0; mt < 8; ++mt) {
            const int t = mt * 16 + fr; float s = 0.f;
#pragma unroll
            for (int w2 = 0; w2 < 8; ++w2) s += ssb[t * 8 + w2];
            const float rs = rsqrtf(s * (1.0f / W) + EPS);
#pragma unroll
            for (int ni = 0; ni < 2; ++ni) { const int n = (wid * 2 + ni) * 16 + quad * 4; const bf16x4 o4 = *(const LAS bf16x4*)(Ob + t * 264 + n);
                u32x2 w; w.x = pk2(bfs2f(o4[0]) * rs, bfs2f(o4[1]) * rs); w.y = pk2(bfs2f(o4[2]) * rs, bfs2f(o4[3]) * rs);
                *(u32x2*)(y + (t0 + t) * DM + YC_C + n) = w; }
        }
    }
    __syncthreads();
}

template <bool DIAG> __device__ __forceinline__ void attn_step2(const LAS unsigned char* buf, int kbase, int qrow0, int quad, int fr, const bf16x8 (&qf)[2][2], float (&m)[2], float (&lsum)[2], f32x4 (&oacc)[2][4]) {
    const LAS bf16_t* Kt = (const LAS bf16_t*)buf; const LAS bf16_t* Vt = (const LAS bf16_t*)(buf + 9216); const LAS float* csl = (const LAS float*)(buf + 18432);
    float p[2][4][4];
#pragma unroll
    for (int st = 0; st < 4; ++st) {
        const f32x4 c4 = *(const LAS f32x4*)(csl + st * 16 + quad * 4);
        const bf16x8 kf0 = *(const LAS bf16x8*)(Kt + (st * 16 + fr) * 72 + quad * 8), kf1 = *(const LAS bf16x8*)(Kt + (st * 16 + fr) * 72 + 32 + quad * 8);
#pragma unroll
        for (int qs = 0; qs < 2; ++qs) {
            f32x4 acc = mfma16(kf0, qf[qs][0], c4); acc = mfma16(kf1, qf[qs][1], acc);
#pragma unroll
            for (int r = 0; r < 4; ++r) { float v = acc[r]; if (DIAG && (kbase + st * 16 + quad * 4 + r > qrow0 + qs * 16)) v = -1e30f; p[qs][st][r] = v; }
        }
    }
    bf16x8 pf[2][2]; float alpha[2];
#pragma unroll
    for (int qs = 0; qs < 2; ++qs) {
        float mx = -1e30f;
#pragma unroll
        for (int st = 0; st < 4; ++st)
#pragma unroll
            for (int r = 0; r < 4; ++r) mx = fmaxf(mx, p[qs][st][r]);
        mx = quad_max(mx);
        const float mnew = fmaxf(m[qs], mx); alpha[qs] = __builtin_amdgcn_exp2f(m[qs] - mnew); m[qs] = mnew;
        float ps = 0.f;
#pragma unroll
        for (int st = 0; st < 4; ++st)
#pragma unroll
            for (int r = 0; r < 4; ++r) { const float e = __builtin_amdgcn_exp2f(p[qs][st][r] - mnew); p[qs][st][r] = e; ps += e; }
        lsum[qs] = lsum[qs] * alpha[qs] + ps;
#pragma unroll
        for (int ks = 0; ks < 2; ++ks) { u32x4 w; w.x = pk2(p[qs][2 * ks][0], p[qs][2 * ks][1]); w.y = pk2(p[qs][2 * ks][2], p[qs][2 * ks][3]); w.z = pk2(p[qs][2 * ks + 1][0], p[qs][2 * ks + 1][1]); w.w = pk2(p[qs][2 * ks + 1][2], p[qs][2 * ks + 1][3]); pf[qs][ks] = __builtin_bit_cast(bf16x8, w); }
    }
#pragma unroll
    for (int dt = 0; dt < 4; ++dt) {
        oacc[0][dt] = oacc[0][dt] * alpha[0]; oacc[1][dt] = oacc[1][dt] * alpha[1];
#pragma unroll
        for (int ks = 0; ks < 2; ++ks) {
            const bf16x4 v0 = *(const LAS bf16x4*)(Vt + (dt * 16 + fr) * 72 + ks * 32 + quad * 4), v1 = *(const LAS bf16x4*)(Vt + (dt * 16 + fr) * 72 + ks * 32 + 16 + quad * 4);
            const bf16x8 vf = (bf16x8){v0[0], v0[1], v0[2], v0[3], v1[0], v1[1], v1[2], v1[3]};
            oacc[0][dt] = mfma16(vf, pf[0][ks], oacc[0][dt]); oacc[1][dt] = mfma16(vf, pf[1][ks], oacc[1][dt]);
        }
    }
}
__device__ __forceinline__ void attn_unit(int b, int h, int qb, const Args& a, unsigned char* lds) {
    const bf16_t* z = (const bf16_t*)(ws_() + WS_Z); bf16_t* y = (bf16_t*)(ws_() + WS_Y);
    const float* cs = (const float*)(ws_() + WS_CS); float* ssd = (float*)(ws_() + WS_SSD);
    constexpr int ABUF = 9216 + 9216 + 256;
    LAS unsigned char* lb = (LAS unsigned char*)lds;
    const int tid = opaque_tid(), lane = tid & 63, wid = tid >> 6, fr = lane & 15, quad = lane >> 4, grp = wid >> 2, wq = wid & 3;
    const int q0 = qb * 128, qw = q0 + wq * 32, qrow0 = qw + fr;
    const size_t rb = (size_t)b * SEQ;
    bf16x8 qf[2][2];
    {
        const float SC = 0.125f * LOG2E;
#pragma unroll
        for (int qs = 0; qs < 2; ++qs)
#pragma unroll
            for (int ds = 0; ds < 2; ++ds) { const bf16x8 qv = *(const bf16x8*)(z + (rb + qrow0 + qs * 16) * ZW + ZC_Q + h * 64 + ds * 32 + quad * 8); float t8[8];
#pragma unroll
                for (int e = 0; e < 8; ++e) t8[e] = bfs2f(qv[e]) * SC;
                qf[qs][ds] = pack8(t8); }
    }
    float m[2] = {-1e30f, -1e30f}, lsum[2] = {0.f, 0.f}; f32x4 oacc[2][4];
#pragma unroll
    for (int qs = 0; qs < 2; ++qs)
#pragma unroll
        for (int dt = 0; dt < 4; ++dt) oacc[qs][dt] = (f32x4){0.f, 0.f, 0.f, 0.f};
    float qbnd[2];
    {
        float kv = (lane <= qb) ? ((const float*)(ws_() + WS_KMAX))[(b * NCH + lane) * 4 + h] : 0.f;
        kv = wave_max(kv);
        const float kmax = __builtin_amdgcn_sqrtf(kv) * 1.01f + 1e-3f;
#pragma unroll
        for (int qs = 0; qs < 2; ++qs) { float q2 = 0.f;
#pragma unroll
            for (int ds = 0; ds < 2; ++ds)
#pragma unroll
                for (int e = 0; e < 8; ++e) { const float f = bfs2f(qf[qs][ds][e]); q2 += f * f; }
            q2 = quad_sum(q2); qbnd[qs] = (__builtin_amdgcn_sqrtf(q2) * 1.01f + 1e-3f) * kmax; }
    }
    const int NSS = qb + 1;
    volatile LAS unsigned* vote = (volatile LAS unsigned*)(lds + LDS_BYTES - 64);
    if (tid < 3) vote[tid] = 0u;
    bf16x8 kreg[2], vreg[2]; float creg = 0.f;
#define ATT_LOAD(S) do { const size_t kb_ = rb + (size_t)(S) * 128; \
        _Pragma("unroll") for (int p_ = 0; p_ < 2; ++p_) { const int id_ = tid + 512 * p_; \
            kreg[p_] = *(const bf16x8*)(z + (kb_ + (id_ >> 3)) * ZW + ZC_K + h * 64 + (id_ & 7) * 8); \
            vreg[p_] = *(const bf16x8*)(z + (kb_ + 2 * (tid & 63) + p_) * ZW + ZC_V + h * 64 + (tid >> 6) * 8); } \
        if (tid < 128) creg = cs[(kb_ + tid) * 4 + h]; } while (0)
#define ATT_STORE(S) do { LAS unsigned char* bb_ = lb + ((S) & 1) * (2 * ABUF); \
        _Pragma("unroll") for (int p_ = 0; p_ < 2; ++p_) { const int id_ = tid + 512 * p_; const int k128_ = id_ >> 3; \
            *(LAS bf16x8*)((LAS bf16_t*)(bb_ + (k128_ >> 6) * ABUF) + (k128_ & 63) * 72 + (id_ & 7) * 8) = kreg[p_]; } \
        { LAS unsigned* vt_ = (LAS unsigned*)(bb_ + ((tid & 63) >> 5) * ABUF + 9216);     \
            _Pragma("unroll") for (int e_ = 0; e_ < 8; ++e_) vt_[(((tid >> 6) * 8 + e_) * 72 + ((2 * (tid & 63)) & 63)) >> 1] = (unsigned)(unsigned short)vreg[0][e_] | ((unsigned)(unsigned short)vreg[1][e_] << 16); } \
        if (tid < 128) ((LAS float*)(bb_ + (tid >> 6) * ABUF + 18432))[tid & 63] = -creg; } while (0)
    ATT_LOAD(NSS - 1); ATT_STORE(NSS - 1);
    if (NSS > 1) ATT_LOAD(NSS - 2);
    __syncthreads();
    int kstep = 0;
    for (int S = NSS - 1; S >= 0; --S) {
        if (S >= 1) ATT_STORE(S - 1);
        if (S >= 2) ATT_LOAD(S - 2);
        float cl = 0.f; if (S >= 1) cl = cs[(rb + (size_t)(S - 1) * 128 + 127) * 4 + h];
        const int kbase = S * 128 + grp * 64;
        const LAS unsigned char* hb = lb + (S & 1) * (2 * ABUF) + grp * ABUF;
        if (S + 1 < NSS) attn_step2<false>(hb, kbase, qrow0, quad, fr, qf, m, lsum, oacc);
        else if (kbase <= qw + 31) attn_step2<true>(hb, kbase, qrow0, quad, fr, qf, m, lsum, oacc);
        const bool need = (S >= 1) && ((qbnd[0] - cl - m[0] >= -160.f) || (qbnd[1] - cl - m[1] >= -160.f));
        const int vw = kstep % 3;
        if (need) vote[vw] = 1u;
        __syncthreads();
        const unsigned go = vote[vw];
        if (tid == 0) vote[(kstep + 2) % 3] = 0u;
        ++kstep;
        if (!go) break;
    }
#undef ATT_LOAD
#undef ATT_STORE
    LAS float* mg = (LAS float*)lb;
    const int ml = wq * 64 + lane;
    if (grp == 1) {
#pragma unroll
        for (int qs = 0; qs < 2; ++qs) { mg[(qs * 18 + 0) * 256 + ml] = m[qs]; mg[(qs * 18 + 1) * 256 + ml] = lsum[qs];
#pragma unroll
            for (int dt = 0; dt < 4; ++dt)
#pragma unroll
                for (int r = 0; r < 4; ++r) mg[(qs * 18 + 2 + dt * 4 + r) * 256 + ml] = oacc[qs][dt][r]; }
    }
    __syncthreads();
    if (grp == 0) {
#pragma unroll
        for (int qs = 0; qs < 2; ++qs) {
            const float m1 = mg[(qs * 18 + 0) * 256 + ml], l1 = mg[(qs * 18 + 1) * 256 + ml];
            const float mt = fmaxf(m[qs], m1), f0 = __builtin_amdgcn_exp2f(m[qs] - mt), f1 = __builtin_amdgcn_exp2f(m1 - mt);
            float lt = quad_sum(lsum[qs] * f0 + l1 * f1);
            const float inv = 1.0f / lt; float ss = 0.f;
            const size_t tq = rb + qrow0 + qs * 16;
#pragma unroll
            for (int dt = 0; dt < 4; ++dt) { f32x4 o;
#pragma unroll
                for (int r = 0; r < 4; ++r) { o[r] = (oacc[qs][dt][r] * f0 + mg[(qs * 18 + 2 + dt * 4 + r) * 256 + ml] * f1) * inv; ss += o[r] * o[r]; }
                u32x2 w; w.x = pk2(o[0], o[1]); w.y = pk2(o[2], o[3]); *(u32x2*)(y + tq * DM + YC_D + h * 64 + dt * 16 + quad * 4) = w; }
            ss = quad_sum(ss);
            if (quad == 0) ssd[tq * 4 + h] = ss;
        }
    }
    __syncthreads();
}

#define XB_TMO      128
#define XB_XCNT(j)  (256  + 64 * (j))
#define XB_XSUB(j)  (1280 + 64 * (j))
#define XB_XGEN(j)  (2304 + 64 * (j))
#define XB_TOP      3328
#define XB_TOPGEN   3392
#define XCD_BAR_WORDS 3456
#define XB_SPIN_CAP (1u << 18)

__device__ __forceinline__ unsigned xb_ld(unsigned* p)              { return __hip_atomic_load(p, __ATOMIC_RELAXED, __HIP_MEMORY_SCOPE_AGENT); }
__device__ __forceinline__ unsigned xb_add(unsigned* p, unsigned v) { return __hip_atomic_fetch_add(p, v, __ATOMIC_RELAXED, __HIP_MEMORY_SCOPE_AGENT); }
__device__ __forceinline__ unsigned xb_xcc_id() { return (unsigned)__builtin_amdgcn_s_getreg((3 << 11) | 20) & 0xFu; }
#define XB_SPIN(cond, bar) do { unsigned _sp = 0; while (cond) { __builtin_amdgcn_s_sleep(1); \
    if ((++_sp & 255u) == 0u) { if (xb_ld(&(bar)[XB_TMO])) break; if (_sp > XB_SPIN_CAP) { atomicAdd(&(bar)[XB_TMO], 1u); break; } } } } while (0)

struct XcdBarrier {
    unsigned* bar; unsigned x;
    volatile LAS unsigned* st;
};

__device__ __forceinline__ XcdBarrier xcd_barrier_post(unsigned* bar, volatile LAS unsigned* st) {
    XcdBarrier b; b.bar = bar; b.x = xb_xcc_id(); b.st = st;
    if (opaque_tid() == 0) (void)xb_add(&bar[XB_XCNT(b.x)], 1u);
    return b;
}
__device__ __forceinline__ void xcd_barrier_complete(unsigned* bar, unsigned x, unsigned& nloc, unsigned& nx) {
    const unsigned G = gridDim.x * gridDim.y * gridDim.z;
    unsigned sum, cnt, mine, sp = 0u;
    for (;;) {
        sum = 0u; cnt = 0u; mine = 0u;
#pragma unroll
        for (unsigned j = 0; j < 16; ++j) { const unsigned c = xb_ld(&bar[XB_XCNT(j)]); sum += c; cnt += (c > 0u) ? 1u : 0u; mine = (j == x) ? c : mine; }
        if (sum == G) break;
        __builtin_amdgcn_s_sleep(1);
        if ((++sp & 255u) == 0u) { if (xb_ld(&bar[XB_TMO])) break; if (sp > XB_SPIN_CAP) { atomicAdd(&bar[XB_TMO], 1u); break; } }
    }
    nloc = mine > 0u ? mine : 1u; nx = cnt > 0u ? cnt : 1u;
}

__device__ __forceinline__ void xcd_barrier(const XcdBarrier& b) {
    asm volatile("s_waitcnt vmcnt(0)" ::: "memory");
    __syncthreads();
    if (opaque_tid() == 0) {
        unsigned* bar = b.bar;
        __builtin_amdgcn_s_waitcnt(0);
        unsigned nloc = b.st[0], nx = b.st[1];
        if (nloc == 0u) { xcd_barrier_complete(bar, b.x, nloc, nx); b.st[0] = nloc; b.st[1] = nx; }
        const unsigned old = xb_add(&bar[XB_XSUB(b.x)], 1u);
        const unsigned gen = old / nloc;
        if (old + 1u == (gen + 1u) * nloc) {
            __builtin_amdgcn_fence(__ATOMIC_RELEASE, "agent");
            asm volatile("s_waitcnt vmcnt(0)" ::: "memory");
            const unsigned og = xb_add(&bar[XB_TOP], 1u);
            const unsigned tg = og / nx;
            if (og + 1u == (tg + 1u) * nx) xb_add(&bar[XB_TOPGEN], 1u);
            else XB_SPIN(xb_ld(&bar[XB_TOPGEN]) == tg, bar);
            __builtin_amdgcn_fence(__ATOMIC_ACQUIRE, "agent");
            xb_add(&bar[XB_XGEN(b.x)], 1u);
            asm volatile("s_waitcnt vmcnt(0)" ::: "memory");
        } else {
            XB_SPIN(xb_ld(&bar[XB_XGEN(b.x)]) == gen, bar);
            __builtin_amdgcn_fence(__ATOMIC_ACQUIRE, "agent");
            asm volatile("s_waitcnt vmcnt(0)" ::: "memory");
        }
    }
    __syncthreads();
}

#ifndef PROBE_DUP
#define PROBE_DUP 0
#endif
#ifndef ITEM_MASK
#define ITEM_MASK 127
#endif
__global__ void __launch_bounds__(NTHR, 2) fwd_kernel(Args a) {
    extern __shared__ __attribute__((aligned(16))) unsigned char lds[];
    {
        volatile LAS unsigned* bst0 = (volatile LAS unsigned*)(lds + LDS_BYTES - 16);
        if (opaque_tid() == 0) { bst0[0] = 0u; bst0[1] = 0u; }
        __syncthreads();
        (void)xcd_barrier_post((unsigned*)(ws_() + WS_BAR), bst0);
    }
    if (PH_HI > 4096) cg::this_grid().sync();
#define SEAM(k) do { if ((k) + 1 < PH_HI) { XcdBarrier xb_; xb_.bar = (unsigned*)(ws_() + WS_BAR); xb_.x = xb_xcc_id(); xb_.st = (volatile LAS unsigned*)(lds + LDS_BYTES - 16); xcd_barrier(xb_); if (PROBE_DUP == 1) xcd_barrier(xb_); } } while (0)
#define IN(k) (PH_LO <= (k) && (k) < PH_HI)
    if (IN(0)) { prep_phase(a, lds); if (PROBE_DUP == 4) prep_phase(a, lds); SEAM(0); }
    for (int l = 0; l < DEPTH; ++l) {
        const int pb = 1 + 8 * l;
        if (IN(pb + 0)) {
            if (l == 0) norm_phase<false, 1>(INP(0), INP(1) + l * DM, (bf16_t*)out_(), (bf16_t*)(ws_() + WS_H), nullptr, (const float*)(ws_() + WS_WF) + (size_t)l * DM * 4, INP(23) + l * 4, (float*)(ws_() + WS_LOGF));
            else norm_phase<true, 1>(ws_() + WS_H, INP(1) + l * DM, (bf16_t*)out_(), nullptr, nullptr, (const float*)(ws_() + WS_WF) + (size_t)l * DM * 4, INP(23) + l * 4, (float*)(ws_() + WS_LOGF));
            SEAM(pb + 0);
        }
        if (IN(pb + 1)) {
            pg8::Gemm g{(const pg8::bf16_t*)out_(), (const pg8::bf16_t*)(ws_() + WS_WIN) + (size_t)l * ZW * DM, T, ZW, DM}; pg8::StaticOrder S; S.init(T, ZW, grid_(), bid_());
            EpiStoreBf16<0> E{(bf16_t*)(ws_() + WS_Z), ZW, nullptr};
            pg8::gemm_phase<EpiStoreBf16<0>, pg8::StaticOrder, true, true>((PG8_LAS unsigned char*)lds, g, S, E);
            SEAM(pb + 1);
        }
        if (IN(pb + 2)) {
            for (int rep = 0; rep < (PROBE_DUP == 2 ? 2 : 1); ++rep)
            for (int it = bid_(); it < 260; it += grid_()) {
                if (it < 128) { if (ITEM_MASK & 1) s5_item<1>(l, it >> 5, it & 31, a, lds); }
                else if (it < 256) { if (ITEM_MASK & 4) lru_item<1>(l, (it - 128) >> 5, (it - 128) & 31, a, lds); }
                else { if (ITEM_MASK & 8) cumsum_item(it - 256, (const float*)(ws_() + WS_LOGF), (float*)(ws_() + WS_CS), lds); }
            }
            SEAM(pb + 2);
        }
        if (IN(pb + 3)) {
            for (int rep = 0; rep < (PROBE_DUP == 3 ? 2 : 1); ++rep) {
            for (int rep2 = 0; rep2 < (PROBE_DUP == 5 ? 2 : 1); ++rep2)
            for (int up = bid_(); up < 256; up += grid_()) {
                const int pr = up >> 4, j = up & 15;
                if (ITEM_MASK & 16) { attn_unit(pr >> 2, pr & 3, 31 - j, a, lds);
                attn_unit(pr >> 2, pr & 3, j, a, lds); }
            }
            for (int rep3 = 0; rep3 < (PROBE_DUP == 6 ? 2 : 1); ++rep3)
            for (int it = bid_(); it < 256; it += grid_()) {
                if (it < 128) { if (ITEM_MASK & 32) s5_item<2>(l, it >> 5, it & 31, a, lds); }
                else { if (ITEM_MASK & 64) lru_item<2>(l, (it - 128) >> 5, (it - 128) & 31, a, lds); }
            }
            if (ITEM_MASK & 2) {
                unsigned* qctr = (unsigned*)(ws_() + WS_BAR) + 3600 + l;
                volatile LAS unsigned* qslot = (volatile LAS unsigned*)(lds + LDS_BYTES - 48);
                for (;;) {
                    __syncthreads();
                    if (opaque_tid() == 0) qslot[0] = __hip_atomic_fetch_add(qctr, 1u, __ATOMIC_RELAXED, __HIP_MEMORY_SCOPE_AGENT);
                    __syncthreads();
                    const unsigned qi = qslot[0];
                    if (qi >= 256u) break;
                    if (qi < 128u) sgu_item<1>(l, (int)(qi >> 5), (int)(qi & 31), a, lds);
                    else sgu_item<0>(l, (int)((qi - 128u) >> 5), (int)(qi & 31), a, lds);
                }
            }
            }
            SEAM(pb + 3);
        }
        if (IN(pb + 4)) {
            pg8::Gemm g{(const pg8::bf16_t*)(ws_() + WS_Y), (const pg8::bf16_t*)(ws_() + WS_WOUT) + (size_t)l * DM * DM, T, DM, DM}; pg8::StaticOrder S; S.init(T, DM, grid_(), bid_());
            EpiRes<true, true> E{(bf16_t*)(ws_() + WS_H), DM, (const float*)(ws_() + WS_SSD), (float*)(ws_() + WS_SS2)};
            pg8::gemm_phase<EpiRes<true, true>, pg8::StaticOrder, true, true>((PG8_LAS unsigned char*)lds, g, S, E);
            SEAM(pb + 4);
        }
        if (IN(pb + 6)) {
            pg8::Gemm g{(const pg8::bf16_t*)(ws_() + WS_H), (const pg8::bf16_t*)(ws_() + WS_WMI) + (size_t)l * DFF * DM, T, DFF, DM}; pg8::StaticOrder S; S.init(T, DFF, grid_(), bid_());
            EpiStoreBf16<1, true> E{(bf16_t*)(ws_() + WS_ACT), DFF, (const float*)(ws_() + WS_SS2)};
            pg8::gemm_phase<EpiStoreBf16<1, true>, pg8::StaticOrder, true, true>((PG8_LAS unsigned char*)lds, g, S, E);
            SEAM(pb + 6);
        }
        if (IN(pb + 7)) {
            pg8::Gemm g{(const pg8::bf16_t*)(ws_() + WS_ACT), (const pg8::bf16_t*)(ws_() + WS_WMO) + (size_t)l * DM * DFF, T, DM, DFF}; pg8::StaticOrder S; S.init(T, DM, grid_(), bid_());
            EpiRes<false, false> E{(bf16_t*)(ws_() + WS_H), DM, nullptr, nullptr};
            pg8::gemm_phase<EpiRes<false, false>, pg8::StaticOrder, true, true>((PG8_LAS unsigned char*)lds, g, S, E);
            SEAM(pb + 7);
        }
    }
    if (IN(33)) norm_phase<true, 2>(ws_() + WS_H, INP(29), nullptr, nullptr, out_(), nullptr, nullptr, nullptr);
#undef SEAM
#undef IN
}


#ifndef DUMP_SEL
#define DUMP_SEL 0
#endif
#ifndef DUMP_LAST
#define DUMP_LAST 33
#endif
__global__ void dump_kernel(const unsigned char* ws, float* out) {
    const size_t i = (size_t)blockIdx.x * blockDim.x + threadIdx.x;
    const size_t t = i >> 10, c = i & 1023;
    float v = 0.f;
    if (DUMP_SEL == 1) v = bf2f(((const bf16_t*)(ws + WS_H))[i]);
    if (DUMP_SEL == 2) v = bf2f(((const bf16_t*)(ws + WS_Z))[t * ZW + c]) + bf2f(((const bf16_t*)(ws + WS_Z))[t * ZW + c + 1024]);
    if (DUMP_SEL == 3) v = bf2f(((const bf16_t*)(ws + WS_Y))[i]);
    if (DUMP_SEL == 5) v = ((const float*)(ws + WS_SSD))[(t * 4 + (c & 3))] + ((const float*)(ws + WS_CS))[(t * 4 + (c & 3))];
    if (DUMP_SEL == 7) v = ((const float*)(ws + WS_ELOC))[i & 262143];
    if (DUMP_SEL == 8) v = ((const float*)(ws + WS_LA))[i & 32767] + ((const float*)(ws + WS_LB))[i & 32767];
    if (DUMP_SEL == 6) v = bf2f(((const bf16_t*)(ws + WS_WIN))[i]) + bf2f(((const bf16_t*)(ws + WS_WMI))[i]) + bf2f(((const bf16_t*)(ws + WS_WMO))[i]) + bf2f(((const bf16_t*)(ws + WS_WOUT))[i & 0x3fffff]);
    out[i] = v;
}
#ifndef N_LAUNCH_MODE
#define N_LAUNCH_MODE 1
#endif
extern "C" void kernel_launch(void* const* d_in, const int* in_sizes, int n_in, void* d_out, int out_size, void* d_ws, size_t ws_size, hipStream_t stream) {
    static int grid = 0;
    if (grid == 0) {
        if (n_in != 30 || out_size != T * DM || ws_size < WS_END) { fprintf(stderr, "kernel_launch: unexpected shapes (n_in %d, out %d, ws %zu, need %zu)\n", n_in, out_size, ws_size, (size_t)WS_END); grid = -1; return; }
        int dev = 0, cus = 0, per_cu = 0;
        hipGetDevice(&dev); hipDeviceGetAttribute(&cus, hipDeviceAttributeMultiprocessorCount, dev);
        if (hipFuncSetAttribute((const void*)fwd_kernel, hipFuncAttributeMaxDynamicSharedMemorySize, LDS_BYTES) != hipSuccess) { fprintf(stderr, "kernel_launch: hipFuncSetAttribute failed\n"); grid = -1; return; }
        if (hipOccupancyMaxActiveBlocksPerMultiprocessor(&per_cu, (const void*)fwd_kernel, NTHR, LDS_BYTES) != hipSuccess || per_cu < 1) { fprintf(stderr, "kernel_launch: occupancy query says %d\n", per_cu); per_cu = 1; }
        (void)hipGetLastError();
        grid = cus;
        if (grid > 256) grid = 256;
    }
    if (grid < 0) return;
    Args a{};
    for (int i = 0; i < 30; ++i) a.in[i] = (const float*)d_in[i];
    a.out = (float*)d_out; a.ws = (unsigned char*)d_ws;
    if (N_LAUNCH_MODE == 1) {
        a.ph_lo = 0; a.ph_hi = 34;
        if (hipMemsetAsync((unsigned char*)d_ws + WS_BAR, 0, 16 * 1024, stream) != hipSuccess) { fprintf(stderr, "kernel_launch: memset of the barrier words failed\n"); return; }
        void* args[] = {&a};
        hipError_t e = hipLaunchCooperativeKernel((const void*)fwd_kernel, dim3(grid), dim3(NTHR), args, LDS_BYTES, stream);
        if (e != hipSuccess) fprintf(stderr, "kernel_launch: cooperative launch failed: %s (grid %d)\n", hipGetErrorString(e), grid);
    } else {
        for (int ph = 0; ph <= DUMP_LAST; ++ph) { a.ph_lo = ph; a.ph_hi = ph + 1; hipLaunchKernelGGL(fwd_kernel, dim3(grid), dim3(NTHR), LDS_BYTES, stream, a); }
        if (DUMP_SEL != 0 && DUMP_SEL != 4) hipLaunchKernelGGL(dump_kernel, dim3(T * DM / 256), dim3(256), 0, stream, (const unsigned char*)d_ws, (float*)d_out);
    }
}
```

```cpp
#include <hip/hip_runtime.h>
#include <hip/hip_cooperative_groups.h>
#include <cstdio>
#include <cstdint>
namespace cg = cooperative_groups;
__device__ __forceinline__ int opaque_tid() { int t = __builtin_amdgcn_workitem_id_x(); asm volatile("" : "+v"(t)); return t; }
namespace pg8 {
#define PG8_LAS __attribute__((address_space(3)))
typedef unsigned short bf16_t;
typedef short bf16x8 __attribute__((ext_vector_type(8)));
typedef float f32x4 __attribute__((ext_vector_type(4)));
typedef unsigned u32x4 __attribute__((ext_vector_type(4)));
constexpr int BM = 256, BK = 64, HALF = 128, HTB = HALF * BK * 2  , STAGE_BYTES = 8 * HTB, NXCD = 8, WGM = 8;

__host__ __device__ __forceinline__ int lds_byte(int r, int c) { const int st = (r >> 4) * 2 + (c >> 5), rr = r & 15, cc = c & 31, ob = rr * 64 + cc * 2; return st * 1024 + (ob ^ (((ob >> 9) & 1) << 5)); }
__host__ __device__ __forceinline__ void stage_rc(int b, int& R, int& C) { const int st = b / 1024, sb = b % 1024, swz = sb ^ (((sb >> 9) & 1) << 5); R = (st >> 1) * 16 + swz / 64; C = (st & 1) * 32 + (swz % 64) / 2; }
__host__ __device__ __forceinline__ int perm32(int rho) { const int n = rho >> 4, i = rho & 15; return 8 * (i >> 2) + 4 * n + (i & 3); }

struct Unit { int pm, pn; };
struct Gemm { const bf16_t* A; const bf16_t* Bt; int M, N, K; };

struct StaticOrder {
    int nM, nN, nwg, G, c;
    __host__ __device__ void init(int M, int N, int G_, int c_) { nM = M / BM; nN = N / BM; nwg = nM * nN; G = G_; c = c_; }
    __host__ __device__ bool next(int i, Unit& u) const {
        const long L = (long)i * G + c; if (L >= nwg) return false;
        int wgid = (int)L; { const int q = nwg / NXCD, r = nwg % NXCD, xcd = wgid % NXCD, off = wgid / NXCD; wgid = (xcd < r ? xcd * (q + 1) : r * (q + 1) + (xcd - r) * q) + off; }
        const int nig = WGM * nN, gid = wgid / nig, fm = gid * WGM, gsz = (nM - fm) < WGM ? (nM - fm) : WGM;
        u.pm = fm + ((wgid % nig) % gsz); u.pn = (wgid % nig) / gsz; return true;
    }
    __device__ __forceinline__ void a_ready(const Unit&) const {}
    __device__ __forceinline__ void done(const Unit&) const {}
};

__device__ __forceinline__ unsigned cvt_pk_bf16(float lo, float hi) { unsigned r; asm volatile("v_cvt_pk_bf16_f32 %0, %1, %2" : "=v"(r) : "v"(lo), "v"(hi)); return r; }
template <class Epi, class Sched, bool ALIGN_EPI = false, bool SP2 = false>
__device__ __forceinline__ void gemm_phase(PG8_LAS unsigned char* lds, const Gemm g, const Sched& S, const Epi& E) {
    const int tid = opaque_tid(), wid = __builtin_amdgcn_readfirstlane(tid >> 6), lane = tid & 63, wr = wid >> 2, wc = wid & 3, fr = lane & 15, fq = lane >> 4;
    const int K = g.K, nt = K / BK;
    unsigned voffA[2], voffB[2];
#pragma unroll
    for (int i = 0; i < 2; ++i) { int R, C; stage_rc(tid * 16 + i * 8192, R, C); const int Rb = Epi::PERM ? ((R & ~31) + perm32(R & 31)) : R;
        voffA[i] = (unsigned)(R * K + C) * 2u; voffB[i] = (unsigned)(Rb * K + C) * 2u; }
    const size_t kstep = (size_t)(BK * 2);
    const size_t hstep = (size_t)HALF * K * 2;
    const size_t tstep = 2 * hstep;
    const unsigned ldsw = (unsigned)wid * 1024u;
    const int aoff = lds_byte(wr * 64 + fr, fq * 8), boff = lds_byte(wc * 32 + fr, fq * 8);
#define PG8_SA(b, h) (((b) * 2 + (h)) * HTB)
#define PG8_SB(b, h) ((4 + (b) * 2 + (h)) * HTB)
#define PG8_STAGE(bufoff, gbase, voff) do { _Pragma("unroll") for (int _i = 0; _i < 2; ++_i) \
        __builtin_amdgcn_global_load_lds((const unsigned*)((const char*)(gbase) + (voff)[_i]), (PG8_LAS unsigned*)(lds + (bufoff) + ldsw + _i * 8192), 16, 0, 0); } while (0)
#define PG8_LDA(dst, b, h) do { _Pragma("unroll") for (int m = 0; m < 4; ++m) _Pragma("unroll") for (int k = 0; k < 2; ++k) dst[m][k] = *(const PG8_LAS bf16x8*)(lds + PG8_SA(b, h) + aoff + m * 2048 + k * 1024); } while (0)
#define PG8_LDB(dst, b, h) do { _Pragma("unroll") for (int n = 0; n < 2; ++n) _Pragma("unroll") for (int k = 0; k < 2; ++k) dst[n][k] = *(const PG8_LAS bf16x8*)(lds + PG8_SB(b, h) + boff + n * 2048 + k * 1024); } while (0)
#define PG8_MMA(ai, bj, At, Bt) do { __builtin_amdgcn_s_setprio(1); _Pragma("unroll") for (int m = 0; m < 4; ++m) _Pragma("unroll") for (int n = 0; n < 2; ++n) _Pragma("unroll") for (int k = 0; k < 2; ++k) \
        acc[ai][bj][m][n] = __builtin_amdgcn_mfma_f32_16x16x32_bf16(Bt[n][k], At[m][k], acc[ai][bj][m][n], 0, 0, 0); __builtin_amdgcn_s_setprio(0); } while (0)
#define PG8_WAIT_V(n) asm volatile("s_waitcnt vmcnt(" #n ")" ::: "memory")
#define PG8_WAIT_L(n) asm volatile("s_waitcnt lgkmcnt(" #n ")" ::: "memory")
#define PG8_BAR __builtin_amdgcn_s_barrier()
#define PG8_SCHED __builtin_amdgcn_sched_barrier(0)
    Unit cur, nxt; int ui = 0;
    if (!S.next(0, cur)) return;
    if constexpr (Epi::KPREP) { Unit pu; for (int i = 0; i < 12 && S.next(i, pu); ++i) E.kprep(pu, lds + STAGE_BYTES + i * 1024, tid); }
    f32x4 acc[2][2][4][2];
#pragma unroll
    for (int a = 0; a < 2; ++a)
#pragma unroll
        for (int b = 0; b < 2; ++b)
#pragma unroll
            for (int m = 0; m < 4; ++m)
#pragma unroll
                for (int n = 0; n < 2; ++n) acc[a][b][m][n] = (f32x4){0.f, 0.f, 0.f, 0.f};
    bf16x8 At[4][2], B0[2][2], B1[2][2];
    const char* cA = (const char*)g.A + (size_t)cur.pm * tstep; const char* cB = (const char*)g.Bt + (size_t)cur.pn * tstep;
    S.a_ready(cur);
    if constexpr (SP2) {
        PG8_STAGE(PG8_SB(0, 0), cB, voffB); PG8_STAGE(PG8_SB(0, 1), cB + hstep, voffB); PG8_STAGE(PG8_SA(0, 0), cA, voffA); PG8_STAGE(PG8_SA(0, 1), cA + hstep, voffA);
        if (wr == 1) PG8_BAR;
        PG8_WAIT_V(2); PG8_BAR;
        PG8_STAGE(PG8_SB(1, 0), cB + kstep, voffB); PG8_STAGE(PG8_SA(1, 0), cA + kstep, voffA); PG8_STAGE(PG8_SB(1, 1), cB + hstep + kstep, voffB);
        PG8_WAIT_V(6); PG8_BAR;
    } else {
        PG8_STAGE(PG8_SB(0, 0), cB, voffB); PG8_STAGE(PG8_SA(0, 0), cA, voffA); PG8_STAGE(PG8_SB(0, 1), cB + hstep, voffB); PG8_STAGE(PG8_SA(0, 1), cA + hstep, voffA);
        if (wr == 1) PG8_BAR;
        PG8_WAIT_V(4); PG8_BAR;
        PG8_STAGE(PG8_SB(1, 0), cB + kstep, voffB); PG8_STAGE(PG8_SA(1, 0), cA + kstep, voffA); PG8_STAGE(PG8_SB(1, 1), cB + hstep + kstep, voffB);
        PG8_WAIT_V(6); PG8_BAR;
    }
    for (;;) {
        const bool has_next = S.next(ui + 1, nxt);
        const char* nA = has_next ? (const char*)g.A + (size_t)nxt.pm * tstep : cA; const char* nB = has_next ? (const char*)g.Bt + (size_t)nxt.pn * tstep : cB;
        for (int t = 0; t < nt; t += 2) {
            const bool last = (t == nt - 2);
            const char* a1 = cA + (size_t)(t + 1) * kstep;
            const char* a2 = last ? nA : cA + (size_t)(t + 2) * kstep; const char* b2 = last ? nB : cB + (size_t)(t + 2) * kstep;
            const char* a3 = a2 + kstep; const char* b3 = b2 + kstep;
            if (last && has_next) S.a_ready(nxt);
            if constexpr (SP2) {
            PG8_LDB(B0, 0, 0); PG8_LDB(B1, 0, 1); PG8_SCHED; PG8_LDA(At, 0, 0); PG8_STAGE(PG8_SA(1, 1), a1 + hstep, voffA);
            PG8_WAIT_V(8); PG8_WAIT_L(0); PG8_BAR; PG8_MMA(0, 0, At, B0); PG8_MMA(0, 1, At, B1); PG8_BAR; PG8_SCHED;
            PG8_LDA(At, 0, 1); PG8_STAGE(PG8_SB(0, 0), b2, voffB); PG8_STAGE(PG8_SB(0, 1), b2 + hstep, voffB); PG8_STAGE(PG8_SA(0, 0), a2, voffA);
            PG8_WAIT_V(8); PG8_WAIT_L(0); PG8_BAR; PG8_MMA(1, 0, At, B0); PG8_MMA(1, 1, At, B1); PG8_BAR; PG8_SCHED;
            PG8_LDB(B0, 1, 0); PG8_LDB(B1, 1, 1); PG8_SCHED; PG8_LDA(At, 1, 0); PG8_STAGE(PG8_SA(0, 1), a2 + hstep, voffA);
            PG8_WAIT_V(8); PG8_WAIT_L(0); PG8_BAR; PG8_MMA(0, 0, At, B0); PG8_MMA(0, 1, At, B1); PG8_BAR; PG8_SCHED;
            PG8_LDA(At, 1, 1); PG8_STAGE(PG8_SB(1, 0), b3, voffB); PG8_STAGE(PG8_SB(1, 1), b3 + hstep, voffB); PG8_STAGE(PG8_SA(1, 0), a3, voffA);
            PG8_WAIT_V(8); PG8_WAIT_L(0); PG8_BAR; PG8_MMA(1, 0, At, B0); PG8_MMA(1, 1, At, B1); PG8_BAR; PG8_SCHED;
            } else {
            PG8_LDB(B0, 0, 0); PG8_SCHED; PG8_LDA(At, 0, 0); PG8_STAGE(PG8_SA(1, 1), a1 + hstep, voffA);
            PG8_WAIT_L(8); PG8_BAR; PG8_WAIT_L(0); PG8_MMA(0, 0, At, B0); PG8_BAR; PG8_SCHED;
            PG8_LDB(B1, 0, 1); PG8_STAGE(PG8_SB(0, 0), b2, voffB);
            PG8_BAR; PG8_WAIT_L(0); PG8_MMA(0, 1, At, B1); PG8_BAR;
            PG8_LDA(At, 0, 1); PG8_STAGE(PG8_SA(0, 0), a2, voffA);
            PG8_BAR; PG8_WAIT_L(0); PG8_MMA(1, 0, At, B0); PG8_BAR; PG8_SCHED;
            PG8_STAGE(PG8_SB(0, 1), b2 + hstep, voffB);
            PG8_WAIT_V(6); PG8_BAR; PG8_MMA(1, 1, At, B1); PG8_BAR;
            PG8_LDB(B0, 1, 0); PG8_SCHED; PG8_LDA(At, 1, 0); PG8_STAGE(PG8_SA(0, 1), a2 + hstep, voffA);
            PG8_WAIT_L(8); PG8_BAR; PG8_WAIT_L(0); PG8_MMA(0, 0, At, B0); PG8_BAR; PG8_SCHED;
            PG8_LDB(B1, 1, 1); PG8_STAGE(PG8_SB(1, 0), b3, voffB);
            PG8_BAR; PG8_WAIT_L(0); PG8_MMA(0, 1, At, B1); PG8_BAR;
            PG8_LDA(At, 1, 1); PG8_STAGE(PG8_SA(1, 0), a3, voffA);
            PG8_BAR; PG8_WAIT_L(0); PG8_MMA(1, 0, At, B0); PG8_BAR; PG8_SCHED;
            PG8_STAGE(PG8_SB(1, 1), b3 + hstep, voffB);
            PG8_WAIT_V(6); PG8_BAR; PG8_MMA(1, 1, At, B1); PG8_BAR;
            }
            if constexpr (Epi::KHOOK) { if (t == 2) E.khook(acc, lds + STAGE_BYTES + ui * 1024, wr, fr); }
        }
        if constexpr (ALIGN_EPI) { if (wr == 0) PG8_BAR; }
        if constexpr (!Epi::AFTER_DRAIN) { E(acc, cur, wr, wc, fr, fq, lds + STAGE_BYTES + ui * 1024); S.done(cur); }
        if (!has_next) break;
#pragma unroll
        for (int a = 0; a < 2; ++a)
#pragma unroll
            for (int b = 0; b < 2; ++b)
#pragma unroll
                for (int m = 0; m < 4; ++m)
#pragma unroll
                    for (int n = 0; n < 2; ++n) acc[a][b][m][n] = (f32x4){0.f, 0.f, 0.f, 0.f};
        cur = nxt; cA = nA; cB = nB; ++ui;
        if constexpr (ALIGN_EPI) { if (wr == 1) PG8_BAR; }
    }
    PG8_WAIT_V(0);
    if constexpr (!ALIGN_EPI) { if (wr == 0) PG8_BAR; }
    PG8_BAR;
    if constexpr (Epi::AFTER_DRAIN) { E.fused(acc, cur, wr, wc, fr, fq, lds, wid, lane); S.done(cur); }
#undef PG8_SA
#undef PG8_SB
#undef PG8_STAGE
#undef PG8_LDA
#undef PG8_LDB
#undef PG8_MMA
#undef PG8_WAIT_V
#undef PG8_WAIT_L
#undef PG8_BAR
#undef PG8_SCHED
}
}

#define LAS __attribute__((address_space(3)))
typedef unsigned short bf16_t;
typedef short bf16x8 __attribute__((ext_vector_type(8)));
typedef short bf16x4 __attribute__((ext_vector_type(4)));
typedef float f32x4 __attribute__((ext_vector_type(4)));
typedef float f32x2 __attribute__((ext_vector_type(2)));
typedef unsigned u32x4 __attribute__((ext_vector_type(4)));
typedef unsigned u32x2 __attribute__((ext_vector_type(2)));

constexpr int NB = 4, SEQ = 4096, DM = 1024, DEPTH = 4, T = NB * SEQ, W = 256, DFF = 4096, NIN = 2052, ZW = 2048;
constexpr int NCH = SEQ / 128;
constexpr float EPS = 1e-6f;
constexpr float LOG2E = 1.4426950408889634f;
constexpr int NTHR = 512;
constexpr int LDS_BYTES = 147456;
constexpr int ZC_AU = 0, ZC_AV = 256, ZC_B = 512, ZC_CX = 768, ZC_CG = 1024, ZC_Q = 1280, ZC_K = 1536, ZC_V = 1792;
constexpr int YC_D = 0, YC_A = 256, YC_B = 512, YC_C = 768;

constexpr size_t MiB = 1u << 20;
constexpr size_t WS_WIN = 0, WS_WOUT = 16 * MiB, WS_WMI = 24 * MiB, WS_WMO = 56 * MiB, WS_R = 88 * MiB, WS_Z = WS_R, WS_Y = WS_R + 64 * MiB, WS_ACT = WS_R,
                 WS_H = 216 * MiB, WS_S = 248 * MiB;
constexpr size_t WS_GLUT = WS_S, WS_WAT = WS_GLUT + 512 * 1024, WS_WXT = WS_WAT + 128 * 1024, WS_BBT = WS_WXT + 128 * 1024, WS_CMT = WS_BBT + 256 * 1024,
                 WS_ABAR = WS_CMT + 256 * 1024, WS_A128 = WS_ABAR + 32 * 1024, WS_WF = WS_A128 + 32 * 1024, WS_LOGF = WS_WF + 64 * 1024, WS_CS = WS_LOGF + 256 * 1024,
                 WS_SSD = WS_CS + 256 * 1024, WS_ELOC = WS_SSD + 256 * 1024, WS_LA = WS_ELOC + 1024 * 1024, WS_LB = WS_LA + 128 * 1024, WS_BAR = WS_LB + 128 * 1024, WS_SS2 = WS_BAR + 16 * 1024, WS_KMAX = WS_SS2 + 1024 * 1024, WS_END = WS_KMAX + 4096;

struct Args {
    const float* in[30]; float* out; unsigned char* ws; int ph_lo, ph_hi;
};


typedef const __attribute__((address_space(4))) unsigned long long* kargp_t;
__device__ __forceinline__ unsigned long long karg_(int i) { kargp_t tab = (kargp_t)__builtin_amdgcn_kernarg_segment_ptr(); asm volatile("" : "+s"(tab)); return tab[i]; }
#define INP(i) ((const float*)karg_(i))
__device__ __forceinline__ unsigned char* ws_() { return (unsigned char*)karg_(31); }
__device__ __forceinline__ float* out_() { return (float*)karg_(30); }
#define PH_LO ((int)(unsigned)(karg_(32) & 0xffffffffull))
#define PH_HI ((int)(unsigned)(karg_(32) >> 32))
__device__ __forceinline__ int bid_() { return blockIdx.x; }
__device__ __forceinline__ int grid_() { return gridDim.x; }
__device__ __forceinline__ float bf2f(bf16_t v) { return __uint_as_float((unsigned)v << 16); }
__device__ __forceinline__ float bfs2f(short v) { return __uint_as_float(((unsigned)(unsigned short)v) << 16); }
typedef __bf16 bf16x2_t __attribute__((ext_vector_type(2)));
__device__ __forceinline__ unsigned pk2(float lo, float hi) { const f32x2 v = {lo, hi}; const bf16x2_t b = __builtin_convertvector(v, bf16x2_t); return __builtin_bit_cast(unsigned, b); }
__device__ __forceinline__ bf16_t f2bf(float f) { return (bf16_t)(pk2(f, 0.f) & 0xffffu); }
__device__ __forceinline__ float gelu_t(float x) { const float y2 = (1.5957691216057308f * LOG2E) * (x + 0.044715f * x * x * x); return x * __builtin_amdgcn_rcpf(1.0f + __builtin_amdgcn_exp2f(-y2)); }
__device__ __forceinline__ float sigm(float x) { return __builtin_amdgcn_rcpf(1.0f + __builtin_amdgcn_exp2f(-LOG2E * x)); }
__device__ __forceinline__ float softplus_f(float x) { return fmaxf(x, 0.f) + log1pf(__expf(-fabsf(x))); }
__device__ __forceinline__ f32x4 mfma16(bf16x8 a, bf16x8 b, f32x4 c) { return __builtin_amdgcn_mfma_f32_16x16x32_bf16(a, b, c, 0, 0, 0); }
__device__ __forceinline__ float quad_sum(float v) {
    { const auto r = __builtin_amdgcn_permlane16_swap(__float_as_uint(v), __float_as_uint(v), false, false); v = __uint_as_float(r[0]) + __uint_as_float(r[1]); }
    { const auto r = __builtin_amdgcn_permlane32_swap(__float_as_uint(v), __float_as_uint(v), false, false); v = __uint_as_float(r[0]) + __uint_as_float(r[1]); }
    return v;
}
template <int CTRL> __device__ __forceinline__ float dpp_mov(float x) { return __uint_as_float((unsigned)__builtin_amdgcn_update_dpp(0, (int)__float_as_uint(x), CTRL, 0xf, 0xf, true)); }
__device__ __forceinline__ float wave_sum(float v) {
    v += dpp_mov<0xB1>(v); v += dpp_mov<0x4E>(v); v += dpp_mov<0x141>(v); v += dpp_mov<0x140>(v);
    return quad_sum(v);
}
__device__ __forceinline__ float wave_max(float v);
__device__ __forceinline__ float quad_max(float v) {
    { const auto r = __builtin_amdgcn_permlane16_swap(__float_as_uint(v), __float_as_uint(v), false, false); v = fmaxf(__uint_as_float(r[0]), __uint_as_float(r[1])); }
    { const auto r = __builtin_amdgcn_permlane32_swap(__float_as_uint(v), __float_as_uint(v), false, false); v = fmaxf(__uint_as_float(r[0]), __uint_as_float(r[1])); }
    return v;
}
__device__ __forceinline__ bf16x8 pack8(const float* v) {
    u32x4 w; w.x = pk2(v[0], v[1]); w.y = pk2(v[2], v[3]); w.z = pk2(v[4], v[5]); w.w = pk2(v[6], v[7]); return __builtin_bit_cast(bf16x8, w);
}
__device__ __forceinline__ bf16x8 zero8() { return (bf16x8){0, 0, 0, 0, 0, 0, 0, 0}; }

__device__ __forceinline__ float wave_max(float v) {
    v = fmaxf(v, dpp_mov<0xB1>(v)); v = fmaxf(v, dpp_mov<0x4E>(v)); v = fmaxf(v, dpp_mov<0x141>(v)); v = fmaxf(v, dpp_mov<0x140>(v));
    return quad_max(v);
}
template <int N> __device__ __forceinline__ float dpp_shr(float x, float ident) {
    return __uint_as_float((unsigned)__builtin_amdgcn_update_dpp((int)__float_as_uint(ident), (int)__float_as_uint(x), 0x110 + N, 0xf, 0xf, false));
}
__device__ __forceinline__ float neg_expm1(float x) {
    const float s = -x * (1.0f + x * (0.5f + x * (0.16666667f + x * (0.041666668f + x * (0.0083333338f + x * 0.0013888889f)))));
    const float e = 1.0f - __builtin_amdgcn_exp2f(LOG2E * x);
    return (x > -0.25f) ? s : e;
}
template <int ACT  , bool ROWS = false> struct EpiStoreBf16 {
    static constexpr bool PERM = true, AFTER_DRAIN = false, KHOOK = false, KPREP = ROWS;
    __device__ __forceinline__ void kprep(const pg8::Unit& u, PG8_LAS unsigned char* tab, int tid) const {
        if (tid < 256) { const float* rp = rowss + (size_t)(u.pm * 256 + tid) * 16; const f32x4 s0 = *(const f32x4*)rp, s1 = *(const f32x4*)(rp + 4), s2 = *(const f32x4*)(rp + 8), s3 = *(const f32x4*)(rp + 12);
            const float tot = ((s0[0] + s0[1]) + (s0[2] + s0[3])) + ((s1[0] + s1[1]) + (s1[2] + s1[3])) + ((s2[0] + s2[1]) + (s2[2] + s2[3])) + ((s3[0] + s3[1]) + (s3[2] + s3[3]));
            ((PG8_LAS float*)tab)[tid] = rsqrtf(tot * (1.0f / DM) + EPS); }
    }
    bf16_t* O; int ldc; const float* rowss;
    __device__ __forceinline__ void operator()(const pg8::f32x4 (&acc)[2][2][4][2], const pg8::Unit& u, int wr, int wc, int fr, int fq, PG8_LAS unsigned char* tab) const {
        const int row0 = u.pm * 256 + wr * 64 + fr, col0 = u.pn * 256 + wc * 32 + 8 * fq;
#pragma unroll
        for (int ai = 0; ai < 2; ++ai)
#pragma unroll
            for (int m = 0; m < 4; ++m) { bf16_t* rowp = O + (size_t)(row0 + ai * 128 + m * 16) * ldc + col0;
                const float rsc = ROWS ? ((const PG8_LAS float*)tab)[wr * 64 + fr + ai * 128 + m * 16] : 1.0f;
#pragma unroll
                for (int bj = 0; bj < 2; ++bj) { pg8::f32x4 v0 = acc[ai][bj][m][0] * rsc, v1 = acc[ai][bj][m][1] * rsc;
                    if (ACT == 1) {
#pragma unroll
                        for (int e = 0; e < 4; ++e) { const float a = fmaxf(v0[e], 0.f), b = fmaxf(v1[e], 0.f); v0[e] = a * a; v1[e] = b * b; } }
                    u32x4 w; w.x = pk2(v0[0], v0[1]); w.y = pk2(v0[2], v0[3]); w.z = pk2(v1[0], v1[1]); w.w = pk2(v1[2], v1[3]);
                    *(u32x4*)(rowp + bj * 128) = w; } }
    }
};
template <bool HOOK, bool NORMOUT> struct EpiRes {
    static constexpr bool PERM = true, AFTER_DRAIN = false, KHOOK = HOOK, KPREP = HOOK;
    bf16_t* xb; int ldc; const float* ssd; float* ss2;
    __device__ __forceinline__ void operator()(const pg8::f32x4 (&acc)[2][2][4][2], const pg8::Unit& u, int wr, int wc, int fr, int fq, PG8_LAS unsigned char* tab) const {
        const int col0 = u.pn * 256 + wc * 32 + 8 * fq;
#pragma unroll
        for (int ai = 0; ai < 2; ++ai)
#pragma unroll
            for (int m = 0; m < 4; ++m) { const int row = u.pm * 256 + ai * 128 + wr * 64 + m * 16 + fr; bf16_t* rowp = xb + (size_t)row * ldc + col0; float sq = 0.f;
#pragma unroll
                for (int bj = 0; bj < 2; ++bj) { const bf16x8 s = *(const bf16x8*)(rowp + bj * 128); float o[8];
#pragma unroll
                    for (int e = 0; e < 4; ++e) { o[e] = bfs2f(s[e]) + acc[ai][bj][m][0][e]; o[4 + e] = bfs2f(s[4 + e]) + acc[ai][bj][m][1][e]; }
                    if (NORMOUT) {
#pragma unroll
                        for (int e = 0; e < 8; ++e) sq += o[e] * o[e]; }
                    *(bf16x8*)(rowp + bj * 128) = pack8(o); }
                if (NORMOUT) { sq = quad_sum(sq); if (fq == 0) ss2[(size_t)row * 16 + u.pn * 4 + wc] = sq; }
                if (m & 1) asm volatile("" ::: "memory"); }
    }
    __device__ __forceinline__ void kprep(const pg8::Unit& u, PG8_LAS unsigned char* tab, int tid) const {
        if (tid < 256) { const f32x4 s4 = *(const f32x4*)(ssd + (size_t)(u.pm * 256 + tid) * 4); ((PG8_LAS float*)tab)[tid] = rsqrtf((s4[0] + s4[1] + s4[2] + s4[3]) * (1.0f / 256.0f) + EPS); }
    }
    __device__ __forceinline__ void khook(pg8::f32x4 (&acc)[2][2][4][2], PG8_LAS unsigned char* tab, int wr, int fr) const {
#pragma unroll
        for (int ai = 0; ai < 2; ++ai)
#pragma unroll
            for (int m = 0; m < 4; ++m) { const float rs = ((const PG8_LAS float*)tab)[ai * 128 + wr * 64 + m * 16 + fr];
#pragma unroll
                for (int bj = 0; bj < 2; ++bj)
#pragma unroll
                    for (int n = 0; n < 2; ++n) acc[ai][bj][m][n] *= rs; }
    }
};

template <int TN> __device__ __forceinline__ void tc_job(unsigned char* lds, const float* src, size_t sb, int ld, int K, int N, int nbatch, bf16_t* dst, const float* gain, int kshift, int rot) {
    LAS float* tile = (LAS float*)lds;
    constexpr int CG = TN / 64, NLD = TN / 32  , NST = TN / 64  ;
    const int tid = opaque_tid(), nk = K / 64, nn = N / TN, ntile = nbatch * nk * nn;
    for (int ti = (int)((bid_() + grid_() - (rot % grid_())) % grid_()); ti < ntile; ti += grid_()) {
        const int b = ti / (nk * nn), rem = ti % (nk * nn), kt = rem / nn, nt = rem % nn;
        const float* s = src + (size_t)b * sb + (size_t)(kt * 64) * ld + nt * TN;
        f32x4 v[NLD];
#pragma unroll
        for (int p = 0; p < NLD; ++p) { const int idx = tid + 512 * p, c16 = idx & 15, kq = (idx >> 4) & 3, rest = idx >> 6, kl = (rest / CG) * 4 + kq, n4 = ((rest % CG) * 16 + c16) * 4;
            v[p] = *(const f32x4*)(s + (size_t)kl * ld + n4);
            if (gain) { const float gg = gain[(size_t)b * K + kt * 64 + kl]; v[p] = v[p] * gg; } }
        __syncthreads();
#pragma unroll
        for (int p = 0; p < NLD; ++p) { const int idx = tid + 512 * p, c16 = idx & 15, kq = (idx >> 4) & 3, rest = idx >> 6, kl = (rest / CG) * 4 + kq, n4 = ((rest % CG) * 16 + c16) * 4;
            tile[kl * (TN + 1) + n4 + 0] = v[p][0]; tile[kl * (TN + 1) + n4 + 1] = v[p][1]; tile[kl * (TN + 1) + n4 + 2] = v[p][2]; tile[kl * (TN + 1) + n4 + 3] = v[p][3]; }
        __syncthreads();
#pragma unroll
        for (int p = 0; p < NST; ++p) { const int idx = tid + 512 * p, nl = idx >> 3, kc = (idx & 7) * 8; float o[8];
#pragma unroll
            for (int e = 0; e < 8; ++e) o[e] = tile[(kc + e) * (TN + 1) + nl];
            const int kd = (kt * 64 + kc + kshift) % K;
            *(bf16x8*)(dst + (size_t)b * N * K + (size_t)(nt * TN + nl) * K + kd) = pack8(o); }
    }
    __syncthreads();
}

__device__ __forceinline__ void prep_phase(const Args& a, unsigned char* lds) {
    unsigned char* ws = ws_();
    tc_job<256>(lds, INP(2), (size_t)DM * NIN, NIN, DM, ZW, DEPTH, (bf16_t*)(ws + WS_WIN), INP(1), 0, 0);
    tc_job<256>(lds, INP(25), (size_t)DM * DM, DM, DM, DM, DEPTH, (bf16_t*)(ws + WS_WOUT), INP(24), 256, 0);
    tc_job<256>(lds, INP(27), (size_t)DM * DFF, DFF, DM, DFF, DEPTH, (bf16_t*)(ws + WS_WMI), INP(26), 0, 0);
    tc_job<256>(lds, INP(28), (size_t)DFF * DM, DM, DFF, DM, DEPTH, (bf16_t*)(ws + WS_WMO), nullptr, 0, 0);
    tc_job<256>(lds, INP(14), (size_t)W * W, W, W, W, DEPTH, (bf16_t*)(ws + WS_GLUT), nullptr, 0, 0);
    tc_job<64>(lds, INP(18), (size_t)64 * 64, 64, 64, 64, DEPTH * 4, (bf16_t*)(ws + WS_WAT), nullptr, 0, 64);
    tc_job<64>(lds, INP(20), (size_t)64 * 64, 64, 64, 64, DEPTH * 4, (bf16_t*)(ws + WS_WXT), nullptr, 0, 96);
    const int gid = bid_() * NTHR + opaque_tid();
    if (gid < DEPTH * 1024) {
        const int l = gid >> 10, gp = gid & 1023, g = gp >> 6, p = gp & 63;
        const float lre = INP(6)[gid], lim = INP(7)[gid], dt = expf(INP(8)[l * 16 + g]);
        const float mag = expf(lre * dt), are = mag * cosf(lim * dt), aim = mag * sinf(lim * dt);
        const float den = lre * lre + lim * lim, nre = are - 1.0f, nim = aim;
        const float fre = (nre * lre + nim * lim) / den, fim = (nim * lre - nre * lim) / den;
        ((f32x2*)(ws + WS_ABAR))[gid] = (f32x2){are, aim};
        float pr = are, pi = aim;
#pragma unroll
        for (int s = 0; s < 7; ++s) { const float nr = pr * pr - pi * pi, ni = 2.0f * pr * pi; pr = nr; pi = ni; }
        ((f32x2*)(ws + WS_A128))[gid] = (f32x2){pr, pi};
        const float* bre = INP(9) + (size_t)gid * 16; const float* bim = INP(10) + (size_t)gid * 16;
        bf16_t* bbt = (bf16_t*)(ws + WS_BBT) + ((size_t)(l * 16 + g) * 128 + 2 * p) * 16;
#pragma unroll
        for (int h = 0; h < 16; ++h) { const float br = bre[h], bi = bim[h]; bbt[h] = f2bf(fre * br - fim * bi); bbt[16 + h] = f2bf(fre * bi + fim * br); }
        bf16_t* cmt = (bf16_t*)(ws + WS_CMT) + (size_t)(l * 16 + g) * 16 * 128;
#pragma unroll
        for (int h = 0; h < 16; ++h) { const size_t ci = ((size_t)(l * 16 + g) * 16 + h) * 64 + p; ((unsigned*)cmt)[(h * 128 + 2 * p) >> 1] = pk2(INP(11)[ci], -INP(12)[ci]); }
        const float* wr = INP(2) + ((size_t)l * DM + gp) * NIN + ZW;
        ((f32x4*)(ws + WS_WF))[gid] = *(const f32x4*)wr * INP(1)[gid];
    }
}

template <bool SRCB, int MODE> __device__ __forceinline__ void norm_phase(const void* xsv, const float* g, bf16_t* xb, float* ss2, float* od, const float* wf, const float* bfg, float* logf) {
    const int lane = opaque_tid() & 63, wid = opaque_tid() >> 6;
    const int gw = bid_() * 8 + wid, nw = grid_() * 8;
    for (int row = gw; row < T; row += nw) {
        f32x4 v[4]; float ss = 0.f;
#pragma unroll
        for (int i = 0; i < 4; ++i) {
            if (SRCB) { const bf16x4 q = *(const bf16x4*)((const bf16_t*)xsv + (size_t)row * DM + i * 256 + lane * 4); v[i] = (f32x4){bfs2f(q[0]), bfs2f(q[1]), bfs2f(q[2]), bfs2f(q[3])}; }
            else { v[i] = *(const f32x4*)((const float*)xsv + (size_t)row * DM + i * 256 + lane * 4);
                if (MODE == 1) { u32x2 w; w.x = pk2(v[i][0], v[i][1]); w.y = pk2(v[i][2], v[i][3]); *(u32x2*)(xb + (size_t)row * DM + i * 256 + lane * 4) = w; } }
            ss += v[i][0] * v[i][0] + v[i][1] * v[i][1] + v[i][2] * v[i][2] + v[i][3] * v[i][3]; }
        ss = wave_sum(ss);
        const float rs = rsqrtf(ss * (1.0f / DM) + EPS);
        if (MODE == 1 && !SRCB) { if (lane < 16) ss2[(size_t)row * 16 + lane] = (lane == 0) ? ss : 0.f; }
        float f0 = 0.f, f1 = 0.f, f2 = 0.f, f3 = 0.f;
#pragma unroll
        for (int i = 0; i < 4; ++i) {
            if (MODE == 2) { const f32x4 gg = *(const f32x4*)(g + i * 256 + lane * 4); *(f32x4*)(od + (size_t)row * DM + i * 256 + lane * 4) = v[i] * rs * gg; }
            if (MODE == 1) {
#pragma unroll
                for (int e = 0; e < 4; ++e) { const f32x4 w4 = *(const f32x4*)(wf + (size_t)(i * 256 + lane * 4 + e) * 4); const float hv = v[i][e] * rs; f0 += hv * w4[0]; f1 += hv * w4[1]; f2 += hv * w4[2]; f3 += hv * w4[3]; } }
        }
        if (MODE == 1) {
            f0 = wave_sum(f0); f1 = wave_sum(f1); f2 = wave_sum(f2); f3 = wave_sum(f3);
            if (lane == 0) { f32x4 o; const float fv[4] = {f0 + bfg[0], f1 + bfg[1], f2 + bfg[2], f3 + bfg[3]};
#pragma unroll
                for (int e = 0; e < 4; ++e) o[e] = fminf(fv[e], 0.f) - log1pf(__expf(-fabsf(fv[e])));
                *(f32x4*)(logf + (size_t)row * 4) = o; }
        }
    }
}

__device__ __forceinline__ void cumsum_item(int b, const float* logf, float* cs, unsigned char* lds) {
    LAS float* wt = (LAS float*)lds;
    const int tid = opaque_tid(), lane = tid & 63, wid = tid >> 6;
    f32x4 v[8]; f32x4 run = (f32x4){0.f, 0.f, 0.f, 0.f};
    const float* src = logf + ((size_t)b * SEQ + (size_t)tid * 8) * 4;
#pragma unroll
    for (int e = 0; e < 8; ++e) { run = run + *(const f32x4*)(src + e * 4); v[e] = run; }
    f32x4 inc = run;
#pragma unroll
    for (int d = 1; d < 64; d <<= 1) {
        const int sl = ((lane >= d) ? lane - d : lane) << 2; f32x4 o;
#pragma unroll
        for (int e = 0; e < 4; ++e) o[e] = __uint_as_float((unsigned)__builtin_amdgcn_ds_bpermute(sl, (int)__float_as_uint(inc[e])));
        if (lane >= d) inc = inc + o;
    }
    __syncthreads();
    if (lane == 63) { wt[wid * 4 + 0] = inc[0]; wt[wid * 4 + 1] = inc[1]; wt[wid * 4 + 2] = inc[2]; wt[wid * 4 + 3] = inc[3]; }
    __syncthreads();
    f32x4 off = inc - run;
    for (int w2 = 0; w2 < wid; ++w2) { off[0] += wt[w2 * 4 + 0]; off[1] += wt[w2 * 4 + 1]; off[2] += wt[w2 * 4 + 2]; off[3] += wt[w2 * 4 + 3]; }
    float* dst = cs + ((size_t)b * SEQ + (size_t)tid * 8) * 4;
#pragma unroll
    for (int e = 0; e < 8; ++e) *(f32x4*)(dst + e * 4) = (v[e] + off) * LOG2E;
    __syncthreads();
}

template <int HALF> __device__ __forceinline__ void sgu_item(int l, int b, int c, const Args& a, unsigned char* lds) {
    const bf16_t* z = (const bf16_t*)(ws_() + WS_Z); bf16_t* y = (bf16_t*)(ws_() + WS_Y);
    LAS bf16_t* vnT = (LAS bf16_t*)lds;
    LAS float* ssb = (LAS float*)(lds + 69632);
    const int tid = opaque_tid(), lane = tid & 63, wid = tid >> 6, fr = lane & 15, quad = lane >> 4;
    const size_t t0 = (size_t)b * SEQ + (size_t)c * 128;
    const float* ng = INP(3) + l * W;
    __syncthreads();
    float gch[4];
#pragma unroll
    for (int e = 0; e < 4; ++e) gch[e] = ng[lane + 64 * e];
    constexpr int TPW = HALF ? 16 : 8;
#pragma unroll
    for (int half = 0; half < TPW / 8; ++half) {
        float val[8][4];
#pragma unroll
        for (int i = 0; i < 8; ++i) {
            const bf16_t* zr = z + (t0 + wid * TPW + half * 8 + i) * ZW + ZC_AV; float ss = 0.f;
#pragma unroll
            for (int e = 0; e < 4; ++e) { const float gv = gelu_t(bf2f(zr[lane + 64 * e])); val[i][e] = gv; ss += gv * gv; }
            ss = wave_sum(ss); const float rs = rsqrtf(ss * (1.0f / W) + EPS);
#pragma unroll
            for (int e = 0; e < 4; ++e) val[i][e] *= rs * gch[e];
        }
#pragma unroll
        for (int e = 0; e < 4; ++e) { float t8[8];
#pragma unroll
            for (int i = 0; i < 8; ++i) t8[i] = val[i][e];
            *(LAS bf16x8*)(vnT + (lane + 64 * e) * 136 + wid * TPW + half * 8) = pack8(t8); }
    }
    __syncthreads();
    const int h = wid & 3;
    const float* wsrc = INP(4) + ((size_t)(l * 4 + h) * 128) * 128;
    const float* bsrc = INP(5) + (size_t)(l * 4 + h) * 128;
    float outv[2][4][4];
#pragma unroll
    for (int i = 0; i < 2; ++i) {
        const int mt = HALF * 4 + (wid >> 2) + 2 * i, t = mt * 16 + fr;
        f32x4 acc[4];
#pragma unroll
        for (int nt = 0; nt < 4; ++nt) acc[nt] = (f32x4){0.f, 0.f, 0.f, 0.f};
        f32x4 wl[4][2];
#pragma unroll
        for (int kk = 0; kk < 4; ++kk) { const int k0 = (kk * 32 < (mt + 1) * 16) ? kk * 32 : 0; const float* wp = wsrc + (size_t)t * 128 + k0 + quad * 8; wl[kk][0] = *(const f32x4*)wp; wl[kk][1] = *(const f32x4*)(wp + 4); }
#pragma unroll
        for (int kk = 0; kk < 4; ++kk) {
            const int k0 = kk * 32;
            if (k0 < (mt + 1) * 16) {
                float wv[8] = {wl[kk][0][0], wl[kk][0][1], wl[kk][0][2], wl[kk][0][3], wl[kk][1][0], wl[kk][1][1], wl[kk][1][2], wl[kk][1][3]};
#pragma unroll
                for (int e = 0; e < 8; ++e) if (k0 + quad * 8 + e > t) wv[e] = 0.f;
                const bf16x8 wf = pack8(wv);
#pragma unroll
                for (int nt = 0; nt < 4; ++nt) { const bf16x8 vf = *(const LAS bf16x8*)(vnT + (h * 64 + nt * 16 + fr) * 136 + k0 + quad * 8); acc[nt] = mfma16(vf, wf, acc[nt]); }
            }
        }
        const float bs = bsrc[t]; float ss = 0.f;
#pragma unroll
        for (int nt = 0; nt < 4; ++nt) { const int ch = h * 64 + nt * 16 + quad * 4; const bf16x4 u4 = *(const bf16x4*)(z + (t0 + t) * ZW + ZC_AU + ch);
#pragma unroll
            for (int r = 0; r < 4; ++r) { const float o = gelu_t(bfs2f(u4[r])) * (acc[nt][r] + bs); outv[i][nt][r] = o; ss += o * o; } }
        ss = quad_sum(ss);
        if (quad == 0) ssb[t * 4 + h] = ss;
    }
    __syncthreads();
#pragma unroll
    for (int i = 0; i < 2; ++i) {
        const int mt = HALF * 4 + (wid >> 2) + 2 * i, t = mt * 16 + fr;
        const float rs = rsqrtf((ssb[t * 4 + 0] + ssb[t * 4 + 1] + ssb[t * 4 + 2] + ssb[t * 4 + 3]) * (1.0f / W) + EPS);
#pragma unroll
        for (int nt = 0; nt < 4; ++nt) { const int ch = h * 64 + nt * 16 + quad * 4; u32x2 w; w.x = pk2(outv[i][nt][0] * rs, outv[i][nt][1] * rs); w.y = pk2(outv[i][nt][2] * rs, outv[i][nt][3] * rs);
            *(u32x2*)(y + (t0 + t) * DM + YC_A + ch) = w; }
    }
    __syncthreads();
}

template <int PASS> __device__ __forceinline__ void s5_item(int l, int b, int c, const Args& a, unsigned char* lds) {
    const bf16_t* z = (const bf16_t*)(ws_() + WS_Z); bf16_t* y = (bf16_t*)(ws_() + WS_Y);
    LAS unsigned char* BU = (LAS unsigned char*)lds;
    LAS unsigned* BU32 = (LAS unsigned*)lds;
    LAS bf16_t* Yb = (LAS bf16_t*)(lds + 65792);
    LAS float* ssb = (LAS float*)(lds + 65792 + 67584);
    const int tid = opaque_tid(), lane = tid & 63, wid = tid >> 6, fr = lane & 15, quad = lane >> 4;
    const int sx0 = wid * 128 + lane, sx1 = sx0 + 64;
    const size_t t0 = (size_t)b * SEQ + (size_t)c * 128;
    const f32x2* abar = (const f32x2*)(ws_() + WS_ABAR) + l * 1024;
    f32x2* eloc = (f32x2*)(ws_() + WS_ELOC);
    float ar[2], ai[2], sre[2], sim[2];
#pragma unroll
    for (int q = 0; q < 2; ++q) { const f32x2 ab = abar[q ? sx1 : sx0]; ar[q] = ab[0]; ai[q] = ab[1]; sre[q] = 0.f; sim[q] = 0.f; }
    if (PASS == 2) {
        const f32x2* a128 = (const f32x2*)(ws_() + WS_A128) + l * 1024;
        const f32x2 p0 = a128[sx0], p1 = a128[sx1];
        for (int cc0 = 0; cc0 < c; cc0 += 8) {
            f32x2 e0[8], e1[8];
#pragma unroll
            for (int u = 0; u < 8; ++u) { const int cc = (cc0 + u < c) ? cc0 + u : c - 1; e0[u] = eloc[((size_t)(b * NCH + cc)) * 1024 + sx0]; e1[u] = eloc[((size_t)(b * NCH + cc)) * 1024 + sx1]; }
#pragma unroll
            for (int u = 0; u < 8; ++u) if (cc0 + u < c) {
                const float nr0 = p0[0] * sre[0] - p0[1] * sim[0] + e0[u][0], ni0 = p0[0] * sim[0] + p0[1] * sre[0] + e0[u][1]; sre[0] = nr0; sim[0] = ni0;
                const float nr1 = p1[0] * sre[1] - p1[1] * sim[1] + e1[u][0], ni1 = p1[0] * sim[1] + p1[1] * sre[1] + e1[u][1]; sre[1] = nr1; sim[1] = ni1; }
        }
    }
    bf16x8 bfrag[2][8];
    const bf16_t* bbt = (const bf16_t*)(ws_() + WS_BBT);
#pragma unroll
    for (int gi = 0; gi < 2; ++gi)
#pragma unroll
        for (int j = 0; j < 8; ++j) bfrag[gi][j] = (quad < 2) ? *(const bf16x8*)(bbt + ((size_t)(l * 16 + wid * 2 + gi) * 128 + j * 16 + fr) * 16 + quad * 8) : zero8();
    bf16x8 cfrag[2][4];
    if (PASS == 2) {
        const bf16_t* cmt = (const bf16_t*)(ws_() + WS_CMT);
#pragma unroll
        for (int gi = 0; gi < 2; ++gi)
#pragma unroll
            for (int ks = 0; ks < 4; ++ks) cfrag[gi][ks] = *(const bf16x8*)(cmt + ((size_t)(l * 16 + wid * 2 + gi) * 16 + fr) * 128 + ks * 32 + quad * 8);
    }
    const float* dsk = INP(13) + l * W;
    __syncthreads();
    bf16x8 ufn[2];
#pragma unroll
    for (int gi = 0; gi < 2; ++gi) ufn[gi] = (quad < 2) ? *(const bf16x8*)(z + (t0 + fr) * ZW + ZC_B + (wid * 2 + gi) * 16 + quad * 8) : zero8();
    for (int sc = 0; sc < 8; ++sc) {
        const size_t tr = t0 + sc * 16 + fr;
        bf16x8 ufc[2] = {ufn[0], ufn[1]};
        bf16x4 u4c[2] = {(bf16x4){0, 0, 0, 0}, (bf16x4){0, 0, 0, 0}};
        if (PASS == 2) {
#pragma unroll
            for (int gi = 0; gi < 2; ++gi) u4c[gi] = *(const bf16x4*)(z + tr * ZW + ZC_B + (wid * 2 + gi) * 16 + quad * 4);
        }
        if (sc < 7) {
#pragma unroll
            for (int gi = 0; gi < 2; ++gi) ufn[gi] = (quad < 2) ? *(const bf16x8*)(z + (tr + 16) * ZW + ZC_B + (wid * 2 + gi) * 16 + quad * 8) : zero8();
        }
#pragma unroll
        for (int gi = 0; gi < 2; ++gi) {
            const int g = wid * 2 + gi;
            const bf16x8 uf = ufc[gi];
#pragma unroll
            for (int j = 0; j < 8; ++j) {
                const f32x4 acc = mfma16(bfrag[gi][j], uf, (f32x4){0.f, 0.f, 0.f, 0.f});
                u32x2 w; w.x = pk2(acc[0], acc[1]); w.y = pk2(acc[2], acc[3]);
                *(LAS u32x2*)(BU + fr * 4112 + (g * 64 + j * 8 + quad * 2) * 4) = w;
            }
        }
        asm volatile("s_waitcnt lgkmcnt(0)" ::: "memory");
        {
            unsigned wv[16][2];
#pragma unroll
            for (int tt = 0; tt < 16; ++tt) { wv[tt][0] = BU32[tt * 1028 + sx0]; wv[tt][1] = BU32[tt * 1028 + sx1]; }
#pragma unroll
            for (int tt = 0; tt < 16; ++tt) {
#pragma unroll
                for (int q = 0; q < 2; ++q) {
                    const unsigned w = wv[tt][q];
                    const f32x2 bu2 = {__uint_as_float(w << 16), __uint_as_float(w & 0xffff0000u)};
                    const f32x2 s2 = {sre[q], sim[q]}, sw = {sim[q], sre[q]}, arr = {ar[q], ar[q]}, aii = {-ai[q], ai[q]};
                    const f32x2 n2 = aii * sw + (arr * s2 + bu2);
                    sre[q] = n2[0]; sim[q] = n2[1];
                    if (PASS == 2) wv[tt][q] = pk2(n2[0], n2[1]);
                }
            }
            if (PASS == 2) {
#pragma unroll
                for (int tt = 0; tt < 16; ++tt) { BU32[tt * 1028 + sx0] = wv[tt][0]; BU32[tt * 1028 + sx1] = wv[tt][1]; }
            }
        }
        asm volatile("s_waitcnt lgkmcnt(0)" ::: "memory");
        if (PASS == 2) {
#pragma unroll
            for (int gi = 0; gi < 2; ++gi) {
                const int g = wid * 2 + gi; f32x4 acc = (f32x4){0.f, 0.f, 0.f, 0.f};
#pragma unroll
                for (int ks = 0; ks < 4; ++ks) { const bf16x8 sf = *(const LAS bf16x8*)(BU + fr * 4112 + g * 256 + (ks * 32 + quad * 8) * 2); acc = mfma16(cfrag[gi][ks], sf, acc); }
                const int ch = g * 16 + quad * 4; const bf16x4 u4 = u4c[gi]; const f32x4 d4 = *(const f32x4*)(dsk + ch);
                float o[4];
#pragma unroll
                for (int r = 0; r < 4; ++r) o[r] = gelu_t(acc[r] + d4[r] * bfs2f(u4[r]));
                u32x2 w; w.x = pk2(o[0], o[1]); w.y = pk2(o[2], o[3]);
                *(LAS u32x2*)(Yb + (sc * 16 + fr) * 264 + ch) = w;
            }
        }
    }
    if (PASS == 1) {
#pragma unroll
        for (int q = 0; q < 2; ++q) eloc[((size_t)(b * NCH + c)) * 1024 + (q ? sx1 : sx0)] = (f32x2){sre[q], sim[q]};
    } else {
        __syncthreads();
        const bf16_t* glut = (const bf16_t*)(ws_() + WS_GLUT) + (size_t)l * W * W;
        const float* glub = INP(15) + l * W;
        bf16x8 gfrag[2][8];
#pragma unroll
        for (int ni = 0; ni < 2; ++ni)
#pragma unroll
            for (int ks = 0; ks < 8; ++ks) gfrag[ni][ks] = *(const bf16x8*)(glut + (size_t)((wid * 2 + ni) * 16 + fr) * W + ks * 32 + quad * 8);
        float outv[8][2][4];
#pragma unroll
        for (int mt = 0; mt < 8; ++mt) {
            f32x4 acc0 = (f32x4){0.f, 0.f, 0.f, 0.f}, acc1 = acc0;
#pragma unroll
            for (int ks = 0; ks < 8; ++ks) { const bf16x8 yf = *(const LAS bf16x8*)(Yb + (mt * 16 + fr) * 264 + ks * 32 + quad * 8); acc0 = mfma16(gfrag[0][ks], yf, acc0); acc1 = mfma16(gfrag[1][ks], yf, acc1); }
            float ss = 0.f;
#pragma unroll
            for (int ni = 0; ni < 2; ++ni) { const int n = (wid * 2 + ni) * 16 + quad * 4; const bf16x4 y4 = *(const LAS bf16x4*)(Yb + (mt * 16 + fr) * 264 + n); const f32x4 gb = *(const f32x4*)(glub + n);
#pragma unroll
                for (int r = 0; r < 4; ++r) { const float gt = (ni == 0 ? acc0[r] : acc1[r]) + gb[r]; const float o = bfs2f(y4[r]) * sigm(gt); outv[mt][ni][r] = o; ss += o * o; } }
            ss = quad_sum(ss);
            if (quad == 0) ssb[(mt * 16 + fr) * 8 + wid] = ss;
        }
        __syncthreads();
#pragma unroll
        for (int mt = 0; mt < 8; ++mt) {
            const int t = mt * 16 + fr; float s = 0.f;
#pragma unroll
            for (int w2 = 0; w2 < 8; ++w2) s += ssb[t * 8 + w2];
            const float rs = rsqrtf(s * (1.0f / W) + EPS);
#pragma unroll
            for (int ni = 0; ni < 2; ++ni) { const int n = (wid * 2 + ni) * 16 + quad * 4; u32x2 w; w.x = pk2(outv[mt][ni][0] * rs, outv[mt][ni][1] * rs); w.y = pk2(outv[mt][ni][2] * rs, outv[mt][ni][3] * rs);
                *(u32x2*)(y + (t0 + t) * DM + YC_B + n) = w; }
        }
    }
    __syncthreads();
}

template <int PASS> __device__ __forceinline__ void lru_item(int l, int b, int c, const Args& a, unsigned char* lds) {
    const bf16_t* z = (const bf16_t*)(ws_() + WS_Z); bf16_t* y = (bf16_t*)(ws_() + WS_Y);
    LAS bf16_t* XC = (LAS bf16_t*)lds;
    LAS float* ssb = (LAS float*)(lds + 67584);
    const int tid = opaque_tid(), lane = tid & 63, wid = tid >> 6, fr = lane & 15, quad = lane >> 4;
    const size_t t0 = (size_t)b * SEQ + (size_t)c * 128;
    float* LAp = (float*)(ws_() + WS_LA); float* LBp = (float*)(ws_() + WS_LB);
    __syncthreads();
    {
        const float* cw = INP(16) + (size_t)l * 4 * W; const float* cb = INP(17) + l * W;
#pragma unroll 4
        for (int it = 0; it < 8; ++it) {
            const int p = tid + 512 * it, tok = p >> 5, ch0 = (p & 31) * 8; float acc[8];
            { const f32x4 c0 = *(const f32x4*)(cb + ch0), c1 = *(const f32x4*)(cb + ch0 + 4); acc[0] = c0[0]; acc[1] = c0[1]; acc[2] = c0[2]; acc[3] = c0[3]; acc[4] = c1[0]; acc[5] = c1[1]; acc[6] = c1[2]; acc[7] = c1[3]; }
#pragma unroll
            for (int k = 0; k < 4; ++k) {
                const int tt = tok - 3 + k;
                if (c * 128 + tt >= 0) {
                    const bf16x8 xv = *(const bf16x8*)(z + (size_t)((long)t0 + tt) * ZW + ZC_CX + ch0);
                    const f32x4 w0 = *(const f32x4*)(cw + k * W + ch0), w1 = *(const f32x4*)(cw + k * W + ch0 + 4);
                    acc[0] += w0[0] * bfs2f(xv[0]); acc[1] += w0[1] * bfs2f(xv[1]); acc[2] += w0[2] * bfs2f(xv[2]); acc[3] += w0[3] * bfs2f(xv[3]);
                    acc[4] += w1[0] * bfs2f(xv[4]); acc[5] += w1[1] * bfs2f(xv[5]); acc[6] += w1[2] * bfs2f(xv[6]); acc[7] += w1[3] * bfs2f(xv[7]);
                }
            }
            *(LAS bf16x8*)(XC + tok * 264 + ch0) = pack8(acc);
        }
    }
    __syncthreads();
    const int hh = wid >> 1;
    const bf16_t* wat = (const bf16_t*)(ws_() + WS_WAT) + (size_t)(l * 4 + hh) * 64 * 64;
    const bf16_t* wxt = (const bf16_t*)(ws_() + WS_WXT) + (size_t)(l * 4 + hh) * 64 * 64;
    bf16x8 waf[2][2], wxf[2][2]; float sp8[2][4], bav[2][4], bxv[2][4], H[2][4], Acar[2][4], Bcar[2][4];
#pragma unroll
    for (int ni = 0; ni < 2; ++ni) {
        const int nl = (wid * 2 + ni) * 16 - hh * 64 + fr;
#pragma unroll
        for (int ks = 0; ks < 2; ++ks) { waf[ni][ks] = *(const bf16x8*)(wat + nl * 64 + ks * 32 + quad * 8); wxf[ni][ks] = *(const bf16x8*)(wxt + nl * 64 + ks * 32 + quad * 8); }
#pragma unroll
        for (int r = 0; r < 4; ++r) { const int ch = (wid * 2 + ni) * 16 + quad * 4 + r;
            sp8[ni][r] = 8.0f * softplus_f(-INP(22)[l * W + ch]); bav[ni][r] = INP(19)[l * W + ch]; bxv[ni][r] = INP(21)[l * W + ch];
            H[ni][r] = 0.f; Acar[ni][r] = 1.f; Bcar[ni][r] = 0.f;
        }
    }
    if (PASS == 2 && c > 0) {
#pragma unroll
        for (int ni = 0; ni < 2; ++ni) {
            const size_t ob = (size_t)(b * NCH) * W + (wid * 2 + ni) * 16 + quad * 4;
            const bool v0 = fr < c, v1 = 16 + fr < c;
            f32x4 a0 = (f32x4){1.f, 1.f, 1.f, 1.f}, b0 = (f32x4){0.f, 0.f, 0.f, 0.f}, a1 = a0, b1 = b0;
            if (v0) { a0 = *(const f32x4*)(LAp + ob + (size_t)fr * W); b0 = *(const f32x4*)(LBp + ob + (size_t)fr * W); }
            if (v1) { a1 = *(const f32x4*)(LAp + ob + (size_t)(16 + fr) * W); b1 = *(const f32x4*)(LBp + ob + (size_t)(16 + fr) * W); }
#pragma unroll
            for (int r = 0; r < 4; ++r) {
                float av = a0[r], bb = b0[r], aw = a1[r], bw = b1[r], ap, bp;
                ap = dpp_shr<1>(av, 1.0f); bp = dpp_shr<1>(bb, 0.0f); bb = av * bp + bb; av = av * ap;   ap = dpp_shr<1>(aw, 1.0f); bp = dpp_shr<1>(bw, 0.0f); bw = aw * bp + bw; aw = aw * ap;
                ap = dpp_shr<2>(av, 1.0f); bp = dpp_shr<2>(bb, 0.0f); bb = av * bp + bb; av = av * ap;   ap = dpp_shr<2>(aw, 1.0f); bp = dpp_shr<2>(bw, 0.0f); bw = aw * bp + bw; aw = aw * ap;
                ap = dpp_shr<4>(av, 1.0f); bp = dpp_shr<4>(bb, 0.0f); bb = av * bp + bb; av = av * ap;   ap = dpp_shr<4>(aw, 1.0f); bp = dpp_shr<4>(bw, 0.0f); bw = aw * bp + bw; aw = aw * ap;
                ap = dpp_shr<8>(av, 1.0f); bp = dpp_shr<8>(bb, 0.0f); bb = av * bp + bb; av = av * ap;   ap = dpp_shr<8>(aw, 1.0f); bp = dpp_shr<8>(bw, 0.0f); bw = aw * bp + bw; aw = aw * ap;
                const float B0t = __shfl(bb, 15, 16), A1t = __shfl(aw, 15, 16), B1t = __shfl(bw, 15, 16);
                H[ni][r] = A1t * B0t + B1t;
            }
        }
    }
    LAS bf16_t* Ob = (LAS bf16_t*)(lds + 67584 + 4096);
#pragma unroll 2
    for (int mt = 0; mt < 8; ++mt) {
        bf16x8 xf[2];
#pragma unroll
        for (int ks = 0; ks < 2; ++ks) xf[ks] = *(const LAS bf16x8*)(XC + (mt * 16 + fr) * 264 + hh * 64 + ks * 32 + quad * 8);
        float ss = 0.f;
#pragma unroll
        for (int ni = 0; ni < 2; ++ni) {
            f32x4 accA = (f32x4){0.f, 0.f, 0.f, 0.f}, accX = accA;
#pragma unroll
            for (int ks = 0; ks < 2; ++ks) { accA = mfma16(waf[ni][ks], xf[ks], accA); accX = mfma16(wxf[ni][ks], xf[ks], accX); }
            const int ch0 = (wid * 2 + ni) * 16 + quad * 4;
            const bf16x4 xc4 = *(const LAS bf16x4*)(XC + (mt * 16 + fr) * 264 + ch0);
            bf16x4 g4 = (bf16x4){0, 0, 0, 0};
            if (PASS == 2) g4 = *(const bf16x4*)(z + (t0 + mt * 16 + fr) * ZW + ZC_CG + ch0);
            float ov[4] = {0.f, 0.f, 0.f, 0.f};
#pragma unroll
            for (int r = 0; r < 4; ++r) {
                const float rg = sigm(accA[r] + bav[ni][r]), ig = sigm(accX[r] + bxv[ni][r]);
                const float la = -rg * sp8[ni][r];
                float av = __builtin_amdgcn_exp2f(LOG2E * la), bb = __builtin_amdgcn_sqrtf(fmaxf(neg_expm1(2.0f * la), 0.f)) * (ig * bfs2f(xc4[r]));
                { float ap, bp;
                  ap = dpp_shr<1>(av, 1.0f); bp = dpp_shr<1>(bb, 0.0f); bb = av * bp + bb; av = av * ap;
                  ap = dpp_shr<2>(av, 1.0f); bp = dpp_shr<2>(bb, 0.0f); bb = av * bp + bb; av = av * ap;
                  ap = dpp_shr<4>(av, 1.0f); bp = dpp_shr<4>(bb, 0.0f); bb = av * bp + bb; av = av * ap;
                  ap = dpp_shr<8>(av, 1.0f); bp = dpp_shr<8>(bb, 0.0f); bb = av * bp + bb; av = av * ap; }
                if (PASS == 1) { const float At = __shfl(av, 15, 16), Bt = __shfl(bb, 15, 16); Bcar[ni][r] = At * Bcar[ni][r] + Bt; Acar[ni][r] *= At; }
                else { const float hv = av * H[ni][r] + bb; H[ni][r] = __shfl(hv, 15, 16); const float o = hv * gelu_t(bfs2f(g4[r])); ov[r] = o; ss += o * o; }
            }
            if (PASS == 2) { u32x2 w; w.x = pk2(ov[0], ov[1]); w.y = pk2(ov[2], ov[3]); *(LAS u32x2*)(Ob + (mt * 16 + fr) * 264 + ch0) = w; }
        }
        if (PASS == 2) { ss = quad_sum(ss); if (quad == 0) ssb[(mt * 16 + fr) * 8 + wid] = ss; }
    }
    if (PASS == 1) {
        if (fr == 0) {
#pragma unroll
            for (int ni = 0; ni < 2; ++ni)
#pragma unroll
                for (int r = 0; r < 4; ++r) { const size_t o = ((size_t)(b * NCH + c)) * W + (wid * 2 + ni) * 16 + quad * 4 + r; LAp[o] = Acar[ni][r]; LBp[o] = Bcar[ni][r]; }
        }
        {
            const int tok = tid >> 2, hd = tid & 3; float s2 = 0.f;
#pragma unroll
            for (int j = 0; j < 8; ++j) { const bf16x8 kv = *(const bf16x8*)(z + (t0 + tok) * ZW + ZC_K + hd * 64 + j * 8);
#pragma unroll
                for (int e = 0; e < 8; ++e) { const float f = bfs2f(kv[e]); s2 += f * f; } }
            ssb[tok * 4 + hd] = s2;
            __syncthreads();
            if (tid < 4) { float mxv = 0.f; for (int i = 0; i < 128; ++i) mxv = fmaxf(mxv, ssb[i * 4 + tid]); ((float*)(ws_() + WS_KMAX))[(b * NCH + c) * 4 + tid] = mxv; }
        }
    } else {
        __syncthreads();
#pragma unroll 2
        for (int mt = 0; mt < 8; ++mt) {
            const int t = mt * 16 + fr; float s = 0.f;
#pragma unroll
            for (int w2 = 0; w2 < 8; ++w2) s += ssb[t * 8 + w2];
            const float rs = rsqrtf(s * (1.0f / W) + EPS);
#pragma unroll
            for (int ni = 0; ni < 2; ++ni) { const int n = (wid * 2 + ni) * 16 + quad * 4; const bf16x4 o4 = *(const LAS bf16x4*)(Ob + t * 264 + n);
                u32x2 w; w.x = pk2(bfs2f(o4[0]) * rs, bfs2f(o4[1]) * rs); w.y = pk2(bfs2f(o4[2]) * rs, bfs2f(o4[3]) * rs);
                *(u32x2*)(y + (t0 + t) * DM + YC_C + n) = w; }
        }
    }
    __syncthreads();
}

template <bool DIAG> __device__ __forceinline__ void attn_step2(const LAS unsigned char* buf, int kbase, int qrow0, int quad, int fr, const bf16x8 (&qf)[2][2], float (&m)[2], float (&lsum)[2], f32x4 (&oacc)[2][4]) {
    const LAS bf16_t* Kt = (const LAS bf16_t*)buf; const LAS bf16_t* Vt = (const LAS bf16_t*)(buf + 9216); const LAS float* csl = (const LAS float*)(buf + 18432);
    float p[2][4][4];
#pragma unroll
    for (int st = 0; st < 4; ++st) {
        const f32x4 c4 = *(const LAS f32x4*)(csl + st * 16 + quad * 4);
        const bf16x8 kf0 = *(const LAS bf16x8*)(Kt + (st * 16 + fr) * 72 + quad * 8), kf1 = *(const LAS bf16x8*)(Kt + (st * 16 + fr) * 72 + 32 + quad * 8);
#pragma unroll
        for (int qs = 0; qs < 2; ++qs) {
            f32x4 acc = mfma16(kf0, qf[qs][0], c4); acc = mfma16(kf1, qf[qs][1], acc);
#pragma unroll
            for (int r = 0; r < 4; ++r) { float v = acc[r]; if (DIAG && (kbase + st * 16 + quad * 4 + r > qrow0 + qs * 16)) v = -1e30f; p[qs][st][r] = v; }
        }
    }
    bf16x8 pf[2][2]; float alpha[2];
#pragma unroll
    for (int qs = 0; qs < 2; ++qs) {
        float mx = -1e30f;
#pragma unroll
        for (int st = 0; st < 4; ++st)
#pragma unroll
            for (int r = 0; r < 4; ++r) mx = fmaxf(mx, p[qs][st][r]);
        mx = quad_max(mx);
        const float mnew = fmaxf(m[qs], mx); alpha[qs] = __builtin_amdgcn_exp2f(m[qs] - mnew); m[qs] = mnew;
        float ps = 0.f;
#pragma unroll
        for (int st = 0; st < 4; ++st)
#pragma unroll
            for (int r = 0; r < 4; ++r) { const float e = __builtin_amdgcn_exp2f(p[qs][st][r] - mnew); p[qs][st][r] = e; ps += e; }
        lsum[qs] = lsum[qs] * alpha[qs] + ps;
#pragma unroll
        for (int ks = 0; ks < 2; ++ks) { u32x4 w; w.x = pk2(p[qs][2 * ks][0], p[qs][2 * ks][1]); w.y = pk2(p[qs][2 * ks][2], p[qs][2 * ks][3]); w.z = pk2(p[qs][2 * ks + 1][0], p[qs][2 * ks + 1][1]); w.w = pk2(p[qs][2 * ks + 1][2], p[qs][2 * ks + 1][3]); pf[qs][ks] = __builtin_bit_cast(bf16x8, w); }
    }
#pragma unroll
    for (int dt = 0; dt < 4; ++dt) {
        oacc[0][dt] = oacc[0][dt] * alpha[0]; oacc[1][dt] = oacc[1][dt] * alpha[1];
#pragma unroll
        for (int ks = 0; ks < 2; ++ks) {
            const bf16x4 v0 = *(const LAS bf16x4*)(Vt + (dt * 16 + fr) * 72 + ks * 32 + quad * 4), v1 = *(const LAS bf16x4*)(Vt + (dt * 16 + fr) * 72 + ks * 32 + 16 + quad * 4);
            const bf16x8 vf = (bf16x8){v0[0], v0[1], v0[2], v0[3], v1[0], v1[1], v1[2], v1[3]};
            oacc[0][dt] = mfma16(vf, pf[0][ks], oacc[0][dt]); oacc[1][dt] = mfma16(vf, pf[1][ks], oacc[1][dt]);
        }
    }
}
__device__ __forceinline__ void attn_unit(int b, int h, int qb, const Args& a, unsigned char* lds) {
    const bf16_t* z = (const bf16_t*)(ws_() + WS_Z); bf16_t* y = (bf16_t*)(ws_() + WS_Y);
    const float* cs = (const float*)(ws_() + WS_CS); float* ssd = (float*)(ws_() + WS_SSD);
    constexpr int ABUF = 9216 + 9216 + 256;
    LAS unsigned char* lb = (LAS unsigned char*)lds;
    const int tid = opaque_tid(), lane = tid & 63, wid = tid >> 6, fr = lane & 15, quad = lane >> 4, grp = wid >> 2, wq = wid & 3;
    const int q0 = qb * 128, qw = q0 + wq * 32, qrow0 = qw + fr;
    const size_t rb = (size_t)b * SEQ;
    bf16x8 qf[2][2];
    {
        const float SC = 0.125f * LOG2E;
#pragma unroll
        for (int qs = 0; qs < 2; ++qs)
#pragma unroll
            for (int ds = 0; ds < 2; ++ds) { const bf16x8 qv = *(const bf16x8*)(z + (rb + qrow0 + qs * 16) * ZW + ZC_Q + h * 64 + ds * 32 + quad * 8); float t8[8];
#pragma unroll
                for (int e = 0; e < 8; ++e) t8[e] = bfs2f(qv[e]) * SC;
                qf[qs][ds] = pack8(t8); }
    }
    float m[2] = {-1e30f, -1e30f}, lsum[2] = {0.f, 0.f}; f32x4 oacc[2][4];
#pragma unroll
    for (int qs = 0; qs < 2; ++qs)
#pragma unroll
        for (int dt = 0; dt < 4; ++dt) oacc[qs][dt] = (f32x4){0.f, 0.f, 0.f, 0.f};
    float qbnd[2];
    {
        float kv = (lane <= qb) ? ((const float*)(ws_() + WS_KMAX))[(b * NCH + lane) * 4 + h] : 0.f;
        kv = wave_max(kv);
        const float kmax = __builtin_amdgcn_sqrtf(kv) * 1.01f + 1e-3f;
#pragma unroll
        for (int qs = 0; qs < 2; ++qs) { float q2 = 0.f;
#pragma unroll
            for (int ds = 0; ds < 2; ++ds)
#pragma unroll
                for (int e = 0; e < 8; ++e) { const float f = bfs2f(qf[qs][ds][e]); q2 += f * f; }
            q2 = quad_sum(q2); qbnd[qs] = (__builtin_amdgcn_sqrtf(q2) * 1.01f + 1e-3f) * kmax; }
    }
    const int NSS = qb + 1;
    volatile LAS unsigned* vote = (volatile LAS unsigned*)(lds + LDS_BYTES - 64);
    if (tid < 3) vote[tid] = 0u;
    bf16x8 kreg[2], vreg[2]; float creg = 0.f;
#define ATT_LOAD(S) do { const size_t kb_ = rb + (size_t)(S) * 128; \
        _Pragma("unroll") for (int p_ = 0; p_ < 2; ++p_) { const int id_ = tid + 512 * p_; \
            kreg[p_] = *(const bf16x8*)(z + (kb_ + (id_ >> 3)) * ZW + ZC_K + h * 64 + (id_ & 7) * 8); \
            vreg[p_] = *(const bf16x8*)(z + (kb_ + 2 * (tid & 63) + p_) * ZW + ZC_V + h * 64 + (tid >> 6) * 8); } \
        if (tid < 128) creg = cs[(kb_ + tid) * 4 + h]; } while (0)
#define ATT_STORE(S) do { LAS unsigned char* bb_ = lb + ((S) & 1) * (2 * ABUF); \
        _Pragma("unroll") for (int p_ = 0; p_ < 2; ++p_) { const int id_ = tid + 512 * p_; const int k128_ = id_ >> 3; \
            *(LAS bf16x8*)((LAS bf16_t*)(bb_ + (k128_ >> 6) * ABUF) + (k128_ & 63) * 72 + (id_ & 7) * 8) = kreg[p_]; } \
        { LAS unsigned* vt_ = (LAS unsigned*)(bb_ + ((tid & 63) >> 5) * ABUF + 9216);     \
            _Pragma("unroll") for (int e_ = 0; e_ < 8; ++e_) vt_[(((tid >> 6) * 8 + e_) * 72 + ((2 * (tid & 63)) & 63)) >> 1] = (unsigned)(unsigned short)vreg[0][e_] | ((unsigned)(unsigned short)vreg[1][e_] << 16); } \
        if (tid < 128) ((LAS float*)(bb_ + (tid >> 6) * ABUF + 18432))[tid & 63] = -creg; } while (0)
    ATT_LOAD(NSS - 1); ATT_STORE(NSS - 1);
    if (NSS > 1) ATT_LOAD(NSS - 2);
    __syncthreads();
    int kstep = 0;
    for (int S = NSS - 1; S >= 0; --S) {
        if (S >= 1) ATT_STORE(S - 1);
        if (S >= 2) ATT_LOAD(S - 2);
        float cl = 0.f; if (S >= 1) cl = cs[(rb + (size_t)(S - 1) * 128 + 127) * 4 + h];
        const int kbase = S * 128 + grp * 64;
        const LAS unsigned char* hb = lb + (S & 1) * (2 * ABUF) + grp * ABUF;
        if (S + 1 < NSS) attn_step2<false>(hb, kbase, qrow0, quad, fr, qf, m, lsum, oacc);
        else if (kbase <= qw + 31) attn_step2<true>(hb, kbase, qrow0, quad, fr, qf, m, lsum, oacc);
        const bool need = (S >= 1) && ((qbnd[0] - cl - m[0] >= -160.f) || (qbnd[1] - cl - m[1] >= -160.f));
        const int vw = kstep % 3;
        if (need) vote[vw] = 1u;
        __syncthreads();
        const unsigned go = vote[vw];
        if (tid == 0) vote[(kstep + 2) % 3] = 0u;
        ++kstep;
        if (!go) break;
    }
#undef ATT_LOAD
#undef ATT_STORE
    LAS float* mg = (LAS float*)lb;
    const int ml = wq * 64 + lane;
    if (grp == 1) {
#pragma unroll
        for (int qs = 0; qs < 2; ++qs) { mg[(qs * 18 + 0) * 256 + ml] = m[qs]; mg[(qs * 18 + 1) * 256 + ml] = lsum[qs];
#pragma unroll
            for (int dt = 0; dt < 4; ++dt)
#pragma unroll
                for (int r = 0; r < 4; ++r) mg[(qs * 18 + 2 + dt * 4 + r) * 256 + ml] = oacc[qs][dt][r]; }
    }
    __syncthreads();
    if (grp == 0) {
#pragma unroll
        for (int qs = 0; qs < 2; ++qs) {
            const float m1 = mg[(qs * 18 + 0) * 256 + ml], l1 = mg[(qs * 18 + 1) * 256 + ml];
            const float mt = fmaxf(m[qs], m1), f0 = __builtin_amdgcn_exp2f(m[qs] - mt), f1 = __builtin_amdgcn_exp2f(m1 - mt);
            float lt = quad_sum(lsum[qs] * f0 + l1 * f1);
            const float inv = 1.0f / lt; float ss = 0.f;
            const size_t tq = rb + qrow0 + qs * 16;
#pragma unroll
            for (int dt = 0; dt < 4; ++dt) { f32x4 o;
#pragma unroll
                for (int r = 0; r < 4; ++r) { o[r] = (oacc[qs][dt][r] * f0 + mg[(qs * 18 + 2 + dt * 4 + r) * 256 + ml] * f1) * inv; ss += o[r] * o[r]; }
                u32x2 w; w.x = pk2(o[0], o[1]); w.y = pk2(o[2], o[3]); *(u32x2*)(y + tq * DM + YC_D + h * 64 + dt * 16 + quad * 4) = w; }
            ss = quad_sum(ss);
            if (quad == 0) ssd[tq * 4 + h] = ss;
        }
    }
    __syncthreads();
}

#define XB_TMO      128
#define XB_XCNT(j)  (256  + 64 * (j))
#define XB_XSUB(j)  (1280 + 64 * (j))
#define XB_XGEN(j)  (2304 + 64 * (j))
#define XB_TOP      3328
#define XB_TOPGEN   3392
#define XCD_BAR_WORDS 3456
#define XB_SPIN_CAP (1u << 18)

__device__ __forceinline__ unsigned xb_ld(unsigned* p)              { return __hip_atomic_load(p, __ATOMIC_RELAXED, __HIP_MEMORY_SCOPE_AGENT); }
__device__ __forceinline__ unsigned xb_add(unsigned* p, unsigned v) { return __hip_atomic_fetch_add(p, v, __ATOMIC_RELAXED, __HIP_MEMORY_SCOPE_AGENT); }
__device__ __forceinline__ unsigned xb_xcc_id() { return (unsigned)__builtin_amdgcn_s_getreg((3 << 11) | 20) & 0xFu; }
#define XB_SPIN(cond, bar) do { unsigned _sp = 0; while (cond) { __builtin_amdgcn_s_sleep(1); \
    if ((++_sp & 255u) == 0u) { if (xb_ld(&(bar)[XB_TMO])) break; if (_sp > XB_SPIN_CAP) { atomicAdd(&(bar)[XB_TMO], 1u); break; } } } } while (0)

struct XcdBarrier {
    unsigned* bar; unsigned x;
    volatile LAS unsigned* st;
};

__device__ __forceinline__ XcdBarrier xcd_barrier_post(unsigned* bar, volatile LAS unsigned* st) {
    XcdBarrier b; b.bar = bar; b.x = xb_xcc_id(); b.st = st;
    if (opaque_tid() == 0) (void)xb_add(&bar[XB_XCNT(b.x)], 1u);
    return b;
}
__device__ __forceinline__ void xcd_barrier_complete(unsigned* bar, unsigned x, unsigned& nloc, unsigned& nx) {
    const unsigned G = gridDim.x * gridDim.y * gridDim.z;
    unsigned sum, cnt, mine, sp = 0u;
    for (;;) {
        sum = 0u; cnt = 0u; mine = 0u;
#pragma unroll
        for (unsigned j = 0; j < 16; ++j) { const unsigned c = xb_ld(&bar[XB_XCNT(j)]); sum += c; cnt += (c > 0u) ? 1u : 0u; mine = (j == x) ? c : mine; }
        if (sum == G) break;
        __builtin_amdgcn_s_sleep(1);
        if ((++sp & 255u) == 0u) { if (xb_ld(&bar[XB_TMO])) break; if (sp > XB_SPIN_CAP) { atomicAdd(&bar[XB_TMO], 1u); break; } }
    }
    nloc = mine > 0u ? mine : 1u; nx = cnt > 0u ? cnt : 1u;
}

__device__ __forceinline__ void xcd_barrier(const XcdBarrier& b) {
    asm volatile("s_waitcnt vmcnt(0)" ::: "memory");
    __syncthreads();
    if (opaque_tid() == 0) {
        unsigned* bar = b.bar;
        __builtin_amdgcn_s_waitcnt(0);
        unsigned nloc = b.st[0], nx = b.st[1];
        if (nloc == 0u) { xcd_barrier_complete(bar, b.x, nloc, nx); b.st[0] = nloc; b.st[1] = nx; }
        const unsigned old = xb_add(&bar[XB_XSUB(b.x)], 1u);
        const unsigned gen = old / nloc;
        if (old + 1u == (gen + 1u) * nloc) {
            __builtin_amdgcn_fence(__ATOMIC_RELEASE, "agent");
            asm volatile("s_waitcnt vmcnt(0)" ::: "memory");
            const unsigned og = xb_add(&bar[XB_TOP], 1u);
            const unsigned tg = og / nx;
            if (og + 1u == (tg + 1u) * nx) xb_add(&bar[XB_TOPGEN], 1u);
            else XB_SPIN(xb_ld(&bar[XB_TOPGEN]) == tg, bar);
            __builtin_amdgcn_fence(__ATOMIC_ACQUIRE, "agent");
            xb_add(&bar[XB_XGEN(b.x)], 1u);
            asm volatile("s_waitcnt vmcnt(0)" ::: "memory");
        } else {
            XB_SPIN(xb_ld(&bar[XB_XGEN(b.x)]) == gen, bar);
            __builtin_amdgcn_fence(__ATOMIC_ACQUIRE, "agent");
            asm volatile("s_waitcnt vmcnt(0)" ::: "memory");
        }
    }
    __syncthreads();
}

#ifndef PROBE_DUP
#define PROBE_DUP 0
#endif
#ifndef ITEM_MASK
#define ITEM_MASK 127
#endif
__global__ void __launch_bounds__(NTHR, 2) fwd_kernel(Args a) {
    extern __shared__ __attribute__((aligned(16))) unsigned char lds[];
    {
        volatile LAS unsigned* bst0 = (volatile LAS unsigned*)(lds + LDS_BYTES - 16);
        if (opaque_tid() == 0) { bst0[0] = 0u; bst0[1] = 0u; }
        __syncthreads();
        (void)xcd_barrier_post((unsigned*)(ws_() + WS_BAR), bst0);
    }
    if (PH_HI > 4096) cg::this_grid().sync();
#define SEAM(k) do { if ((k) + 1 < PH_HI) { XcdBarrier xb_; xb_.bar = (unsigned*)(ws_() + WS_BAR); xb_.x = xb_xcc_id(); xb_.st = (volatile LAS unsigned*)(lds + LDS_BYTES - 16); xcd_barrier(xb_); if (PROBE_DUP == 1) xcd_barrier(xb_); } } while (0)
#define IN(k) (PH_LO <= (k) && (k) < PH_HI)
    if (IN(0)) { prep_phase(a, lds); if (PROBE_DUP == 4) prep_phase(a, lds); SEAM(0); }
    for (int l = 0; l < DEPTH; ++l) {
        const int pb = 1 + 8 * l;
        if (l == 0 && IN(pb + 0)) {
            norm_phase<false, 1>(INP(0), nullptr, (bf16_t*)(ws_() + WS_H), (float*)(ws_() + WS_SS2), nullptr, (const float*)(ws_() + WS_WF), INP(23), (float*)(ws_() + WS_LOGF));
            SEAM(pb + 0);
        }
        if (IN(pb + 1)) {
            pg8::Gemm g{(const pg8::bf16_t*)(ws_() + WS_H), (const pg8::bf16_t*)(ws_() + WS_WIN) + (size_t)l * ZW * DM, T, ZW, DM}; pg8::StaticOrder S; S.init(T, ZW, grid_(), bid_());
            EpiStoreBf16<0, true> E{(bf16_t*)(ws_() + WS_Z), ZW, (const float*)(ws_() + WS_SS2)};
            pg8::gemm_phase<EpiStoreBf16<0, true>, pg8::StaticOrder, true, true>((PG8_LAS unsigned char*)lds, g, S, E);
            if (PROBE_DUP == 9) pg8::gemm_phase<EpiStoreBf16<0, true>, pg8::StaticOrder, true, true>((PG8_LAS unsigned char*)lds, g, S, E);
            if (l > 0) norm_phase<true, 1>(ws_() + WS_H, nullptr, nullptr, nullptr, nullptr, (const float*)(ws_() + WS_WF) + (size_t)l * DM * 4, INP(23) + l * 4, (float*)(ws_() + WS_LOGF));
            SEAM(pb + 1);
        }
        if (IN(pb + 2)) {
            for (int rep = 0; rep < (PROBE_DUP == 2 ? 2 : 1); ++rep)
            for (int it = bid_(); it < 260; it += grid_()) {
                if (it < 128) { if (ITEM_MASK & 1) s5_item<1>(l, it >> 5, it & 31, a, lds); }
                else if (it < 256) { if (ITEM_MASK & 4) lru_item<1>(l, (it - 128) >> 5, (it - 128) & 31, a, lds); }
                else { if (ITEM_MASK & 8) cumsum_item(it - 256, (const float*)(ws_() + WS_LOGF), (float*)(ws_() + WS_CS), lds); }
            }
            SEAM(pb + 2);
        }
        if (IN(pb + 3)) {
            for (int rep = 0; rep < (PROBE_DUP == 3 ? 2 : 1); ++rep) {
            for (int rep2 = 0; rep2 < (PROBE_DUP == 5 ? 2 : 1); ++rep2)
            for (int up = bid_(); up < 256; up += grid_()) {
                const int pr = up >> 4, j = up & 15;
                if (ITEM_MASK & 16) { attn_unit(pr >> 2, pr & 3, 31 - j, a, lds);
                attn_unit(pr >> 2, pr & 3, j, a, lds); }
            }
            for (int rep3 = 0; rep3 < (PROBE_DUP == 6 ? 2 : 1); ++rep3)
            for (int it = bid_(); it < 256; it += grid_()) {
                if (it < 128) { if (ITEM_MASK & 32) s5_item<2>(l, it >> 5, it & 31, a, lds); }
                else { if (ITEM_MASK & 64) lru_item<2>(l, (it - 128) >> 5, (it - 128) & 31, a, lds); }
            }
            if (ITEM_MASK & 2) {
                unsigned* qctr = (unsigned*)(ws_() + WS_BAR) + 3600 + l;
                volatile LAS unsigned* qslot = (volatile LAS unsigned*)(lds + LDS_BYTES - 48);
                for (;;) {
                    __syncthreads();
                    if (opaque_tid() == 0) qslot[0] = __hip_atomic_fetch_add(qctr, 1u, __ATOMIC_RELAXED, __HIP_MEMORY_SCOPE_AGENT);
                    __syncthreads();
                    const unsigned qi = qslot[0];
                    if (qi >= 256u) break;
                    if (qi < 128u) sgu_item<1>(l, (int)(qi >> 5), (int)(qi & 31), a, lds);
                    else sgu_item<0>(l, (int)((qi - 128u) >> 5), (int)(qi & 31), a, lds);
                }
            }
            }
            SEAM(pb + 3);
        }
        if (IN(pb + 4)) {
            pg8::Gemm g{(const pg8::bf16_t*)(ws_() + WS_Y), (const pg8::bf16_t*)(ws_() + WS_WOUT) + (size_t)l * DM * DM, T, DM, DM}; pg8::StaticOrder S; S.init(T, DM, grid_(), bid_());
            EpiRes<true, true> E{(bf16_t*)(ws_() + WS_H), DM, (const float*)(ws_() + WS_SSD), (float*)(ws_() + WS_SS2)};
            pg8::gemm_phase<EpiRes<true, true>, pg8::StaticOrder, true, true>((PG8_LAS unsigned char*)lds, g, S, E);
            SEAM(pb + 4);
        }
        if (IN(pb + 6)) {
            pg8::Gemm g{(const pg8::bf16_t*)(ws_() + WS_H), (const pg8::bf16_t*)(ws_() + WS_WMI) + (size_t)l * DFF * DM, T, DFF, DM}; pg8::StaticOrder S; S.init(T, DFF, grid_(), bid_());
            EpiStoreBf16<1, true> E{(bf16_t*)(ws_() + WS_ACT), DFF, (const float*)(ws_() + WS_SS2)};
            pg8::gemm_phase<EpiStoreBf16<1, true>, pg8::StaticOrder, true, true>((PG8_LAS unsigned char*)lds, g, S, E);
            SEAM(pb + 6);
        }
        if (IN(pb + 7)) {
            pg8::Gemm g{(const pg8::bf16_t*)(ws_() + WS_ACT), (const pg8::bf16_t*)(ws_() + WS_WMO) + (size_t)l * DM * DFF, T, DM, DFF}; pg8::StaticOrder S; S.init(T, DM, grid_(), bid_());
            EpiRes<false, true> E{(bf16_t*)(ws_() + WS_H), DM, nullptr, (float*)(ws_() + WS_SS2)};
            pg8::gemm_phase<EpiRes<false, true>, pg8::StaticOrder, true, true>((PG8_LAS unsigned char*)lds, g, S, E);
            SEAM(pb + 7);
        }
    }
    if (IN(33)) norm_phase<true, 2>(ws_() + WS_H, INP(29), nullptr, nullptr, out_(), nullptr, nullptr, nullptr);
#undef SEAM
#undef IN
}


#ifndef DUMP_SEL
#define DUMP_SEL 0
#endif
#ifndef DUMP_LAST
#define DUMP_LAST 33
#endif
__global__ void dump_kernel(const unsigned char* ws, float* out) {
    const size_t i = (size_t)blockIdx.x * blockDim.x + threadIdx.x;
    const size_t t = i >> 10, c = i & 1023;
    float v = 0.f;
    if (DUMP_SEL == 1) v = bf2f(((const bf16_t*)(ws + WS_H))[i]);
    if (DUMP_SEL == 2) v = bf2f(((const bf16_t*)(ws + WS_Z))[t * ZW + c]) + bf2f(((const bf16_t*)(ws + WS_Z))[t * ZW + c + 1024]);
    if (DUMP_SEL == 3) v = bf2f(((const bf16_t*)(ws + WS_Y))[i]);
    if (DUMP_SEL == 5) v = ((const float*)(ws + WS_SSD))[(t * 4 + (c & 3))] + ((const float*)(ws + WS_CS))[(t * 4 + (c & 3))];
    if (DUMP_SEL == 7) v = ((const float*)(ws + WS_ELOC))[i & 262143];
    if (DUMP_SEL == 8) v = ((const float*)(ws + WS_LA))[i & 32767] + ((const float*)(ws + WS_LB))[i & 32767];
    if (DUMP_SEL == 6) v = bf2f(((const bf16_t*)(ws + WS_WIN))[i]) + bf2f(((const bf16_t*)(ws + WS_WMI))[i]) + bf2f(((const bf16_t*)(ws + WS_WMO))[i]) + bf2f(((const bf16_t*)(ws + WS_WOUT))[i & 0x3fffff]);
    out[i] = v;
}
#ifndef N_LAUNCH_MODE
#define N_LAUNCH_MODE 1
#endif
extern "C" void kernel_launch(void* const* d_in, const int* in_sizes, int n_in, void* d_out, int out_size, void* d_ws, size_t ws_size, hipStream_t stream) {
    static int grid = 0;
    if (grid == 0) {
        if (n_in != 30 || out_size != T * DM || ws_size < WS_END) { fprintf(stderr, "kernel_launch: unexpected shapes (n_in %d, out %d, ws %zu, need %zu)\n", n_in, out_size, ws_size, (size_t)WS_END); grid = -1; return; }
        int dev = 0, cus = 0, per_cu = 0;
        hipGetDevice(&dev); hipDeviceGetAttribute(&cus, hipDeviceAttributeMultiprocessorCount, dev);
        if (hipFuncSetAttribute((const void*)fwd_kernel, hipFuncAttributeMaxDynamicSharedMemorySize, LDS_BYTES) != hipSuccess) { fprintf(stderr, "kernel_launch: hipFuncSetAttribute failed\n"); grid = -1; return; }
        if (hipOccupancyMaxActiveBlocksPerMultiprocessor(&per_cu, (const void*)fwd_kernel, NTHR, LDS_BYTES) != hipSuccess || per_cu < 1) { fprintf(stderr, "kernel_launch: occupancy query says %d\n", per_cu); per_cu = 1; }
        (void)hipGetLastError();
        grid = cus;
        if (grid > 256) grid = 256;
    }
    if (grid < 0) return;
    Args a{};
    for (int i = 0; i < 30; ++i) a.in[i] = (const float*)d_in[i];
    a.out = (float*)d_out; a.ws = (unsigned char*)d_ws;
    if (N_LAUNCH_MODE == 1) {
        a.ph_lo = 0; a.ph_hi = 34;
        if (hipMemsetAsync((unsigned char*)d_ws + WS_BAR, 0, 16 * 1024, stream) != hipSuccess) { fprintf(stderr, "kernel_launch: memset of the barrier words failed\n"); return; }
        void* args[] = {&a};
        hipError_t e = hipLaunchCooperativeKernel((const void*)fwd_kernel, dim3(grid), dim3(NTHR), args, LDS_BYTES, stream);
        if (e != hipSuccess) fprintf(stderr, "kernel_launch: cooperative launch failed: %s (grid %d)\n", hipGetErrorString(e), grid);
    } else {
        for (int ph = 0; ph <= DUMP_LAST; ++ph) { a.ph_lo = ph; a.ph_hi = ph + 1; hipLaunchKernelGGL(fwd_kernel, dim3(grid), dim3(NTHR), LDS_BYTES, stream, a); }
        if (DUMP_SEL != 0 && DUMP_SEL != 4) hipLaunchKernelGGL(dump_kernel, dim3(T * DM / 256), dim3(256), 0, stream, (const unsigned char*)d_ws, (float*)d_out);
    }
}
```

```cpp
#include <hip/hip_runtime.h>
#include <hip/hip_cooperative_groups.h>
#include <cstdio>
#include <cstdint>
namespace cg = cooperative_groups;
__device__ __forceinline__ int opaque_tid() { int t = __builtin_amdgcn_workitem_id_x(); asm volatile("" : "+v"(t)); return t; }
namespace pg8 {
#define PG8_LAS __attribute__((address_space(3)))
typedef unsigned short bf16_t;
typedef short bf16x8 __attribute__((ext_vector_type(8)));
typedef float f32x4 __attribute__((ext_vector_type(4)));
typedef unsigned u32x4 __attribute__((ext_vector_type(4)));
constexpr int BM = 256, BK = 64, HALF = 128, HTB = HALF * BK * 2  , STAGE_BYTES = 8 * HTB, NXCD = 8, WGM = 4;

__host__ __device__ __forceinline__ int lds_byte(int r, int c) { const int st = (r >> 4) * 2 + (c >> 5), rr = r & 15, cc = c & 31, ob = rr * 64 + cc * 2; return st * 1024 + (ob ^ (((ob >> 9) & 1) << 5)); }
__host__ __device__ __forceinline__ void stage_rc(int b, int& R, int& C) { const int st = b / 1024, sb = b % 1024, swz = sb ^ (((sb >> 9) & 1) << 5); R = (st >> 1) * 16 + swz / 64; C = (st & 1) * 32 + (swz % 64) / 2; }
__host__ __device__ __forceinline__ int perm32(int rho) { const int n = rho >> 4, i = rho & 15; return 8 * (i >> 2) + 4 * n + (i & 3); }

struct Unit { int pm, pn; };
struct Gemm { const bf16_t* A; const bf16_t* Bt; int M, N, K; };

struct StaticOrder {
    int nM, nN, nwg, G, c, wgm;
    __host__ __device__ void init(int M, int N, int G_, int c_, int wgm_ = WGM) { nM = M / BM; nN = N / BM; nwg = nM * nN; G = G_; c = c_; wgm = wgm_; }
    __host__ __device__ bool next(int i, Unit& u) const {
        const long L = (long)i * G + c; if (L >= nwg) return false;
        int wgid = (int)L; { const int q = nwg / NXCD, r = nwg % NXCD, xcd = wgid % NXCD, off = wgid / NXCD; wgid = (xcd < r ? xcd * (q + 1) : r * (q + 1) + (xcd - r) * q) + off; }
        const int nig = wgm * nN, gid = wgid / nig, fm = gid * wgm, gsz = (nM - fm) < wgm ? (nM - fm) : wgm;
        u.pm = fm + ((wgid % nig) % gsz); u.pn = (wgid % nig) / gsz; return true;
    }
    __device__ __forceinline__ void a_ready(const Unit&) const {}
    __device__ __forceinline__ void done(const Unit&) const {}
};

__device__ __forceinline__ unsigned cvt_pk_bf16(float lo, float hi) { unsigned r; asm volatile("v_cvt_pk_bf16_f32 %0, %1, %2" : "=v"(r) : "v"(lo), "v"(hi)); return r; }
template <class Epi, class Sched, bool ALIGN_EPI = false, bool SP2 = false>
__device__ __forceinline__ void gemm_phase(PG8_LAS unsigned char* lds, const Gemm g, const Sched& S, const Epi& E) {
    const int tid = opaque_tid(), wid = __builtin_amdgcn_readfirstlane(tid >> 6), lane = tid & 63, wr = wid >> 2, wc = wid & 3, fr = lane & 15, fq = lane >> 4;
    const int K = g.K, nt = K / BK;
    unsigned voffA[2], voffB[2];
#pragma unroll
    for (int i = 0; i < 2; ++i) { int R, C; stage_rc(tid * 16 + i * 8192, R, C); const int Rb = Epi::PERM ? ((R & ~31) + perm32(R & 31)) : R;
        voffA[i] = (unsigned)(R * K + C) * 2u; voffB[i] = (unsigned)(Rb * K + C) * 2u; }
    const size_t kstep = (size_t)(BK * 2);
    const size_t hstep = (size_t)HALF * K * 2;
    const size_t tstep = 2 * hstep;
    const unsigned ldsw = (unsigned)wid * 1024u;
    const int aoff = lds_byte(wr * 64 + fr, fq * 8), boff = lds_byte(wc * 32 + fr, fq * 8);
#define PG8_SA(b, h) (((b) * 2 + (h)) * HTB)
#define PG8_SB(b, h) ((4 + (b) * 2 + (h)) * HTB)
#define PG8_STAGE(bufoff, gbase, voff) do { _Pragma("unroll") for (int _i = 0; _i < 2; ++_i) \
        __builtin_amdgcn_global_load_lds((const unsigned*)((const char*)(gbase) + (voff)[_i]), (PG8_LAS unsigned*)(lds + (bufoff) + ldsw + _i * 8192), 16, 0, 0); } while (0)
#define PG8_LDA(dst, b, h) do { _Pragma("unroll") for (int m = 0; m < 4; ++m) _Pragma("unroll") for (int k = 0; k < 2; ++k) dst[m][k] = *(const PG8_LAS bf16x8*)(lds + PG8_SA(b, h) + aoff + m * 2048 + k * 1024); } while (0)
#define PG8_LDB(dst, b, h) do { _Pragma("unroll") for (int n = 0; n < 2; ++n) _Pragma("unroll") for (int k = 0; k < 2; ++k) dst[n][k] = *(const PG8_LAS bf16x8*)(lds + PG8_SB(b, h) + boff + n * 2048 + k * 1024); } while (0)
#define PG8_MMA(ai, bj, At, Bt) do { __builtin_amdgcn_s_setprio(1); _Pragma("unroll") for (int m = 0; m < 4; ++m) _Pragma("unroll") for (int n = 0; n < 2; ++n) _Pragma("unroll") for (int k = 0; k < 2; ++k) \
        acc[ai][bj][m][n] = __builtin_amdgcn_mfma_f32_16x16x32_bf16(Bt[n][k], At[m][k], acc[ai][bj][m][n], 0, 0, 0); __builtin_amdgcn_s_setprio(0); } while (0)
#define PG8_WAIT_V(n) asm volatile("s_waitcnt vmcnt(" #n ")" ::: "memory")
#define PG8_WAIT_L(n) asm volatile("s_waitcnt lgkmcnt(" #n ")" ::: "memory")
#define PG8_BAR __builtin_amdgcn_s_barrier()
#define PG8_SCHED __builtin_amdgcn_sched_barrier(0)
    Unit cur, nxt; int ui = 0;
    if (!S.next(0, cur)) return;
    if constexpr (Epi::KPREP) { Unit pu; for (int i = 0; i < 12 && S.next(i, pu); ++i) E.kprep(pu, lds + STAGE_BYTES + i * 1024, tid); }
    f32x4 acc[2][2][4][2];
#pragma unroll
    for (int a = 0; a < 2; ++a)
#pragma unroll
        for (int b = 0; b < 2; ++b)
#pragma unroll
            for (int m = 0; m < 4; ++m)
#pragma unroll
                for (int n = 0; n < 2; ++n) acc[a][b][m][n] = (f32x4){0.f, 0.f, 0.f, 0.f};
    bf16x8 At[4][2], B0[2][2], B1[2][2];
    const char* cA = (const char*)g.A + (size_t)cur.pm * tstep; const char* cB = (const char*)g.Bt + (size_t)cur.pn * tstep;
    S.a_ready(cur);
    if constexpr (SP2) {
        PG8_STAGE(PG8_SB(0, 0), cB, voffB); PG8_STAGE(PG8_SB(0, 1), cB + hstep, voffB); PG8_STAGE(PG8_SA(0, 0), cA, voffA); PG8_STAGE(PG8_SA(0, 1), cA + hstep, voffA);
        if (wr == 1) PG8_BAR;
        PG8_WAIT_V(2); PG8_BAR;
        PG8_STAGE(PG8_SB(1, 0), cB + kstep, voffB); PG8_STAGE(PG8_SA(1, 0), cA + kstep, voffA); PG8_STAGE(PG8_SB(1, 1), cB + hstep + kstep, voffB);
        PG8_WAIT_V(6); PG8_BAR;
    } else {
        PG8_STAGE(PG8_SB(0, 0), cB, voffB); PG8_STAGE(PG8_SA(0, 0), cA, voffA); PG8_STAGE(PG8_SB(0, 1), cB + hstep, voffB); PG8_STAGE(PG8_SA(0, 1), cA + hstep, voffA);
        if (wr == 1) PG8_BAR;
        PG8_WAIT_V(4); PG8_BAR;
        PG8_STAGE(PG8_SB(1, 0), cB + kstep, voffB); PG8_STAGE(PG8_SA(1, 0), cA + kstep, voffA); PG8_STAGE(PG8_SB(1, 1), cB + hstep + kstep, voffB);
        PG8_WAIT_V(6); PG8_BAR;
    }
    for (;;) {
        const bool has_next = S.next(ui + 1, nxt);
        const char* nA = has_next ? (const char*)g.A + (size_t)nxt.pm * tstep : cA; const char* nB = has_next ? (const char*)g.Bt + (size_t)nxt.pn * tstep : cB;
        for (int t = 0; t < nt; t += 2) {
            const bool last = (t == nt - 2);
            const char* a1 = cA + (size_t)(t + 1) * kstep;
            const char* a2 = last ? nA : cA + (size_t)(t + 2) * kstep; const char* b2 = last ? nB : cB + (size_t)(t + 2) * kstep;
            const char* a3 = a2 + kstep; const char* b3 = b2 + kstep;
            if (last && has_next) S.a_ready(nxt);
            if constexpr (SP2) {
            PG8_LDB(B0, 0, 0); PG8_LDB(B1, 0, 1); PG8_SCHED; PG8_LDA(At, 0, 0); PG8_STAGE(PG8_SA(1, 1), a1 + hstep, voffA);
            PG8_WAIT_V(8); PG8_WAIT_L(0); PG8_BAR; PG8_MMA(0, 0, At, B0); PG8_MMA(0, 1, At, B1); PG8_BAR; PG8_SCHED;
            PG8_LDA(At, 0, 1); PG8_STAGE(PG8_SB(0, 0), b2, voffB); PG8_STAGE(PG8_SB(0, 1), b2 + hstep, voffB); PG8_STAGE(PG8_SA(0, 0), a2, voffA);
            PG8_WAIT_V(8); PG8_WAIT_L(0); PG8_BAR; PG8_MMA(1, 0, At, B0); PG8_MMA(1, 1, At, B1); PG8_BAR; PG8_SCHED;
            PG8_LDB(B0, 1, 0); PG8_LDB(B1, 1, 1); PG8_SCHED; PG8_LDA(At, 1, 0); PG8_STAGE(PG8_SA(0, 1), a2 + hstep, voffA);
            PG8_WAIT_V(8); PG8_WAIT_L(0); PG8_BAR; PG8_MMA(0, 0, At, B0); PG8_MMA(0, 1, At, B1); PG8_BAR; PG8_SCHED;
            PG8_LDA(At, 1, 1); PG8_STAGE(PG8_SB(1, 0), b3, voffB); PG8_STAGE(PG8_SB(1, 1), b3 + hstep, voffB); PG8_STAGE(PG8_SA(1, 0), a3, voffA);
            PG8_WAIT_V(8); PG8_WAIT_L(0); PG8_BAR; PG8_MMA(1, 0, At, B0); PG8_MMA(1, 1, At, B1); PG8_BAR; PG8_SCHED;
            } else {
            PG8_LDB(B0, 0, 0); PG8_SCHED; PG8_LDA(At, 0, 0); PG8_STAGE(PG8_SA(1, 1), a1 + hstep, voffA);
            PG8_WAIT_L(8); PG8_BAR; PG8_WAIT_L(0); PG8_MMA(0, 0, At, B0); PG8_BAR; PG8_SCHED;
            PG8_LDB(B1, 0, 1); PG8_STAGE(PG8_SB(0, 0), b2, voffB);
            PG8_BAR; PG8_WAIT_L(0); PG8_MMA(0, 1, At, B1); PG8_BAR;
            PG8_LDA(At, 0, 1); PG8_STAGE(PG8_SA(0, 0), a2, voffA);
            PG8_BAR; PG8_WAIT_L(0); PG8_MMA(1, 0, At, B0); PG8_BAR; PG8_SCHED;
            PG8_STAGE(PG8_SB(0, 1), b2 + hstep, voffB);
            PG8_WAIT_V(6); PG8_BAR; PG8_MMA(1, 1, At, B1); PG8_BAR;
            PG8_LDB(B0, 1, 0); PG8_SCHED; PG8_LDA(At, 1, 0); PG8_STAGE(PG8_SA(0, 1), a2 + hstep, voffA);
            PG8_WAIT_L(8); PG8_BAR; PG8_WAIT_L(0); PG8_MMA(0, 0, At, B0); PG8_BAR; PG8_SCHED;
            PG8_LDB(B1, 1, 1); PG8_STAGE(PG8_SB(1, 0), b3, voffB);
            PG8_BAR; PG8_WAIT_L(0); PG8_MMA(0, 1, At, B1); PG8_BAR;
            PG8_LDA(At, 1, 1); PG8_STAGE(PG8_SA(1, 0), a3, voffA);
            PG8_BAR; PG8_WAIT_L(0); PG8_MMA(1, 0, At, B0); PG8_BAR; PG8_SCHED;
            PG8_STAGE(PG8_SB(1, 1), b3 + hstep, voffB);
            PG8_WAIT_V(6); PG8_BAR; PG8_MMA(1, 1, At, B1); PG8_BAR;
            }
            if constexpr (Epi::KHOOK) { if (t == 2) E.khook(acc, lds + STAGE_BYTES + ui * 1024, wr, fr); }
        }
        if constexpr (ALIGN_EPI) { if (wr == 0) PG8_BAR; }
        if constexpr (!Epi::AFTER_DRAIN) { E(acc, cur, wr, wc, fr, fq, lds + STAGE_BYTES + ui * 1024); S.done(cur); }
        if (!has_next) break;
#pragma unroll
        for (int a = 0; a < 2; ++a)
#pragma unroll
            for (int b = 0; b < 2; ++b)
#pragma unroll
                for (int m = 0; m < 4; ++m)
#pragma unroll
                    for (int n = 0; n < 2; ++n) acc[a][b][m][n] = (f32x4){0.f, 0.f, 0.f, 0.f};
        cur = nxt; cA = nA; cB = nB; ++ui;
        if constexpr (ALIGN_EPI) { if (wr == 1) PG8_BAR; }
    }
    PG8_WAIT_V(0);
    if constexpr (!ALIGN_EPI) { if (wr == 0) PG8_BAR; }
    PG8_BAR;
    if constexpr (Epi::AFTER_DRAIN) { E.fused(acc, cur, wr, wc, fr, fq, lds, wid, lane); S.done(cur); }
#undef PG8_SA
#undef PG8_SB
#undef PG8_STAGE
#undef PG8_LDA
#undef PG8_LDB
#undef PG8_MMA
#undef PG8_WAIT_V
#undef PG8_WAIT_L
#undef PG8_BAR
#undef PG8_SCHED
}
}

#define LAS __attribute__((address_space(3)))
typedef unsigned short bf16_t;
typedef short bf16x8 __attribute__((ext_vector_type(8)));
typedef short bf16x4 __attribute__((ext_vector_type(4)));
typedef float f32x4 __attribute__((ext_vector_type(4)));
typedef float f32x2 __attribute__((ext_vector_type(2)));
typedef unsigned u32x4 __attribute__((ext_vector_type(4)));
typedef unsigned u32x2 __attribute__((ext_vector_type(2)));

constexpr int NB = 4, SEQ = 4096, DM = 1024, DEPTH = 4, T = NB * SEQ, W = 256, DFF = 4096, NIN = 2052, ZW = 2048;
constexpr int NCH = SEQ / 128;
constexpr float EPS = 1e-6f;
constexpr float LOG2E = 1.4426950408889634f;
constexpr int NTHR = 512;
constexpr int LDS_BYTES = 147456;
constexpr int ZC_AU = 0, ZC_AV = 256, ZC_B = 512, ZC_CX = 768, ZC_CG = 1024, ZC_Q = 1280, ZC_K = 1536, ZC_V = 1792;
constexpr int YC_D = 0, YC_A = 256, YC_B = 512, YC_C = 768;

constexpr size_t MiB = 1u << 20;
constexpr size_t WS_WIN = 0, WS_WOUT = 16 * MiB, WS_WMI = 24 * MiB, WS_WMO = 56 * MiB, WS_R = 88 * MiB, WS_Z = WS_R, WS_Y = WS_R + 64 * MiB, WS_ACT = WS_R,
                 WS_H = 216 * MiB, WS_S = 248 * MiB;
constexpr size_t WS_GLUT = WS_S, WS_WAT = WS_GLUT + 512 * 1024, WS_WXT = WS_WAT + 128 * 1024, WS_BBT = WS_WXT + 128 * 1024, WS_CMT = WS_BBT + 256 * 1024,
                 WS_ABAR = WS_CMT + 256 * 1024, WS_A128 = WS_ABAR + 32 * 1024, WS_WF = WS_A128 + 32 * 1024, WS_LOGF = WS_WF + 64 * 1024, WS_CS = WS_LOGF + 256 * 1024,
                 WS_SSD = WS_CS + 256 * 1024, WS_ELOC = WS_SSD + 256 * 1024, WS_LA = WS_ELOC + 1024 * 1024, WS_LB = WS_LA + 128 * 1024, WS_BAR = WS_LB + 128 * 1024, WS_SS2 = WS_BAR + 16 * 1024, WS_KMAX = WS_SS2 + 1024 * 1024, WS_END = WS_KMAX + 4096;

struct Args {
    const float* in[30]; float* out; unsigned char* ws; int ph_lo, ph_hi;
};


typedef const __attribute__((address_space(4))) unsigned long long* kargp_t;
__device__ __forceinline__ unsigned long long karg_(int i) { kargp_t tab = (kargp_t)__builtin_amdgcn_kernarg_segment_ptr(); asm volatile("" : "+s"(tab)); return tab[i]; }
#define INP(i) ((const float*)karg_(i))
__device__ __forceinline__ unsigned char* ws_() { return (unsigned char*)karg_(31); }
__device__ __forceinline__ float* out_() { return (float*)karg_(30); }
#define PH_LO ((int)(unsigned)(karg_(32) & 0xffffffffull))
#define PH_HI ((int)(unsigned)(karg_(32) >> 32))
__device__ __forceinline__ int bid_() { return blockIdx.x; }
__device__ __forceinline__ int grid_() { return gridDim.x; }
__device__ __forceinline__ float bf2f(bf16_t v) { return __uint_as_float((unsigned)v << 16); }
__device__ __forceinline__ float bfs2f(short v) { return __uint_as_float(((unsigned)(unsigned short)v) << 16); }
typedef __bf16 bf16x2_t __attribute__((ext_vector_type(2)));
__device__ __forceinline__ unsigned pk2(float lo, float hi) { const f32x2 v = {lo, hi}; const bf16x2_t b = __builtin_convertvector(v, bf16x2_t); return __builtin_bit_cast(unsigned, b); }
__device__ __forceinline__ bf16_t f2bf(float f) { return (bf16_t)(pk2(f, 0.f) & 0xffffu); }
__device__ __forceinline__ float gelu_t(float x) { const float y2 = (1.5957691216057308f * LOG2E) * (x + 0.044715f * x * x * x); return x * __builtin_amdgcn_rcpf(1.0f + __builtin_amdgcn_exp2f(-y2)); }
__device__ __forceinline__ float sigm(float x) { return __builtin_amdgcn_rcpf(1.0f + __builtin_amdgcn_exp2f(-LOG2E * x)); }
__device__ __forceinline__ float softplus_f(float x) { return fmaxf(x, 0.f) + log1pf(__expf(-fabsf(x))); }
__device__ __forceinline__ f32x4 mfma16(bf16x8 a, bf16x8 b, f32x4 c) { return __builtin_amdgcn_mfma_f32_16x16x32_bf16(a, b, c, 0, 0, 0); }
__device__ __forceinline__ float quad_sum(float v) {
    { const auto r = __builtin_amdgcn_permlane16_swap(__float_as_uint(v), __float_as_uint(v), false, false); v = __uint_as_float(r[0]) + __uint_as_float(r[1]); }
    { const auto r = __builtin_amdgcn_permlane32_swap(__float_as_uint(v), __float_as_uint(v), false, false); v = __uint_as_float(r[0]) + __uint_as_float(r[1]); }
    return v;
}
template <int CTRL> __device__ __forceinline__ float dpp_mov(float x) { return __uint_as_float((unsigned)__builtin_amdgcn_update_dpp(0, (int)__float_as_uint(x), CTRL, 0xf, 0xf, true)); }
__device__ __forceinline__ float wave_sum(float v) {
    v += dpp_mov<0xB1>(v); v += dpp_mov<0x4E>(v); v += dpp_mov<0x141>(v); v += dpp_mov<0x140>(v);
    return quad_sum(v);
}
__device__ __forceinline__ float wave_max(float v);
__device__ __forceinline__ float quad_max(float v) {
    { const auto r = __builtin_amdgcn_permlane16_swap(__float_as_uint(v), __float_as_uint(v), false, false); v = fmaxf(__uint_as_float(r[0]), __uint_as_float(r[1])); }
    { const auto r = __builtin_amdgcn_permlane32_swap(__float_as_uint(v), __float_as_uint(v), false, false); v = fmaxf(__uint_as_float(r[0]), __uint_as_float(r[1])); }
    return v;
}
__device__ __forceinline__ bf16x8 pack8(const float* v) {
    u32x4 w; w.x = pk2(v[0], v[1]); w.y = pk2(v[2], v[3]); w.z = pk2(v[4], v[5]); w.w = pk2(v[6], v[7]); return __builtin_bit_cast(bf16x8, w);
}
__device__ __forceinline__ bf16x8 zero8() { return (bf16x8){0, 0, 0, 0, 0, 0, 0, 0}; }

__device__ __forceinline__ float wave_max(float v) {
    v = fmaxf(v, dpp_mov<0xB1>(v)); v = fmaxf(v, dpp_mov<0x4E>(v)); v = fmaxf(v, dpp_mov<0x141>(v)); v = fmaxf(v, dpp_mov<0x140>(v));
    return quad_max(v);
}
template <int N> __device__ __forceinline__ float dpp_shr(float x, float ident) {
    return __uint_as_float((unsigned)__builtin_amdgcn_update_dpp((int)__float_as_uint(ident), (int)__float_as_uint(x), 0x110 + N, 0xf, 0xf, false));
}
__device__ __forceinline__ float neg_expm1(float x) {
    const float s = -x * (1.0f + x * (0.5f + x * (0.16666667f + x * (0.041666668f + x * (0.0083333338f + x * 0.0013888889f)))));
    const float e = 1.0f - __builtin_amdgcn_exp2f(LOG2E * x);
    return (x > -0.25f) ? s : e;
}
template <int ACT  , bool ROWS = false> struct EpiStoreBf16 {
    static constexpr bool PERM = true, AFTER_DRAIN = false, KHOOK = false, KPREP = ROWS;
    __device__ __forceinline__ void kprep(const pg8::Unit& u, PG8_LAS unsigned char* tab, int tid) const {
        if (tid < 256) { const float* rp = rowss + (size_t)(u.pm * 256 + tid) * 16; const f32x4 s0 = *(const f32x4*)rp, s1 = *(const f32x4*)(rp + 4), s2 = *(const f32x4*)(rp + 8), s3 = *(const f32x4*)(rp + 12);
            const float tot = ((s0[0] + s0[1]) + (s0[2] + s0[3])) + ((s1[0] + s1[1]) + (s1[2] + s1[3])) + ((s2[0] + s2[1]) + (s2[2] + s2[3])) + ((s3[0] + s3[1]) + (s3[2] + s3[3]));
            ((PG8_LAS float*)tab)[tid] = rsqrtf(tot * (1.0f / DM) + EPS); }
    }
    bf16_t* O; int ldc; const float* rowss;
    __device__ __forceinline__ void operator()(const pg8::f32x4 (&acc)[2][2][4][2], const pg8::Unit& u, int wr, int wc, int fr, int fq, PG8_LAS unsigned char* tab) const {
        const int row0 = u.pm * 256 + wr * 64 + fr, col0 = u.pn * 256 + wc * 32 + 8 * fq;
#pragma unroll
        for (int ai = 0; ai < 2; ++ai)
#pragma unroll
            for (int m = 0; m < 4; ++m) { bf16_t* rowp = O + (size_t)(row0 + ai * 128 + m * 16) * ldc + col0;
                const float rsc = ROWS ? ((const PG8_LAS float*)tab)[wr * 64 + fr + ai * 128 + m * 16] : 1.0f;
#pragma unroll
                for (int bj = 0; bj < 2; ++bj) { pg8::f32x4 v0 = acc[ai][bj][m][0] * rsc, v1 = acc[ai][bj][m][1] * rsc;
                    if (ACT == 1) {
#pragma unroll
                        for (int e = 0; e < 4; ++e) { const float a = fmaxf(v0[e], 0.f), b = fmaxf(v1[e], 0.f); v0[e] = a * a; v1[e] = b * b; } }
                    u32x4 w; w.x = pk2(v0[0], v0[1]); w.y = pk2(v0[2], v0[3]); w.z = pk2(v1[0], v1[1]); w.w = pk2(v1[2], v1[3]);
                    *(u32x4*)(rowp + bj * 128) = w; } }
    }
};
template <bool HOOK, bool NORMOUT> struct EpiRes {
    static constexpr bool PERM = true, AFTER_DRAIN = false, KHOOK = HOOK, KPREP = HOOK;
    bf16_t* xb; int ldc; const float* ssd; float* ss2;
    __device__ __forceinline__ void operator()(const pg8::f32x4 (&acc)[2][2][4][2], const pg8::Unit& u, int wr, int wc, int fr, int fq, PG8_LAS unsigned char* tab) const {
        const int col0 = u.pn * 256 + wc * 32 + 8 * fq;
#pragma unroll
        for (int ai = 0; ai < 2; ++ai)
#pragma unroll
            for (int m = 0; m < 4; ++m) { const int row = u.pm * 256 + ai * 128 + wr * 64 + m * 16 + fr; bf16_t* rowp = xb + (size_t)row * ldc + col0; float sq = 0.f;
#pragma unroll
                for (int bj = 0; bj < 2; ++bj) { const bf16x8 s = *(const bf16x8*)(rowp + bj * 128); float o[8];
#pragma unroll
                    for (int e = 0; e < 4; ++e) { o[e] = bfs2f(s[e]) + acc[ai][bj][m][0][e]; o[4 + e] = bfs2f(s[4 + e]) + acc[ai][bj][m][1][e]; }
                    if (NORMOUT) {
#pragma unroll
                        for (int e = 0; e < 8; ++e) sq += o[e] * o[e]; }
                    *(bf16x8*)(rowp + bj * 128) = pack8(o); }
                if (NORMOUT) { sq = quad_sum(sq); if (fq == 0) ss2[(size_t)row * 16 + u.pn * 4 + wc] = sq; }
                if (m & 1) asm volatile("" ::: "memory"); }
    }
    __device__ __forceinline__ void kprep(const pg8::Unit& u, PG8_LAS unsigned char* tab, int tid) const {
        if (tid < 256) { const f32x4 s4 = *(const f32x4*)(ssd + (size_t)(u.pm * 256 + tid) * 4); ((PG8_LAS float*)tab)[tid] = rsqrtf((s4[0] + s4[1] + s4[2] + s4[3]) * (1.0f / 256.0f) + EPS); }
    }
    __device__ __forceinline__ void khook(pg8::f32x4 (&acc)[2][2][4][2], PG8_LAS unsigned char* tab, int wr, int fr) const {
#pragma unroll
        for (int ai = 0; ai < 2; ++ai)
#pragma unroll
            for (int m = 0; m < 4; ++m) { const float rs = ((const PG8_LAS float*)tab)[ai * 128 + wr * 64 + m * 16 + fr];
#pragma unroll
                for (int bj = 0; bj < 2; ++bj)
#pragma unroll
                    for (int n = 0; n < 2; ++n) acc[ai][bj][m][n] *= rs; }
    }
};

template <int TN> __device__ __forceinline__ void tc_job(unsigned char* lds, const float* src, size_t sb, int ld, int K, int N, int nbatch, bf16_t* dst, const float* gain, int kshift, int rot) {
    LAS float* tile = (LAS float*)lds;
    constexpr int CG = TN / 64, NLD = TN / 32  , NST = TN / 64  ;
    const int tid = opaque_tid(), nk = K / 64, nn = N / TN, ntile = nbatch * nk * nn;
    for (int ti = (int)((bid_() + grid_() - (rot % grid_())) % grid_()); ti < ntile; ti += grid_()) {
        const int b = ti / (nk * nn), rem = ti % (nk * nn), kt = rem / nn, nt = rem % nn;
        const float* s = src + (size_t)b * sb + (size_t)(kt * 64) * ld + nt * TN;
        f32x4 v[NLD];
#pragma unroll
        for (int p = 0; p < NLD; ++p) { const int idx = tid + 512 * p, c16 = idx & 15, kq = (idx >> 4) & 3, rest = idx >> 6, kl = (rest / CG) * 4 + kq, n4 = ((rest % CG) * 16 + c16) * 4;
            v[p] = *(const f32x4*)(s + (size_t)kl * ld + n4);
            if (gain) { const float gg = gain[(size_t)b * K + kt * 64 + kl]; v[p] = v[p] * gg; } }
        __syncthreads();
#pragma unroll
        for (int p = 0; p < NLD; ++p) { const int idx = tid + 512 * p, c16 = idx & 15, kq = (idx >> 4) & 3, rest = idx >> 6, kl = (rest / CG) * 4 + kq, n4 = ((rest % CG) * 16 + c16) * 4;
            tile[kl * (TN + 1) + n4 + 0] = v[p][0]; tile[kl * (TN + 1) + n4 + 1] = v[p][1]; tile[kl * (TN + 1) + n4 + 2] = v[p][2]; tile[kl * (TN + 1) + n4 + 3] = v[p][3]; }
        __syncthreads();
#pragma unroll
        for (int p = 0; p < NST; ++p) { const int idx = tid + 512 * p, nl = idx >> 3, kc = (idx & 7) * 8; float o[8];
#pragma unroll
            for (int e = 0; e < 8; ++e) o[e] = tile[(kc + e) * (TN + 1) + nl];
            const int kd = (kt * 64 + kc + kshift) % K;
            *(bf16x8*)(dst + (size_t)b * N * K + (size_t)(nt * TN + nl) * K + kd) = pack8(o); }
    }
    __syncthreads();
}

__device__ __forceinline__ void prep_phase(const Args& a, unsigned char* lds) {
    unsigned char* ws = ws_();
    tc_job<256>(lds, INP(2), (size_t)DM * NIN, NIN, DM, ZW, DEPTH, (bf16_t*)(ws + WS_WIN), INP(1), 0, 0);
    tc_job<256>(lds, INP(25), (size_t)DM * DM, DM, DM, DM, DEPTH, (bf16_t*)(ws + WS_WOUT), INP(24), 256, 0);
    tc_job<256>(lds, INP(27), (size_t)DM * DFF, DFF, DM, DFF, DEPTH, (bf16_t*)(ws + WS_WMI), INP(26), 0, 0);
    tc_job<256>(lds, INP(28), (size_t)DFF * DM, DM, DFF, DM, DEPTH, (bf16_t*)(ws + WS_WMO), nullptr, 0, 0);
    tc_job<256>(lds, INP(14), (size_t)W * W, W, W, W, DEPTH, (bf16_t*)(ws + WS_GLUT), nullptr, 0, 0);
    tc_job<64>(lds, INP(18), (size_t)64 * 64, 64, 64, 64, DEPTH * 4, (bf16_t*)(ws + WS_WAT), nullptr, 0, 64);
    tc_job<64>(lds, INP(20), (size_t)64 * 64, 64, 64, 64, DEPTH * 4, (bf16_t*)(ws + WS_WXT), nullptr, 0, 96);
    const int gid = bid_() * NTHR + opaque_tid();
    if (gid < DEPTH * 1024) {
        const int l = gid >> 10, gp = gid & 1023, g = gp >> 6, p = gp & 63;
        const float lre = INP(6)[gid], lim = INP(7)[gid], dt = expf(INP(8)[l * 16 + g]);
        const float mag = expf(lre * dt), are = mag * cosf(lim * dt), aim = mag * sinf(lim * dt);
        const float den = lre * lre + lim * lim, nre = are - 1.0f, nim = aim;
        const float fre = (nre * lre + nim * lim) / den, fim = (nim * lre - nre * lim) / den;
        ((f32x2*)(ws + WS_ABAR))[gid] = (f32x2){are, aim};
        float pr = are, pi = aim;
#pragma unroll
        for (int s = 0; s < 7; ++s) { const float nr = pr * pr - pi * pi, ni = 2.0f * pr * pi; pr = nr; pi = ni; }
        ((f32x2*)(ws + WS_A128))[gid] = (f32x2){pr, pi};
        const float* bre = INP(9) + (size_t)gid * 16; const float* bim = INP(10) + (size_t)gid * 16;
        bf16_t* bbt = (bf16_t*)(ws + WS_BBT) + ((size_t)(l * 16 + g) * 128 + 2 * p) * 16;
#pragma unroll
        for (int h = 0; h < 16; ++h) { const float br = bre[h], bi = bim[h]; bbt[h] = f2bf(fre * br - fim * bi); bbt[16 + h] = f2bf(fre * bi + fim * br); }
        bf16_t* cmt = (bf16_t*)(ws + WS_CMT) + (size_t)(l * 16 + g) * 16 * 128;
#pragma unroll
        for (int h = 0; h < 16; ++h) { const size_t ci = ((size_t)(l * 16 + g) * 16 + h) * 64 + p; ((unsigned*)cmt)[(h * 128 + 2 * p) >> 1] = pk2(INP(11)[ci], -INP(12)[ci]); }
        const float* wr = INP(2) + ((size_t)l * DM + gp) * NIN + ZW;
        ((f32x4*)(ws + WS_WF))[gid] = *(const f32x4*)wr * INP(1)[gid];
    }
}

template <bool SRCB, int MODE> __device__ __forceinline__ void norm_phase(const void* xsv, const float* g, bf16_t* xb, float* ss2, float* od, const float* wf, const float* bfg, float* logf) {
    const int lane = opaque_tid() & 63, wid = opaque_tid() >> 6;
    const int gw = bid_() * 8 + wid, nw = grid_() * 8;
    for (int row = gw; row < T; row += nw) {
        f32x4 v[4]; float ss = 0.f;
#pragma unroll
        for (int i = 0; i < 4; ++i) {
            if (SRCB) { const bf16x4 q = *(const bf16x4*)((const bf16_t*)xsv + (size_t)row * DM + i * 256 + lane * 4); v[i] = (f32x4){bfs2f(q[0]), bfs2f(q[1]), bfs2f(q[2]), bfs2f(q[3])}; }
            else { v[i] = *(const f32x4*)((const float*)xsv + (size_t)row * DM + i * 256 + lane * 4);
                if (MODE == 1) { u32x2 w; w.x = pk2(v[i][0], v[i][1]); w.y = pk2(v[i][2], v[i][3]); *(u32x2*)(xb + (size_t)row * DM + i * 256 + lane * 4) = w; } }
            ss += v[i][0] * v[i][0] + v[i][1] * v[i][1] + v[i][2] * v[i][2] + v[i][3] * v[i][3]; }
        ss = wave_sum(ss);
        const float rs = rsqrtf(ss * (1.0f / DM) + EPS);
        if (MODE == 1 && !SRCB) { if (lane < 16) ss2[(size_t)row * 16 + lane] = (lane == 0) ? ss : 0.f; }
        float f0 = 0.f, f1 = 0.f, f2 = 0.f, f3 = 0.f;
#pragma unroll
        for (int i = 0; i < 4; ++i) {
            if (MODE == 2) { const f32x4 gg = *(const f32x4*)(g + i * 256 + lane * 4); *(f32x4*)(od + (size_t)row * DM + i * 256 + lane * 4) = v[i] * rs * gg; }
            if (MODE == 1) {
#pragma unroll
                for (int e = 0; e < 4; ++e) { const f32x4 w4 = *(const f32x4*)(wf + (size_t)(i * 256 + lane * 4 + e) * 4); const float hv = v[i][e] * rs; f0 += hv * w4[0]; f1 += hv * w4[1]; f2 += hv * w4[2]; f3 += hv * w4[3]; } }
        }
        if (MODE == 1) {
            f0 = wave_sum(f0); f1 = wave_sum(f1); f2 = wave_sum(f2); f3 = wave_sum(f3);
            if (lane == 0) { f32x4 o; const float fv[4] = {f0 + bfg[0], f1 + bfg[1], f2 + bfg[2], f3 + bfg[3]};
#pragma unroll
                for (int e = 0; e < 4; ++e) o[e] = fminf(fv[e], 0.f) - log1pf(__expf(-fabsf(fv[e])));
                *(f32x4*)(logf + (size_t)row * 4) = o; }
        }
    }
}

__device__ __forceinline__ void cumsum_item(int b, const float* logf, float* cs, unsigned char* lds) {
    LAS float* wt = (LAS float*)lds;
    const int tid = opaque_tid(), lane = tid & 63, wid = tid >> 6;
    f32x4 v[8]; f32x4 run = (f32x4){0.f, 0.f, 0.f, 0.f};
    const float* src = logf + ((size_t)b * SEQ + (size_t)tid * 8) * 4;
#pragma unroll
    for (int e = 0; e < 8; ++e) { run = run + *(const f32x4*)(src + e * 4); v[e] = run; }
    f32x4 inc = run;
#pragma unroll
    for (int d = 1; d < 64; d <<= 1) {
        const int sl = ((lane >= d) ? lane - d : lane) << 2; f32x4 o;
#pragma unroll
        for (int e = 0; e < 4; ++e) o[e] = __uint_as_float((unsigned)__builtin_amdgcn_ds_bpermute(sl, (int)__float_as_uint(inc[e])));
        if (lane >= d) inc = inc + o;
    }
    __syncthreads();
    if (lane == 63) { wt[wid * 4 + 0] = inc[0]; wt[wid * 4 + 1] = inc[1]; wt[wid * 4 + 2] = inc[2]; wt[wid * 4 + 3] = inc[3]; }
    __syncthreads();
    f32x4 off = inc - run;
    for (int w2 = 0; w2 < wid; ++w2) { off[0] += wt[w2 * 4 + 0]; off[1] += wt[w2 * 4 + 1]; off[2] += wt[w2 * 4 + 2]; off[3] += wt[w2 * 4 + 3]; }
    float* dst = cs + ((size_t)b * SEQ + (size_t)tid * 8) * 4;
#pragma unroll
    for (int e = 0; e < 8; ++e) *(f32x4*)(dst + e * 4) = (v[e] + off) * LOG2E;
    __syncthreads();
}

template <int HALF> __device__ __forceinline__ void sgu_item(int l, int b, int c, const Args& a, unsigned char* lds) {
    const bf16_t* z = (const bf16_t*)(ws_() + WS_Z); bf16_t* y = (bf16_t*)(ws_() + WS_Y);
    LAS bf16_t* vnT = (LAS bf16_t*)lds;
    LAS float* ssb = (LAS float*)(lds + 69632);
    const int tid = opaque_tid(), lane = tid & 63, wid = tid >> 6, fr = lane & 15, quad = lane >> 4;
    const size_t t0 = (size_t)b * SEQ + (size_t)c * 128;
    const float* ng = INP(3) + l * W;
    __syncthreads();
    float gch[4];
#pragma unroll
    for (int e = 0; e < 4; ++e) gch[e] = ng[lane + 64 * e];
    constexpr int TPW = HALF ? 16 : 8;
#pragma unroll
    for (int half = 0; half < TPW / 8; ++half) {
        float val[8][4];
#pragma unroll
        for (int i = 0; i < 8; ++i) {
            const bf16_t* zr = z + (t0 + wid * TPW + half * 8 + i) * ZW + ZC_AV; float ss = 0.f;
#pragma unroll
            for (int e = 0; e < 4; ++e) { const float gv = gelu_t(bf2f(zr[lane + 64 * e])); val[i][e] = gv; ss += gv * gv; }
            ss = wave_sum(ss); const float rs = rsqrtf(ss * (1.0f / W) + EPS);
#pragma unroll
            for (int e = 0; e < 4; ++e) val[i][e] *= rs * gch[e];
        }
#pragma unroll
        for (int e = 0; e < 4; ++e) { float t8[8];
#pragma unroll
            for (int i = 0; i < 8; ++i) t8[i] = val[i][e];
            *(LAS bf16x8*)(vnT + (lane + 64 * e) * 136 + wid * TPW + half * 8) = pack8(t8); }
    }
    __syncthreads();
    const int h = wid & 3;
    const float* wsrc = INP(4) + ((size_t)(l * 4 + h) * 128) * 128;
    const float* bsrc = INP(5) + (size_t)(l * 4 + h) * 128;
    float outv[2][4][4];
#pragma unroll
    for (int i = 0; i < 2; ++i) {
        const int mt = HALF * 4 + (wid >> 2) + 2 * i, t = mt * 16 + fr;
        f32x4 acc[4];
#pragma unroll
        for (int nt = 0; nt < 4; ++nt) acc[nt] = (f32x4){0.f, 0.f, 0.f, 0.f};
        f32x4 wl[4][2];
#pragma unroll
        for (int kk = 0; kk < 4; ++kk) { const int k0 = (kk * 32 < (mt + 1) * 16) ? kk * 32 : 0; const float* wp = wsrc + (size_t)t * 128 + k0 + quad * 8; wl[kk][0] = *(const f32x4*)wp; wl[kk][1] = *(const f32x4*)(wp + 4); }
#pragma unroll
        for (int kk = 0; kk < 4; ++kk) {
            const int k0 = kk * 32;
            if (k0 < (mt + 1) * 16) {
                float wv[8] = {wl[kk][0][0], wl[kk][0][1], wl[kk][0][2], wl[kk][0][3], wl[kk][1][0], wl[kk][1][1], wl[kk][1][2], wl[kk][1][3]};
#pragma unroll
                for (int e = 0; e < 8; ++e) if (k0 + quad * 8 + e > t) wv[e] = 0.f;
                const bf16x8 wf = pack8(wv);
#pragma unroll
                for (int nt = 0; nt < 4; ++nt) { const bf16x8 vf = *(const LAS bf16x8*)(vnT + (h * 64 + nt * 16 + fr) * 136 + k0 + quad * 8); acc[nt] = mfma16(vf, wf, acc[nt]); }
            }
        }
        const float bs = bsrc[t]; float ss = 0.f;
#pragma unroll
        for (int nt = 0; nt < 4; ++nt) { const int ch = h * 64 + nt * 16 + quad * 4; const bf16x4 u4 = *(const bf16x4*)(z + (t0 + t) * ZW + ZC_AU + ch);
#pragma unroll
            for (int r = 0; r < 4; ++r) { const float o = gelu_t(bfs2f(u4[r])) * (acc[nt][r] + bs); outv[i][nt][r] = o; ss += o * o; } }
        ss = quad_sum(ss);
        if (quad == 0) ssb[t * 4 + h] = ss;
    }
    __syncthreads();
#pragma unroll
    for (int i = 0; i < 2; ++i) {
        const int mt = HALF * 4 + (wid >> 2) + 2 * i, t = mt * 16 + fr;
        const float rs = rsqrtf((ssb[t * 4 + 0] + ssb[t * 4 + 1] + ssb[t * 4 + 2] + ssb[t * 4 + 3]) * (1.0f / W) + EPS);
#pragma unroll
        for (int nt = 0; nt < 4; ++nt) { const int ch = h * 64 + nt * 16 + quad * 4; u32x2 w; w.x = pk2(outv[i][nt][0] * rs, outv[i][nt][1] * rs); w.y = pk2(outv[i][nt][2] * rs, outv[i][nt][3] * rs);
            *(u32x2*)(y + (t0 + t) * DM + YC_A + ch) = w; }
    }
    __syncthreads();
}

template <int PASS> __device__ __forceinline__ void s5_item(int l, int b, int c, const Args& a, unsigned char* lds) {
    const bf16_t* z = (const bf16_t*)(ws_() + WS_Z); bf16_t* y = (bf16_t*)(ws_() + WS_Y);
    LAS unsigned char* BU = (LAS unsigned char*)lds;
    LAS unsigned* BU32 = (LAS unsigned*)lds;
    LAS bf16_t* Yb = (LAS bf16_t*)(lds + 65792);
    LAS float* ssb = (LAS float*)(lds + 65792 + 67584);
    const int tid = opaque_tid(), lane = tid & 63, wid = tid >> 6, fr = lane & 15, quad = lane >> 4;
    const int sx0 = wid * 128 + lane, sx1 = sx0 + 64;
    const size_t t0 = (size_t)b * SEQ + (size_t)c * 128;
    const f32x2* abar = (const f32x2*)(ws_() + WS_ABAR) + l * 1024;
    f32x2* eloc = (f32x2*)(ws_() + WS_ELOC);
    float ar[2], ai[2], sre[2], sim[2];
#pragma unroll
    for (int q = 0; q < 2; ++q) { const f32x2 ab = abar[q ? sx1 : sx0]; ar[q] = ab[0]; ai[q] = ab[1]; sre[q] = 0.f; sim[q] = 0.f; }
    if (PASS == 2) {
        const f32x2* a128 = (const f32x2*)(ws_() + WS_A128) + l * 1024;
        const f32x2 p0 = a128[sx0], p1 = a128[sx1];
        for (int cc0 = 0; cc0 < c; cc0 += 8) {
            f32x2 e0[8], e1[8];
#pragma unroll
            for (int u = 0; u < 8; ++u) { const int cc = (cc0 + u < c) ? cc0 + u : c - 1; e0[u] = eloc[((size_t)(b * NCH + cc)) * 1024 + sx0]; e1[u] = eloc[((size_t)(b * NCH + cc)) * 1024 + sx1]; }
#pragma unroll
            for (int u = 0; u < 8; ++u) if (cc0 + u < c) {
                const float nr0 = p0[0] * sre[0] - p0[1] * sim[0] + e0[u][0], ni0 = p0[0] * sim[0] + p0[1] * sre[0] + e0[u][1]; sre[0] = nr0; sim[0] = ni0;
                const float nr1 = p1[0] * sre[1] - p1[1] * sim[1] + e1[u][0], ni1 = p1[0] * sim[1] + p1[1] * sre[1] + e1[u][1]; sre[1] = nr1; sim[1] = ni1; }
        }
    }
    bf16x8 bfrag[2][8];
    const bf16_t* bbt = (const bf16_t*)(ws_() + WS_BBT);
#pragma unroll
    for (int gi = 0; gi < 2; ++gi)
#pragma unroll
        for (int j = 0; j < 8; ++j) bfrag[gi][j] = (quad < 2) ? *(const bf16x8*)(bbt + ((size_t)(l * 16 + wid * 2 + gi) * 128 + j * 16 + fr) * 16 + quad * 8) : zero8();
    bf16x8 cfrag[2][4];
    if (PASS == 2) {
        const bf16_t* cmt = (const bf16_t*)(ws_() + WS_CMT);
#pragma unroll
        for (int gi = 0; gi < 2; ++gi)
#pragma unroll
            for (int ks = 0; ks < 4; ++ks) cfrag[gi][ks] = *(const bf16x8*)(cmt + ((size_t)(l * 16 + wid * 2 + gi) * 16 + fr) * 128 + ks * 32 + quad * 8);
    }
    const float* dsk = INP(13) + l * W;
    __syncthreads();
    bf16x8 ufn[2];
#pragma unroll
    for (int gi = 0; gi < 2; ++gi) ufn[gi] = (quad < 2) ? *(const bf16x8*)(z + (t0 + fr) * ZW + ZC_B + (wid * 2 + gi) * 16 + quad * 8) : zero8();
    for (int sc = 0; sc < 8; ++sc) {
        const size_t tr = t0 + sc * 16 + fr;
        bf16x8 ufc[2] = {ufn[0], ufn[1]};
        bf16x4 u4c[2] = {(bf16x4){0, 0, 0, 0}, (bf16x4){0, 0, 0, 0}};
        if (PASS == 2) {
#pragma unroll
            for (int gi = 0; gi < 2; ++gi) u4c[gi] = *(const bf16x4*)(z + tr * ZW + ZC_B + (wid * 2 + gi) * 16 + quad * 4);
        }
        if (sc < 7) {
#pragma unroll
            for (int gi = 0; gi < 2; ++gi) ufn[gi] = (quad < 2) ? *(const bf16x8*)(z + (tr + 16) * ZW + ZC_B + (wid * 2 + gi) * 16 + quad * 8) : zero8();
        }
#pragma unroll
        for (int gi = 0; gi < 2; ++gi) {
            const int g = wid * 2 + gi;
            const bf16x8 uf = ufc[gi];
#pragma unroll
            for (int j = 0; j < 8; ++j) {
                const f32x4 acc = mfma16(bfrag[gi][j], uf, (f32x4){0.f, 0.f, 0.f, 0.f});
                u32x2 w; w.x = pk2(acc[0], acc[1]); w.y = pk2(acc[2], acc[3]);
                *(LAS u32x2*)(BU + fr * 4112 + (g * 64 + j * 8 + quad * 2) * 4) = w;
            }
        }
        asm volatile("s_waitcnt lgkmcnt(0)" ::: "memory");
        {
            unsigned wv[16][2];
#pragma unroll
            for (int tt = 0; tt < 16; ++tt) { wv[tt][0] = BU32[tt * 1028 + sx0]; wv[tt][1] = BU32[tt * 1028 + sx1]; }
#pragma unroll
            for (int tt = 0; tt < 16; ++tt) {
#pragma unroll
                for (int q = 0; q < 2; ++q) {
                    const unsigned w = wv[tt][q];
                    const f32x2 bu2 = {__uint_as_float(w << 16), __uint_as_float(w & 0xffff0000u)};
                    const f32x2 s2 = {sre[q], sim[q]}, sw = {sim[q], sre[q]}, arr = {ar[q], ar[q]}, aii = {-ai[q], ai[q]};
                    const f32x2 n2 = aii * sw + (arr * s2 + bu2);
                    sre[q] = n2[0]; sim[q] = n2[1];
                    if (PASS == 2) wv[tt][q] = pk2(n2[0], n2[1]);
                }
            }
            if (PASS == 2) {
#pragma unroll
                for (int tt = 0; tt < 16; ++tt) { BU32[tt * 1028 + sx0] = wv[tt][0]; BU32[tt * 1028 + sx1] = wv[tt][1]; }
            }
        }
        asm volatile("s_waitcnt lgkmcnt(0)" ::: "memory");
        if (PASS == 2) {
#pragma unroll
            for (int gi = 0; gi < 2; ++gi) {
                const int g = wid * 2 + gi; f32x4 acc = (f32x4){0.f, 0.f, 0.f, 0.f};
#pragma unroll
                for (int ks = 0; ks < 4; ++ks) { const bf16x8 sf = *(const LAS bf16x8*)(BU + fr * 4112 + g * 256 + (ks * 32 + quad * 8) * 2); acc = mfma16(cfrag[gi][ks], sf, acc); }
                const int ch = g * 16 + quad * 4; const bf16x4 u4 = u4c[gi]; const f32x4 d4 = *(const f32x4*)(dsk + ch);
                float o[4];
#pragma unroll
                for (int r = 0; r < 4; ++r) o[r] = gelu_t(acc[r] + d4[r] * bfs2f(u4[r]));
                u32x2 w; w.x = pk2(o[0], o[1]); w.y = pk2(o[2], o[3]);
                *(LAS u32x2*)(Yb + (sc * 16 + fr) * 264 + ch) = w;
            }
        }
    }
    if (PASS == 1) {
#pragma unroll
        for (int q = 0; q < 2; ++q) eloc[((size_t)(b * NCH + c)) * 1024 + (q ? sx1 : sx0)] = (f32x2){sre[q], sim[q]};
    } else {
        __syncthreads();
        const bf16_t* glut = (const bf16_t*)(ws_() + WS_GLUT) + (size_t)l * W * W;
        const float* glub = INP(15) + l * W;
        bf16x8 gfrag[2][8];
#pragma unroll
        for (int ni = 0; ni < 2; ++ni)
#pragma unroll
            for (int ks = 0; ks < 8; ++ks) gfrag[ni][ks] = *(const bf16x8*)(glut + (size_t)((wid * 2 + ni) * 16 + fr) * W + ks * 32 + quad * 8);
        float outv[8][2][4];
#pragma unroll
        for (int mt = 0; mt < 8; ++mt) {
            f32x4 acc0 = (f32x4){0.f, 0.f, 0.f, 0.f}, acc1 = acc0;
#pragma unroll
            for (int ks = 0; ks < 8; ++ks) { const bf16x8 yf = *(const LAS bf16x8*)(Yb + (mt * 16 + fr) * 264 + ks * 32 + quad * 8); acc0 = mfma16(gfrag[0][ks], yf, acc0); acc1 = mfma16(gfrag[1][ks], yf, acc1); }
            float ss = 0.f;
#pragma unroll
            for (int ni = 0; ni < 2; ++ni) { const int n = (wid * 2 + ni) * 16 + quad * 4; const bf16x4 y4 = *(const LAS bf16x4*)(Yb + (mt * 16 + fr) * 264 + n); const f32x4 gb = *(const f32x4*)(glub + n);
#pragma unroll
                for (int r = 0; r < 4; ++r) { const float gt = (ni == 0 ? acc0[r] : acc1[r]) + gb[r]; const float o = bfs2f(y4[r]) * sigm(gt); outv[mt][ni][r] = o; ss += o * o; } }
            ss = quad_sum(ss);
            if (quad == 0) ssb[(mt * 16 + fr) * 8 + wid] = ss;
        }
        __syncthreads();
#pragma unroll
        for (int mt = 0; mt < 8; ++mt) {
            const int t = mt * 16 + fr; float s = 0.f;
#pragma unroll
            for (int w2 = 0; w2 < 8; ++w2) s += ssb[t * 8 + w2];
            const float rs = rsqrtf(s * (1.0f / W) + EPS);
#pragma unroll
            for (int ni = 0; ni < 2; ++ni) { const int n = (wid * 2 + ni) * 16 + quad * 4; u32x2 w; w.x = pk2(outv[mt][ni][0] * rs, outv[mt][ni][1] * rs); w.y = pk2(outv[mt][ni][2] * rs, outv[mt][ni][3] * rs);
                *(u32x2*)(y + (t0 + t) * DM + YC_B + n) = w; }
        }
    }
    __syncthreads();
}

template <int PASS> __device__ __forceinline__ void lru_item(int l, int b, int c, const Args& a, unsigned char* lds) {
    const bf16_t* z = (const bf16_t*)(ws_() + WS_Z); bf16_t* y = (bf16_t*)(ws_() + WS_Y);
    LAS bf16_t* XC = (LAS bf16_t*)lds;
    LAS float* ssb = (LAS float*)(lds + 67584);
    const int tid = opaque_tid(), lane = tid & 63, wid = tid >> 6, fr = lane & 15, quad = lane >> 4;
    const size_t t0 = (size_t)b * SEQ + (size_t)c * 128;
    float* LAp = (float*)(ws_() + WS_LA); float* LBp = (float*)(ws_() + WS_LB);
    __syncthreads();
    {
        const float* cw = INP(16) + (size_t)l * 4 * W; const float* cb = INP(17) + l * W;
#pragma unroll 4
        for (int it = 0; it < 8; ++it) {
            const int p = tid + 512 * it, tok = p >> 5, ch0 = (p & 31) * 8; float acc[8];
            { const f32x4 c0 = *(const f32x4*)(cb + ch0), c1 = *(const f32x4*)(cb + ch0 + 4); acc[0] = c0[0]; acc[1] = c0[1]; acc[2] = c0[2]; acc[3] = c0[3]; acc[4] = c1[0]; acc[5] = c1[1]; acc[6] = c1[2]; acc[7] = c1[3]; }
#pragma unroll
            for (int k = 0; k < 4; ++k) {
                const int tt = tok - 3 + k;
                if (c * 128 + tt >= 0) {
                    const bf16x8 xv = *(const bf16x8*)(z + (size_t)((long)t0 + tt) * ZW + ZC_CX + ch0);
                    const f32x4 w0 = *(const f32x4*)(cw + k * W + ch0), w1 = *(const f32x4*)(cw + k * W + ch0 + 4);
                    acc[0] += w0[0] * bfs2f(xv[0]); acc[1] += w0[1] * bfs2f(xv[1]); acc[2] += w0[2] * bfs2f(xv[2]); acc[3] += w0[3] * bfs2f(xv[3]);
                    acc[4] += w1[0] * bfs2f(xv[4]); acc[5] += w1[1] * bfs2f(xv[5]); acc[6] += w1[2] * bfs2f(xv[6]); acc[7] += w1[3] * bfs2f(xv[7]);
                }
            }
            *(LAS bf16x8*)(XC + tok * 264 + ch0) = pack8(acc);
        }
    }
    __syncthreads();
    const int hh = wid >> 1;
    const bf16_t* wat = (const bf16_t*)(ws_() + WS_WAT) + (size_t)(l * 4 + hh) * 64 * 64;
    const bf16_t* wxt = (const bf16_t*)(ws_() + WS_WXT) + (size_t)(l * 4 + hh) * 64 * 64;
    bf16x8 waf[2][2], wxf[2][2]; float sp8[2][4], bav[2][4], bxv[2][4], H[2][4], Acar[2][4], Bcar[2][4];
#pragma unroll
    for (int ni = 0; ni < 2; ++ni) {
        const int nl = (wid * 2 + ni) * 16 - hh * 64 + fr;
#pragma unroll
        for (int ks = 0; ks < 2; ++ks) { waf[ni][ks] = *(const bf16x8*)(wat + nl * 64 + ks * 32 + quad * 8); wxf[ni][ks] = *(const bf16x8*)(wxt + nl * 64 + ks * 32 + quad * 8); }
#pragma unroll
        for (int r = 0; r < 4; ++r) { const int ch = (wid * 2 + ni) * 16 + quad * 4 + r;
            sp8[ni][r] = 8.0f * softplus_f(-INP(22)[l * W + ch]); bav[ni][r] = INP(19)[l * W + ch]; bxv[ni][r] = INP(21)[l * W + ch];
            H[ni][r] = 0.f; Acar[ni][r] = 1.f; Bcar[ni][r] = 0.f;
        }
    }
    if (PASS == 2 && c > 0) {
#pragma unroll
        for (int ni = 0; ni < 2; ++ni) {
            const size_t ob = (size_t)(b * NCH) * W + (wid * 2 + ni) * 16 + quad * 4;
            const bool v0 = fr < c, v1 = 16 + fr < c;
            f32x4 a0 = (f32x4){1.f, 1.f, 1.f, 1.f}, b0 = (f32x4){0.f, 0.f, 0.f, 0.f}, a1 = a0, b1 = b0;
            if (v0) { a0 = *(const f32x4*)(LAp + ob + (size_t)fr * W); b0 = *(const f32x4*)(LBp + ob + (size_t)fr * W); }
            if (v1) { a1 = *(const f32x4*)(LAp + ob + (size_t)(16 + fr) * W); b1 = *(const f32x4*)(LBp + ob + (size_t)(16 + fr) * W); }
#pragma unroll
            for (int r = 0; r < 4; ++r) {
                float av = a0[r], bb = b0[r], aw = a1[r], bw = b1[r], ap, bp;
                ap = dpp_shr<1>(av, 1.0f); bp = dpp_shr<1>(bb, 0.0f); bb = av * bp + bb; av = av * ap;   ap = dpp_shr<1>(aw, 1.0f); bp = dpp_shr<1>(bw, 0.0f); bw = aw * bp + bw; aw = aw * ap;
                ap = dpp_shr<2>(av, 1.0f); bp = dpp_shr<2>(bb, 0.0f); bb = av * bp + bb; av = av * ap;   ap = dpp_shr<2>(aw, 1.0f); bp = dpp_shr<2>(bw, 0.0f); bw = aw * bp + bw; aw = aw * ap;
                ap = dpp_shr<4>(av, 1.0f); bp = dpp_shr<4>(bb, 0.0f); bb = av * bp + bb; av = av * ap;   ap = dpp_shr<4>(aw, 1.0f); bp = dpp_shr<4>(bw, 0.0f); bw = aw * bp + bw; aw = aw * ap;
                ap = dpp_shr<8>(av, 1.0f); bp = dpp_shr<8>(bb, 0.0f); bb = av * bp + bb; av = av * ap;   ap = dpp_shr<8>(aw, 1.0f); bp = dpp_shr<8>(bw, 0.0f); bw = aw * bp + bw; aw = aw * ap;
                const float B0t = __shfl(bb, 15, 16), A1t = __shfl(aw, 15, 16), B1t = __shfl(bw, 15, 16);
                H[ni][r] = A1t * B0t + B1t;
            }
        }
    }
    LAS bf16_t* Ob = (LAS bf16_t*)(lds + 67584 + 4096);
#pragma unroll 2
    for (int mt = 0; mt < 8; ++mt) {
        bf16x8 xf[2];
#pragma unroll
        for (int ks = 0; ks < 2; ++ks) xf[ks] = *(const LAS bf16x8*)(XC + (mt * 16 + fr) * 264 + hh * 64 + ks * 32 + quad * 8);
        float ss = 0.f;
#pragma unroll
        for (int ni = 0; ni < 2; ++ni) {
            f32x4 accA = (f32x4){0.f, 0.f, 0.f, 0.f}, accX = accA;
#pragma unroll
            for (int ks = 0; ks < 2; ++ks) { accA = mfma16(waf[ni][ks], xf[ks], accA); accX = mfma16(wxf[ni][ks], xf[ks], accX); }
            const int ch0 = (wid * 2 + ni) * 16 + quad * 4;
            const bf16x4 xc4 = *(const LAS bf16x4*)(XC + (mt * 16 + fr) * 264 + ch0);
            bf16x4 g4 = (bf16x4){0, 0, 0, 0};
            if (PASS == 2) g4 = *(const bf16x4*)(z + (t0 + mt * 16 + fr) * ZW + ZC_CG + ch0);
            float ov[4] = {0.f, 0.f, 0.f, 0.f};
#pragma unroll
            for (int r = 0; r < 4; ++r) {
                const float rg = sigm(accA[r] + bav[ni][r]), ig = sigm(accX[r] + bxv[ni][r]);
                const float la = -rg * sp8[ni][r];
                float av = __builtin_amdgcn_exp2f(LOG2E * la), bb = __builtin_amdgcn_sqrtf(fmaxf(neg_expm1(2.0f * la), 0.f)) * (ig * bfs2f(xc4[r]));
                { float ap, bp;
                  ap = dpp_shr<1>(av, 1.0f); bp = dpp_shr<1>(bb, 0.0f); bb = av * bp + bb; av = av * ap;
                  ap = dpp_shr<2>(av, 1.0f); bp = dpp_shr<2>(bb, 0.0f); bb = av * bp + bb; av = av * ap;
                  ap = dpp_shr<4>(av, 1.0f); bp = dpp_shr<4>(bb, 0.0f); bb = av * bp + bb; av = av * ap;
                  ap = dpp_shr<8>(av, 1.0f); bp = dpp_shr<8>(bb, 0.0f); bb = av * bp + bb; av = av * ap; }
                if (PASS == 1) { const float At = __shfl(av, 15, 16), Bt = __shfl(bb, 15, 16); Bcar[ni][r] = At * Bcar[ni][r] + Bt; Acar[ni][r] *= At; }
                else { const float hv = av * H[ni][r] + bb; H[ni][r] = __shfl(hv, 15, 16); const float o = hv * gelu_t(bfs2f(g4[r])); ov[r] = o; ss += o * o; }
            }
            if (PASS == 2) { u32x2 w; w.x = pk2(ov[0], ov[1]); w.y = pk2(ov[2], ov[3]); *(LAS u32x2*)(Ob + (mt * 16 + fr) * 264 + ch0) = w; }
        }
        if (PASS == 2) { ss = quad_sum(ss); if (quad == 0) ssb[(mt * 16 + fr) * 8 + wid] = ss; }
    }
    if (PASS == 1) {
        if (fr == 0) {
#pragma unroll
            for (int ni = 0; ni < 2; ++ni)
#pragma unroll
                for (int r = 0; r < 4; ++r) { const size_t o = ((size_t)(b * NCH + c)) * W + (wid * 2 + ni) * 16 + quad * 4 + r; LAp[o] = Acar[ni][r]; LBp[o] = Bcar[ni][r]; }
        }
        {
            const int tok = tid >> 2, hd = tid & 3; float s2 = 0.f;
#pragma unroll
            for (int j = 0; j < 8; ++j) { const bf16x8 kv = *(const bf16x8*)(z + (t0 + tok) * ZW + ZC_K + hd * 64 + j * 8);
#pragma unroll
                for (int e = 0; e < 8; ++e) { const float f = bfs2f(kv[e]); s2 += f * f; } }
            ssb[tok * 4 + hd] = s2;
            __syncthreads();
            if (tid < 4) { float mxv = 0.f; for (int i = 0; i < 128; ++i) mxv = fmaxf(mxv, ssb[i * 4 + tid]); ((float*)(ws_() + WS_KMAX))[(b * NCH + c) * 4 + tid] = mxv; }
        }
    } else {
        __syncthreads();
#pragma unroll 2
        for (int mt = 0; mt < 8; ++mt) {
            const int t = mt * 16 + fr; float s = 0.f;
#pragma unroll
            for (int w2 = 0; w2 < 8; ++w2) s += ssb[t * 8 + w2];
            const float rs = rsqrtf(s * (1.0f / W) + EPS);
#pragma unroll
            for (int ni = 0; ni < 2; ++ni) { const int n = (wid * 2 + ni) * 16 + quad * 4; const bf16x4 o4 = *(const LAS bf16x4*)(Ob + t * 264 + n);
                u32x2 w; w.x = pk2(bfs2f(o4[0]) * rs, bfs2f(o4[1]) * rs); w.y = pk2(bfs2f(o4[2]) * rs, bfs2f(o4[3]) * rs);
                *(u32x2*)(y + (t0 + t) * DM + YC_C + n) = w; }
        }
    }
    __syncthreads();
}

template <bool DIAG> __device__ __forceinline__ void attn_step2(const LAS unsigned char* buf, int kbase, int qrow0, int quad, int fr, const bf16x8 (&qf)[2][2], float (&m)[2], float (&lsum)[2], f32x4 (&oacc)[2][4]) {
    const LAS bf16_t* Kt = (const LAS bf16_t*)buf; const LAS bf16_t* Vt = (const LAS bf16_t*)(buf + 9216); const LAS float* csl = (const LAS float*)(buf + 18432);
    float p[2][4][4];
#pragma unroll
    for (int st = 0; st < 4; ++st) {
        const f32x4 c4 = *(const LAS f32x4*)(csl + st * 16 + quad * 4);
        const bf16x8 kf0 = *(const LAS bf16x8*)(Kt + (st * 16 + fr) * 72 + quad * 8), kf1 = *(const LAS bf16x8*)(Kt + (st * 16 + fr) * 72 + 32 + quad * 8);
#pragma unroll
        for (int qs = 0; qs < 2; ++qs) {
            f32x4 acc = mfma16(kf0, qf[qs][0], c4); acc = mfma16(kf1, qf[qs][1], acc);
#pragma unroll
            for (int r = 0; r < 4; ++r) { float v = acc[r]; if (DIAG && (kbase + st * 16 + quad * 4 + r > qrow0 + qs * 16)) v = -1e30f; p[qs][st][r] = v; }
        }
    }
    bf16x8 pf[2][2]; float alpha[2];
#pragma unroll
    for (int qs = 0; qs < 2; ++qs) {
        float mx = -1e30f;
#pragma unroll
        for (int st = 0; st < 4; ++st)
#pragma unroll
            for (int r = 0; r < 4; ++r) mx = fmaxf(mx, p[qs][st][r]);
        mx = quad_max(mx);
        const float mnew = fmaxf(m[qs], mx); alpha[qs] = __builtin_amdgcn_exp2f(m[qs] - mnew); m[qs] = mnew;
        float ps = 0.f;
#pragma unroll
        for (int st = 0; st < 4; ++st)
#pragma unroll
            for (int r = 0; r < 4; ++r) { const float e = __builtin_amdgcn_exp2f(p[qs][st][r] - mnew); p[qs][st][r] = e; ps += e; }
        lsum[qs] = lsum[qs] * alpha[qs] + ps;
#pragma unroll
        for (int ks = 0; ks < 2; ++ks) { u32x4 w; w.x = pk2(p[qs][2 * ks][0], p[qs][2 * ks][1]); w.y = pk2(p[qs][2 * ks][2], p[qs][2 * ks][3]); w.z = pk2(p[qs][2 * ks + 1][0], p[qs][2 * ks + 1][1]); w.w = pk2(p[qs][2 * ks + 1][2], p[qs][2 * ks + 1][3]); pf[qs][ks] = __builtin_bit_cast(bf16x8, w); }
    }
#pragma unroll
    for (int dt = 0; dt < 4; ++dt) {
        oacc[0][dt] = oacc[0][dt] * alpha[0]; oacc[1][dt] = oacc[1][dt] * alpha[1];
#pragma unroll
        for (int ks = 0; ks < 2; ++ks) {
            const bf16x4 v0 = *(const LAS bf16x4*)(Vt + (dt * 16 + fr) * 72 + ks * 32 + quad * 4), v1 = *(const LAS bf16x4*)(Vt + (dt * 16 + fr) * 72 + ks * 32 + 16 + quad * 4);
            const bf16x8 vf = (bf16x8){v0[0], v0[1], v0[2], v0[3], v1[0], v1[1], v1[2], v1[3]};
            oacc[0][dt] = mfma16(vf, pf[0][ks], oacc[0][dt]); oacc[1][dt] = mfma16(vf, pf[1][ks], oacc[1][dt]);
        }
    }
}
__device__ __forceinline__ void attn_unit(int b, int h, int qb, const Args& a, unsigned char* lds) {
    const bf16_t* z = (const bf16_t*)(ws_() + WS_Z); bf16_t* y = (bf16_t*)(ws_() + WS_Y);
    const float* cs = (const float*)(ws_() + WS_CS); float* ssd = (float*)(ws_() + WS_SSD);
    constexpr int ABUF = 9216 + 9216 + 256;
    LAS unsigned char* lb = (LAS unsigned char*)lds;
    const int tid = opaque_tid(), lane = tid & 63, wid = tid >> 6, fr = lane & 15, quad = lane >> 4, grp = wid >> 2, wq = wid & 3;
    const int q0 = qb * 128, qw = q0 + wq * 32, qrow0 = qw + fr;
    const size_t rb = (size_t)b * SEQ;
    bf16x8 qf[2][2];
    {
        const float SC = 0.125f * LOG2E;
#pragma unroll
        for (int qs = 0; qs < 2; ++qs)
#pragma unroll
            for (int ds = 0; ds < 2; ++ds) { const bf16x8 qv = *(const bf16x8*)(z + (rb + qrow0 + qs * 16) * ZW + ZC_Q + h * 64 + ds * 32 + quad * 8); float t8[8];
#pragma unroll
                for (int e = 0; e < 8; ++e) t8[e] = bfs2f(qv[e]) * SC;
                qf[qs][ds] = pack8(t8); }
    }
    float m[2] = {-1e30f, -1e30f}, lsum[2] = {0.f, 0.f}; f32x4 oacc[2][4];
#pragma unroll
    for (int qs = 0; qs < 2; ++qs)
#pragma unroll
        for (int dt = 0; dt < 4; ++dt) oacc[qs][dt] = (f32x4){0.f, 0.f, 0.f, 0.f};
    float qbnd[2];
    {
        float kv = (lane <= qb) ? ((const float*)(ws_() + WS_KMAX))[(b * NCH + lane) * 4 + h] : 0.f;
        kv = wave_max(kv);
        const float kmax = __builtin_amdgcn_sqrtf(kv) * 1.01f + 1e-3f;
#pragma unroll
        for (int qs = 0; qs < 2; ++qs) { float q2 = 0.f;
#pragma unroll
            for (int ds = 0; ds < 2; ++ds)
#pragma unroll
                for (int e = 0; e < 8; ++e) { const float f = bfs2f(qf[qs][ds][e]); q2 += f * f; }
            q2 = quad_sum(q2); qbnd[qs] = (__builtin_amdgcn_sqrtf(q2) * 1.01f + 1e-3f) * kmax; }
    }
    const int NSS = qb + 1;
    volatile LAS unsigned* vote = (volatile LAS unsigned*)(lds + LDS_BYTES - 64);
    if (tid < 3) vote[tid] = 0u;
    bf16x8 kreg[2], vreg[2]; float creg = 0.f;
#define ATT_LOAD(S) do { const size_t kb_ = rb + (size_t)(S) * 128; \
        _Pragma("unroll") for (int p_ = 0; p_ < 2; ++p_) { const int id_ = tid + 512 * p_; \
            kreg[p_] = *(const bf16x8*)(z + (kb_ + (id_ >> 3)) * ZW + ZC_K + h * 64 + (id_ & 7) * 8); \
            vreg[p_] = *(const bf16x8*)(z + (kb_ + 2 * (tid & 63) + p_) * ZW + ZC_V + h * 64 + (tid >> 6) * 8); } \
        if (tid < 128) creg = cs[(kb_ + tid) * 4 + h]; } while (0)
#define ATT_STORE(S) do { LAS unsigned char* bb_ = lb + ((S) & 1) * (2 * ABUF); \
        _Pragma("unroll") for (int p_ = 0; p_ < 2; ++p_) { const int id_ = tid + 512 * p_; const int k128_ = id_ >> 3; \
            *(LAS bf16x8*)((LAS bf16_t*)(bb_ + (k128_ >> 6) * ABUF) + (k128_ & 63) * 72 + (id_ & 7) * 8) = kreg[p_]; } \
        { LAS unsigned* vt_ = (LAS unsigned*)(bb_ + ((tid & 63) >> 5) * ABUF + 9216);     \
            _Pragma("unroll") for (int e_ = 0; e_ < 8; ++e_) vt_[(((tid >> 6) * 8 + e_) * 72 + ((2 * (tid & 63)) & 63)) >> 1] = (unsigned)(unsigned short)vreg[0][e_] | ((unsigned)(unsigned short)vreg[1][e_] << 16); } \
        if (tid < 128) ((LAS float*)(bb_ + (tid >> 6) * ABUF + 18432))[tid & 63] = -creg; } while (0)
    ATT_LOAD(NSS - 1); ATT_STORE(NSS - 1);
    if (NSS > 1) ATT_LOAD(NSS - 2);
    __syncthreads();
    int kstep = 0;
    for (int S = NSS - 1; S >= 0; --S) {
        if (S >= 1) ATT_STORE(S - 1);
        if (S >= 2) ATT_LOAD(S - 2);
        float cl = 0.f; if (S >= 1) cl = cs[(rb + (size_t)(S - 1) * 128 + 127) * 4 + h];
        const int kbase = S * 128 + grp * 64;
        const LAS unsigned char* hb = lb + (S & 1) * (2 * ABUF) + grp * ABUF;
        if (S + 1 < NSS) attn_step2<false>(hb, kbase, qrow0, quad, fr, qf, m, lsum, oacc);
        else if (kbase <= qw + 31) attn_step2<true>(hb, kbase, qrow0, quad, fr, qf, m, lsum, oacc);
        const bool need = (S >= 1) && ((qbnd[0] - cl - m[0] >= -160.f) || (qbnd[1] - cl - m[1] >= -160.f));
        const int vw = kstep % 3;
        if (need) vote[vw] = 1u;
        __syncthreads();
        const unsigned go = vote[vw];
        if (tid == 0) vote[(kstep + 2) % 3] = 0u;
        ++kstep;
        if (!go) break;
    }
#undef ATT_LOAD
#undef ATT_STORE
    LAS float* mg = (LAS float*)lb;
    const int ml = wq * 64 + lane;
    if (grp == 1) {
#pragma unroll
        for (int qs = 0; qs < 2; ++qs) { mg[(qs * 18 + 0) * 256 + ml] = m[qs]; mg[(qs * 18 + 1) * 256 + ml] = lsum[qs];
#pragma unroll
            for (int dt = 0; dt < 4; ++dt)
#pragma unroll
                for (int r = 0; r < 4; ++r) mg[(qs * 18 + 2 + dt * 4 + r) * 256 + ml] = oacc[qs][dt][r]; }
    }
    __syncthreads();
    if (grp == 0) {
#pragma unroll
        for (int qs = 0; qs < 2; ++qs) {
            const float m1 = mg[(qs * 18 + 0) * 256 + ml], l1 = mg[(qs * 18 + 1) * 256 + ml];
            const float mt = fmaxf(m[qs], m1), f0 = __builtin_amdgcn_exp2f(m[qs] - mt), f1 = __builtin_amdgcn_exp2f(m1 - mt);
            float lt = quad_sum(lsum[qs] * f0 + l1 * f1);
            const float inv = 1.0f / lt; float ss = 0.f;
            const size_t tq = rb + qrow0 + qs * 16;
#pragma unroll
            for (int dt = 0; dt < 4; ++dt) { f32x4 o;
#pragma unroll
                for (int r = 0; r < 4; ++r) { o[r] = (oacc[qs][dt][r] * f0 + mg[(qs * 18 + 2 + dt * 4 + r) * 256 + ml] * f1) * inv; ss += o[r] * o[r]; }
                u32x2 w; w.x = pk2(o[0], o[1]); w.y = pk2(o[2], o[3]); *(u32x2*)(y + tq * DM + YC_D + h * 64 + dt * 16 + quad * 4) = w; }
            ss = quad_sum(ss);
            if (quad == 0) ssd[tq * 4 + h] = ss;
        }
    }
    __syncthreads();
}

#define XB_TMO      128
#define XB_XCNT(j)  (256  + 64 * (j))
#define XB_XSUB(j)  (1280 + 64 * (j))
#define XB_XGEN(j)  (2304 + 64 * (j))
#define XB_TOP      3328
#define XB_TOPGEN   3392
#define XCD_BAR_WORDS 3456
#define XB_SPIN_CAP (1u << 18)

__device__ __forceinline__ unsigned xb_ld(unsigned* p)              { return __hip_atomic_load(p, __ATOMIC_RELAXED, __HIP_MEMORY_SCOPE_AGENT); }
__device__ __forceinline__ unsigned xb_add(unsigned* p, unsigned v) { return __hip_atomic_fetch_add(p, v, __ATOMIC_RELAXED, __HIP_MEMORY_SCOPE_AGENT); }
__device__ __forceinline__ unsigned xb_xcc_id() { return (unsigned)__builtin_amdgcn_s_getreg((3 << 11) | 20) & 0xFu; }
#define XB_SPIN(cond, bar) do { unsigned _sp = 0; while (cond) { __builtin_amdgcn_s_sleep(1); \
    if ((++_sp & 255u) == 0u) { if (xb_ld(&(bar)[XB_TMO])) break; if (_sp > XB_SPIN_CAP) { atomicAdd(&(bar)[XB_TMO], 1u); break; } } } } while (0)

struct XcdBarrier {
    unsigned* bar; unsigned x;
    volatile LAS unsigned* st;
};

__device__ __forceinline__ XcdBarrier xcd_barrier_post(unsigned* bar, volatile LAS unsigned* st) {
    XcdBarrier b; b.bar = bar; b.x = xb_xcc_id(); b.st = st;
    if (opaque_tid() == 0) (void)xb_add(&bar[XB_XCNT(b.x)], 1u);
    return b;
}
__device__ __forceinline__ void xcd_barrier_complete(unsigned* bar, unsigned x, unsigned& nloc, unsigned& nx) {
    const unsigned G = gridDim.x * gridDim.y * gridDim.z;
    unsigned sum, cnt, mine, sp = 0u;
    for (;;) {
        sum = 0u; cnt = 0u; mine = 0u;
#pragma unroll
        for (unsigned j = 0; j < 16; ++j) { const unsigned c = xb_ld(&bar[XB_XCNT(j)]); sum += c; cnt += (c > 0u) ? 1u : 0u; mine = (j == x) ? c : mine; }
        if (sum == G) break;
        __builtin_amdgcn_s_sleep(1);
        if ((++sp & 255u) == 0u) { if (xb_ld(&bar[XB_TMO])) break; if (sp > XB_SPIN_CAP) { atomicAdd(&bar[XB_TMO], 1u); break; } }
    }
    nloc = mine > 0u ? mine : 1u; nx = cnt > 0u ? cnt : 1u;
}

__device__ __forceinline__ void xcd_barrier(const XcdBarrier& b) {
    asm volatile("s_waitcnt vmcnt(0)" ::: "memory");
    __syncthreads();
    if (opaque_tid() == 0) {
        unsigned* bar = b.bar;
        __builtin_amdgcn_s_waitcnt(0);
        unsigned nloc = b.st[0], nx = b.st[1];
        if (nloc == 0u) { xcd_barrier_complete(bar, b.x, nloc, nx); b.st[0] = nloc; b.st[1] = nx; }
        const unsigned old = xb_add(&bar[XB_XSUB(b.x)], 1u);
        const unsigned gen = old / nloc;
        if (old + 1u == (gen + 1u) * nloc) {
            __builtin_amdgcn_fence(__ATOMIC_RELEASE, "agent");
            asm volatile("s_waitcnt vmcnt(0)" ::: "memory");
            const unsigned og = xb_add(&bar[XB_TOP], 1u);
            const unsigned tg = og / nx;
            if (og + 1u == (tg + 1u) * nx) xb_add(&bar[XB_TOPGEN], 1u);
            else XB_SPIN(xb_ld(&bar[XB_TOPGEN]) == tg, bar);
            __builtin_amdgcn_fence(__ATOMIC_ACQUIRE, "agent");
            xb_add(&bar[XB_XGEN(b.x)], 1u);
            asm volatile("s_waitcnt vmcnt(0)" ::: "memory");
        } else {
            XB_SPIN(xb_ld(&bar[XB_XGEN(b.x)]) == gen, bar);
            __builtin_amdgcn_fence(__ATOMIC_ACQUIRE, "agent");
            asm volatile("s_waitcnt vmcnt(0)" ::: "memory");
        }
    }
    __syncthreads();
}

#ifndef WGM_G1
#define WGM_G1 2
#endif
#ifndef WGM_G2
#define WGM_G2 4
#endif
#ifndef WGM_G3
#define WGM_G3 4
#endif
#ifndef WGM_G4
#define WGM_G4 8
#endif
#ifndef PROBE_DUP
#define PROBE_DUP 0
#endif
#ifndef ITEM_MASK
#define ITEM_MASK 127
#endif
__global__ void __launch_bounds__(NTHR, 2) fwd_kernel(Args a) {
    extern __shared__ __attribute__((aligned(16))) unsigned char lds[];
    {
        volatile LAS unsigned* bst0 = (volatile LAS unsigned*)(lds + LDS_BYTES - 16);
        if (opaque_tid() == 0) { bst0[0] = 0u; bst0[1] = 0u; }
        __syncthreads();
        (void)xcd_barrier_post((unsigned*)(ws_() + WS_BAR), bst0);
    }
    if (PH_HI > 4096) cg::this_grid().sync();
#define SEAM(k) do { if ((k) + 1 < PH_HI) { XcdBarrier xb_; xb_.bar = (unsigned*)(ws_() + WS_BAR); xb_.x = xb_xcc_id(); xb_.st = (volatile LAS unsigned*)(lds + LDS_BYTES - 16); xcd_barrier(xb_); if (PROBE_DUP == 1) xcd_barrier(xb_); } } while (0)
#define IN(k) (PH_LO <= (k) && (k) < PH_HI)
    if (IN(0)) { prep_phase(a, lds); if (PROBE_DUP == 4) prep_phase(a, lds); SEAM(0); }
    for (int l = 0; l < DEPTH; ++l) {
        const int pb = 1 + 8 * l;
        if (l == 0 && IN(pb + 0)) {
            norm_phase<false, 1>(INP(0), nullptr, (bf16_t*)(ws_() + WS_H), (float*)(ws_() + WS_SS2), nullptr, (const float*)(ws_() + WS_WF), INP(23), (float*)(ws_() + WS_LOGF));
            SEAM(pb + 0);
        }
        if (IN(pb + 1)) {
            pg8::Gemm g{(const pg8::bf16_t*)(ws_() + WS_H), (const pg8::bf16_t*)(ws_() + WS_WIN) + (size_t)l * ZW * DM, T, ZW, DM}; pg8::StaticOrder S; S.init(T, ZW, grid_(), bid_(), WGM_G1);
            EpiStoreBf16<0, true> E{(bf16_t*)(ws_() + WS_Z), ZW, (const float*)(ws_() + WS_SS2)};
            pg8::gemm_phase<EpiStoreBf16<0, true>, pg8::StaticOrder, true, true>((PG8_LAS unsigned char*)lds, g, S, E);
            if (PROBE_DUP == 9) pg8::gemm_phase<EpiStoreBf16<0, true>, pg8::StaticOrder, true, true>((PG8_LAS unsigned char*)lds, g, S, E);
            if (l > 0) norm_phase<true, 1>(ws_() + WS_H, nullptr, nullptr, nullptr, nullptr, (const float*)(ws_() + WS_WF) + (size_t)l * DM * 4, INP(23) + l * 4, (float*)(ws_() + WS_LOGF));
            SEAM(pb + 1);
        }
        if (IN(pb + 2)) {
            for (int rep = 0; rep < (PROBE_DUP == 2 ? 2 : 1); ++rep)
            for (int it = bid_(); it < 260; it += grid_()) {
                if (it < 128) { if (ITEM_MASK & 1) s5_item<1>(l, it >> 5, it & 31, a, lds); }
                else if (it < 256) { if (ITEM_MASK & 4) lru_item<1>(l, (it - 128) >> 5, (it - 128) & 31, a, lds); }
                else { if (ITEM_MASK & 8) cumsum_item(it - 256, (const float*)(ws_() + WS_LOGF), (float*)(ws_() + WS_CS), lds); }
            }
            SEAM(pb + 2);
        }
        if (IN(pb + 3)) {
            for (int rep = 0; rep < (PROBE_DUP == 3 ? 2 : 1); ++rep) {
            for (int rep2 = 0; rep2 < (PROBE_DUP == 5 ? 2 : 1); ++rep2)
            for (int up = bid_(); up < 256; up += grid_()) {
                const int pr = up >> 4, j = up & 15;
                if (ITEM_MASK & 16) { attn_unit(pr >> 2, pr & 3, 31 - j, a, lds);
                attn_unit(pr >> 2, pr & 3, j, a, lds); }
            }
            for (int rep3 = 0; rep3 < (PROBE_DUP == 6 ? 2 : 1); ++rep3)
            for (int it = bid_(); it < 256; it += grid_()) {
                if (it < 128) { if (ITEM_MASK & 32) s5_item<2>(l, it >> 5, it & 31, a, lds); }
                else { if (ITEM_MASK & 64) lru_item<2>(l, (it - 128) >> 5, (it - 128) & 31, a, lds); }
            }
            if (ITEM_MASK & 2) {
                unsigned* qctr = (unsigned*)(ws_() + WS_BAR) + 3600 + l;
                volatile LAS unsigned* qslot = (volatile LAS unsigned*)(lds + LDS_BYTES - 48);
                for (;;) {
                    __syncthreads();
                    if (opaque_tid() == 0) qslot[0] = __hip_atomic_fetch_add(qctr, 1u, __ATOMIC_RELAXED, __HIP_MEMORY_SCOPE_AGENT);
                    __syncthreads();
                    const unsigned qi = qslot[0];
                    if (qi >= 256u) break;
                    if (qi < 128u) sgu_item<1>(l, (int)(qi >> 5), (int)(qi & 31), a, lds);
                    else sgu_item<0>(l, (int)((qi - 128u) >> 5), (int)(qi & 31), a, lds);
                }
            }
            }
            SEAM(pb + 3);
        }
        if (IN(pb + 4)) {
            pg8::Gemm g{(const pg8::bf16_t*)(ws_() + WS_Y), (const pg8::bf16_t*)(ws_() + WS_WOUT) + (size_t)l * DM * DM, T, DM, DM}; pg8::StaticOrder S; S.init(T, DM, grid_(), bid_(), WGM_G2);
            EpiRes<true, true> E{(bf16_t*)(ws_() + WS_H), DM, (const float*)(ws_() + WS_SSD), (float*)(ws_() + WS_SS2)};
            pg8::gemm_phase<EpiRes<true, true>, pg8::StaticOrder, true, true>((PG8_LAS unsigned char*)lds, g, S, E);
            SEAM(pb + 4);
        }
        if (IN(pb + 6)) {
            pg8::Gemm g{(const pg8::bf16_t*)(ws_() + WS_H), (const pg8::bf16_t*)(ws_() + WS_WMI) + (size_t)l * DFF * DM, T, DFF, DM}; pg8::StaticOrder S; S.init(T, DFF, grid_(), bid_(), WGM_G3);
            EpiStoreBf16<1, true> E{(bf16_t*)(ws_() + WS_ACT), DFF, (const float*)(ws_() + WS_SS2)};
            pg8::gemm_phase<EpiStoreBf16<1, true>, pg8::StaticOrder, true, true>((PG8_LAS unsigned char*)lds, g, S, E);
            SEAM(pb + 6);
        }
        if (IN(pb + 7)) {
            pg8::Gemm g{(const pg8::bf16_t*)(ws_() + WS_ACT), (const pg8::bf16_t*)(ws_() + WS_WMO) + (size_t)l * DM * DFF, T, DM, DFF}; pg8::StaticOrder S; S.init(T, DM, grid_(), bid_(), WGM_G4);
            EpiRes<false, true> E{(bf16_t*)(ws_() + WS_H), DM, nullptr, (float*)(ws_() + WS_SS2)};
            pg8::gemm_phase<EpiRes<false, true>, pg8::StaticOrder, true, true>((PG8_LAS unsigned char*)lds, g, S, E);
            SEAM(pb + 7);
        }
    }
    if (IN(33)) norm_phase<true, 2>(ws_() + WS_H, INP(29), nullptr, nullptr, out_(), nullptr, nullptr, nullptr);
#undef SEAM
#undef IN
}


#ifndef DUMP_SEL
#define DUMP_SEL 0
#endif
#ifndef DUMP_LAST
#define DUMP_LAST 33
#endif
__global__ void dump_kernel(const unsigned char* ws, float* out) {
    const size_t i = (size_t)blockIdx.x * blockDim.x + threadIdx.x;
    const size_t t = i >> 10, c = i & 1023;
    float v = 0.f;
    if (DUMP_SEL == 1) v = bf2f(((const bf16_t*)(ws + WS_H))[i]);
    if (DUMP_SEL == 2) v = bf2f(((const bf16_t*)(ws + WS_Z))[t * ZW + c]) + bf2f(((const bf16_t*)(ws + WS_Z))[t * ZW + c + 1024]);
    if (DUMP_SEL == 3) v = bf2f(((const bf16_t*)(ws + WS_Y))[i]);
    if (DUMP_SEL == 5) v = ((const float*)(ws + WS_SSD))[(t * 4 + (c & 3))] + ((const float*)(ws + WS_CS))[(t * 4 + (c & 3))];
    if (DUMP_SEL == 7) v = ((const float*)(ws + WS_ELOC))[i & 262143];
    if (DUMP_SEL == 8) v = ((const float*)(ws + WS_LA))[i & 32767] + ((const float*)(ws + WS_LB))[i & 32767];
    if (DUMP_SEL == 6) v = bf2f(((const bf16_t*)(ws + WS_WIN))[i]) + bf2f(((const bf16_t*)(ws + WS_WMI))[i]) + bf2f(((const bf16_t*)(ws + WS_WMO))[i]) + bf2f(((const bf16_t*)(ws + WS_WOUT))[i & 0x3fffff]);
    out[i] = v;
}
#ifndef N_LAUNCH_MODE
#define N_LAUNCH_MODE 1
#endif
extern "C" void kernel_launch(void* const* d_in, const int* in_sizes, int n_in, void* d_out, int out_size, void* d_ws, size_t ws_size, hipStream_t stream) {
    static int grid = 0;
    if (grid == 0) {
        if (n_in != 30 || out_size != T * DM || ws_size < WS_END) { fprintf(stderr, "kernel_launch: unexpected shapes (n_in %d, out %d, ws %zu, need %zu)\n", n_in, out_size, ws_size, (size_t)WS_END); grid = -1; return; }
        int dev = 0, cus = 0, per_cu = 0;
        hipGetDevice(&dev); hipDeviceGetAttribute(&cus, hipDeviceAttributeMultiprocessorCount, dev);
        if (hipFuncSetAttribute((const void*)fwd_kernel, hipFuncAttributeMaxDynamicSharedMemorySize, LDS_BYTES) != hipSuccess) { fprintf(stderr, "kernel_launch: hipFuncSetAttribute failed\n"); grid = -1; return; }
        if (hipOccupancyMaxActiveBlocksPerMultiprocessor(&per_cu, (const void*)fwd_kernel, NTHR, LDS_BYTES) != hipSuccess || per_cu < 1) { fprintf(stderr, "kernel_launch: occupancy query says %d\n", per_cu); per_cu = 1; }
        (void)hipGetLastError();
        grid = cus;
        if (grid > 256) grid = 256;
    }
    if (grid < 0) return;
    Args a{};
    for (int i = 0; i < 30; ++i) a.in[i] = (const float*)d_in[i];
    a.out = (float*)d_out; a.ws = (unsigned char*)d_ws;
    if (N_LAUNCH_MODE == 1) {
        a.ph_lo = 0; a.ph_hi = 34;
        if (hipMemsetAsync((unsigned char*)d_ws + WS_BAR, 0, 16 * 1024, stream) != hipSuccess) { fprintf(stderr, "kernel_launch: memset of the barrier words failed\n"); return; }
        void* args[] = {&a};
        hipError_t e = hipLaunchCooperativeKernel((const void*)fwd_kernel, dim3(grid), dim3(NTHR), args, LDS_BYTES, stream);
        if (e != hipSuccess) fprintf(stderr, "kernel_launch: cooperative launch failed: %s (grid %d)\n", hipGetErrorString(e), grid);
    } else {
        for (int ph = 0; ph <= DUMP_LAST; ++ph) { a.ph_lo = ph; a.ph_hi = ph + 1; hipLaunchKernelGGL(fwd_kernel, dim3(grid), dim3(NTHR), LDS_BYTES, stream, a); }
        if (DUMP_SEL != 0 && DUMP_SEL != 4) hipLaunchKernelGGL(dump_kernel, dim3(T * DM / 256), dim3(256), 0, stream, (const unsigned char*)d_ws, (float*)d_out);
    }
}
```

```cpp
#include <hip/hip_runtime.h>
#include <hip/hip_cooperative_groups.h>
#include <cstdio>
#include <cstdint>
namespace cg = cooperative_groups;
__device__ __forceinline__ int opaque_tid() { int t = __builtin_amdgcn_workitem_id_x(); asm volatile("" : "+v"(t)); return t; }
namespace pg8 {
#define PG8_LAS __attribute__((address_space(3)))
typedef unsigned short bf16_t;
typedef short bf16x8 __attribute__((ext_vector_type(8)));
typedef float f32x4 __attribute__((ext_vector_type(4)));
typedef unsigned u32x4 __attribute__((ext_vector_type(4)));
constexpr int BM = 256, BK = 64, HALF = 128, HTB = HALF * BK * 2  , STAGE_BYTES = 8 * HTB, NXCD = 8, WGM = 4;

__host__ __device__ __forceinline__ int lds_byte(int r, int c) { const int st = (r >> 4) * 2 + (c >> 5), rr = r & 15, cc = c & 31, ob = rr * 64 + cc * 2; return st * 1024 + (ob ^ (((ob >> 9) & 1) << 5)); }
__host__ __device__ __forceinline__ void stage_rc(int b, int& R, int& C) { const int st = b / 1024, sb = b % 1024, swz = sb ^ (((sb >> 9) & 1) << 5); R = (st >> 1) * 16 + swz / 64; C = (st & 1) * 32 + (swz % 64) / 2; }
__host__ __device__ __forceinline__ int perm32(int rho) { const int n = rho >> 4, i = rho & 15; return 8 * (i >> 2) + 4 * n + (i & 3); }

struct Unit { int pm, pn; };
struct Gemm { const bf16_t* A; const bf16_t* Bt; int M, N, K; };

struct StaticOrder {
    int nM, nN, nwg, G, c, wgm;
    __host__ __device__ void init(int M, int N, int G_, int c_, int wgm_ = WGM) { nM = M / BM; nN = N / BM; nwg = nM * nN; G = G_; c = c_; wgm = wgm_; }
    __host__ __device__ bool next(int i, Unit& u) const {
        const long L = (long)i * G + c; if (L >= nwg) return false;
        int wgid = (int)L; { const int q = nwg / NXCD, r = nwg % NXCD, xcd = wgid % NXCD, off = wgid / NXCD; wgid = (xcd < r ? xcd * (q + 1) : r * (q + 1) + (xcd - r) * q) + off; }
        const int nig = wgm * nN, gid = wgid / nig, fm = gid * wgm, gsz = (nM - fm) < wgm ? (nM - fm) : wgm;
        u.pm = fm + ((wgid % nig) % gsz); u.pn = (wgid % nig) / gsz; return true;
    }
    __device__ __forceinline__ void a_ready(const Unit&) const {}
    __device__ __forceinline__ void done(const Unit&) const {}
};

__device__ __forceinline__ unsigned cvt_pk_bf16(float lo, float hi) { unsigned r; asm volatile("v_cvt_pk_bf16_f32 %0, %1, %2" : "=v"(r) : "v"(lo), "v"(hi)); return r; }
template <class Epi, class Sched, bool ALIGN_EPI = false, bool SP2 = false>
__device__ __forceinline__ void gemm_phase(PG8_LAS unsigned char* lds, const Gemm g, const Sched& S, const Epi& E) {
    const int tid = opaque_tid(), wid = __builtin_amdgcn_readfirstlane(tid >> 6), lane = tid & 63, wr = wid >> 2, wc = wid & 3, fr = lane & 15, fq = lane >> 4;
    const int K = g.K, nt = K / BK;
    unsigned voffA[2], voffB[2];
#pragma unroll
    for (int i = 0; i < 2; ++i) { int R, C; stage_rc(tid * 16 + i * 8192, R, C); const int Rb = Epi::PERM ? ((R & ~31) + perm32(R & 31)) : R;
        voffA[i] = (unsigned)(R * K + C) * 2u; voffB[i] = (unsigned)(Rb * K + C) * 2u; }
    const size_t kstep = (size_t)(BK * 2);
    const size_t hstep = (size_t)HALF * K * 2;
    const size_t tstep = 2 * hstep;
    const unsigned ldsw = (unsigned)wid * 1024u;
    const int aoff = lds_byte(wr * 64 + fr, fq * 8), boff = lds_byte(wc * 32 + fr, fq * 8);
#define PG8_SA(b, h) (((b) * 2 + (h)) * HTB)
#define PG8_SB(b, h) ((4 + (b) * 2 + (h)) * HTB)
#define PG8_STAGE(bufoff, gbase, voff) do { _Pragma("unroll") for (int _i = 0; _i < 2; ++_i) \
        __builtin_amdgcn_global_load_lds((const unsigned*)((const char*)(gbase) + (voff)[_i]), (PG8_LAS unsigned*)(lds + (bufoff) + ldsw + _i * 8192), 16, 0, 0); } while (0)
#define PG8_LDA(dst, b, h) do { _Pragma("unroll") for (int m = 0; m < 4; ++m) _Pragma("unroll") for (int k = 0; k < 2; ++k) dst[m][k] = *(const PG8_LAS bf16x8*)(lds + PG8_SA(b, h) + aoff + m * 2048 + k * 1024); } while (0)
#define PG8_LDB(dst, b, h) do { _Pragma("unroll") for (int n = 0; n < 2; ++n) _Pragma("unroll") for (int k = 0; k < 2; ++k) dst[n][k] = *(const PG8_LAS bf16x8*)(lds + PG8_SB(b, h) + boff + n * 2048 + k * 1024); } while (0)
#define PG8_MMA(ai, bj, At, Bt) do { __builtin_amdgcn_s_setprio(1); _Pragma("unroll") for (int m = 0; m < 4; ++m) _Pragma("unroll") for (int n = 0; n < 2; ++n) _Pragma("unroll") for (int k = 0; k < 2; ++k) \
        acc[ai][bj][m][n] = __builtin_amdgcn_mfma_f32_16x16x32_bf16(Bt[n][k], At[m][k], acc[ai][bj][m][n], 0, 0, 0); __builtin_amdgcn_s_setprio(0); } while (0)
#define PG8_WAIT_V(n) asm volatile("s_waitcnt vmcnt(" #n ")" ::: "memory")
#define PG8_WAIT_L(n) asm volatile("s_waitcnt lgkmcnt(" #n ")" ::: "memory")
#define PG8_BAR __builtin_amdgcn_s_barrier()
#define PG8_SCHED __builtin_amdgcn_sched_barrier(0)
    Unit cur, nxt; int ui = 0;
    if (!S.next(0, cur)) return;
    if constexpr (Epi::KPREP) { Unit pu; for (int i = 0; i < 12 && S.next(i, pu); ++i) E.kprep(pu, lds + STAGE_BYTES + i * 1024, tid); }
    f32x4 acc[2][2][4][2];
#pragma unroll
    for (int a = 0; a < 2; ++a)
#pragma unroll
        for (int b = 0; b < 2; ++b)
#pragma unroll
            for (int m = 0; m < 4; ++m)
#pragma unroll
                for (int n = 0; n < 2; ++n) acc[a][b][m][n] = (f32x4){0.f, 0.f, 0.f, 0.f};
    bf16x8 At[4][2], B0[2][2], B1[2][2];
    const char* cA = (const char*)g.A + (size_t)cur.pm * tstep; const char* cB = (const char*)g.Bt + (size_t)cur.pn * tstep;
    S.a_ready(cur);
    if constexpr (SP2) {
        PG8_STAGE(PG8_SB(0, 0), cB, voffB); PG8_STAGE(PG8_SB(0, 1), cB + hstep, voffB); PG8_STAGE(PG8_SA(0, 0), cA, voffA); PG8_STAGE(PG8_SA(0, 1), cA + hstep, voffA);
        if (wr == 1) PG8_BAR;
        PG8_WAIT_V(2); PG8_BAR;
        PG8_STAGE(PG8_SB(1, 0), cB + kstep, voffB); PG8_STAGE(PG8_SA(1, 0), cA + kstep, voffA); PG8_STAGE(PG8_SB(1, 1), cB + hstep + kstep, voffB);
        PG8_WAIT_V(6); PG8_BAR;
    } else {
        PG8_STAGE(PG8_SB(0, 0), cB, voffB); PG8_STAGE(PG8_SA(0, 0), cA, voffA); PG8_STAGE(PG8_SB(0, 1), cB + hstep, voffB); PG8_STAGE(PG8_SA(0, 1), cA + hstep, voffA);
        if (wr == 1) PG8_BAR;
        PG8_WAIT_V(4); PG8_BAR;
        PG8_STAGE(PG8_SB(1, 0), cB + kstep, voffB); PG8_STAGE(PG8_SA(1, 0), cA + kstep, voffA); PG8_STAGE(PG8_SB(1, 1), cB + hstep + kstep, voffB);
        PG8_WAIT_V(6); PG8_BAR;
    }
    for (;;) {
        const bool has_next = S.next(ui + 1, nxt);
        const char* nA = has_next ? (const char*)g.A + (size_t)nxt.pm * tstep : cA; const char* nB = has_next ? (const char*)g.Bt + (size_t)nxt.pn * tstep : cB;
        for (int t = 0; t < nt; t += 2) {
            const bool last = (t == nt - 2);
            const char* a1 = cA + (size_t)(t + 1) * kstep;
            const char* a2 = last ? nA : cA + (size_t)(t + 2) * kstep; const char* b2 = last ? nB : cB + (size_t)(t + 2) * kstep;
            const char* a3 = a2 + kstep; const char* b3 = b2 + kstep;
            if (last && has_next) S.a_ready(nxt);
            if constexpr (SP2) {
            PG8_LDB(B0, 0, 0); PG8_LDB(B1, 0, 1); PG8_SCHED; PG8_LDA(At, 0, 0); PG8_STAGE(PG8_SA(1, 1), a1 + hstep, voffA);
            PG8_WAIT_V(8); PG8_WAIT_L(0); PG8_BAR; PG8_MMA(0, 0, At, B0); PG8_MMA(0, 1, At, B1); PG8_BAR; PG8_SCHED;
            PG8_LDA(At, 0, 1); PG8_STAGE(PG8_SB(0, 0), b2, voffB); PG8_STAGE(PG8_SB(0, 1), b2 + hstep, voffB); PG8_STAGE(PG8_SA(0, 0), a2, voffA);
            PG8_WAIT_V(8); PG8_WAIT_L(0); PG8_BAR; PG8_MMA(1, 0, At, B0); PG8_MMA(1, 1, At, B1); PG8_BAR; PG8_SCHED;
            PG8_LDB(B0, 1, 0); PG8_LDB(B1, 1, 1); PG8_SCHED; PG8_LDA(At, 1, 0); PG8_STAGE(PG8_SA(0, 1), a2 + hstep, voffA);
            PG8_WAIT_V(8); PG8_WAIT_L(0); PG8_BAR; PG8_MMA(0, 0, At, B0); PG8_MMA(0, 1, At, B1); PG8_BAR; PG8_SCHED;
            PG8_LDA(At, 1, 1); PG8_STAGE(PG8_SB(1, 0), b3, voffB); PG8_STAGE(PG8_SB(1, 1), b3 + hstep, voffB); PG8_STAGE(PG8_SA(1, 0), a3, voffA);
            PG8_WAIT_V(8); PG8_WAIT_L(0); PG8_BAR; PG8_MMA(1, 0, At, B0); PG8_MMA(1, 1, At, B1); PG8_BAR; PG8_SCHED;
            } else {
            PG8_LDB(B0, 0, 0); PG8_SCHED; PG8_LDA(At, 0, 0); PG8_STAGE(PG8_SA(1, 1), a1 + hstep, voffA);
            PG8_WAIT_L(8); PG8_BAR; PG8_WAIT_L(0); PG8_MMA(0, 0, At, B0); PG8_BAR; PG8_SCHED;
            PG8_LDB(B1, 0, 1); PG8_STAGE(PG8_SB(0, 0), b2, voffB);
            PG8_BAR; PG8_WAIT_L(0); PG8_MMA(0, 1, At, B1); PG8_BAR;
            PG8_LDA(At, 0, 1); PG8_STAGE(PG8_SA(0, 0), a2, voffA);
            PG8_BAR; PG8_WAIT_L(0); PG8_MMA(1, 0, At, B0); PG8_BAR; PG8_SCHED;
            PG8_STAGE(PG8_SB(0, 1), b2 + hstep, voffB);
            PG8_WAIT_V(6); PG8_BAR; PG8_MMA(1, 1, At, B1); PG8_BAR;
            PG8_LDB(B0, 1, 0); PG8_SCHED; PG8_LDA(At, 1, 0); PG8_STAGE(PG8_SA(0, 1), a2 + hstep, voffA);
            PG8_WAIT_L(8); PG8_BAR; PG8_WAIT_L(0); PG8_MMA(0, 0, At, B0); PG8_BAR; PG8_SCHED;
            PG8_LDB(B1, 1, 1); PG8_STAGE(PG8_SB(1, 0), b3, voffB);
            PG8_BAR; PG8_WAIT_L(0); PG8_MMA(0, 1, At, B1); PG8_BAR;
            PG8_LDA(At, 1, 1); PG8_STAGE(PG8_SA(1, 0), a3, voffA);
            PG8_BAR; PG8_WAIT_L(0); PG8_MMA(1, 0, At, B0); PG8_BAR; PG8_SCHED;
            PG8_STAGE(PG8_SB(1, 1), b3 + hstep, voffB);
            PG8_WAIT_V(6); PG8_BAR; PG8_MMA(1, 1, At, B1); PG8_BAR;
            }
            if constexpr (Epi::KHOOK) { if (t == 2) E.khook(acc, lds + STAGE_BYTES + ui * 1024, wr, fr); }
        }
        if constexpr (ALIGN_EPI) { if (wr == 0) PG8_BAR; }
        if constexpr (!Epi::AFTER_DRAIN) { E(acc, cur, wr, wc, fr, fq, lds + STAGE_BYTES + ui * 1024); S.done(cur); }
        if (!has_next) break;
#pragma unroll
        for (int a = 0; a < 2; ++a)
#pragma unroll
            for (int b = 0; b < 2; ++b)
#pragma unroll
                for (int m = 0; m < 4; ++m)
#pragma unroll
                    for (int n = 0; n < 2; ++n) acc[a][b][m][n] = (f32x4){0.f, 0.f, 0.f, 0.f};
        cur = nxt; cA = nA; cB = nB; ++ui;
        if constexpr (ALIGN_EPI) { if (wr == 1) PG8_BAR; }
    }
    PG8_WAIT_V(0);
    if constexpr (!ALIGN_EPI) { if (wr == 0) PG8_BAR; }
    PG8_BAR;
    if constexpr (Epi::AFTER_DRAIN) { E.fused(acc, cur, wr, wc, fr, fq, lds, wid, lane); S.done(cur); }
#undef PG8_SA
#undef PG8_SB
#undef PG8_STAGE
#undef PG8_LDA
#undef PG8_LDB
#undef PG8_MMA
#undef PG8_WAIT_V
#undef PG8_WAIT_L
#undef PG8_BAR
#undef PG8_SCHED
}
}

#define LAS __attribute__((address_space(3)))
typedef unsigned short bf16_t;
typedef short bf16x8 __attribute__((ext_vector_type(8)));
typedef short bf16x4 __attribute__((ext_vector_type(4)));
typedef float f32x4 __attribute__((ext_vector_type(4)));
typedef float f32x2 __attribute__((ext_vector_type(2)));
typedef unsigned u32x4 __attribute__((ext_vector_type(4)));
typedef unsigned u32x2 __attribute__((ext_vector_type(2)));

constexpr int NB = 4, SEQ = 4096, DM = 1024, DEPTH = 4, T = NB * SEQ, W = 256, DFF = 4096, NIN = 2052, ZW = 2048;
constexpr int NCH = SEQ / 128;
constexpr float EPS = 1e-6f;
constexpr float LOG2E = 1.4426950408889634f;
constexpr int NTHR = 512;
constexpr int LDS_BYTES = 147456;
constexpr int ZC_AU = 0, ZC_AV = 256, ZC_B = 512, ZC_CX = 768, ZC_CG = 1024, ZC_Q = 1280, ZC_K = 1536, ZC_V = 1792;
constexpr int YC_D = 0, YC_A = 256, YC_B = 512, YC_C = 768;

constexpr size_t MiB = 1u << 20;
constexpr size_t WS_WIN = 0, WS_WOUT = 16 * MiB, WS_WMI = 24 * MiB, WS_WMO = 56 * MiB, WS_R = 88 * MiB, WS_Z = WS_R, WS_Y = WS_R + 64 * MiB, WS_ACT = WS_R,
                 WS_H = 216 * MiB, WS_S = 248 * MiB;
constexpr size_t WS_GLUT = WS_S, WS_WAT = WS_GLUT + 512 * 1024, WS_WXT = WS_WAT + 128 * 1024, WS_BBT = WS_WXT + 128 * 1024, WS_CMT = WS_BBT + 256 * 1024,
                 WS_ABAR = WS_CMT + 256 * 1024, WS_A128 = WS_ABAR + 32 * 1024, WS_WF = WS_A128 + 32 * 1024, WS_LOGF = WS_WF + 64 * 1024, WS_CS = WS_LOGF + 256 * 1024,
                 WS_SSD = WS_CS + 256 * 1024, WS_ELOC = WS_SSD + 256 * 1024, WS_LA = WS_ELOC + 1024 * 1024, WS_LB = WS_LA + 128 * 1024, WS_BAR = WS_LB + 128 * 1024, WS_SS2 = WS_BAR + 16 * 1024, WS_KMAX = WS_SS2 + 1024 * 1024, WS_END = WS_KMAX + 4096;

struct Args {
    const float* in[30]; float* out; unsigned char* ws; int ph_lo, ph_hi;
};


typedef const __attribute__((address_space(4))) unsigned long long* kargp_t;
__device__ __forceinline__ unsigned long long karg_(int i) { kargp_t tab = (kargp_t)__builtin_amdgcn_kernarg_segment_ptr(); asm volatile("" : "+s"(tab)); return tab[i]; }
#define INP(i) ((const float*)karg_(i))
__device__ __forceinline__ unsigned char* ws_() { return (unsigned char*)karg_(31); }
__device__ __forceinline__ float* out_() { return (float*)karg_(30); }
#define PH_LO ((int)(unsigned)(karg_(32) & 0xffffffffull))
#define PH_HI ((int)(unsigned)(karg_(32) >> 32))
__device__ __forceinline__ int bid_() { return blockIdx.x; }
__device__ __forceinline__ int grid_() { return gridDim.x; }
__device__ __forceinline__ float bf2f(bf16_t v) { return __uint_as_float((unsigned)v << 16); }
__device__ __forceinline__ float bfs2f(short v) { return __uint_as_float(((unsigned)(unsigned short)v) << 16); }
typedef __bf16 bf16x2_t __attribute__((ext_vector_type(2)));
__device__ __forceinline__ unsigned pk2(float lo, float hi) { const f32x2 v = {lo, hi}; const bf16x2_t b = __builtin_convertvector(v, bf16x2_t); return __builtin_bit_cast(unsigned, b); }
__device__ __forceinline__ bf16_t f2bf(float f) { return (bf16_t)(pk2(f, 0.f) & 0xffffu); }
__device__ __forceinline__ float gelu_t(float x) { const float y2 = (1.5957691216057308f * LOG2E) * (x + 0.044715f * x * x * x); return x * __builtin_amdgcn_rcpf(1.0f + __builtin_amdgcn_exp2f(-y2)); }
__device__ __forceinline__ float sigm(float x) { return __builtin_amdgcn_rcpf(1.0f + __builtin_amdgcn_exp2f(-LOG2E * x)); }
__device__ __forceinline__ float softplus_f(float x) { return fmaxf(x, 0.f) + log1pf(__expf(-fabsf(x))); }
__device__ __forceinline__ f32x4 mfma16(bf16x8 a, bf16x8 b, f32x4 c) { return __builtin_amdgcn_mfma_f32_16x16x32_bf16(a, b, c, 0, 0, 0); }
__device__ __forceinline__ float quad_sum(float v) {
    { const auto r = __builtin_amdgcn_permlane16_swap(__float_as_uint(v), __float_as_uint(v), false, false); v = __uint_as_float(r[0]) + __uint_as_float(r[1]); }
    { const auto r = __builtin_amdgcn_permlane32_swap(__float_as_uint(v), __float_as_uint(v), false, false); v = __uint_as_float(r[0]) + __uint_as_float(r[1]); }
    return v;
}
template <int CTRL> __device__ __forceinline__ float dpp_mov(float x) { return __uint_as_float((unsigned)__builtin_amdgcn_update_dpp(0, (int)__float_as_uint(x), CTRL, 0xf, 0xf, true)); }
__device__ __forceinline__ float wave_sum(float v) {
    v += dpp_mov<0xB1>(v); v += dpp_mov<0x4E>(v); v += dpp_mov<0x141>(v); v += dpp_mov<0x140>(v);
    return quad_sum(v);
}
__device__ __forceinline__ float wave_max(float v);
__device__ __forceinline__ float quad_max(float v) {
    { const auto r = __builtin_amdgcn_permlane16_swap(__float_as_uint(v), __float_as_uint(v), false, false); v = fmaxf(__uint_as_float(r[0]), __uint_as_float(r[1])); }
    { const auto r = __builtin_amdgcn_permlane32_swap(__float_as_uint(v), __float_as_uint(v), false, false); v = fmaxf(__uint_as_float(r[0]), __uint_as_float(r[1])); }
    return v;
}
__device__ __forceinline__ bf16x8 pack8(const float* v) {
    u32x4 w; w.x = pk2(v[0], v[1]); w.y = pk2(v[2], v[3]); w.z = pk2(v[4], v[5]); w.w = pk2(v[6], v[7]); return __builtin_bit_cast(bf16x8, w);
}
__device__ __forceinline__ bf16x8 zero8() { return (bf16x8){0, 0, 0, 0, 0, 0, 0, 0}; }

__device__ __forceinline__ float wave_max(float v) {
    v = fmaxf(v, dpp_mov<0xB1>(v)); v = fmaxf(v, dpp_mov<0x4E>(v)); v = fmaxf(v, dpp_mov<0x141>(v)); v = fmaxf(v, dpp_mov<0x140>(v));
    return quad_max(v);
}
template <int N> __device__ __forceinline__ float dpp_shr(float x, float ident) {
    return __uint_as_float((unsigned)__builtin_amdgcn_update_dpp((int)__float_as_uint(ident), (int)__float_as_uint(x), 0x110 + N, 0xf, 0xf, false));
}
__device__ __forceinline__ float neg_expm1(float x) {
    const float s = -x * (1.0f + x * (0.5f + x * (0.16666667f + x * (0.041666668f + x * (0.0083333338f + x * 0.0013888889f)))));
    const float e = 1.0f - __builtin_amdgcn_exp2f(LOG2E * x);
    return (x > -0.25f) ? s : e;
}
template <int ACT  , bool ROWS = false> struct EpiStoreBf16 {
    static constexpr bool PERM = true, AFTER_DRAIN = false, KHOOK = false, KPREP = ROWS;
    __device__ __forceinline__ void kprep(const pg8::Unit& u, PG8_LAS unsigned char* tab, int tid) const {
        if (tid < 256) { const float* rp = rowss + (size_t)(u.pm * 256 + tid) * 16; const f32x4 s0 = *(const f32x4*)rp, s1 = *(const f32x4*)(rp + 4), s2 = *(const f32x4*)(rp + 8), s3 = *(const f32x4*)(rp + 12);
            const float tot = ((s0[0] + s0[1]) + (s0[2] + s0[3])) + ((s1[0] + s1[1]) + (s1[2] + s1[3])) + ((s2[0] + s2[1]) + (s2[2] + s2[3])) + ((s3[0] + s3[1]) + (s3[2] + s3[3]));
            ((PG8_LAS float*)tab)[tid] = rsqrtf(tot * (1.0f / DM) + EPS); }
    }
    bf16_t* O; int ldc; const float* rowss;
    __device__ __forceinline__ void operator()(const pg8::f32x4 (&acc)[2][2][4][2], const pg8::Unit& u, int wr, int wc, int fr, int fq, PG8_LAS unsigned char* tab) const {
        const int row0 = u.pm * 256 + wr * 64 + fr, col0 = u.pn * 256 + wc * 32 + 8 * fq;
#pragma unroll
        for (int ai = 0; ai < 2; ++ai)
#pragma unroll
            for (int m = 0; m < 4; ++m) { bf16_t* rowp = O + (size_t)(row0 + ai * 128 + m * 16) * ldc + col0;
                const float rsc = ROWS ? ((const PG8_LAS float*)tab)[wr * 64 + fr + ai * 128 + m * 16] : 1.0f;
#pragma unroll
                for (int bj = 0; bj < 2; ++bj) { pg8::f32x4 v0 = acc[ai][bj][m][0] * rsc, v1 = acc[ai][bj][m][1] * rsc;
                    if (ACT == 1) {
#pragma unroll
                        for (int e = 0; e < 4; ++e) { const float a = fmaxf(v0[e], 0.f), b = fmaxf(v1[e], 0.f); v0[e] = a * a; v1[e] = b * b; } }
                    u32x4 w; w.x = pk2(v0[0], v0[1]); w.y = pk2(v0[2], v0[3]); w.z = pk2(v1[0], v1[1]); w.w = pk2(v1[2], v1[3]);
                    *(u32x4*)(rowp + bj * 128) = w; } }
    }
};
template <bool HOOK, bool NORMOUT> struct EpiRes {
    static constexpr bool PERM = true, AFTER_DRAIN = false, KHOOK = HOOK, KPREP = HOOK;
    bf16_t* xb; int ldc; const float* ssd; float* ss2;
    __device__ __forceinline__ void operator()(const pg8::f32x4 (&acc)[2][2][4][2], const pg8::Unit& u, int wr, int wc, int fr, int fq, PG8_LAS unsigned char* tab) const {
        const int col0 = u.pn * 256 + wc * 32 + 8 * fq;
#pragma unroll
        for (int ai = 0; ai < 2; ++ai)
#pragma unroll
            for (int m = 0; m < 4; ++m) { const int row = u.pm * 256 + ai * 128 + wr * 64 + m * 16 + fr; bf16_t* rowp = xb + (size_t)row * ldc + col0; float sq = 0.f;
#pragma unroll
                for (int bj = 0; bj < 2; ++bj) { const bf16x8 s = *(const bf16x8*)(rowp + bj * 128); float o[8];
#pragma unroll
                    for (int e = 0; e < 4; ++e) { o[e] = bfs2f(s[e]) + acc[ai][bj][m][0][e]; o[4 + e] = bfs2f(s[4 + e]) + acc[ai][bj][m][1][e]; }
                    if (NORMOUT) {
#pragma unroll
                        for (int e = 0; e < 8; ++e) sq += o[e] * o[e]; }
                    *(bf16x8*)(rowp + bj * 128) = pack8(o); }
                if (NORMOUT) { sq = quad_sum(sq); if (fq == 0) ss2[(size_t)row * 16 + u.pn * 4 + wc] = sq; }
                if (m & 1) asm volatile("" ::: "memory"); }
    }
    __device__ __forceinline__ void kprep(const pg8::Unit& u, PG8_LAS unsigned char* tab, int tid) const {
        if (tid < 256) { const f32x4 s4 = *(const f32x4*)(ssd + (size_t)(u.pm * 256 + tid) * 4); ((PG8_LAS float*)tab)[tid] = rsqrtf((s4[0] + s4[1] + s4[2] + s4[3]) * (1.0f / 256.0f) + EPS); }
    }
    __device__ __forceinline__ void khook(pg8::f32x4 (&acc)[2][2][4][2], PG8_LAS unsigned char* tab, int wr, int fr) const {
#pragma unroll
        for (int ai = 0; ai < 2; ++ai)
#pragma unroll
            for (int m = 0; m < 4; ++m) { const float rs = ((const PG8_LAS float*)tab)[ai * 128 + wr * 64 + m * 16 + fr];
#pragma unroll
                for (int bj = 0; bj < 2; ++bj)
#pragma unroll
                    for (int n = 0; n < 2; ++n) acc[ai][bj][m][n] *= rs; }
    }
};

template <int TN> __device__ __forceinline__ void tc_job(unsigned char* lds, const float* src, size_t sb, int ld, int K, int N, int nbatch, bf16_t* dst, const float* gain, int kshift, int rot) {
    LAS float* tile = (LAS float*)lds;
    constexpr int CG = TN / 64, NLD = TN / 32  , NST = TN / 64  ;
    const int tid = opaque_tid(), nk = K / 64, nn = N / TN, ntile = nbatch * nk * nn;
    for (int ti = (int)((bid_() + grid_() - (rot % grid_())) % grid_()); ti < ntile; ti += grid_()) {
        const int b = ti / (nk * nn), rem = ti % (nk * nn), kt = rem / nn, nt = rem % nn;
        const float* s = src + (size_t)b * sb + (size_t)(kt * 64) * ld + nt * TN;
        f32x4 v[NLD];
#pragma unroll
        for (int p = 0; p < NLD; ++p) { const int idx = tid + 512 * p, c16 = idx & 15, kq = (idx >> 4) & 3, rest = idx >> 6, kl = (rest / CG) * 4 + kq, n4 = ((rest % CG) * 16 + c16) * 4;
            v[p] = *(const f32x4*)(s + (size_t)kl * ld + n4);
            if (gain) { const float gg = gain[(size_t)b * K + kt * 64 + kl]; v[p] = v[p] * gg; } }
        __syncthreads();
#pragma unroll
        for (int p = 0; p < NLD; ++p) { const int idx = tid + 512 * p, c16 = idx & 15, kq = (idx >> 4) & 3, rest = idx >> 6, kl = (rest / CG) * 4 + kq, n4 = ((rest % CG) * 16 + c16) * 4;
            tile[kl * (TN + 1) + n4 + 0] = v[p][0]; tile[kl * (TN + 1) + n4 + 1] = v[p][1]; tile[kl * (TN + 1) + n4 + 2] = v[p][2]; tile[kl * (TN + 1) + n4 + 3] = v[p][3]; }
        __syncthreads();
#pragma unroll
        for (int p = 0; p < NST; ++p) { const int idx = tid + 512 * p, nl = idx >> 3, kc = (idx & 7) * 8; float o[8];
#pragma unroll
            for (int e = 0; e < 8; ++e) o[e] = tile[(kc + e) * (TN + 1) + nl];
            const int kd = (kt * 64 + kc + kshift) % K;
            *(bf16x8*)(dst + (size_t)b * N * K + (size_t)(nt * TN + nl) * K + kd) = pack8(o); }
    }
    __syncthreads();
}

__device__ __forceinline__ void prep_phase(const Args& a, unsigned char* lds) {
    unsigned char* ws = ws_();
    tc_job<256>(lds, INP(2), (size_t)DM * NIN, NIN, DM, ZW, DEPTH, (bf16_t*)(ws + WS_WIN), INP(1), 0, 0);
    tc_job<256>(lds, INP(25), (size_t)DM * DM, DM, DM, DM, DEPTH, (bf16_t*)(ws + WS_WOUT), INP(24), 256, 0);
    tc_job<256>(lds, INP(27), (size_t)DM * DFF, DFF, DM, DFF, DEPTH, (bf16_t*)(ws + WS_WMI), INP(26), 0, 0);
    tc_job<256>(lds, INP(28), (size_t)DFF * DM, DM, DFF, DM, DEPTH, (bf16_t*)(ws + WS_WMO), nullptr, 0, 0);
    tc_job<256>(lds, INP(14), (size_t)W * W, W, W, W, DEPTH, (bf16_t*)(ws + WS_GLUT), nullptr, 0, 0);
    tc_job<64>(lds, INP(18), (size_t)64 * 64, 64, 64, 64, DEPTH * 4, (bf16_t*)(ws + WS_WAT), nullptr, 0, 64);
    tc_job<64>(lds, INP(20), (size_t)64 * 64, 64, 64, 64, DEPTH * 4, (bf16_t*)(ws + WS_WXT), nullptr, 0, 96);
    const int gid = bid_() * NTHR + opaque_tid();
    if (gid < DEPTH * 1024) {
        const int l = gid >> 10, gp = gid & 1023, g = gp >> 6, p = gp & 63;
        const float lre = INP(6)[gid], lim = INP(7)[gid], dt = expf(INP(8)[l * 16 + g]);
        const float mag = expf(lre * dt), are = mag * cosf(lim * dt), aim = mag * sinf(lim * dt);
        const float den = lre * lre + lim * lim, nre = are - 1.0f, nim = aim;
        const float fre = (nre * lre + nim * lim) / den, fim = (nim * lre - nre * lim) / den;
        ((f32x2*)(ws + WS_ABAR))[gid] = (f32x2){are, aim};
        float pr = are, pi = aim;
#pragma unroll
        for (int s = 0; s < 7; ++s) { const float nr = pr * pr - pi * pi, ni = 2.0f * pr * pi; pr = nr; pi = ni; }
        ((f32x2*)(ws + WS_A128))[gid] = (f32x2){pr, pi};
        const float* bre = INP(9) + (size_t)gid * 16; const float* bim = INP(10) + (size_t)gid * 16;
        bf16_t* bbt = (bf16_t*)(ws + WS_BBT) + ((size_t)(l * 16 + g) * 128 + 2 * p) * 16;
#pragma unroll
        for (int h = 0; h < 16; ++h) { const float br = bre[h], bi = bim[h]; bbt[h] = f2bf(fre * br - fim * bi); bbt[16 + h] = f2bf(fre * bi + fim * br); }
        bf16_t* cmt = (bf16_t*)(ws + WS_CMT) + (size_t)(l * 16 + g) * 16 * 128;
#pragma unroll
        for (int h = 0; h < 16; ++h) { const size_t ci = ((size_t)(l * 16 + g) * 16 + h) * 64 + p; ((unsigned*)cmt)[(h * 128 + 2 * p) >> 1] = pk2(INP(11)[ci], -INP(12)[ci]); }
        const float* wr = INP(2) + ((size_t)l * DM + gp) * NIN + ZW;
        ((f32x4*)(ws + WS_WF))[gid] = *(const f32x4*)wr * INP(1)[gid];
    }
}

template <bool SRCB, int MODE> __device__ __forceinline__ void norm_phase(const void* xsv, const float* g, bf16_t* xb, float* ss2, float* od, const float* wf, const float* bfg, float* logf) {
    const int lane = opaque_tid() & 63, wid = opaque_tid() >> 6;
    const int gw = bid_() * 8 + wid, nw = grid_() * 8;
    for (int row = gw; row < T; row += nw) {
        f32x4 v[4]; float ss = 0.f;
#pragma unroll
        for (int i = 0; i < 4; ++i) {
            if (SRCB) { const bf16x4 q = *(const bf16x4*)((const bf16_t*)xsv + (size_t)row * DM + i * 256 + lane * 4); v[i] = (f32x4){bfs2f(q[0]), bfs2f(q[1]), bfs2f(q[2]), bfs2f(q[3])}; }
            else { v[i] = *(const f32x4*)((const float*)xsv + (size_t)row * DM + i * 256 + lane * 4);
                if (MODE == 1) { u32x2 w; w.x = pk2(v[i][0], v[i][1]); w.y = pk2(v[i][2], v[i][3]); *(u32x2*)(xb + (size_t)row * DM + i * 256 + lane * 4) = w; } }
            ss += v[i][0] * v[i][0] + v[i][1] * v[i][1] + v[i][2] * v[i][2] + v[i][3] * v[i][3]; }
        ss = wave_sum(ss);
        const float rs = rsqrtf(ss * (1.0f / DM) + EPS);
        if (MODE == 1 && !SRCB) { if (lane < 16) ss2[(size_t)row * 16 + lane] = (lane == 0) ? ss : 0.f; }
        float f0 = 0.f, f1 = 0.f, f2 = 0.f, f3 = 0.f;
#pragma unroll
        for (int i = 0; i < 4; ++i) {
            if (MODE == 2) { const f32x4 gg = *(const f32x4*)(g + i * 256 + lane * 4); *(f32x4*)(od + (size_t)row * DM + i * 256 + lane * 4) = v[i] * rs * gg; }
            if (MODE == 1) {
#pragma unroll
                for (int e = 0; e < 4; ++e) { const f32x4 w4 = *(const f32x4*)(wf + (size_t)(i * 256 + lane * 4 + e) * 4); const float hv = v[i][e] * rs; f0 += hv * w4[0]; f1 += hv * w4[1]; f2 += hv * w4[2]; f3 += hv * w4[3]; } }
        }
        if (MODE == 1) {
            f0 = wave_sum(f0); f1 = wave_sum(f1); f2 = wave_sum(f2); f3 = wave_sum(f3);
            if (lane == 0) { f32x4 o; const float fv[4] = {f0 + bfg[0], f1 + bfg[1], f2 + bfg[2], f3 + bfg[3]};
#pragma unroll
                for (int e = 0; e < 4; ++e) o[e] = fminf(fv[e], 0.f) - log1pf(__expf(-fabsf(fv[e])));
                *(f32x4*)(logf + (size_t)row * 4) = o; }
        }
    }
}

__device__ __forceinline__ void cumsum_item(int b, const float* logf, float* cs, unsigned char* lds) {
    LAS float* wt = (LAS float*)lds;
    const int tid = opaque_tid(), lane = tid & 63, wid = tid >> 6;
    f32x4 v[8]; f32x4 run = (f32x4){0.f, 0.f, 0.f, 0.f};
    const float* src = logf + ((size_t)b * SEQ + (size_t)tid * 8) * 4;
#pragma unroll
    for (int e = 0; e < 8; ++e) { run = run + *(const f32x4*)(src + e * 4); v[e] = run; }
    f32x4 inc = run;
#pragma unroll
    for (int d = 1; d < 64; d <<= 1) {
        const int sl = ((lane >= d) ? lane - d : lane) << 2; f32x4 o;
#pragma unroll
        for (int e = 0; e < 4; ++e) o[e] = __uint_as_float((unsigned)__builtin_amdgcn_ds_bpermute(sl, (int)__float_as_uint(inc[e])));
        if (lane >= d) inc = inc + o;
    }
    __syncthreads();
    if (lane == 63) { wt[wid * 4 + 0] = inc[0]; wt[wid * 4 + 1] = inc[1]; wt[wid * 4 + 2] = inc[2]; wt[wid * 4 + 3] = inc[3]; }
    __syncthreads();
    f32x4 off = inc - run;
    for (int w2 = 0; w2 < wid; ++w2) { off[0] += wt[w2 * 4 + 0]; off[1] += wt[w2 * 4 + 1]; off[2] += wt[w2 * 4 + 2]; off[3] += wt[w2 * 4 + 3]; }
    float* dst = cs + ((size_t)b * SEQ + (size_t)tid * 8) * 4;
#pragma unroll
    for (int e = 0; e < 8; ++e) *(f32x4*)(dst + e * 4) = (v[e] + off) * LOG2E;
    __syncthreads();
}

template <int HALF> __device__ __forceinline__ void sgu_item(int l, int b, int c, const Args& a, unsigned char* lds) {
    const bf16_t* z = (const bf16_t*)(ws_() + WS_Z); bf16_t* y = (bf16_t*)(ws_() + WS_Y);
    LAS bf16_t* vnT = (LAS bf16_t*)lds;
    LAS float* ssb = (LAS float*)(lds + 69632);
    const int tid = opaque_tid(), lane = tid & 63, wid = tid >> 6, fr = lane & 15, quad = lane >> 4;
    const size_t t0 = (size_t)b * SEQ + (size_t)c * 128;
    const float* ng = INP(3) + l * W;
    __syncthreads();
    float gch[4];
#pragma unroll
    for (int e = 0; e < 4; ++e) gch[e] = ng[lane + 64 * e];
    constexpr int TPW = HALF ? 16 : 8;
#pragma unroll
    for (int half = 0; half < TPW / 8; ++half) {
        float val[8][4];
#pragma unroll
        for (int i = 0; i < 8; ++i) {
            const bf16_t* zr = z + (t0 + wid * TPW + half * 8 + i) * ZW + ZC_AV; float ss = 0.f;
#pragma unroll
            for (int e = 0; e < 4; ++e) { const float gv = gelu_t(bf2f(zr[lane + 64 * e])); val[i][e] = gv; ss += gv * gv; }
            ss = wave_sum(ss); const float rs = rsqrtf(ss * (1.0f / W) + EPS);
#pragma unroll
            for (int e = 0; e < 4; ++e) val[i][e] *= rs * gch[e];
        }
#pragma unroll
        for (int e = 0; e < 4; ++e) { float t8[8];
#pragma unroll
            for (int i = 0; i < 8; ++i) t8[i] = val[i][e];
            *(LAS bf16x8*)(vnT + (lane + 64 * e) * 136 + wid * TPW + half * 8) = pack8(t8); }
    }
    __syncthreads();
    const int h = wid & 3;
    const float* wsrc = INP(4) + ((size_t)(l * 4 + h) * 128) * 128;
    const float* bsrc = INP(5) + (size_t)(l * 4 + h) * 128;
    float outv[2][4][4];
#pragma unroll
    for (int i = 0; i < 2; ++i) {
        const int mt = HALF * 4 + (wid >> 2) + 2 * i, t = mt * 16 + fr;
        f32x4 acc[4];
#pragma unroll
        for (int nt = 0; nt < 4; ++nt) acc[nt] = (f32x4){0.f, 0.f, 0.f, 0.f};
        f32x4 wl[4][2];
#pragma unroll
        for (int kk = 0; kk < 4; ++kk) { const int k0 = (kk * 32 < (mt + 1) * 16) ? kk * 32 : 0; const float* wp = wsrc + (size_t)t * 128 + k0 + quad * 8; wl[kk][0] = *(const f32x4*)wp; wl[kk][1] = *(const f32x4*)(wp + 4); }
#pragma unroll
        for (int kk = 0; kk < 4; ++kk) {
            const int k0 = kk * 32;
            if (k0 < (mt + 1) * 16) {
                float wv[8] = {wl[kk][0][0], wl[kk][0][1], wl[kk][0][2], wl[kk][0][3], wl[kk][1][0], wl[kk][1][1], wl[kk][1][2], wl[kk][1][3]};
#pragma unroll
                for (int e = 0; e < 8; ++e) if (k0 + quad * 8 + e > t) wv[e] = 0.f;
                const bf16x8 wf = pack8(wv);
#pragma unroll
                for (int nt = 0; nt < 4; ++nt) { const bf16x8 vf = *(const LAS bf16x8*)(vnT + (h * 64 + nt * 16 + fr) * 136 + k0 + quad * 8); acc[nt] = mfma16(vf, wf, acc[nt]); }
            }
        }
        const float bs = bsrc[t]; float ss = 0.f;
#pragma unroll
        for (int nt = 0; nt < 4; ++nt) { const int ch = h * 64 + nt * 16 + quad * 4; const bf16x4 u4 = *(const bf16x4*)(z + (t0 + t) * ZW + ZC_AU + ch);
#pragma unroll
            for (int r = 0; r < 4; ++r) { const float o = gelu_t(bfs2f(u4[r])) * (acc[nt][r] + bs); outv[i][nt][r] = o; ss += o * o; } }
        ss = quad_sum(ss);
        if (quad == 0) ssb[t * 4 + h] = ss;
    }
    __syncthreads();
#pragma unroll
    for (int i = 0; i < 2; ++i) {
        const int mt = HALF * 4 + (wid >> 2) + 2 * i, t = mt * 16 + fr;
        const float rs = rsqrtf((ssb[t * 4 + 0] + ssb[t * 4 + 1] + ssb[t * 4 + 2] + ssb[t * 4 + 3]) * (1.0f / W) + EPS);
#pragma unroll
        for (int nt = 0; nt < 4; ++nt) { const int ch = h * 64 + nt * 16 + quad * 4; u32x2 w; w.x = pk2(outv[i][nt][0] * rs, outv[i][nt][1] * rs); w.y = pk2(outv[i][nt][2] * rs, outv[i][nt][3] * rs);
            *(u32x2*)(y + (t0 + t) * DM + YC_A + ch) = w; }
    }
    __syncthreads();
}

template <int PASS> __device__ __forceinline__ void s5_item(int l, int b, int c, const Args& a, unsigned char* lds) {
    const bf16_t* z = (const bf16_t*)(ws_() + WS_Z); bf16_t* y = (bf16_t*)(ws_() + WS_Y);
    LAS unsigned char* BU = (LAS unsigned char*)lds;
    LAS unsigned* BU32 = (LAS unsigned*)lds;
    LAS bf16_t* Yb = (LAS bf16_t*)(lds + 65792);
    LAS float* ssb = (LAS float*)(lds + 65792 + 67584);
    const int tid = opaque_tid(), lane = tid & 63, wid = tid >> 6, fr = lane & 15, quad = lane >> 4;
    const int sx0 = wid * 128 + lane, sx1 = sx0 + 64;
    const size_t t0 = (size_t)b * SEQ + (size_t)c * 128;
    const f32x2* abar = (const f32x2*)(ws_() + WS_ABAR) + l * 1024;
    f32x2* eloc = (f32x2*)(ws_() + WS_ELOC);
    float ar[2], ai[2], sre[2], sim[2];
#pragma unroll
    for (int q = 0; q < 2; ++q) { const f32x2 ab = abar[q ? sx1 : sx0]; ar[q] = ab[0]; ai[q] = ab[1]; sre[q] = 0.f; sim[q] = 0.f; }
    if (PASS == 2) {
        const f32x2* a128 = (const f32x2*)(ws_() + WS_A128) + l * 1024;
        const f32x2 p0 = a128[sx0], p1 = a128[sx1];
        for (int cc0 = 0; cc0 < c; cc0 += 8) {
            f32x2 e0[8], e1[8];
#pragma unroll
            for (int u = 0; u < 8; ++u) { const int cc = (cc0 + u < c) ? cc0 + u : c - 1; e0[u] = eloc[((size_t)(b * NCH + cc)) * 1024 + sx0]; e1[u] = eloc[((size_t)(b * NCH + cc)) * 1024 + sx1]; }
#pragma unroll
            for (int u = 0; u < 8; ++u) if (cc0 + u < c) {
                const float nr0 = p0[0] * sre[0] - p0[1] * sim[0] + e0[u][0], ni0 = p0[0] * sim[0] + p0[1] * sre[0] + e0[u][1]; sre[0] = nr0; sim[0] = ni0;
                const float nr1 = p1[0] * sre[1] - p1[1] * sim[1] + e1[u][0], ni1 = p1[0] * sim[1] + p1[1] * sre[1] + e1[u][1]; sre[1] = nr1; sim[1] = ni1; }
        }
    }
    bf16x8 bfrag[2][8];
    const bf16_t* bbt = (const bf16_t*)(ws_() + WS_BBT);
#pragma unroll
    for (int gi = 0; gi < 2; ++gi)
#pragma unroll
        for (int j = 0; j < 8; ++j) bfrag[gi][j] = (quad < 2) ? *(const bf16x8*)(bbt + ((size_t)(l * 16 + wid * 2 + gi) * 128 + j * 16 + fr) * 16 + quad * 8) : zero8();
    bf16x8 cfrag[2][4];
    if (PASS == 2) {
        const bf16_t* cmt = (const bf16_t*)(ws_() + WS_CMT);
#pragma unroll
        for (int gi = 0; gi < 2; ++gi)
#pragma unroll
            for (int ks = 0; ks < 4; ++ks) cfrag[gi][ks] = *(const bf16x8*)(cmt + ((size_t)(l * 16 + wid * 2 + gi) * 16 + fr) * 128 + ks * 32 + quad * 8);
    }
    const float* dsk = INP(13) + l * W;
    __syncthreads();
    bf16x8 ufn[2];
#pragma unroll
    for (int gi = 0; gi < 2; ++gi) ufn[gi] = (quad < 2) ? *(const bf16x8*)(z + (t0 + fr) * ZW + ZC_B + (wid * 2 + gi) * 16 + quad * 8) : zero8();
    for (int sc = 0; sc < 8; ++sc) {
        const size_t tr = t0 + sc * 16 + fr;
        bf16x8 ufc[2] = {ufn[0], ufn[1]};
        bf16x4 u4c[2] = {(bf16x4){0, 0, 0, 0}, (bf16x4){0, 0, 0, 0}};
        if (PASS == 2) {
#pragma unroll
            for (int gi = 0; gi < 2; ++gi) u4c[gi] = *(const bf16x4*)(z + tr * ZW + ZC_B + (wid * 2 + gi) * 16 + quad * 4);
        }
        if (sc < 7) {
#pragma unroll
            for (int gi = 0; gi < 2; ++gi) ufn[gi] = (quad < 2) ? *(const bf16x8*)(z + (tr + 16) * ZW + ZC_B + (wid * 2 + gi) * 16 + quad * 8) : zero8();
        }
#pragma unroll
        for (int gi = 0; gi < 2; ++gi) {
            const int g = wid * 2 + gi;
            const bf16x8 uf = ufc[gi];
#pragma unroll
            for (int j = 0; j < 8; ++j) {
                const f32x4 acc = mfma16(bfrag[gi][j], uf, (f32x4){0.f, 0.f, 0.f, 0.f});
                u32x2 w; w.x = pk2(acc[0], acc[1]); w.y = pk2(acc[2], acc[3]);
                *(LAS u32x2*)(BU + fr * 4112 + (g * 64 + j * 8 + quad * 2) * 4) = w;
            }
        }
        asm volatile("s_waitcnt lgkmcnt(0)" ::: "memory");
        {
            unsigned wv[16][2];
#pragma unroll
            for (int tt = 0; tt < 16; ++tt) { wv[tt][0] = BU32[tt * 1028 + sx0]; wv[tt][1] = BU32[tt * 1028 + sx1]; }
#pragma unroll
            for (int tt = 0; tt < 16; ++tt) {
#pragma unroll
                for (int q = 0; q < 2; ++q) {
                    const unsigned w = wv[tt][q];
                    const f32x2 bu2 = {__uint_as_float(w << 16), __uint_as_float(w & 0xffff0000u)};
                    const f32x2 s2 = {sre[q], sim[q]}, sw = {sim[q], sre[q]}, arr = {ar[q], ar[q]}, aii = {-ai[q], ai[q]};
                    const f32x2 n2 = aii * sw + (arr * s2 + bu2);
                    sre[q] = n2[0]; sim[q] = n2[1];
                    if (PASS == 2) wv[tt][q] = pk2(n2[0], n2[1]);
                }
            }
            if (PASS == 2) {
#pragma unroll
                for (int tt = 0; tt < 16; ++tt) { BU32[tt * 1028 + sx0] = wv[tt][0]; BU32[tt * 1028 + sx1] = wv[tt][1]; }
            }
        }
        asm volatile("s_waitcnt lgkmcnt(0)" ::: "memory");
        if (PASS == 2) {
#pragma unroll
            for (int gi = 0; gi < 2; ++gi) {
                const int g = wid * 2 + gi; f32x4 acc = (f32x4){0.f, 0.f, 0.f, 0.f};
#pragma unroll
                for (int ks = 0; ks < 4; ++ks) { const bf16x8 sf = *(const LAS bf16x8*)(BU + fr * 4112 + g * 256 + (ks * 32 + quad * 8) * 2); acc = mfma16(cfrag[gi][ks], sf, acc); }
                const int ch = g * 16 + quad * 4; const bf16x4 u4 = u4c[gi]; const f32x4 d4 = *(const f32x4*)(dsk + ch);
                float o[4];
#pragma unroll
                for (int r = 0; r < 4; ++r) o[r] = gelu_t(acc[r] + d4[r] * bfs2f(u4[r]));
                u32x2 w; w.x = pk2(o[0], o[1]); w.y = pk2(o[2], o[3]);
                *(LAS u32x2*)(Yb + (sc * 16 + fr) * 264 + ch) = w;
            }
        }
    }
    if (PASS == 1) {
#pragma unroll
        for (int q = 0; q < 2; ++q) eloc[((size_t)(b * NCH + c)) * 1024 + (q ? sx1 : sx0)] = (f32x2){sre[q], sim[q]};
    } else {
        __syncthreads();
        const bf16_t* glut = (const bf16_t*)(ws_() + WS_GLUT) + (size_t)l * W * W;
        const float* glub = INP(15) + l * W;
        bf16x8 gfrag[2][8];
#pragma unroll
        for (int ni = 0; ni < 2; ++ni)
#pragma unroll
            for (int ks = 0; ks < 8; ++ks) gfrag[ni][ks] = *(const bf16x8*)(glut + (size_t)((wid * 2 + ni) * 16 + fr) * W + ks * 32 + quad * 8);
        float outv[8][2][4];
#pragma unroll
        for (int mt = 0; mt < 8; ++mt) {
            f32x4 acc0 = (f32x4){0.f, 0.f, 0.f, 0.f}, acc1 = acc0;
#pragma unroll
            for (int ks = 0; ks < 8; ++ks) { const bf16x8 yf = *(const LAS bf16x8*)(Yb + (mt * 16 + fr) * 264 + ks * 32 + quad * 8); acc0 = mfma16(gfrag[0][ks], yf, acc0); acc1 = mfma16(gfrag[1][ks], yf, acc1); }
            float ss = 0.f;
#pragma unroll
            for (int ni = 0; ni < 2; ++ni) { const int n = (wid * 2 + ni) * 16 + quad * 4; const bf16x4 y4 = *(const LAS bf16x4*)(Yb + (mt * 16 + fr) * 264 + n); const f32x4 gb = *(const f32x4*)(glub + n);
#pragma unroll
                for (int r = 0; r < 4; ++r) { const float gt = (ni == 0 ? acc0[r] : acc1[r]) + gb[r]; const float o = bfs2f(y4[r]) * sigm(gt); outv[mt][ni][r] = o; ss += o * o; } }
            ss = quad_sum(ss);
            if (quad == 0) ssb[(mt * 16 + fr) * 8 + wid] = ss;
        }
        __syncthreads();
#pragma unroll
        for (int mt = 0; mt < 8; ++mt) {
            const int t = mt * 16 + fr; float s = 0.f;
#pragma unroll
            for (int w2 = 0; w2 < 8; ++w2) s += ssb[t * 8 + w2];
            const float rs = rsqrtf(s * (1.0f / W) + EPS);
#pragma unroll
            for (int ni = 0; ni < 2; ++ni) { const int n = (wid * 2 + ni) * 16 + quad * 4; u32x2 w; w.x = pk2(outv[mt][ni][0] * rs, outv[mt][ni][1] * rs); w.y = pk2(outv[mt][ni][2] * rs, outv[mt][ni][3] * rs);
                *(u32x2*)(y + (t0 + t) * DM + YC_B + n) = w; }
        }
    }
    __syncthreads();
}

template <int PASS> __device__ __forceinline__ void lru_item(int l, int b, int c, const Args& a, unsigned char* lds) {
    const bf16_t* z = (const bf16_t*)(ws_() + WS_Z); bf16_t* y = (bf16_t*)(ws_() + WS_Y);
    LAS bf16_t* XC = (LAS bf16_t*)lds;
    LAS float* ssb = (LAS float*)(lds + 67584);
    const int tid = opaque_tid(), lane = tid & 63, wid = tid >> 6, fr = lane & 15, quad = lane >> 4;
    const size_t t0 = (size_t)b * SEQ + (size_t)c * 128;
    float* LAp = (float*)(ws_() + WS_LA); float* LBp = (float*)(ws_() + WS_LB);
    __syncthreads();
    {
        const float* cw = INP(16) + (size_t)l * 4 * W; const float* cb = INP(17) + l * W;
#pragma unroll 4
        for (int it = 0; it < 8; ++it) {
            const int p = tid + 512 * it, tok = p >> 5, ch0 = (p & 31) * 8; float acc[8];
            { const f32x4 c0 = *(const f32x4*)(cb + ch0), c1 = *(const f32x4*)(cb + ch0 + 4); acc[0] = c0[0]; acc[1] = c0[1]; acc[2] = c0[2]; acc[3] = c0[3]; acc[4] = c1[0]; acc[5] = c1[1]; acc[6] = c1[2]; acc[7] = c1[3]; }
#pragma unroll
            for (int k = 0; k < 4; ++k) {
                const int tt = tok - 3 + k;
                if (c * 128 + tt >= 0) {
                    const bf16x8 xv = *(const bf16x8*)(z + (size_t)((long)t0 + tt) * ZW + ZC_CX + ch0);
                    const f32x4 w0 = *(const f32x4*)(cw + k * W + ch0), w1 = *(const f32x4*)(cw + k * W + ch0 + 4);
                    acc[0] += w0[0] * bfs2f(xv[0]); acc[1] += w0[1] * bfs2f(xv[1]); acc[2] += w0[2] * bfs2f(xv[2]); acc[3] += w0[3] * bfs2f(xv[3]);
                    acc[4] += w1[0] * bfs2f(xv[4]); acc[5] += w1[1] * bfs2f(xv[5]); acc[6] += w1[2] * bfs2f(xv[6]); acc[7] += w1[3] * bfs2f(xv[7]);
                }
            }
            *(LAS bf16x8*)(XC + tok * 264 + ch0) = pack8(acc);
        }
    }
    __syncthreads();
    const int hh = wid >> 1;
    const bf16_t* wat = (const bf16_t*)(ws_() + WS_WAT) + (size_t)(l * 4 + hh) * 64 * 64;
    const bf16_t* wxt = (const bf16_t*)(ws_() + WS_WXT) + (size_t)(l * 4 + hh) * 64 * 64;
    bf16x8 waf[2][2], wxf[2][2]; float sp8[2][4], bav[2][4], bxv[2][4], H[2][4], Acar[2][4], Bcar[2][4];
#pragma unroll
    for (int ni = 0; ni < 2; ++ni) {
        const int nl = (wid * 2 + ni) * 16 - hh * 64 + fr;
#pragma unroll
        for (int ks = 0; ks < 2; ++ks) { waf[ni][ks] = *(const bf16x8*)(wat + nl * 64 + ks * 32 + quad * 8); wxf[ni][ks] = *(const bf16x8*)(wxt + nl * 64 + ks * 32 + quad * 8); }
#pragma unroll
        for (int r = 0; r < 4; ++r) { const int ch = (wid * 2 + ni) * 16 + quad * 4 + r;
            sp8[ni][r] = 8.0f * softplus_f(-INP(22)[l * W + ch]); bav[ni][r] = INP(19)[l * W + ch]; bxv[ni][r] = INP(21)[l * W + ch];
            H[ni][r] = 0.f; Acar[ni][r] = 1.f; Bcar[ni][r] = 0.f;
        }
    }
    if (PASS == 2 && c > 0) {
#pragma unroll
        for (int ni = 0; ni < 2; ++ni) {
            const size_t ob = (size_t)(b * NCH) * W + (wid * 2 + ni) * 16 + quad * 4;
            const bool v0 = fr < c, v1 = 16 + fr < c;
            f32x4 a0 = (f32x4){1.f, 1.f, 1.f, 1.f}, b0 = (f32x4){0.f, 0.f, 0.f, 0.f}, a1 = a0, b1 = b0;
            if (v0) { a0 = *(const f32x4*)(LAp + ob + (size_t)fr * W); b0 = *(const f32x4*)(LBp + ob + (size_t)fr * W); }
            if (v1) { a1 = *(const f32x4*)(LAp + ob + (size_t)(16 + fr) * W); b1 = *(const f32x4*)(LBp + ob + (size_t)(16 + fr) * W); }
#pragma unroll
            for (int r = 0; r < 4; ++r) {
                float av = a0[r], bb = b0[r], aw = a1[r], bw = b1[r], ap, bp;
                ap = dpp_shr<1>(av, 1.0f); bp = dpp_shr<1>(bb, 0.0f); bb = av * bp + bb; av = av * ap;   ap = dpp_shr<1>(aw, 1.0f); bp = dpp_shr<1>(bw, 0.0f); bw = aw * bp + bw; aw = aw * ap;
                ap = dpp_shr<2>(av, 1.0f); bp = dpp_shr<2>(bb, 0.0f); bb = av * bp + bb; av = av * ap;   ap = dpp_shr<2>(aw, 1.0f); bp = dpp_shr<2>(bw, 0.0f); bw = aw * bp + bw; aw = aw * ap;
                ap = dpp_shr<4>(av, 1.0f); bp = dpp_shr<4>(bb, 0.0f); bb = av * bp + bb; av = av * ap;   ap = dpp_shr<4>(aw, 1.0f); bp = dpp_shr<4>(bw, 0.0f); bw = aw * bp + bw; aw = aw * ap;
                ap = dpp_shr<8>(av, 1.0f); bp = dpp_shr<8>(bb, 0.0f); bb = av * bp + bb; av = av * ap;   ap = dpp_shr<8>(aw, 1.0f); bp = dpp_shr<8>(bw, 0.0f); bw = aw * bp + bw; aw = aw * ap;
                const float B0t = __shfl(bb, 15, 16), A1t = __shfl(aw, 15, 16), B1t = __shfl(bw, 15, 16);
                H[ni][r] = A1t * B0t + B1t;
            }
        }
    }
    LAS bf16_t* Ob = (LAS bf16_t*)(lds + 67584 + 4096);
#pragma unroll 2
    for (int mt = 0; mt < 8; ++mt) {
        bf16x8 xf[2];
#pragma unroll
        for (int ks = 0; ks < 2; ++ks) xf[ks] = *(const LAS bf16x8*)(XC + (mt * 16 + fr) * 264 + hh * 64 + ks * 32 + quad * 8);
        float ss = 0.f;
#pragma unroll
        for (int ni = 0; ni < 2; ++ni) {
            f32x4 accA = (f32x4){0.f, 0.f, 0.f, 0.f}, accX = accA;
#pragma unroll
            for (int ks = 0; ks < 2; ++ks) { accA = mfma16(waf[ni][ks], xf[ks], accA); accX = mfma16(wxf[ni][ks], xf[ks], accX); }
            const int ch0 = (wid * 2 + ni) * 16 + quad * 4;
            const bf16x4 xc4 = *(const LAS bf16x4*)(XC + (mt * 16 + fr) * 264 + ch0);
            bf16x4 g4 = (bf16x4){0, 0, 0, 0};
            if (PASS == 2) g4 = *(const bf16x4*)(z + (t0 + mt * 16 + fr) * ZW + ZC_CG + ch0);
            float ov[4] = {0.f, 0.f, 0.f, 0.f};
#pragma unroll
            for (int r = 0; r < 4; ++r) {
                const float rg = sigm(accA[r] + bav[ni][r]), ig = sigm(accX[r] + bxv[ni][r]);
                const float la = -rg * sp8[ni][r];
                float av = __builtin_amdgcn_exp2f(LOG2E * la), bb = __builtin_amdgcn_sqrtf(fmaxf(neg_expm1(2.0f * la), 0.f)) * (ig * bfs2f(xc4[r]));
                { float ap, bp;
                  ap = dpp_shr<1>(av, 1.0f); bp = dpp_shr<1>(bb, 0.0f); bb = av * bp + bb; av = av * ap;
                  ap = dpp_shr<2>(av, 1.0f); bp = dpp_shr<2>(bb, 0.0f); bb = av * bp + bb; av = av * ap;
                  ap = dpp_shr<4>(av, 1.0f); bp = dpp_shr<4>(bb, 0.0f); bb = av * bp + bb; av = av * ap;
                  ap = dpp_shr<8>(av, 1.0f); bp = dpp_shr<8>(bb, 0.0f); bb = av * bp + bb; av = av * ap; }
                if (PASS == 1) { const float At = __shfl(av, 15, 16), Bt = __shfl(bb, 15, 16); Bcar[ni][r] = At * Bcar[ni][r] + Bt; Acar[ni][r] *= At; }
                else { const float hv = av * H[ni][r] + bb; H[ni][r] = __shfl(hv, 15, 16); const float o = hv * gelu_t(bfs2f(g4[r])); ov[r] = o; ss += o * o; }
            }
            if (PASS == 2) { u32x2 w; w.x = pk2(ov[0], ov[1]); w.y = pk2(ov[2], ov[3]); *(LAS u32x2*)(Ob + (mt * 16 + fr) * 264 + ch0) = w; }
        }
        if (PASS == 2) { ss = quad_sum(ss); if (quad == 0) ssb[(mt * 16 + fr) * 8 + wid] = ss; }
    }
    if (PASS == 1) {
        if (fr == 0) {
#pragma unroll
            for (int ni = 0; ni < 2; ++ni)
#pragma unroll
                for (int r = 0; r < 4; ++r) { const size_t o = ((size_t)(b * NCH + c)) * W + (wid * 2 + ni) * 16 + quad * 4 + r; LAp[o] = Acar[ni][r]; LBp[o] = Bcar[ni][r]; }
        }
        {
            const int tok = tid >> 2, hd = tid & 3; float s2 = 0.f;
#pragma unroll
            for (int j = 0; j < 8; ++j) { const bf16x8 kv = *(const bf16x8*)(z + (t0 + tok) * ZW + ZC_K + hd * 64 + j * 8);
#pragma unroll
                for (int e = 0; e < 8; ++e) { const float f = bfs2f(kv[e]); s2 += f * f; } }
            ssb[tok * 4 + hd] = s2;
            __syncthreads();
            if (tid < 4) { float mxv = 0.f; for (int i = 0; i < 128; ++i) mxv = fmaxf(mxv, ssb[i * 4 + tid]); ((float*)(ws_() + WS_KMAX))[(b * NCH + c) * 4 + tid] = mxv; }
        }
    } else {
        __syncthreads();
#pragma unroll 2
        for (int mt = 0; mt < 8; ++mt) {
            const int t = mt * 16 + fr; float s = 0.f;
#pragma unroll
            for (int w2 = 0; w2 < 8; ++w2) s += ssb[t * 8 + w2];
            const float rs = rsqrtf(s * (1.0f / W) + EPS);
#pragma unroll
            for (int ni = 0; ni < 2; ++ni) { const int n = (wid * 2 + ni) * 16 + quad * 4; const bf16x4 o4 = *(const LAS bf16x4*)(Ob + t * 264 + n);
                u32x2 w; w.x = pk2(bfs2f(o4[0]) * rs, bfs2f(o4[1]) * rs); w.y = pk2(bfs2f(o4[2]) * rs, bfs2f(o4[3]) * rs);
                *(u32x2*)(y + (t0 + t) * DM + YC_C + n) = w; }
        }
    }
    __syncthreads();
}

template <bool DIAG> __device__ __forceinline__ void attn_step2(const LAS unsigned char* buf, int kbase, int qrow0, int quad, int fr, const bf16x8 (&qf)[2][2], float (&m)[2], float (&lsum)[2], f32x4 (&oacc)[2][4]) {
    const LAS bf16_t* Kt = (const LAS bf16_t*)buf; const LAS bf16_t* Vt = (const LAS bf16_t*)(buf + 9216); const LAS float* csl = (const LAS float*)(buf + 18432);
    float p[2][4][4];
#pragma unroll
    for (int st = 0; st < 4; ++st) {
        const f32x4 c4 = *(const LAS f32x4*)(csl + st * 16 + quad * 4);
        const bf16x8 kf0 = *(const LAS bf16x8*)(Kt + (st * 16 + fr) * 72 + quad * 8), kf1 = *(const LAS bf16x8*)(Kt + (st * 16 + fr) * 72 + 32 + quad * 8);
#pragma unroll
        for (int qs = 0; qs < 2; ++qs) {
            f32x4 acc = mfma16(kf0, qf[qs][0], c4); acc = mfma16(kf1, qf[qs][1], acc);
#pragma unroll
            for (int r = 0; r < 4; ++r) { float v = acc[r]; if (DIAG && (kbase + st * 16 + quad * 4 + r > qrow0 + qs * 16)) v = -1e30f; p[qs][st][r] = v; }
        }
    }
    bf16x8 pf[2][2]; float alpha[2];
#pragma unroll
    for (int qs = 0; qs < 2; ++qs) {
        float mx = -1e30f;
#pragma unroll
        for (int st = 0; st < 4; ++st)
#pragma unroll
            for (int r = 0; r < 4; ++r) mx = fmaxf(mx, p[qs][st][r]);
        mx = quad_max(mx);
        const float mnew = fmaxf(m[qs], mx); alpha[qs] = __builtin_amdgcn_exp2f(m[qs] - mnew); m[qs] = mnew;
        float ps = 0.f;
#pragma unroll
        for (int st = 0; st < 4; ++st)
#pragma unroll
            for (int r = 0; r < 4; ++r) { const float e = __builtin_amdgcn_exp2f(p[qs][st][r] - mnew); p[qs][st][r] = e; ps += e; }
        lsum[qs] = lsum[qs] * alpha[qs] + ps;
#pragma unroll
        for (int ks = 0; ks < 2; ++ks) { u32x4 w; w.x = pk2(p[qs][2 * ks][0], p[qs][2 * ks][1]); w.y = pk2(p[qs][2 * ks][2], p[qs][2 * ks][3]); w.z = pk2(p[qs][2 * ks + 1][0], p[qs][2 * ks + 1][1]); w.w = pk2(p[qs][2 * ks + 1][2], p[qs][2 * ks + 1][3]); pf[qs][ks] = __builtin_bit_cast(bf16x8, w); }
    }
#pragma unroll
    for (int dt = 0; dt < 4; ++dt) {
        oacc[0][dt] = oacc[0][dt] * alpha[0]; oacc[1][dt] = oacc[1][dt] * alpha[1];
#pragma unroll
        for (int ks = 0; ks < 2; ++ks) {
            const bf16x4 v0 = *(const LAS bf16x4*)(Vt + (dt * 16 + fr) * 72 + ks * 32 + quad * 4), v1 = *(const LAS bf16x4*)(Vt + (dt * 16 + fr) * 72 + ks * 32 + 16 + quad * 4);
            const bf16x8 vf = (bf16x8){v0[0], v0[1], v0[2], v0[3], v1[0], v1[1], v1[2], v1[3]};
            oacc[0][dt] = mfma16(vf, pf[0][ks], oacc[0][dt]); oacc[1][dt] = mfma16(vf, pf[1][ks], oacc[1][dt]);
        }
    }
}
__device__ __forceinline__ void attn_unit(int b, int h, int qb, const Args& a, unsigned char* lds) {
    const bf16_t* z = (const bf16_t*)(ws_() + WS_Z); bf16_t* y = (bf16_t*)(ws_() + WS_Y);
    const float* cs = (const float*)(ws_() + WS_CS); float* ssd = (float*)(ws_() + WS_SSD);
    constexpr int ABUF = 9216 + 9216 + 256;
    LAS unsigned char* lb = (LAS unsigned char*)lds;
    const int tid = opaque_tid(), lane = tid & 63, wid = tid >> 6, fr = lane & 15, quad = lane >> 4, grp = wid >> 2, wq = wid & 3;
    const int q0 = qb * 128, qw = q0 + wq * 32, qrow0 = qw + fr;
    const size_t rb = (size_t)b * SEQ;
    bf16x8 qf[2][2];
    {
        const float SC = 0.125f * LOG2E;
#pragma unroll
        for (int qs = 0; qs < 2; ++qs)
#pragma unroll
            for (int ds = 0; ds < 2; ++ds) { const bf16x8 qv = *(const bf16x8*)(z + (rb + qrow0 + qs * 16) * ZW + ZC_Q + h * 64 + ds * 32 + quad * 8); float t8[8];
#pragma unroll
                for (int e = 0; e < 8; ++e) t8[e] = bfs2f(qv[e]) * SC;
                qf[qs][ds] = pack8(t8); }
    }
    float m[2] = {-1e30f, -1e30f}, lsum[2] = {0.f, 0.f}; f32x4 oacc[2][4];
#pragma unroll
    for (int qs = 0; qs < 2; ++qs)
#pragma unroll
        for (int dt = 0; dt < 4; ++dt) oacc[qs][dt] = (f32x4){0.f, 0.f, 0.f, 0.f};
    float qbnd[2];
    {
        float kv = (lane <= qb) ? ((const float*)(ws_() + WS_KMAX))[(b * NCH + lane) * 4 + h] : 0.f;
        kv = wave_max(kv);
        const float kmax = __builtin_amdgcn_sqrtf(kv) * 1.01f + 1e-3f;
#pragma unroll
        for (int qs = 0; qs < 2; ++qs) { float q2 = 0.f;
#pragma unroll
            for (int ds = 0; ds < 2; ++ds)
#pragma unroll
                for (int e = 0; e < 8; ++e) { const float f = bfs2f(qf[qs][ds][e]); q2 += f * f; }
            q2 = quad_sum(q2); qbnd[qs] = (__builtin_amdgcn_sqrtf(q2) * 1.01f + 1e-3f) * kmax; }
    }
    const int NSS = qb + 1;
    volatile LAS unsigned* vote = (volatile LAS unsigned*)(lds + LDS_BYTES - 64);
    if (tid < 3) vote[tid] = 0u;
    bf16x8 kreg[2], vreg[2]; float creg = 0.f;
#define ATT_LOAD(S) do { const size_t kb_ = rb + (size_t)(S) * 128; \
        _Pragma("unroll") for (int p_ = 0; p_ < 2; ++p_) { const int id_ = tid + 512 * p_; \
            kreg[p_] = *(const bf16x8*)(z + (kb_ + (id_ >> 3)) * ZW + ZC_K + h * 64 + (id_ & 7) * 8); \
            vreg[p_] = *(const bf16x8*)(z + (kb_ + 2 * (tid & 63) + p_) * ZW + ZC_V + h * 64 + (tid >> 6) * 8); } \
        if (tid < 128) creg = cs[(kb_ + tid) * 4 + h]; } while (0)
#define ATT_STORE(S) do { LAS unsigned char* bb_ = lb + ((S) & 1) * (2 * ABUF); \
        _Pragma("unroll") for (int p_ = 0; p_ < 2; ++p_) { const int id_ = tid + 512 * p_; const int k128_ = id_ >> 3; \
            *(LAS bf16x8*)((LAS bf16_t*)(bb_ + (k128_ >> 6) * ABUF) + (k128_ & 63) * 72 + (id_ & 7) * 8) = kreg[p_]; } \
        { LAS unsigned* vt_ = (LAS unsigned*)(bb_ + ((tid & 63) >> 5) * ABUF + 9216);     \
            _Pragma("unroll") for (int e_ = 0; e_ < 8; ++e_) vt_[(((tid >> 6) * 8 + e_) * 72 + ((2 * (tid & 63)) & 63)) >> 1] = (unsigned)(unsigned short)vreg[0][e_] | ((unsigned)(unsigned short)vreg[1][e_] << 16); } \
        if (tid < 128) ((LAS float*)(bb_ + (tid >> 6) * ABUF + 18432))[tid & 63] = -creg; } while (0)
    ATT_LOAD(NSS - 1); ATT_STORE(NSS - 1);
    if (NSS > 1) ATT_LOAD(NSS - 2);
    __syncthreads();
    int kstep = 0;
    for (int S = NSS - 1; S >= 0; --S) {
        if (S >= 1) ATT_STORE(S - 1);
        if (S >= 2) ATT_LOAD(S - 2);
        float cl = 0.f; if (S >= 1) cl = cs[(rb + (size_t)(S - 1) * 128 + 127) * 4 + h];
        const int kbase = S * 128 + grp * 64;
        const LAS unsigned char* hb = lb + (S & 1) * (2 * ABUF) + grp * ABUF;
        if (S + 1 < NSS) attn_step2<false>(hb, kbase, qrow0, quad, fr, qf, m, lsum, oacc);
        else if (kbase <= qw + 31) attn_step2<true>(hb, kbase, qrow0, quad, fr, qf, m, lsum, oacc);
        const bool need = (S >= 1) && ((qbnd[0] - cl - m[0] >= -160.f) || (qbnd[1] - cl - m[1] >= -160.f));
        const int vw = kstep % 3;
        if (need) vote[vw] = 1u;
        __syncthreads();
        const unsigned go = vote[vw];
        if (tid == 0) vote[(kstep + 2) % 3] = 0u;
        ++kstep;
        if (!go) break;
    }
#undef ATT_LOAD
#undef ATT_STORE
    LAS float* mg = (LAS float*)lb;
    const int ml = wq * 64 + lane;
    if (grp == 1) {
#pragma unroll
        for (int qs = 0; qs < 2; ++qs) { mg[(qs * 18 + 0) * 256 + ml] = m[qs]; mg[(qs * 18 + 1) * 256 + ml] = lsum[qs];
#pragma unroll
            for (int dt = 0; dt < 4; ++dt)
#pragma unroll
                for (int r = 0; r < 4; ++r) mg[(qs * 18 + 2 + dt * 4 + r) * 256 + ml] = oacc[qs][dt][r]; }
    }
    __syncthreads();
    if (grp == 0) {
#pragma unroll
        for (int qs = 0; qs < 2; ++qs) {
            const float m1 = mg[(qs * 18 + 0) * 256 + ml], l1 = mg[(qs * 18 + 1) * 256 + ml];
            const float mt = fmaxf(m[qs], m1), f0 = __builtin_amdgcn_exp2f(m[qs] - mt), f1 = __builtin_amdgcn_exp2f(m1 - mt);
            float lt = quad_sum(lsum[qs] * f0 + l1 * f1);
            const float inv = 1.0f / lt; float ss = 0.f;
            const size_t tq = rb + qrow0 + qs * 16;
#pragma unroll
            for (int dt = 0; dt < 4; ++dt) { f32x4 o;
#pragma unroll
                for (int r = 0; r < 4; ++r) { o[r] = (oacc[qs][dt][r] * f0 + mg[(qs * 18 + 2 + dt * 4 + r) * 256 + ml] * f1) * inv; ss += o[r] * o[r]; }
                u32x2 w; w.x = pk2(o[0], o[1]); w.y = pk2(o[2], o[3]); *(u32x2*)(y + tq * DM + YC_D + h * 64 + dt * 16 + quad * 4) = w; }
            ss = quad_sum(ss);
            if (quad == 0) ssd[tq * 4 + h] = ss;
        }
    }
    __syncthreads();
}

#define XB_TMO      128
#define XB_XCNT(j)  (256  + 64 * (j))
#define XB_XSUB(j)  (1280 + 64 * (j))
#define XB_XGEN(j)  (2304 + 64 * (j))
#define XB_TOP      3328
#define XB_TOPGEN   3392
#define XCD_BAR_WORDS 3456
#define XB_SPIN_CAP (1u << 18)

__device__ __forceinline__ unsigned xb_ld(unsigned* p)              { return __hip_atomic_load(p, __ATOMIC_RELAXED, __HIP_MEMORY_SCOPE_AGENT); }
__device__ __forceinline__ unsigned xb_add(unsigned* p, unsigned v) { return __hip_atomic_fetch_add(p, v, __ATOMIC_RELAXED, __HIP_MEMORY_SCOPE_AGENT); }
__device__ __forceinline__ unsigned xb_xcc_id() { return (unsigned)__builtin_amdgcn_s_getreg((3 << 11) | 20) & 0xFu; }
#define XB_SPIN(cond, bar) do { unsigned _sp = 0; while (cond) { __builtin_amdgcn_s_sleep(1); \
    if ((++_sp & 255u) == 0u) { if (xb_ld(&(bar)[XB_TMO])) break; if (_sp > XB_SPIN_CAP) { atomicAdd(&(bar)[XB_TMO], 1u); break; } } } } while (0)

struct XcdBarrier {
    unsigned* bar; unsigned x;
    volatile LAS unsigned* st;
};

__device__ __forceinline__ XcdBarrier xcd_barrier_post(unsigned* bar, volatile LAS unsigned* st) {
    XcdBarrier b; b.bar = bar; b.x = xb_xcc_id(); b.st = st;
    if (opaque_tid() == 0) (void)xb_add(&bar[XB_XCNT(b.x)], 1u);
    return b;
}
__device__ __forceinline__ void xcd_barrier_complete(unsigned* bar, unsigned x, unsigned& nloc, unsigned& nx) {
    const unsigned G = gridDim.x * gridDim.y * gridDim.z;
    unsigned sum, cnt, mine, sp = 0u;
    for (;;) {
        sum = 0u; cnt = 0u; mine = 0u;
#pragma unroll
        for (unsigned j = 0; j < 16; ++j) { const unsigned c = xb_ld(&bar[XB_XCNT(j)]); sum += c; cnt += (c > 0u) ? 1u : 0u; mine = (j == x) ? c : mine; }
        if (sum == G) break;
        __builtin_amdgcn_s_sleep(1);
        if ((++sp & 255u) == 0u) { if (xb_ld(&bar[XB_TMO])) break; if (sp > XB_SPIN_CAP) { atomicAdd(&bar[XB_TMO], 1u); break; } }
    }
    nloc = mine > 0u ? mine : 1u; nx = cnt > 0u ? cnt : 1u;
}

__device__ __forceinline__ void xcd_barrier(const XcdBarrier& b) {
    asm volatile("s_waitcnt vmcnt(0)" ::: "memory");
    __syncthreads();
    if (opaque_tid() == 0) {
        unsigned* bar = b.bar;
        __builtin_amdgcn_s_waitcnt(0);
        unsigned nloc = b.st[0], nx = b.st[1];
        if (nloc == 0u) { xcd_barrier_complete(bar, b.x, nloc, nx); b.st[0] = nloc; b.st[1] = nx; }
        const unsigned old = xb_add(&bar[XB_XSUB(b.x)], 1u);
        const unsigned gen = old / nloc;
        if (old + 1u == (gen + 1u) * nloc) {
            __builtin_amdgcn_fence(__ATOMIC_RELEASE, "agent");
            asm volatile("s_waitcnt vmcnt(0)" ::: "memory");
            const unsigned og = xb_add(&bar[XB_TOP], 1u);
            const unsigned tg = og / nx;
            if (og + 1u == (tg + 1u) * nx) xb_add(&bar[XB_TOPGEN], 1u);
            else XB_SPIN(xb_ld(&bar[XB_TOPGEN]) == tg, bar);
            __builtin_amdgcn_fence(__ATOMIC_ACQUIRE, "agent");
            xb_add(&bar[XB_XGEN(b.x)], 1u);
            asm volatile("s_waitcnt vmcnt(0)" ::: "memory");
        } else {
            XB_SPIN(xb_ld(&bar[XB_XGEN(b.x)]) == gen, bar);
            __builtin_amdgcn_fence(__ATOMIC_ACQUIRE, "agent");
            asm volatile("s_waitcnt vmcnt(0)" ::: "memory");
        }
    }
    __syncthreads();
}

#ifndef WGM_G1
#define WGM_G1 2
#endif
#ifndef WGM_G2
#define WGM_G2 4
#endif
#ifndef WGM_G3
#define WGM_G3 4
#endif
#ifndef WGM_G4
#define WGM_G4 8
#endif
#ifndef PROBE_DUP
#define PROBE_DUP 0
#endif
#ifndef ITEM_MASK
#define ITEM_MASK 127
#endif
__global__ void __launch_bounds__(NTHR, 2) fwd_kernel(Args a) {
    extern __shared__ __attribute__((aligned(16))) unsigned char lds[];
    {
        volatile LAS unsigned* bst0 = (volatile LAS unsigned*)(lds + LDS_BYTES - 16);
        if (opaque_tid() == 0) { bst0[0] = 0u; bst0[1] = 0u; }
        __syncthreads();
        (void)xcd_barrier_post((unsigned*)(ws_() + WS_BAR), bst0);
    }
    if (PH_HI > 4096) cg::this_grid().sync();
#define SEAM(k) do { if ((k) + 1 < PH_HI) { XcdBarrier xb_; xb_.bar = (unsigned*)(ws_() + WS_BAR); xb_.x = xb_xcc_id(); xb_.st = (volatile LAS unsigned*)(lds + LDS_BYTES - 16); xcd_barrier(xb_); if (PROBE_DUP == 1) xcd_barrier(xb_); } } while (0)
#define IN(k) (PH_LO <= (k) && (k) < PH_HI)
    if (IN(0)) { prep_phase(a, lds); if (PROBE_DUP == 4) prep_phase(a, lds); SEAM(0); }
    for (int l = 0; l < DEPTH; ++l) {
        const int pb = 1 + 8 * l;
        if (l == 0 && IN(pb + 0)) {
            norm_phase<false, 1>(INP(0), nullptr, (bf16_t*)(ws_() + WS_H), (float*)(ws_() + WS_SS2), nullptr, (const float*)(ws_() + WS_WF), INP(23), (float*)(ws_() + WS_LOGF));
            SEAM(pb + 0);
        }
        if (IN(pb + 1)) {
            pg8::Gemm g{(const pg8::bf16_t*)(ws_() + WS_H), (const pg8::bf16_t*)(ws_() + WS_WIN) + (size_t)l * ZW * DM, T, ZW, DM}; pg8::StaticOrder S; S.init(T, ZW, grid_(), bid_(), WGM_G1);
            EpiStoreBf16<0, true> E{(bf16_t*)(ws_() + WS_Z), ZW, (const float*)(ws_() + WS_SS2)};
            pg8::gemm_phase<EpiStoreBf16<0, true>, pg8::StaticOrder, true, true>((PG8_LAS unsigned char*)lds, g, S, E);
            if (PROBE_DUP == 9) pg8::gemm_phase<EpiStoreBf16<0, true>, pg8::StaticOrder, true, true>((PG8_LAS unsigned char*)lds, g, S, E);
            if (l > 0) norm_phase<true, 1>(ws_() + WS_H, nullptr, nullptr, nullptr, nullptr, (const float*)(ws_() + WS_WF) + (size_t)l * DM * 4, INP(23) + l * 4, (float*)(ws_() + WS_LOGF));
            SEAM(pb + 1);
        }
        if (IN(pb + 2)) {
            for (int rep = 0; rep < (PROBE_DUP == 2 ? 2 : 1); ++rep)
            for (int it = bid_(); it < 260; it += grid_()) {
                if (it < 128) { if (ITEM_MASK & 1) s5_item<1>(l, it >> 5, it & 31, a, lds); }
                else if (it < 256) { if (ITEM_MASK & 4) lru_item<1>(l, (it - 128) >> 5, (it - 128) & 31, a, lds); }
                else { if (ITEM_MASK & 8) cumsum_item(it - 256, (const float*)(ws_() + WS_LOGF), (float*)(ws_() + WS_CS), lds); }
            }
            SEAM(pb + 2);
        }
        if (IN(pb + 3)) {
            for (int rep = 0; rep < (PROBE_DUP == 3 ? 2 : 1); ++rep) {
            for (int rep2 = 0; rep2 < (PROBE_DUP == 5 ? 2 : 1); ++rep2)
            for (int up = bid_(); up < 256; up += grid_()) {
                const int xcd_ = up & 7, ix_ = up >> 3, pr = xcd_ + 8 * (ix_ >> 4), j = ix_ & 15;
                if (ITEM_MASK & 16) { attn_unit(pr >> 2, pr & 3, 31 - j, a, lds);
                attn_unit(pr >> 2, pr & 3, j, a, lds); }
            }
            for (int rep3 = 0; rep3 < (PROBE_DUP == 6 ? 2 : 1); ++rep3)
            for (int it = bid_(); it < 256; it += grid_()) {
                if (it < 128) { if (ITEM_MASK & 32) s5_item<2>(l, it >> 5, it & 31, a, lds); }
                else { if (ITEM_MASK & 64) lru_item<2>(l, (it - 128) >> 5, (it - 128) & 31, a, lds); }
            }
            if (ITEM_MASK & 2) {
                unsigned* qctr = (unsigned*)(ws_() + WS_BAR) + 3600 + l;
                volatile LAS unsigned* qslot = (volatile LAS unsigned*)(lds + LDS_BYTES - 48);
                for (;;) {
                    __syncthreads();
                    if (opaque_tid() == 0) qslot[0] = __hip_atomic_fetch_add(qctr, 1u, __ATOMIC_RELAXED, __HIP_MEMORY_SCOPE_AGENT);
                    __syncthreads();
                    const unsigned qi = qslot[0];
                    if (qi >= 256u) break;
                    if (qi < 128u) sgu_item<1>(l, (int)(qi >> 5), (int)(qi & 31), a, lds);
                    else sgu_item<0>(l, (int)((qi - 128u) >> 5), (int)(qi & 31), a, lds);
                }
            }
            }
            SEAM(pb + 3);
        }
        if (IN(pb + 4)) {
            pg8::Gemm g{(const pg8::bf16_t*)(ws_() + WS_Y), (const pg8::bf16_t*)(ws_() + WS_WOUT) + (size_t)l * DM * DM, T, DM, DM}; pg8::StaticOrder S; S.init(T, DM, grid_(), bid_(), WGM_G2);
            EpiRes<true, true> E{(bf16_t*)(ws_() + WS_H), DM, (const float*)(ws_() + WS_SSD), (float*)(ws_() + WS_SS2)};
            pg8::gemm_phase<EpiRes<true, true>, pg8::StaticOrder, true, true>((PG8_LAS unsigned char*)lds, g, S, E);
            SEAM(pb + 4);
        }
        if (IN(pb + 6)) {
            pg8::Gemm g{(const pg8::bf16_t*)(ws_() + WS_H), (const pg8::bf16_t*)(ws_() + WS_WMI) + (size_t)l * DFF * DM, T, DFF, DM}; pg8::StaticOrder S; S.init(T, DFF, grid_(), bid_(), WGM_G3);
            EpiStoreBf16<1, true> E{(bf16_t*)(ws_() + WS_ACT), DFF, (const float*)(ws_() + WS_SS2)};
            pg8::gemm_phase<EpiStoreBf16<1, true>, pg8::StaticOrder, true, true>((PG8_LAS unsigned char*)lds, g, S, E);
            SEAM(pb + 6);
        }
        if (IN(pb + 7)) {
            pg8::Gemm g{(const pg8::bf16_t*)(ws_() + WS_ACT), (const pg8::bf16_t*)(ws_() + WS_WMO) + (size_t)l * DM * DFF, T, DM, DFF}; pg8::StaticOrder S; S.init(T, DM, grid_(), bid_(), WGM_G4);
            EpiRes<false, true> E{(bf16_t*)(ws_() + WS_H), DM, nullptr, (float*)(ws_() + WS_SS2)};
            pg8::gemm_phase<EpiRes<false, true>, pg8::StaticOrder, true, true>((PG8_LAS unsigned char*)lds, g, S, E);
            SEAM(pb + 7);
        }
    }
    if (IN(33)) norm_phase<true, 2>(ws_() + WS_H, INP(29), nullptr, nullptr, out_(), nullptr, nullptr, nullptr);
#undef SEAM
#undef IN
}


#ifndef DUMP_SEL
#define DUMP_SEL 0
#endif
#ifndef DUMP_LAST
#define DUMP_LAST 33
#endif
__global__ void dump_kernel(const unsigned char* ws, float* out) {
    const size_t i = (size_t)blockIdx.x * blockDim.x + threadIdx.x;
    const size_t t = i >> 10, c = i & 1023;
    float v = 0.f;
    if (DUMP_SEL == 1) v = bf2f(((const bf16_t*)(ws + WS_H))[i]);
    if (DUMP_SEL == 2) v = bf2f(((const bf16_t*)(ws + WS_Z))[t * ZW + c]) + bf2f(((const bf16_t*)(ws + WS_Z))[t * ZW + c + 1024]);
    if (DUMP_SEL == 3) v = bf2f(((const bf16_t*)(ws + WS_Y))[i]);
    if (DUMP_SEL == 5) v = ((const float*)(ws + WS_SSD))[(t * 4 + (c & 3))] + ((const float*)(ws + WS_CS))[(t * 4 + (c & 3))];
    if (DUMP_SEL == 7) v = ((const float*)(ws + WS_ELOC))[i & 262143];
    if (DUMP_SEL == 8) v = ((const float*)(ws + WS_LA))[i & 32767] + ((const float*)(ws + WS_LB))[i & 32767];
    if (DUMP_SEL == 6) v = bf2f(((const bf16_t*)(ws + WS_WIN))[i]) + bf2f(((const bf16_t*)(ws + WS_WMI))[i]) + bf2f(((const bf16_t*)(ws + WS_WMO))[i]) + bf2f(((const bf16_t*)(ws + WS_WOUT))[i & 0x3fffff]);
    out[i] = v;
}
#ifndef N_LAUNCH_MODE
#define N_LAUNCH_MODE 1
#endif
extern "C" void kernel_launch(void* const* d_in, const int* in_sizes, int n_in, void* d_out, int out_size, void* d_ws, size_t ws_size, hipStream_t stream) {
    static int grid = 0;
    if (grid == 0) {
        if (n_in != 30 || out_size != T * DM || ws_size < WS_END) { fprintf(stderr, "kernel_launch: unexpected shapes (n_in %d, out %d, ws %zu, need %zu)\n", n_in, out_size, ws_size, (size_t)WS_END); grid = -1; return; }
        int dev = 0, cus = 0, per_cu = 0;
        hipGetDevice(&dev); hipDeviceGetAttribute(&cus, hipDeviceAttributeMultiprocessorCount, dev);
        if (hipFuncSetAttribute((const void*)fwd_kernel, hipFuncAttributeMaxDynamicSharedMemorySize, LDS_BYTES) != hipSuccess) { fprintf(stderr, "kernel_launch: hipFuncSetAttribute failed\n"); grid = -1; return; }
        if (hipOccupancyMaxActiveBlocksPerMultiprocessor(&per_cu, (const void*)fwd_kernel, NTHR, LDS_BYTES) != hipSuccess || per_cu < 1) { fprintf(stderr, "kernel_launch: occupancy query says %d\n", per_cu); per_cu = 1; }
        (void)hipGetLastError();
        grid = cus;
        if (grid > 256) grid = 256;
    }
    if (grid < 0) return;
    Args a{};
    for (int i = 0; i < 30; ++i) a.in[i] = (const float*)d_in[i];
    a.out = (float*)d_out; a.ws = (unsigned char*)d_ws;
    if (N_LAUNCH_MODE == 1) {
        a.ph_lo = 0; a.ph_hi = 34;
        if (hipMemsetAsync((unsigned char*)d_ws + WS_BAR, 0, 16 * 1024, stream) != hipSuccess) { fprintf(stderr, "kernel_launch: memset of the barrier words failed\n"); return; }
        void* args[] = {&a};
        hipError_t e = hipLaunchCooperativeKernel((const void*)fwd_kernel, dim3(grid), dim3(NTHR), args, LDS_BYTES, stream);
        if (e != hipSuccess) fprintf(stderr, "kernel_launch: cooperative launch failed: %s (grid %d)\n", hipGetErrorString(e), grid);
    } else {
        for (int ph = 0; ph <= DUMP_LAST; ++ph) { a.ph_lo = ph; a.ph_hi = ph + 1; hipLaunchKernelGGL(fwd_kernel, dim3(grid), dim3(NTHR), LDS_BYTES, stream, a); }
        if (DUMP_SEL != 0 && DUMP_SEL != 4) hipLaunchKernelGGL(dump_kernel, dim3(T * DM / 256), dim3(256), 0, stream, (const unsigned char*)d_ws, (float*)d_out);
    }
}
```

```cpp
#include <hip/hip_runtime.h>
#include <hip/hip_cooperative_groups.h>
#include <cstdio>
#include <cstdint>
namespace cg = cooperative_groups;
__device__ __forceinline__ int opaque_tid() { int t = __builtin_amdgcn_workitem_id_x(); asm volatile("" : "+v"(t)); return t; }
namespace pg8 {
#define PG8_LAS __attribute__((address_space(3)))
typedef unsigned short bf16_t;
typedef short bf16x8 __attribute__((ext_vector_type(8)));
typedef float f32x4 __attribute__((ext_vector_type(4)));
typedef unsigned u32x4 __attribute__((ext_vector_type(4)));
constexpr int BM = 256, BK = 64, HALF = 128, HTB = HALF * BK * 2  , STAGE_BYTES = 8 * HTB, NXCD = 8, WGM = 4;

__host__ __device__ __forceinline__ int lds_byte(int r, int c) { const int st = (r >> 4) * 2 + (c >> 5), rr = r & 15, cc = c & 31, ob = rr * 64 + cc * 2; return st * 1024 + (ob ^ (((ob >> 9) & 1) << 5)); }
__host__ __device__ __forceinline__ void stage_rc(int b, int& R, int& C) { const int st = b / 1024, sb = b % 1024, swz = sb ^ (((sb >> 9) & 1) << 5); R = (st >> 1) * 16 + swz / 64; C = (st & 1) * 32 + (swz % 64) / 2; }
__host__ __device__ __forceinline__ int perm32(int rho) { const int n = rho >> 4, i = rho & 15; return 8 * (i >> 2) + 4 * n + (i & 3); }

struct Unit { int pm, pn; };
struct Gemm { const bf16_t* A; const bf16_t* Bt; int M, N, K; };

struct StaticOrder {
    int nM, nN, nwg, G, c, wgm;
    __host__ __device__ void init(int M, int N, int G_, int c_, int wgm_ = WGM) { nM = M / BM; nN = N / BM; nwg = nM * nN; G = G_; c = c_; wgm = wgm_; }
    __host__ __device__ bool next(int i, Unit& u) const {
        const long L = (long)i * G + c; if (L >= nwg) return false;
        int wgid = (int)L; { const int q = nwg / NXCD, r = nwg % NXCD, xcd = wgid % NXCD, off = wgid / NXCD; wgid = (xcd < r ? xcd * (q + 1) : r * (q + 1) + (xcd - r) * q) + off; }
        const int nig = wgm * nN, gid = wgid / nig, fm = gid * wgm, gsz = (nM - fm) < wgm ? (nM - fm) : wgm;
        u.pm = fm + ((wgid % nig) % gsz); u.pn = (wgid % nig) / gsz; return true;
    }
    __device__ __forceinline__ void a_ready(const Unit&) const {}
    __device__ __forceinline__ void done(const Unit&) const {}
};

__device__ __forceinline__ unsigned cvt_pk_bf16(float lo, float hi) { unsigned r; asm volatile("v_cvt_pk_bf16_f32 %0, %1, %2" : "=v"(r) : "v"(lo), "v"(hi)); return r; }
template <class Epi, class Sched, bool ALIGN_EPI = false, bool SP2 = false>
__device__ __forceinline__ void gemm_phase(PG8_LAS unsigned char* lds, const Gemm g, const Sched& S, const Epi& E) {
    const int tid = opaque_tid(), wid = __builtin_amdgcn_readfirstlane(tid >> 6), lane = tid & 63, wr = wid >> 2, wc = wid & 3, fr = lane & 15, fq = lane >> 4;
    const int K = g.K, nt = K / BK;
    unsigned voffA[2], voffB[2];
#pragma unroll
    for (int i = 0; i < 2; ++i) { int R, C; stage_rc(tid * 16 + i * 8192, R, C); const int Rb = Epi::PERM ? ((R & ~31) + perm32(R & 31)) : R;
        voffA[i] = (unsigned)(R * K + C) * 2u; voffB[i] = (unsigned)(Rb * K + C) * 2u; }
    const size_t kstep = (size_t)(BK * 2);
    const size_t hstep = (size_t)HALF * K * 2;
    const size_t tstep = 2 * hstep;
    const unsigned ldsw = (unsigned)wid * 1024u;
    const int aoff = lds_byte(wr * 64 + fr, fq * 8), boff = lds_byte(wc * 32 + fr, fq * 8);
#define PG8_SA(b, h) (((b) * 2 + (h)) * HTB)
#define PG8_SB(b, h) ((4 + (b) * 2 + (h)) * HTB)
#define PG8_STAGE(bufoff, gbase, voff) do { _Pragma("unroll") for (int _i = 0; _i < 2; ++_i) \
        __builtin_amdgcn_global_load_lds((const unsigned*)((const char*)(gbase) + (voff)[_i]), (PG8_LAS unsigned*)(lds + (bufoff) + ldsw + _i * 8192), 16, 0, 0); } while (0)
#define PG8_LDA(dst, b, h) do { _Pragma("unroll") for (int m = 0; m < 4; ++m) _Pragma("unroll") for (int k = 0; k < 2; ++k) dst[m][k] = *(const PG8_LAS bf16x8*)(lds + PG8_SA(b, h) + aoff + m * 2048 + k * 1024); } while (0)
#define PG8_LDB(dst, b, h) do { _Pragma("unroll") for (int n = 0; n < 2; ++n) _Pragma("unroll") for (int k = 0; k < 2; ++k) dst[n][k] = *(const PG8_LAS bf16x8*)(lds + PG8_SB(b, h) + boff + n * 2048 + k * 1024); } while (0)
#define PG8_MMA(ai, bj, At, Bt) do { __builtin_amdgcn_s_setprio(1); _Pragma("unroll") for (int m = 0; m < 4; ++m) _Pragma("unroll") for (int n = 0; n < 2; ++n) _Pragma("unroll") for (int k = 0; k < 2; ++k) \
        acc[ai][bj][m][n] = __builtin_amdgcn_mfma_f32_16x16x32_bf16(Bt[n][k], At[m][k], acc[ai][bj][m][n], 0, 0, 0); __builtin_amdgcn_s_setprio(0); } while (0)
#define PG8_WAIT_V(n) asm volatile("s_waitcnt vmcnt(" #n ")" ::: "memory")
#define PG8_WAIT_L(n) asm volatile("s_waitcnt lgkmcnt(" #n ")" ::: "memory")
#define PG8_BAR __builtin_amdgcn_s_barrier()
#define PG8_SCHED __builtin_amdgcn_sched_barrier(0)
    Unit cur, nxt; int ui = 0;
    if (!S.next(0, cur)) return;
    if constexpr (Epi::KPREP) { Unit pu; for (int i = 0; i < 12 && S.next(i, pu); ++i) E.kprep(pu, lds + STAGE_BYTES + i * 1024, tid); }
    f32x4 acc[2][2][4][2];
#pragma unroll
    for (int a = 0; a < 2; ++a)
#pragma unroll
        for (int b = 0; b < 2; ++b)
#pragma unroll
            for (int m = 0; m < 4; ++m)
#pragma unroll
                for (int n = 0; n < 2; ++n) acc[a][b][m][n] = (f32x4){0.f, 0.f, 0.f, 0.f};
    bf16x8 At[4][2], B0[2][2], B1[2][2];
    const char* cA = (const char*)g.A + (size_t)cur.pm * tstep; const char* cB = (const char*)g.Bt + (size_t)cur.pn * tstep;
    S.a_ready(cur);
    if constexpr (SP2) {
        PG8_STAGE(PG8_SB(0, 0), cB, voffB); PG8_STAGE(PG8_SB(0, 1), cB + hstep, voffB); PG8_STAGE(PG8_SA(0, 0), cA, voffA); PG8_STAGE(PG8_SA(0, 1), cA + hstep, voffA);
        if (wr == 1) PG8_BAR;
        PG8_WAIT_V(2); PG8_BAR;
        PG8_STAGE(PG8_SB(1, 0), cB + kstep, voffB); PG8_STAGE(PG8_SA(1, 0), cA + kstep, voffA); PG8_STAGE(PG8_SB(1, 1), cB + hstep + kstep, voffB);
        PG8_WAIT_V(6); PG8_BAR;
    } else {
        PG8_STAGE(PG8_SB(0, 0), cB, voffB); PG8_STAGE(PG8_SA(0, 0), cA, voffA); PG8_STAGE(PG8_SB(0, 1), cB + hstep, voffB); PG8_STAGE(PG8_SA(0, 1), cA + hstep, voffA);
        if (wr == 1) PG8_BAR;
        PG8_WAIT_V(4); PG8_BAR;
        PG8_STAGE(PG8_SB(1, 0), cB + kstep, voffB); PG8_STAGE(PG8_SA(1, 0), cA + kstep, voffA); PG8_STAGE(PG8_SB(1, 1), cB + hstep + kstep, voffB);
        PG8_WAIT_V(6); PG8_BAR;
    }
    for (;;) {
        const bool has_next = S.next(ui + 1, nxt);
        const char* nA = has_next ? (const char*)g.A + (size_t)nxt.pm * tstep : cA; const char* nB = has_next ? (const char*)g.Bt + (size_t)nxt.pn * tstep : cB;
        for (int t = 0; t < nt; t += 2) {
            const bool last = (t == nt - 2);
            const char* a1 = cA + (size_t)(t + 1) * kstep;
            const char* a2 = last ? nA : cA + (size_t)(t + 2) * kstep; const char* b2 = last ? nB : cB + (size_t)(t + 2) * kstep;
            const char* a3 = a2 + kstep; const char* b3 = b2 + kstep;
            if (last && has_next) S.a_ready(nxt);
            if constexpr (SP2) {
            PG8_LDB(B0, 0, 0); PG8_LDB(B1, 0, 1); PG8_SCHED; PG8_LDA(At, 0, 0); PG8_STAGE(PG8_SA(1, 1), a1 + hstep, voffA);
            PG8_WAIT_V(8); PG8_WAIT_L(0); PG8_BAR; PG8_MMA(0, 0, At, B0); PG8_MMA(0, 1, At, B1); PG8_BAR; PG8_SCHED;
            PG8_LDA(At, 0, 1); PG8_STAGE(PG8_SB(0, 0), b2, voffB); PG8_STAGE(PG8_SB(0, 1), b2 + hstep, voffB); PG8_STAGE(PG8_SA(0, 0), a2, voffA);
            PG8_WAIT_V(8); PG8_WAIT_L(0); PG8_BAR; PG8_MMA(1, 0, At, B0); PG8_MMA(1, 1, At, B1); PG8_BAR; PG8_SCHED;
            PG8_LDB(B0, 1, 0); PG8_LDB(B1, 1, 1); PG8_SCHED; PG8_LDA(At, 1, 0); PG8_STAGE(PG8_SA(0, 1), a2 + hstep, voffA);
            PG8_WAIT_V(8); PG8_WAIT_L(0); PG8_BAR; PG8_MMA(0, 0, At, B0); PG8_MMA(0, 1, At, B1); PG8_BAR; PG8_SCHED;
            PG8_LDA(At, 1, 1); PG8_STAGE(PG8_SB(1, 0), b3, voffB); PG8_STAGE(PG8_SB(1, 1), b3 + hstep, voffB); PG8_STAGE(PG8_SA(1, 0), a3, voffA);
            PG8_WAIT_V(8); PG8_WAIT_L(0); PG8_BAR; PG8_MMA(1, 0, At, B0); PG8_MMA(1, 1, At, B1); PG8_BAR; PG8_SCHED;
            } else {
            PG8_LDB(B0, 0, 0); PG8_SCHED; PG8_LDA(At, 0, 0); PG8_STAGE(PG8_SA(1, 1), a1 + hstep, voffA);
            PG8_WAIT_L(8); PG8_BAR; PG8_WAIT_L(0); PG8_MMA(0, 0, At, B0); PG8_BAR; PG8_SCHED;
            PG8_LDB(B1, 0, 1); PG8_STAGE(PG8_SB(0, 0), b2, voffB);
            PG8_BAR; PG8_WAIT_L(0); PG8_MMA(0, 1, At, B1); PG8_BAR;
            PG8_LDA(At, 0, 1); PG8_STAGE(PG8_SA(0, 0), a2, voffA);
            PG8_BAR; PG8_WAIT_L(0); PG8_MMA(1, 0, At, B0); PG8_BAR; PG8_SCHED;
            PG8_STAGE(PG8_SB(0, 1), b2 + hstep, voffB);
            PG8_WAIT_V(6); PG8_BAR; PG8_MMA(1, 1, At, B1); PG8_BAR;
            PG8_LDB(B0, 1, 0); PG8_SCHED; PG8_LDA(At, 1, 0); PG8_STAGE(PG8_SA(0, 1), a2 + hstep, voffA);
            PG8_WAIT_L(8); PG8_BAR; PG8_WAIT_L(0); PG8_MMA(0, 0, At, B0); PG8_BAR; PG8_SCHED;
            PG8_LDB(B1, 1, 1); PG8_STAGE(PG8_SB(1, 0), b3, voffB);
            PG8_BAR; PG8_WAIT_L(0); PG8_MMA(0, 1, At, B1); PG8_BAR;
            PG8_LDA(At, 1, 1); PG8_STAGE(PG8_SA(1, 0), a3, voffA);
            PG8_BAR; PG8_WAIT_L(0); PG8_MMA(1, 0, At, B0); PG8_BAR; PG8_SCHED;
            PG8_STAGE(PG8_SB(1, 1), b3 + hstep, voffB);
            PG8_WAIT_V(6); PG8_BAR; PG8_MMA(1, 1, At, B1); PG8_BAR;
            }
            if constexpr (Epi::KHOOK) { if (t == 2) E.khook(acc, lds + STAGE_BYTES + ui * 1024, wr, fr); }
        }
        if constexpr (ALIGN_EPI) { if (wr == 0) PG8_BAR; }
        if constexpr (!Epi::AFTER_DRAIN) { E(acc, cur, wr, wc, fr, fq, lds + STAGE_BYTES + ui * 1024); S.done(cur); }
        if (!has_next) break;
#pragma unroll
        for (int a = 0; a < 2; ++a)
#pragma unroll
            for (int b = 0; b < 2; ++b)
#pragma unroll
                for (int m = 0; m < 4; ++m)
#pragma unroll
                    for (int n = 0; n < 2; ++n) acc[a][b][m][n] = (f32x4){0.f, 0.f, 0.f, 0.f};
        cur = nxt; cA = nA; cB = nB; ++ui;
        if constexpr (ALIGN_EPI) { if (wr == 1) PG8_BAR; }
    }
    PG8_WAIT_V(0);
    if constexpr (!ALIGN_EPI) { if (wr == 0) PG8_BAR; }
    PG8_BAR;
    if constexpr (Epi::AFTER_DRAIN) { E.fused(acc, cur, wr, wc, fr, fq, lds, wid, lane); S.done(cur); }
#undef PG8_SA
#undef PG8_SB
#undef PG8_STAGE
#undef PG8_LDA
#undef PG8_LDB
#undef PG8_MMA
#undef PG8_WAIT_V
#undef PG8_WAIT_L
#undef PG8_BAR
#undef PG8_SCHED
}
}

#define LAS __attribute__((address_space(3)))
typedef unsigned short bf16_t;
typedef short bf16x8 __attribute__((ext_vector_type(8)));
typedef short bf16x4 __attribute__((ext_vector_type(4)));
typedef float f32x4 __attribute__((ext_vector_type(4)));
typedef float f32x2 __attribute__((ext_vector_type(2)));
typedef unsigned u32x4 __attribute__((ext_vector_type(4)));
typedef unsigned u32x2 __attribute__((ext_vector_type(2)));

constexpr int NB = 4, SEQ = 4096, DM = 1024, DEPTH = 4, T = NB * SEQ, W = 256, DFF = 4096, NIN = 2052, ZW = 2048;
constexpr int NCH = SEQ / 128;
constexpr float EPS = 1e-6f;
constexpr float LOG2E = 1.4426950408889634f;
constexpr int NTHR = 512;
constexpr int LDS_BYTES = 147456;
constexpr int ZC_AU = 0, ZC_AV = 256, ZC_B = 512, ZC_CX = 768, ZC_CG = 1024, ZC_Q = 1280, ZC_K = 1536, ZC_V = 1792;
constexpr int YC_D = 0, YC_A = 256, YC_B = 512, YC_C = 768;

constexpr size_t MiB = 1u << 20;
constexpr size_t WS_WIN = 0, WS_WOUT = 16 * MiB, WS_WMI = 24 * MiB, WS_WMO = 56 * MiB, WS_R = 88 * MiB, WS_Z = WS_R, WS_Y = WS_R + 64 * MiB, WS_ACT = WS_R,
                 WS_H = 216 * MiB, WS_S = 248 * MiB;
constexpr size_t WS_GLUT = WS_S, WS_WAT = WS_GLUT + 512 * 1024, WS_WXT = WS_WAT + 128 * 1024, WS_BBT = WS_WXT + 128 * 1024, WS_CMT = WS_BBT + 256 * 1024,
                 WS_ABAR = WS_CMT + 256 * 1024, WS_A128 = WS_ABAR + 32 * 1024, WS_WF = WS_A128 + 32 * 1024, WS_LOGF = WS_WF + 64 * 1024, WS_CS = WS_LOGF + 256 * 1024,
                 WS_SSD = WS_CS + 256 * 1024, WS_ELOC = WS_SSD + 256 * 1024, WS_LA = WS_ELOC + 1024 * 1024, WS_LB = WS_LA + 128 * 1024, WS_BAR = WS_LB + 128 * 1024, WS_SS2 = WS_BAR + 16 * 1024, WS_KMAX = WS_SS2 + 1024 * 1024, WS_END = WS_KMAX + 4096;

struct Args {
    const float* in[30]; float* out; unsigned char* ws; int ph_lo, ph_hi;
};


typedef const __attribute__((address_space(4))) unsigned long long* kargp_t;
__device__ __forceinline__ unsigned long long karg_(int i) { kargp_t tab = (kargp_t)__builtin_amdgcn_kernarg_segment_ptr(); asm volatile("" : "+s"(tab)); return tab[i]; }
#define INP(i) ((const float*)karg_(i))
__device__ __forceinline__ unsigned char* ws_() { return (unsigned char*)karg_(31); }
__device__ __forceinline__ float* out_() { return (float*)karg_(30); }
#define PH_LO ((int)(unsigned)(karg_(32) & 0xffffffffull))
#define PH_HI ((int)(unsigned)(karg_(32) >> 32))
__device__ __forceinline__ int bid_() { return blockIdx.x; }
__device__ __forceinline__ int grid_() { return gridDim.x; }
__device__ __forceinline__ float bf2f(bf16_t v) { return __uint_as_float((unsigned)v << 16); }
__device__ __forceinline__ float bfs2f(short v) { return __uint_as_float(((unsigned)(unsigned short)v) << 16); }
typedef __bf16 bf16x2_t __attribute__((ext_vector_type(2)));
__device__ __forceinline__ unsigned pk2(float lo, float hi) { const f32x2 v = {lo, hi}; const bf16x2_t b = __builtin_convertvector(v, bf16x2_t); return __builtin_bit_cast(unsigned, b); }
__device__ __forceinline__ bf16_t f2bf(float f) { return (bf16_t)(pk2(f, 0.f) & 0xffffu); }
__device__ __forceinline__ float gelu_t(float x) { const float y2 = (1.5957691216057308f * LOG2E) * (x + 0.044715f * x * x * x); return x * __builtin_amdgcn_rcpf(1.0f + __builtin_amdgcn_exp2f(-y2)); }
__device__ __forceinline__ float sigm(float x) { return __builtin_amdgcn_rcpf(1.0f + __builtin_amdgcn_exp2f(-LOG2E * x)); }
__device__ __forceinline__ float softplus_f(float x) { return fmaxf(x, 0.f) + log1pf(__expf(-fabsf(x))); }
__device__ __forceinline__ f32x4 mfma16(bf16x8 a, bf16x8 b, f32x4 c) { return __builtin_amdgcn_mfma_f32_16x16x32_bf16(a, b, c, 0, 0, 0); }
__device__ __forceinline__ float quad_sum(float v) {
    { const auto r = __builtin_amdgcn_permlane16_swap(__float_as_uint(v), __float_as_uint(v), false, false); v = __uint_as_float(r[0]) + __uint_as_float(r[1]); }
    { const auto r = __builtin_amdgcn_permlane32_swap(__float_as_uint(v), __float_as_uint(v), false, false); v = __uint_as_float(r[0]) + __uint_as_float(r[1]); }
    return v;
}
template <int CTRL> __device__ __forceinline__ float dpp_mov(float x) { return __uint_as_float((unsigned)__builtin_amdgcn_update_dpp(0, (int)__float_as_uint(x), CTRL, 0xf, 0xf, true)); }
__device__ __forceinline__ float wave_sum(float v) {
    v += dpp_mov<0xB1>(v); v += dpp_mov<0x4E>(v); v += dpp_mov<0x141>(v); v += dpp_mov<0x140>(v);
    return quad_sum(v);
}
__device__ __forceinline__ float wave_max(float v);
__device__ __forceinline__ float quad_max(float v) {
    { const auto r = __builtin_amdgcn_permlane16_swap(__float_as_uint(v), __float_as_uint(v), false, false); v = fmaxf(__uint_as_float(r[0]), __uint_as_float(r[1])); }
    { const auto r = __builtin_amdgcn_permlane32_swap(__float_as_uint(v), __float_as_uint(v), false, false); v = fmaxf(__uint_as_float(r[0]), __uint_as_float(r[1])); }
    return v;
}
__device__ __forceinline__ bf16x8 pack8(const float* v) {
    u32x4 w; w.x = pk2(v[0], v[1]); w.y = pk2(v[2], v[3]); w.z = pk2(v[4], v[5]); w.w = pk2(v[6], v[7]); return __builtin_bit_cast(bf16x8, w);
}
__device__ __forceinline__ bf16x8 zero8() { return (bf16x8){0, 0, 0, 0, 0, 0, 0, 0}; }

__device__ __forceinline__ float wave_max(float v) {
    v = fmaxf(v, dpp_mov<0xB1>(v)); v = fmaxf(v, dpp_mov<0x4E>(v)); v = fmaxf(v, dpp_mov<0x141>(v)); v = fmaxf(v, dpp_mov<0x140>(v));
    return quad_max(v);
}
template <int N> __device__ __forceinline__ float dpp_shr(float x, float ident) {
    return __uint_as_float((unsigned)__builtin_amdgcn_update_dpp((int)__float_as_uint(ident), (int)__float_as_uint(x), 0x110 + N, 0xf, 0xf, false));
}
__device__ __forceinline__ float neg_expm1(float x) {
    const float s = -x * (1.0f + x * (0.5f + x * (0.16666667f + x * (0.041666668f + x * (0.0083333338f + x * 0.0013888889f)))));
    const float e = 1.0f - __builtin_amdgcn_exp2f(LOG2E * x);
    return (x > -0.25f) ? s : e;
}
template <int ACT  , bool ROWS = false> struct EpiStoreBf16 {
    static constexpr bool PERM = true, AFTER_DRAIN = false, KHOOK = false, KPREP = ROWS;
    __device__ __forceinline__ void kprep(const pg8::Unit& u, PG8_LAS unsigned char* tab, int tid) const {
        if (tid < 256) { const float* rp = rowss + (size_t)(u.pm * 256 + tid) * 16; const f32x4 s0 = *(const f32x4*)rp, s1 = *(const f32x4*)(rp + 4), s2 = *(const f32x4*)(rp + 8), s3 = *(const f32x4*)(rp + 12);
            const float tot = ((s0[0] + s0[1]) + (s0[2] + s0[3])) + ((s1[0] + s1[1]) + (s1[2] + s1[3])) + ((s2[0] + s2[1]) + (s2[2] + s2[3])) + ((s3[0] + s3[1]) + (s3[2] + s3[3]));
            ((PG8_LAS float*)tab)[tid] = rsqrtf(tot * (1.0f / DM) + EPS); }
    }
    bf16_t* O; int ldc; const float* rowss;
    __device__ __forceinline__ void operator()(const pg8::f32x4 (&acc)[2][2][4][2], const pg8::Unit& u, int wr, int wc, int fr, int fq, PG8_LAS unsigned char* tab) const {
        const int row0 = u.pm * 256 + wr * 64 + fr, col0 = u.pn * 256 + wc * 32 + 8 * fq;
#pragma unroll
        for (int ai = 0; ai < 2; ++ai)
#pragma unroll
            for (int m = 0; m < 4; ++m) { bf16_t* rowp = O + (size_t)(row0 + ai * 128 + m * 16) * ldc + col0;
                const float rsc = ROWS ? ((const PG8_LAS float*)tab)[wr * 64 + fr + ai * 128 + m * 16] : 1.0f;
#pragma unroll
                for (int bj = 0; bj < 2; ++bj) { pg8::f32x4 v0 = acc[ai][bj][m][0] * rsc, v1 = acc[ai][bj][m][1] * rsc;
                    if (ACT == 1) {
#pragma unroll
                        for (int e = 0; e < 4; ++e) { const float a = fmaxf(v0[e], 0.f), b = fmaxf(v1[e], 0.f); v0[e] = a * a; v1[e] = b * b; } }
                    u32x4 w; w.x = pk2(v0[0], v0[1]); w.y = pk2(v0[2], v0[3]); w.z = pk2(v1[0], v1[1]); w.w = pk2(v1[2], v1[3]);
                    *(u32x4*)(rowp + bj * 128) = w; } }
    }
};
template <bool HOOK, bool NORMOUT> struct EpiRes {
    static constexpr bool PERM = true, AFTER_DRAIN = false, KHOOK = HOOK, KPREP = HOOK;
    bf16_t* xb; int ldc; const float* ssd; float* ss2;
    __device__ __forceinline__ void operator()(const pg8::f32x4 (&acc)[2][2][4][2], const pg8::Unit& u, int wr, int wc, int fr, int fq, PG8_LAS unsigned char* tab) const {
        const int col0 = u.pn * 256 + wc * 32 + 8 * fq;
#pragma unroll
        for (int ai = 0; ai < 2; ++ai)
#pragma unroll
            for (int m = 0; m < 4; ++m) { const int row = u.pm * 256 + ai * 128 + wr * 64 + m * 16 + fr; bf16_t* rowp = xb + (size_t)row * ldc + col0; float sq = 0.f;
#pragma unroll
                for (int bj = 0; bj < 2; ++bj) { const bf16x8 s = *(const bf16x8*)(rowp + bj * 128); float o[8];
#pragma unroll
                    for (int e = 0; e < 4; ++e) { o[e] = bfs2f(s[e]) + acc[ai][bj][m][0][e]; o[4 + e] = bfs2f(s[4 + e]) + acc[ai][bj][m][1][e]; }
                    if (NORMOUT) {
#pragma unroll
                        for (int e = 0; e < 8; ++e) sq += o[e] * o[e]; }
                    *(bf16x8*)(rowp + bj * 128) = pack8(o); }
                if (NORMOUT) { sq = quad_sum(sq); if (fq == 0) ss2[(size_t)row * 16 + u.pn * 4 + wc] = sq; }
                if (m & 1) asm volatile("" ::: "memory"); }
    }
    __device__ __forceinline__ void kprep(const pg8::Unit& u, PG8_LAS unsigned char* tab, int tid) const {
        if (tid < 256) { const f32x4 s4 = *(const f32x4*)(ssd + (size_t)(u.pm * 256 + tid) * 4); ((PG8_LAS float*)tab)[tid] = rsqrtf((s4[0] + s4[1] + s4[2] + s4[3]) * (1.0f / 256.0f) + EPS); }
    }
    __device__ __forceinline__ void khook(pg8::f32x4 (&acc)[2][2][4][2], PG8_LAS unsigned char* tab, int wr, int fr) const {
#pragma unroll
        for (int ai = 0; ai < 2; ++ai)
#pragma unroll
            for (int m = 0; m < 4; ++m) { const float rs = ((const PG8_LAS float*)tab)[ai * 128 + wr * 64 + m * 16 + fr];
#pragma unroll
                for (int bj = 0; bj < 2; ++bj)
#pragma unroll
                    for (int n = 0; n < 2; ++n) acc[ai][bj][m][n] *= rs; }
    }
};

template <int TN> __device__ __forceinline__ void tc_job(unsigned char* lds, const float* src, size_t sb, int ld, int K, int N, int nbatch, bf16_t* dst, const float* gain, int kshift, int rot) {
    LAS float* tile = (LAS float*)lds;
    constexpr int CG = TN / 64, NLD = TN / 32  , NST = TN / 64  ;
    const int tid = opaque_tid(), nk = K / 64, nn = N / TN, ntile = nbatch * nk * nn;
    for (int ti = (int)((bid_() + grid_() - (rot % grid_())) % grid_()); ti < ntile; ti += grid_()) {
        const int b = ti / (nk * nn), rem = ti % (nk * nn), kt = rem / nn, nt = rem % nn;
        const float* s = src + (size_t)b * sb + (size_t)(kt * 64) * ld + nt * TN;
        f32x4 v[NLD];
#pragma unroll
        for (int p = 0; p < NLD; ++p) { const int idx = tid + 512 * p, c16 = idx & 15, kq = (idx >> 4) & 3, rest = idx >> 6, kl = (rest / CG) * 4 + kq, n4 = ((rest % CG) * 16 + c16) * 4;
            v[p] = *(const f32x4*)(s + (size_t)kl * ld + n4);
            if (gain) { const float gg = gain[(size_t)b * K + kt * 64 + kl]; v[p] = v[p] * gg; } }
        __syncthreads();
#pragma unroll
        for (int p = 0; p < NLD; ++p) { const int idx = tid + 512 * p, c16 = idx & 15, kq = (idx >> 4) & 3, rest = idx >> 6, kl = (rest / CG) * 4 + kq, n4 = ((rest % CG) * 16 + c16) * 4;
            tile[kl * (TN + 1) + n4 + 0] = v[p][0]; tile[kl * (TN + 1) + n4 + 1] = v[p][1]; tile[kl * (TN + 1) + n4 + 2] = v[p][2]; tile[kl * (TN + 1) + n4 + 3] = v[p][3]; }
        __syncthreads();
#pragma unroll
        for (int p = 0; p < NST; ++p) { const int idx = tid + 512 * p, nl = idx >> 3, kc = (idx & 7) * 8; float o[8];
#pragma unroll
            for (int e = 0; e < 8; ++e) o[e] = tile[(kc + e) * (TN + 1) + nl];
            const int kd = (kt * 64 + kc + kshift) % K;
            *(bf16x8*)(dst + (size_t)b * N * K + (size_t)(nt * TN + nl) * K + kd) = pack8(o); }
    }
    __syncthreads();
}

__device__ __forceinline__ void prep_phase(const Args& a, unsigned char* lds) {
    unsigned char* ws = ws_();
    tc_job<256>(lds, INP(2), (size_t)DM * NIN, NIN, DM, ZW, DEPTH, (bf16_t*)(ws + WS_WIN), INP(1), 0, 0);
    tc_job<256>(lds, INP(25), (size_t)DM * DM, DM, DM, DM, DEPTH, (bf16_t*)(ws + WS_WOUT), INP(24), 256, 0);
    tc_job<256>(lds, INP(27), (size_t)DM * DFF, DFF, DM, DFF, DEPTH, (bf16_t*)(ws + WS_WMI), INP(26), 0, 0);
    tc_job<256>(lds, INP(28), (size_t)DFF * DM, DM, DFF, DM, DEPTH, (bf16_t*)(ws + WS_WMO), nullptr, 0, 0);
    tc_job<256>(lds, INP(14), (size_t)W * W, W, W, W, DEPTH, (bf16_t*)(ws + WS_GLUT), nullptr, 0, 0);
    tc_job<64>(lds, INP(18), (size_t)64 * 64, 64, 64, 64, DEPTH * 4, (bf16_t*)(ws + WS_WAT), nullptr, 0, 64);
    tc_job<64>(lds, INP(20), (size_t)64 * 64, 64, 64, 64, DEPTH * 4, (bf16_t*)(ws + WS_WXT), nullptr, 0, 96);
    const int gid = bid_() * NTHR + opaque_tid();
    if (gid < DEPTH * 1024) {
        const int l = gid >> 10, gp = gid & 1023, g = gp >> 6, p = gp & 63;
        const float lre = INP(6)[gid], lim = INP(7)[gid], dt = expf(INP(8)[l * 16 + g]);
        const float mag = expf(lre * dt), are = mag * cosf(lim * dt), aim = mag * sinf(lim * dt);
        const float den = lre * lre + lim * lim, nre = are - 1.0f, nim = aim;
        const float fre = (nre * lre + nim * lim) / den, fim = (nim * lre - nre * lim) / den;
        ((f32x2*)(ws + WS_ABAR))[gid] = (f32x2){are, aim};
        float pr = are, pi = aim;
#pragma unroll
        for (int s = 0; s < 7; ++s) { const float nr = pr * pr - pi * pi, ni = 2.0f * pr * pi; pr = nr; pi = ni; }
        ((f32x2*)(ws + WS_A128))[gid] = (f32x2){pr, pi};
        const float* bre = INP(9) + (size_t)gid * 16; const float* bim = INP(10) + (size_t)gid * 16;
        bf16_t* bbt = (bf16_t*)(ws + WS_BBT) + ((size_t)(l * 16 + g) * 128 + 2 * p) * 16;
#pragma unroll
        for (int h = 0; h < 16; ++h) { const float br = bre[h], bi = bim[h]; bbt[h] = f2bf(fre * br - fim * bi); bbt[16 + h] = f2bf(fre * bi + fim * br); }
        bf16_t* cmt = (bf16_t*)(ws + WS_CMT) + (size_t)(l * 16 + g) * 16 * 128;
#pragma unroll
        for (int h = 0; h < 16; ++h) { const size_t ci = ((size_t)(l * 16 + g) * 16 + h) * 64 + p; ((unsigned*)cmt)[(h * 128 + 2 * p) >> 1] = pk2(INP(11)[ci], -INP(12)[ci]); }
        const float* wr = INP(2) + ((size_t)l * DM + gp) * NIN + ZW;
        ((f32x4*)(ws + WS_WF))[gid] = *(const f32x4*)wr * INP(1)[gid];
    }
}

template <bool SRCB, int MODE> __device__ __forceinline__ void norm_phase(const void* xsv, const float* g, bf16_t* xb, float* ss2, float* od, const float* wf, const float* bfg, float* logf) {
    const int lane = opaque_tid() & 63, wid = opaque_tid() >> 6;
    const int gw = bid_() * 8 + wid, nw = grid_() * 8;
    for (int row = gw; row < T; row += nw) {
        f32x4 v[4]; float ss = 0.f;
#pragma unroll
        for (int i = 0; i < 4; ++i) {
            if (SRCB) { const bf16x4 q = *(const bf16x4*)((const bf16_t*)xsv + (size_t)row * DM + i * 256 + lane * 4); v[i] = (f32x4){bfs2f(q[0]), bfs2f(q[1]), bfs2f(q[2]), bfs2f(q[3])}; }
            else { v[i] = *(const f32x4*)((const float*)xsv + (size_t)row * DM + i * 256 + lane * 4);
                if (MODE == 1) { u32x2 w; w.x = pk2(v[i][0], v[i][1]); w.y = pk2(v[i][2], v[i][3]); *(u32x2*)(xb + (size_t)row * DM + i * 256 + lane * 4) = w; } }
            ss += v[i][0] * v[i][0] + v[i][1] * v[i][1] + v[i][2] * v[i][2] + v[i][3] * v[i][3]; }
        ss = wave_sum(ss);
        const float rs = rsqrtf(ss * (1.0f / DM) + EPS);
        if (MODE == 1 && !SRCB) { if (lane < 16) ss2[(size_t)row * 16 + lane] = (lane == 0) ? ss : 0.f; }
        float f0 = 0.f, f1 = 0.f, f2 = 0.f, f3 = 0.f;
#pragma unroll
        for (int i = 0; i < 4; ++i) {
            if (MODE == 2) { const f32x4 gg = *(const f32x4*)(g + i * 256 + lane * 4); *(f32x4*)(od + (size_t)row * DM + i * 256 + lane * 4) = v[i] * rs * gg; }
            if (MODE == 1) {
#pragma unroll
                for (int e = 0; e < 4; ++e) { const f32x4 w4 = *(const f32x4*)(wf + (size_t)(i * 256 + lane * 4 + e) * 4); const float hv = v[i][e] * rs; f0 += hv * w4[0]; f1 += hv * w4[1]; f2 += hv * w4[2]; f3 += hv * w4[3]; } }
        }
        if (MODE == 1) {
            f0 = wave_sum(f0); f1 = wave_sum(f1); f2 = wave_sum(f2); f3 = wave_sum(f3);
            if (lane == 0) { f32x4 o; const float fv[4] = {f0 + bfg[0], f1 + bfg[1], f2 + bfg[2], f3 + bfg[3]};
#pragma unroll
                for (int e = 0; e < 4; ++e) o[e] = fminf(fv[e], 0.f) - log1pf(__expf(-fabsf(fv[e])));
                *(f32x4*)(logf + (size_t)row * 4) = o; }
        }
    }
}

__device__ __forceinline__ void cumsum_item(int b, const float* logf, float* cs, unsigned char* lds) {
    LAS float* wt = (LAS float*)lds;
    const int tid = opaque_tid(), lane = tid & 63, wid = tid >> 6;
    f32x4 v[8]; f32x4 run = (f32x4){0.f, 0.f, 0.f, 0.f};
    const float* src = logf + ((size_t)b * SEQ + (size_t)tid * 8) * 4;
#pragma unroll
    for (int e = 0; e < 8; ++e) { run = run + *(const f32x4*)(src + e * 4); v[e] = run; }
    f32x4 inc = run;
#pragma unroll
    for (int d = 1; d < 64; d <<= 1) {
        const int sl = ((lane >= d) ? lane - d : lane) << 2; f32x4 o;
#pragma unroll
        for (int e = 0; e < 4; ++e) o[e] = __uint_as_float((unsigned)__builtin_amdgcn_ds_bpermute(sl, (int)__float_as_uint(inc[e])));
        if (lane >= d) inc = inc + o;
    }
    __syncthreads();
    if (lane == 63) { wt[wid * 4 + 0] = inc[0]; wt[wid * 4 + 1] = inc[1]; wt[wid * 4 + 2] = inc[2]; wt[wid * 4 + 3] = inc[3]; }
    __syncthreads();
    f32x4 off = inc - run;
    for (int w2 = 0; w2 < wid; ++w2) { off[0] += wt[w2 * 4 + 0]; off[1] += wt[w2 * 4 + 1]; off[2] += wt[w2 * 4 + 2]; off[3] += wt[w2 * 4 + 3]; }
    float* dst = cs + ((size_t)b * SEQ + (size_t)tid * 8) * 4;
#pragma unroll
    for (int e = 0; e < 8; ++e) *(f32x4*)(dst + e * 4) = (v[e] + off) * LOG2E;
    __syncthreads();
}

template <int HALF> __device__ __forceinline__ void sgu_item(int l, int b, int c, const Args& a, unsigned char* lds) {
    const bf16_t* z = (const bf16_t*)(ws_() + WS_Z); bf16_t* y = (bf16_t*)(ws_() + WS_Y);
    LAS bf16_t* vnT = (LAS bf16_t*)lds;
    LAS float* ssb = (LAS float*)(lds + 69632);
    const int tid = opaque_tid(), lane = tid & 63, wid = tid >> 6, fr = lane & 15, quad = lane >> 4;
    const size_t t0 = (size_t)b * SEQ + (size_t)c * 128;
    const float* ng = INP(3) + l * W;
    __syncthreads();
    float gch[4];
#pragma unroll
    for (int e = 0; e < 4; ++e) gch[e] = ng[lane + 64 * e];
    constexpr int TPW = HALF ? 16 : 8;
#pragma unroll
    for (int half = 0; half < TPW / 8; ++half) {
        float val[8][4];
#pragma unroll
        for (int i = 0; i < 8; ++i) {
            const bf16_t* zr = z + (t0 + wid * TPW + half * 8 + i) * ZW + ZC_AV; float ss = 0.f;
#pragma unroll
            for (int e = 0; e < 4; ++e) { const float gv = gelu_t(bf2f(zr[lane + 64 * e])); val[i][e] = gv; ss += gv * gv; }
            ss = wave_sum(ss); const float rs = rsqrtf(ss * (1.0f / W) + EPS);
#pragma unroll
            for (int e = 0; e < 4; ++e) val[i][e] *= rs * gch[e];
        }
#pragma unroll
        for (int e = 0; e < 4; ++e) { float t8[8];
#pragma unroll
            for (int i = 0; i < 8; ++i) t8[i] = val[i][e];
            *(LAS bf16x8*)(vnT + (lane + 64 * e) * 136 + wid * TPW + half * 8) = pack8(t8); }
    }
    __syncthreads();
    const int h = wid & 3;
    const float* wsrc = INP(4) + ((size_t)(l * 4 + h) * 128) * 128;
    const float* bsrc = INP(5) + (size_t)(l * 4 + h) * 128;
    float outv[2][4][4];
#pragma unroll
    for (int i = 0; i < 2; ++i) {
        const int mt = HALF * 4 + (wid >> 2) + 2 * i, t = mt * 16 + fr;
        f32x4 acc[4];
#pragma unroll
        for (int nt = 0; nt < 4; ++nt) acc[nt] = (f32x4){0.f, 0.f, 0.f, 0.f};
        f32x4 wl[4][2];
#pragma unroll
        for (int kk = 0; kk < 4; ++kk) { const int k0 = (kk * 32 < (mt + 1) * 16) ? kk * 32 : 0; const float* wp = wsrc + (size_t)t * 128 + k0 + quad * 8; wl[kk][0] = *(const f32x4*)wp; wl[kk][1] = *(const f32x4*)(wp + 4); }
#pragma unroll
        for (int kk = 0; kk < 4; ++kk) {
            const int k0 = kk * 32;
            if (k0 < (mt + 1) * 16) {
                float wv[8] = {wl[kk][0][0], wl[kk][0][1], wl[kk][0][2], wl[kk][0][3], wl[kk][1][0], wl[kk][1][1], wl[kk][1][2], wl[kk][1][3]};
#pragma unroll
                for (int e = 0; e < 8; ++e) if (k0 + quad * 8 + e > t) wv[e] = 0.f;
                const bf16x8 wf = pack8(wv);
#pragma unroll
                for (int nt = 0; nt < 4; ++nt) { const bf16x8 vf = *(const LAS bf16x8*)(vnT + (h * 64 + nt * 16 + fr) * 136 + k0 + quad * 8); acc[nt] = mfma16(vf, wf, acc[nt]); }
            }
        }
        const float bs = bsrc[t]; float ss = 0.f;
#pragma unroll
        for (int nt = 0; nt < 4; ++nt) { const int ch = h * 64 + nt * 16 + quad * 4; const bf16x4 u4 = *(const bf16x4*)(z + (t0 + t) * ZW + ZC_AU + ch);
#pragma unroll
            for (int r = 0; r < 4; ++r) { const float o = gelu_t(bfs2f(u4[r])) * (acc[nt][r] + bs); outv[i][nt][r] = o; ss += o * o; } }
        ss = quad_sum(ss);
        if (quad == 0) ssb[t * 4 + h] = ss;
    }
    __syncthreads();
#pragma unroll
    for (int i = 0; i < 2; ++i) {
        const int mt = HALF * 4 + (wid >> 2) + 2 * i, t = mt * 16 + fr;
        const float rs = rsqrtf((ssb[t * 4 + 0] + ssb[t * 4 + 1] + ssb[t * 4 + 2] + ssb[t * 4 + 3]) * (1.0f / W) + EPS);
#pragma unroll
        for (int nt = 0; nt < 4; ++nt) { const int ch = h * 64 + nt * 16 + quad * 4; u32x2 w; w.x = pk2(outv[i][nt][0] * rs, outv[i][nt][1] * rs); w.y = pk2(outv[i][nt][2] * rs, outv[i][nt][3] * rs);
            *(u32x2*)(y + (t0 + t) * DM + YC_A + ch) = w; }
    }
    __syncthreads();
}

template <int PASS> __device__ __forceinline__ void s5_item(int l, int b, int c, const Args& a, unsigned char* lds) {
    const bf16_t* z = (const bf16_t*)(ws_() + WS_Z); bf16_t* y = (bf16_t*)(ws_() + WS_Y);
    LAS unsigned char* BU = (LAS unsigned char*)lds;
    LAS unsigned* BU32 = (LAS unsigned*)lds;
    LAS bf16_t* Yb = (LAS bf16_t*)(lds + 65792);
    LAS float* ssb = (LAS float*)(lds + 65792 + 67584);
    const int tid = opaque_tid(), lane = tid & 63, wid = tid >> 6, fr = lane & 15, quad = lane >> 4;
    const int sx0 = wid * 128 + lane, sx1 = sx0 + 64;
    const size_t t0 = (size_t)b * SEQ + (size_t)c * 128;
    const f32x2* abar = (const f32x2*)(ws_() + WS_ABAR) + l * 1024;
    f32x2* eloc = (f32x2*)(ws_() + WS_ELOC);
    float ar[2], ai[2], sre[2], sim[2];
#pragma unroll
    for (int q = 0; q < 2; ++q) { const f32x2 ab = abar[q ? sx1 : sx0]; ar[q] = ab[0]; ai[q] = ab[1]; sre[q] = 0.f; sim[q] = 0.f; }
    if (PASS == 2) {
        const f32x2* a128 = (const f32x2*)(ws_() + WS_A128) + l * 1024;
        const f32x2 p0 = a128[sx0], p1 = a128[sx1];
        for (int cc0 = 0; cc0 < c; cc0 += 8) {
            f32x2 e0[8], e1[8];
#pragma unroll
            for (int u = 0; u < 8; ++u) { const int cc = (cc0 + u < c) ? cc0 + u : c - 1; e0[u] = eloc[((size_t)(b * NCH + cc)) * 1024 + sx0]; e1[u] = eloc[((size_t)(b * NCH + cc)) * 1024 + sx1]; }
#pragma unroll
            for (int u = 0; u < 8; ++u) if (cc0 + u < c) {
                const float nr0 = p0[0] * sre[0] - p0[1] * sim[0] + e0[u][0], ni0 = p0[0] * sim[0] + p0[1] * sre[0] + e0[u][1]; sre[0] = nr0; sim[0] = ni0;
                const float nr1 = p1[0] * sre[1] - p1[1] * sim[1] + e1[u][0], ni1 = p1[0] * sim[1] + p1[1] * sre[1] + e1[u][1]; sre[1] = nr1; sim[1] = ni1; }
        }
    }
    bf16x8 bfrag[2][8];
    const bf16_t* bbt = (const bf16_t*)(ws_() + WS_BBT);
#pragma unroll
    for (int gi = 0; gi < 2; ++gi)
#pragma unroll
        for (int j = 0; j < 8; ++j) bfrag[gi][j] = (quad < 2) ? *(const bf16x8*)(bbt + ((size_t)(l * 16 + wid * 2 + gi) * 128 + j * 16 + fr) * 16 + quad * 8) : zero8();
    bf16x8 cfrag[2][4];
    if (PASS == 2) {
        const bf16_t* cmt = (const bf16_t*)(ws_() + WS_CMT);
#pragma unroll
        for (int gi = 0; gi < 2; ++gi)
#pragma unroll
            for (int ks = 0; ks < 4; ++ks) cfrag[gi][ks] = *(const bf16x8*)(cmt + ((size_t)(l * 16 + wid * 2 + gi) * 16 + fr) * 128 + ks * 32 + quad * 8);
    }
    const float* dsk = INP(13) + l * W;
    __syncthreads();
    bf16x8 ufn[2];
#pragma unroll
    for (int gi = 0; gi < 2; ++gi) ufn[gi] = (quad < 2) ? *(const bf16x8*)(z + (t0 + fr) * ZW + ZC_B + (wid * 2 + gi) * 16 + quad * 8) : zero8();
    for (int sc = 0; sc < 8; ++sc) {
        const size_t tr = t0 + sc * 16 + fr;
        bf16x8 ufc[2] = {ufn[0], ufn[1]};
        bf16x4 u4c[2] = {(bf16x4){0, 0, 0, 0}, (bf16x4){0, 0, 0, 0}};
        if (PASS == 2) {
#pragma unroll
            for (int gi = 0; gi < 2; ++gi) u4c[gi] = *(const bf16x4*)(z + tr * ZW + ZC_B + (wid * 2 + gi) * 16 + quad * 4);
        }
        if (sc < 7) {
#pragma unroll
            for (int gi = 0; gi < 2; ++gi) ufn[gi] = (quad < 2) ? *(const bf16x8*)(z + (tr + 16) * ZW + ZC_B + (wid * 2 + gi) * 16 + quad * 8) : zero8();
        }
#pragma unroll
        for (int gi = 0; gi < 2; ++gi) {
            const int g = wid * 2 + gi;
            const bf16x8 uf = ufc[gi];
#pragma unroll
            for (int j = 0; j < 8; ++j) {
                const f32x4 acc = mfma16(bfrag[gi][j], uf, (f32x4){0.f, 0.f, 0.f, 0.f});
                u32x2 w; w.x = pk2(acc[0], acc[1]); w.y = pk2(acc[2], acc[3]);
                *(LAS u32x2*)(BU + fr * 4112 + (g * 64 + j * 8 + quad * 2) * 4) = w;
            }
        }
        asm volatile("s_waitcnt lgkmcnt(0)" ::: "memory");
        {
            unsigned wv[16][2];
#pragma unroll
            for (int tt = 0; tt < 16; ++tt) { wv[tt][0] = BU32[tt * 1028 + sx0]; wv[tt][1] = BU32[tt * 1028 + sx1]; }
#pragma unroll
            for (int tt = 0; tt < 16; ++tt) {
#pragma unroll
                for (int q = 0; q < 2; ++q) {
                    const unsigned w = wv[tt][q];
                    const f32x2 bu2 = {__uint_as_float(w << 16), __uint_as_float(w & 0xffff0000u)};
                    const f32x2 s2 = {sre[q], sim[q]}, sw = {sim[q], sre[q]}, arr = {ar[q], ar[q]}, aii = {-ai[q], ai[q]};
                    const f32x2 n2 = aii * sw + (arr * s2 + bu2);
                    sre[q] = n2[0]; sim[q] = n2[1];
                    if (PASS == 2) wv[tt][q] = pk2(n2[0], n2[1]);
                }
            }
            if (PASS == 2) {
#pragma unroll
                for (int tt = 0; tt < 16; ++tt) { BU32[tt * 1028 + sx0] = wv[tt][0]; BU32[tt * 1028 + sx1] = wv[tt][1]; }
            }
        }
        asm volatile("s_waitcnt lgkmcnt(0)" ::: "memory");
        if (PASS == 2) {
#pragma unroll
            for (int gi = 0; gi < 2; ++gi) {
                const int g = wid * 2 + gi; f32x4 acc = (f32x4){0.f, 0.f, 0.f, 0.f};
#pragma unroll
                for (int ks = 0; ks < 4; ++ks) { const bf16x8 sf = *(const LAS bf16x8*)(BU + fr * 4112 + g * 256 + (ks * 32 + quad * 8) * 2); acc = mfma16(cfrag[gi][ks], sf, acc); }
                const int ch = g * 16 + quad * 4; const bf16x4 u4 = u4c[gi]; const f32x4 d4 = *(const f32x4*)(dsk + ch);
                float o[4];
#pragma unroll
                for (int r = 0; r < 4; ++r) o[r] = gelu_t(acc[r] + d4[r] * bfs2f(u4[r]));
                u32x2 w; w.x = pk2(o[0], o[1]); w.y = pk2(o[2], o[3]);
                *(LAS u32x2*)(Yb + (sc * 16 + fr) * 264 + ch) = w;
            }
        }
    }
    if (PASS == 1) {
#pragma unroll
        for (int q = 0; q < 2; ++q) eloc[((size_t)(b * NCH + c)) * 1024 + (q ? sx1 : sx0)] = (f32x2){sre[q], sim[q]};
    } else {
        __syncthreads();
        const bf16_t* glut = (const bf16_t*)(ws_() + WS_GLUT) + (size_t)l * W * W;
        const float* glub = INP(15) + l * W;
        bf16x8 gfrag[2][8];
#pragma unroll
        for (int ni = 0; ni < 2; ++ni)
#pragma unroll
            for (int ks = 0; ks < 8; ++ks) gfrag[ni][ks] = *(const bf16x8*)(glut + (size_t)((wid * 2 + ni) * 16 + fr) * W + ks * 32 + quad * 8);
        float outv[8][2][4];
#pragma unroll
        for (int mt = 0; mt < 8; ++mt) {
            f32x4 acc0 = (f32x4){0.f, 0.f, 0.f, 0.f}, acc1 = acc0;
#pragma unroll
            for (int ks = 0; ks < 8; ++ks) { const bf16x8 yf = *(const LAS bf16x8*)(Yb + (mt * 16 + fr) * 264 + ks * 32 + quad * 8); acc0 = mfma16(gfrag[0][ks], yf, acc0); acc1 = mfma16(gfrag[1][ks], yf, acc1); }
            float ss = 0.f;
#pragma unroll
            for (int ni = 0; ni < 2; ++ni) { const int n = (wid * 2 + ni) * 16 + quad * 4; const bf16x4 y4 = *(const LAS bf16x4*)(Yb + (mt * 16 + fr) * 264 + n); const f32x4 gb = *(const f32x4*)(glub + n);
#pragma unroll
                for (int r = 0; r < 4; ++r) { const float gt = (ni == 0 ? acc0[r] : acc1[r]) + gb[r]; const float o = bfs2f(y4[r]) * sigm(gt); outv[mt][ni][r] = o; ss += o * o; } }
            ss = quad_sum(ss);
            if (quad == 0) ssb[(mt * 16 + fr) * 8 + wid] = ss;
        }
        __syncthreads();
#pragma unroll
        for (int mt = 0; mt < 8; ++mt) {
            const int t = mt * 16 + fr; float s = 0.f;
#pragma unroll
            for (int w2 = 0; w2 < 8; ++w2) s += ssb[t * 8 + w2];
            const float rs = rsqrtf(s * (1.0f / W) + EPS);
#pragma unroll
            for (int ni = 0; ni < 2; ++ni) { const int n = (wid * 2 + ni) * 16 + quad * 4; u32x2 w; w.x = pk2(outv[mt][ni][0] * rs, outv[mt][ni][1] * rs); w.y = pk2(outv[mt][ni][2] * rs, outv[mt][ni][3] * rs);
                *(u32x2*)(y + (t0 + t) * DM + YC_B + n) = w; }
        }
    }
    __syncthreads();
}

template <int PASS> __device__ __forceinline__ void lru_item(int l, int b, int c, const Args& a, unsigned char* lds) {
    const bf16_t* z = (const bf16_t*)(ws_() + WS_Z); bf16_t* y = (bf16_t*)(ws_() + WS_Y);
    LAS bf16_t* XC = (LAS bf16_t*)lds;
    LAS float* ssb = (LAS float*)(lds + 67584);
    const int tid = opaque_tid(), lane = tid & 63, wid = tid >> 6, fr = lane & 15, quad = lane >> 4;
    const size_t t0 = (size_t)b * SEQ + (size_t)c * 128;
    float* LAp = (float*)(ws_() + WS_LA); float* LBp = (float*)(ws_() + WS_LB);
    __syncthreads();
    {
        const float* cw = INP(16) + (size_t)l * 4 * W; const float* cb = INP(17) + l * W;
#pragma unroll 4
        for (int it = 0; it < 8; ++it) {
            const int p = tid + 512 * it, tok = p >> 5, ch0 = (p & 31) * 8; float acc[8];
            { const f32x4 c0 = *(const f32x4*)(cb + ch0), c1 = *(const f32x4*)(cb + ch0 + 4); acc[0] = c0[0]; acc[1] = c0[1]; acc[2] = c0[2]; acc[3] = c0[3]; acc[4] = c1[0]; acc[5] = c1[1]; acc[6] = c1[2]; acc[7] = c1[3]; }
#pragma unroll
            for (int k = 0; k < 4; ++k) {
                const int tt = tok - 3 + k;
                if (c * 128 + tt >= 0) {
                    const bf16x8 xv = *(const bf16x8*)(z + (size_t)((long)t0 + tt) * ZW + ZC_CX + ch0);
                    const f32x4 w0 = *(const f32x4*)(cw + k * W + ch0), w1 = *(const f32x4*)(cw + k * W + ch0 + 4);
                    acc[0] += w0[0] * bfs2f(xv[0]); acc[1] += w0[1] * bfs2f(xv[1]); acc[2] += w0[2] * bfs2f(xv[2]); acc[3] += w0[3] * bfs2f(xv[3]);
                    acc[4] += w1[0] * bfs2f(xv[4]); acc[5] += w1[1] * bfs2f(xv[5]); acc[6] += w1[2] * bfs2f(xv[6]); acc[7] += w1[3] * bfs2f(xv[7]);
                }
            }
            *(LAS bf16x8*)(XC + tok * 264 + ch0) = pack8(acc);
        }
    }
    __syncthreads();
    const int hh = wid >> 1;
    const bf16_t* wat = (const bf16_t*)(ws_() + WS_WAT) + (size_t)(l * 4 + hh) * 64 * 64;
    const bf16_t* wxt = (const bf16_t*)(ws_() + WS_WXT) + (size_t)(l * 4 + hh) * 64 * 64;
    bf16x8 waf[2][2], wxf[2][2]; float sp8[2][4], bav[2][4], bxv[2][4], H[2][4], Acar[2][4], Bcar[2][4];
#pragma unroll
    for (int ni = 0; ni < 2; ++ni) {
        const int nl = (wid * 2 + ni) * 16 - hh * 64 + fr;
#pragma unroll
        for (int ks = 0; ks < 2; ++ks) { waf[ni][ks] = *(const bf16x8*)(wat + nl * 64 + ks * 32 + quad * 8); wxf[ni][ks] = *(const bf16x8*)(wxt + nl * 64 + ks * 32 + quad * 8); }
#pragma unroll
        for (int r = 0; r < 4; ++r) { const int ch = (wid * 2 + ni) * 16 + quad * 4 + r;
            sp8[ni][r] = 8.0f * softplus_f(-INP(22)[l * W + ch]); bav[ni][r] = INP(19)[l * W + ch]; bxv[ni][r] = INP(21)[l * W + ch];
            H[ni][r] = 0.f; Acar[ni][r] = 1.f; Bcar[ni][r] = 0.f;
        }
    }
    if (PASS == 2 && c > 0) {
#pragma unroll
        for (int ni = 0; ni < 2; ++ni) {
            const size_t ob = (size_t)(b * NCH) * W + (wid * 2 + ni) * 16 + quad * 4;
            const bool v0 = fr < c, v1 = 16 + fr < c;
            f32x4 a0 = (f32x4){1.f, 1.f, 1.f, 1.f}, b0 = (f32x4){0.f, 0.f, 0.f, 0.f}, a1 = a0, b1 = b0;
            if (v0) { a0 = *(const f32x4*)(LAp + ob + (size_t)fr * W); b0 = *(const f32x4*)(LBp + ob + (size_t)fr * W); }
            if (v1) { a1 = *(const f32x4*)(LAp + ob + (size_t)(16 + fr) * W); b1 = *(const f32x4*)(LBp + ob + (size_t)(16 + fr) * W); }
#pragma unroll
            for (int r = 0; r < 4; ++r) {
                float av = a0[r], bb = b0[r], aw = a1[r], bw = b1[r], ap, bp;
                ap = dpp_shr<1>(av, 1.0f); bp = dpp_shr<1>(bb, 0.0f); bb = av * bp + bb; av = av * ap;   ap = dpp_shr<1>(aw, 1.0f); bp = dpp_shr<1>(bw, 0.0f); bw = aw * bp + bw; aw = aw * ap;
                ap = dpp_shr<2>(av, 1.0f); bp = dpp_shr<2>(bb, 0.0f); bb = av * bp + bb; av = av * ap;   ap = dpp_shr<2>(aw, 1.0f); bp = dpp_shr<2>(bw, 0.0f); bw = aw * bp + bw; aw = aw * ap;
                ap = dpp_shr<4>(av, 1.0f); bp = dpp_shr<4>(bb, 0.0f); bb = av * bp + bb; av = av * ap;   ap = dpp_shr<4>(aw, 1.0f); bp = dpp_shr<4>(bw, 0.0f); bw = aw * bp + bw; aw = aw * ap;
                ap = dpp_shr<8>(av, 1.0f); bp = dpp_shr<8>(bb, 0.0f); bb = av * bp + bb; av = av * ap;   ap = dpp_shr<8>(aw, 1.0f); bp = dpp_shr<8>(bw, 0.0f); bw = aw * bp + bw; aw = aw * ap;
                const float B0t = __shfl(bb, 15, 16), A1t = __shfl(aw, 15, 16), B1t = __shfl(bw, 15, 16);
                H[ni][r] = A1t * B0t + B1t;
            }
        }
    }
    LAS bf16_t* Ob = (LAS bf16_t*)(lds + 67584 + 4096);
#pragma unroll 2
    for (int mt = 0; mt < 8; ++mt) {
        bf16x8 xf[2];
#pragma unroll
        for (int ks = 0; ks < 2; ++ks) xf[ks] = *(const LAS bf16x8*)(XC + (mt * 16 + fr) * 264 + hh * 64 + ks * 32 + quad * 8);
        float ss = 0.f;
#pragma unroll
        for (int ni = 0; ni < 2; ++ni) {
            f32x4 accA = (f32x4){0.f, 0.f, 0.f, 0.f}, accX = accA;
#pragma unroll
            for (int ks = 0; ks < 2; ++ks) { accA = mfma16(waf[ni][ks], xf[ks], accA); accX = mfma16(wxf[ni][ks], xf[ks], accX); }
            const int ch0 = (wid * 2 + ni) * 16 + quad * 4;
            const bf16x4 xc4 = *(const LAS bf16x4*)(XC + (mt * 16 + fr) * 264 + ch0);
            bf16x4 g4 = (bf16x4){0, 0, 0, 0};
            if (PASS == 2) g4 = *(const bf16x4*)(z + (t0 + mt * 16 + fr) * ZW + ZC_CG + ch0);
            float ov[4] = {0.f, 0.f, 0.f, 0.f};
#pragma unroll
            for (int r = 0; r < 4; ++r) {
                const float rg = sigm(accA[r] + bav[ni][r]), ig = sigm(accX[r] + bxv[ni][r]);
                const float la = -rg * sp8[ni][r];
                float av = __builtin_amdgcn_exp2f(LOG2E * la), bb = __builtin_amdgcn_sqrtf(fmaxf(neg_expm1(2.0f * la), 0.f)) * (ig * bfs2f(xc4[r]));
                { float ap, bp;
                  ap = dpp_shr<1>(av, 1.0f); bp = dpp_shr<1>(bb, 0.0f); bb = av * bp + bb; av = av * ap;
                  ap = dpp_shr<2>(av, 1.0f); bp = dpp_shr<2>(bb, 0.0f); bb = av * bp + bb; av = av * ap;
                  ap = dpp_shr<4>(av, 1.0f); bp = dpp_shr<4>(bb, 0.0f); bb = av * bp + bb; av = av * ap;
                  ap = dpp_shr<8>(av, 1.0f); bp = dpp_shr<8>(bb, 0.0f); bb = av * bp + bb; av = av * ap; }
                if (PASS == 1) { const float At = __shfl(av, 15, 16), Bt = __shfl(bb, 15, 16); Bcar[ni][r] = At * Bcar[ni][r] + Bt; Acar[ni][r] *= At; }
                else { const float hv = av * H[ni][r] + bb; H[ni][r] = __shfl(hv, 15, 16); const float o = hv * gelu_t(bfs2f(g4[r])); ov[r] = o; ss += o * o; }
            }
            if (PASS == 2) { u32x2 w; w.x = pk2(ov[0], ov[1]); w.y = pk2(ov[2], ov[3]); *(LAS u32x2*)(Ob + (mt * 16 + fr) * 264 + ch0) = w; }
        }
        if (PASS == 2) { ss = quad_sum(ss); if (quad == 0) ssb[(mt * 16 + fr) * 8 + wid] = ss; }
    }
    if (PASS == 1) {
        if (fr == 0) {
#pragma unroll
            for (int ni = 0; ni < 2; ++ni)
#pragma unroll
                for (int r = 0; r < 4; ++r) { const size_t o = ((size_t)(b * NCH + c)) * W + (wid * 2 + ni) * 16 + quad * 4 + r; LAp[o] = Acar[ni][r]; LBp[o] = Bcar[ni][r]; }
        }
        {
            const int tok = tid >> 2, hd = tid & 3; float s2 = 0.f;
#pragma unroll
            for (int j = 0; j < 8; ++j) { const bf16x8 kv = *(const bf16x8*)(z + (t0 + tok) * ZW + ZC_K + hd * 64 + j * 8);
#pragma unroll
                for (int e = 0; e < 8; ++e) { const float f = bfs2f(kv[e]); s2 += f * f; } }
            ssb[tok * 4 + hd] = s2;
            __syncthreads();
            if (tid < 4) { float mxv = 0.f; for (int i = 0; i < 128; ++i) mxv = fmaxf(mxv, ssb[i * 4 + tid]); ((float*)(ws_() + WS_KMAX))[(b * NCH + c) * 4 + tid] = mxv; }
        }
    } else {
        __syncthreads();
#pragma unroll 2
        for (int mt = 0; mt < 8; ++mt) {
            const int t = mt * 16 + fr; float s = 0.f;
#pragma unroll
            for (int w2 = 0; w2 < 8; ++w2) s += ssb[t * 8 + w2];
            const float rs = rsqrtf(s * (1.0f / W) + EPS);
#pragma unroll
            for (int ni = 0; ni < 2; ++ni) { const int n = (wid * 2 + ni) * 16 + quad * 4; const bf16x4 o4 = *(const LAS bf16x4*)(Ob + t * 264 + n);
                u32x2 w; w.x = pk2(bfs2f(o4[0]) * rs, bfs2f(o4[1]) * rs); w.y = pk2(bfs2f(o4[2]) * rs, bfs2f(o4[3]) * rs);
                *(u32x2*)(y + (t0 + t) * DM + YC_C + n) = w; }
        }
    }
    __syncthreads();
}

template <bool DIAG> __device__ __forceinline__ void attn_step2(const LAS unsigned char* buf, int kbase, int qrow0, int quad, int fr, const bf16x8 (&qf)[2][2], float (&m)[2], float (&lsum)[2], f32x4 (&oacc)[2][4]) {
    const LAS bf16_t* Kt = (const LAS bf16_t*)buf; const LAS bf16_t* Vt = (const LAS bf16_t*)(buf + 9216); const LAS float* csl = (const LAS float*)(buf + 18432);
    float p[2][4][4];
#pragma unroll
    for (int st = 0; st < 4; ++st) {
        const f32x4 c4 = *(const LAS f32x4*)(csl + st * 16 + quad * 4);
        const bf16x8 kf0 = *(const LAS bf16x8*)(Kt + (st * 16 + fr) * 72 + quad * 8), kf1 = *(const LAS bf16x8*)(Kt + (st * 16 + fr) * 72 + 32 + quad * 8);
#pragma unroll
        for (int qs = 0; qs < 2; ++qs) {
            f32x4 acc = mfma16(kf0, qf[qs][0], c4); acc = mfma16(kf1, qf[qs][1], acc);
#pragma unroll
            for (int r = 0; r < 4; ++r) { float v = acc[r]; if (DIAG && (kbase + st * 16 + quad * 4 + r > qrow0 + qs * 16)) v = -1e30f; p[qs][st][r] = v; }
        }
    }
    bf16x8 pf[2][2];
#pragma unroll
    for (int qs = 0; qs < 2; ++qs) {
        float mx = -1e30f;
#pragma unroll
        for (int st = 0; st < 4; ++st)
#pragma unroll
            for (int r = 0; r < 4; ++r) mx = fmaxf(mx, p[qs][st][r]);
        mx = quad_max(mx);
        if (__any(mx > m[qs])) {
            const float mnew = fmaxf(m[qs], mx), al = __builtin_amdgcn_exp2f(m[qs] - mnew); m[qs] = mnew; lsum[qs] *= al;
#pragma unroll
            for (int dt = 0; dt < 4; ++dt) oacc[qs][dt] = oacc[qs][dt] * al;
        }
        const float mcur = m[qs];
        float ps = 0.f;
#pragma unroll
        for (int st = 0; st < 4; ++st)
#pragma unroll
            for (int r = 0; r < 4; ++r) { const float e = __builtin_amdgcn_exp2f(p[qs][st][r] - mcur); p[qs][st][r] = e; ps += e; }
        lsum[qs] += ps;
#pragma unroll
        for (int ks = 0; ks < 2; ++ks) { u32x4 w; w.x = pk2(p[qs][2 * ks][0], p[qs][2 * ks][1]); w.y = pk2(p[qs][2 * ks][2], p[qs][2 * ks][3]); w.z = pk2(p[qs][2 * ks + 1][0], p[qs][2 * ks + 1][1]); w.w = pk2(p[qs][2 * ks + 1][2], p[qs][2 * ks + 1][3]); pf[qs][ks] = __builtin_bit_cast(bf16x8, w); }
    }
#pragma unroll
    for (int dt = 0; dt < 4; ++dt) {
#pragma unroll
        for (int ks = 0; ks < 2; ++ks) {
            const bf16x4 v0 = *(const LAS bf16x4*)(Vt + (dt * 16 + fr) * 72 + ks * 32 + quad * 4), v1 = *(const LAS bf16x4*)(Vt + (dt * 16 + fr) * 72 + ks * 32 + 16 + quad * 4);
            const bf16x8 vf = (bf16x8){v0[0], v0[1], v0[2], v0[3], v1[0], v1[1], v1[2], v1[3]};
            oacc[0][dt] = mfma16(vf, pf[0][ks], oacc[0][dt]); oacc[1][dt] = mfma16(vf, pf[1][ks], oacc[1][dt]);
        }
    }
}
__device__ __forceinline__ void attn_unit(int b, int h, int qb, const Args& a, unsigned char* lds) {
    const bf16_t* z = (const bf16_t*)(ws_() + WS_Z); bf16_t* y = (bf16_t*)(ws_() + WS_Y);
    const float* cs = (const float*)(ws_() + WS_CS); float* ssd = (float*)(ws_() + WS_SSD);
    constexpr int ABUF = 9216 + 9216 + 256;
    LAS unsigned char* lb = (LAS unsigned char*)lds;
    const int tid = opaque_tid(), lane = tid & 63, wid = tid >> 6, fr = lane & 15, quad = lane >> 4, grp = wid >> 2, wq = wid & 3;
    const int q0 = qb * 128, qw = q0 + wq * 32, qrow0 = qw + fr;
    const size_t rb = (size_t)b * SEQ;
    bf16x8 qf[2][2];
    {
        const float SC = 0.125f * LOG2E;
#pragma unroll
        for (int qs = 0; qs < 2; ++qs)
#pragma unroll
            for (int ds = 0; ds < 2; ++ds) { const bf16x8 qv = *(const bf16x8*)(z + (rb + qrow0 + qs * 16) * ZW + ZC_Q + h * 64 + ds * 32 + quad * 8); float t8[8];
#pragma unroll
                for (int e = 0; e < 8; ++e) t8[e] = bfs2f(qv[e]) * SC;
                qf[qs][ds] = pack8(t8); }
    }
    float m[2] = {-1e30f, -1e30f}, lsum[2] = {0.f, 0.f}; f32x4 oacc[2][4];
#pragma unroll
    for (int qs = 0; qs < 2; ++qs)
#pragma unroll
        for (int dt = 0; dt < 4; ++dt) oacc[qs][dt] = (f32x4){0.f, 0.f, 0.f, 0.f};
    float qbnd[2];
    {
        float kv = (lane <= qb) ? ((const float*)(ws_() + WS_KMAX))[(b * NCH + lane) * 4 + h] : 0.f;
        kv = wave_max(kv);
        const float kmax = __builtin_amdgcn_sqrtf(kv) * 1.01f + 1e-3f;
#pragma unroll
        for (int qs = 0; qs < 2; ++qs) { float q2 = 0.f;
#pragma unroll
            for (int ds = 0; ds < 2; ++ds)
#pragma unroll
                for (int e = 0; e < 8; ++e) { const float f = bfs2f(qf[qs][ds][e]); q2 += f * f; }
            q2 = quad_sum(q2); qbnd[qs] = (__builtin_amdgcn_sqrtf(q2) * 1.01f + 1e-3f) * kmax; }
    }
    const int NSS = qb + 1;
    volatile LAS unsigned* vote = (volatile LAS unsigned*)(lds + LDS_BYTES - 64);
    if (tid < 3) vote[tid] = 0u;
    bf16x8 kreg[2], vreg[2]; float creg = 0.f;
#define ATT_LOAD(S) do { const size_t kb_ = rb + (size_t)(S) * 128; \
        _Pragma("unroll") for (int p_ = 0; p_ < 2; ++p_) { const int id_ = tid + 512 * p_; \
            kreg[p_] = *(const bf16x8*)(z + (kb_ + (id_ >> 3)) * ZW + ZC_K + h * 64 + (id_ & 7) * 8); \
            vreg[p_] = *(const bf16x8*)(z + (kb_ + 2 * (tid & 63) + p_) * ZW + ZC_V + h * 64 + (tid >> 6) * 8); } \
        if (tid < 128) creg = cs[(kb_ + tid) * 4 + h]; } while (0)
#define ATT_STORE(S) do { LAS unsigned char* bb_ = lb + ((S) & 1) * (2 * ABUF); \
        _Pragma("unroll") for (int p_ = 0; p_ < 2; ++p_) { const int id_ = tid + 512 * p_; const int k128_ = id_ >> 3; \
            *(LAS bf16x8*)((LAS bf16_t*)(bb_ + (k128_ >> 6) * ABUF) + (k128_ & 63) * 72 + (id_ & 7) * 8) = kreg[p_]; } \
        { LAS unsigned* vt_ = (LAS unsigned*)(bb_ + ((tid & 63) >> 5) * ABUF + 9216);     \
            _Pragma("unroll") for (int e_ = 0; e_ < 8; ++e_) vt_[(((tid >> 6) * 8 + e_) * 72 + ((2 * (tid & 63)) & 63)) >> 1] = (unsigned)(unsigned short)vreg[0][e_] | ((unsigned)(unsigned short)vreg[1][e_] << 16); } \
        if (tid < 128) ((LAS float*)(bb_ + (tid >> 6) * ABUF + 18432))[tid & 63] = -creg; } while (0)
    ATT_LOAD(NSS - 1); ATT_STORE(NSS - 1);
    if (NSS > 1) ATT_LOAD(NSS - 2);
    __syncthreads();
    int kstep = 0;
    for (int S = NSS - 1; S >= 0; --S) {
        if (S >= 1) ATT_STORE(S - 1);
        if (S >= 2) ATT_LOAD(S - 2);
        float cl = 0.f; if (S >= 1) cl = cs[(rb + (size_t)(S - 1) * 128 + 127) * 4 + h];
        const int kbase = S * 128 + grp * 64;
        const LAS unsigned char* hb = lb + (S & 1) * (2 * ABUF) + grp * ABUF;
        if (S + 1 < NSS) attn_step2<false>(hb, kbase, qrow0, quad, fr, qf, m, lsum, oacc);
        else if (kbase <= qw + 31) attn_step2<true>(hb, kbase, qrow0, quad, fr, qf, m, lsum, oacc);
        const bool need = (S >= 1) && ((qbnd[0] - cl - m[0] >= -160.f) || (qbnd[1] - cl - m[1] >= -160.f));
        const int vw = kstep % 3;
        if (need) vote[vw] = 1u;
        __syncthreads();
        const unsigned go = vote[vw];
        if (tid == 0) vote[(kstep + 2) % 3] = 0u;
        ++kstep;
        if (!go) break;
    }
#undef ATT_LOAD
#undef ATT_STORE
    LAS float* mg = (LAS float*)lb;
    const int ml = wq * 64 + lane;
    if (grp == 1) {
#pragma unroll
        for (int qs = 0; qs < 2; ++qs) { mg[(qs * 18 + 0) * 256 + ml] = m[qs]; mg[(qs * 18 + 1) * 256 + ml] = lsum[qs];
#pragma unroll
            for (int dt = 0; dt < 4; ++dt)
#pragma unroll
                for (int r = 0; r < 4; ++r) mg[(qs * 18 + 2 + dt * 4 + r) * 256 + ml] = oacc[qs][dt][r]; }
    }
    __syncthreads();
    if (grp == 0) {
#pragma unroll
        for (int qs = 0; qs < 2; ++qs) {
            const float m1 = mg[(qs * 18 + 0) * 256 + ml], l1 = mg[(qs * 18 + 1) * 256 + ml];
            const float mt = fmaxf(m[qs], m1), f0 = __builtin_amdgcn_exp2f(m[qs] - mt), f1 = __builtin_amdgcn_exp2f(m1 - mt);
            float lt = quad_sum(lsum[qs] * f0 + l1 * f1);
            const float inv = 1.0f / lt; float ss = 0.f;
            const size_t tq = rb + qrow0 + qs * 16;
#pragma unroll
            for (int dt = 0; dt < 4; ++dt) { f32x4 o;
#pragma unroll
                for (int r = 0; r < 4; ++r) { o[r] = (oacc[qs][dt][r] * f0 + mg[(qs * 18 + 2 + dt * 4 + r) * 256 + ml] * f1) * inv; ss += o[r] * o[r]; }
                u32x2 w; w.x = pk2(o[0], o[1]); w.y = pk2(o[2], o[3]); *(u32x2*)(y + tq * DM + YC_D + h * 64 + dt * 16 + quad * 4) = w; }
            ss = quad_sum(ss);
            if (quad == 0) ssd[tq * 4 + h] = ss;
        }
    }
    __syncthreads();
}

#define XB_TMO      128
#define XB_XCNT(j)  (256  + 64 * (j))
#define XB_XSUB(j)  (1280 + 64 * (j))
#define XB_XGEN(j)  (2304 + 64 * (j))
#define XB_TOP      3328
#define XB_TOPGEN   3392
#define XCD_BAR_WORDS 3456
#define XB_SPIN_CAP (1u << 18)

__device__ __forceinline__ unsigned xb_ld(unsigned* p)              { return __hip_atomic_load(p, __ATOMIC_RELAXED, __HIP_MEMORY_SCOPE_AGENT); }
__device__ __forceinline__ unsigned xb_add(unsigned* p, unsigned v) { return __hip_atomic_fetch_add(p, v, __ATOMIC_RELAXED, __HIP_MEMORY_SCOPE_AGENT); }
__device__ __forceinline__ unsigned xb_xcc_id() { return (unsigned)__builtin_amdgcn_s_getreg((3 << 11) | 20) & 0xFu; }
#define XB_SPIN(cond, bar) do { unsigned _sp = 0; while (cond) { __builtin_amdgcn_s_sleep(1); \
    if ((++_sp & 255u) == 0u) { if (xb_ld(&(bar)[XB_TMO])) break; if (_sp > XB_SPIN_CAP) { atomicAdd(&(bar)[XB_TMO], 1u); break; } } } } while (0)

struct XcdBarrier {
    unsigned* bar; unsigned x;
    volatile LAS unsigned* st;
};

__device__ __forceinline__ XcdBarrier xcd_barrier_post(unsigned* bar, volatile LAS unsigned* st) {
    XcdBarrier b; b.bar = bar; b.x = xb_xcc_id(); b.st = st;
    if (opaque_tid() == 0) (void)xb_add(&bar[XB_XCNT(b.x)], 1u);
    return b;
}
__device__ __forceinline__ void xcd_barrier_complete(unsigned* bar, unsigned x, unsigned& nloc, unsigned& nx) {
    const unsigned G = gridDim.x * gridDim.y * gridDim.z;
    unsigned sum, cnt, mine, sp = 0u;
    for (;;) {
        sum = 0u; cnt = 0u; mine = 0u;
#pragma unroll
        for (unsigned j = 0; j < 16; ++j) { const unsigned c = xb_ld(&bar[XB_XCNT(j)]); sum += c; cnt += (c > 0u) ? 1u : 0u; mine = (j == x) ? c : mine; }
        if (sum == G) break;
        __builtin_amdgcn_s_sleep(1);
        if ((++sp & 255u) == 0u) { if (xb_ld(&bar[XB_TMO])) break; if (sp > XB_SPIN_CAP) { atomicAdd(&bar[XB_TMO], 1u); break; } }
    }
    nloc = mine > 0u ? mine : 1u; nx = cnt > 0u ? cnt : 1u;
}

__device__ __forceinline__ void xcd_barrier(const XcdBarrier& b) {
    asm volatile("s_waitcnt vmcnt(0)" ::: "memory");
    __syncthreads();
    if (opaque_tid() == 0) {
        unsigned* bar = b.bar;
        __builtin_amdgcn_s_waitcnt(0);
        unsigned nloc = b.st[0], nx = b.st[1];
        if (nloc == 0u) { xcd_barrier_complete(bar, b.x, nloc, nx); b.st[0] = nloc; b.st[1] = nx; }
        const unsigned old = xb_add(&bar[XB_XSUB(b.x)], 1u);
        const unsigned gen = old / nloc;
        if (old + 1u == (gen + 1u) * nloc) {
            __builtin_amdgcn_fence(__ATOMIC_RELEASE, "agent");
            asm volatile("s_waitcnt vmcnt(0)" ::: "memory");
            const unsigned og = xb_add(&bar[XB_TOP], 1u);
            const unsigned tg = og / nx;
            if (og + 1u == (tg + 1u) * nx) xb_add(&bar[XB_TOPGEN], 1u);
            else XB_SPIN(xb_ld(&bar[XB_TOPGEN]) == tg, bar);
            __builtin_amdgcn_fence(__ATOMIC_ACQUIRE, "agent");
            xb_add(&bar[XB_XGEN(b.x)], 1u);
            asm volatile("s_waitcnt vmcnt(0)" ::: "memory");
        } else {
            XB_SPIN(xb_ld(&bar[XB_XGEN(b.x)]) == gen, bar);
            __builtin_amdgcn_fence(__ATOMIC_ACQUIRE, "agent");
            asm volatile("s_waitcnt vmcnt(0)" ::: "memory");
        }
    }
    __syncthreads();
}

#ifndef WGM_G1
#define WGM_G1 2
#endif
#ifndef WGM_G2
#define WGM_G2 4
#endif
#ifndef WGM_G3
#define WGM_G3 4
#endif
#ifndef WGM_G4
#define WGM_G4 8
#endif
#ifndef PROBE_DUP
#define PROBE_DUP 0
#endif
#ifndef ITEM_MASK
#define ITEM_MASK 127
#endif
__global__ void __launch_bounds__(NTHR, 2) fwd_kernel(Args a) {
    extern __shared__ __attribute__((aligned(16))) unsigned char lds[];
    {
        volatile LAS unsigned* bst0 = (volatile LAS unsigned*)(lds + LDS_BYTES - 16);
        if (opaque_tid() == 0) { bst0[0] = 0u; bst0[1] = 0u; }
        __syncthreads();
        (void)xcd_barrier_post((unsigned*)(ws_() + WS_BAR), bst0);
    }
    if (PH_HI > 4096) cg::this_grid().sync();
#define SEAM(k) do { if ((k) + 1 < PH_HI) { XcdBarrier xb_; xb_.bar = (unsigned*)(ws_() + WS_BAR); xb_.x = xb_xcc_id(); xb_.st = (volatile LAS unsigned*)(lds + LDS_BYTES - 16); xcd_barrier(xb_); if (PROBE_DUP == 1) xcd_barrier(xb_); } } while (0)
#define IN(k) (PH_LO <= (k) && (k) < PH_HI)
    if (IN(0)) { prep_phase(a, lds); if (PROBE_DUP == 4) prep_phase(a, lds); SEAM(0); }
    for (int l = 0; l < DEPTH; ++l) {
        const int pb = 1 + 8 * l;
        if (l == 0 && IN(pb + 0)) {
            norm_phase<false, 1>(INP(0), nullptr, (bf16_t*)(ws_() + WS_H), (float*)(ws_() + WS_SS2), nullptr, (const float*)(ws_() + WS_WF), INP(23), (float*)(ws_() + WS_LOGF));
            SEAM(pb + 0);
        }
        if (IN(pb + 1)) {
            pg8::Gemm g{(const pg8::bf16_t*)(ws_() + WS_H), (const pg8::bf16_t*)(ws_() + WS_WIN) + (size_t)l * ZW * DM, T, ZW, DM}; pg8::StaticOrder S; S.init(T, ZW, grid_(), bid_(), WGM_G1);
            EpiStoreBf16<0, true> E{(bf16_t*)(ws_() + WS_Z), ZW, (const float*)(ws_() + WS_SS2)};
            pg8::gemm_phase<EpiStoreBf16<0, true>, pg8::StaticOrder, true, true>((PG8_LAS unsigned char*)lds, g, S, E);
            if (PROBE_DUP == 9) pg8::gemm_phase<EpiStoreBf16<0, true>, pg8::StaticOrder, true, true>((PG8_LAS unsigned char*)lds, g, S, E);
            if (l > 0) norm_phase<true, 1>(ws_() + WS_H, nullptr, nullptr, nullptr, nullptr, (const float*)(ws_() + WS_WF) + (size_t)l * DM * 4, INP(23) + l * 4, (float*)(ws_() + WS_LOGF));
            SEAM(pb + 1);
        }
        if (IN(pb + 2)) {
            for (int rep = 0; rep < (PROBE_DUP == 2 ? 2 : 1); ++rep)
            for (int it = bid_(); it < 260; it += grid_()) {
                if (it < 128) { if (ITEM_MASK & 1) s5_item<1>(l, it >> 5, it & 31, a, lds); }
                else if (it < 256) { if (ITEM_MASK & 4) lru_item<1>(l, (it - 128) >> 5, (it - 128) & 31, a, lds); }
                else { if (ITEM_MASK & 8) cumsum_item(it - 256, (const float*)(ws_() + WS_LOGF), (float*)(ws_() + WS_CS), lds); }
            }
            SEAM(pb + 2);
        }
        if (IN(pb + 3)) {
            for (int rep = 0; rep < (PROBE_DUP == 3 ? 2 : 1); ++rep) {
            for (int rep2 = 0; rep2 < (PROBE_DUP == 5 ? 2 : 1); ++rep2)
            for (int up = bid_(); up < 256; up += grid_()) {
                const int xcd_ = up & 7, ix_ = up >> 3, pr = xcd_ + 8 * (ix_ >> 4), j = ix_ & 15;
                if (ITEM_MASK & 16) { attn_unit(pr >> 2, pr & 3, 31 - j, a, lds);
                attn_unit(pr >> 2, pr & 3, j, a, lds); }
            }
            for (int rep3 = 0; rep3 < (PROBE_DUP == 6 ? 2 : 1); ++rep3)
            for (int it = bid_(); it < 256; it += grid_()) {
                if (it < 128) { if (ITEM_MASK & 32) s5_item<2>(l, it >> 5, it & 31, a, lds); }
                else { if (ITEM_MASK & 64) lru_item<2>(l, (it - 128) >> 5, (it - 128) & 31, a, lds); }
            }
            if (ITEM_MASK & 2) {
                unsigned* qctr = (unsigned*)(ws_() + WS_BAR) + 3600 + l;
                volatile LAS unsigned* qslot = (volatile LAS unsigned*)(lds + LDS_BYTES - 48);
                for (;;) {
                    __syncthreads();
                    if (opaque_tid() == 0) qslot[0] = __hip_atomic_fetch_add(qctr, 1u, __ATOMIC_RELAXED, __HIP_MEMORY_SCOPE_AGENT);
                    __syncthreads();
                    const unsigned qi = qslot[0];
                    if (qi >= 256u) break;
                    if (qi < 128u) sgu_item<1>(l, (int)(qi >> 5), (int)(qi & 31), a, lds);
                    else sgu_item<0>(l, (int)((qi - 128u) >> 5), (int)(qi & 31), a, lds);
                }
            }
            }
            SEAM(pb + 3);
        }
        if (IN(pb + 4)) {
            pg8::Gemm g{(const pg8::bf16_t*)(ws_() + WS_Y), (const pg8::bf16_t*)(ws_() + WS_WOUT) + (size_t)l * DM * DM, T, DM, DM}; pg8::StaticOrder S; S.init(T, DM, grid_(), bid_(), WGM_G2);
            EpiRes<true, true> E{(bf16_t*)(ws_() + WS_H), DM, (const float*)(ws_() + WS_SSD), (float*)(ws_() + WS_SS2)};
            pg8::gemm_phase<EpiRes<true, true>, pg8::StaticOrder, true, true>((PG8_LAS unsigned char*)lds, g, S, E);
            SEAM(pb + 4);
        }
        if (IN(pb + 6)) {
            pg8::Gemm g{(const pg8::bf16_t*)(ws_() + WS_H), (const pg8::bf16_t*)(ws_() + WS_WMI) + (size_t)l * DFF * DM, T, DFF, DM}; pg8::StaticOrder S; S.init(T, DFF, grid_(), bid_(), WGM_G3);
            EpiStoreBf16<1, true> E{(bf16_t*)(ws_() + WS_ACT), DFF, (const float*)(ws_() + WS_SS2)};
            pg8::gemm_phase<EpiStoreBf16<1, true>, pg8::StaticOrder, true, true>((PG8_LAS unsigned char*)lds, g, S, E);
            SEAM(pb + 6);
        }
        if (IN(pb + 7)) {
            pg8::Gemm g{(const pg8::bf16_t*)(ws_() + WS_ACT), (const pg8::bf16_t*)(ws_() + WS_WMO) + (size_t)l * DM * DFF, T, DM, DFF}; pg8::StaticOrder S; S.init(T, DM, grid_(), bid_(), WGM_G4);
            EpiRes<false, true> E{(bf16_t*)(ws_() + WS_H), DM, nullptr, (float*)(ws_() + WS_SS2)};
            pg8::gemm_phase<EpiRes<false, true>, pg8::StaticOrder, true, true>((PG8_LAS unsigned char*)lds, g, S, E);
            SEAM(pb + 7);
        }
    }
    if (IN(33)) norm_phase<true, 2>(ws_() + WS_H, INP(29), nullptr, nullptr, out_(), nullptr, nullptr, nullptr);
#undef SEAM
#undef IN
}


#ifndef DUMP_SEL
#define DUMP_SEL 0
#endif
#ifndef DUMP_LAST
#define DUMP_LAST 33
#endif
__global__ void dump_kernel(const unsigned char* ws, float* out) {
    const size_t i = (size_t)blockIdx.x * blockDim.x + threadIdx.x;
    const size_t t = i >> 10, c = i & 1023;
    float v = 0.f;
    if (DUMP_SEL == 1) v = bf2f(((const bf16_t*)(ws + WS_H))[i]);
    if (DUMP_SEL == 2) v = bf2f(((const bf16_t*)(ws + WS_Z))[t * ZW + c]) + bf2f(((const bf16_t*)(ws + WS_Z))[t * ZW + c + 1024]);
    if (DUMP_SEL == 3) v = bf2f(((const bf16_t*)(ws + WS_Y))[i]);
    if (DUMP_SEL == 5) v = ((const float*)(ws + WS_SSD))[(t * 4 + (c & 3))] + ((const float*)(ws + WS_CS))[(t * 4 + (c & 3))];
    if (DUMP_SEL == 7) v = ((const float*)(ws + WS_ELOC))[i & 262143];
    if (DUMP_SEL == 8) v = ((const float*)(ws + WS_LA))[i & 32767] + ((const float*)(ws + WS_LB))[i & 32767];
    if (DUMP_SEL == 6) v = bf2f(((const bf16_t*)(ws + WS_WIN))[i]) + bf2f(((const bf16_t*)(ws + WS_WMI))[i]) + bf2f(((const bf16_t*)(ws + WS_WMO))[i]) + bf2f(((const bf16_t*)(ws + WS_WOUT))[i & 0x3fffff]);
    out[i] = v;
}
#ifndef N_LAUNCH_MODE
#define N_LAUNCH_MODE 1
#endif
extern "C" void kernel_launch(void* const* d_in, const int* in_sizes, int n_in, void* d_out, int out_size, void* d_ws, size_t ws_size, hipStream_t stream) {
    static int grid = 0;
    if (grid == 0) {
        if (n_in != 30 || out_size != T * DM || ws_size < WS_END) { fprintf(stderr, "kernel_launch: unexpected shapes (n_in %d, out %d, ws %zu, need %zu)\n", n_in, out_size, ws_size, (size_t)WS_END); grid = -1; return; }
        int dev = 0, cus = 0, per_cu = 0;
        hipGetDevice(&dev); hipDeviceGetAttribute(&cus, hipDeviceAttributeMultiprocessorCount, dev);
        if (hipFuncSetAttribute((const void*)fwd_kernel, hipFuncAttributeMaxDynamicSharedMemorySize, LDS_BYTES) != hipSuccess) { fprintf(stderr, "kernel_launch: hipFuncSetAttribute failed\n"); grid = -1; return; }
        if (hipOccupancyMaxActiveBlocksPerMultiprocessor(&per_cu, (const void*)fwd_kernel, NTHR, LDS_BYTES) != hipSuccess || per_cu < 1) { fprintf(stderr, "kernel_launch: occupancy query says %d\n", per_cu); per_cu = 1; }
        (void)hipGetLastError();
        grid = cus;
        if (grid > 256) grid = 256;
    }
    if (grid < 0) return;
    Args a{};
    for (int i = 0; i < 30; ++i) a.in[i] = (const float*)d_in[i];
    a.out = (float*)d_out; a.ws = (unsigned char*)d_ws;
    if (N_LAUNCH_MODE == 1) {
        a.ph_lo = 0; a.ph_hi = 34;
        if (hipMemsetAsync((unsigned char*)d_ws + WS_BAR, 0, 16 * 1024, stream) != hipSuccess) { fprintf(stderr, "kernel_launch: memset of the barrier words failed\n"); return; }
        void* args[] = {&a};
        hipError_t e = hipLaunchCooperativeKernel((const void*)fwd_kernel, dim3(grid), dim3(NTHR), args, LDS_BYTES, stream);
        if (e != hipSuccess) fprintf(stderr, "kernel_launch: cooperative launch failed: %s (grid %d)\n", hipGetErrorString(e), grid);
    } else {
        for (int ph = 0; ph <= DUMP_LAST; ++ph) { a.ph_lo = ph; a.ph_hi = ph + 1; hipLaunchKernelGGL(fwd_kernel, dim3(grid), dim3(NTHR), LDS_BYTES, stream, a); }
        if (DUMP_SEL != 0 && DUMP_SEL != 4) hipLaunchKernelGGL(dump_kernel, dim3(T * DM / 256), dim3(256), 0, stream, (const unsigned char*)d_ws, (float*)d_out);
    }
}
```

```cpp
#include <hip/hip_runtime.h>
#include <hip/hip_cooperative_groups.h>
#include <cstdio>
#include <cstdint>
namespace cg = cooperative_groups;
__device__ __forceinline__ int opaque_tid() { int t = __builtin_amdgcn_workitem_id_x(); asm volatile("" : "+v"(t)); return t; }
namespace pg8 {
#define PG8_LAS __attribute__((address_space(3)))
typedef unsigned short bf16_t;
typedef short bf16x8 __attribute__((ext_vector_type(8)));
typedef float f32x4 __attribute__((ext_vector_type(4)));
typedef unsigned u32x4 __attribute__((ext_vector_type(4)));
constexpr int BM = 256, BK = 64, HALF = 128, HTB = HALF * BK * 2  , STAGE_BYTES = 8 * HTB, NXCD = 8, WGM = 4;

__host__ __device__ __forceinline__ int lds_byte(int r, int c) { const int st = (r >> 4) * 2 + (c >> 5), rr = r & 15, cc = c & 31, ob = rr * 64 + cc * 2; return st * 1024 + (ob ^ (((ob >> 9) & 1) << 5)); }
__host__ __device__ __forceinline__ void stage_rc(int b, int& R, int& C) { const int st = b / 1024, sb = b % 1024, swz = sb ^ (((sb >> 9) & 1) << 5); R = (st >> 1) * 16 + swz / 64; C = (st & 1) * 32 + (swz % 64) / 2; }
__host__ __device__ __forceinline__ int perm32(int rho) { const int n = rho >> 4, i = rho & 15; return 8 * (i >> 2) + 4 * n + (i & 3); }

struct Unit { int pm, pn; };
struct Gemm { const bf16_t* A; const bf16_t* Bt; int M, N, K; };

struct StaticOrder {
    int nM, nN, nwg, G, c, wgm;
    __host__ __device__ void init(int M, int N, int G_, int c_, int wgm_ = WGM) { nM = M / BM; nN = N / BM; nwg = nM * nN; G = G_; c = c_; wgm = wgm_; }
    __host__ __device__ bool next(int i, Unit& u) const {
        const long L = (long)i * G + c; if (L >= nwg) return false;
        int wgid = (int)L; { const int q = nwg / NXCD, r = nwg % NXCD, xcd = wgid % NXCD, off = wgid / NXCD; wgid = (xcd < r ? xcd * (q + 1) : r * (q + 1) + (xcd - r) * q) + off; }
        const int nig = wgm * nN, gid = wgid / nig, fm = gid * wgm, gsz = (nM - fm) < wgm ? (nM - fm) : wgm;
        u.pm = fm + ((wgid % nig) % gsz); u.pn = (wgid % nig) / gsz; return true;
    }
    __device__ __forceinline__ void a_ready(const Unit&) const {}
    __device__ __forceinline__ void done(const Unit&) const {}
};

__device__ __forceinline__ unsigned cvt_pk_bf16(float lo, float hi) { unsigned r; asm volatile("v_cvt_pk_bf16_f32 %0, %1, %2" : "=v"(r) : "v"(lo), "v"(hi)); return r; }
template <class Epi, class Sched, bool ALIGN_EPI = false, bool SP2 = false>
__device__ __forceinline__ void gemm_phase(PG8_LAS unsigned char* lds, const Gemm g, const Sched& S, const Epi& E) {
    const int tid = opaque_tid(), wid = __builtin_amdgcn_readfirstlane(tid >> 6), lane = tid & 63, wr = wid >> 2, wc = wid & 3, fr = lane & 15, fq = lane >> 4;
    const int K = g.K, nt = K / BK;
    unsigned voffA[2], voffB[2];
#pragma unroll
    for (int i = 0; i < 2; ++i) { int R, C; stage_rc(tid * 16 + i * 8192, R, C); const int Rb = Epi::PERM ? ((R & ~31) + perm32(R & 31)) : R;
        voffA[i] = (unsigned)(R * K + C) * 2u; voffB[i] = (unsigned)(Rb * K + C) * 2u; }
    const size_t kstep = (size_t)(BK * 2);
    const size_t hstep = (size_t)HALF * K * 2;
    const size_t tstep = 2 * hstep;
    const unsigned ldsw = (unsigned)wid * 1024u;
    const int aoff = lds_byte(wr * 64 + fr, fq * 8), boff = lds_byte(wc * 32 + fr, fq * 8);
#define PG8_SA(b, h) (((b) * 2 + (h)) * HTB)
#define PG8_SB(b, h) ((4 + (b) * 2 + (h)) * HTB)
#define PG8_STAGE(bufoff, gbase, voff) do { _Pragma("unroll") for (int _i = 0; _i < 2; ++_i) \
        __builtin_amdgcn_global_load_lds((const unsigned*)((const char*)(gbase) + (voff)[_i]), (PG8_LAS unsigned*)(lds + (bufoff) + ldsw + _i * 8192), 16, 0, 0); } while (0)
#define PG8_LDA(dst, b, h) do { _Pragma("unroll") for (int m = 0; m < 4; ++m) _Pragma("unroll") for (int k = 0; k < 2; ++k) dst[m][k] = *(const PG8_LAS bf16x8*)(lds + PG8_SA(b, h) + aoff + m * 2048 + k * 1024); } while (0)
#define PG8_LDB(dst, b, h) do { _Pragma("unroll") for (int n = 0; n < 2; ++n) _Pragma("unroll") for (int k = 0; k < 2; ++k) dst[n][k] = *(const PG8_LAS bf16x8*)(lds + PG8_SB(b, h) + boff + n * 2048 + k * 1024); } while (0)
#define PG8_MMA(ai, bj, At, Bt) do { __builtin_amdgcn_s_setprio(1); _Pragma("unroll") for (int m = 0; m < 4; ++m) _Pragma("unroll") for (int n = 0; n < 2; ++n) _Pragma("unroll") for (int k = 0; k < 2; ++k) \
        acc[ai][bj][m][n] = __builtin_amdgcn_mfma_f32_16x16x32_bf16(Bt[n][k], At[m][k], acc[ai][bj][m][n], 0, 0, 0); __builtin_amdgcn_s_setprio(0); } while (0)
#define PG8_WAIT_V(n) asm volatile("s_waitcnt vmcnt(" #n ")" ::: "memory")
#define PG8_WAIT_L(n) asm volatile("s_waitcnt lgkmcnt(" #n ")" ::: "memory")
#define PG8_BAR __builtin_amdgcn_s_barrier()
#define PG8_SCHED __builtin_amdgcn_sched_barrier(0)
    Unit cur, nxt; int ui = 0;
    if (!S.next(0, cur)) return;
    if constexpr (Epi::KPREP) { Unit pu; for (int i = 0; i < 12 && S.next(i, pu); ++i) E.kprep(pu, lds + STAGE_BYTES + i * 1024, tid); }
    f32x4 acc[2][2][4][2];
#pragma unroll
    for (int a = 0; a < 2; ++a)
#pragma unroll
        for (int b = 0; b < 2; ++b)
#pragma unroll
            for (int m = 0; m < 4; ++m)
#pragma unroll
                for (int n = 0; n < 2; ++n) acc[a][b][m][n] = (f32x4){0.f, 0.f, 0.f, 0.f};
    bf16x8 At[4][2], B0[2][2], B1[2][2];
    const char* cA = (const char*)g.A + (size_t)cur.pm * tstep; const char* cB = (const char*)g.Bt + (size_t)cur.pn * tstep;
    S.a_ready(cur);
    if constexpr (SP2) {
        PG8_STAGE(PG8_SB(0, 0), cB, voffB); PG8_STAGE(PG8_SB(0, 1), cB + hstep, voffB); PG8_STAGE(PG8_SA(0, 0), cA, voffA); PG8_STAGE(PG8_SA(0, 1), cA + hstep, voffA);
        if (wr == 1) PG8_BAR;
        PG8_WAIT_V(2); PG8_BAR;
        PG8_STAGE(PG8_SB(1, 0), cB + kstep, voffB); PG8_STAGE(PG8_SA(1, 0), cA + kstep, voffA); PG8_STAGE(PG8_SB(1, 1), cB + hstep + kstep, voffB);
        PG8_WAIT_V(6); PG8_BAR;
    } else {
        PG8_STAGE(PG8_SB(0, 0), cB, voffB); PG8_STAGE(PG8_SA(0, 0), cA, voffA); PG8_STAGE(PG8_SB(0, 1), cB + hstep, voffB); PG8_STAGE(PG8_SA(0, 1), cA + hstep, voffA);
        if (wr == 1) PG8_BAR;
        PG8_WAIT_V(4); PG8_BAR;
        PG8_STAGE(PG8_SB(1, 0), cB + kstep, voffB); PG8_STAGE(PG8_SA(1, 0), cA + kstep, voffA); PG8_STAGE(PG8_SB(1, 1), cB + hstep + kstep, voffB);
        PG8_WAIT_V(6); PG8_BAR;
    }
    for (;;) {
        const bool has_next = S.next(ui + 1, nxt);
        const char* nA = has_next ? (const char*)g.A + (size_t)nxt.pm * tstep : cA; const char* nB = has_next ? (const char*)g.Bt + (size_t)nxt.pn * tstep : cB;
        for (int t = 0; t < nt; t += 2) {
            const bool last = (t == nt - 2);
            const char* a1 = cA + (size_t)(t + 1) * kstep;
            const char* a2 = last ? nA : cA + (size_t)(t + 2) * kstep; const char* b2 = last ? nB : cB + (size_t)(t + 2) * kstep;
            const char* a3 = a2 + kstep; const char* b3 = b2 + kstep;
            if (last && has_next) S.a_ready(nxt);
            if constexpr (SP2) {
            PG8_LDB(B0, 0, 0); PG8_LDB(B1, 0, 1); PG8_SCHED; PG8_LDA(At, 0, 0); PG8_STAGE(PG8_SA(1, 1), a1 + hstep, voffA);
            PG8_WAIT_V(8); PG8_WAIT_L(0); PG8_BAR; PG8_MMA(0, 0, At, B0); PG8_MMA(0, 1, At, B1); PG8_BAR; PG8_SCHED;
            PG8_LDA(At, 0, 1); PG8_STAGE(PG8_SB(0, 0), b2, voffB); PG8_STAGE(PG8_SB(0, 1), b2 + hstep, voffB); PG8_STAGE(PG8_SA(0, 0), a2, voffA);
            PG8_WAIT_V(8); PG8_WAIT_L(0); PG8_BAR; PG8_MMA(1, 0, At, B0); PG8_MMA(1, 1, At, B1); PG8_BAR; PG8_SCHED;
            PG8_LDB(B0, 1, 0); PG8_LDB(B1, 1, 1); PG8_SCHED; PG8_LDA(At, 1, 0); PG8_STAGE(PG8_SA(0, 1), a2 + hstep, voffA);
            PG8_WAIT_V(8); PG8_WAIT_L(0); PG8_BAR; PG8_MMA(0, 0, At, B0); PG8_MMA(0, 1, At, B1); PG8_BAR; PG8_SCHED;
            PG8_LDA(At, 1, 1); PG8_STAGE(PG8_SB(1, 0), b3, voffB); PG8_STAGE(PG8_SB(1, 1), b3 + hstep, voffB); PG8_STAGE(PG8_SA(1, 0), a3, voffA);
            PG8_WAIT_V(8); PG8_WAIT_L(0); PG8_BAR; PG8_MMA(1, 0, At, B0); PG8_MMA(1, 1, At, B1); PG8_BAR; PG8_SCHED;
            } else {
            PG8_LDB(B0, 0, 0); PG8_SCHED; PG8_LDA(At, 0, 0); PG8_STAGE(PG8_SA(1, 1), a1 + hstep, voffA);
            PG8_WAIT_L(8); PG8_BAR; PG8_WAIT_L(0); PG8_MMA(0, 0, At, B0); PG8_BAR; PG8_SCHED;
            PG8_LDB(B1, 0, 1); PG8_STAGE(PG8_SB(0, 0), b2, voffB);
            PG8_BAR; PG8_WAIT_L(0); PG8_MMA(0, 1, At, B1); PG8_BAR;
            PG8_LDA(At, 0, 1); PG8_STAGE(PG8_SA(0, 0), a2, voffA);
            PG8_BAR; PG8_WAIT_L(0); PG8_MMA(1, 0, At, B0); PG8_BAR; PG8_SCHED;
            PG8_STAGE(PG8_SB(0, 1), b2 + hstep, voffB);
            PG8_WAIT_V(6); PG8_BAR; PG8_MMA(1, 1, At, B1); PG8_BAR;
            PG8_LDB(B0, 1, 0); PG8_SCHED; PG8_LDA(At, 1, 0); PG8_STAGE(PG8_SA(0, 1), a2 + hstep, voffA);
            PG8_WAIT_L(8); PG8_BAR; PG8_WAIT_L(0); PG8_MMA(0, 0, At, B0); PG8_BAR; PG8_SCHED;
            PG8_LDB(B1, 1, 1); PG8_STAGE(PG8_SB(1, 0), b3, voffB);
            PG8_BAR; PG8_WAIT_L(0); PG8_MMA(0, 1, At, B1); PG8_BAR;
            PG8_LDA(At, 1, 1); PG8_STAGE(PG8_SA(1, 0), a3, voffA);
            PG8_BAR; PG8_WAIT_L(0); PG8_MMA(1, 0, At, B0); PG8_BAR; PG8_SCHED;
            PG8_STAGE(PG8_SB(1, 1), b3 + hstep, voffB);
            PG8_WAIT_V(6); PG8_BAR; PG8_MMA(1, 1, At, B1); PG8_BAR;
            }
            if constexpr (Epi::KHOOK) { if (t == 2) E.khook(acc, lds + STAGE_BYTES + ui * 1024, wr, fr); }
        }
        if constexpr (ALIGN_EPI) { if (wr == 0) PG8_BAR; }
        if constexpr (!Epi::AFTER_DRAIN) { E(acc, cur, wr, wc, fr, fq, lds + STAGE_BYTES + ui * 1024); S.done(cur); }
        if (!has_next) break;
#pragma unroll
        for (int a = 0; a < 2; ++a)
#pragma unroll
            for (int b = 0; b < 2; ++b)
#pragma unroll
                for (int m = 0; m < 4; ++m)
#pragma unroll
                    for (int n = 0; n < 2; ++n) acc[a][b][m][n] = (f32x4){0.f, 0.f, 0.f, 0.f};
        cur = nxt; cA = nA; cB = nB; ++ui;
        if constexpr (ALIGN_EPI) { if (wr == 1) PG8_BAR; }
    }
    PG8_WAIT_V(0);
    if constexpr (!ALIGN_EPI) { if (wr == 0) PG8_BAR; }
    PG8_BAR;
    if constexpr (Epi::AFTER_DRAIN) { E.fused(acc, cur, wr, wc, fr, fq, lds, wid, lane); S.done(cur); }
#undef PG8_SA
#undef PG8_SB
#undef PG8_STAGE
#undef PG8_LDA
#undef PG8_LDB
#undef PG8_MMA
#undef PG8_WAIT_V
#undef PG8_WAIT_L
#undef PG8_BAR
#undef PG8_SCHED
}
}

#define LAS __attribute__((address_space(3)))
typedef unsigned short bf16_t;
typedef short bf16x8 __attribute__((ext_vector_type(8)));
typedef short bf16x4 __attribute__((ext_vector_type(4)));
typedef float f32x4 __attribute__((ext_vector_type(4)));
typedef float f32x2 __attribute__((ext_vector_type(2)));
typedef unsigned u32x4 __attribute__((ext_vector_type(4)));
typedef unsigned u32x2 __attribute__((ext_vector_type(2)));
typedef short v4i16_t __attribute__((ext_vector_type(4)));

constexpr int NB = 4, SEQ = 4096, DM = 1024, DEPTH = 4, T = NB * SEQ, W = 256, DFF = 4096, NIN = 2052, ZW = 2048;
constexpr int NCH = SEQ / 128;
constexpr float EPS = 1e-6f;
constexpr float LOG2E = 1.4426950408889634f;
constexpr int NTHR = 512;
constexpr int LDS_BYTES = 147456;
constexpr int ZC_AU = 0, ZC_AV = 256, ZC_B = 512, ZC_CX = 768, ZC_CG = 1024, ZC_Q = 1280, ZC_K = 1536, ZC_V = 1792;
constexpr int YC_D = 0, YC_A = 256, YC_B = 512, YC_C = 768;

constexpr size_t MiB = 1u << 20;
constexpr size_t WS_WIN = 0, WS_WOUT = 16 * MiB, WS_WMI = 24 * MiB, WS_WMO = 56 * MiB, WS_R = 88 * MiB, WS_Z = WS_R, WS_Y = WS_R + 64 * MiB, WS_ACT = WS_R,
                 WS_H = 216 * MiB, WS_S = 248 * MiB;
constexpr size_t WS_GLUT = WS_S, WS_WAT = WS_GLUT + 512 * 1024, WS_WXT = WS_WAT + 128 * 1024, WS_BBT = WS_WXT + 128 * 1024, WS_CMT = WS_BBT + 256 * 1024,
                 WS_ABAR = WS_CMT + 256 * 1024, WS_A128 = WS_ABAR + 32 * 1024, WS_WF = WS_A128 + 32 * 1024, WS_LOGF = WS_WF + 64 * 1024, WS_CS = WS_LOGF + 256 * 1024,
                 WS_SSD = WS_CS + 256 * 1024, WS_ELOC = WS_SSD + 256 * 1024, WS_LA = WS_ELOC + 1024 * 1024, WS_LB = WS_LA + 128 * 1024, WS_BAR = WS_LB + 128 * 1024, WS_SS2 = WS_BAR + 16 * 1024, WS_KMAX = WS_SS2 + 1024 * 1024, WS_END = WS_KMAX + 4096;

struct Args {
    const float* in[30]; float* out; unsigned char* ws; int ph_lo, ph_hi;
};


typedef const __attribute__((address_space(4))) unsigned long long* kargp_t;
__device__ __forceinline__ unsigned long long karg_(int i) { kargp_t tab = (kargp_t)__builtin_amdgcn_kernarg_segment_ptr(); asm volatile("" : "+s"(tab)); return tab[i]; }
#define INP(i) ((const float*)karg_(i))
__device__ __forceinline__ unsigned char* ws_() { return (unsigned char*)karg_(31); }
__device__ __forceinline__ float* out_() { return (float*)karg_(30); }
#define PH_LO ((int)(unsigned)(karg_(32) & 0xffffffffull))
#define PH_HI ((int)(unsigned)(karg_(32) >> 32))
__device__ __forceinline__ int bid_() { return blockIdx.x; }
__device__ __forceinline__ int grid_() { return gridDim.x; }
__device__ __forceinline__ float bf2f(bf16_t v) { return __uint_as_float((unsigned)v << 16); }
__device__ __forceinline__ float bfs2f(short v) { return __uint_as_float(((unsigned)(unsigned short)v) << 16); }
typedef __bf16 bf16x2_t __attribute__((ext_vector_type(2)));
__device__ __forceinline__ unsigned pk2(float lo, float hi) { const f32x2 v = {lo, hi}; const bf16x2_t b = __builtin_convertvector(v, bf16x2_t); return __builtin_bit_cast(unsigned, b); }
__device__ __forceinline__ bf16_t f2bf(float f) { return (bf16_t)(pk2(f, 0.f) & 0xffffu); }
__device__ __forceinline__ float gelu_t(float x) { const float y2 = (1.5957691216057308f * LOG2E) * (x + 0.044715f * x * x * x); return x * __builtin_amdgcn_rcpf(1.0f + __builtin_amdgcn_exp2f(-y2)); }
__device__ __forceinline__ float sigm(float x) { return __builtin_amdgcn_rcpf(1.0f + __builtin_amdgcn_exp2f(-LOG2E * x)); }
__device__ __forceinline__ float softplus_f(float x) { return fmaxf(x, 0.f) + log1pf(__expf(-fabsf(x))); }
__device__ __forceinline__ f32x4 mfma16(bf16x8 a, bf16x8 b, f32x4 c) { return __builtin_amdgcn_mfma_f32_16x16x32_bf16(a, b, c, 0, 0, 0); }
__device__ __forceinline__ float quad_sum(float v) {
    { const auto r = __builtin_amdgcn_permlane16_swap(__float_as_uint(v), __float_as_uint(v), false, false); v = __uint_as_float(r[0]) + __uint_as_float(r[1]); }
    { const auto r = __builtin_amdgcn_permlane32_swap(__float_as_uint(v), __float_as_uint(v), false, false); v = __uint_as_float(r[0]) + __uint_as_float(r[1]); }
    return v;
}
template <int CTRL> __device__ __forceinline__ float dpp_mov(float x) { return __uint_as_float((unsigned)__builtin_amdgcn_update_dpp(0, (int)__float_as_uint(x), CTRL, 0xf, 0xf, true)); }
__device__ __forceinline__ float wave_sum(float v) {
    v += dpp_mov<0xB1>(v); v += dpp_mov<0x4E>(v); v += dpp_mov<0x141>(v); v += dpp_mov<0x140>(v);
    return quad_sum(v);
}
__device__ __forceinline__ float wave_max(float v);
__device__ __forceinline__ float quad_max(float v) {
    { const auto r = __builtin_amdgcn_permlane16_swap(__float_as_uint(v), __float_as_uint(v), false, false); v = fmaxf(__uint_as_float(r[0]), __uint_as_float(r[1])); }
    { const auto r = __builtin_amdgcn_permlane32_swap(__float_as_uint(v), __float_as_uint(v), false, false); v = fmaxf(__uint_as_float(r[0]), __uint_as_float(r[1])); }
    return v;
}
__device__ __forceinline__ bf16x8 pack8(const float* v) {
    u32x4 w; w.x = pk2(v[0], v[1]); w.y = pk2(v[2], v[3]); w.z = pk2(v[4], v[5]); w.w = pk2(v[6], v[7]); return __builtin_bit_cast(bf16x8, w);
}
__device__ __forceinline__ bf16x8 zero8() { return (bf16x8){0, 0, 0, 0, 0, 0, 0, 0}; }

__device__ __forceinline__ float wave_max(float v) {
    v = fmaxf(v, dpp_mov<0xB1>(v)); v = fmaxf(v, dpp_mov<0x4E>(v)); v = fmaxf(v, dpp_mov<0x141>(v)); v = fmaxf(v, dpp_mov<0x140>(v));
    return quad_max(v);
}
template <int N> __device__ __forceinline__ float dpp_shr(float x, float ident) {
    return __uint_as_float((unsigned)__builtin_amdgcn_update_dpp((int)__float_as_uint(ident), (int)__float_as_uint(x), 0x110 + N, 0xf, 0xf, false));
}
__device__ __forceinline__ float neg_expm1(float x) {
    const float s = -x * (1.0f + x * (0.5f + x * (0.16666667f + x * (0.041666668f + x * (0.0083333338f + x * 0.0013888889f)))));
    const float e = 1.0f - __builtin_amdgcn_exp2f(LOG2E * x);
    return (x > -0.25f) ? s : e;
}
template <int ACT  , bool ROWS = false> struct EpiStoreBf16 {
    static constexpr bool PERM = true, AFTER_DRAIN = false, KHOOK = false, KPREP = ROWS;
    __device__ __forceinline__ void kprep(const pg8::Unit& u, PG8_LAS unsigned char* tab, int tid) const {
        if (tid < 256) { const float* rp = rowss + (size_t)(u.pm * 256 + tid) * 16; const f32x4 s0 = *(const f32x4*)rp, s1 = *(const f32x4*)(rp + 4), s2 = *(const f32x4*)(rp + 8), s3 = *(const f32x4*)(rp + 12);
            const float tot = ((s0[0] + s0[1]) + (s0[2] + s0[3])) + ((s1[0] + s1[1]) + (s1[2] + s1[3])) + ((s2[0] + s2[1]) + (s2[2] + s2[3])) + ((s3[0] + s3[1]) + (s3[2] + s3[3]));
            ((PG8_LAS float*)tab)[tid] = rsqrtf(tot * (1.0f / DM) + EPS); }
    }
    bf16_t* O; int ldc; const float* rowss;
    __device__ __forceinline__ void operator()(const pg8::f32x4 (&acc)[2][2][4][2], const pg8::Unit& u, int wr, int wc, int fr, int fq, PG8_LAS unsigned char* tab) const {
        const int row0 = u.pm * 256 + wr * 64 + fr, col0 = u.pn * 256 + wc * 32 + 8 * fq;
#pragma unroll
        for (int ai = 0; ai < 2; ++ai)
#pragma unroll
            for (int m = 0; m < 4; ++m) { bf16_t* rowp = O + (size_t)(row0 + ai * 128 + m * 16) * ldc + col0;
                const float rsc = ROWS ? ((const PG8_LAS float*)tab)[wr * 64 + fr + ai * 128 + m * 16] : 1.0f;
#pragma unroll
                for (int bj = 0; bj < 2; ++bj) { pg8::f32x4 v0 = acc[ai][bj][m][0] * rsc, v1 = acc[ai][bj][m][1] * rsc;
                    if (ACT == 1) {
#pragma unroll
                        for (int e = 0; e < 4; ++e) { const float a = fmaxf(v0[e], 0.f), b = fmaxf(v1[e], 0.f); v0[e] = a * a; v1[e] = b * b; } }
                    u32x4 w; w.x = pk2(v0[0], v0[1]); w.y = pk2(v0[2], v0[3]); w.z = pk2(v1[0], v1[1]); w.w = pk2(v1[2], v1[3]);
                    *(u32x4*)(rowp + bj * 128) = w; } }
    }
};
template <bool HOOK, bool NORMOUT> struct EpiRes {
    static constexpr bool PERM = true, AFTER_DRAIN = false, KHOOK = HOOK, KPREP = HOOK;
    bf16_t* xb; int ldc; const float* ssd; float* ss2;
    __device__ __forceinline__ void operator()(const pg8::f32x4 (&acc)[2][2][4][2], const pg8::Unit& u, int wr, int wc, int fr, int fq, PG8_LAS unsigned char* tab) const {
        const int col0 = u.pn * 256 + wc * 32 + 8 * fq;
#pragma unroll
        for (int ai = 0; ai < 2; ++ai)
#pragma unroll
            for (int m = 0; m < 4; ++m) { const int row = u.pm * 256 + ai * 128 + wr * 64 + m * 16 + fr; bf16_t* rowp = xb + (size_t)row * ldc + col0; float sq = 0.f;
#pragma unroll
                for (int bj = 0; bj < 2; ++bj) { const bf16x8 s = *(const bf16x8*)(rowp + bj * 128); float o[8];
#pragma unroll
                    for (int e = 0; e < 4; ++e) { o[e] = bfs2f(s[e]) + acc[ai][bj][m][0][e]; o[4 + e] = bfs2f(s[4 + e]) + acc[ai][bj][m][1][e]; }
                    if (NORMOUT) {
#pragma unroll
                        for (int e = 0; e < 8; ++e) sq += o[e] * o[e]; }
                    *(bf16x8*)(rowp + bj * 128) = pack8(o); }
                if (NORMOUT) { sq = quad_sum(sq); if (fq == 0) ss2[(size_t)row * 16 + u.pn * 4 + wc] = sq; }
                if (m & 1) asm volatile("" ::: "memory"); }
    }
    __device__ __forceinline__ void kprep(const pg8::Unit& u, PG8_LAS unsigned char* tab, int tid) const {
        if (tid < 256) { const f32x4 s4 = *(const f32x4*)(ssd + (size_t)(u.pm * 256 + tid) * 4); ((PG8_LAS float*)tab)[tid] = rsqrtf((s4[0] + s4[1] + s4[2] + s4[3]) * (1.0f / 256.0f) + EPS); }
    }
    __device__ __forceinline__ void khook(pg8::f32x4 (&acc)[2][2][4][2], PG8_LAS unsigned char* tab, int wr, int fr) const {
#pragma unroll
        for (int ai = 0; ai < 2; ++ai)
#pragma unroll
            for (int m = 0; m < 4; ++m) { const float rs = ((const PG8_LAS float*)tab)[ai * 128 + wr * 64 + m * 16 + fr];
#pragma unroll
                for (int bj = 0; bj < 2; ++bj)
#pragma unroll
                    for (int n = 0; n < 2; ++n) acc[ai][bj][m][n] *= rs; }
    }
};

template <int TN> __device__ __forceinline__ void tc_job(unsigned char* lds, const float* src, size_t sb, int ld, int K, int N, int nbatch, bf16_t* dst, const float* gain, int kshift, int rot) {
    LAS float* tile = (LAS float*)lds;
    constexpr int CG = TN / 64, NLD = TN / 32  , NST = TN / 64  ;
    const int tid = opaque_tid(), nk = K / 64, nn = N / TN, ntile = nbatch * nk * nn;
    for (int ti = (int)((bid_() + grid_() - (rot % grid_())) % grid_()); ti < ntile; ti += grid_()) {
        const int b = ti / (nk * nn), rem = ti % (nk * nn), kt = rem / nn, nt = rem % nn;
        const float* s = src + (size_t)b * sb + (size_t)(kt * 64) * ld + nt * TN;
        f32x4 v[NLD];
#pragma unroll
        for (int p = 0; p < NLD; ++p) { const int idx = tid + 512 * p, c16 = idx & 15, kq = (idx >> 4) & 3, rest = idx >> 6, kl = (rest / CG) * 4 + kq, n4 = ((rest % CG) * 16 + c16) * 4;
            v[p] = *(const f32x4*)(s + (size_t)kl * ld + n4);
            if (gain) { const float gg = gain[(size_t)b * K + kt * 64 + kl]; v[p] = v[p] * gg; } }
        __syncthreads();
#pragma unroll
        for (int p = 0; p < NLD; ++p) { const int idx = tid + 512 * p, c16 = idx & 15, kq = (idx >> 4) & 3, rest = idx >> 6, kl = (rest / CG) * 4 + kq, n4 = ((rest % CG) * 16 + c16) * 4;
            tile[kl * (TN + 1) + n4 + 0] = v[p][0]; tile[kl * (TN + 1) + n4 + 1] = v[p][1]; tile[kl * (TN + 1) + n4 + 2] = v[p][2]; tile[kl * (TN + 1) + n4 + 3] = v[p][3]; }
        __syncthreads();
#pragma unroll
        for (int p = 0; p < NST; ++p) { const int idx = tid + 512 * p, nl = idx >> 3, kc = (idx & 7) * 8; float o[8];
#pragma unroll
            for (int e = 0; e < 8; ++e) o[e] = tile[(kc + e) * (TN + 1) + nl];
            const int kd = (kt * 64 + kc + kshift) % K;
            *(bf16x8*)(dst + (size_t)b * N * K + (size_t)(nt * TN + nl) * K + kd) = pack8(o); }
    }
    __syncthreads();
}

__device__ __forceinline__ void prep_phase(const Args& a, unsigned char* lds) {
    unsigned char* ws = ws_();
    tc_job<256>(lds, INP(2), (size_t)DM * NIN, NIN, DM, ZW, DEPTH, (bf16_t*)(ws + WS_WIN), INP(1), 0, 0);
    tc_job<256>(lds, INP(25), (size_t)DM * DM, DM, DM, DM, DEPTH, (bf16_t*)(ws + WS_WOUT), INP(24), 256, 0);
    tc_job<256>(lds, INP(27), (size_t)DM * DFF, DFF, DM, DFF, DEPTH, (bf16_t*)(ws + WS_WMI), INP(26), 0, 0);
    tc_job<256>(lds, INP(28), (size_t)DFF * DM, DM, DFF, DM, DEPTH, (bf16_t*)(ws + WS_WMO), nullptr, 0, 0);
    tc_job<256>(lds, INP(14), (size_t)W * W, W, W, W, DEPTH, (bf16_t*)(ws + WS_GLUT), nullptr, 0, 0);
    tc_job<64>(lds, INP(18), (size_t)64 * 64, 64, 64, 64, DEPTH * 4, (bf16_t*)(ws + WS_WAT), nullptr, 0, 64);
    tc_job<64>(lds, INP(20), (size_t)64 * 64, 64, 64, 64, DEPTH * 4, (bf16_t*)(ws + WS_WXT), nullptr, 0, 96);
    const int gid = bid_() * NTHR + opaque_tid();
    if (gid < DEPTH * 1024) {
        const int l = gid >> 10, gp = gid & 1023, g = gp >> 6, p = gp & 63;
        const float lre = INP(6)[gid], lim = INP(7)[gid], dt = expf(INP(8)[l * 16 + g]);
        const float mag = expf(lre * dt), are = mag * cosf(lim * dt), aim = mag * sinf(lim * dt);
        const float den = lre * lre + lim * lim, nre = are - 1.0f, nim = aim;
        const float fre = (nre * lre + nim * lim) / den, fim = (nim * lre - nre * lim) / den;
        ((f32x2*)(ws + WS_ABAR))[gid] = (f32x2){are, aim};
        float pr = are, pi = aim;
#pragma unroll
        for (int s = 0; s < 7; ++s) { const float nr = pr * pr - pi * pi, ni = 2.0f * pr * pi; pr = nr; pi = ni; }
        ((f32x2*)(ws + WS_A128))[gid] = (f32x2){pr, pi};
        const float* bre = INP(9) + (size_t)gid * 16; const float* bim = INP(10) + (size_t)gid * 16;
        bf16_t* bbt = (bf16_t*)(ws + WS_BBT) + ((size_t)(l * 16 + g) * 128 + 2 * p) * 16;
#pragma unroll
        for (int h = 0; h < 16; ++h) { const float br = bre[h], bi = bim[h]; bbt[h] = f2bf(fre * br - fim * bi); bbt[16 + h] = f2bf(fre * bi + fim * br); }
        bf16_t* cmt = (bf16_t*)(ws + WS_CMT) + (size_t)(l * 16 + g) * 16 * 128;
#pragma unroll
        for (int h = 0; h < 16; ++h) { const size_t ci = ((size_t)(l * 16 + g) * 16 + h) * 64 + p; ((unsigned*)cmt)[(h * 128 + 2 * p) >> 1] = pk2(INP(11)[ci], -INP(12)[ci]); }
        const float* wr = INP(2) + ((size_t)l * DM + gp) * NIN + ZW;
        ((f32x4*)(ws + WS_WF))[gid] = *(const f32x4*)wr * INP(1)[gid];
    }
}

template <bool SRCB, int MODE> __device__ __forceinline__ void norm_phase(const void* xsv, const float* g, bf16_t* xb, float* ss2, float* od, const float* wf, const float* bfg, float* logf) {
    const int lane = opaque_tid() & 63, wid = opaque_tid() >> 6;
    const int gw = bid_() * 8 + wid, nw = grid_() * 8;
    for (int row = gw; row < T; row += nw) {
        f32x4 v[4]; float ss = 0.f;
#pragma unroll
        for (int i = 0; i < 4; ++i) {
            if (SRCB) { const bf16x4 q = *(const bf16x4*)((const bf16_t*)xsv + (size_t)row * DM + i * 256 + lane * 4); v[i] = (f32x4){bfs2f(q[0]), bfs2f(q[1]), bfs2f(q[2]), bfs2f(q[3])}; }
            else { v[i] = *(const f32x4*)((const float*)xsv + (size_t)row * DM + i * 256 + lane * 4);
                if (MODE == 1) { u32x2 w; w.x = pk2(v[i][0], v[i][1]); w.y = pk2(v[i][2], v[i][3]); *(u32x2*)(xb + (size_t)row * DM + i * 256 + lane * 4) = w; } }
            ss += v[i][0] * v[i][0] + v[i][1] * v[i][1] + v[i][2] * v[i][2] + v[i][3] * v[i][3]; }
        ss = wave_sum(ss);
        const float rs = rsqrtf(ss * (1.0f / DM) + EPS);
        if (MODE == 1 && !SRCB) { if (lane < 16) ss2[(size_t)row * 16 + lane] = (lane == 0) ? ss : 0.f; }
        float f0 = 0.f, f1 = 0.f, f2 = 0.f, f3 = 0.f;
#pragma unroll
        for (int i = 0; i < 4; ++i) {
            if (MODE == 2) { const f32x4 gg = *(const f32x4*)(g + i * 256 + lane * 4); *(f32x4*)(od + (size_t)row * DM + i * 256 + lane * 4) = v[i] * rs * gg; }
            if (MODE == 1) {
#pragma unroll
                for (int e = 0; e < 4; ++e) { const f32x4 w4 = *(const f32x4*)(wf + (size_t)(i * 256 + lane * 4 + e) * 4); const float hv = v[i][e] * rs; f0 += hv * w4[0]; f1 += hv * w4[1]; f2 += hv * w4[2]; f3 += hv * w4[3]; } }
        }
        if (MODE == 1) {
            f0 = wave_sum(f0); f1 = wave_sum(f1); f2 = wave_sum(f2); f3 = wave_sum(f3);
            if (lane == 0) { f32x4 o; const float fv[4] = {f0 + bfg[0], f1 + bfg[1], f2 + bfg[2], f3 + bfg[3]};
#pragma unroll
                for (int e = 0; e < 4; ++e) o[e] = fminf(fv[e], 0.f) - log1pf(__expf(-fabsf(fv[e])));
                *(f32x4*)(logf + (size_t)row * 4) = o; }
        }
    }
}

__device__ __forceinline__ void cumsum_item(int b, const float* logf, float* cs, unsigned char* lds) {
    LAS float* wt = (LAS float*)lds;
    const int tid = opaque_tid(), lane = tid & 63, wid = tid >> 6;
    f32x4 v[8]; f32x4 run = (f32x4){0.f, 0.f, 0.f, 0.f};
    const float* src = logf + ((size_t)b * SEQ + (size_t)tid * 8) * 4;
#pragma unroll
    for (int e = 0; e < 8; ++e) { run = run + *(const f32x4*)(src + e * 4); v[e] = run; }
    f32x4 inc = run;
#pragma unroll
    for (int d = 1; d < 64; d <<= 1) {
        const int sl = ((lane >= d) ? lane - d : lane) << 2; f32x4 o;
#pragma unroll
        for (int e = 0; e < 4; ++e) o[e] = __uint_as_float((unsigned)__builtin_amdgcn_ds_bpermute(sl, (int)__float_as_uint(inc[e])));
        if (lane >= d) inc = inc + o;
    }
    __syncthreads();
    if (lane == 63) { wt[wid * 4 + 0] = inc[0]; wt[wid * 4 + 1] = inc[1]; wt[wid * 4 + 2] = inc[2]; wt[wid * 4 + 3] = inc[3]; }
    __syncthreads();
    f32x4 off = inc - run;
    for (int w2 = 0; w2 < wid; ++w2) { off[0] += wt[w2 * 4 + 0]; off[1] += wt[w2 * 4 + 1]; off[2] += wt[w2 * 4 + 2]; off[3] += wt[w2 * 4 + 3]; }
    float* dst = cs + ((size_t)b * SEQ + (size_t)tid * 8) * 4;
#pragma unroll
    for (int e = 0; e < 8; ++e) *(f32x4*)(dst + e * 4) = (v[e] + off) * LOG2E;
    __syncthreads();
}

template <int HALF> __device__ __forceinline__ void sgu_item(int l, int b, int c, const Args& a, unsigned char* lds) {
    const bf16_t* z = (const bf16_t*)(ws_() + WS_Z); bf16_t* y = (bf16_t*)(ws_() + WS_Y);
    LAS bf16_t* vnT = (LAS bf16_t*)lds;
    LAS float* ssb = (LAS float*)(lds + 69632);
    const int tid = opaque_tid(), lane = tid & 63, wid = tid >> 6, fr = lane & 15, quad = lane >> 4;
    const size_t t0 = (size_t)b * SEQ + (size_t)c * 128;
    const float* ng = INP(3) + l * W;
    __syncthreads();
    float gch[4];
#pragma unroll
    for (int e = 0; e < 4; ++e) gch[e] = ng[lane + 64 * e];
    constexpr int TPW = HALF ? 16 : 8;
#pragma unroll
    for (int half = 0; half < TPW / 8; ++half) {
        float val[8][4];
#pragma unroll
        for (int i = 0; i < 8; ++i) {
            const bf16_t* zr = z + (t0 + wid * TPW + half * 8 + i) * ZW + ZC_AV; float ss = 0.f;
#pragma unroll
            for (int e = 0; e < 4; ++e) { const float gv = gelu_t(bf2f(zr[lane + 64 * e])); val[i][e] = gv; ss += gv * gv; }
            ss = wave_sum(ss); const float rs = rsqrtf(ss * (1.0f / W) + EPS);
#pragma unroll
            for (int e = 0; e < 4; ++e) val[i][e] *= rs * gch[e];
        }
#pragma unroll
        for (int e = 0; e < 4; ++e) { float t8[8];
#pragma unroll
            for (int i = 0; i < 8; ++i) t8[i] = val[i][e];
            *(LAS bf16x8*)(vnT + (lane + 64 * e) * 136 + wid * TPW + half * 8) = pack8(t8); }
    }
    __syncthreads();
    const int h = wid & 3;
    const float* wsrc = INP(4) + ((size_t)(l * 4 + h) * 128) * 128;
    const float* bsrc = INP(5) + (size_t)(l * 4 + h) * 128;
    float outv[2][4][4];
#pragma unroll
    for (int i = 0; i < 2; ++i) {
        const int mt = HALF * 4 + (wid >> 2) + 2 * i, t = mt * 16 + fr;
        f32x4 acc[4];
#pragma unroll
        for (int nt = 0; nt < 4; ++nt) acc[nt] = (f32x4){0.f, 0.f, 0.f, 0.f};
        f32x4 wl[4][2];
#pragma unroll
        for (int kk = 0; kk < 4; ++kk) { const int k0 = (kk * 32 < (mt + 1) * 16) ? kk * 32 : 0; const float* wp = wsrc + (size_t)t * 128 + k0 + quad * 8; wl[kk][0] = *(const f32x4*)wp; wl[kk][1] = *(const f32x4*)(wp + 4); }
#pragma unroll
        for (int kk = 0; kk < 4; ++kk) {
            const int k0 = kk * 32;
            if (k0 < (mt + 1) * 16) {
                float wv[8] = {wl[kk][0][0], wl[kk][0][1], wl[kk][0][2], wl[kk][0][3], wl[kk][1][0], wl[kk][1][1], wl[kk][1][2], wl[kk][1][3]};
#pragma unroll
                for (int e = 0; e < 8; ++e) if (k0 + quad * 8 + e > t) wv[e] = 0.f;
                const bf16x8 wf = pack8(wv);
#pragma unroll
                for (int nt = 0; nt < 4; ++nt) { const bf16x8 vf = *(const LAS bf16x8*)(vnT + (h * 64 + nt * 16 + fr) * 136 + k0 + quad * 8); acc[nt] = mfma16(vf, wf, acc[nt]); }
            }
        }
        const float bs = bsrc[t]; float ss = 0.f;
#pragma unroll
        for (int nt = 0; nt < 4; ++nt) { const int ch = h * 64 + nt * 16 + quad * 4; const bf16x4 u4 = *(const bf16x4*)(z + (t0 + t) * ZW + ZC_AU + ch);
#pragma unroll
            for (int r = 0; r < 4; ++r) { const float o = gelu_t(bfs2f(u4[r])) * (acc[nt][r] + bs); outv[i][nt][r] = o; ss += o * o; } }
        ss = quad_sum(ss);
        if (quad == 0) ssb[t * 4 + h] = ss;
    }
    __syncthreads();
#pragma unroll
    for (int i = 0; i < 2; ++i) {
        const int mt = HALF * 4 + (wid >> 2) + 2 * i, t = mt * 16 + fr;
        const float rs = rsqrtf((ssb[t * 4 + 0] + ssb[t * 4 + 1] + ssb[t * 4 + 2] + ssb[t * 4 + 3]) * (1.0f / W) + EPS);
#pragma unroll
        for (int nt = 0; nt < 4; ++nt) { const int ch = h * 64 + nt * 16 + quad * 4; u32x2 w; w.x = pk2(outv[i][nt][0] * rs, outv[i][nt][1] * rs); w.y = pk2(outv[i][nt][2] * rs, outv[i][nt][3] * rs);
            *(u32x2*)(y + (t0 + t) * DM + YC_A + ch) = w; }
    }
    __syncthreads();
}

template <int PASS> __device__ __forceinline__ void s5_item(int l, int b, int c, const Args& a, unsigned char* lds) {
    const bf16_t* z = (const bf16_t*)(ws_() + WS_Z); bf16_t* y = (bf16_t*)(ws_() + WS_Y);
    LAS unsigned char* BU = (LAS unsigned char*)lds;
    LAS unsigned* BU32 = (LAS unsigned*)lds;
    LAS bf16_t* Yb = (LAS bf16_t*)(lds + 65792);
    LAS float* ssb = (LAS float*)(lds + 65792 + 67584);
    const int tid = opaque_tid(), lane = tid & 63, wid = tid >> 6, fr = lane & 15, quad = lane >> 4;
    const int sx0 = wid * 128 + lane, sx1 = sx0 + 64;
    const size_t t0 = (size_t)b * SEQ + (size_t)c * 128;
    const f32x2* abar = (const f32x2*)(ws_() + WS_ABAR) + l * 1024;
    f32x2* eloc = (f32x2*)(ws_() + WS_ELOC);
    float ar[2], ai[2], sre[2], sim[2];
#pragma unroll
    for (int q = 0; q < 2; ++q) { const f32x2 ab = abar[q ? sx1 : sx0]; ar[q] = ab[0]; ai[q] = ab[1]; sre[q] = 0.f; sim[q] = 0.f; }
    if (PASS == 2) {
        const f32x2* a128 = (const f32x2*)(ws_() + WS_A128) + l * 1024;
        const f32x2 p0 = a128[sx0], p1 = a128[sx1];
        for (int cc0 = 0; cc0 < c; cc0 += 8) {
            f32x2 e0[8], e1[8];
#pragma unroll
            for (int u = 0; u < 8; ++u) { const int cc = (cc0 + u < c) ? cc0 + u : c - 1; e0[u] = eloc[((size_t)(b * NCH + cc)) * 1024 + sx0]; e1[u] = eloc[((size_t)(b * NCH + cc)) * 1024 + sx1]; }
#pragma unroll
            for (int u = 0; u < 8; ++u) if (cc0 + u < c) {
                const float nr0 = p0[0] * sre[0] - p0[1] * sim[0] + e0[u][0], ni0 = p0[0] * sim[0] + p0[1] * sre[0] + e0[u][1]; sre[0] = nr0; sim[0] = ni0;
                const float nr1 = p1[0] * sre[1] - p1[1] * sim[1] + e1[u][0], ni1 = p1[0] * sim[1] + p1[1] * sre[1] + e1[u][1]; sre[1] = nr1; sim[1] = ni1; }
        }
    }
    bf16x8 bfrag[2][8];
    const bf16_t* bbt = (const bf16_t*)(ws_() + WS_BBT);
#pragma unroll
    for (int gi = 0; gi < 2; ++gi)
#pragma unroll
        for (int j = 0; j < 8; ++j) bfrag[gi][j] = (quad < 2) ? *(const bf16x8*)(bbt + ((size_t)(l * 16 + wid * 2 + gi) * 128 + j * 16 + fr) * 16 + quad * 8) : zero8();
    bf16x8 cfrag[2][4];
    if (PASS == 2) {
        const bf16_t* cmt = (const bf16_t*)(ws_() + WS_CMT);
#pragma unroll
        for (int gi = 0; gi < 2; ++gi)
#pragma unroll
            for (int ks = 0; ks < 4; ++ks) cfrag[gi][ks] = *(const bf16x8*)(cmt + ((size_t)(l * 16 + wid * 2 + gi) * 16 + fr) * 128 + ks * 32 + quad * 8);
    }
    const float* dsk = INP(13) + l * W;
    __syncthreads();
    bf16x8 ufn[2];
#pragma unroll
    for (int gi = 0; gi < 2; ++gi) ufn[gi] = (quad < 2) ? *(const bf16x8*)(z + (t0 + fr) * ZW + ZC_B + (wid * 2 + gi) * 16 + quad * 8) : zero8();
    for (int sc = 0; sc < 8; ++sc) {
        const size_t tr = t0 + sc * 16 + fr;
        bf16x8 ufc[2] = {ufn[0], ufn[1]};
        bf16x4 u4c[2] = {(bf16x4){0, 0, 0, 0}, (bf16x4){0, 0, 0, 0}};
        if (PASS == 2) {
#pragma unroll
            for (int gi = 0; gi < 2; ++gi) u4c[gi] = *(const bf16x4*)(z + tr * ZW + ZC_B + (wid * 2 + gi) * 16 + quad * 4);
        }
        if (sc < 7) {
#pragma unroll
            for (int gi = 0; gi < 2; ++gi) ufn[gi] = (quad < 2) ? *(const bf16x8*)(z + (tr + 16) * ZW + ZC_B + (wid * 2 + gi) * 16 + quad * 8) : zero8();
        }
#pragma unroll
        for (int gi = 0; gi < 2; ++gi) {
            const int g = wid * 2 + gi;
            const bf16x8 uf = ufc[gi];
#pragma unroll
            for (int j = 0; j < 8; ++j) {
                const f32x4 acc = mfma16(bfrag[gi][j], uf, (f32x4){0.f, 0.f, 0.f, 0.f});
                u32x2 w; w.x = pk2(acc[0], acc[1]); w.y = pk2(acc[2], acc[3]);
                *(LAS u32x2*)(BU + fr * 4112 + (g * 64 + j * 8 + quad * 2) * 4) = w;
            }
        }
        asm volatile("s_waitcnt lgkmcnt(0)" ::: "memory");
        {
            unsigned wv[16][2];
#pragma unroll
            for (int tt = 0; tt < 16; ++tt) { wv[tt][0] = BU32[tt * 1028 + sx0]; wv[tt][1] = BU32[tt * 1028 + sx1]; }
#pragma unroll
            for (int tt = 0; tt < 16; ++tt) {
#pragma unroll
                for (int q = 0; q < 2; ++q) {
                    const unsigned w = wv[tt][q];
                    const f32x2 bu2 = {__uint_as_float(w << 16), __uint_as_float(w & 0xffff0000u)};
                    const f32x2 s2 = {sre[q], sim[q]}, sw = {sim[q], sre[q]}, arr = {ar[q], ar[q]}, aii = {-ai[q], ai[q]};
                    const f32x2 n2 = aii * sw + (arr * s2 + bu2);
                    sre[q] = n2[0]; sim[q] = n2[1];
                    if (PASS == 2) wv[tt][q] = pk2(n2[0], n2[1]);
                }
            }
            if (PASS == 2) {
#pragma unroll
                for (int tt = 0; tt < 16; ++tt) { BU32[tt * 1028 + sx0] = wv[tt][0]; BU32[tt * 1028 + sx1] = wv[tt][1]; }
            }
        }
        asm volatile("s_waitcnt lgkmcnt(0)" ::: "memory");
        if (PASS == 2) {
#pragma unroll
            for (int gi = 0; gi < 2; ++gi) {
                const int g = wid * 2 + gi; f32x4 acc = (f32x4){0.f, 0.f, 0.f, 0.f};
#pragma unroll
                for (int ks = 0; ks < 4; ++ks) { const bf16x8 sf = *(const LAS bf16x8*)(BU + fr * 4112 + g * 256 + (ks * 32 + quad * 8) * 2); acc = mfma16(cfrag[gi][ks], sf, acc); }
                const int ch = g * 16 + quad * 4; const bf16x4 u4 = u4c[gi]; const f32x4 d4 = *(const f32x4*)(dsk + ch);
                float o[4];
#pragma unroll
                for (int r = 0; r < 4; ++r) o[r] = gelu_t(acc[r] + d4[r] * bfs2f(u4[r]));
                u32x2 w; w.x = pk2(o[0], o[1]); w.y = pk2(o[2], o[3]);
                *(LAS u32x2*)(Yb + (sc * 16 + fr) * 264 + ch) = w;
            }
        }
    }
    if (PASS == 1) {
#pragma unroll
        for (int q = 0; q < 2; ++q) eloc[((size_t)(b * NCH + c)) * 1024 + (q ? sx1 : sx0)] = (f32x2){sre[q], sim[q]};
    } else {
        __syncthreads();
        const bf16_t* glut = (const bf16_t*)(ws_() + WS_GLUT) + (size_t)l * W * W;
        const float* glub = INP(15) + l * W;
        bf16x8 gfrag[2][8];
#pragma unroll
        for (int ni = 0; ni < 2; ++ni)
#pragma unroll
            for (int ks = 0; ks < 8; ++ks) gfrag[ni][ks] = *(const bf16x8*)(glut + (size_t)((wid * 2 + ni) * 16 + fr) * W + ks * 32 + quad * 8);
        float outv[8][2][4];
#pragma unroll
        for (int mt = 0; mt < 8; ++mt) {
            f32x4 acc0 = (f32x4){0.f, 0.f, 0.f, 0.f}, acc1 = acc0;
#pragma unroll
            for (int ks = 0; ks < 8; ++ks) { const bf16x8 yf = *(const LAS bf16x8*)(Yb + (mt * 16 + fr) * 264 + ks * 32 + quad * 8); acc0 = mfma16(gfrag[0][ks], yf, acc0); acc1 = mfma16(gfrag[1][ks], yf, acc1); }
            float ss = 0.f;
#pragma unroll
            for (int ni = 0; ni < 2; ++ni) { const int n = (wid * 2 + ni) * 16 + quad * 4; const bf16x4 y4 = *(const LAS bf16x4*)(Yb + (mt * 16 + fr) * 264 + n); const f32x4 gb = *(const f32x4*)(glub + n);
#pragma unroll
                for (int r = 0; r < 4; ++r) { const float gt = (ni == 0 ? acc0[r] : acc1[r]) + gb[r]; const float o = bfs2f(y4[r]) * sigm(gt); outv[mt][ni][r] = o; ss += o * o; } }
            ss = quad_sum(ss);
            if (quad == 0) ssb[(mt * 16 + fr) * 8 + wid] = ss;
        }
        __syncthreads();
#pragma unroll
        for (int mt = 0; mt < 8; ++mt) {
            const int t = mt * 16 + fr; float s = 0.f;
#pragma unroll
            for (int w2 = 0; w2 < 8; ++w2) s += ssb[t * 8 + w2];
            const float rs = rsqrtf(s * (1.0f / W) + EPS);
#pragma unroll
            for (int ni = 0; ni < 2; ++ni) { const int n = (wid * 2 + ni) * 16 + quad * 4; u32x2 w; w.x = pk2(outv[mt][ni][0] * rs, outv[mt][ni][1] * rs); w.y = pk2(outv[mt][ni][2] * rs, outv[mt][ni][3] * rs);
                *(u32x2*)(y + (t0 + t) * DM + YC_B + n) = w; }
        }
    }
    __syncthreads();
}

template <int PASS> __device__ __forceinline__ void lru_item(int l, int b, int c, const Args& a, unsigned char* lds) {
    const bf16_t* z = (const bf16_t*)(ws_() + WS_Z); bf16_t* y = (bf16_t*)(ws_() + WS_Y);
    LAS bf16_t* XC = (LAS bf16_t*)lds;
    LAS float* ssb = (LAS float*)(lds + 67584);
    const int tid = opaque_tid(), lane = tid & 63, wid = tid >> 6, fr = lane & 15, quad = lane >> 4;
    const size_t t0 = (size_t)b * SEQ + (size_t)c * 128;
    float* LAp = (float*)(ws_() + WS_LA); float* LBp = (float*)(ws_() + WS_LB);
    __syncthreads();
    {
        const float* cw = INP(16) + (size_t)l * 4 * W; const float* cb = INP(17) + l * W;
#pragma unroll 4
        for (int it = 0; it < 8; ++it) {
            const int p = tid + 512 * it, tok = p >> 5, ch0 = (p & 31) * 8; float acc[8];
            { const f32x4 c0 = *(const f32x4*)(cb + ch0), c1 = *(const f32x4*)(cb + ch0 + 4); acc[0] = c0[0]; acc[1] = c0[1]; acc[2] = c0[2]; acc[3] = c0[3]; acc[4] = c1[0]; acc[5] = c1[1]; acc[6] = c1[2]; acc[7] = c1[3]; }
#pragma unroll
            for (int k = 0; k < 4; ++k) {
                const int tt = tok - 3 + k;
                if (c * 128 + tt >= 0) {
                    const bf16x8 xv = *(const bf16x8*)(z + (size_t)((long)t0 + tt) * ZW + ZC_CX + ch0);
                    const f32x4 w0 = *(const f32x4*)(cw + k * W + ch0), w1 = *(const f32x4*)(cw + k * W + ch0 + 4);
                    acc[0] += w0[0] * bfs2f(xv[0]); acc[1] += w0[1] * bfs2f(xv[1]); acc[2] += w0[2] * bfs2f(xv[2]); acc[3] += w0[3] * bfs2f(xv[3]);
                    acc[4] += w1[0] * bfs2f(xv[4]); acc[5] += w1[1] * bfs2f(xv[5]); acc[6] += w1[2] * bfs2f(xv[6]); acc[7] += w1[3] * bfs2f(xv[7]);
                }
            }
            *(LAS bf16x8*)(XC + tok * 264 + ch0) = pack8(acc);
        }
    }
    __syncthreads();
    const int hh = wid >> 1;
    const bf16_t* wat = (const bf16_t*)(ws_() + WS_WAT) + (size_t)(l * 4 + hh) * 64 * 64;
    const bf16_t* wxt = (const bf16_t*)(ws_() + WS_WXT) + (size_t)(l * 4 + hh) * 64 * 64;
    bf16x8 waf[2][2], wxf[2][2]; float sp8[2][4], bav[2][4], bxv[2][4], H[2][4], Acar[2][4], Bcar[2][4];
#pragma unroll
    for (int ni = 0; ni < 2; ++ni) {
        const int nl = (wid * 2 + ni) * 16 - hh * 64 + fr;
#pragma unroll
        for (int ks = 0; ks < 2; ++ks) { waf[ni][ks] = *(const bf16x8*)(wat + nl * 64 + ks * 32 + quad * 8); wxf[ni][ks] = *(const bf16x8*)(wxt + nl * 64 + ks * 32 + quad * 8); }
#pragma unroll
        for (int r = 0; r < 4; ++r) { const int ch = (wid * 2 + ni) * 16 + quad * 4 + r;
            sp8[ni][r] = 8.0f * softplus_f(-INP(22)[l * W + ch]); bav[ni][r] = INP(19)[l * W + ch]; bxv[ni][r] = INP(21)[l * W + ch];
            H[ni][r] = 0.f; Acar[ni][r] = 1.f; Bcar[ni][r] = 0.f;
        }
    }
    if (PASS == 2 && c > 0) {
#pragma unroll
        for (int ni = 0; ni < 2; ++ni) {
            const size_t ob = (size_t)(b * NCH) * W + (wid * 2 + ni) * 16 + quad * 4;
            const bool v0 = fr < c, v1 = 16 + fr < c;
            f32x4 a0 = (f32x4){1.f, 1.f, 1.f, 1.f}, b0 = (f32x4){0.f, 0.f, 0.f, 0.f}, a1 = a0, b1 = b0;
            if (v0) { a0 = *(const f32x4*)(LAp + ob + (size_t)fr * W); b0 = *(const f32x4*)(LBp + ob + (size_t)fr * W); }
            if (v1) { a1 = *(const f32x4*)(LAp + ob + (size_t)(16 + fr) * W); b1 = *(const f32x4*)(LBp + ob + (size_t)(16 + fr) * W); }
#pragma unroll
            for (int r = 0; r < 4; ++r) {
                float av = a0[r], bb = b0[r], aw = a1[r], bw = b1[r], ap, bp;
                ap = dpp_shr<1>(av, 1.0f); bp = dpp_shr<1>(bb, 0.0f); bb = av * bp + bb; av = av * ap;   ap = dpp_shr<1>(aw, 1.0f); bp = dpp_shr<1>(bw, 0.0f); bw = aw * bp + bw; aw = aw * ap;
                ap = dpp_shr<2>(av, 1.0f); bp = dpp_shr<2>(bb, 0.0f); bb = av * bp + bb; av = av * ap;   ap = dpp_shr<2>(aw, 1.0f); bp = dpp_shr<2>(bw, 0.0f); bw = aw * bp + bw; aw = aw * ap;
                ap = dpp_shr<4>(av, 1.0f); bp = dpp_shr<4>(bb, 0.0f); bb = av * bp + bb; av = av * ap;   ap = dpp_shr<4>(aw, 1.0f); bp = dpp_shr<4>(bw, 0.0f); bw = aw * bp + bw; aw = aw * ap;
                ap = dpp_shr<8>(av, 1.0f); bp = dpp_shr<8>(bb, 0.0f); bb = av * bp + bb; av = av * ap;   ap = dpp_shr<8>(aw, 1.0f); bp = dpp_shr<8>(bw, 0.0f); bw = aw * bp + bw; aw = aw * ap;
                const float B0t = __shfl(bb, 15, 16), A1t = __shfl(aw, 15, 16), B1t = __shfl(bw, 15, 16);
                H[ni][r] = A1t * B0t + B1t;
            }
        }
    }
    LAS bf16_t* Ob = (LAS bf16_t*)(lds + 67584 + 4096);
#pragma unroll 2
    for (int mt = 0; mt < 8; ++mt) {
        bf16x8 xf[2];
#pragma unroll
        for (int ks = 0; ks < 2; ++ks) xf[ks] = *(const LAS bf16x8*)(XC + (mt * 16 + fr) * 264 + hh * 64 + ks * 32 + quad * 8);
        float ss = 0.f;
#pragma unroll
        for (int ni = 0; ni < 2; ++ni) {
            f32x4 accA = (f32x4){0.f, 0.f, 0.f, 0.f}, accX = accA;
#pragma unroll
            for (int ks = 0; ks < 2; ++ks) { accA = mfma16(waf[ni][ks], xf[ks], accA); accX = mfma16(wxf[ni][ks], xf[ks], accX); }
            const int ch0 = (wid * 2 + ni) * 16 + quad * 4;
            const bf16x4 xc4 = *(const LAS bf16x4*)(XC + (mt * 16 + fr) * 264 + ch0);
            bf16x4 g4 = (bf16x4){0, 0, 0, 0};
            if (PASS == 2) g4 = *(const bf16x4*)(z + (t0 + mt * 16 + fr) * ZW + ZC_CG + ch0);
            float ov[4] = {0.f, 0.f, 0.f, 0.f};
#pragma unroll
            for (int r = 0; r < 4; ++r) {
                const float rg = sigm(accA[r] + bav[ni][r]), ig = sigm(accX[r] + bxv[ni][r]);
                const float la = -rg * sp8[ni][r];
                float av = __builtin_amdgcn_exp2f(LOG2E * la), bb = __builtin_amdgcn_sqrtf(fmaxf(neg_expm1(2.0f * la), 0.f)) * (ig * bfs2f(xc4[r]));
                { float ap, bp;
                  ap = dpp_shr<1>(av, 1.0f); bp = dpp_shr<1>(bb, 0.0f); bb = av * bp + bb; av = av * ap;
                  ap = dpp_shr<2>(av, 1.0f); bp = dpp_shr<2>(bb, 0.0f); bb = av * bp + bb; av = av * ap;
                  ap = dpp_shr<4>(av, 1.0f); bp = dpp_shr<4>(bb, 0.0f); bb = av * bp + bb; av = av * ap;
                  ap = dpp_shr<8>(av, 1.0f); bp = dpp_shr<8>(bb, 0.0f); bb = av * bp + bb; av = av * ap; }
                if (PASS == 1) { const float At = __shfl(av, 15, 16), Bt = __shfl(bb, 15, 16); Bcar[ni][r] = At * Bcar[ni][r] + Bt; Acar[ni][r] *= At; }
                else { const float hv = av * H[ni][r] + bb; H[ni][r] = __shfl(hv, 15, 16); const float o = hv * gelu_t(bfs2f(g4[r])); ov[r] = o; ss += o * o; }
            }
            if (PASS == 2) { u32x2 w; w.x = pk2(ov[0], ov[1]); w.y = pk2(ov[2], ov[3]); *(LAS u32x2*)(Ob + (mt * 16 + fr) * 264 + ch0) = w; }
        }
        if (PASS == 2) { ss = quad_sum(ss); if (quad == 0) ssb[(mt * 16 + fr) * 8 + wid] = ss; }
    }
    if (PASS == 1) {
        if (fr == 0) {
#pragma unroll
            for (int ni = 0; ni < 2; ++ni)
#pragma unroll
                for (int r = 0; r < 4; ++r) { const size_t o = ((size_t)(b * NCH + c)) * W + (wid * 2 + ni) * 16 + quad * 4 + r; LAp[o] = Acar[ni][r]; LBp[o] = Bcar[ni][r]; }
        }
        {
            const int tok = tid >> 2, hd = tid & 3; float s2 = 0.f;
#pragma unroll
            for (int j = 0; j < 8; ++j) { const bf16x8 kv = *(const bf16x8*)(z + (t0 + tok) * ZW + ZC_K + hd * 64 + j * 8);
#pragma unroll
                for (int e = 0; e < 8; ++e) { const float f = bfs2f(kv[e]); s2 += f * f; } }
            ssb[tok * 4 + hd] = s2;
            __syncthreads();
            if (tid < 4) { float mxv = 0.f; for (int i = 0; i < 128; ++i) mxv = fmaxf(mxv, ssb[i * 4 + tid]); ((float*)(ws_() + WS_KMAX))[(b * NCH + c) * 4 + tid] = mxv; }
        }
    } else {
        __syncthreads();
#pragma unroll 2
        for (int mt = 0; mt < 8; ++mt) {
            const int t = mt * 16 + fr; float s = 0.f;
#pragma unroll
            for (int w2 = 0; w2 < 8; ++w2) s += ssb[t * 8 + w2];
            const float rs = rsqrtf(s * (1.0f / W) + EPS);
#pragma unroll
            for (int ni = 0; ni < 2; ++ni) { const int n = (wid * 2 + ni) * 16 + quad * 4; const bf16x4 o4 = *(const LAS bf16x4*)(Ob + t * 264 + n);
                u32x2 w; w.x = pk2(bfs2f(o4[0]) * rs, bfs2f(o4[1]) * rs); w.y = pk2(bfs2f(o4[2]) * rs, bfs2f(o4[3]) * rs);
                *(u32x2*)(y + (t0 + t) * DM + YC_C + n) = w; }
        }
    }
    __syncthreads();
}

template <bool DIAG> __device__ __forceinline__ void attn_step2(const LAS unsigned char* buf, int kbase, int qrow0, int quad, int fr, const bf16x8 (&qf)[2][2], float (&m)[2], float (&lsum)[2], f32x4 (&oacc)[2][4]) {
    const LAS bf16_t* Kt = (const LAS bf16_t*)buf; const LAS bf16_t* Vt = (const LAS bf16_t*)(buf + 9216); const LAS float* csl = (const LAS float*)(buf + 18432);
    LAS bf16_t* vtr0 = (LAS bf16_t*)Vt + (quad * 4 + (fr >> 2)) * 72 + (fr & 3) * 4;
    float p[2][4][4];
#pragma unroll
    for (int st = 0; st < 4; ++st) {
        const f32x4 c4 = *(const LAS f32x4*)(csl + st * 16 + quad * 4);
        const bf16x8 kf0 = *(const LAS bf16x8*)(Kt + (st * 16 + fr) * 72 + quad * 8), kf1 = *(const LAS bf16x8*)(Kt + (st * 16 + fr) * 72 + 32 + quad * 8);
#pragma unroll
        for (int qs = 0; qs < 2; ++qs) {
            f32x4 acc = mfma16(kf0, qf[qs][0], c4); acc = mfma16(kf1, qf[qs][1], acc);
#pragma unroll
            for (int r = 0; r < 4; ++r) { float v = acc[r]; if (DIAG && (kbase + st * 16 + quad * 4 + r > qrow0 + qs * 16)) v = -1e30f; p[qs][st][r] = v; }
        }
    }
    bf16x8 pf[2][2];
#pragma unroll
    for (int qs = 0; qs < 2; ++qs) {
        float mx = -1e30f;
#pragma unroll
        for (int st = 0; st < 4; ++st)
#pragma unroll
            for (int r = 0; r < 4; ++r) mx = fmaxf(mx, p[qs][st][r]);
        mx = quad_max(mx);
        if (__any(mx > m[qs])) {
            const float mnew = fmaxf(m[qs], mx), al = __builtin_amdgcn_exp2f(m[qs] - mnew); m[qs] = mnew; lsum[qs] *= al;
#pragma unroll
            for (int dt = 0; dt < 4; ++dt) oacc[qs][dt] = oacc[qs][dt] * al;
        }
        const float mcur = m[qs];
        float ps = 0.f;
#pragma unroll
        for (int st = 0; st < 4; ++st)
#pragma unroll
            for (int r = 0; r < 4; ++r) { const float e = __builtin_amdgcn_exp2f(p[qs][st][r] - mcur); p[qs][st][r] = e; ps += e; }
        lsum[qs] += ps;
#pragma unroll
        for (int ks = 0; ks < 2; ++ks) { u32x4 w; w.x = pk2(p[qs][2 * ks][0], p[qs][2 * ks][1]); w.y = pk2(p[qs][2 * ks][2], p[qs][2 * ks][3]); w.z = pk2(p[qs][2 * ks + 1][0], p[qs][2 * ks + 1][1]); w.w = pk2(p[qs][2 * ks + 1][2], p[qs][2 * ks + 1][3]); pf[qs][ks] = __builtin_bit_cast(bf16x8, w); }
    }
#pragma unroll
    for (int dt = 0; dt < 4; ++dt) {
#pragma unroll
        for (int ks = 0; ks < 2; ++ks) {
            const bf16x4 v0 = __builtin_bit_cast(bf16x4, __builtin_amdgcn_ds_read_tr16_b64_v4i16((LAS v4i16_t*)(vtr0 + (ks * 32) * 72 + dt * 16)));
            const bf16x4 v1 = __builtin_bit_cast(bf16x4, __builtin_amdgcn_ds_read_tr16_b64_v4i16((LAS v4i16_t*)(vtr0 + (ks * 32 + 16) * 72 + dt * 16)));
            const bf16x8 vf = (bf16x8){v0[0], v0[1], v0[2], v0[3], v1[0], v1[1], v1[2], v1[3]};
            oacc[0][dt] = mfma16(vf, pf[0][ks], oacc[0][dt]); oacc[1][dt] = mfma16(vf, pf[1][ks], oacc[1][dt]);
        }
    }
}
__device__ __forceinline__ void attn_unit(int b, int h, int qb, const Args& a, unsigned char* lds) {
    const bf16_t* z = (const bf16_t*)(ws_() + WS_Z); bf16_t* y = (bf16_t*)(ws_() + WS_Y);
    const float* cs = (const float*)(ws_() + WS_CS); float* ssd = (float*)(ws_() + WS_SSD);
    constexpr int ABUF = 9216 + 9216 + 256;
    LAS unsigned char* lb = (LAS unsigned char*)lds;
    const int tid = opaque_tid(), lane = tid & 63, wid = tid >> 6, fr = lane & 15, quad = lane >> 4, grp = wid >> 2, wq = wid & 3;
    const int q0 = qb * 128, qw = q0 + wq * 32, qrow0 = qw + fr;
    const size_t rb = (size_t)b * SEQ;
    bf16x8 qf[2][2];
    {
        const float SC = 0.125f * LOG2E;
#pragma unroll
        for (int qs = 0; qs < 2; ++qs)
#pragma unroll
            for (int ds = 0; ds < 2; ++ds) { const bf16x8 qv = *(const bf16x8*)(z + (rb + qrow0 + qs * 16) * ZW + ZC_Q + h * 64 + ds * 32 + quad * 8); float t8[8];
#pragma unroll
                for (int e = 0; e < 8; ++e) t8[e] = bfs2f(qv[e]) * SC;
                qf[qs][ds] = pack8(t8); }
    }
    float m[2] = {-1e30f, -1e30f}, lsum[2] = {0.f, 0.f}; f32x4 oacc[2][4];
#pragma unroll
    for (int qs = 0; qs < 2; ++qs)
#pragma unroll
        for (int dt = 0; dt < 4; ++dt) oacc[qs][dt] = (f32x4){0.f, 0.f, 0.f, 0.f};
    float qbnd[2];
    {
        float kv = (lane <= qb) ? ((const float*)(ws_() + WS_KMAX))[(b * NCH + lane) * 4 + h] : 0.f;
        kv = wave_max(kv);
        const float kmax = __builtin_amdgcn_sqrtf(kv) * 1.01f + 1e-3f;
#pragma unroll
        for (int qs = 0; qs < 2; ++qs) { float q2 = 0.f;
#pragma unroll
            for (int ds = 0; ds < 2; ++ds)
#pragma unroll
                for (int e = 0; e < 8; ++e) { const float f = bfs2f(qf[qs][ds][e]); q2 += f * f; }
            q2 = quad_sum(q2); qbnd[qs] = (__builtin_amdgcn_sqrtf(q2) * 1.01f + 1e-3f) * kmax; }
    }
    const int NSS = qb + 1;
    volatile LAS unsigned* vote = (volatile LAS unsigned*)(lds + LDS_BYTES - 64);
    if (tid < 3) vote[tid] = 0u;
    bf16x8 kreg[2], vreg[2]; float creg = 0.f;
#define ATT_LOAD(S) do { const size_t kb_ = rb + (size_t)(S) * 128; \
        _Pragma("unroll") for (int p_ = 0; p_ < 2; ++p_) { const int id_ = tid + 512 * p_; \
            kreg[p_] = *(const bf16x8*)(z + (kb_ + (id_ >> 3)) * ZW + ZC_K + h * 64 + (id_ & 7) * 8); \
            vreg[p_] = *(const bf16x8*)(z + (kb_ + (id_ >> 3)) * ZW + ZC_V + h * 64 + (id_ & 7) * 8); } \
        if (tid < 128) creg = cs[(kb_ + tid) * 4 + h]; } while (0)
#define ATT_STORE(S) do { LAS unsigned char* bb_ = lb + ((S) & 1) * (2 * ABUF); \
        _Pragma("unroll") for (int p_ = 0; p_ < 2; ++p_) { const int id_ = tid + 512 * p_; const int k128_ = id_ >> 3; \
            *(LAS bf16x8*)((LAS bf16_t*)(bb_ + (k128_ >> 6) * ABUF) + (k128_ & 63) * 72 + (id_ & 7) * 8) = kreg[p_]; \
            *(LAS bf16x8*)((LAS bf16_t*)(bb_ + (k128_ >> 6) * ABUF + 9216) + (k128_ & 63) * 72 + (id_ & 7) * 8) = vreg[p_]; } \
        if (tid < 128) ((LAS float*)(bb_ + (tid >> 6) * ABUF + 18432))[tid & 63] = -creg; } while (0)
    ATT_LOAD(NSS - 1); ATT_STORE(NSS - 1);
    if (NSS > 1) ATT_LOAD(NSS - 2);
    __syncthreads();
    int kstep = 0;
    for (int S = NSS - 1; S >= 0; --S) {
        if (S >= 1) ATT_STORE(S - 1);
        if (S >= 2) ATT_LOAD(S - 2);
        float cl = 0.f; if (S >= 1) cl = cs[(rb + (size_t)(S - 1) * 128 + 127) * 4 + h];
        const int kbase = S * 128 + grp * 64;
        const LAS unsigned char* hb = lb + (S & 1) * (2 * ABUF) + grp * ABUF;
        if (S + 1 < NSS) attn_step2<false>(hb, kbase, qrow0, quad, fr, qf, m, lsum, oacc);
        else if (kbase <= qw + 31) attn_step2<true>(hb, kbase, qrow0, quad, fr, qf, m, lsum, oacc);
        const bool need = (S >= 1) && ((qbnd[0] - cl - m[0] >= -160.f) || (qbnd[1] - cl - m[1] >= -160.f));
        const int vw = kstep % 3;
        if (need) vote[vw] = 1u;
        __syncthreads();
        const unsigned go = vote[vw];
        if (tid == 0) vote[(kstep + 2) % 3] = 0u;
        ++kstep;
        if (!go) break;
    }
#undef ATT_LOAD
#undef ATT_STORE
    LAS float* mg = (LAS float*)lb;
    const int ml = wq * 64 + lane;
    if (grp == 1) {
#pragma unroll
        for (int qs = 0; qs < 2; ++qs) { mg[(qs * 18 + 0) * 256 + ml] = m[qs]; mg[(qs * 18 + 1) * 256 + ml] = lsum[qs];
#pragma unroll
            for (int dt = 0; dt < 4; ++dt)
#pragma unroll
                for (int r = 0; r < 4; ++r) mg[(qs * 18 + 2 + dt * 4 + r) * 256 + ml] = oacc[qs][dt][r]; }
    }
    __syncthreads();
    if (grp == 0) {
#pragma unroll
        for (int qs = 0; qs < 2; ++qs) {
            const float m1 = mg[(qs * 18 + 0) * 256 + ml], l1 = mg[(qs * 18 + 1) * 256 + ml];
            const float mt = fmaxf(m[qs], m1), f0 = __builtin_amdgcn_exp2f(m[qs] - mt), f1 = __builtin_amdgcn_exp2f(m1 - mt);
            float lt = quad_sum(lsum[qs] * f0 + l1 * f1);
            const float inv = 1.0f / lt; float ss = 0.f;
            const size_t tq = rb + qrow0 + qs * 16;
#pragma unroll
            for (int dt = 0; dt < 4; ++dt) { f32x4 o;
#pragma unroll
                for (int r = 0; r < 4; ++r) { o[r] = (oacc[qs][dt][r] * f0 + mg[(qs * 18 + 2 + dt * 4 + r) * 256 + ml] * f1) * inv; ss += o[r] * o[r]; }
                u32x2 w; w.x = pk2(o[0], o[1]); w.y = pk2(o[2], o[3]); *(u32x2*)(y + tq * DM + YC_D + h * 64 + dt * 16 + quad * 4) = w; }
            ss = quad_sum(ss);
            if (quad == 0) ssd[tq * 4 + h] = ss;
        }
    }
    __syncthreads();
}

#define XB_TMO      128
#define XB_XCNT(j)  (256  + 64 * (j))
#define XB_XSUB(j)  (1280 + 64 * (j))
#define XB_XGEN(j)  (2304 + 64 * (j))
#define XB_TOP      3328
#define XB_TOPGEN   3392
#define XCD_BAR_WORDS 3456
#define XB_SPIN_CAP (1u << 18)

__device__ __forceinline__ unsigned xb_ld(unsigned* p)              { return __hip_atomic_load(p, __ATOMIC_RELAXED, __HIP_MEMORY_SCOPE_AGENT); }
__device__ __forceinline__ unsigned xb_add(unsigned* p, unsigned v) { return __hip_atomic_fetch_add(p, v, __ATOMIC_RELAXED, __HIP_MEMORY_SCOPE_AGENT); }
__device__ __forceinline__ unsigned xb_xcc_id() { return (unsigned)__builtin_amdgcn_s_getreg((3 << 11) | 20) & 0xFu; }
#define XB_SPIN(cond, bar) do { unsigned _sp = 0; while (cond) { __builtin_amdgcn_s_sleep(1); \
    if ((++_sp & 255u) == 0u) { if (xb_ld(&(bar)[XB_TMO])) break; if (_sp > XB_SPIN_CAP) { atomicAdd(&(bar)[XB_TMO], 1u); break; } } } } while (0)

struct XcdBarrier {
    unsigned* bar; unsigned x;
    volatile LAS unsigned* st;
};

__device__ __forceinline__ XcdBarrier xcd_barrier_post(unsigned* bar, volatile LAS unsigned* st) {
    XcdBarrier b; b.bar = bar; b.x = xb_xcc_id(); b.st = st;
    if (opaque_tid() == 0) (void)xb_add(&bar[XB_XCNT(b.x)], 1u);
    return b;
}
__device__ __forceinline__ void xcd_barrier_complete(unsigned* bar, unsigned x, unsigned& nloc, unsigned& nx) {
    const unsigned G = gridDim.x * gridDim.y * gridDim.z;
    unsigned sum, cnt, mine, sp = 0u;
    for (;;) {
        sum = 0u; cnt = 0u; mine = 0u;
#pragma unroll
        for (unsigned j = 0; j < 16; ++j) { const unsigned c = xb_ld(&bar[XB_XCNT(j)]); sum += c; cnt += (c > 0u) ? 1u : 0u; mine = (j == x) ? c : mine; }
        if (sum == G) break;
        __builtin_amdgcn_s_sleep(1);
        if ((++sp & 255u) == 0u) { if (xb_ld(&bar[XB_TMO])) break; if (sp > XB_SPIN_CAP) { atomicAdd(&bar[XB_TMO], 1u); break; } }
    }
    nloc = mine > 0u ? mine : 1u; nx = cnt > 0u ? cnt : 1u;
}

__device__ __forceinline__ void xcd_barrier(const XcdBarrier& b) {
    asm volatile("s_waitcnt vmcnt(0)" ::: "memory");
    __syncthreads();
    if (opaque_tid() == 0) {
        unsigned* bar = b.bar;
        __builtin_amdgcn_s_waitcnt(0);
        unsigned nloc = b.st[0], nx = b.st[1];
        if (nloc == 0u) { xcd_barrier_complete(bar, b.x, nloc, nx); b.st[0] = nloc; b.st[1] = nx; }
        const unsigned old = xb_add(&bar[XB_XSUB(b.x)], 1u);
        const unsigned gen = old / nloc;
        if (old + 1u == (gen + 1u) * nloc) {
            __builtin_amdgcn_fence(__ATOMIC_RELEASE, "agent");
            asm volatile("s_waitcnt vmcnt(0)" ::: "memory");
            const unsigned og = xb_add(&bar[XB_TOP], 1u);
            const unsigned tg = og / nx;
            if (og + 1u == (tg + 1u) * nx) xb_add(&bar[XB_TOPGEN], 1u);
            else XB_SPIN(xb_ld(&bar[XB_TOPGEN]) == tg, bar);
            __builtin_amdgcn_fence(__ATOMIC_ACQUIRE, "agent");
            xb_add(&bar[XB_XGEN(b.x)], 1u);
            asm volatile("s_waitcnt vmcnt(0)" ::: "memory");
        } else {
            XB_SPIN(xb_ld(&bar[XB_XGEN(b.x)]) == gen, bar);
            __builtin_amdgcn_fence(__ATOMIC_ACQUIRE, "agent");
            asm volatile("s_waitcnt vmcnt(0)" ::: "memory");
        }
    }
    __syncthreads();
}

#ifndef WGM_G1
#define WGM_G1 2
#endif
#ifndef WGM_G2
#define WGM_G2 4
#endif
#ifndef WGM_G3
#define WGM_G3 4
#endif
#ifndef WGM_G4
#define WGM_G4 8
#endif
#ifndef PROBE_DUP
#define PROBE_DUP 0
#endif
#ifndef ITEM_MASK
#define ITEM_MASK 127
#endif
__global__ void __launch_bounds__(NTHR, 2) fwd_kernel(Args a) {
    extern __shared__ __attribute__((aligned(16))) unsigned char lds[];
    {
        volatile LAS unsigned* bst0 = (volatile LAS unsigned*)(lds + LDS_BYTES - 16);
        if (opaque_tid() == 0) { bst0[0] = 0u; bst0[1] = 0u; }
        __syncthreads();
        (void)xcd_barrier_post((unsigned*)(ws_() + WS_BAR), bst0);
    }
    if (PH_HI > 4096) cg::this_grid().sync();
#define SEAM(k) do { if ((k) + 1 < PH_HI) { XcdBarrier xb_; xb_.bar = (unsigned*)(ws_() + WS_BAR); xb_.x = xb_xcc_id(); xb_.st = (volatile LAS unsigned*)(lds + LDS_BYTES - 16); xcd_barrier(xb_); if (PROBE_DUP == 1) xcd_barrier(xb_); } } while (0)
#define IN(k) (PH_LO <= (k) && (k) < PH_HI)
    if (IN(0)) { prep_phase(a, lds); if (PROBE_DUP == 4) prep_phase(a, lds); SEAM(0); }
    for (int l = 0; l < DEPTH; ++l) {
        const int pb = 1 + 8 * l;
        if (l == 0 && IN(pb + 0)) {
            norm_phase<false, 1>(INP(0), nullptr, (bf16_t*)(ws_() + WS_H), (float*)(ws_() + WS_SS2), nullptr, (const float*)(ws_() + WS_WF), INP(23), (float*)(ws_() + WS_LOGF));
            SEAM(pb + 0);
        }
        if (IN(pb + 1)) {
            pg8::Gemm g{(const pg8::bf16_t*)(ws_() + WS_H), (const pg8::bf16_t*)(ws_() + WS_WIN) + (size_t)l * ZW * DM, T, ZW, DM}; pg8::StaticOrder S; S.init(T, ZW, grid_(), bid_(), WGM_G1);
            EpiStoreBf16<0, true> E{(bf16_t*)(ws_() + WS_Z), ZW, (const float*)(ws_() + WS_SS2)};
            pg8::gemm_phase<EpiStoreBf16<0, true>, pg8::StaticOrder, true, true>((PG8_LAS unsigned char*)lds, g, S, E);
            if (PROBE_DUP == 9) pg8::gemm_phase<EpiStoreBf16<0, true>, pg8::StaticOrder, true, true>((PG8_LAS unsigned char*)lds, g, S, E);
            if (l > 0) norm_phase<true, 1>(ws_() + WS_H, nullptr, nullptr, nullptr, nullptr, (const float*)(ws_() + WS_WF) + (size_t)l * DM * 4, INP(23) + l * 4, (float*)(ws_() + WS_LOGF));
            SEAM(pb + 1);
        }
        if (IN(pb + 2)) {
            for (int rep = 0; rep < (PROBE_DUP == 2 ? 2 : 1); ++rep)
            for (int it = bid_(); it < 260; it += grid_()) {
                if (it < 128) { if (ITEM_MASK & 1) s5_item<1>(l, it >> 5, it & 31, a, lds); }
                else if (it < 256) { if (ITEM_MASK & 4) lru_item<1>(l, (it - 128) >> 5, (it - 128) & 31, a, lds); }
                else { if (ITEM_MASK & 8) cumsum_item(it - 256, (const float*)(ws_() + WS_LOGF), (float*)(ws_() + WS_CS), lds); }
            }
            SEAM(pb + 2);
        }
        if (IN(pb + 3)) {
            for (int rep = 0; rep < (PROBE_DUP == 3 ? 2 : 1); ++rep) {
            for (int rep2 = 0; rep2 < (PROBE_DUP == 5 ? 2 : 1); ++rep2)
            for (int up = bid_(); up < 256; up += grid_()) {
                const int xcd_ = up & 7, ix_ = up >> 3, pr = xcd_ + 8 * (ix_ >> 4), j = ix_ & 15;
                if (ITEM_MASK & 16) { attn_unit(pr >> 2, pr & 3, 31 - j, a, lds);
                attn_unit(pr >> 2, pr & 3, j, a, lds); }
            }
            for (int rep3 = 0; rep3 < (PROBE_DUP == 6 ? 2 : 1); ++rep3)
            for (int it = bid_(); it < 256; it += grid_()) {
                if (it < 128) { if (ITEM_MASK & 32) s5_item<2>(l, it >> 5, it & 31, a, lds); }
                else { if (ITEM_MASK & 64) lru_item<2>(l, (it - 128) >> 5, (it - 128) & 31, a, lds); }
            }
            if (ITEM_MASK & 2) {
                unsigned* qctr = (unsigned*)(ws_() + WS_BAR) + 3600 + l;
                volatile LAS unsigned* qslot = (volatile LAS unsigned*)(lds + LDS_BYTES - 48);
                for (;;) {
                    __syncthreads();
                    if (opaque_tid() == 0) qslot[0] = __hip_atomic_fetch_add(qctr, 1u, __ATOMIC_RELAXED, __HIP_MEMORY_SCOPE_AGENT);
                    __syncthreads();
                    const unsigned qi = qslot[0];
                    if (qi >= 256u) break;
                    if (qi < 128u) sgu_item<1>(l, (int)(qi >> 5), (int)(qi & 31), a, lds);
                    else sgu_item<0>(l, (int)((qi - 128u) >> 5), (int)(qi & 31), a, lds);
                }
            }
            }
            SEAM(pb + 3);
        }
        if (IN(pb + 4)) {
            pg8::Gemm g{(const pg8::bf16_t*)(ws_() + WS_Y), (const pg8::bf16_t*)(ws_() + WS_WOUT) + (size_t)l * DM * DM, T, DM, DM}; pg8::StaticOrder S; S.init(T, DM, grid_(), bid_(), WGM_G2);
            EpiRes<true, true> E{(bf16_t*)(ws_() + WS_H), DM, (const float*)(ws_() + WS_SSD), (float*)(ws_() + WS_SS2)};
            pg8::gemm_phase<EpiRes<true, true>, pg8::StaticOrder, true, true>((PG8_LAS unsigned char*)lds, g, S, E);
            SEAM(pb + 4);
        }
        if (IN(pb + 6)) {
            pg8::Gemm g{(const pg8::bf16_t*)(ws_() + WS_H), (const pg8::bf16_t*)(ws_() + WS_WMI) + (size_t)l * DFF * DM, T, DFF, DM}; pg8::StaticOrder S; S.init(T, DFF, grid_(), bid_(), WGM_G3);
            EpiStoreBf16<1, true> E{(bf16_t*)(ws_() + WS_ACT), DFF, (const float*)(ws_() + WS_SS2)};
            pg8::gemm_phase<EpiStoreBf16<1, true>, pg8::StaticOrder, true, true>((PG8_LAS unsigned char*)lds, g, S, E);
            SEAM(pb + 6);
        }
        if (IN(pb + 7)) {
            pg8::Gemm g{(const pg8::bf16_t*)(ws_() + WS_ACT), (const pg8::bf16_t*)(ws_() + WS_WMO) + (size_t)l * DM * DFF, T, DM, DFF}; pg8::StaticOrder S; S.init(T, DM, grid_(), bid_(), WGM_G4);
            EpiRes<false, true> E{(bf16_t*)(ws_() + WS_H), DM, nullptr, (float*)(ws_() + WS_SS2)};
            pg8::gemm_phase<EpiRes<false, true>, pg8::StaticOrder, true, true>((PG8_LAS unsigned char*)lds, g, S, E);
            SEAM(pb + 7);
        }
    }
    if (IN(33)) norm_phase<true, 2>(ws_() + WS_H, INP(29), nullptr, nullptr, out_(), nullptr, nullptr, nullptr);
#undef SEAM
#undef IN
}


#ifndef DUMP_SEL
#define DUMP_SEL 0
#endif
#ifndef DUMP_LAST
#define DUMP_LAST 33
#endif
__global__ void dump_kernel(const unsigned char* ws, float* out) {
    const size_t i = (size_t)blockIdx.x * blockDim.x + threadIdx.x;
    const size_t t = i >> 10, c = i & 1023;
    float v = 0.f;
    if (DUMP_SEL == 1) v = bf2f(((const bf16_t*)(ws + WS_H))[i]);
    if (DUMP_SEL == 2) v = bf2f(((const bf16_t*)(ws + WS_Z))[t * ZW + c]) + bf2f(((const bf16_t*)(ws + WS_Z))[t * ZW + c + 1024]);
    if (DUMP_SEL == 3) v = bf2f(((const bf16_t*)(ws + WS_Y))[i]);
    if (DUMP_SEL == 5) v = ((const float*)(ws + WS_SSD))[(t * 4 + (c & 3))] + ((const float*)(ws + WS_CS))[(t * 4 + (c & 3))];
    if (DUMP_SEL == 7) v = ((const float*)(ws + WS_ELOC))[i & 262143];
    if (DUMP_SEL == 8) v = ((const float*)(ws + WS_LA))[i & 32767] + ((const float*)(ws + WS_LB))[i & 32767];
    if (DUMP_SEL == 6) v = bf2f(((const bf16_t*)(ws + WS_WIN))[i]) + bf2f(((const bf16_t*)(ws + WS_WMI))[i]) + bf2f(((const bf16_t*)(ws + WS_WMO))[i]) + bf2f(((const bf16_t*)(ws + WS_WOUT))[i & 0x3fffff]);
    out[i] = v;
}
#ifndef N_LAUNCH_MODE
#define N_LAUNCH_MODE 1
#endif
extern "C" void kernel_launch(void* const* d_in, const int* in_sizes, int n_in, void* d_out, int out_size, void* d_ws, size_t ws_size, hipStream_t stream) {
    static int grid = 0;
    if (grid == 0) {
        if (n_in != 30 || out_size != T * DM || ws_size < WS_END) { fprintf(stderr, "kernel_launch: unexpected shapes (n_in %d, out %d, ws %zu, need %zu)\n", n_in, out_size, ws_size, (size_t)WS_END); grid = -1; return; }
        int dev = 0, cus = 0, per_cu = 0;
        hipGetDevice(&dev); hipDeviceGetAttribute(&cus, hipDeviceAttributeMultiprocessorCount, dev);
        if (hipFuncSetAttribute((const void*)fwd_kernel, hipFuncAttributeMaxDynamicSharedMemorySize, LDS_BYTES) != hipSuccess) { fprintf(stderr, "kernel_launch: hipFuncSetAttribute failed\n"); grid = -1; return; }
        if (hipOccupancyMaxActiveBlocksPerMultiprocessor(&per_cu, (const void*)fwd_kernel, NTHR, LDS_BYTES) != hipSuccess || per_cu < 1) { fprintf(stderr, "kernel_launch: occupancy query says %d\n", per_cu); per_cu = 1; }
        (void)hipGetLastError();
        grid = cus;
        if (grid > 256) grid = 256;
    }
    if (grid < 0) return;
    Args a{};
    for (int i = 0; i < 30; ++i) a.in[i] = (const float*)d_in[i];
    a.out = (float*)d_out; a.ws = (unsigned char*)d_ws;
    if (N_LAUNCH_MODE == 1) {
        a.ph_lo = 0; a.ph_hi = 34;
        if (hipMemsetAsync((unsigned char*)d_ws + WS_BAR, 0, 16 * 1024, stream) != hipSuccess) { fprintf(stderr, "kernel_launch: memset of the barrier words failed\n"); return; }
        void* args[] = {&a};
        hipError_t e = hipLaunchCooperativeKernel((const void*)fwd_kernel, dim3(grid), dim3(NTHR), args, LDS_BYTES, stream);
        if (e != hipSuccess) fprintf(stderr, "kernel_launch: cooperative launch failed: %s (grid %d)\n", hipGetErrorString(e), grid);
    } else {
        for (int ph = 0; ph <= DUMP_LAST; ++ph) { a.ph_lo = ph; a.ph_hi = ph + 1; hipLaunchKernelGGL(fwd_kernel, dim3(grid), dim3(NTHR), LDS_BYTES, stream, a); }
        if (DUMP_SEL != 0 && DUMP_SEL != 4) hipLaunchKernelGGL(dump_kernel, dim3(T * DM / 256), dim3(256), 0, stream, (const unsigned char*)d_ws, (float*)d_out);
    }
}
```

```cpp
#include <hip/hip_runtime.h>
#include <hip/hip_cooperative_groups.h>
#include <cstdio>
#include <cstdint>
namespace cg = cooperative_groups;
__device__ __forceinline__ int opaque_tid() { int t = __builtin_amdgcn_workitem_id_x(); asm volatile("" : "+v"(t)); return t; }
namespace pg8 {
#define PG8_LAS __attribute__((address_space(3)))
typedef unsigned short bf16_t;
typedef short bf16x8 __attribute__((ext_vector_type(8)));
typedef float f32x4 __attribute__((ext_vector_type(4)));
typedef unsigned u32x4 __attribute__((ext_vector_type(4)));
constexpr int BM = 256, BK = 64, HALF = 128, HTB = HALF * BK * 2  , STAGE_BYTES = 8 * HTB, NXCD = 8, WGM = 4;

__host__ __device__ __forceinline__ int lds_byte(int r, int c) { const int st = (r >> 4) * 2 + (c >> 5), rr = r & 15, cc = c & 31, ob = rr * 64 + cc * 2; return st * 1024 + (ob ^ (((ob >> 9) & 1) << 5)); }
__host__ __device__ __forceinline__ void stage_rc(int b, int& R, int& C) { const int st = b / 1024, sb = b % 1024, swz = sb ^ (((sb >> 9) & 1) << 5); R = (st >> 1) * 16 + swz / 64; C = (st & 1) * 32 + (swz % 64) / 2; }
__host__ __device__ __forceinline__ int perm32(int rho) { const int n = rho >> 4, i = rho & 15; return 8 * (i >> 2) + 4 * n + (i & 3); }

struct Unit { int pm, pn; };
struct Gemm { const bf16_t* A; const bf16_t* Bt; int M, N, K; };

struct StaticOrder {
    int nM, nN, nwg, G, c, wgm;
    __host__ __device__ void init(int M, int N, int G_, int c_, int wgm_ = WGM) { nM = M / BM; nN = N / BM; nwg = nM * nN; G = G_; c = c_; wgm = wgm_; }
    __host__ __device__ bool next(int i, Unit& u) const {
        const long L = (long)i * G + c; if (L >= nwg) return false;
        int wgid = (int)L; { const int q = nwg / NXCD, r = nwg % NXCD, xcd = wgid % NXCD, off = wgid / NXCD; wgid = (xcd < r ? xcd * (q + 1) : r * (q + 1) + (xcd - r) * q) + off; }
        const int nig = wgm * nN, gid = wgid / nig, fm = gid * wgm, gsz = (nM - fm) < wgm ? (nM - fm) : wgm;
        u.pm = fm + ((wgid % nig) % gsz); u.pn = (wgid % nig) / gsz; return true;
    }
    __device__ __forceinline__ void a_ready(const Unit&) const {}
    __device__ __forceinline__ void done(const Unit&) const {}
};

__device__ __forceinline__ unsigned cvt_pk_bf16(float lo, float hi) { unsigned r; asm volatile("v_cvt_pk_bf16_f32 %0, %1, %2" : "=v"(r) : "v"(lo), "v"(hi)); return r; }
template <class Epi, class Sched, bool ALIGN_EPI = false, bool SP2 = false>
__device__ __forceinline__ void gemm_phase(PG8_LAS unsigned char* lds, const Gemm g, const Sched& S, const Epi& E) {
    const int tid = opaque_tid(), wid = __builtin_amdgcn_readfirstlane(tid >> 6), lane = tid & 63, wr = wid >> 2, wc = wid & 3, fr = lane & 15, fq = lane >> 4;
    const int K = g.K, nt = K / BK;
    unsigned voffA[2], voffB[2];
#pragma unroll
    for (int i = 0; i < 2; ++i) { int R, C; stage_rc(tid * 16 + i * 8192, R, C); const int Rb = Epi::PERM ? ((R & ~31) + perm32(R & 31)) : R;
        voffA[i] = (unsigned)(R * K + C) * 2u; voffB[i] = (unsigned)(Rb * K + C) * 2u; }
    const size_t kstep = (size_t)(BK * 2);
    const size_t hstep = (size_t)HALF * K * 2;
    const size_t tstep = 2 * hstep;
    const unsigned ldsw = (unsigned)wid * 1024u;
    const int aoff = lds_byte(wr * 64 + fr, fq * 8), boff = lds_byte(wc * 32 + fr, fq * 8);
#define PG8_SA(b, h) (((b) * 2 + (h)) * HTB)
#define PG8_SB(b, h) ((4 + (b) * 2 + (h)) * HTB)
#define PG8_STAGE(bufoff, gbase, voff) do { _Pragma("unroll") for (int _i = 0; _i < 2; ++_i) \
        __builtin_amdgcn_global_load_lds((const unsigned*)((const char*)(gbase) + (voff)[_i]), (PG8_LAS unsigned*)(lds + (bufoff) + ldsw + _i * 8192), 16, 0, 0); } while (0)
#define PG8_LDA(dst, b, h) do { _Pragma("unroll") for (int m = 0; m < 4; ++m) _Pragma("unroll") for (int k = 0; k < 2; ++k) dst[m][k] = *(const PG8_LAS bf16x8*)(lds + PG8_SA(b, h) + aoff + m * 2048 + k * 1024); } while (0)
#define PG8_LDB(dst, b, h) do { _Pragma("unroll") for (int n = 0; n < 2; ++n) _Pragma("unroll") for (int k = 0; k < 2; ++k) dst[n][k] = *(const PG8_LAS bf16x8*)(lds + PG8_SB(b, h) + boff + n * 2048 + k * 1024); } while (0)
#define PG8_MMA(ai, bj, At, Bt) do { __builtin_amdgcn_s_setprio(1); _Pragma("unroll") for (int m = 0; m < 4; ++m) _Pragma("unroll") for (int n = 0; n < 2; ++n) _Pragma("unroll") for (int k = 0; k < 2; ++k) \
        acc[ai][bj][m][n] = __builtin_amdgcn_mfma_f32_16x16x32_bf16(Bt[n][k], At[m][k], acc[ai][bj][m][n], 0, 0, 0); __builtin_amdgcn_s_setprio(0); } while (0)
#define PG8_WAIT_V(n) asm volatile("s_waitcnt vmcnt(" #n ")" ::: "memory")
#define PG8_WAIT_L(n) asm volatile("s_waitcnt lgkmcnt(" #n ")" ::: "memory")
#define PG8_BAR __builtin_amdgcn_s_barrier()
#define PG8_SCHED __builtin_amdgcn_sched_barrier(0)
    Unit cur, nxt; int ui = 0;
    if (!S.next(0, cur)) return;
    if constexpr (Epi::KPREP) { Unit pu; for (int i = 0; i < 12 && S.next(i, pu); ++i) E.kprep(pu, lds + STAGE_BYTES + i * 1024, tid); }
    f32x4 acc[2][2][4][2];
#pragma unroll
    for (int a = 0; a < 2; ++a)
#pragma unroll
        for (int b = 0; b < 2; ++b)
#pragma unroll
            for (int m = 0; m < 4; ++m)
#pragma unroll
                for (int n = 0; n < 2; ++n) acc[a][b][m][n] = (f32x4){0.f, 0.f, 0.f, 0.f};
    bf16x8 At[4][2], B0[2][2], B1[2][2];
    const char* cA = (const char*)g.A + (size_t)cur.pm * tstep; const char* cB = (const char*)g.Bt + (size_t)cur.pn * tstep;
    S.a_ready(cur);
    if constexpr (SP2) {
        PG8_STAGE(PG8_SB(0, 0), cB, voffB); PG8_STAGE(PG8_SB(0, 1), cB + hstep, voffB); PG8_STAGE(PG8_SA(0, 0), cA, voffA); PG8_STAGE(PG8_SA(0, 1), cA + hstep, voffA);
        if (wr == 1) PG8_BAR;
        PG8_WAIT_V(2); PG8_BAR;
        PG8_STAGE(PG8_SB(1, 0), cB + kstep, voffB); PG8_STAGE(PG8_SA(1, 0), cA + kstep, voffA); PG8_STAGE(PG8_SB(1, 1), cB + hstep + kstep, voffB);
        PG8_WAIT_V(6); PG8_BAR;
    } else {
        PG8_STAGE(PG8_SB(0, 0), cB, voffB); PG8_STAGE(PG8_SA(0, 0), cA, voffA); PG8_STAGE(PG8_SB(0, 1), cB + hstep, voffB); PG8_STAGE(PG8_SA(0, 1), cA + hstep, voffA);
        if (wr == 1) PG8_BAR;
        PG8_WAIT_V(4); PG8_BAR;
        PG8_STAGE(PG8_SB(1, 0), cB + kstep, voffB); PG8_STAGE(PG8_SA(1, 0), cA + kstep, voffA); PG8_STAGE(PG8_SB(1, 1), cB + hstep + kstep, voffB);
        PG8_WAIT_V(6); PG8_BAR;
    }
    for (;;) {
        const bool has_next = S.next(ui + 1, nxt);
        const char* nA = has_next ? (const char*)g.A + (size_t)nxt.pm * tstep : cA; const char* nB = has_next ? (const char*)g.Bt + (size_t)nxt.pn * tstep : cB;
        for (int t = 0; t < nt; t += 2) {
            const bool last = (t == nt - 2);
            const char* a1 = cA + (size_t)(t + 1) * kstep;
            const char* a2 = last ? nA : cA + (size_t)(t + 2) * kstep; const char* b2 = last ? nB : cB + (size_t)(t + 2) * kstep;
            const char* a3 = a2 + kstep; const char* b3 = b2 + kstep;
            if (last && has_next) S.a_ready(nxt);
            if constexpr (SP2) {
            PG8_LDB(B0, 0, 0); PG8_LDB(B1, 0, 1); PG8_SCHED; PG8_LDA(At, 0, 0); PG8_STAGE(PG8_SA(1, 1), a1 + hstep, voffA);
            PG8_WAIT_V(8); PG8_WAIT_L(0); PG8_BAR; PG8_MMA(0, 0, At, B0); PG8_MMA(0, 1, At, B1); PG8_BAR; PG8_SCHED;
            PG8_LDA(At, 0, 1); PG8_STAGE(PG8_SB(0, 0), b2, voffB); PG8_STAGE(PG8_SB(0, 1), b2 + hstep, voffB); PG8_STAGE(PG8_SA(0, 0), a2, voffA);
            PG8_WAIT_V(8); PG8_WAIT_L(0); PG8_BAR; PG8_MMA(1, 0, At, B0); PG8_MMA(1, 1, At, B1); PG8_BAR; PG8_SCHED;
            PG8_LDB(B0, 1, 0); PG8_LDB(B1, 1, 1); PG8_SCHED; PG8_LDA(At, 1, 0); PG8_STAGE(PG8_SA(0, 1), a2 + hstep, voffA);
            PG8_WAIT_V(8); PG8_WAIT_L(0); PG8_BAR; PG8_MMA(0, 0, At, B0); PG8_MMA(0, 1, At, B1); PG8_BAR; PG8_SCHED;
            PG8_LDA(At, 1, 1); PG8_STAGE(PG8_SB(1, 0), b3, voffB); PG8_STAGE(PG8_SB(1, 1), b3 + hstep, voffB); PG8_STAGE(PG8_SA(1, 0), a3, voffA);
            PG8_WAIT_V(8); PG8_WAIT_L(0); PG8_BAR; PG8_MMA(1, 0, At, B0); PG8_MMA(1, 1, At, B1); PG8_BAR; PG8_SCHED;
            } else {
            PG8_LDB(B0, 0, 0); PG8_SCHED; PG8_LDA(At, 0, 0); PG8_STAGE(PG8_SA(1, 1), a1 + hstep, voffA);
            PG8_WAIT_L(8); PG8_BAR; PG8_WAIT_L(0); PG8_MMA(0, 0, At, B0); PG8_BAR; PG8_SCHED;
            PG8_LDB(B1, 0, 1); PG8_STAGE(PG8_SB(0, 0), b2, voffB);
            PG8_BAR; PG8_WAIT_L(0); PG8_MMA(0, 1, At, B1); PG8_BAR;
            PG8_LDA(At, 0, 1); PG8_STAGE(PG8_SA(0, 0), a2, voffA);
            PG8_BAR; PG8_WAIT_L(0); PG8_MMA(1, 0, At, B0); PG8_BAR; PG8_SCHED;
            PG8_STAGE(PG8_SB(0, 1), b2 + hstep, voffB);
            PG8_WAIT_V(6); PG8_BAR; PG8_MMA(1, 1, At, B1); PG8_BAR;
            PG8_LDB(B0, 1, 0); PG8_SCHED; PG8_LDA(At, 1, 0); PG8_STAGE(PG8_SA(0, 1), a2 + hstep, voffA);
            PG8_WAIT_L(8); PG8_BAR; PG8_WAIT_L(0); PG8_MMA(0, 0, At, B0); PG8_BAR; PG8_SCHED;
            PG8_LDB(B1, 1, 1); PG8_STAGE(PG8_SB(1, 0), b3, voffB);
            PG8_BAR; PG8_WAIT_L(0); PG8_MMA(0, 1, At, B1); PG8_BAR;
            PG8_LDA(At, 1, 1); PG8_STAGE(PG8_SA(1, 0), a3, voffA);
            PG8_BAR; PG8_WAIT_L(0); PG8_MMA(1, 0, At, B0); PG8_BAR; PG8_SCHED;
            PG8_STAGE(PG8_SB(1, 1), b3 + hstep, voffB);
            PG8_WAIT_V(6); PG8_BAR; PG8_MMA(1, 1, At, B1); PG8_BAR;
            }
            if constexpr (Epi::KHOOK) { if (t == 2) E.khook(acc, lds + STAGE_BYTES + ui * 1024, wr, fr); }
        }
        if constexpr (ALIGN_EPI) { if (wr == 0) PG8_BAR; }
        if constexpr (!Epi::AFTER_DRAIN) { E(acc, cur, wr, wc, fr, fq, lds + STAGE_BYTES + ui * 1024); S.done(cur); }
        if (!has_next) break;
#pragma unroll
        for (int a = 0; a < 2; ++a)
#pragma unroll
            for (int b = 0; b < 2; ++b)
#pragma unroll
                for (int m = 0; m < 4; ++m)
#pragma unroll
                    for (int n = 0; n < 2; ++n) acc[a][b][m][n] = (f32x4){0.f, 0.f, 0.f, 0.f};
        cur = nxt; cA = nA; cB = nB; ++ui;
        if constexpr (ALIGN_EPI) { if (wr == 1) PG8_BAR; }
    }
    PG8_WAIT_V(0);
    if constexpr (!ALIGN_EPI) { if (wr == 0) PG8_BAR; }
    PG8_BAR;
    if constexpr (Epi::AFTER_DRAIN) { E.fused(acc, cur, wr, wc, fr, fq, lds, wid, lane); S.done(cur); }
#undef PG8_SA
#undef PG8_SB
#undef PG8_STAGE
#undef PG8_LDA
#undef PG8_LDB
#undef PG8_MMA
#undef PG8_WAIT_V
#undef PG8_WAIT_L
#undef PG8_BAR
#undef PG8_SCHED
}
}

#define LAS __attribute__((address_space(3)))
typedef unsigned short bf16_t;
typedef short bf16x8 __attribute__((ext_vector_type(8)));
typedef short bf16x4 __attribute__((ext_vector_type(4)));
typedef float f32x4 __attribute__((ext_vector_type(4)));
typedef float f32x2 __attribute__((ext_vector_type(2)));
typedef unsigned u32x4 __attribute__((ext_vector_type(4)));
typedef unsigned u32x2 __attribute__((ext_vector_type(2)));
typedef short v4i16_t __attribute__((ext_vector_type(4)));

constexpr int NB = 4, SEQ = 4096, DM = 1024, DEPTH = 4, T = NB * SEQ, W = 256, DFF = 4096, NIN = 2052, ZW = 2048;
constexpr int NCH = SEQ / 128;
constexpr float EPS = 1e-6f;
constexpr float LOG2E = 1.4426950408889634f;
constexpr int NTHR = 512;
constexpr int LDS_BYTES = 147456;
constexpr int ZC_AU = 0, ZC_AV = 256, ZC_B = 512, ZC_CX = 768, ZC_CG = 1024, ZC_Q = 1280, ZC_K = 1536, ZC_V = 1792;
constexpr int YC_D = 0, YC_A = 256, YC_B = 512, YC_C = 768;

constexpr size_t MiB = 1u << 20;
constexpr size_t WS_WIN = 0, WS_WOUT = 16 * MiB, WS_WMI = 24 * MiB, WS_WMO = 56 * MiB, WS_R = 88 * MiB, WS_Z = WS_R, WS_Y = WS_R + 64 * MiB, WS_ACT = WS_R,
                 WS_H = 216 * MiB, WS_S = 248 * MiB;
constexpr size_t WS_GLUT = WS_S, WS_WAT = WS_GLUT + 512 * 1024, WS_WXT = WS_WAT + 128 * 1024, WS_BBT = WS_WXT + 128 * 1024, WS_CMT = WS_BBT + 256 * 1024,
                 WS_ABAR = WS_CMT + 256 * 1024, WS_A128 = WS_ABAR + 32 * 1024, WS_WF = WS_A128 + 32 * 1024, WS_LOGF = WS_WF + 64 * 1024, WS_CS = WS_LOGF + 256 * 1024,
                 WS_SSD = WS_CS + 256 * 1024, WS_ELOC = WS_SSD + 256 * 1024, WS_LA = WS_ELOC + 1024 * 1024, WS_LB = WS_LA + 128 * 1024, WS_BAR = WS_LB + 128 * 1024, WS_SS2 = WS_BAR + 16 * 1024, WS_KMAX = WS_SS2 + 1024 * 1024, WS_END = WS_KMAX + 4096;

struct Args {
    const float* in[30]; float* out; unsigned char* ws; int ph_lo, ph_hi;
};


typedef const __attribute__((address_space(4))) unsigned long long* kargp_t;
__device__ __forceinline__ unsigned long long karg_(int i) { kargp_t tab = (kargp_t)__builtin_amdgcn_kernarg_segment_ptr(); asm volatile("" : "+s"(tab)); return tab[i]; }
#define INP(i) ((const float*)karg_(i))
__device__ __forceinline__ unsigned char* ws_() { return (unsigned char*)karg_(31); }
__device__ __forceinline__ float* out_() { return (float*)karg_(30); }
#define PH_LO ((int)(unsigned)(karg_(32) & 0xffffffffull))
#define PH_HI ((int)(unsigned)(karg_(32) >> 32))
__device__ __forceinline__ int bid_() { return blockIdx.x; }
__device__ __forceinline__ int grid_() { return gridDim.x; }
__device__ __forceinline__ float bf2f(bf16_t v) { return __uint_as_float((unsigned)v << 16); }
__device__ __forceinline__ float bfs2f(short v) { return __uint_as_float(((unsigned)(unsigned short)v) << 16); }
typedef __bf16 bf16x2_t __attribute__((ext_vector_type(2)));
__device__ __forceinline__ unsigned pk2(float lo, float hi) { const f32x2 v = {lo, hi}; const bf16x2_t b = __builtin_convertvector(v, bf16x2_t); return __builtin_bit_cast(unsigned, b); }
__device__ __forceinline__ bf16_t f2bf(float f) { return (bf16_t)(pk2(f, 0.f) & 0xffffu); }
__device__ __forceinline__ float gelu_t(float x) { const float y2 = (1.5957691216057308f * LOG2E) * (x + 0.044715f * x * x * x); return x * __builtin_amdgcn_rcpf(1.0f + __builtin_amdgcn_exp2f(-y2)); }
__device__ __forceinline__ float sigm(float x) { return __builtin_amdgcn_rcpf(1.0f + __builtin_amdgcn_exp2f(-LOG2E * x)); }
__device__ __forceinline__ float softplus_f(float x) { return fmaxf(x, 0.f) + log1pf(__expf(-fabsf(x))); }
__device__ __forceinline__ f32x4 mfma16(bf16x8 a, bf16x8 b, f32x4 c) { return __builtin_amdgcn_mfma_f32_16x16x32_bf16(a, b, c, 0, 0, 0); }
__device__ __forceinline__ float quad_sum(float v) {
    { const auto r = __builtin_amdgcn_permlane16_swap(__float_as_uint(v), __float_as_uint(v), false, false); v = __uint_as_float(r[0]) + __uint_as_float(r[1]); }
    { const auto r = __builtin_amdgcn_permlane32_swap(__float_as_uint(v), __float_as_uint(v), false, false); v = __uint_as_float(r[0]) + __uint_as_float(r[1]); }
    return v;
}
template <int CTRL> __device__ __forceinline__ float dpp_mov(float x) { return __uint_as_float((unsigned)__builtin_amdgcn_update_dpp(0, (int)__float_as_uint(x), CTRL, 0xf, 0xf, true)); }
__device__ __forceinline__ float wave_sum(float v) {
    v += dpp_mov<0xB1>(v); v += dpp_mov<0x4E>(v); v += dpp_mov<0x141>(v); v += dpp_mov<0x140>(v);
    return quad_sum(v);
}
__device__ __forceinline__ float wave_max(float v);
__device__ __forceinline__ float quad_max(float v) {
    { const auto r = __builtin_amdgcn_permlane16_swap(__float_as_uint(v), __float_as_uint(v), false, false); v = fmaxf(__uint_as_float(r[0]), __uint_as_float(r[1])); }
    { const auto r = __builtin_amdgcn_permlane32_swap(__float_as_uint(v), __float_as_uint(v), false, false); v = fmaxf(__uint_as_float(r[0]), __uint_as_float(r[1])); }
    return v;
}
__device__ __forceinline__ bf16x8 pack8(const float* v) {
    u32x4 w; w.x = pk2(v[0], v[1]); w.y = pk2(v[2], v[3]); w.z = pk2(v[4], v[5]); w.w = pk2(v[6], v[7]); return __builtin_bit_cast(bf16x8, w);
}
__device__ __forceinline__ bf16x8 zero8() { return (bf16x8){0, 0, 0, 0, 0, 0, 0, 0}; }

__device__ __forceinline__ float wave_max(float v) {
    v = fmaxf(v, dpp_mov<0xB1>(v)); v = fmaxf(v, dpp_mov<0x4E>(v)); v = fmaxf(v, dpp_mov<0x141>(v)); v = fmaxf(v, dpp_mov<0x140>(v));
    return quad_max(v);
}
template <int N> __device__ __forceinline__ float dpp_shr(float x, float ident) {
    return __uint_as_float((unsigned)__builtin_amdgcn_update_dpp((int)__float_as_uint(ident), (int)__float_as_uint(x), 0x110 + N, 0xf, 0xf, false));
}
__device__ __forceinline__ float neg_expm1(float x) {
    const float s = -x * (1.0f + x * (0.5f + x * (0.16666667f + x * (0.041666668f + x * (0.0083333338f + x * 0.0013888889f)))));
    const float e = 1.0f - __builtin_amdgcn_exp2f(LOG2E * x);
    return (x > -0.25f) ? s : e;
}
template <int ACT  , bool ROWS = false> struct EpiStoreBf16 {
    static constexpr bool PERM = true, AFTER_DRAIN = false, KHOOK = false, KPREP = ROWS;
    __device__ __forceinline__ void kprep(const pg8::Unit& u, PG8_LAS unsigned char* tab, int tid) const {
        if (tid < 256) { const float* rp = rowss + (size_t)(u.pm * 256 + tid) * 16; const f32x4 s0 = *(const f32x4*)rp, s1 = *(const f32x4*)(rp + 4), s2 = *(const f32x4*)(rp + 8), s3 = *(const f32x4*)(rp + 12);
            const float tot = ((s0[0] + s0[1]) + (s0[2] + s0[3])) + ((s1[0] + s1[1]) + (s1[2] + s1[3])) + ((s2[0] + s2[1]) + (s2[2] + s2[3])) + ((s3[0] + s3[1]) + (s3[2] + s3[3]));
            ((PG8_LAS float*)tab)[tid] = rsqrtf(tot * (1.0f / DM) + EPS); }
    }
    bf16_t* O; int ldc; const float* rowss;
    __device__ __forceinline__ void operator()(const pg8::f32x4 (&acc)[2][2][4][2], const pg8::Unit& u, int wr, int wc, int fr, int fq, PG8_LAS unsigned char* tab) const {
        const int row0 = u.pm * 256 + wr * 64 + fr, col0 = u.pn * 256 + wc * 32 + 8 * fq;
#pragma unroll
        for (int ai = 0; ai < 2; ++ai)
#pragma unroll
            for (int m = 0; m < 4; ++m) { bf16_t* rowp = O + (size_t)(row0 + ai * 128 + m * 16) * ldc + col0;
                const float rsc = ROWS ? ((const PG8_LAS float*)tab)[wr * 64 + fr + ai * 128 + m * 16] : 1.0f;
#pragma unroll
                for (int bj = 0; bj < 2; ++bj) { pg8::f32x4 v0 = acc[ai][bj][m][0] * rsc, v1 = acc[ai][bj][m][1] * rsc;
                    if (ACT == 1) {
#pragma unroll
                        for (int e = 0; e < 4; ++e) { const float a = fmaxf(v0[e], 0.f), b = fmaxf(v1[e], 0.f); v0[e] = a * a; v1[e] = b * b; } }
                    u32x4 w; w.x = pk2(v0[0], v0[1]); w.y = pk2(v0[2], v0[3]); w.z = pk2(v1[0], v1[1]); w.w = pk2(v1[2], v1[3]);
                    *(u32x4*)(rowp + bj * 128) = w; } }
    }
};
template <bool HOOK, bool NORMOUT> struct EpiRes {
    static constexpr bool PERM = true, AFTER_DRAIN = false, KHOOK = HOOK, KPREP = HOOK;
    bf16_t* xb; int ldc; const float* ssd; float* ss2;
    __device__ __forceinline__ void operator()(const pg8::f32x4 (&acc)[2][2][4][2], const pg8::Unit& u, int wr, int wc, int fr, int fq, PG8_LAS unsigned char* tab) const {
        const int col0 = u.pn * 256 + wc * 32 + 8 * fq;
#pragma unroll
        for (int ai = 0; ai < 2; ++ai)
#pragma unroll
            for (int m = 0; m < 4; ++m) { const int row = u.pm * 256 + ai * 128 + wr * 64 + m * 16 + fr; bf16_t* rowp = xb + (size_t)row * ldc + col0; float sq = 0.f;
#pragma unroll
                for (int bj = 0; bj < 2; ++bj) { const bf16x8 s = *(const bf16x8*)(rowp + bj * 128); float o[8];
#pragma unroll
                    for (int e = 0; e < 4; ++e) { o[e] = bfs2f(s[e]) + acc[ai][bj][m][0][e]; o[4 + e] = bfs2f(s[4 + e]) + acc[ai][bj][m][1][e]; }
                    if (NORMOUT) {
#pragma unroll
                        for (int e = 0; e < 8; ++e) sq += o[e] * o[e]; }
                    *(bf16x8*)(rowp + bj * 128) = pack8(o); }
                if (NORMOUT) { sq = quad_sum(sq); if (fq == 0) ss2[(size_t)row * 16 + u.pn * 4 + wc] = sq; }
                if (m & 1) asm volatile("" ::: "memory"); }
    }
    __device__ __forceinline__ void kprep(const pg8::Unit& u, PG8_LAS unsigned char* tab, int tid) const {
        if (tid < 256) { const f32x4 s4 = *(const f32x4*)(ssd + (size_t)(u.pm * 256 + tid) * 4); ((PG8_LAS float*)tab)[tid] = rsqrtf((s4[0] + s4[1] + s4[2] + s4[3]) * (1.0f / 256.0f) + EPS); }
    }
    __device__ __forceinline__ void khook(pg8::f32x4 (&acc)[2][2][4][2], PG8_LAS unsigned char* tab, int wr, int fr) const {
#pragma unroll
        for (int ai = 0; ai < 2; ++ai)
#pragma unroll
            for (int m = 0; m < 4; ++m) { const float rs = ((const PG8_LAS float*)tab)[ai * 128 + wr * 64 + m * 16 + fr];
#pragma unroll
                for (int bj = 0; bj < 2; ++bj)
#pragma unroll
                    for (int n = 0; n < 2; ++n) acc[ai][bj][m][n] *= rs; }
    }
};

template <int TN> __device__ __forceinline__ void tc_job(unsigned char* lds, const float* src, size_t sb, int ld, int K, int N, int nbatch, bf16_t* dst, const float* gain, int kshift, int rot) {
    LAS float* tile = (LAS float*)lds;
    constexpr int CG = TN / 64, NLD = TN / 32  , NST = TN / 64  ;
    const int tid = opaque_tid(), nk = K / 64, nn = N / TN, ntile = nbatch * nk * nn;
    for (int ti = (int)((bid_() + grid_() - (rot % grid_())) % grid_()); ti < ntile; ti += grid_()) {
        const int b = ti / (nk * nn), rem = ti % (nk * nn), kt = rem / nn, nt = rem % nn;
        const float* s = src + (size_t)b * sb + (size_t)(kt * 64) * ld + nt * TN;
        f32x4 v[NLD];
#pragma unroll
        for (int p = 0; p < NLD; ++p) { const int idx = tid + 512 * p, c16 = idx & 15, kq = (idx >> 4) & 3, rest = idx >> 6, kl = (rest / CG) * 4 + kq, n4 = ((rest % CG) * 16 + c16) * 4;
            v[p] = *(const f32x4*)(s + (size_t)kl * ld + n4);
            if (gain) { const float gg = gain[(size_t)b * K + kt * 64 + kl]; v[p] = v[p] * gg; } }
        __syncthreads();
#pragma unroll
        for (int p = 0; p < NLD; ++p) { const int idx = tid + 512 * p, c16 = idx & 15, kq = (idx >> 4) & 3, rest = idx >> 6, kl = (rest / CG) * 4 + kq, n4 = ((rest % CG) * 16 + c16) * 4;
            tile[kl * (TN + 1) + n4 + 0] = v[p][0]; tile[kl * (TN + 1) + n4 + 1] = v[p][1]; tile[kl * (TN + 1) + n4 + 2] = v[p][2]; tile[kl * (TN + 1) + n4 + 3] = v[p][3]; }
        __syncthreads();
#pragma unroll
        for (int p = 0; p < NST; ++p) { const int idx = tid + 512 * p, nl = idx >> 3, kc = (idx & 7) * 8; float o[8];
#pragma unroll
            for (int e = 0; e < 8; ++e) o[e] = tile[(kc + e) * (TN + 1) + nl];
            const int kd = (kt * 64 + kc + kshift) % K;
            *(bf16x8*)(dst + (size_t)b * N * K + (size_t)(nt * TN + nl) * K + kd) = pack8(o); }
    }
    __syncthreads();
}

__device__ __forceinline__ void prep_phase(const Args& a, unsigned char* lds) {
    unsigned char* ws = ws_();
    tc_job<256>(lds, INP(2), (size_t)DM * NIN, NIN, DM, ZW, DEPTH, (bf16_t*)(ws + WS_WIN), INP(1), 0, 0);
    tc_job<256>(lds, INP(25), (size_t)DM * DM, DM, DM, DM, DEPTH, (bf16_t*)(ws + WS_WOUT), INP(24), 256, 0);
    tc_job<256>(lds, INP(27), (size_t)DM * DFF, DFF, DM, DFF, DEPTH, (bf16_t*)(ws + WS_WMI), INP(26), 0, 0);
    tc_job<256>(lds, INP(28), (size_t)DFF * DM, DM, DFF, DM, DEPTH, (bf16_t*)(ws + WS_WMO), nullptr, 0, 0);
    tc_job<256>(lds, INP(14), (size_t)W * W, W, W, W, DEPTH, (bf16_t*)(ws + WS_GLUT), nullptr, 0, 0);
    tc_job<64>(lds, INP(18), (size_t)64 * 64, 64, 64, 64, DEPTH * 4, (bf16_t*)(ws + WS_WAT), nullptr, 0, 64);
    tc_job<64>(lds, INP(20), (size_t)64 * 64, 64, 64, 64, DEPTH * 4, (bf16_t*)(ws + WS_WXT), nullptr, 0, 96);
    const int gid = bid_() * NTHR + opaque_tid();
    if (gid < DEPTH * 1024) {
        const int l = gid >> 10, gp = gid & 1023, g = gp >> 6, p = gp & 63;
        const float lre = INP(6)[gid], lim = INP(7)[gid], dt = expf(INP(8)[l * 16 + g]);
        const float mag = expf(lre * dt), are = mag * cosf(lim * dt), aim = mag * sinf(lim * dt);
        const float den = lre * lre + lim * lim, nre = are - 1.0f, nim = aim;
        const float fre = (nre * lre + nim * lim) / den, fim = (nim * lre - nre * lim) / den;
        ((f32x2*)(ws + WS_ABAR))[gid] = (f32x2){are, aim};
        float pr = are, pi = aim;
#pragma unroll
        for (int s = 0; s < 7; ++s) { const float nr = pr * pr - pi * pi, ni = 2.0f * pr * pi; pr = nr; pi = ni; }
        ((f32x2*)(ws + WS_A128))[gid] = (f32x2){pr, pi};
        const float* bre = INP(9) + (size_t)gid * 16; const float* bim = INP(10) + (size_t)gid * 16;
        bf16_t* bbt = (bf16_t*)(ws + WS_BBT) + ((size_t)(l * 16 + g) * 128 + 2 * p) * 16;
#pragma unroll
        for (int h = 0; h < 16; ++h) { const float br = bre[h], bi = bim[h]; bbt[h] = f2bf(fre * br - fim * bi); bbt[16 + h] = f2bf(fre * bi + fim * br); }
        bf16_t* cmt = (bf16_t*)(ws + WS_CMT) + (size_t)(l * 16 + g) * 16 * 128;
#pragma unroll
        for (int h = 0; h < 16; ++h) { const size_t ci = ((size_t)(l * 16 + g) * 16 + h) * 64 + p; ((unsigned*)cmt)[(h * 128 + 2 * p) >> 1] = pk2(INP(11)[ci], -INP(12)[ci]); }
        const float* wr = INP(2) + ((size_t)l * DM + gp) * NIN + ZW;
        ((f32x4*)(ws + WS_WF))[gid] = *(const f32x4*)wr * INP(1)[gid];
    }
}

template <bool SRCB, int MODE> __device__ __forceinline__ void norm_phase(const void* xsv, const float* g, bf16_t* xb, float* ss2, float* od, const float* wf, const float* bfg, float* logf) {
    const int lane = opaque_tid() & 63, wid = opaque_tid() >> 6;
    const int gw = bid_() * 8 + wid, nw = grid_() * 8;
    for (int row = gw; row < T; row += nw) {
        f32x4 v[4]; float ss = 0.f;
#pragma unroll
        for (int i = 0; i < 4; ++i) {
            if (SRCB) { const bf16x4 q = *(const bf16x4*)((const bf16_t*)xsv + (size_t)row * DM + i * 256 + lane * 4); v[i] = (f32x4){bfs2f(q[0]), bfs2f(q[1]), bfs2f(q[2]), bfs2f(q[3])}; }
            else { v[i] = *(const f32x4*)((const float*)xsv + (size_t)row * DM + i * 256 + lane * 4);
                if (MODE == 1) { u32x2 w; w.x = pk2(v[i][0], v[i][1]); w.y = pk2(v[i][2], v[i][3]); *(u32x2*)(xb + (size_t)row * DM + i * 256 + lane * 4) = w; } }
            ss += v[i][0] * v[i][0] + v[i][1] * v[i][1] + v[i][2] * v[i][2] + v[i][3] * v[i][3]; }
        ss = wave_sum(ss);
        const float rs = rsqrtf(ss * (1.0f / DM) + EPS);
        if (MODE == 1 && !SRCB) { if (lane < 16) ss2[(size_t)row * 16 + lane] = (lane == 0) ? ss : 0.f; }
        float f0 = 0.f, f1 = 0.f, f2 = 0.f, f3 = 0.f;
#pragma unroll
        for (int i = 0; i < 4; ++i) {
            if (MODE == 2) { const f32x4 gg = *(const f32x4*)(g + i * 256 + lane * 4); *(f32x4*)(od + (size_t)row * DM + i * 256 + lane * 4) = v[i] * rs * gg; }
            if (MODE == 1) {
#pragma unroll
                for (int e = 0; e < 4; ++e) { const f32x4 w4 = *(const f32x4*)(wf + (size_t)(i * 256 + lane * 4 + e) * 4); const float hv = v[i][e] * rs; f0 += hv * w4[0]; f1 += hv * w4[1]; f2 += hv * w4[2]; f3 += hv * w4[3]; } }
        }
        if (MODE == 1) {
            f0 = wave_sum(f0); f1 = wave_sum(f1); f2 = wave_sum(f2); f3 = wave_sum(f3);
            if (lane == 0) { f32x4 o; const float fv[4] = {f0 + bfg[0], f1 + bfg[1], f2 + bfg[2], f3 + bfg[3]};
#pragma unroll
                for (int e = 0; e < 4; ++e) o[e] = fminf(fv[e], 0.f) - log1pf(__expf(-fabsf(fv[e])));
                *(f32x4*)(logf + (size_t)row * 4) = o; }
        }
    }
}

__device__ __forceinline__ void cumsum_item(int b, const float* logf, float* cs, unsigned char* lds) {
    LAS float* wt = (LAS float*)lds;
    const int tid = opaque_tid(), lane = tid & 63, wid = tid >> 6;
    f32x4 v[8]; f32x4 run = (f32x4){0.f, 0.f, 0.f, 0.f};
    const float* src = logf + ((size_t)b * SEQ + (size_t)tid * 8) * 4;
#pragma unroll
    for (int e = 0; e < 8; ++e) { run = run + *(const f32x4*)(src + e * 4); v[e] = run; }
    f32x4 inc = run;
#pragma unroll
    for (int d = 1; d < 64; d <<= 1) {
        const int sl = ((lane >= d) ? lane - d : lane) << 2; f32x4 o;
#pragma unroll
        for (int e = 0; e < 4; ++e) o[e] = __uint_as_float((unsigned)__builtin_amdgcn_ds_bpermute(sl, (int)__float_as_uint(inc[e])));
        if (lane >= d) inc = inc + o;
    }
    __syncthreads();
    if (lane == 63) { wt[wid * 4 + 0] = inc[0]; wt[wid * 4 + 1] = inc[1]; wt[wid * 4 + 2] = inc[2]; wt[wid * 4 + 3] = inc[3]; }
    __syncthreads();
    f32x4 off = inc - run;
    for (int w2 = 0; w2 < wid; ++w2) { off[0] += wt[w2 * 4 + 0]; off[1] += wt[w2 * 4 + 1]; off[2] += wt[w2 * 4 + 2]; off[3] += wt[w2 * 4 + 3]; }
    float* dst = cs + ((size_t)b * SEQ + (size_t)tid * 8) * 4;
#pragma unroll
    for (int e = 0; e < 8; ++e) *(f32x4*)(dst + e * 4) = (v[e] + off) * LOG2E;
    __syncthreads();
}

template <int HALF> __device__ __forceinline__ void sgu_item(int l, int b, int c, const Args& a, unsigned char* lds) {
    const bf16_t* z = (const bf16_t*)(ws_() + WS_Z); bf16_t* y = (bf16_t*)(ws_() + WS_Y);
    LAS bf16_t* vn = (LAS bf16_t*)lds;
    LAS float* ssb = (LAS float*)(lds + 69632);
    const int tid = opaque_tid(), lane = tid & 63, wid = tid >> 6, fr = lane & 15, quad = lane >> 4;
    const size_t t0 = (size_t)b * SEQ + (size_t)c * 128;
    const float* ng = INP(3) + l * W;
    __syncthreads();
    const f32x4 gch = *(const f32x4*)(ng + lane * 4);
    constexpr int TPW = HALF ? 16 : 8;
#pragma unroll
    for (int i = 0; i < TPW; ++i) {
        const int s = wid * TPW + i;
        const bf16x4 zv = *(const bf16x4*)(z + (t0 + s) * ZW + ZC_AV + lane * 4);
        float gv[4]; float ss = 0.f;
#pragma unroll
        for (int e = 0; e < 4; ++e) { gv[e] = gelu_t(bfs2f(zv[e])); ss += gv[e] * gv[e]; }
        ss = wave_sum(ss); const float rs = rsqrtf(ss * (1.0f / W) + EPS);
        u32x2 w; w.x = pk2(gv[0] * rs * gch[0], gv[1] * rs * gch[1]); w.y = pk2(gv[2] * rs * gch[2], gv[3] * rs * gch[3]);
        *(LAS u32x2*)(vn + s * 264 + lane * 4) = w;
    }
    __syncthreads();
    const int h = wid & 3;
    const float* wsrc = INP(4) + ((size_t)(l * 4 + h) * 128) * 128;
    const float* bsrc = INP(5) + (size_t)(l * 4 + h) * 128;
    float outv[2][4][4];
#pragma unroll
    for (int i = 0; i < 2; ++i) {
        const int mt = HALF * 4 + (wid >> 2) + 2 * i, t = mt * 16 + fr;
        f32x4 acc[4];
#pragma unroll
        for (int nt = 0; nt < 4; ++nt) acc[nt] = (f32x4){0.f, 0.f, 0.f, 0.f};
        f32x4 wl[4][2];
#pragma unroll
        for (int kk = 0; kk < 4; ++kk) { const int k0 = (kk * 32 < (mt + 1) * 16) ? kk * 32 : 0; const float* wp = wsrc + (size_t)t * 128 + k0 + quad * 8; wl[kk][0] = *(const f32x4*)wp; wl[kk][1] = *(const f32x4*)(wp + 4); }
#pragma unroll
        for (int kk = 0; kk < 4; ++kk) {
            const int k0 = kk * 32;
            if (k0 < (mt + 1) * 16) {
                float wv[8] = {wl[kk][0][0], wl[kk][0][1], wl[kk][0][2], wl[kk][0][3], wl[kk][1][0], wl[kk][1][1], wl[kk][1][2], wl[kk][1][3]};
#pragma unroll
                for (int e = 0; e < 8; ++e) if (k0 + quad * 8 + e > t) wv[e] = 0.f;
                const bf16x8 wf = pack8(wv);
#pragma unroll
                for (int nt = 0; nt < 4; ++nt) {
                    LAS bf16_t* tp = vn + (k0 + quad * 8 + (fr >> 2)) * 264 + h * 64 + nt * 16 + (fr & 3) * 4;
                    const bf16x4 lo = __builtin_bit_cast(bf16x4, __builtin_amdgcn_ds_read_tr16_b64_v4i16((LAS v4i16_t*)tp));
                    const bf16x4 hi = __builtin_bit_cast(bf16x4, __builtin_amdgcn_ds_read_tr16_b64_v4i16((LAS v4i16_t*)(tp + 4 * 264)));
                    const bf16x8 vf = (bf16x8){lo[0], lo[1], lo[2], lo[3], hi[0], hi[1], hi[2], hi[3]};
                    acc[nt] = mfma16(vf, wf, acc[nt]); }
            }
        }
        const float bs = bsrc[t]; float ss = 0.f;
#pragma unroll
        for (int nt = 0; nt < 4; ++nt) { const int ch = h * 64 + nt * 16 + quad * 4; const bf16x4 u4 = *(const bf16x4*)(z + (t0 + t) * ZW + ZC_AU + ch);
#pragma unroll
            for (int r = 0; r < 4; ++r) { const float o = gelu_t(bfs2f(u4[r])) * (acc[nt][r] + bs); outv[i][nt][r] = o; ss += o * o; } }
        ss = quad_sum(ss);
        if (quad == 0) ssb[t * 4 + h] = ss;
    }
    __syncthreads();
#pragma unroll
    for (int i = 0; i < 2; ++i) {
        const int mt = HALF * 4 + (wid >> 2) + 2 * i, t = mt * 16 + fr;
        const float rs = rsqrtf((ssb[t * 4 + 0] + ssb[t * 4 + 1] + ssb[t * 4 + 2] + ssb[t * 4 + 3]) * (1.0f / W) + EPS);
#pragma unroll
        for (int nt = 0; nt < 4; ++nt) { const int ch = h * 64 + nt * 16 + quad * 4; u32x2 w; w.x = pk2(outv[i][nt][0] * rs, outv[i][nt][1] * rs); w.y = pk2(outv[i][nt][2] * rs, outv[i][nt][3] * rs);
            *(u32x2*)(y + (t0 + t) * DM + YC_A + ch) = w; }
    }
    __syncthreads();
}

template <int PASS> __device__ __forceinline__ void s5_item(int l, int b, int c, const Args& a, unsigned char* lds) {
    const bf16_t* z = (const bf16_t*)(ws_() + WS_Z); bf16_t* y = (bf16_t*)(ws_() + WS_Y);
    LAS unsigned char* BU = (LAS unsigned char*)lds;
    LAS unsigned* BU32 = (LAS unsigned*)lds;
    LAS bf16_t* Yb = (LAS bf16_t*)(lds + 65792);
    LAS float* ssb = (LAS float*)(lds + 65792 + 67584);
    const int tid = opaque_tid(), lane = tid & 63, wid = tid >> 6, fr = lane & 15, quad = lane >> 4;
    const int sx0 = wid * 128 + lane, sx1 = sx0 + 64;
    const size_t t0 = (size_t)b * SEQ + (size_t)c * 128;
    const f32x2* abar = (const f32x2*)(ws_() + WS_ABAR) + l * 1024;
    f32x2* eloc = (f32x2*)(ws_() + WS_ELOC);
    float ar[2], ai[2], sre[2], sim[2];
#pragma unroll
    for (int q = 0; q < 2; ++q) { const f32x2 ab = abar[q ? sx1 : sx0]; ar[q] = ab[0]; ai[q] = ab[1]; sre[q] = 0.f; sim[q] = 0.f; }
    if (PASS == 2) {
        const f32x2* a128 = (const f32x2*)(ws_() + WS_A128) + l * 1024;
        const f32x2 p0 = a128[sx0], p1 = a128[sx1];
        for (int cc0 = 0; cc0 < c; cc0 += 8) {
            f32x2 e0[8], e1[8];
#pragma unroll
            for (int u = 0; u < 8; ++u) { const int cc = (cc0 + u < c) ? cc0 + u : c - 1; e0[u] = eloc[((size_t)(b * NCH + cc)) * 1024 + sx0]; e1[u] = eloc[((size_t)(b * NCH + cc)) * 1024 + sx1]; }
#pragma unroll
            for (int u = 0; u < 8; ++u) if (cc0 + u < c) {
                const float nr0 = p0[0] * sre[0] - p0[1] * sim[0] + e0[u][0], ni0 = p0[0] * sim[0] + p0[1] * sre[0] + e0[u][1]; sre[0] = nr0; sim[0] = ni0;
                const float nr1 = p1[0] * sre[1] - p1[1] * sim[1] + e1[u][0], ni1 = p1[0] * sim[1] + p1[1] * sre[1] + e1[u][1]; sre[1] = nr1; sim[1] = ni1; }
        }
    }
    bf16x8 bfrag[2][8];
    const bf16_t* bbt = (const bf16_t*)(ws_() + WS_BBT);
#pragma unroll
    for (int gi = 0; gi < 2; ++gi)
#pragma unroll
        for (int j = 0; j < 8; ++j) bfrag[gi][j] = (quad < 2) ? *(const bf16x8*)(bbt + ((size_t)(l * 16 + wid * 2 + gi) * 128 + j * 16 + fr) * 16 + quad * 8) : zero8();
    bf16x8 cfrag[2][4];
    if (PASS == 2) {
        const bf16_t* cmt = (const bf16_t*)(ws_() + WS_CMT);
#pragma unroll
        for (int gi = 0; gi < 2; ++gi)
#pragma unroll
            for (int ks = 0; ks < 4; ++ks) cfrag[gi][ks] = *(const bf16x8*)(cmt + ((size_t)(l * 16 + wid * 2 + gi) * 16 + fr) * 128 + ks * 32 + quad * 8);
    }
    const float* dsk = INP(13) + l * W;
    __syncthreads();
    bf16x8 ufn[2];
#pragma unroll
    for (int gi = 0; gi < 2; ++gi) ufn[gi] = (quad < 2) ? *(const bf16x8*)(z + (t0 + fr) * ZW + ZC_B + (wid * 2 + gi) * 16 + quad * 8) : zero8();
    for (int sc = 0; sc < 8; ++sc) {
        const size_t tr = t0 + sc * 16 + fr;
        bf16x8 ufc[2] = {ufn[0], ufn[1]};
        bf16x4 u4c[2] = {(bf16x4){0, 0, 0, 0}, (bf16x4){0, 0, 0, 0}};
        if (PASS == 2) {
#pragma unroll
            for (int gi = 0; gi < 2; ++gi) u4c[gi] = *(const bf16x4*)(z + tr * ZW + ZC_B + (wid * 2 + gi) * 16 + quad * 4);
        }
        if (sc < 7) {
#pragma unroll
            for (int gi = 0; gi < 2; ++gi) ufn[gi] = (quad < 2) ? *(const bf16x8*)(z + (tr + 16) * ZW + ZC_B + (wid * 2 + gi) * 16 + quad * 8) : zero8();
        }
#pragma unroll
        for (int gi = 0; gi < 2; ++gi) {
            const int g = wid * 2 + gi;
            const bf16x8 uf = ufc[gi];
#pragma unroll
            for (int j = 0; j < 8; ++j) {
                const f32x4 acc = mfma16(bfrag[gi][j], uf, (f32x4){0.f, 0.f, 0.f, 0.f});
                u32x2 w; w.x = pk2(acc[0], acc[1]); w.y = pk2(acc[2], acc[3]);
                *(LAS u32x2*)(BU + fr * 4112 + (g * 64 + j * 8 + quad * 2) * 4) = w;
            }
        }
        asm volatile("s_waitcnt lgkmcnt(0)" ::: "memory");
        {
            unsigned wv[16][2];
#pragma unroll
            for (int tt = 0; tt < 16; ++tt) { wv[tt][0] = BU32[tt * 1028 + sx0]; wv[tt][1] = BU32[tt * 1028 + sx1]; }
#pragma unroll
            for (int tt = 0; tt < 16; ++tt) {
#pragma unroll
                for (int q = 0; q < 2; ++q) {
                    const unsigned w = wv[tt][q];
                    const f32x2 bu2 = {__uint_as_float(w << 16), __uint_as_float(w & 0xffff0000u)};
                    const f32x2 s2 = {sre[q], sim[q]}, sw = {sim[q], sre[q]}, arr = {ar[q], ar[q]}, aii = {-ai[q], ai[q]};
                    const f32x2 n2 = aii * sw + (arr * s2 + bu2);
                    sre[q] = n2[0]; sim[q] = n2[1];
                    if (PASS == 2) wv[tt][q] = pk2(n2[0], n2[1]);
                }
            }
            if (PASS == 2) {
#pragma unroll
                for (int tt = 0; tt < 16; ++tt) { BU32[tt * 1028 + sx0] = wv[tt][0]; BU32[tt * 1028 + sx1] = wv[tt][1]; }
            }
        }
        asm volatile("s_waitcnt lgkmcnt(0)" ::: "memory");
        if (PASS == 2) {
#pragma unroll
            for (int gi = 0; gi < 2; ++gi) {
                const int g = wid * 2 + gi; f32x4 acc = (f32x4){0.f, 0.f, 0.f, 0.f};
#pragma unroll
                for (int ks = 0; ks < 4; ++ks) { const bf16x8 sf = *(const LAS bf16x8*)(BU + fr * 4112 + g * 256 + (ks * 32 + quad * 8) * 2); acc = mfma16(cfrag[gi][ks], sf, acc); }
                const int ch = g * 16 + quad * 4; const bf16x4 u4 = u4c[gi]; const f32x4 d4 = *(const f32x4*)(dsk + ch);
                float o[4];
#pragma unroll
                for (int r = 0; r < 4; ++r) o[r] = gelu_t(acc[r] + d4[r] * bfs2f(u4[r]));
                u32x2 w; w.x = pk2(o[0], o[1]); w.y = pk2(o[2], o[3]);
                *(LAS u32x2*)(Yb + (sc * 16 + fr) * 264 + ch) = w;
            }
        }
    }
    if (PASS == 1) {
#pragma unroll
        for (int q = 0; q < 2; ++q) eloc[((size_t)(b * NCH + c)) * 1024 + (q ? sx1 : sx0)] = (f32x2){sre[q], sim[q]};
    } else {
        __syncthreads();
        const bf16_t* glut = (const bf16_t*)(ws_() + WS_GLUT) + (size_t)l * W * W;
        const float* glub = INP(15) + l * W;
        bf16x8 gfrag[2][8];
#pragma unroll
        for (int ni = 0; ni < 2; ++ni)
#pragma unroll
            for (int ks = 0; ks < 8; ++ks) gfrag[ni][ks] = *(const bf16x8*)(glut + (size_t)((wid * 2 + ni) * 16 + fr) * W + ks * 32 + quad * 8);
        float outv[8][2][4];
#pragma unroll
        for (int mt = 0; mt < 8; ++mt) {
            f32x4 acc0 = (f32x4){0.f, 0.f, 0.f, 0.f}, acc1 = acc0;
#pragma unroll
            for (int ks = 0; ks < 8; ++ks) { const bf16x8 yf = *(const LAS bf16x8*)(Yb + (mt * 16 + fr) * 264 + ks * 32 + quad * 8); acc0 = mfma16(gfrag[0][ks], yf, acc0); acc1 = mfma16(gfrag[1][ks], yf, acc1); }
            float ss = 0.f;
#pragma unroll
            for (int ni = 0; ni < 2; ++ni) { const int n = (wid * 2 + ni) * 16 + quad * 4; const bf16x4 y4 = *(const LAS bf16x4*)(Yb + (mt * 16 + fr) * 264 + n); const f32x4 gb = *(const f32x4*)(glub + n);
#pragma unroll
                for (int r = 0; r < 4; ++r) { const float gt = (ni == 0 ? acc0[r] : acc1[r]) + gb[r]; const float o = bfs2f(y4[r]) * sigm(gt); outv[mt][ni][r] = o; ss += o * o; } }
            ss = quad_sum(ss);
            if (quad == 0) ssb[(mt * 16 + fr) * 8 + wid] = ss;
        }
        __syncthreads();
#pragma unroll
        for (int mt = 0; mt < 8; ++mt) {
            const int t = mt * 16 + fr; float s = 0.f;
#pragma unroll
            for (int w2 = 0; w2 < 8; ++w2) s += ssb[t * 8 + w2];
            const float rs = rsqrtf(s * (1.0f / W) + EPS);
#pragma unroll
            for (int ni = 0; ni < 2; ++ni) { const int n = (wid * 2 + ni) * 16 + quad * 4; u32x2 w; w.x = pk2(outv[mt][ni][0] * rs, outv[mt][ni][1] * rs); w.y = pk2(outv[mt][ni][2] * rs, outv[mt][ni][3] * rs);
                *(u32x2*)(y + (t0 + t) * DM + YC_B + n) = w; }
        }
    }
    __syncthreads();
}

template <int PASS> __device__ __forceinline__ void lru_item(int l, int b, int c, const Args& a, unsigned char* lds) {
    const bf16_t* z = (const bf16_t*)(ws_() + WS_Z); bf16_t* y = (bf16_t*)(ws_() + WS_Y);
    LAS bf16_t* XC = (LAS bf16_t*)lds;
    LAS float* ssb = (LAS float*)(lds + 67584);
    const int tid = opaque_tid(), lane = tid & 63, wid = tid >> 6, fr = lane & 15, quad = lane >> 4;
    const size_t t0 = (size_t)b * SEQ + (size_t)c * 128;
    float* LAp = (float*)(ws_() + WS_LA); float* LBp = (float*)(ws_() + WS_LB);
    __syncthreads();
    {
        const float* cw = INP(16) + (size_t)l * 4 * W; const float* cb = INP(17) + l * W;
#pragma unroll 4
        for (int it = 0; it < 8; ++it) {
            const int p = tid + 512 * it, tok = p >> 5, ch0 = (p & 31) * 8; float acc[8];
            { const f32x4 c0 = *(const f32x4*)(cb + ch0), c1 = *(const f32x4*)(cb + ch0 + 4); acc[0] = c0[0]; acc[1] = c0[1]; acc[2] = c0[2]; acc[3] = c0[3]; acc[4] = c1[0]; acc[5] = c1[1]; acc[6] = c1[2]; acc[7] = c1[3]; }
#pragma unroll
            for (int k = 0; k < 4; ++k) {
                const int tt = tok - 3 + k;
                if (c * 128 + tt >= 0) {
                    const bf16x8 xv = *(const bf16x8*)(z + (size_t)((long)t0 + tt) * ZW + ZC_CX + ch0);
                    const f32x4 w0 = *(const f32x4*)(cw + k * W + ch0), w1 = *(const f32x4*)(cw + k * W + ch0 + 4);
                    acc[0] += w0[0] * bfs2f(xv[0]); acc[1] += w0[1] * bfs2f(xv[1]); acc[2] += w0[2] * bfs2f(xv[2]); acc[3] += w0[3] * bfs2f(xv[3]);
                    acc[4] += w1[0] * bfs2f(xv[4]); acc[5] += w1[1] * bfs2f(xv[5]); acc[6] += w1[2] * bfs2f(xv[6]); acc[7] += w1[3] * bfs2f(xv[7]);
                }
            }
            *(LAS bf16x8*)(XC + tok * 264 + ch0) = pack8(acc);
        }
    }
    __syncthreads();
    const int hh = wid >> 1;
    const bf16_t* wat = (const bf16_t*)(ws_() + WS_WAT) + (size_t)(l * 4 + hh) * 64 * 64;
    const bf16_t* wxt = (const bf16_t*)(ws_() + WS_WXT) + (size_t)(l * 4 + hh) * 64 * 64;
    bf16x8 waf[2][2], wxf[2][2]; float sp8[2][4], bav[2][4], bxv[2][4], H[2][4], Acar[2][4], Bcar[2][4];
#pragma unroll
    for (int ni = 0; ni < 2; ++ni) {
        const int nl = (wid * 2 + ni) * 16 - hh * 64 + fr;
#pragma unroll
        for (int ks = 0; ks < 2; ++ks) { waf[ni][ks] = *(const bf16x8*)(wat + nl * 64 + ks * 32 + quad * 8); wxf[ni][ks] = *(const bf16x8*)(wxt + nl * 64 + ks * 32 + quad * 8); }
#pragma unroll
        for (int r = 0; r < 4; ++r) { const int ch = (wid * 2 + ni) * 16 + quad * 4 + r;
            sp8[ni][r] = 8.0f * softplus_f(-INP(22)[l * W + ch]); bav[ni][r] = INP(19)[l * W + ch]; bxv[ni][r] = INP(21)[l * W + ch];
            H[ni][r] = 0.f; Acar[ni][r] = 1.f; Bcar[ni][r] = 0.f;
        }
    }
    if (PASS == 2 && c > 0) {
#pragma unroll
        for (int ni = 0; ni < 2; ++ni) {
            const size_t ob = (size_t)(b * NCH) * W + (wid * 2 + ni) * 16 + quad * 4;
            const bool v0 = fr < c, v1 = 16 + fr < c;
            f32x4 a0 = (f32x4){1.f, 1.f, 1.f, 1.f}, b0 = (f32x4){0.f, 0.f, 0.f, 0.f}, a1 = a0, b1 = b0;
            if (v0) { a0 = *(const f32x4*)(LAp + ob + (size_t)fr * W); b0 = *(const f32x4*)(LBp + ob + (size_t)fr * W); }
            if (v1) { a1 = *(const f32x4*)(LAp + ob + (size_t)(16 + fr) * W); b1 = *(const f32x4*)(LBp + ob + (size_t)(16 + fr) * W); }
#pragma unroll
            for (int r = 0; r < 4; ++r) {
                float av = a0[r], bb = b0[r], aw = a1[r], bw = b1[r], ap, bp;
                ap = dpp_shr<1>(av, 1.0f); bp = dpp_shr<1>(bb, 0.0f); bb = av * bp + bb; av = av * ap;   ap = dpp_shr<1>(aw, 1.0f); bp = dpp_shr<1>(bw, 0.0f); bw = aw * bp + bw; aw = aw * ap;
                ap = dpp_shr<2>(av, 1.0f); bp = dpp_shr<2>(bb, 0.0f); bb = av * bp + bb; av = av * ap;   ap = dpp_shr<2>(aw, 1.0f); bp = dpp_shr<2>(bw, 0.0f); bw = aw * bp + bw; aw = aw * ap;
                ap = dpp_shr<4>(av, 1.0f); bp = dpp_shr<4>(bb, 0.0f); bb = av * bp + bb; av = av * ap;   ap = dpp_shr<4>(aw, 1.0f); bp = dpp_shr<4>(bw, 0.0f); bw = aw * bp + bw; aw = aw * ap;
                ap = dpp_shr<8>(av, 1.0f); bp = dpp_shr<8>(bb, 0.0f); bb = av * bp + bb; av = av * ap;   ap = dpp_shr<8>(aw, 1.0f); bp = dpp_shr<8>(bw, 0.0f); bw = aw * bp + bw; aw = aw * ap;
                const float B0t = __shfl(bb, 15, 16), A1t = __shfl(aw, 15, 16), B1t = __shfl(bw, 15, 16);
                H[ni][r] = A1t * B0t + B1t;
            }
        }
    }
    LAS bf16_t* Ob = (LAS bf16_t*)(lds + 67584 + 4096);
#pragma unroll 2
    for (int mt = 0; mt < 8; ++mt) {
        bf16x8 xf[2];
#pragma unroll
        for (int ks = 0; ks < 2; ++ks) xf[ks] = *(const LAS bf16x8*)(XC + (mt * 16 + fr) * 264 + hh * 64 + ks * 32 + quad * 8);
        float ss = 0.f;
#pragma unroll
        for (int ni = 0; ni < 2; ++ni) {
            f32x4 accA = (f32x4){0.f, 0.f, 0.f, 0.f}, accX = accA;
#pragma unroll
            for (int ks = 0; ks < 2; ++ks) { accA = mfma16(waf[ni][ks], xf[ks], accA); accX = mfma16(wxf[ni][ks], xf[ks], accX); }
            const int ch0 = (wid * 2 + ni) * 16 + quad * 4;
            const bf16x4 xc4 = *(const LAS bf16x4*)(XC + (mt * 16 + fr) * 264 + ch0);
            bf16x4 g4 = (bf16x4){0, 0, 0, 0};
            if (PASS == 2) g4 = *(const bf16x4*)(z + (t0 + mt * 16 + fr) * ZW + ZC_CG + ch0);
            float ov[4] = {0.f, 0.f, 0.f, 0.f};
#pragma unroll
            for (int r = 0; r < 4; ++r) {
                const float rg = sigm(accA[r] + bav[ni][r]), ig = sigm(accX[r] + bxv[ni][r]);
                const float la = -rg * sp8[ni][r];
                float av = __builtin_amdgcn_exp2f(LOG2E * la), bb = __builtin_amdgcn_sqrtf(fmaxf(neg_expm1(2.0f * la), 0.f)) * (ig * bfs2f(xc4[r]));
                { float ap, bp;
                  ap = dpp_shr<1>(av, 1.0f); bp = dpp_shr<1>(bb, 0.0f); bb = av * bp + bb; av = av * ap;
                  ap = dpp_shr<2>(av, 1.0f); bp = dpp_shr<2>(bb, 0.0f); bb = av * bp + bb; av = av * ap;
                  ap = dpp_shr<4>(av, 1.0f); bp = dpp_shr<4>(bb, 0.0f); bb = av * bp + bb; av = av * ap;
                  ap = dpp_shr<8>(av, 1.0f); bp = dpp_shr<8>(bb, 0.0f); bb = av * bp + bb; av = av * ap; }
                if (PASS == 1) { const float At = __shfl(av, 15, 16), Bt = __shfl(bb, 15, 16); Bcar[ni][r] = At * Bcar[ni][r] + Bt; Acar[ni][r] *= At; }
                else { const float hv = av * H[ni][r] + bb; H[ni][r] = __shfl(hv, 15, 16); const float o = hv * gelu_t(bfs2f(g4[r])); ov[r] = o; ss += o * o; }
            }
            if (PASS == 2) { u32x2 w; w.x = pk2(ov[0], ov[1]); w.y = pk2(ov[2], ov[3]); *(LAS u32x2*)(Ob + (mt * 16 + fr) * 264 + ch0) = w; }
        }
        if (PASS == 2) { ss = quad_sum(ss); if (quad == 0) ssb[(mt * 16 + fr) * 8 + wid] = ss; }
    }
    if (PASS == 1) {
        if (fr == 0) {
#pragma unroll
            for (int ni = 0; ni < 2; ++ni)
#pragma unroll
                for (int r = 0; r < 4; ++r) { const size_t o = ((size_t)(b * NCH + c)) * W + (wid * 2 + ni) * 16 + quad * 4 + r; LAp[o] = Acar[ni][r]; LBp[o] = Bcar[ni][r]; }
        }
        {
            const int tok = tid >> 2, hd = tid & 3; float s2 = 0.f;
#pragma unroll
            for (int j = 0; j < 8; ++j) { const bf16x8 kv = *(const bf16x8*)(z + (t0 + tok) * ZW + ZC_K + hd * 64 + j * 8);
#pragma unroll
                for (int e = 0; e < 8; ++e) { const float f = bfs2f(kv[e]); s2 += f * f; } }
            ssb[tok * 4 + hd] = s2;
            __syncthreads();
            if (tid < 4) { float mxv = 0.f; for (int i = 0; i < 128; ++i) mxv = fmaxf(mxv, ssb[i * 4 + tid]); ((float*)(ws_() + WS_KMAX))[(b * NCH + c) * 4 + tid] = mxv; }
        }
    } else {
        __syncthreads();
#pragma unroll 2
        for (int mt = 0; mt < 8; ++mt) {
            const int t = mt * 16 + fr; float s = 0.f;
#pragma unroll
            for (int w2 = 0; w2 < 8; ++w2) s += ssb[t * 8 + w2];
            const float rs = rsqrtf(s * (1.0f / W) + EPS);
#pragma unroll
            for (int ni = 0; ni < 2; ++ni) { const int n = (wid * 2 + ni) * 16 + quad * 4; const bf16x4 o4 = *(const LAS bf16x4*)(Ob + t * 264 + n);
                u32x2 w; w.x = pk2(bfs2f(o4[0]) * rs, bfs2f(o4[1]) * rs); w.y = pk2(bfs2f(o4[2]) * rs, bfs2f(o4[3]) * rs);
                *(u32x2*)(y + (t0 + t) * DM + YC_C + n) = w; }
        }
    }
    __syncthreads();
}

template <bool DIAG> __device__ __forceinline__ void attn_step2(const LAS unsigned char* buf, int kbase, int qrow0, int quad, int fr, const bf16x8 (&qf)[2][2], float (&m)[2], float (&lsum)[2], f32x4 (&oacc)[2][4]) {
    const LAS bf16_t* Kt = (const LAS bf16_t*)buf; const LAS bf16_t* Vt = (const LAS bf16_t*)(buf + 9216); const LAS float* csl = (const LAS float*)(buf + 18432);
    LAS bf16_t* vtr0 = (LAS bf16_t*)Vt + (quad * 4 + (fr >> 2)) * 72 + (fr & 3) * 4;
    float p[2][4][4];
#pragma unroll
    for (int st = 0; st < 4; ++st) {
        const f32x4 c4 = *(const LAS f32x4*)(csl + st * 16 + quad * 4);
        const bf16x8 kf0 = *(const LAS bf16x8*)(Kt + (st * 16 + fr) * 72 + quad * 8), kf1 = *(const LAS bf16x8*)(Kt + (st * 16 + fr) * 72 + 32 + quad * 8);
#pragma unroll
        for (int qs = 0; qs < 2; ++qs) {
            f32x4 acc = mfma16(kf0, qf[qs][0], c4); acc = mfma16(kf1, qf[qs][1], acc);
#pragma unroll
            for (int r = 0; r < 4; ++r) { float v = acc[r]; if (DIAG && (kbase + st * 16 + quad * 4 + r > qrow0 + qs * 16)) v = -1e30f; p[qs][st][r] = v; }
        }
    }
    bf16x8 pf[2][2];
#pragma unroll
    for (int qs = 0; qs < 2; ++qs) {
        float mx = -1e30f;
#pragma unroll
        for (int st = 0; st < 4; ++st)
#pragma unroll
            for (int r = 0; r < 4; ++r) mx = fmaxf(mx, p[qs][st][r]);
        mx = quad_max(mx);
        if (__any(mx > m[qs])) {
            const float mnew = fmaxf(m[qs], mx), al = __builtin_amdgcn_exp2f(m[qs] - mnew); m[qs] = mnew; lsum[qs] *= al;
#pragma unroll
            for (int dt = 0; dt < 4; ++dt) oacc[qs][dt] = oacc[qs][dt] * al;
        }
        const float mcur = m[qs];
        float ps = 0.f;
#pragma unroll
        for (int st = 0; st < 4; ++st)
#pragma unroll
            for (int r = 0; r < 4; ++r) { const float e = __builtin_amdgcn_exp2f(p[qs][st][r] - mcur); p[qs][st][r] = e; ps += e; }
        lsum[qs] += ps;
#pragma unroll
        for (int ks = 0; ks < 2; ++ks) { u32x4 w; w.x = pk2(p[qs][2 * ks][0], p[qs][2 * ks][1]); w.y = pk2(p[qs][2 * ks][2], p[qs][2 * ks][3]); w.z = pk2(p[qs][2 * ks + 1][0], p[qs][2 * ks + 1][1]); w.w = pk2(p[qs][2 * ks + 1][2], p[qs][2 * ks + 1][3]); pf[qs][ks] = __builtin_bit_cast(bf16x8, w); }
    }
#pragma unroll
    for (int dt = 0; dt < 4; ++dt) {
#pragma unroll
        for (int ks = 0; ks < 2; ++ks) {
            const bf16x4 v0 = __builtin_bit_cast(bf16x4, __builtin_amdgcn_ds_read_tr16_b64_v4i16((LAS v4i16_t*)(vtr0 + (ks * 32) * 72 + dt * 16)));
            const bf16x4 v1 = __builtin_bit_cast(bf16x4, __builtin_amdgcn_ds_read_tr16_b64_v4i16((LAS v4i16_t*)(vtr0 + (ks * 32 + 16) * 72 + dt * 16)));
            const bf16x8 vf = (bf16x8){v0[0], v0[1], v0[2], v0[3], v1[0], v1[1], v1[2], v1[3]};
            oacc[0][dt] = mfma16(vf, pf[0][ks], oacc[0][dt]); oacc[1][dt] = mfma16(vf, pf[1][ks], oacc[1][dt]);
        }
    }
}
__device__ __forceinline__ void attn_unit(int b, int h, int qb, const Args& a, unsigned char* lds) {
    const bf16_t* z = (const bf16_t*)(ws_() + WS_Z); bf16_t* y = (bf16_t*)(ws_() + WS_Y);
    const float* cs = (const float*)(ws_() + WS_CS); float* ssd = (float*)(ws_() + WS_SSD);
    constexpr int ABUF = 9216 + 9216 + 256;
    LAS unsigned char* lb = (LAS unsigned char*)lds;
    const int tid = opaque_tid(), lane = tid & 63, wid = tid >> 6, fr = lane & 15, quad = lane >> 4, grp = wid >> 2, wq = wid & 3;
    const int q0 = qb * 128, qw = q0 + wq * 32, qrow0 = qw + fr;
    const size_t rb = (size_t)b * SEQ;
    bf16x8 qf[2][2];
    {
        const float SC = 0.125f * LOG2E;
#pragma unroll
        for (int qs = 0; qs < 2; ++qs)
#pragma unroll
            for (int ds = 0; ds < 2; ++ds) { const bf16x8 qv = *(const bf16x8*)(z + (rb + qrow0 + qs * 16) * ZW + ZC_Q + h * 64 + ds * 32 + quad * 8); float t8[8];
#pragma unroll
                for (int e = 0; e < 8; ++e) t8[e] = bfs2f(qv[e]) * SC;
                qf[qs][ds] = pack8(t8); }
    }
    float m[2] = {-1e30f, -1e30f}, lsum[2] = {0.f, 0.f}; f32x4 oacc[2][4];
#pragma unroll
    for (int qs = 0; qs < 2; ++qs)
#pragma unroll
        for (int dt = 0; dt < 4; ++dt) oacc[qs][dt] = (f32x4){0.f, 0.f, 0.f, 0.f};
    float qbnd[2];
    {
        float kv = (lane <= qb) ? ((const float*)(ws_() + WS_KMAX))[(b * NCH + lane) * 4 + h] : 0.f;
        kv = wave_max(kv);
        const float kmax = __builtin_amdgcn_sqrtf(kv) * 1.01f + 1e-3f;
#pragma unroll
        for (int qs = 0; qs < 2; ++qs) { float q2 = 0.f;
#pragma unroll
            for (int ds = 0; ds < 2; ++ds)
#pragma unroll
                for (int e = 0; e < 8; ++e) { const float f = bfs2f(qf[qs][ds][e]); q2 += f * f; }
            q2 = quad_sum(q2); qbnd[qs] = (__builtin_amdgcn_sqrtf(q2) * 1.01f + 1e-3f) * kmax; }
    }
    const int NSS = qb + 1;
    volatile LAS unsigned* vote = (volatile LAS unsigned*)(lds + LDS_BYTES - 64);
    if (tid < 3) vote[tid] = 0u;
    bf16x8 kreg[2], vreg[2]; float creg = 0.f;
#define ATT_LOAD(S) do { const size_t kb_ = rb + (size_t)(S) * 128; \
        _Pragma("unroll") for (int p_ = 0; p_ < 2; ++p_) { const int id_ = tid + 512 * p_; \
            kreg[p_] = *(const bf16x8*)(z + (kb_ + (id_ >> 3)) * ZW + ZC_K + h * 64 + (id_ & 7) * 8); \
            vreg[p_] = *(const bf16x8*)(z + (kb_ + (id_ >> 3)) * ZW + ZC_V + h * 64 + (id_ & 7) * 8); } \
        if (tid < 128) creg = cs[(kb_ + tid) * 4 + h]; } while (0)
#define ATT_STORE(S) do { LAS unsigned char* bb_ = lb + ((S) & 1) * (2 * ABUF); \
        _Pragma("unroll") for (int p_ = 0; p_ < 2; ++p_) { const int id_ = tid + 512 * p_; const int k128_ = id_ >> 3; \
            *(LAS bf16x8*)((LAS bf16_t*)(bb_ + (k128_ >> 6) * ABUF) + (k128_ & 63) * 72 + (id_ & 7) * 8) = kreg[p_]; \
            *(LAS bf16x8*)((LAS bf16_t*)(bb_ + (k128_ >> 6) * ABUF + 9216) + (k128_ & 63) * 72 + (id_ & 7) * 8) = vreg[p_]; } \
        if (tid < 128) ((LAS float*)(bb_ + (tid >> 6) * ABUF + 18432))[tid & 63] = -creg; } while (0)
    ATT_LOAD(NSS - 1); ATT_STORE(NSS - 1);
    if (NSS > 1) ATT_LOAD(NSS - 2);
    __syncthreads();
    int kstep = 0;
    for (int S = NSS - 1; S >= 0; --S) {
        if (S >= 1) ATT_STORE(S - 1);
        if (S >= 2) ATT_LOAD(S - 2);
        float cl = 0.f; if (S >= 1) cl = cs[(rb + (size_t)(S - 1) * 128 + 127) * 4 + h];
        const int kbase = S * 128 + grp * 64;
        const LAS unsigned char* hb = lb + (S & 1) * (2 * ABUF) + grp * ABUF;
        if (S + 1 < NSS) attn_step2<false>(hb, kbase, qrow0, quad, fr, qf, m, lsum, oacc);
        else if (kbase <= qw + 31) attn_step2<true>(hb, kbase, qrow0, quad, fr, qf, m, lsum, oacc);
        const bool need = (S >= 1) && ((qbnd[0] - cl - m[0] >= -160.f) || (qbnd[1] - cl - m[1] >= -160.f));
        const int vw = kstep % 3;
        if (need) vote[vw] = 1u;
        __syncthreads();
        const unsigned go = vote[vw];
        if (tid == 0) vote[(kstep + 2) % 3] = 0u;
        ++kstep;
        if (!go) break;
    }
#undef ATT_LOAD
#undef ATT_STORE
    LAS float* mg = (LAS float*)lb;
    const int ml = wq * 64 + lane;
    if (grp == 1) {
#pragma unroll
        for (int qs = 0; qs < 2; ++qs) { mg[(qs * 18 + 0) * 256 + ml] = m[qs]; mg[(qs * 18 + 1) * 256 + ml] = lsum[qs];
#pragma unroll
            for (int dt = 0; dt < 4; ++dt)
#pragma unroll
                for (int r = 0; r < 4; ++r) mg[(qs * 18 + 2 + dt * 4 + r) * 256 + ml] = oacc[qs][dt][r]; }
    }
    __syncthreads();
    if (grp == 0) {
#pragma unroll
        for (int qs = 0; qs < 2; ++qs) {
            const float m1 = mg[(qs * 18 + 0) * 256 + ml], l1 = mg[(qs * 18 + 1) * 256 + ml];
            const float mt = fmaxf(m[qs], m1), f0 = __builtin_amdgcn_exp2f(m[qs] - mt), f1 = __builtin_amdgcn_exp2f(m1 - mt);
            float lt = quad_sum(lsum[qs] * f0 + l1 * f1);
            const float inv = 1.0f / lt; float ss = 0.f;
            const size_t tq = rb + qrow0 + qs * 16;
#pragma unroll
            for (int dt = 0; dt < 4; ++dt) { f32x4 o;
#pragma unroll
                for (int r = 0; r < 4; ++r) { o[r] = (oacc[qs][dt][r] * f0 + mg[(qs * 18 + 2 + dt * 4 + r) * 256 + ml] * f1) * inv; ss += o[r] * o[r]; }
                u32x2 w; w.x = pk2(o[0], o[1]); w.y = pk2(o[2], o[3]); *(u32x2*)(y + tq * DM + YC_D + h * 64 + dt * 16 + quad * 4) = w; }
            ss = quad_sum(ss);
            if (quad == 0) ssd[tq * 4 + h] = ss;
        }
    }
    __syncthreads();
}

#define XB_TMO      128
#define XB_XCNT(j)  (256  + 64 * (j))
#define XB_XSUB(j)  (1280 + 64 * (j))
#define XB_XGEN(j)  (2304 + 64 * (j))
#define XB_TOP      3328
#define XB_TOPGEN   3392
#define XCD_BAR_WORDS 3456
#define XB_SPIN_CAP (1u << 18)

__device__ __forceinline__ unsigned xb_ld(unsigned* p)              { return __hip_atomic_load(p, __ATOMIC_RELAXED, __HIP_MEMORY_SCOPE_AGENT); }
__device__ __forceinline__ unsigned xb_add(unsigned* p, unsigned v) { return __hip_atomic_fetch_add(p, v, __ATOMIC_RELAXED, __HIP_MEMORY_SCOPE_AGENT); }
__device__ __forceinline__ unsigned xb_xcc_id() { return (unsigned)__builtin_amdgcn_s_getreg((3 << 11) | 20) & 0xFu; }
#define XB_SPIN(cond, bar) do { unsigned _sp = 0; while (cond) { __builtin_amdgcn_s_sleep(1); \
    if ((++_sp & 255u) == 0u) { if (xb_ld(&(bar)[XB_TMO])) break; if (_sp > XB_SPIN_CAP) { atomicAdd(&(bar)[XB_TMO], 1u); break; } } } } while (0)

struct XcdBarrier {
    unsigned* bar; unsigned x;
    volatile LAS unsigned* st;
};

__device__ __forceinline__ XcdBarrier xcd_barrier_post(unsigned* bar, volatile LAS unsigned* st) {
    XcdBarrier b; b.bar = bar; b.x = xb_xcc_id(); b.st = st;
    if (opaque_tid() == 0) (void)xb_add(&bar[XB_XCNT(b.x)], 1u);
    return b;
}
__device__ __forceinline__ void xcd_barrier_complete(unsigned* bar, unsigned x, unsigned& nloc, unsigned& nx) {
    const unsigned G = gridDim.x * gridDim.y * gridDim.z;
    unsigned sum, cnt, mine, sp = 0u;
    for (;;) {
        sum = 0u; cnt = 0u; mine = 0u;
#pragma unroll
        for (unsigned j = 0; j < 16; ++j) { const unsigned c = xb_ld(&bar[XB_XCNT(j)]); sum += c; cnt += (c > 0u) ? 1u : 0u; mine = (j == x) ? c : mine; }
        if (sum == G) break;
        __builtin_amdgcn_s_sleep(1);
        if ((++sp & 255u) == 0u) { if (xb_ld(&bar[XB_TMO])) break; if (sp > XB_SPIN_CAP) { atomicAdd(&bar[XB_TMO], 1u); break; } }
    }
    nloc = mine > 0u ? mine : 1u; nx = cnt > 0u ? cnt : 1u;
}

__device__ __forceinline__ void xcd_barrier(const XcdBarrier& b) {
    asm volatile("s_waitcnt vmcnt(0)" ::: "memory");
    __syncthreads();
    if (opaque_tid() == 0) {
        unsigned* bar = b.bar;
        __builtin_amdgcn_s_waitcnt(0);
        unsigned nloc = b.st[0], nx = b.st[1];
        if (nloc == 0u) { xcd_barrier_complete(bar, b.x, nloc, nx); b.st[0] = nloc; b.st[1] = nx; }
        const unsigned old = xb_add(&bar[XB_XSUB(b.x)], 1u);
        const unsigned gen = old / nloc;
        if (old + 1u == (gen + 1u) * nloc) {
            __builtin_amdgcn_fence(__ATOMIC_RELEASE, "agent");
            asm volatile("s_waitcnt vmcnt(0)" ::: "memory");
            const unsigned og = xb_add(&bar[XB_TOP], 1u);
            const unsigned tg = og / nx;
            if (og + 1u == (tg + 1u) * nx) xb_add(&bar[XB_TOPGEN], 1u);
            else XB_SPIN(xb_ld(&bar[XB_TOPGEN]) == tg, bar);
            __builtin_amdgcn_fence(__ATOMIC_ACQUIRE, "agent");
            xb_add(&bar[XB_XGEN(b.x)], 1u);
            asm volatile("s_waitcnt vmcnt(0)" ::: "memory");
        } else {
            XB_SPIN(xb_ld(&bar[XB_XGEN(b.x)]) == gen, bar);
            __builtin_amdgcn_fence(__ATOMIC_ACQUIRE, "agent");
            asm volatile("s_waitcnt vmcnt(0)" ::: "memory");
        }
    }
    __syncthreads();
}

#ifndef WGM_G1
#define WGM_G1 2
#endif
#ifndef WGM_G2
#define WGM_G2 4
#endif
#ifndef WGM_G3
#define WGM_G3 4
#endif
#ifndef WGM_G4
#define WGM_G4 8
#endif
#ifndef PROBE_DUP
#define PROBE_DUP 0
#endif
#ifndef ITEM_MASK
#define ITEM_MASK 127
#endif
__global__ void __launch_bounds__(NTHR, 2) fwd_kernel(Args a) {
    extern __shared__ __attribute__((aligned(16))) unsigned char lds[];
    {
        volatile LAS unsigned* bst0 = (volatile LAS unsigned*)(lds + LDS_BYTES - 16);
        if (opaque_tid() == 0) { bst0[0] = 0u; bst0[1] = 0u; }
        __syncthreads();
        (void)xcd_barrier_post((unsigned*)(ws_() + WS_BAR), bst0);
    }
    if (PH_HI > 4096) cg::this_grid().sync();
#define SEAM(k) do { if ((k) + 1 < PH_HI) { XcdBarrier xb_; xb_.bar = (unsigned*)(ws_() + WS_BAR); xb_.x = xb_xcc_id(); xb_.st = (volatile LAS unsigned*)(lds + LDS_BYTES - 16); xcd_barrier(xb_); if (PROBE_DUP == 1) xcd_barrier(xb_); } } while (0)
#define IN(k) (PH_LO <= (k) && (k) < PH_HI)
    if (IN(0)) { prep_phase(a, lds); if (PROBE_DUP == 4) prep_phase(a, lds); SEAM(0); }
    for (int l = 0; l < DEPTH; ++l) {
        const int pb = 1 + 8 * l;
        if (l == 0 && IN(pb + 0)) {
            norm_phase<false, 1>(INP(0), nullptr, (bf16_t*)(ws_() + WS_H), (float*)(ws_() + WS_SS2), nullptr, (const float*)(ws_() + WS_WF), INP(23), (float*)(ws_() + WS_LOGF));
            SEAM(pb + 0);
        }
        if (IN(pb + 1)) {
            pg8::Gemm g{(const pg8::bf16_t*)(ws_() + WS_H), (const pg8::bf16_t*)(ws_() + WS_WIN) + (size_t)l * ZW * DM, T, ZW, DM}; pg8::StaticOrder S; S.init(T, ZW, grid_(), bid_(), WGM_G1);
            EpiStoreBf16<0, true> E{(bf16_t*)(ws_() + WS_Z), ZW, (const float*)(ws_() + WS_SS2)};
            pg8::gemm_phase<EpiStoreBf16<0, true>, pg8::StaticOrder, true, true>((PG8_LAS unsigned char*)lds, g, S, E);
            if (PROBE_DUP == 9) pg8::gemm_phase<EpiStoreBf16<0, true>, pg8::StaticOrder, true, true>((PG8_LAS unsigned char*)lds, g, S, E);
            if (l > 0) norm_phase<true, 1>(ws_() + WS_H, nullptr, nullptr, nullptr, nullptr, (const float*)(ws_() + WS_WF) + (size_t)l * DM * 4, INP(23) + l * 4, (float*)(ws_() + WS_LOGF));
            SEAM(pb + 1);
        }
        if (IN(pb + 2)) {
            for (int rep = 0; rep < (PROBE_DUP == 2 ? 2 : 1); ++rep)
            for (int it = bid_(); it < 260; it += grid_()) {
                if (it < 128) { if (ITEM_MASK & 1) s5_item<1>(l, it >> 5, it & 31, a, lds); }
                else if (it < 256) { if (ITEM_MASK & 4) lru_item<1>(l, (it - 128) >> 5, (it - 128) & 31, a, lds); }
                else { if (ITEM_MASK & 8) cumsum_item(it - 256, (const float*)(ws_() + WS_LOGF), (float*)(ws_() + WS_CS), lds); }
            }
            SEAM(pb + 2);
        }
        if (IN(pb + 3)) {
            for (int rep = 0; rep < (PROBE_DUP == 3 ? 2 : 1); ++rep) {
            for (int rep2 = 0; rep2 < (PROBE_DUP == 5 ? 2 : 1); ++rep2)
            for (int up = bid_(); up < 256; up += grid_()) {
                const int xcd_ = up & 7, ix_ = up >> 3, pr = xcd_ + 8 * (ix_ >> 4), j = ix_ & 15;
                if (ITEM_MASK & 16) { attn_unit(pr >> 2, pr & 3, 31 - j, a, lds);
                attn_unit(pr >> 2, pr & 3, j, a, lds); }
            }
            for (int rep3 = 0; rep3 < (PROBE_DUP == 6 ? 2 : 1); ++rep3)
            for (int it = bid_(); it < 256; it += grid_()) {
                if (it < 128) { if (ITEM_MASK & 32) s5_item<2>(l, it >> 5, it & 31, a, lds); }
                else { if (ITEM_MASK & 64) lru_item<2>(l, (it - 128) >> 5, (it - 128) & 31, a, lds); }
            }
            if (ITEM_MASK & 2) {
                unsigned* qctr = (unsigned*)(ws_() + WS_BAR) + 3600 + l;
                volatile LAS unsigned* qslot = (volatile LAS unsigned*)(lds + LDS_BYTES - 48);
                for (;;) {
                    __syncthreads();
                    if (opaque_tid() == 0) qslot[0] = __hip_atomic_fetch_add(qctr, 1u, __ATOMIC_RELAXED, __HIP_MEMORY_SCOPE_AGENT);
                    __syncthreads();
                    const unsigned qi = qslot[0];
                    if (qi >= 256u) break;
                    if (qi < 128u) sgu_item<1>(l, (int)(qi >> 5), (int)(qi & 31), a, lds);
                    else sgu_item<0>(l, (int)((qi - 128u) >> 5), (int)(qi & 31), a, lds);
                }
            }
            }
            SEAM(pb + 3);
        }
        if (IN(pb + 4)) {
            pg8::Gemm g{(const pg8::bf16_t*)(ws_() + WS_Y), (const pg8::bf16_t*)(ws_() + WS_WOUT) + (size_t)l * DM * DM, T, DM, DM}; pg8::StaticOrder S; S.init(T, DM, grid_(), bid_(), WGM_G2);
            EpiRes<true, true> E{(bf16_t*)(ws_() + WS_H), DM, (const float*)(ws_() + WS_SSD), (float*)(ws_() + WS_SS2)};
            pg8::gemm_phase<EpiRes<true, true>, pg8::StaticOrder, true, true>((PG8_LAS unsigned char*)lds, g, S, E);
            SEAM(pb + 4);
        }
        if (IN(pb + 6)) {
            pg8::Gemm g{(const pg8::bf16_t*)(ws_() + WS_H), (const pg8::bf16_t*)(ws_() + WS_WMI) + (size_t)l * DFF * DM, T, DFF, DM}; pg8::StaticOrder S; S.init(T, DFF, grid_(), bid_(), WGM_G3);
            EpiStoreBf16<1, true> E{(bf16_t*)(ws_() + WS_ACT), DFF, (const float*)(ws_() + WS_SS2)};
            pg8::gemm_phase<EpiStoreBf16<1, true>, pg8::StaticOrder, true, true>((PG8_LAS unsigned char*)lds, g, S, E);
            SEAM(pb + 6);
        }
        if (IN(pb + 7)) {
            pg8::Gemm g{(const pg8::bf16_t*)(ws_() + WS_ACT), (const pg8::bf16_t*)(ws_() + WS_WMO) + (size_t)l * DM * DFF, T, DM, DFF}; pg8::StaticOrder S; S.init(T, DM, grid_(), bid_(), WGM_G4);
            EpiRes<false, true> E{(bf16_t*)(ws_() + WS_H), DM, nullptr, (float*)(ws_() + WS_SS2)};
            pg8::gemm_phase<EpiRes<false, true>, pg8::StaticOrder, true, true>((PG8_LAS unsigned char*)lds, g, S, E);
            SEAM(pb + 7);
        }
    }
    if (IN(33)) norm_phase<true, 2>(ws_() + WS_H, INP(29), nullptr, nullptr, out_(), nullptr, nullptr, nullptr);
#undef SEAM
#undef IN
}


#ifndef DUMP_SEL
#define DUMP_SEL 0
#endif
#ifndef DUMP_LAST
#define DUMP_LAST 33
#endif
__global__ void dump_kernel(const unsigned char* ws, float* out) {
    const size_t i = (size_t)blockIdx.x * blockDim.x + threadIdx.x;
    const size_t t = i >> 10, c = i & 1023;
    float v = 0.f;
    if (DUMP_SEL == 1) v = bf2f(((const bf16_t*)(ws + WS_H))[i]);
    if (DUMP_SEL == 2) v = bf2f(((const bf16_t*)(ws + WS_Z))[t * ZW + c]) + bf2f(((const bf16_t*)(ws + WS_Z))[t * ZW + c + 1024]);
    if (DUMP_SEL == 3) v = bf2f(((const bf16_t*)(ws + WS_Y))[i]);
    if (DUMP_SEL == 5) v = ((const float*)(ws + WS_SSD))[(t * 4 + (c & 3))] + ((const float*)(ws + WS_CS))[(t * 4 + (c & 3))];
    if (DUMP_SEL == 7) v = ((const float*)(ws + WS_ELOC))[i & 262143];
    if (DUMP_SEL == 8) v = ((const float*)(ws + WS_LA))[i & 32767] + ((const float*)(ws + WS_LB))[i & 32767];
    if (DUMP_SEL == 6) v = bf2f(((const bf16_t*)(ws + WS_WIN))[i]) + bf2f(((const bf16_t*)(ws + WS_WMI))[i]) + bf2f(((const bf16_t*)(ws + WS_WMO))[i]) + bf2f(((const bf16_t*)(ws + WS_WOUT))[i & 0x3fffff]);
    out[i] = v;
}
#ifndef N_LAUNCH_MODE
#define N_LAUNCH_MODE 1
#endif
extern "C" void kernel_launch(void* const* d_in, const int* in_sizes, int n_in, void* d_out, int out_size, void* d_ws, size_t ws_size, hipStream_t stream) {
    static int grid = 0;
    if (grid == 0) {
        if (n_in != 30 || out_size != T * DM || ws_size < WS_END) { fprintf(stderr, "kernel_launch: unexpected shapes (n_in %d, out %d, ws %zu, need %zu)\n", n_in, out_size, ws_size, (size_t)WS_END); grid = -1; return; }
        int dev = 0, cus = 0, per_cu = 0;
        hipGetDevice(&dev); hipDeviceGetAttribute(&cus, hipDeviceAttributeMultiprocessorCount, dev);
        if (hipFuncSetAttribute((const void*)fwd_kernel, hipFuncAttributeMaxDynamicSharedMemorySize, LDS_BYTES) != hipSuccess) { fprintf(stderr, "kernel_launch: hipFuncSetAttribute failed\n"); grid = -1; return; }
        if (hipOccupancyMaxActiveBlocksPerMultiprocessor(&per_cu, (const void*)fwd_kernel, NTHR, LDS_BYTES) != hipSuccess || per_cu < 1) { fprintf(stderr, "kernel_launch: occupancy query says %d\n", per_cu); per_cu = 1; }
        (void)hipGetLastError();
        grid = cus;
        if (grid > 256) grid = 256;
    }
    if (grid < 0) return;
    Args a{};
    for (int i = 0; i < 30; ++i) a.in[i] = (const float*)d_in[i];
    a.out = (float*)d_out; a.ws = (unsigned char*)d_ws;
    if (N_LAUNCH_MODE == 1) {
        a.ph_lo = 0; a.ph_hi = 34;
        if (hipMemsetAsync((unsigned char*)d_ws + WS_BAR, 0, 16 * 1024, stream) != hipSuccess) { fprintf(stderr, "kernel_launch: memset of the barrier words failed\n"); return; }
        void* args[] = {&a};
        hipError_t e = hipLaunchCooperativeKernel((const void*)fwd_kernel, dim3(grid), dim3(NTHR), args, LDS_BYTES, stream);
        if (e != hipSuccess) fprintf(stderr, "kernel_launch: cooperative launch failed: %s (grid %d)\n", hipGetErrorString(e), grid);
    } else {
        for (int ph = 0; ph <= DUMP_LAST; ++ph) { a.ph_lo = ph; a.ph_hi = ph + 1; hipLaunchKernelGGL(fwd_kernel, dim3(grid), dim3(NTHR), LDS_BYTES, stream, a); }
        if (DUMP_SEL != 0 && DUMP_SEL != 4) hipLaunchKernelGGL(dump_kernel, dim3(T * DM / 256), dim3(256), 0, stream, (const unsigned char*)d_ws, (float*)d_out);
    }
}
```

```cpp
#include <hip/hip_runtime.h>
#include <hip/hip_cooperative_groups.h>
#include <cstdio>
#include <cstdint>
namespace cg = cooperative_groups;
__device__ __forceinline__ int opaque_tid() { int t = __builtin_amdgcn_workitem_id_x(); asm volatile("" : "+v"(t)); return t; }
namespace pg8 {
#define PG8_LAS __attribute__((address_space(3)))
typedef unsigned short bf16_t;
typedef short bf16x8 __attribute__((ext_vector_type(8)));
typedef float f32x4 __attribute__((ext_vector_type(4)));
typedef unsigned u32x4 __attribute__((ext_vector_type(4)));
constexpr int BM = 256, BK = 64, HALF = 128, HTB = HALF * BK * 2  , STAGE_BYTES = 8 * HTB, NXCD = 8, WGM = 4;

__host__ __device__ __forceinline__ int lds_byte(int r, int c) { const int st = (r >> 4) * 2 + (c >> 5), rr = r & 15, cc = c & 31, ob = rr * 64 + cc * 2; return st * 1024 + (ob ^ (((ob >> 9) & 1) << 5)); }
__host__ __device__ __forceinline__ void stage_rc(int b, int& R, int& C) { const int st = b / 1024, sb = b % 1024, swz = sb ^ (((sb >> 9) & 1) << 5); R = (st >> 1) * 16 + swz / 64; C = (st & 1) * 32 + (swz % 64) / 2; }
__host__ __device__ __forceinline__ int perm32(int rho) { const int n = rho >> 4, i = rho & 15; return 8 * (i >> 2) + 4 * n + (i & 3); }

struct Unit { int pm, pn; };
struct Gemm { const bf16_t* A; const bf16_t* Bt; int M, N, K; };

struct StaticOrder {
    int nM, nN, nwg, G, c, wgm;
    __host__ __device__ void init(int M, int N, int G_, int c_, int wgm_ = WGM) { nM = M / BM; nN = N / BM; nwg = nM * nN; G = G_; c = c_; wgm = wgm_; }
    __host__ __device__ bool next(int i, Unit& u) const {
        const long L = (long)i * G + c; if (L >= nwg) return false;
        int wgid = (int)L; { const int q = nwg / NXCD, r = nwg % NXCD, xcd = wgid % NXCD, off = wgid / NXCD; wgid = (xcd < r ? xcd * (q + 1) : r * (q + 1) + (xcd - r) * q) + off; }
        const int nig = wgm * nN, gid = wgid / nig, fm = gid * wgm, gsz = (nM - fm) < wgm ? (nM - fm) : wgm;
        u.pm = fm + ((wgid % nig) % gsz); u.pn = (wgid % nig) / gsz; return true;
    }
    __device__ __forceinline__ void a_ready(const Unit&) const {}
    __device__ __forceinline__ void done(const Unit&) const {}
};

__device__ __forceinline__ unsigned cvt_pk_bf16(float lo, float hi) { unsigned r; asm volatile("v_cvt_pk_bf16_f32 %0, %1, %2" : "=v"(r) : "v"(lo), "v"(hi)); return r; }
template <class Epi, class Sched, bool ALIGN_EPI = false, bool SP2 = false>
__device__ __forceinline__ void gemm_phase(PG8_LAS unsigned char* lds, const Gemm g, const Sched& S, const Epi& E) {
    const int tid = opaque_tid(), wid = __builtin_amdgcn_readfirstlane(tid >> 6), lane = tid & 63, wr = wid >> 2, wc = wid & 3, fr = lane & 15, fq = lane >> 4;
    const int K = g.K, nt = K / BK;
    unsigned voffA[2], voffB[2];
#pragma unroll
    for (int i = 0; i < 2; ++i) { int R, C; stage_rc(tid * 16 + i * 8192, R, C); const int Rb = Epi::PERM ? ((R & ~31) + perm32(R & 31)) : R;
        voffA[i] = (unsigned)(R * K + C) * 2u; voffB[i] = (unsigned)(Rb * K + C) * 2u; }
    const size_t kstep = (size_t)(BK * 2);
    const size_t hstep = (size_t)HALF * K * 2;
    const size_t tstep = 2 * hstep;
    const unsigned ldsw = (unsigned)wid * 1024u;
    const int aoff = lds_byte(wr * 64 + fr, fq * 8), boff = lds_byte(wc * 32 + fr, fq * 8);
#define PG8_SA(b, h) (((b) * 2 + (h)) * HTB)
#define PG8_SB(b, h) ((4 + (b) * 2 + (h)) * HTB)
#define PG8_STAGE(bufoff, gbase, voff) do { _Pragma("unroll") for (int _i = 0; _i < 2; ++_i) \
        __builtin_amdgcn_global_load_lds((const unsigned*)((const char*)(gbase) + (voff)[_i]), (PG8_LAS unsigned*)(lds + (bufoff) + ldsw + _i * 8192), 16, 0, 0); } while (0)
#define PG8_LDA(dst, b, h) do { _Pragma("unroll") for (int m = 0; m < 4; ++m) _Pragma("unroll") for (int k = 0; k < 2; ++k) dst[m][k] = *(const PG8_LAS bf16x8*)(lds + PG8_SA(b, h) + aoff + m * 2048 + k * 1024); } while (0)
#define PG8_LDB(dst, b, h) do { _Pragma("unroll") for (int n = 0; n < 2; ++n) _Pragma("unroll") for (int k = 0; k < 2; ++k) dst[n][k] = *(const PG8_LAS bf16x8*)(lds + PG8_SB(b, h) + boff + n * 2048 + k * 1024); } while (0)
#define PG8_MMA(ai, bj, At, Bt) do { __builtin_amdgcn_s_setprio(1); _Pragma("unroll") for (int m = 0; m < 4; ++m) _Pragma("unroll") for (int n = 0; n < 2; ++n) _Pragma("unroll") for (int k = 0; k < 2; ++k) \
        acc[ai][bj][m][n] = __builtin_amdgcn_mfma_f32_16x16x32_bf16(Bt[n][k], At[m][k], acc[ai][bj][m][n], 0, 0, 0); __builtin_amdgcn_s_setprio(0); } while (0)
#define PG8_WAIT_V(n) asm volatile("s_waitcnt vmcnt(" #n ")" ::: "memory")
#define PG8_WAIT_L(n) asm volatile("s_waitcnt lgkmcnt(" #n ")" ::: "memory")
#define PG8_BAR __builtin_amdgcn_s_barrier()
#define PG8_SCHED __builtin_amdgcn_sched_barrier(0)
    Unit cur, nxt; int ui = 0;
    if (!S.next(0, cur)) return;
    if constexpr (Epi::KPREP) { Unit pu; for (int i = 0; i < 12 && S.next(i, pu); ++i) E.kprep(pu, lds + STAGE_BYTES + i * 1024, tid); }
    f32x4 acc[2][2][4][2];
#pragma unroll
    for (int a = 0; a < 2; ++a)
#pragma unroll
        for (int b = 0; b < 2; ++b)
#pragma unroll
            for (int m = 0; m < 4; ++m)
#pragma unroll
                for (int n = 0; n < 2; ++n) acc[a][b][m][n] = (f32x4){0.f, 0.f, 0.f, 0.f};
    bf16x8 At[4][2], B0[2][2], B1[2][2];
    const char* cA = (const char*)g.A + (size_t)cur.pm * tstep; const char* cB = (const char*)g.Bt + (size_t)cur.pn * tstep;
    S.a_ready(cur);
    if constexpr (SP2) {
        PG8_STAGE(PG8_SB(0, 0), cB, voffB); PG8_STAGE(PG8_SB(0, 1), cB + hstep, voffB); PG8_STAGE(PG8_SA(0, 0), cA, voffA); PG8_STAGE(PG8_SA(0, 1), cA + hstep, voffA);
        if (wr == 1) PG8_BAR;
        PG8_WAIT_V(2); PG8_BAR;
        PG8_STAGE(PG8_SB(1, 0), cB + kstep, voffB); PG8_STAGE(PG8_SA(1, 0), cA + kstep, voffA); PG8_STAGE(PG8_SB(1, 1), cB + hstep + kstep, voffB);
        PG8_WAIT_V(6); PG8_BAR;
    } else {
        PG8_STAGE(PG8_SB(0, 0), cB, voffB); PG8_STAGE(PG8_SA(0, 0), cA, voffA); PG8_STAGE(PG8_SB(0, 1), cB + hstep, voffB); PG8_STAGE(PG8_SA(0, 1), cA + hstep, voffA);
        if (wr == 1) PG8_BAR;
        PG8_WAIT_V(4); PG8_BAR;
        PG8_STAGE(PG8_SB(1, 0), cB + kstep, voffB); PG8_STAGE(PG8_SA(1, 0), cA + kstep, voffA); PG8_STAGE(PG8_SB(1, 1), cB + hstep + kstep, voffB);
        PG8_WAIT_V(6); PG8_BAR;
    }
    for (;;) {
        const bool has_next = S.next(ui + 1, nxt);
        const char* nA = has_next ? (const char*)g.A + (size_t)nxt.pm * tstep : cA; const char* nB = has_next ? (const char*)g.Bt + (size_t)nxt.pn * tstep : cB;
        for (int t = 0; t < nt; t += 2) {
            const bool last = (t == nt - 2);
            const char* a1 = cA + (size_t)(t + 1) * kstep;
            const char* a2 = last ? nA : cA + (size_t)(t + 2) * kstep; const char* b2 = last ? nB : cB + (size_t)(t + 2) * kstep;
            const char* a3 = a2 + kstep; const char* b3 = b2 + kstep;
            if (last && has_next) S.a_ready(nxt);
            if constexpr (SP2) {
            PG8_LDB(B0, 0, 0); PG8_LDB(B1, 0, 1); PG8_SCHED; PG8_LDA(At, 0, 0); PG8_STAGE(PG8_SA(1, 1), a1 + hstep, voffA);
            PG8_WAIT_V(8); PG8_WAIT_L(0); PG8_BAR; PG8_MMA(0, 0, At, B0); PG8_MMA(0, 1, At, B1); PG8_BAR; PG8_SCHED;
            PG8_LDA(At, 0, 1); PG8_STAGE(PG8_SB(0, 0), b2, voffB); PG8_STAGE(PG8_SB(0, 1), b2 + hstep, voffB); PG8_STAGE(PG8_SA(0, 0), a2, voffA);
            PG8_WAIT_V(8); PG8_WAIT_L(0); PG8_BAR; PG8_MMA(1, 0, At, B0); PG8_MMA(1, 1, At, B1); PG8_BAR; PG8_SCHED;
            PG8_LDB(B0, 1, 0); PG8_LDB(B1, 1, 1); PG8_SCHED; PG8_LDA(At, 1, 0); PG8_STAGE(PG8_SA(0, 1), a2 + hstep, voffA);
            PG8_WAIT_V(8); PG8_WAIT_L(0); PG8_BAR; PG8_MMA(0, 0, At, B0); PG8_MMA(0, 1, At, B1); PG8_BAR; PG8_SCHED;
            PG8_LDA(At, 1, 1); PG8_STAGE(PG8_SB(1, 0), b3, voffB); PG8_STAGE(PG8_SB(1, 1), b3 + hstep, voffB); PG8_STAGE(PG8_SA(1, 0), a3, voffA);
            PG8_WAIT_V(8); PG8_WAIT_L(0); PG8_BAR; PG8_MMA(1, 0, At, B0); PG8_MMA(1, 1, At, B1); PG8_BAR; PG8_SCHED;
            } else {
            PG8_LDB(B0, 0, 0); PG8_SCHED; PG8_LDA(At, 0, 0); PG8_STAGE(PG8_SA(1, 1), a1 + hstep, voffA);
            PG8_WAIT_L(8); PG8_BAR; PG8_WAIT_L(0); PG8_MMA(0, 0, At, B0); PG8_BAR; PG8_SCHED;
            PG8_LDB(B1, 0, 1); PG8_STAGE(PG8_SB(0, 0), b2, voffB);
            PG8_BAR; PG8_WAIT_L(0); PG8_MMA(0, 1, At, B1); PG8_BAR;
            PG8_LDA(At, 0, 1); PG8_STAGE(PG8_SA(0, 0), a2, voffA);
            PG8_BAR; PG8_WAIT_L(0); PG8_MMA(1, 0, At, B0); PG8_BAR; PG8_SCHED;
            PG8_STAGE(PG8_SB(0, 1), b2 + hstep, voffB);
            PG8_WAIT_V(6); PG8_BAR; PG8_MMA(1, 1, At, B1); PG8_BAR;
            PG8_LDB(B0, 1, 0); PG8_SCHED; PG8_LDA(At, 1, 0); PG8_STAGE(PG8_SA(0, 1), a2 + hstep, voffA);
            PG8_WAIT_L(8); PG8_BAR; PG8_WAIT_L(0); PG8_MMA(0, 0, At, B0); PG8_BAR; PG8_SCHED;
            PG8_LDB(B1, 1, 1); PG8_STAGE(PG8_SB(1, 0), b3, voffB);
            PG8_BAR; PG8_WAIT_L(0); PG8_MMA(0, 1, At, B1); PG8_BAR;
            PG8_LDA(At, 1, 1); PG8_STAGE(PG8_SA(1, 0), a3, voffA);
            PG8_BAR; PG8_WAIT_L(0); PG8_MMA(1, 0, At, B0); PG8_BAR; PG8_SCHED;
            PG8_STAGE(PG8_SB(1, 1), b3 + hstep, voffB);
            PG8_WAIT_V(6); PG8_BAR; PG8_MMA(1, 1, At, B1); PG8_BAR;
            }
            if constexpr (Epi::KHOOK) { if (t == 2) E.khook(acc, lds + STAGE_BYTES + ui * 1024, wr, fr); }
        }
        if constexpr (ALIGN_EPI) { if (wr == 0) PG8_BAR; }
        if constexpr (!Epi::AFTER_DRAIN) { E(acc, cur, wr, wc, fr, fq, lds + STAGE_BYTES + ui * 1024); S.done(cur); }
        if (!has_next) break;
#pragma unroll
        for (int a = 0; a < 2; ++a)
#pragma unroll
            for (int b = 0; b < 2; ++b)
#pragma unroll
                for (int m = 0; m < 4; ++m)
#pragma unroll
                    for (int n = 0; n < 2; ++n) acc[a][b][m][n] = (f32x4){0.f, 0.f, 0.f, 0.f};
        cur = nxt; cA = nA; cB = nB; ++ui;
        if constexpr (ALIGN_EPI) { if (wr == 1) PG8_BAR; }
    }
    PG8_WAIT_V(0);
    if constexpr (!ALIGN_EPI) { if (wr == 0) PG8_BAR; }
    PG8_BAR;
    if constexpr (Epi::AFTER_DRAIN) { E.fused(acc, cur, wr, wc, fr, fq, lds, wid, lane); S.done(cur); }
#undef PG8_SA
#undef PG8_SB
#undef PG8_STAGE
#undef PG8_LDA
#undef PG8_LDB
#undef PG8_MMA
#undef PG8_WAIT_V
#undef PG8_WAIT_L
#undef PG8_BAR
#undef PG8_SCHED
}
}

#define LAS __attribute__((address_space(3)))
typedef unsigned short bf16_t;
typedef short bf16x8 __attribute__((ext_vector_type(8)));
typedef short bf16x4 __attribute__((ext_vector_type(4)));
typedef float f32x4 __attribute__((ext_vector_type(4)));
typedef float f32x2 __attribute__((ext_vector_type(2)));
typedef unsigned u32x4 __attribute__((ext_vector_type(4)));
typedef unsigned u32x2 __attribute__((ext_vector_type(2)));
typedef short v4i16_t __attribute__((ext_vector_type(4)));

constexpr int NB = 4, SEQ = 4096, DM = 1024, DEPTH = 4, T = NB * SEQ, W = 256, DFF = 4096, NIN = 2052, ZW = 2048;
constexpr int NCH = SEQ / 128;
constexpr float EPS = 1e-6f;
constexpr float LOG2E = 1.4426950408889634f;
constexpr int NTHR = 512;
constexpr int LDS_BYTES = 147456;
constexpr int ZC_AU = 0, ZC_AV = 256, ZC_B = 512, ZC_CX = 768, ZC_CG = 1024, ZC_Q = 1280, ZC_K = 1536, ZC_V = 1792;
constexpr int YC_D = 0, YC_A = 256, YC_B = 512, YC_C = 768;

constexpr size_t MiB = 1u << 20;
constexpr size_t WS_WIN = 0, WS_WOUT = 16 * MiB, WS_WMI = 24 * MiB, WS_WMO = 56 * MiB, WS_R = 88 * MiB, WS_Z = WS_R, WS_Y = WS_R + 64 * MiB, WS_ACT = WS_R,
                 WS_H = 216 * MiB, WS_S = 248 * MiB;
constexpr size_t WS_GLUT = WS_S, WS_WAT = WS_GLUT + 512 * 1024, WS_WXT = WS_WAT + 128 * 1024, WS_BBT = WS_WXT + 128 * 1024, WS_CMT = WS_BBT + 256 * 1024,
                 WS_ABAR = WS_CMT + 256 * 1024, WS_A128 = WS_ABAR + 32 * 1024, WS_WF = WS_A128 + 32 * 1024, WS_LOGF = WS_WF + 64 * 1024, WS_CS = WS_LOGF + 256 * 1024,
                 WS_SSD = WS_CS + 256 * 1024, WS_ELOC = WS_SSD + 256 * 1024, WS_LA = WS_ELOC + 1024 * 1024, WS_LB = WS_LA + 128 * 1024, WS_BAR = WS_LB + 128 * 1024, WS_SS2 = WS_BAR + 16 * 1024, WS_KMAX = WS_SS2 + 1024 * 1024, WS_END = WS_KMAX + 4096;

struct Args {
    const float* in[30]; float* out; unsigned char* ws; int ph_lo, ph_hi;
};


typedef const __attribute__((address_space(4))) unsigned long long* kargp_t;
__device__ __forceinline__ unsigned long long karg_(int i) { kargp_t tab = (kargp_t)__builtin_amdgcn_kernarg_segment_ptr(); asm volatile("" : "+s"(tab)); return tab[i]; }
#define INP(i) ((const float*)karg_(i))
__device__ __forceinline__ unsigned char* ws_() { return (unsigned char*)karg_(31); }
__device__ __forceinline__ float* out_() { return (float*)karg_(30); }
#define PH_LO ((int)(unsigned)(karg_(32) & 0xffffffffull))
#define PH_HI ((int)(unsigned)(karg_(32) >> 32))
__device__ __forceinline__ int bid_() { return blockIdx.x; }
__device__ __forceinline__ int grid_() { return gridDim.x; }
__device__ __forceinline__ float bf2f(bf16_t v) { return __uint_as_float((unsigned)v << 16); }
__device__ __forceinline__ float bfs2f(short v) { return __uint_as_float(((unsigned)(unsigned short)v) << 16); }
typedef __bf16 bf16x2_t __attribute__((ext_vector_type(2)));
__device__ __forceinline__ unsigned pk2(float lo, float hi) { const f32x2 v = {lo, hi}; const bf16x2_t b = __builtin_convertvector(v, bf16x2_t); return __builtin_bit_cast(unsigned, b); }
__device__ __forceinline__ bf16_t f2bf(float f) { return (bf16_t)(pk2(f, 0.f) & 0xffffu); }
__device__ __forceinline__ float gelu_t(float x) { const float y2 = (1.5957691216057308f * LOG2E) * (x + 0.044715f * x * x * x); return x * __builtin_amdgcn_rcpf(1.0f + __builtin_amdgcn_exp2f(-y2)); }
__device__ __forceinline__ float sigm(float x) { return __builtin_amdgcn_rcpf(1.0f + __builtin_amdgcn_exp2f(-LOG2E * x)); }
__device__ __forceinline__ float softplus_f(float x) { return fmaxf(x, 0.f) + log1pf(__expf(-fabsf(x))); }
__device__ __forceinline__ f32x4 mfma16(bf16x8 a, bf16x8 b, f32x4 c) { return __builtin_amdgcn_mfma_f32_16x16x32_bf16(a, b, c, 0, 0, 0); }
__device__ __forceinline__ float quad_sum(float v) {
    { const auto r = __builtin_amdgcn_permlane16_swap(__float_as_uint(v), __float_as_uint(v), false, false); v = __uint_as_float(r[0]) + __uint_as_float(r[1]); }
    { const auto r = __builtin_amdgcn_permlane32_swap(__float_as_uint(v), __float_as_uint(v), false, false); v = __uint_as_float(r[0]) + __uint_as_float(r[1]); }
    return v;
}
template <int CTRL> __device__ __forceinline__ float dpp_mov(float x) { return __uint_as_float((unsigned)__builtin_amdgcn_update_dpp(0, (int)__float_as_uint(x), CTRL, 0xf, 0xf, true)); }
__device__ __forceinline__ float wave_sum(float v) {
    v += dpp_mov<0xB1>(v); v += dpp_mov<0x4E>(v); v += dpp_mov<0x141>(v); v += dpp_mov<0x140>(v);
    return quad_sum(v);
}
__device__ __forceinline__ float wave_max(float v);
__device__ __forceinline__ float quad_max(float v) {
    { const auto r = __builtin_amdgcn_permlane16_swap(__float_as_uint(v), __float_as_uint(v), false, false); v = fmaxf(__uint_as_float(r[0]), __uint_as_float(r[1])); }
    { const auto r = __builtin_amdgcn_permlane32_swap(__float_as_uint(v), __float_as_uint(v), false, false); v = fmaxf(__uint_as_float(r[0]), __uint_as_float(r[1])); }
    return v;
}
__device__ __forceinline__ bf16x8 pack8(const float* v) {
    u32x4 w; w.x = pk2(v[0], v[1]); w.y = pk2(v[2], v[3]); w.z = pk2(v[4], v[5]); w.w = pk2(v[6], v[7]); return __builtin_bit_cast(bf16x8, w);
}
__device__ __forceinline__ bf16x8 zero8() { return (bf16x8){0, 0, 0, 0, 0, 0, 0, 0}; }

__device__ __forceinline__ float wave_max(float v) {
    v = fmaxf(v, dpp_mov<0xB1>(v)); v = fmaxf(v, dpp_mov<0x4E>(v)); v = fmaxf(v, dpp_mov<0x141>(v)); v = fmaxf(v, dpp_mov<0x140>(v));
    return quad_max(v);
}
template <int N> __device__ __forceinline__ float dpp_shr(float x, float ident) {
    return __uint_as_float((unsigned)__builtin_amdgcn_update_dpp((int)__float_as_uint(ident), (int)__float_as_uint(x), 0x110 + N, 0xf, 0xf, false));
}
__device__ __forceinline__ float neg_expm1(float x) {
    const float s = -x * (1.0f + x * (0.5f + x * (0.16666667f + x * (0.041666668f + x * (0.0083333338f + x * 0.0013888889f)))));
    const float e = 1.0f - __builtin_amdgcn_exp2f(LOG2E * x);
    return (x > -0.25f) ? s : e;
}
template <int ACT  , bool ROWS = false> struct EpiStoreBf16 {
    static constexpr bool PERM = true, AFTER_DRAIN = false, KHOOK = false, KPREP = ROWS;
    __device__ __forceinline__ void kprep(const pg8::Unit& u, PG8_LAS unsigned char* tab, int tid) const {
        if (tid < 256) { const float* rp = rowss + (size_t)(u.pm * 256 + tid) * 16; const f32x4 s0 = *(const f32x4*)rp, s1 = *(const f32x4*)(rp + 4), s2 = *(const f32x4*)(rp + 8), s3 = *(const f32x4*)(rp + 12);
            const float tot = ((s0[0] + s0[1]) + (s0[2] + s0[3])) + ((s1[0] + s1[1]) + (s1[2] + s1[3])) + ((s2[0] + s2[1]) + (s2[2] + s2[3])) + ((s3[0] + s3[1]) + (s3[2] + s3[3]));
            ((PG8_LAS float*)tab)[tid] = rsqrtf(tot * (1.0f / DM) + EPS); }
    }
    bf16_t* O; int ldc; const float* rowss;
    __device__ __forceinline__ void operator()(const pg8::f32x4 (&acc)[2][2][4][2], const pg8::Unit& u, int wr, int wc, int fr, int fq, PG8_LAS unsigned char* tab) const {
        const int row0 = u.pm * 256 + wr * 64 + fr, col0 = u.pn * 256 + wc * 32 + 8 * fq;
#pragma unroll
        for (int ai = 0; ai < 2; ++ai)
#pragma unroll
            for (int m = 0; m < 4; ++m) { bf16_t* rowp = O + (size_t)(row0 + ai * 128 + m * 16) * ldc + col0;
                const float rsc = ROWS ? ((const PG8_LAS float*)tab)[wr * 64 + fr + ai * 128 + m * 16] : 1.0f;
#pragma unroll
                for (int bj = 0; bj < 2; ++bj) { pg8::f32x4 v0 = acc[ai][bj][m][0] * rsc, v1 = acc[ai][bj][m][1] * rsc;
                    if (ACT == 1) {
#pragma unroll
                        for (int e = 0; e < 4; ++e) { const float a = fmaxf(v0[e], 0.f), b = fmaxf(v1[e], 0.f); v0[e] = a * a; v1[e] = b * b; } }
                    u32x4 w; w.x = pk2(v0[0], v0[1]); w.y = pk2(v0[2], v0[3]); w.z = pk2(v1[0], v1[1]); w.w = pk2(v1[2], v1[3]);
                    *(u32x4*)(rowp + bj * 128) = w; } }
    }
};
template <bool HOOK, bool NORMOUT> struct EpiRes {
    static constexpr bool PERM = true, AFTER_DRAIN = false, KHOOK = HOOK, KPREP = HOOK;
    bf16_t* xb; int ldc; const float* ssd; float* ss2;
    __device__ __forceinline__ void operator()(const pg8::f32x4 (&acc)[2][2][4][2], const pg8::Unit& u, int wr, int wc, int fr, int fq, PG8_LAS unsigned char* tab) const {
        const int col0 = u.pn * 256 + wc * 32 + 8 * fq;
#pragma unroll
        for (int ai = 0; ai < 2; ++ai)
#pragma unroll
            for (int m = 0; m < 4; ++m) { const int row = u.pm * 256 + ai * 128 + wr * 64 + m * 16 + fr; bf16_t* rowp = xb + (size_t)row * ldc + col0; float sq = 0.f;
#pragma unroll
                for (int bj = 0; bj < 2; ++bj) { const bf16x8 s = *(const bf16x8*)(rowp + bj * 128); float o[8];
#pragma unroll
                    for (int e = 0; e < 4; ++e) { o[e] = bfs2f(s[e]) + acc[ai][bj][m][0][e]; o[4 + e] = bfs2f(s[4 + e]) + acc[ai][bj][m][1][e]; }
                    if (NORMOUT) {
#pragma unroll
                        for (int e = 0; e < 8; ++e) sq += o[e] * o[e]; }
                    *(bf16x8*)(rowp + bj * 128) = pack8(o); }
                if (NORMOUT) { sq = quad_sum(sq); if (fq == 0) ss2[(size_t)row * 16 + u.pn * 4 + wc] = sq; }
                if (m & 1) asm volatile("" ::: "memory"); }
    }
    __device__ __forceinline__ void kprep(const pg8::Unit& u, PG8_LAS unsigned char* tab, int tid) const {
        if (tid < 256) { const f32x4 s4 = *(const f32x4*)(ssd + (size_t)(u.pm * 256 + tid) * 4); ((PG8_LAS float*)tab)[tid] = rsqrtf((s4[0] + s4[1] + s4[2] + s4[3]) * (1.0f / 256.0f) + EPS); }
    }
    __device__ __forceinline__ void khook(pg8::f32x4 (&acc)[2][2][4][2], PG8_LAS unsigned char* tab, int wr, int fr) const {
#pragma unroll
        for (int ai = 0; ai < 2; ++ai)
#pragma unroll
            for (int m = 0; m < 4; ++m) { const float rs = ((const PG8_LAS float*)tab)[ai * 128 + wr * 64 + m * 16 + fr];
#pragma unroll
                for (int bj = 0; bj < 2; ++bj)
#pragma unroll
                    for (int n = 0; n < 2; ++n) acc[ai][bj][m][n] *= rs; }
    }
};

template <int TN> __device__ __forceinline__ void tc_job(unsigned char* lds, const float* src, size_t sb, int ld, int K, int N, int nbatch, bf16_t* dst, const float* gain, int kshift, int rot) {
    LAS float* tile = (LAS float*)lds;
    constexpr int CG = TN / 64, NLD = TN / 32  , NST = TN / 64  ;
    const int tid = opaque_tid(), nk = K / 64, nn = N / TN, ntile = nbatch * nk * nn;
    for (int ti = (int)((bid_() + grid_() - (rot % grid_())) % grid_()); ti < ntile; ti += grid_()) {
        const int b = ti / (nk * nn), rem = ti % (nk * nn), kt = rem / nn, nt = rem % nn;
        const float* s = src + (size_t)b * sb + (size_t)(kt * 64) * ld + nt * TN;
        f32x4 v[NLD];
#pragma unroll
        for (int p = 0; p < NLD; ++p) { const int idx = tid + 512 * p, c16 = idx & 15, kq = (idx >> 4) & 3, rest = idx >> 6, kl = (rest / CG) * 4 + kq, n4 = ((rest % CG) * 16 + c16) * 4;
            v[p] = *(const f32x4*)(s + (size_t)kl * ld + n4);
            if (gain) { const float gg = gain[(size_t)b * K + kt * 64 + kl]; v[p] = v[p] * gg; } }
        __syncthreads();
#pragma unroll
        for (int p = 0; p < NLD; ++p) { const int idx = tid + 512 * p, c16 = idx & 15, kq = (idx >> 4) & 3, rest = idx >> 6, kl = (rest / CG) * 4 + kq, n4 = ((rest % CG) * 16 + c16) * 4;
            tile[kl * (TN + 1) + n4 + 0] = v[p][0]; tile[kl * (TN + 1) + n4 + 1] = v[p][1]; tile[kl * (TN + 1) + n4 + 2] = v[p][2]; tile[kl * (TN + 1) + n4 + 3] = v[p][3]; }
        __syncthreads();
#pragma unroll
        for (int p = 0; p < NST; ++p) { const int idx = tid + 512 * p, nl = idx >> 3, kc = (idx & 7) * 8; float o[8];
#pragma unroll
            for (int e = 0; e < 8; ++e) o[e] = tile[(kc + e) * (TN + 1) + nl];
            const int kd = (kt * 64 + kc + kshift) % K;
            *(bf16x8*)(dst + (size_t)b * N * K + (size_t)(nt * TN + nl) * K + kd) = pack8(o); }
    }
    __syncthreads();
}

__device__ __forceinline__ void prep_phase(const Args& a, unsigned char* lds) {
    unsigned char* ws = ws_();
    tc_job<256>(lds, INP(2), (size_t)DM * NIN, NIN, DM, ZW, DEPTH, (bf16_t*)(ws + WS_WIN), INP(1), 0, 0);
    tc_job<256>(lds, INP(25), (size_t)DM * DM, DM, DM, DM, DEPTH, (bf16_t*)(ws + WS_WOUT), INP(24), 256, 0);
    tc_job<256>(lds, INP(27), (size_t)DM * DFF, DFF, DM, DFF, DEPTH, (bf16_t*)(ws + WS_WMI), INP(26), 0, 0);
    tc_job<256>(lds, INP(28), (size_t)DFF * DM, DM, DFF, DM, DEPTH, (bf16_t*)(ws + WS_WMO), nullptr, 0, 0);
    tc_job<256>(lds, INP(14), (size_t)W * W, W, W, W, DEPTH, (bf16_t*)(ws + WS_GLUT), nullptr, 0, 0);
    tc_job<64>(lds, INP(18), (size_t)64 * 64, 64, 64, 64, DEPTH * 4, (bf16_t*)(ws + WS_WAT), nullptr, 0, 64);
    tc_job<64>(lds, INP(20), (size_t)64 * 64, 64, 64, 64, DEPTH * 4, (bf16_t*)(ws + WS_WXT), nullptr, 0, 96);
    const int gid = bid_() * NTHR + opaque_tid();
    if (gid < DEPTH * 1024) {
        const int l = gid >> 10, gp = gid & 1023, g = gp >> 6, p = gp & 63;
        const float lre = INP(6)[gid], lim = INP(7)[gid], dt = expf(INP(8)[l * 16 + g]);
        const float mag = expf(lre * dt), are = mag * cosf(lim * dt), aim = mag * sinf(lim * dt);
        const float den = lre * lre + lim * lim, nre = are - 1.0f, nim = aim;
        const float fre = (nre * lre + nim * lim) / den, fim = (nim * lre - nre * lim) / den;
        ((f32x2*)(ws + WS_ABAR))[gid] = (f32x2){are, aim};
        float pr = are, pi = aim;
#pragma unroll
        for (int s = 0; s < 7; ++s) { const float nr = pr * pr - pi * pi, ni = 2.0f * pr * pi; pr = nr; pi = ni; }
        ((f32x2*)(ws + WS_A128))[gid] = (f32x2){pr, pi};
        const float* bre = INP(9) + (size_t)gid * 16; const float* bim = INP(10) + (size_t)gid * 16;
        bf16_t* bbt = (bf16_t*)(ws + WS_BBT) + ((size_t)(l * 16 + g) * 128 + 2 * p) * 16;
#pragma unroll
        for (int h = 0; h < 16; ++h) { const float br = bre[h], bi = bim[h]; bbt[h] = f2bf(fre * br - fim * bi); bbt[16 + h] = f2bf(fre * bi + fim * br); }
        bf16_t* cmt = (bf16_t*)(ws + WS_CMT) + (size_t)(l * 16 + g) * 16 * 128;
#pragma unroll
        for (int h = 0; h < 16; ++h) { const size_t ci = ((size_t)(l * 16 + g) * 16 + h) * 64 + p; ((unsigned*)cmt)[(h * 128 + 2 * p) >> 1] = pk2(INP(11)[ci], -INP(12)[ci]); }
        const float* wr = INP(2) + ((size_t)l * DM + gp) * NIN + ZW;
        ((f32x4*)(ws + WS_WF))[gid] = *(const f32x4*)wr * INP(1)[gid];
    }
}

template <bool SRCB, int MODE> __device__ __forceinline__ void norm_phase(const void* xsv, const float* g, bf16_t* xb, float* ss2, float* od, const float* wf, const float* bfg, float* logf) {
    const int lane = opaque_tid() & 63, wid = opaque_tid() >> 6;
    const int gw = bid_() * 8 + wid, nw = grid_() * 8;
    for (int row = gw; row < T; row += nw) {
        f32x4 v[4]; float ss = 0.f;
#pragma unroll
        for (int i = 0; i < 4; ++i) {
            if (SRCB) { const bf16x4 q = *(const bf16x4*)((const bf16_t*)xsv + (size_t)row * DM + i * 256 + lane * 4); v[i] = (f32x4){bfs2f(q[0]), bfs2f(q[1]), bfs2f(q[2]), bfs2f(q[3])}; }
            else { v[i] = *(const f32x4*)((const float*)xsv + (size_t)row * DM + i * 256 + lane * 4);
                if (MODE == 1) { u32x2 w; w.x = pk2(v[i][0], v[i][1]); w.y = pk2(v[i][2], v[i][3]); *(u32x2*)(xb + (size_t)row * DM + i * 256 + lane * 4) = w; } }
            ss += v[i][0] * v[i][0] + v[i][1] * v[i][1] + v[i][2] * v[i][2] + v[i][3] * v[i][3]; }
        ss = wave_sum(ss);
        const float rs = rsqrtf(ss * (1.0f / DM) + EPS);
        if (MODE == 1 && !SRCB) { if (lane < 16) ss2[(size_t)row * 16 + lane] = (lane == 0) ? ss : 0.f; }
        float f0 = 0.f, f1 = 0.f, f2 = 0.f, f3 = 0.f;
#pragma unroll
        for (int i = 0; i < 4; ++i) {
            if (MODE == 2) { const f32x4 gg = *(const f32x4*)(g + i * 256 + lane * 4); *(f32x4*)(od + (size_t)row * DM + i * 256 + lane * 4) = v[i] * rs * gg; }
            if (MODE == 1) {
#pragma unroll
                for (int e = 0; e < 4; ++e) { const f32x4 w4 = *(const f32x4*)(wf + (size_t)(i * 256 + lane * 4 + e) * 4); const float hv = v[i][e] * rs; f0 += hv * w4[0]; f1 += hv * w4[1]; f2 += hv * w4[2]; f3 += hv * w4[3]; } }
        }
        if (MODE == 1) {
            f0 = wave_sum(f0); f1 = wave_sum(f1); f2 = wave_sum(f2); f3 = wave_sum(f3);
            if (lane == 0) { f32x4 o; const float fv[4] = {f0 + bfg[0], f1 + bfg[1], f2 + bfg[2], f3 + bfg[3]};
#pragma unroll
                for (int e = 0; e < 4; ++e) o[e] = fminf(fv[e], 0.f) - log1pf(__expf(-fabsf(fv[e])));
                *(f32x4*)(logf + (size_t)row * 4) = o; }
        }
    }
}

__device__ __forceinline__ void cumsum_item(int b, const float* logf, float* cs, unsigned char* lds) {
    LAS float* wt = (LAS float*)lds;
    const int tid = opaque_tid(), lane = tid & 63, wid = tid >> 6;
    f32x4 v[8]; f32x4 run = (f32x4){0.f, 0.f, 0.f, 0.f};
    const float* src = logf + ((size_t)b * SEQ + (size_t)tid * 8) * 4;
#pragma unroll
    for (int e = 0; e < 8; ++e) { run = run + *(const f32x4*)(src + e * 4); v[e] = run; }
    f32x4 inc = run;
#pragma unroll
    for (int d = 1; d < 64; d <<= 1) {
        const int sl = ((lane >= d) ? lane - d : lane) << 2; f32x4 o;
#pragma unroll
        for (int e = 0; e < 4; ++e) o[e] = __uint_as_float((unsigned)__builtin_amdgcn_ds_bpermute(sl, (int)__float_as_uint(inc[e])));
        if (lane >= d) inc = inc + o;
    }
    __syncthreads();
    if (lane == 63) { wt[wid * 4 + 0] = inc[0]; wt[wid * 4 + 1] = inc[1]; wt[wid * 4 + 2] = inc[2]; wt[wid * 4 + 3] = inc[3]; }
    __syncthreads();
    f32x4 off = inc - run;
    for (int w2 = 0; w2 < wid; ++w2) { off[0] += wt[w2 * 4 + 0]; off[1] += wt[w2 * 4 + 1]; off[2] += wt[w2 * 4 + 2]; off[3] += wt[w2 * 4 + 3]; }
    float* dst = cs + ((size_t)b * SEQ + (size_t)tid * 8) * 4;
#pragma unroll
    for (int e = 0; e < 8; ++e) *(f32x4*)(dst + e * 4) = (v[e] + off) * LOG2E;
    __syncthreads();
}

template <int HALF> __device__ __forceinline__ void sgu_item(int l, int b, int c, const Args& a, unsigned char* lds) {
    const bf16_t* z = (const bf16_t*)(ws_() + WS_Z); bf16_t* y = (bf16_t*)(ws_() + WS_Y);
    LAS bf16_t* vn = (LAS bf16_t*)lds;
    LAS float* ssb = (LAS float*)(lds + 69632);
    const int tid = opaque_tid(), lane = tid & 63, wid = tid >> 6, fr = lane & 15, quad = lane >> 4;
    const size_t t0 = (size_t)b * SEQ + (size_t)c * 128;
    const float* ng = INP(3) + l * W;
    __syncthreads();
    const f32x4 gch = *(const f32x4*)(ng + lane * 4);
    constexpr int TPW = HALF ? 16 : 8;
#pragma unroll
    for (int i = 0; i < TPW; ++i) {
        const int s = wid * TPW + i;
        const bf16x4 zv = *(const bf16x4*)(z + (t0 + s) * ZW + ZC_AV + lane * 4);
        float gv[4]; float ss = 0.f;
#pragma unroll
        for (int e = 0; e < 4; ++e) { gv[e] = gelu_t(bfs2f(zv[e])); ss += gv[e] * gv[e]; }
        ss = wave_sum(ss); const float rs = rsqrtf(ss * (1.0f / W) + EPS);
        u32x2 w; w.x = pk2(gv[0] * rs * gch[0], gv[1] * rs * gch[1]); w.y = pk2(gv[2] * rs * gch[2], gv[3] * rs * gch[3]);
        *(LAS u32x2*)(vn + s * 264 + lane * 4) = w;
    }
    __syncthreads();
    const int h = wid & 3;
    const float* wsrc = INP(4) + ((size_t)(l * 4 + h) * 128) * 128;
    const float* bsrc = INP(5) + (size_t)(l * 4 + h) * 128;
    float outv[2][4][4];
#pragma unroll
    for (int i = 0; i < 2; ++i) {
        const int mt = HALF * 4 + (wid >> 2) + 2 * i, t = mt * 16 + fr;
        f32x4 acc[4];
#pragma unroll
        for (int nt = 0; nt < 4; ++nt) acc[nt] = (f32x4){0.f, 0.f, 0.f, 0.f};
        f32x4 wl[4][2];
#pragma unroll
        for (int kk = 0; kk < 4; ++kk) { const int k0 = (kk * 32 < (mt + 1) * 16) ? kk * 32 : 0; const float* wp = wsrc + (size_t)t * 128 + k0 + quad * 8; wl[kk][0] = *(const f32x4*)wp; wl[kk][1] = *(const f32x4*)(wp + 4); }
#pragma unroll
        for (int kk = 0; kk < 4; ++kk) {
            const int k0 = kk * 32;
            if (k0 < (mt + 1) * 16) {
                float wv[8] = {wl[kk][0][0], wl[kk][0][1], wl[kk][0][2], wl[kk][0][3], wl[kk][1][0], wl[kk][1][1], wl[kk][1][2], wl[kk][1][3]};
#pragma unroll
                for (int e = 0; e < 8; ++e) if (k0 + quad * 8 + e > t) wv[e] = 0.f;
                const bf16x8 wf = pack8(wv);
#pragma unroll
                for (int nt = 0; nt < 4; ++nt) {
                    LAS bf16_t* tp = vn + (k0 + quad * 8 + (fr >> 2)) * 264 + h * 64 + nt * 16 + (fr & 3) * 4;
                    const bf16x4 lo = __builtin_bit_cast(bf16x4, __builtin_amdgcn_ds_read_tr16_b64_v4i16((LAS v4i16_t*)tp));
                    const bf16x4 hi = __builtin_bit_cast(bf16x4, __builtin_amdgcn_ds_read_tr16_b64_v4i16((LAS v4i16_t*)(tp + 4 * 264)));
                    const bf16x8 vf = (bf16x8){lo[0], lo[1], lo[2], lo[3], hi[0], hi[1], hi[2], hi[3]};
                    acc[nt] = mfma16(vf, wf, acc[nt]); }
            }
        }
        const float bs = bsrc[t]; float ss = 0.f;
#pragma unroll
        for (int nt = 0; nt < 4; ++nt) { const int ch = h * 64 + nt * 16 + quad * 4; const bf16x4 u4 = *(const bf16x4*)(z + (t0 + t) * ZW + ZC_AU + ch);
#pragma unroll
            for (int r = 0; r < 4; ++r) { const float o = gelu_t(bfs2f(u4[r])) * (acc[nt][r] + bs); outv[i][nt][r] = o; ss += o * o; } }
        ss = quad_sum(ss);
        if (quad == 0) ssb[t * 4 + h] = ss;
    }
    __syncthreads();
#pragma unroll
    for (int i = 0; i < 2; ++i) {
        const int mt = HALF * 4 + (wid >> 2) + 2 * i, t = mt * 16 + fr;
        const float rs = rsqrtf((ssb[t * 4 + 0] + ssb[t * 4 + 1] + ssb[t * 4 + 2] + ssb[t * 4 + 3]) * (1.0f / W) + EPS);
#pragma unroll
        for (int nt = 0; nt < 4; ++nt) { const int ch = h * 64 + nt * 16 + quad * 4; u32x2 w; w.x = pk2(outv[i][nt][0] * rs, outv[i][nt][1] * rs); w.y = pk2(outv[i][nt][2] * rs, outv[i][nt][3] * rs);
            *(u32x2*)(y + (t0 + t) * DM + YC_A + ch) = w; }
    }
    __syncthreads();
}

template <int PASS> __device__ __forceinline__ void s5_item(int l, int b, int c, const Args& a, unsigned char* lds) {
    const bf16_t* z = (const bf16_t*)(ws_() + WS_Z); bf16_t* y = (bf16_t*)(ws_() + WS_Y);
    LAS unsigned char* BU = (LAS unsigned char*)lds;
    LAS unsigned* BU32 = (LAS unsigned*)lds;
    LAS bf16_t* Yb = (LAS bf16_t*)(lds + 65792);
    LAS float* ssb = (LAS float*)(lds + 65792 + 67584);
    const int tid = opaque_tid(), lane = tid & 63, wid = tid >> 6, fr = lane & 15, quad = lane >> 4;
    const int sx0 = wid * 128 + lane, sx1 = sx0 + 64;
    const size_t t0 = (size_t)b * SEQ + (size_t)c * 128;
    const f32x2* abar = (const f32x2*)(ws_() + WS_ABAR) + l * 1024;
    f32x2* eloc = (f32x2*)(ws_() + WS_ELOC);
    float ar[2], ai[2], sre[2], sim[2];
#pragma unroll
    for (int q = 0; q < 2; ++q) { const f32x2 ab = abar[q ? sx1 : sx0]; ar[q] = ab[0]; ai[q] = ab[1]; sre[q] = 0.f; sim[q] = 0.f; }
    if (PASS == 2) {
        const f32x2* a128 = (const f32x2*)(ws_() + WS_A128) + l * 1024;
        const f32x2 p0 = a128[sx0], p1 = a128[sx1];
        for (int cc0 = 0; cc0 < c; cc0 += 8) {
            f32x2 e0[8], e1[8];
#pragma unroll
            for (int u = 0; u < 8; ++u) { const int cc = (cc0 + u < c) ? cc0 + u : c - 1; e0[u] = eloc[((size_t)(b * NCH + cc)) * 1024 + sx0]; e1[u] = eloc[((size_t)(b * NCH + cc)) * 1024 + sx1]; }
#pragma unroll
            for (int u = 0; u < 8; ++u) if (cc0 + u < c) {
                const float nr0 = p0[0] * sre[0] - p0[1] * sim[0] + e0[u][0], ni0 = p0[0] * sim[0] + p0[1] * sre[0] + e0[u][1]; sre[0] = nr0; sim[0] = ni0;
                const float nr1 = p1[0] * sre[1] - p1[1] * sim[1] + e1[u][0], ni1 = p1[0] * sim[1] + p1[1] * sre[1] + e1[u][1]; sre[1] = nr1; sim[1] = ni1; }
        }
    }
    bf16x8 bfrag[2][8];
    const bf16_t* bbt = (const bf16_t*)(ws_() + WS_BBT);
#pragma unroll
    for (int gi = 0; gi < 2; ++gi)
#pragma unroll
        for (int j = 0; j < 8; ++j) bfrag[gi][j] = (quad < 2) ? *(const bf16x8*)(bbt + ((size_t)(l * 16 + wid * 2 + gi) * 128 + j * 16 + fr) * 16 + quad * 8) : zero8();
    bf16x8 cfrag[2][4];
    if (PASS == 2) {
        const bf16_t* cmt = (const bf16_t*)(ws_() + WS_CMT);
#pragma unroll
        for (int gi = 0; gi < 2; ++gi)
#pragma unroll
            for (int ks = 0; ks < 4; ++ks) cfrag[gi][ks] = *(const bf16x8*)(cmt + ((size_t)(l * 16 + wid * 2 + gi) * 16 + fr) * 128 + ks * 32 + quad * 8);
    }
    const float* dsk = INP(13) + l * W;
    __syncthreads();
    bf16x8 ufn[2];
#pragma unroll
    for (int gi = 0; gi < 2; ++gi) ufn[gi] = (quad < 2) ? *(const bf16x8*)(z + (t0 + fr) * ZW + ZC_B + (wid * 2 + gi) * 16 + quad * 8) : zero8();
    for (int sc = 0; sc < 8; ++sc) {
        const size_t tr = t0 + sc * 16 + fr;
        bf16x8 ufc[2] = {ufn[0], ufn[1]};
        bf16x4 u4c[2] = {(bf16x4){0, 0, 0, 0}, (bf16x4){0, 0, 0, 0}};
        if (PASS == 2) {
#pragma unroll
            for (int gi = 0; gi < 2; ++gi) u4c[gi] = *(const bf16x4*)(z + tr * ZW + ZC_B + (wid * 2 + gi) * 16 + quad * 4);
        }
        if (sc < 7) {
#pragma unroll
            for (int gi = 0; gi < 2; ++gi) ufn[gi] = (quad < 2) ? *(const bf16x8*)(z + (tr + 16) * ZW + ZC_B + (wid * 2 + gi) * 16 + quad * 8) : zero8();
        }
#pragma unroll
        for (int gi = 0; gi < 2; ++gi) {
            const int g = wid * 2 + gi;
            const bf16x8 uf = ufc[gi];
#pragma unroll
            for (int j = 0; j < 8; ++j) {
                const f32x4 acc = mfma16(bfrag[gi][j], uf, (f32x4){0.f, 0.f, 0.f, 0.f});
                u32x2 w; w.x = pk2(acc[0], acc[1]); w.y = pk2(acc[2], acc[3]);
                *(LAS u32x2*)(BU + fr * 4112 + (g * 64 + j * 8 + quad * 2) * 4) = w;
            }
        }
        asm volatile("s_waitcnt lgkmcnt(0)" ::: "memory");
        {
            unsigned wv[16][2];
#pragma unroll
            for (int tt = 0; tt < 16; ++tt) { wv[tt][0] = BU32[tt * 1028 + sx0]; wv[tt][1] = BU32[tt * 1028 + sx1]; }
#pragma unroll
            for (int tt = 0; tt < 16; ++tt) {
#pragma unroll
                for (int q = 0; q < 2; ++q) {
                    const unsigned w = wv[tt][q];
                    const f32x2 bu2 = {__uint_as_float(w << 16), __uint_as_float(w & 0xffff0000u)};
                    const f32x2 s2 = {sre[q], sim[q]}, sw = {sim[q], sre[q]}, arr = {ar[q], ar[q]}, aii = {-ai[q], ai[q]};
                    const f32x2 n2 = aii * sw + (arr * s2 + bu2);
                    sre[q] = n2[0]; sim[q] = n2[1];
                    if (PASS == 2) wv[tt][q] = pk2(n2[0], n2[1]);
                }
            }
            if (PASS == 2) {
#pragma unroll
                for (int tt = 0; tt < 16; ++tt) { BU32[tt * 1028 + sx0] = wv[tt][0]; BU32[tt * 1028 + sx1] = wv[tt][1]; }
            }
        }
        asm volatile("s_waitcnt lgkmcnt(0)" ::: "memory");
        if (PASS == 2) {
#pragma unroll
            for (int gi = 0; gi < 2; ++gi) {
                const int g = wid * 2 + gi; f32x4 acc = (f32x4){0.f, 0.f, 0.f, 0.f};
#pragma unroll
                for (int ks = 0; ks < 4; ++ks) { const bf16x8 sf = *(const LAS bf16x8*)(BU + fr * 4112 + g * 256 + (ks * 32 + quad * 8) * 2); acc = mfma16(cfrag[gi][ks], sf, acc); }
                const int ch = g * 16 + quad * 4; const bf16x4 u4 = u4c[gi]; const f32x4 d4 = *(const f32x4*)(dsk + ch);
                float o[4];
#pragma unroll
                for (int r = 0; r < 4; ++r) o[r] = gelu_t(acc[r] + d4[r] * bfs2f(u4[r]));
                u32x2 w; w.x = pk2(o[0], o[1]); w.y = pk2(o[2], o[3]);
                *(LAS u32x2*)(Yb + (sc * 16 + fr) * 264 + ch) = w;
            }
        }
    }
    if (PASS == 1) {
#pragma unroll
        for (int q = 0; q < 2; ++q) eloc[((size_t)(b * NCH + c)) * 1024 + (q ? sx1 : sx0)] = (f32x2){sre[q], sim[q]};
        {
            LAS float* kq = (LAS float*)(lds + 65792);
            const int tok = tid >> 2, hd = tid & 3; float s2 = 0.f;
#pragma unroll
            for (int j = 0; j < 8; ++j) { const bf16x8 kv = *(const bf16x8*)(z + (t0 + tok) * ZW + ZC_K + hd * 64 + j * 8);
#pragma unroll
                for (int e = 0; e < 8; ++e) { const float f = bfs2f(kv[e]); s2 += f * f; } }
            kq[tok * 4 + hd] = s2;
            __syncthreads();
            if (tid < 4) { float mxv = 0.f; for (int i = 0; i < 128; ++i) mxv = fmaxf(mxv, kq[i * 4 + tid]); ((float*)(ws_() + WS_KMAX))[(b * NCH + c) * 4 + tid] = mxv; }
        }
    } else {
        __syncthreads();
        const bf16_t* glut = (const bf16_t*)(ws_() + WS_GLUT) + (size_t)l * W * W;
        const float* glub = INP(15) + l * W;
        bf16x8 gfrag[2][8];
#pragma unroll
        for (int ni = 0; ni < 2; ++ni)
#pragma unroll
            for (int ks = 0; ks < 8; ++ks) gfrag[ni][ks] = *(const bf16x8*)(glut + (size_t)((wid * 2 + ni) * 16 + fr) * W + ks * 32 + quad * 8);
        float outv[8][2][4];
#pragma unroll
        for (int mt = 0; mt < 8; ++mt) {
            f32x4 acc0 = (f32x4){0.f, 0.f, 0.f, 0.f}, acc1 = acc0;
#pragma unroll
            for (int ks = 0; ks < 8; ++ks) { const bf16x8 yf = *(const LAS bf16x8*)(Yb + (mt * 16 + fr) * 264 + ks * 32 + quad * 8); acc0 = mfma16(gfrag[0][ks], yf, acc0); acc1 = mfma16(gfrag[1][ks], yf, acc1); }
            float ss = 0.f;
#pragma unroll
            for (int ni = 0; ni < 2; ++ni) { const int n = (wid * 2 + ni) * 16 + quad * 4; const bf16x4 y4 = *(const LAS bf16x4*)(Yb + (mt * 16 + fr) * 264 + n); const f32x4 gb = *(const f32x4*)(glub + n);
#pragma unroll
                for (int r = 0; r < 4; ++r) { const float gt = (ni == 0 ? acc0[r] : acc1[r]) + gb[r]; const float o = bfs2f(y4[r]) * sigm(gt); outv[mt][ni][r] = o; ss += o * o; } }
            ss = quad_sum(ss);
            if (quad == 0) ssb[(mt * 16 + fr) * 8 + wid] = ss;
        }
        __syncthreads();
#pragma unroll
        for (int mt = 0; mt < 8; ++mt) {
            const int t = mt * 16 + fr; float s = 0.f;
#pragma unroll
            for (int w2 = 0; w2 < 8; ++w2) s += ssb[t * 8 + w2];
            const float rs = rsqrtf(s * (1.0f / W) + EPS);
#pragma unroll
            for (int ni = 0; ni < 2; ++ni) { const int n = (wid * 2 + ni) * 16 + quad * 4; u32x2 w; w.x = pk2(outv[mt][ni][0] * rs, outv[mt][ni][1] * rs); w.y = pk2(outv[mt][ni][2] * rs, outv[mt][ni][3] * rs);
                *(u32x2*)(y + (t0 + t) * DM + YC_B + n) = w; }
        }
    }
    __syncthreads();
}

template <int PASS> __device__ __forceinline__ void lru_item(int l, int b, int c, const Args& a, unsigned char* lds) {
    const bf16_t* z = (const bf16_t*)(ws_() + WS_Z); bf16_t* y = (bf16_t*)(ws_() + WS_Y);
    LAS bf16_t* XC = (LAS bf16_t*)lds;
    LAS float* ssb = (LAS float*)(lds + 67584);
    const int tid = opaque_tid(), lane = tid & 63, wid = tid >> 6, fr = lane & 15, quad = lane >> 4;
    const size_t t0 = (size_t)b * SEQ + (size_t)c * 128;
    float* LAp = (float*)(ws_() + WS_LA); float* LBp = (float*)(ws_() + WS_LB);
    __syncthreads();
    {
        const float* cw = INP(16) + (size_t)l * 4 * W; const float* cb = INP(17) + l * W;
#pragma unroll 4
        for (int it = 0; it < 8; ++it) {
            const int p = tid + 512 * it, tok = p >> 5, ch0 = (p & 31) * 8; float acc[8];
            { const f32x4 c0 = *(const f32x4*)(cb + ch0), c1 = *(const f32x4*)(cb + ch0 + 4); acc[0] = c0[0]; acc[1] = c0[1]; acc[2] = c0[2]; acc[3] = c0[3]; acc[4] = c1[0]; acc[5] = c1[1]; acc[6] = c1[2]; acc[7] = c1[3]; }
#pragma unroll
            for (int k = 0; k < 4; ++k) {
                const int tt = tok - 3 + k;
                if (c * 128 + tt >= 0) {
                    const bf16x8 xv = *(const bf16x8*)(z + (size_t)((long)t0 + tt) * ZW + ZC_CX + ch0);
                    const f32x4 w0 = *(const f32x4*)(cw + k * W + ch0), w1 = *(const f32x4*)(cw + k * W + ch0 + 4);
                    acc[0] += w0[0] * bfs2f(xv[0]); acc[1] += w0[1] * bfs2f(xv[1]); acc[2] += w0[2] * bfs2f(xv[2]); acc[3] += w0[3] * bfs2f(xv[3]);
                    acc[4] += w1[0] * bfs2f(xv[4]); acc[5] += w1[1] * bfs2f(xv[5]); acc[6] += w1[2] * bfs2f(xv[6]); acc[7] += w1[3] * bfs2f(xv[7]);
                }
            }
            *(LAS bf16x8*)(XC + tok * 264 + ch0) = pack8(acc);
        }
    }
    __syncthreads();
    const int hh = wid >> 1;
    const bf16_t* wat = (const bf16_t*)(ws_() + WS_WAT) + (size_t)(l * 4 + hh) * 64 * 64;
    const bf16_t* wxt = (const bf16_t*)(ws_() + WS_WXT) + (size_t)(l * 4 + hh) * 64 * 64;
    bf16x8 waf[2][2], wxf[2][2]; float sp8[2][4], bav[2][4], bxv[2][4], H[2][4], Acar[2][4], Bcar[2][4];
#pragma unroll
    for (int ni = 0; ni < 2; ++ni) {
        const int nl = (wid * 2 + ni) * 16 - hh * 64 + fr;
#pragma unroll
        for (int ks = 0; ks < 2; ++ks) { waf[ni][ks] = *(const bf16x8*)(wat + nl * 64 + ks * 32 + quad * 8); wxf[ni][ks] = *(const bf16x8*)(wxt + nl * 64 + ks * 32 + quad * 8); }
#pragma unroll
        for (int r = 0; r < 4; ++r) { const int ch = (wid * 2 + ni) * 16 + quad * 4 + r;
            sp8[ni][r] = 8.0f * softplus_f(-INP(22)[l * W + ch]); bav[ni][r] = INP(19)[l * W + ch]; bxv[ni][r] = INP(21)[l * W + ch];
            H[ni][r] = 0.f; Acar[ni][r] = 1.f; Bcar[ni][r] = 0.f;
        }
    }
    if (PASS == 2 && c > 0) {
#pragma unroll
        for (int ni = 0; ni < 2; ++ni) {
            const size_t ob = (size_t)(b * NCH) * W + (wid * 2 + ni) * 16 + quad * 4;
            const bool v0 = fr < c, v1 = 16 + fr < c;
            f32x4 a0 = (f32x4){1.f, 1.f, 1.f, 1.f}, b0 = (f32x4){0.f, 0.f, 0.f, 0.f}, a1 = a0, b1 = b0;
            if (v0) { a0 = *(const f32x4*)(LAp + ob + (size_t)fr * W); b0 = *(const f32x4*)(LBp + ob + (size_t)fr * W); }
            if (v1) { a1 = *(const f32x4*)(LAp + ob + (size_t)(16 + fr) * W); b1 = *(const f32x4*)(LBp + ob + (size_t)(16 + fr) * W); }
#pragma unroll
            for (int r = 0; r < 4; ++r) {
                float av = a0[r], bb = b0[r], aw = a1[r], bw = b1[r], ap, bp;
                ap = dpp_shr<1>(av, 1.0f); bp = dpp_shr<1>(bb, 0.0f); bb = av * bp + bb; av = av * ap;   ap = dpp_shr<1>(aw, 1.0f); bp = dpp_shr<1>(bw, 0.0f); bw = aw * bp + bw; aw = aw * ap;
                ap = dpp_shr<2>(av, 1.0f); bp = dpp_shr<2>(bb, 0.0f); bb = av * bp + bb; av = av * ap;   ap = dpp_shr<2>(aw, 1.0f); bp = dpp_shr<2>(bw, 0.0f); bw = aw * bp + bw; aw = aw * ap;
                ap = dpp_shr<4>(av, 1.0f); bp = dpp_shr<4>(bb, 0.0f); bb = av * bp + bb; av = av * ap;   ap = dpp_shr<4>(aw, 1.0f); bp = dpp_shr<4>(bw, 0.0f); bw = aw * bp + bw; aw = aw * ap;
                ap = dpp_shr<8>(av, 1.0f); bp = dpp_shr<8>(bb, 0.0f); bb = av * bp + bb; av = av * ap;   ap = dpp_shr<8>(aw, 1.0f); bp = dpp_shr<8>(bw, 0.0f); bw = aw * bp + bw; aw = aw * ap;
                const float B0t = __shfl(bb, 15, 16), A1t = __shfl(aw, 15, 16), B1t = __shfl(bw, 15, 16);
                H[ni][r] = A1t * B0t + B1t;
            }
        }
    }
    LAS bf16_t* Ob = (LAS bf16_t*)(lds + 67584 + 4096);
#pragma unroll 2
    for (int mt = 0; mt < 8; ++mt) {
        bf16x8 xf[2];
#pragma unroll
        for (int ks = 0; ks < 2; ++ks) xf[ks] = *(const LAS bf16x8*)(XC + (mt * 16 + fr) * 264 + hh * 64 + ks * 32 + quad * 8);
        float ss = 0.f;
#pragma unroll
        for (int ni = 0; ni < 2; ++ni) {
            f32x4 accA = (f32x4){0.f, 0.f, 0.f, 0.f}, accX = accA;
#pragma unroll
            for (int ks = 0; ks < 2; ++ks) { accA = mfma16(waf[ni][ks], xf[ks], accA); accX = mfma16(wxf[ni][ks], xf[ks], accX); }
            const int ch0 = (wid * 2 + ni) * 16 + quad * 4;
            const bf16x4 xc4 = *(const LAS bf16x4*)(XC + (mt * 16 + fr) * 264 + ch0);
            bf16x4 g4 = (bf16x4){0, 0, 0, 0};
            if (PASS == 2) g4 = *(const bf16x4*)(z + (t0 + mt * 16 + fr) * ZW + ZC_CG + ch0);
            float ov[4] = {0.f, 0.f, 0.f, 0.f};
#pragma unroll
            for (int r = 0; r < 4; ++r) {
                const float rg = sigm(accA[r] + bav[ni][r]), ig = sigm(accX[r] + bxv[ni][r]);
                const float la = -rg * sp8[ni][r];
                float av = __builtin_amdgcn_exp2f(LOG2E * la), bb = __builtin_amdgcn_sqrtf(fmaxf(neg_expm1(2.0f * la), 0.f)) * (ig * bfs2f(xc4[r]));
                { float ap, bp;
                  ap = dpp_shr<1>(av, 1.0f); bp = dpp_shr<1>(bb, 0.0f); bb = av * bp + bb; av = av * ap;
                  ap = dpp_shr<2>(av, 1.0f); bp = dpp_shr<2>(bb, 0.0f); bb = av * bp + bb; av = av * ap;
                  ap = dpp_shr<4>(av, 1.0f); bp = dpp_shr<4>(bb, 0.0f); bb = av * bp + bb; av = av * ap;
                  ap = dpp_shr<8>(av, 1.0f); bp = dpp_shr<8>(bb, 0.0f); bb = av * bp + bb; av = av * ap; }
                if (PASS == 1) { const float At = __shfl(av, 15, 16), Bt = __shfl(bb, 15, 16); Bcar[ni][r] = At * Bcar[ni][r] + Bt; Acar[ni][r] *= At; }
                else { const float hv = av * H[ni][r] + bb; H[ni][r] = __shfl(hv, 15, 16); const float o = hv * gelu_t(bfs2f(g4[r])); ov[r] = o; ss += o * o; }
            }
            if (PASS == 2) { u32x2 w; w.x = pk2(ov[0], ov[1]); w.y = pk2(ov[2], ov[3]); *(LAS u32x2*)(Ob + (mt * 16 + fr) * 264 + ch0) = w; }
        }
        if (PASS == 2) { ss = quad_sum(ss); if (quad == 0) ssb[(mt * 16 + fr) * 8 + wid] = ss; }
    }
    if (PASS == 1) {
        if (fr == 0) {
#pragma unroll
            for (int ni = 0; ni < 2; ++ni)
#pragma unroll
                for (int r = 0; r < 4; ++r) { const size_t o = ((size_t)(b * NCH + c)) * W + (wid * 2 + ni) * 16 + quad * 4 + r; LAp[o] = Acar[ni][r]; LBp[o] = Bcar[ni][r]; }
        }
    } else {
        __syncthreads();
#pragma unroll 2
        for (int mt = 0; mt < 8; ++mt) {
            const int t = mt * 16 + fr; float s = 0.f;
#pragma unroll
            for (int w2 = 0; w2 < 8; ++w2) s += ssb[t * 8 + w2];
            const float rs = rsqrtf(s * (1.0f / W) + EPS);
#pragma unroll
            for (int ni = 0; ni < 2; ++ni) { const int n = (wid * 2 + ni) * 16 + quad * 4; const bf16x4 o4 = *(const LAS bf16x4*)(Ob + t * 264 + n);
                u32x2 w; w.x = pk2(bfs2f(o4[0]) * rs, bfs2f(o4[1]) * rs); w.y = pk2(bfs2f(o4[2]) * rs, bfs2f(o4[3]) * rs);
                *(u32x2*)(y + (t0 + t) * DM + YC_C + n) = w; }
        }
    }
    __syncthreads();
}

template <bool DIAG> __device__ __forceinline__ void attn_step2(const LAS unsigned char* buf, int kbase, int qrow0, int quad, int fr, const bf16x8 (&qf)[2][2], float (&m)[2], float (&lsum)[2], f32x4 (&oacc)[2][4]) {
    const LAS bf16_t* Kt = (const LAS bf16_t*)buf; const LAS bf16_t* Vt = (const LAS bf16_t*)(buf + 9216); const LAS float* csl = (const LAS float*)(buf + 18432);
    LAS bf16_t* vtr0 = (LAS bf16_t*)Vt + (quad * 4 + (fr >> 2)) * 72 + (fr & 3) * 4;
    float p[2][4][4];
#pragma unroll
    for (int st = 0; st < 4; ++st) {
        const f32x4 c4 = *(const LAS f32x4*)(csl + st * 16 + quad * 4);
        const bf16x8 kf0 = *(const LAS bf16x8*)(Kt + (st * 16 + fr) * 72 + quad * 8), kf1 = *(const LAS bf16x8*)(Kt + (st * 16 + fr) * 72 + 32 + quad * 8);
#pragma unroll
        for (int qs = 0; qs < 2; ++qs) {
            f32x4 acc = mfma16(kf0, qf[qs][0], c4); acc = mfma16(kf1, qf[qs][1], acc);
#pragma unroll
            for (int r = 0; r < 4; ++r) { float v = acc[r]; if (DIAG && (kbase + st * 16 + quad * 4 + r > qrow0 + qs * 16)) v = -1e30f; p[qs][st][r] = v; }
        }
    }
    bf16x8 pf[2][2];
#pragma unroll
    for (int qs = 0; qs < 2; ++qs) {
        float mx = -1e30f;
#pragma unroll
        for (int st = 0; st < 4; ++st)
#pragma unroll
            for (int r = 0; r < 4; ++r) mx = fmaxf(mx, p[qs][st][r]);
        mx = quad_max(mx);
        if (__any(mx > m[qs])) {
            const float mnew = fmaxf(m[qs], mx), al = __builtin_amdgcn_exp2f(m[qs] - mnew); m[qs] = mnew; lsum[qs] *= al;
#pragma unroll
            for (int dt = 0; dt < 4; ++dt) oacc[qs][dt] = oacc[qs][dt] * al;
        }
        const float mcur = m[qs];
        float ps = 0.f;
#pragma unroll
        for (int st = 0; st < 4; ++st)
#pragma unroll
            for (int r = 0; r < 4; ++r) { const float e = __builtin_amdgcn_exp2f(p[qs][st][r] - mcur); p[qs][st][r] = e; ps += e; }
        lsum[qs] += ps;
#pragma unroll
        for (int ks = 0; ks < 2; ++ks) { u32x4 w; w.x = pk2(p[qs][2 * ks][0], p[qs][2 * ks][1]); w.y = pk2(p[qs][2 * ks][2], p[qs][2 * ks][3]); w.z = pk2(p[qs][2 * ks + 1][0], p[qs][2 * ks + 1][1]); w.w = pk2(p[qs][2 * ks + 1][2], p[qs][2 * ks + 1][3]); pf[qs][ks] = __builtin_bit_cast(bf16x8, w); }
    }
#pragma unroll
    for (int dt = 0; dt < 4; ++dt) {
#pragma unroll
        for (int ks = 0; ks < 2; ++ks) {
            const bf16x4 v0 = __builtin_bit_cast(bf16x4, __builtin_amdgcn_ds_read_tr16_b64_v4i16((LAS v4i16_t*)(vtr0 + (ks * 32) * 72 + dt * 16)));
            const bf16x4 v1 = __builtin_bit_cast(bf16x4, __builtin_amdgcn_ds_read_tr16_b64_v4i16((LAS v4i16_t*)(vtr0 + (ks * 32 + 16) * 72 + dt * 16)));
            const bf16x8 vf = (bf16x8){v0[0], v0[1], v0[2], v0[3], v1[0], v1[1], v1[2], v1[3]};
            oacc[0][dt] = mfma16(vf, pf[0][ks], oacc[0][dt]); oacc[1][dt] = mfma16(vf, pf[1][ks], oacc[1][dt]);
        }
    }
}
__device__ __forceinline__ void attn_unit(int b, int h, int qb, const Args& a, unsigned char* lds) {
    const bf16_t* z = (const bf16_t*)(ws_() + WS_Z); bf16_t* y = (bf16_t*)(ws_() + WS_Y);
    const float* cs = (const float*)(ws_() + WS_CS); float* ssd = (float*)(ws_() + WS_SSD);
    constexpr int ABUF = 9216 + 9216 + 256;
    LAS unsigned char* lb = (LAS unsigned char*)lds;
    const int tid = opaque_tid(), lane = tid & 63, wid = tid >> 6, fr = lane & 15, quad = lane >> 4, grp = wid >> 2, wq = wid & 3;
    const int q0 = qb * 128, qw = q0 + wq * 32, qrow0 = qw + fr;
    const size_t rb = (size_t)b * SEQ;
    bf16x8 qf[2][2];
    {
        const float SC = 0.125f * LOG2E;
#pragma unroll
        for (int qs = 0; qs < 2; ++qs)
#pragma unroll
            for (int ds = 0; ds < 2; ++ds) { const bf16x8 qv = *(const bf16x8*)(z + (rb + qrow0 + qs * 16) * ZW + ZC_Q + h * 64 + ds * 32 + quad * 8); float t8[8];
#pragma unroll
                for (int e = 0; e < 8; ++e) t8[e] = bfs2f(qv[e]) * SC;
                qf[qs][ds] = pack8(t8); }
    }
    float m[2] = {-1e30f, -1e30f}, lsum[2] = {0.f, 0.f}; f32x4 oacc[2][4];
#pragma unroll
    for (int qs = 0; qs < 2; ++qs)
#pragma unroll
        for (int dt = 0; dt < 4; ++dt) oacc[qs][dt] = (f32x4){0.f, 0.f, 0.f, 0.f};
    float qbnd[2];
    {
        float kv = (lane <= qb) ? ((const float*)(ws_() + WS_KMAX))[(b * NCH + lane) * 4 + h] : 0.f;
        kv = wave_max(kv);
        const float kmax = __builtin_amdgcn_sqrtf(kv) * 1.01f + 1e-3f;
#pragma unroll
        for (int qs = 0; qs < 2; ++qs) { float q2 = 0.f;
#pragma unroll
            for (int ds = 0; ds < 2; ++ds)
#pragma unroll
                for (int e = 0; e < 8; ++e) { const float f = bfs2f(qf[qs][ds][e]); q2 += f * f; }
            q2 = quad_sum(q2); qbnd[qs] = (__builtin_amdgcn_sqrtf(q2) * 1.01f + 1e-3f) * kmax; }
    }
    const int NSS = qb + 1;
    volatile LAS unsigned* vote = (volatile LAS unsigned*)(lds + LDS_BYTES - 64);
    if (tid < 3) vote[tid] = 0u;
    bf16x8 kreg[2], vreg[2]; float creg = 0.f;
#define ATT_LOAD(S) do { const size_t kb_ = rb + (size_t)(S) * 128; \
        _Pragma("unroll") for (int p_ = 0; p_ < 2; ++p_) { const int id_ = tid + 512 * p_; \
            kreg[p_] = *(const bf16x8*)(z + (kb_ + (id_ >> 3)) * ZW + ZC_K + h * 64 + (id_ & 7) * 8); \
            vreg[p_] = *(const bf16x8*)(z + (kb_ + (id_ >> 3)) * ZW + ZC_V + h * 64 + (id_ & 7) * 8); } \
        if (tid < 128) creg = cs[(kb_ + tid) * 4 + h]; } while (0)
#define ATT_STORE(S) do { LAS unsigned char* bb_ = lb + ((S) & 1) * (2 * ABUF); \
        _Pragma("unroll") for (int p_ = 0; p_ < 2; ++p_) { const int id_ = tid + 512 * p_; const int k128_ = id_ >> 3; \
            *(LAS bf16x8*)((LAS bf16_t*)(bb_ + (k128_ >> 6) * ABUF) + (k128_ & 63) * 72 + (id_ & 7) * 8) = kreg[p_]; \
            *(LAS bf16x8*)((LAS bf16_t*)(bb_ + (k128_ >> 6) * ABUF + 9216) + (k128_ & 63) * 72 + (id_ & 7) * 8) = vreg[p_]; } \
        if (tid < 128) ((LAS float*)(bb_ + (tid >> 6) * ABUF + 18432))[tid & 63] = -creg; } while (0)
    ATT_LOAD(NSS - 1); ATT_STORE(NSS - 1);
    if (NSS > 1) ATT_LOAD(NSS - 2);
    __syncthreads();
    int kstep = 0;
    for (int S = NSS - 1; S >= 0; --S) {
        if (S >= 1) ATT_STORE(S - 1);
        if (S >= 2) ATT_LOAD(S - 2);
        float cl = 0.f; if (S >= 1) cl = cs[(rb + (size_t)(S - 1) * 128 + 127) * 4 + h];
        const int kbase = S * 128 + grp * 64;
        const LAS unsigned char* hb = lb + (S & 1) * (2 * ABUF) + grp * ABUF;
        if (S + 1 < NSS) attn_step2<false>(hb, kbase, qrow0, quad, fr, qf, m, lsum, oacc);
        else if (kbase <= qw + 31) attn_step2<true>(hb, kbase, qrow0, quad, fr, qf, m, lsum, oacc);
        const bool need = (S >= 1) && ((qbnd[0] - cl - m[0] >= -160.f) || (qbnd[1] - cl - m[1] >= -160.f));
        const int vw = kstep % 3;
        if (need) vote[vw] = 1u;
        __syncthreads();
        const unsigned go = vote[vw];
        if (tid == 0) vote[(kstep + 2) % 3] = 0u;
        ++kstep;
        if (!go) break;
    }
#undef ATT_LOAD
#undef ATT_STORE
    LAS float* mg = (LAS float*)lb;
    const int ml = wq * 64 + lane;
    if (grp == 1) {
#pragma unroll
        for (int qs = 0; qs < 2; ++qs) { mg[(qs * 18 + 0) * 256 + ml] = m[qs]; mg[(qs * 18 + 1) * 256 + ml] = lsum[qs];
#pragma unroll
            for (int dt = 0; dt < 4; ++dt)
#pragma unroll
                for (int r = 0; r < 4; ++r) mg[(qs * 18 + 2 + dt * 4 + r) * 256 + ml] = oacc[qs][dt][r]; }
    }
    __syncthreads();
    if (grp == 0) {
#pragma unroll
        for (int qs = 0; qs < 2; ++qs) {
            const float m1 = mg[(qs * 18 + 0) * 256 + ml], l1 = mg[(qs * 18 + 1) * 256 + ml];
            const float mt = fmaxf(m[qs], m1), f0 = __builtin_amdgcn_exp2f(m[qs] - mt), f1 = __builtin_amdgcn_exp2f(m1 - mt);
            float lt = quad_sum(lsum[qs] * f0 + l1 * f1);
            const float inv = 1.0f / lt; float ss = 0.f;
            const size_t tq = rb + qrow0 + qs * 16;
#pragma unroll
            for (int dt = 0; dt < 4; ++dt) { f32x4 o;
#pragma unroll
                for (int r = 0; r < 4; ++r) { o[r] = (oacc[qs][dt][r] * f0 + mg[(qs * 18 + 2 + dt * 4 + r) * 256 + ml] * f1) * inv; ss += o[r] * o[r]; }
                u32x2 w; w.x = pk2(o[0], o[1]); w.y = pk2(o[2], o[3]); *(u32x2*)(y + tq * DM + YC_D + h * 64 + dt * 16 + quad * 4) = w; }
            ss = quad_sum(ss);
            if (quad == 0) ssd[tq * 4 + h] = ss;
        }
    }
    __syncthreads();
}

#define XB_TMO      128
#define XB_XCNT(j)  (256  + 64 * (j))
#define XB_XSUB(j)  (1280 + 64 * (j))
#define XB_XGEN(j)  (2304 + 64 * (j))
#define XB_TOP      3328
#define XB_TOPGEN   3392
#define XCD_BAR_WORDS 3456
#define XB_SPIN_CAP (1u << 18)

__device__ __forceinline__ unsigned xb_ld(unsigned* p)              { return __hip_atomic_load(p, __ATOMIC_RELAXED, __HIP_MEMORY_SCOPE_AGENT); }
__device__ __forceinline__ unsigned xb_add(unsigned* p, unsigned v) { return __hip_atomic_fetch_add(p, v, __ATOMIC_RELAXED, __HIP_MEMORY_SCOPE_AGENT); }
__device__ __forceinline__ unsigned xb_xcc_id() { return (unsigned)__builtin_amdgcn_s_getreg((3 << 11) | 20) & 0xFu; }
#define XB_SPIN(cond, bar) do { unsigned _sp = 0; while (cond) { __builtin_amdgcn_s_sleep(1); \
    if ((++_sp & 255u) == 0u) { if (xb_ld(&(bar)[XB_TMO])) break; if (_sp > XB_SPIN_CAP) { atomicAdd(&(bar)[XB_TMO], 1u); break; } } } } while (0)

struct XcdBarrier {
    unsigned* bar; unsigned x;
    volatile LAS unsigned* st;
};

__device__ __forceinline__ XcdBarrier xcd_barrier_post(unsigned* bar, volatile LAS unsigned* st) {
    XcdBarrier b; b.bar = bar; b.x = xb_xcc_id(); b.st = st;
    if (opaque_tid() == 0) (void)xb_add(&bar[XB_XCNT(b.x)], 1u);
    return b;
}
__device__ __forceinline__ void xcd_barrier_complete(unsigned* bar, unsigned x, unsigned& nloc, unsigned& nx) {
    const unsigned G = gridDim.x * gridDim.y * gridDim.z;
    unsigned sum, cnt, mine, sp = 0u;
    for (;;) {
        sum = 0u; cnt = 0u; mine = 0u;
#pragma unroll
        for (unsigned j = 0; j < 16; ++j) { const unsigned c = xb_ld(&bar[XB_XCNT(j)]); sum += c; cnt += (c > 0u) ? 1u : 0u; mine = (j == x) ? c : mine; }
        if (sum == G) break;
        __builtin_amdgcn_s_sleep(1);
        if ((++sp & 255u) == 0u) { if (xb_ld(&bar[XB_TMO])) break; if (sp > XB_SPIN_CAP) { atomicAdd(&bar[XB_TMO], 1u); break; } }
    }
    nloc = mine > 0u ? mine : 1u; nx = cnt > 0u ? cnt : 1u;
}

__device__ __forceinline__ void xcd_barrier(const XcdBarrier& b) {
    asm volatile("s_waitcnt vmcnt(0)" ::: "memory");
    __syncthreads();
    if (opaque_tid() == 0) {
        unsigned* bar = b.bar;
        __builtin_amdgcn_s_waitcnt(0);
        unsigned nloc = b.st[0], nx = b.st[1];
        if (nloc == 0u) { xcd_barrier_complete(bar, b.x, nloc, nx); b.st[0] = nloc; b.st[1] = nx; }
        const unsigned old = xb_add(&bar[XB_XSUB(b.x)], 1u);
        const unsigned gen = old / nloc;
        if (old + 1u == (gen + 1u) * nloc) {
            __builtin_amdgcn_fence(__ATOMIC_RELEASE, "agent");
            asm volatile("s_waitcnt vmcnt(0)" ::: "memory");
            const unsigned og = xb_add(&bar[XB_TOP], 1u);
            const unsigned tg = og / nx;
            if (og + 1u == (tg + 1u) * nx) xb_add(&bar[XB_TOPGEN], 1u);
            else XB_SPIN(xb_ld(&bar[XB_TOPGEN]) == tg, bar);
            __builtin_amdgcn_fence(__ATOMIC_ACQUIRE, "agent");
            xb_add(&bar[XB_XGEN(b.x)], 1u);
            asm volatile("s_waitcnt vmcnt(0)" ::: "memory");
        } else {
            XB_SPIN(xb_ld(&bar[XB_XGEN(b.x)]) == gen, bar);
            __builtin_amdgcn_fence(__ATOMIC_ACQUIRE, "agent");
            asm volatile("s_waitcnt vmcnt(0)" ::: "memory");
        }
    }
    __syncthreads();
}

#ifndef WGM_G1
#define WGM_G1 2
#endif
#ifndef WGM_G2
#define WGM_G2 4
#endif
#ifndef WGM_G3
#define WGM_G3 4
#endif
#ifndef WGM_G4
#define WGM_G4 8
#endif
#ifndef PROBE_DUP
#define PROBE_DUP 0
#endif
#ifndef ITEM_MASK
#define ITEM_MASK 127
#endif
__global__ void __launch_bounds__(NTHR, 2) fwd_kernel(Args a) {
    extern __shared__ __attribute__((aligned(16))) unsigned char lds[];
    {
        volatile LAS unsigned* bst0 = (volatile LAS unsigned*)(lds + LDS_BYTES - 16);
        if (opaque_tid() == 0) { bst0[0] = 0u; bst0[1] = 0u; }
        __syncthreads();
        (void)xcd_barrier_post((unsigned*)(ws_() + WS_BAR), bst0);
    }
    if (PH_HI > 4096) cg::this_grid().sync();
#define SEAM(k) do { if ((k) + 1 < PH_HI) { XcdBarrier xb_; xb_.bar = (unsigned*)(ws_() + WS_BAR); xb_.x = xb_xcc_id(); xb_.st = (volatile LAS unsigned*)(lds + LDS_BYTES - 16); xcd_barrier(xb_); if (PROBE_DUP == 1) xcd_barrier(xb_); } } while (0)
#define IN(k) (PH_LO <= (k) && (k) < PH_HI)
    if (IN(0)) { prep_phase(a, lds); if (PROBE_DUP == 4) prep_phase(a, lds); SEAM(0); }
    for (int l = 0; l < DEPTH; ++l) {
        const int pb = 1 + 8 * l;
        if (l == 0 && IN(pb + 0)) {
            norm_phase<false, 1>(INP(0), nullptr, (bf16_t*)(ws_() + WS_H), (float*)(ws_() + WS_SS2), nullptr, (const float*)(ws_() + WS_WF), INP(23), (float*)(ws_() + WS_LOGF));
            SEAM(pb + 0);
        }
        if (IN(pb + 1)) {
            pg8::Gemm g{(const pg8::bf16_t*)(ws_() + WS_H), (const pg8::bf16_t*)(ws_() + WS_WIN) + (size_t)l * ZW * DM, T, ZW, DM}; pg8::StaticOrder S; S.init(T, ZW, grid_(), bid_(), WGM_G1);
            EpiStoreBf16<0, true> E{(bf16_t*)(ws_() + WS_Z), ZW, (const float*)(ws_() + WS_SS2)};
            pg8::gemm_phase<EpiStoreBf16<0, true>, pg8::StaticOrder, true, true>((PG8_LAS unsigned char*)lds, g, S, E);
            if (PROBE_DUP == 9) pg8::gemm_phase<EpiStoreBf16<0, true>, pg8::StaticOrder, true, true>((PG8_LAS unsigned char*)lds, g, S, E);
            if (l > 0) norm_phase<true, 1>(ws_() + WS_H, nullptr, nullptr, nullptr, nullptr, (const float*)(ws_() + WS_WF) + (size_t)l * DM * 4, INP(23) + l * 4, (float*)(ws_() + WS_LOGF));
            SEAM(pb + 1);
        }
        if (IN(pb + 2)) {
            for (int rep = 0; rep < (PROBE_DUP == 2 ? 2 : 1); ++rep)
            for (int it = bid_(); it < 260; it += grid_()) {
                if (it < 128) { if (ITEM_MASK & 1) s5_item<1>(l, it >> 5, it & 31, a, lds); }
                else if (it < 256) { if (ITEM_MASK & 4) lru_item<1>(l, (it - 128) >> 5, (it - 128) & 31, a, lds); }
                else { if (ITEM_MASK & 8) cumsum_item(it - 256, (const float*)(ws_() + WS_LOGF), (float*)(ws_() + WS_CS), lds); }
            }
            SEAM(pb + 2);
        }
        if (IN(pb + 3)) {
            for (int rep = 0; rep < (PROBE_DUP == 3 ? 2 : 1); ++rep) {
            for (int rep2 = 0; rep2 < (PROBE_DUP == 5 ? 2 : 1); ++rep2)
            for (int up = bid_(); up < 256; up += grid_()) {
                const int xcd_ = up & 7, ix_ = up >> 3, pr = xcd_ + 8 * (ix_ >> 4), j = ix_ & 15;
                if (ITEM_MASK & 16) { attn_unit(pr >> 2, pr & 3, 31 - j, a, lds);
                attn_unit(pr >> 2, pr & 3, j, a, lds); }
            }
            for (int rep3 = 0; rep3 < (PROBE_DUP == 6 ? 2 : 1); ++rep3)
            for (int it = bid_(); it < 256; it += grid_()) {
                if (it < 128) { if (ITEM_MASK & 32) s5_item<2>(l, it >> 5, it & 31, a, lds); }
                else { if (ITEM_MASK & 64) lru_item<2>(l, (it - 128) >> 5, (it - 128) & 31, a, lds); }
            }
            if (ITEM_MASK & 2) {
                unsigned* qctr = (unsigned*)(ws_() + WS_BAR) + 3600 + l;
                volatile LAS unsigned* qslot = (volatile LAS unsigned*)(lds + LDS_BYTES - 48);
                for (;;) {
                    __syncthreads();
                    if (opaque_tid() == 0) qslot[0] = __hip_atomic_fetch_add(qctr, 1u, __ATOMIC_RELAXED, __HIP_MEMORY_SCOPE_AGENT);
                    __syncthreads();
                    const unsigned qi = qslot[0];
                    if (qi >= 256u) break;
                    if (qi < 128u) sgu_item<1>(l, (int)(qi >> 5), (int)(qi & 31), a, lds);
                    else sgu_item<0>(l, (int)((qi - 128u) >> 5), (int)(qi & 31), a, lds);
                }
            }
            }
            SEAM(pb + 3);
        }
        if (IN(pb + 4)) {
            pg8::Gemm g{(const pg8::bf16_t*)(ws_() + WS_Y), (const pg8::bf16_t*)(ws_() + WS_WOUT) + (size_t)l * DM * DM, T, DM, DM}; pg8::StaticOrder S; S.init(T, DM, grid_(), bid_(), WGM_G2);
            EpiRes<true, true> E{(bf16_t*)(ws_() + WS_H), DM, (const float*)(ws_() + WS_SSD), (float*)(ws_() + WS_SS2)};
            pg8::gemm_phase<EpiRes<true, true>, pg8::StaticOrder, true, true>((PG8_LAS unsigned char*)lds, g, S, E);
            SEAM(pb + 4);
        }
        if (IN(pb + 6)) {
            pg8::Gemm g{(const pg8::bf16_t*)(ws_() + WS_H), (const pg8::bf16_t*)(ws_() + WS_WMI) + (size_t)l * DFF * DM, T, DFF, DM}; pg8::StaticOrder S; S.init(T, DFF, grid_(), bid_(), WGM_G3);
            EpiStoreBf16<1, true> E{(bf16_t*)(ws_() + WS_ACT), DFF, (const float*)(ws_() + WS_SS2)};
            pg8::gemm_phase<EpiStoreBf16<1, true>, pg8::StaticOrder, true, true>((PG8_LAS unsigned char*)lds, g, S, E);
            SEAM(pb + 6);
        }
        if (IN(pb + 7)) {
            pg8::Gemm g{(const pg8::bf16_t*)(ws_() + WS_ACT), (const pg8::bf16_t*)(ws_() + WS_WMO) + (size_t)l * DM * DFF, T, DM, DFF}; pg8::StaticOrder S; S.init(T, DM, grid_(), bid_(), WGM_G4);
            EpiRes<false, true> E{(bf16_t*)(ws_() + WS_H), DM, nullptr, (float*)(ws_() + WS_SS2)};
            pg8::gemm_phase<EpiRes<false, true>, pg8::StaticOrder, true, true>((PG8_LAS unsigned char*)lds, g, S, E);
            SEAM(pb + 7);
        }
    }
    if (IN(33)) norm_phase<true, 2>(ws_() + WS_H, INP(29), nullptr, nullptr, out_(), nullptr, nullptr, nullptr);
#undef SEAM
#undef IN
}


#ifndef DUMP_SEL
#define DUMP_SEL 0
#endif
#ifndef DUMP_LAST
#define DUMP_LAST 33
#endif
__global__ void dump_kernel(const unsigned char* ws, float* out) {
    const size_t i = (size_t)blockIdx.x * blockDim.x + threadIdx.x;
    const size_t t = i >> 10, c = i & 1023;
    float v = 0.f;
    if (DUMP_SEL == 1) v = bf2f(((const bf16_t*)(ws + WS_H))[i]);
    if (DUMP_SEL == 2) v = bf2f(((const bf16_t*)(ws + WS_Z))[t * ZW + c]) + bf2f(((const bf16_t*)(ws + WS_Z))[t * ZW + c + 1024]);
    if (DUMP_SEL == 3) v = bf2f(((const bf16_t*)(ws + WS_Y))[i]);
    if (DUMP_SEL == 5) v = ((const float*)(ws + WS_SSD))[(t * 4 + (c & 3))] + ((const float*)(ws + WS_CS))[(t * 4 + (c & 3))];
    if (DUMP_SEL == 7) v = ((const float*)(ws + WS_ELOC))[i & 262143];
    if (DUMP_SEL == 8) v = ((const float*)(ws + WS_LA))[i & 32767] + ((const float*)(ws + WS_LB))[i & 32767];
    if (DUMP_SEL == 6) v = bf2f(((const bf16_t*)(ws + WS_WIN))[i]) + bf2f(((const bf16_t*)(ws + WS_WMI))[i]) + bf2f(((const bf16_t*)(ws + WS_WMO))[i]) + bf2f(((const bf16_t*)(ws + WS_WOUT))[i & 0x3fffff]);
    out[i] = v;
}
#ifndef N_LAUNCH_MODE
#define N_LAUNCH_MODE 1
#endif
extern "C" void kernel_launch(void* const* d_in, const int* in_sizes, int n_in, void* d_out, int out_size, void* d_ws, size_t ws_size, hipStream_t stream) {
    static int grid = 0;
    if (grid == 0) {
        if (n_in != 30 || out_size != T * DM || ws_size < WS_END) { fprintf(stderr, "kernel_launch: unexpected shapes (n_in %d, out %d, ws %zu, need %zu)\n", n_in, out_size, ws_size, (size_t)WS_END); grid = -1; return; }
        int dev = 0, cus = 0, per_cu = 0;
        hipGetDevice(&dev); hipDeviceGetAttribute(&cus, hipDeviceAttributeMultiprocessorCount, dev);
        if (hipFuncSetAttribute((const void*)fwd_kernel, hipFuncAttributeMaxDynamicSharedMemorySize, LDS_BYTES) != hipSuccess) { fprintf(stderr, "kernel_launch: hipFuncSetAttribute failed\n"); grid = -1; return; }
        if (hipOccupancyMaxActiveBlocksPerMultiprocessor(&per_cu, (const void*)fwd_kernel, NTHR, LDS_BYTES) != hipSuccess || per_cu < 1) { fprintf(stderr, "kernel_launch: occupancy query says %d\n", per_cu); per_cu = 1; }
        (void)hipGetLastError();
        grid = cus;
        if (grid > 256) grid = 256;
    }
    if (grid < 0) return;
    Args a{};
    for (int i = 0; i < 30; ++i) a.in[i] = (const float*)d_in[i];
    a.out = (float*)d_out; a.ws = (unsigned char*)d_ws;
    if (N_LAUNCH_MODE == 1) {
        a.ph_lo = 0; a.ph_hi = 34;
        if (hipMemsetAsync((unsigned char*)d_ws + WS_BAR, 0, 16 * 1024, stream) != hipSuccess) { fprintf(stderr, "kernel_launch: memset of the barrier words failed\n"); return; }
        void* args[] = {&a};
        hipError_t e = hipLaunchCooperativeKernel((const void*)fwd_kernel, dim3(grid), dim3(NTHR), args, LDS_BYTES, stream);
        if (e != hipSuccess) fprintf(stderr, "kernel_launch: cooperative launch failed: %s (grid %d)\n", hipGetErrorString(e), grid);
    } else {
        for (int ph = 0; ph <= DUMP_LAST; ++ph) { a.ph_lo = ph; a.ph_hi = ph + 1; hipLaunchKernelGGL(fwd_kernel, dim3(grid), dim3(NTHR), LDS_BYTES, stream, a); }
        if (DUMP_SEL != 0 && DUMP_SEL != 4) hipLaunchKernelGGL(dump_kernel, dim3(T * DM / 256), dim3(256), 0, stream, (const unsigned char*)d_ws, (float*)d_out);
    }
}
```

```cpp
#include <hip/hip_runtime.h>
#include <hip/hip_cooperative_groups.h>
#include <cstdio>
#include <cstdint>
namespace cg = cooperative_groups;
__device__ __forceinline__ int opaque_tid() { int t = __builtin_amdgcn_workitem_id_x(); asm volatile("" : "+v"(t)); return t; }
namespace pg8 {
#define PG8_LAS __attribute__((address_space(3)))
typedef unsigned short bf16_t;
typedef short bf16x8 __attribute__((ext_vector_type(8)));
typedef float f32x4 __attribute__((ext_vector_type(4)));
typedef unsigned u32x4 __attribute__((ext_vector_type(4)));
constexpr int BM = 256, BK = 64, HALF = 128, HTB = HALF * BK * 2  , STAGE_BYTES = 8 * HTB, NXCD = 8, WGM = 4;

__host__ __device__ __forceinline__ int lds_byte(int r, int c) { const int st = (r >> 4) * 2 + (c >> 5), rr = r & 15, cc = c & 31, ob = rr * 64 + cc * 2; return st * 1024 + (ob ^ (((ob >> 9) & 1) << 5)); }
__host__ __device__ __forceinline__ void stage_rc(int b, int& R, int& C) { const int st = b / 1024, sb = b % 1024, swz = sb ^ (((sb >> 9) & 1) << 5); R = (st >> 1) * 16 + swz / 64; C = (st & 1) * 32 + (swz % 64) / 2; }
__host__ __device__ __forceinline__ int perm32(int rho) { const int n = rho >> 4, i = rho & 15; return 8 * (i >> 2) + 4 * n + (i & 3); }

struct Unit { int pm, pn; };
struct Gemm { const bf16_t* A; const bf16_t* Bt; int M, N, K; };

struct StaticOrder {
    int nM, nN, nwg, G, c, wgm;
    __host__ __device__ void init(int M, int N, int G_, int c_, int wgm_ = WGM) { nM = M / BM; nN = N / BM; nwg = nM * nN; G = G_; c = c_; wgm = wgm_; }
    __host__ __device__ bool next(int i, Unit& u) const {
        const long L = (long)i * G + c; if (L >= nwg) return false;
        int wgid = (int)L; { const int q = nwg / NXCD, r = nwg % NXCD, xcd = wgid % NXCD, off = wgid / NXCD; wgid = (xcd < r ? xcd * (q + 1) : r * (q + 1) + (xcd - r) * q) + off; }
        const int nig = wgm * nN, gid = wgid / nig, fm = gid * wgm, gsz = (nM - fm) < wgm ? (nM - fm) : wgm;
        u.pm = fm + ((wgid % nig) % gsz); u.pn = (wgid % nig) / gsz; return true;
    }
    __device__ __forceinline__ void a_ready(const Unit&) const {}
    __device__ __forceinline__ void done(const Unit&) const {}
};

__device__ __forceinline__ unsigned cvt_pk_bf16(float lo, float hi) { unsigned r; asm volatile("v_cvt_pk_bf16_f32 %0, %1, %2" : "=v"(r) : "v"(lo), "v"(hi)); return r; }
template <class Epi, class Sched, bool ALIGN_EPI = false, bool SP2 = false>
__device__ __forceinline__ void gemm_phase(PG8_LAS unsigned char* lds, const Gemm g, const Sched& S, const Epi& E) {
    const int tid = opaque_tid(), wid = __builtin_amdgcn_readfirstlane(tid >> 6), lane = tid & 63, wr = wid >> 2, wc = wid & 3, fr = lane & 15, fq = lane >> 4;
    const int K = g.K, nt = K / BK;
    unsigned voffA[2], voffB[2];
#pragma unroll
    for (int i = 0; i < 2; ++i) { int R, C; stage_rc(tid * 16 + i * 8192, R, C); const int Rb = Epi::PERM ? ((R & ~31) + perm32(R & 31)) : R;
        voffA[i] = (unsigned)(R * K + C) * 2u; voffB[i] = (unsigned)(Rb * K + C) * 2u; }
    const size_t kstep = (size_t)(BK * 2);
    const size_t hstep = (size_t)HALF * K * 2;
    const size_t tstep = 2 * hstep;
    const unsigned ldsw = (unsigned)wid * 1024u;
    const int aoff = lds_byte(wr * 64 + fr, fq * 8), boff = lds_byte(wc * 32 + fr, fq * 8);
#define PG8_SA(b, h) (((b) * 2 + (h)) * HTB)
#define PG8_SB(b, h) ((4 + (b) * 2 + (h)) * HTB)
#define PG8_STAGE(bufoff, gbase, voff) do { _Pragma("unroll") for (int _i = 0; _i < 2; ++_i) \
        __builtin_amdgcn_global_load_lds((const unsigned*)((const char*)(gbase) + (voff)[_i]), (PG8_LAS unsigned*)(lds + (bufoff) + ldsw + _i * 8192), 16, 0, 0); } while (0)
#define PG8_LDA(dst, b, h) do { _Pragma("unroll") for (int m = 0; m < 4; ++m) _Pragma("unroll") for (int k = 0; k < 2; ++k) dst[m][k] = *(const PG8_LAS bf16x8*)(lds + PG8_SA(b, h) + aoff + m * 2048 + k * 1024); } while (0)
#define PG8_LDB(dst, b, h) do { _Pragma("unroll") for (int n = 0; n < 2; ++n) _Pragma("unroll") for (int k = 0; k < 2; ++k) dst[n][k] = *(const PG8_LAS bf16x8*)(lds + PG8_SB(b, h) + boff + n * 2048 + k * 1024); } while (0)
#define PG8_MMA(ai, bj, At, Bt) do { __builtin_amdgcn_s_setprio(1); _Pragma("unroll") for (int m = 0; m < 4; ++m) _Pragma("unroll") for (int n = 0; n < 2; ++n) _Pragma("unroll") for (int k = 0; k < 2; ++k) \
        acc[ai][bj][m][n] = __builtin_amdgcn_mfma_f32_16x16x32_bf16(Bt[n][k], At[m][k], acc[ai][bj][m][n], 0, 0, 0); __builtin_amdgcn_s_setprio(0); } while (0)
#define PG8_WAIT_V(n) asm volatile("s_waitcnt vmcnt(" #n ")" ::: "memory")
#define PG8_WAIT_L(n) asm volatile("s_waitcnt lgkmcnt(" #n ")" ::: "memory")
#define PG8_BAR __builtin_amdgcn_s_barrier()
#define PG8_SCHED __builtin_amdgcn_sched_barrier(0)
    Unit cur, nxt; int ui = 0;
    if (!S.next(0, cur)) return;
    if constexpr (Epi::KPREP) { Unit pu; for (int i = 0; i < 12 && S.next(i, pu); ++i) E.kprep(pu, lds + STAGE_BYTES + i * 1024, tid); }
    f32x4 acc[2][2][4][2];
#pragma unroll
    for (int a = 0; a < 2; ++a)
#pragma unroll
        for (int b = 0; b < 2; ++b)
#pragma unroll
            for (int m = 0; m < 4; ++m)
#pragma unroll
                for (int n = 0; n < 2; ++n) acc[a][b][m][n] = (f32x4){0.f, 0.f, 0.f, 0.f};
    bf16x8 At[4][2], B0[2][2], B1[2][2];
    const char* cA = (const char*)g.A + (size_t)cur.pm * tstep; const char* cB = (const char*)g.Bt + (size_t)cur.pn * tstep;
    S.a_ready(cur);
    if constexpr (SP2) {
        PG8_STAGE(PG8_SB(0, 0), cB, voffB); PG8_STAGE(PG8_SB(0, 1), cB + hstep, voffB); PG8_STAGE(PG8_SA(0, 0), cA, voffA); PG8_STAGE(PG8_SA(0, 1), cA + hstep, voffA);
        if (wr == 1) PG8_BAR;
        PG8_WAIT_V(2); PG8_BAR;
        PG8_STAGE(PG8_SB(1, 0), cB + kstep, voffB); PG8_STAGE(PG8_SA(1, 0), cA + kstep, voffA); PG8_STAGE(PG8_SB(1, 1), cB + hstep + kstep, voffB);
        PG8_WAIT_V(6); PG8_BAR;
    } else {
        PG8_STAGE(PG8_SB(0, 0), cB, voffB); PG8_STAGE(PG8_SA(0, 0), cA, voffA); PG8_STAGE(PG8_SB(0, 1), cB + hstep, voffB); PG8_STAGE(PG8_SA(0, 1), cA + hstep, voffA);
        if (wr == 1) PG8_BAR;
        PG8_WAIT_V(4); PG8_BAR;
        PG8_STAGE(PG8_SB(1, 0), cB + kstep, voffB); PG8_STAGE(PG8_SA(1, 0), cA + kstep, voffA); PG8_STAGE(PG8_SB(1, 1), cB + hstep + kstep, voffB);
        PG8_WAIT_V(6); PG8_BAR;
    }
    for (;;) {
        const bool has_next = S.next(ui + 1, nxt);
        const char* nA = has_next ? (const char*)g.A + (size_t)nxt.pm * tstep : cA; const char* nB = has_next ? (const char*)g.Bt + (size_t)nxt.pn * tstep : cB;
        for (int t = 0; t < nt; t += 2) {
            const bool last = (t == nt - 2);
            const char* a1 = cA + (size_t)(t + 1) * kstep;
            const char* a2 = last ? nA : cA + (size_t)(t + 2) * kstep; const char* b2 = last ? nB : cB + (size_t)(t + 2) * kstep;
            const char* a3 = a2 + kstep; const char* b3 = b2 + kstep;
            if (last && has_next) S.a_ready(nxt);
            if constexpr (SP2) {
            PG8_LDB(B0, 0, 0); PG8_LDB(B1, 0, 1); PG8_SCHED; PG8_LDA(At, 0, 0); PG8_STAGE(PG8_SA(1, 1), a1 + hstep, voffA);
            PG8_WAIT_V(8); PG8_WAIT_L(0); PG8_BAR; PG8_MMA(0, 0, At, B0); PG8_MMA(0, 1, At, B1); PG8_BAR; PG8_SCHED;
            PG8_LDA(At, 0, 1); PG8_STAGE(PG8_SB(0, 0), b2, voffB); PG8_STAGE(PG8_SB(0, 1), b2 + hstep, voffB); PG8_STAGE(PG8_SA(0, 0), a2, voffA);
            PG8_WAIT_V(8); PG8_WAIT_L(0); PG8_BAR; PG8_MMA(1, 0, At, B0); PG8_MMA(1, 1, At, B1); PG8_BAR; PG8_SCHED;
            PG8_LDB(B0, 1, 0); PG8_LDB(B1, 1, 1); PG8_SCHED; PG8_LDA(At, 1, 0); PG8_STAGE(PG8_SA(0, 1), a2 + hstep, voffA);
            PG8_WAIT_V(8); PG8_WAIT_L(0); PG8_BAR; PG8_MMA(0, 0, At, B0); PG8_MMA(0, 1, At, B1); PG8_BAR; PG8_SCHED;
            PG8_LDA(At, 1, 1); PG8_STAGE(PG8_SB(1, 0), b3, voffB); PG8_STAGE(PG8_SB(1, 1), b3 + hstep, voffB); PG8_STAGE(PG8_SA(1, 0), a3, voffA);
            PG8_WAIT_V(8); PG8_WAIT_L(0); PG8_BAR; PG8_MMA(1, 0, At, B0); PG8_MMA(1, 1, At, B1); PG8_BAR; PG8_SCHED;
            } else {
            PG8_LDB(B0, 0, 0); PG8_SCHED; PG8_LDA(At, 0, 0); PG8_STAGE(PG8_SA(1, 1), a1 + hstep, voffA);
            PG8_WAIT_L(8); PG8_BAR; PG8_WAIT_L(0); PG8_MMA(0, 0, At, B0); PG8_BAR; PG8_SCHED;
            PG8_LDB(B1, 0, 1); PG8_STAGE(PG8_SB(0, 0), b2, voffB);
            PG8_BAR; PG8_WAIT_L(0); PG8_MMA(0, 1, At, B1); PG8_BAR;
            PG8_LDA(At, 0, 1); PG8_STAGE(PG8_SA(0, 0), a2, voffA);
            PG8_BAR; PG8_WAIT_L(0); PG8_MMA(1, 0, At, B0); PG8_BAR; PG8_SCHED;
            PG8_STAGE(PG8_SB(0, 1), b2 + hstep, voffB);
            PG8_WAIT_V(6); PG8_BAR; PG8_MMA(1, 1, At, B1); PG8_BAR;
            PG8_LDB(B0, 1, 0); PG8_SCHED; PG8_LDA(At, 1, 0); PG8_STAGE(PG8_SA(0, 1), a2 + hstep, voffA);
            PG8_WAIT_L(8); PG8_BAR; PG8_WAIT_L(0); PG8_MMA(0, 0, At, B0); PG8_BAR; PG8_SCHED;
            PG8_LDB(B1, 1, 1); PG8_STAGE(PG8_SB(1, 0), b3, voffB);
            PG8_BAR; PG8_WAIT_L(0); PG8_MMA(0, 1, At, B1); PG8_BAR;
            PG8_LDA(At, 1, 1); PG8_STAGE(PG8_SA(1, 0), a3, voffA);
            PG8_BAR; PG8_WAIT_L(0); PG8_MMA(1, 0, At, B0); PG8_BAR; PG8_SCHED;
            PG8_STAGE(PG8_SB(1, 1), b3 + hstep, voffB);
            PG8_WAIT_V(6); PG8_BAR; PG8_MMA(1, 1, At, B1); PG8_BAR;
            }
            if constexpr (Epi::KHOOK) { if (t == 2) E.khook(acc, lds + STAGE_BYTES + ui * 1024, wr, fr); }
        }
        if constexpr (ALIGN_EPI) { if (wr == 0) PG8_BAR; }
        if constexpr (!Epi::AFTER_DRAIN) { E(acc, cur, wr, wc, fr, fq, lds + STAGE_BYTES + ui * 1024); S.done(cur); }
        if (!has_next) break;
#pragma unroll
        for (int a = 0; a < 2; ++a)
#pragma unroll
            for (int b = 0; b < 2; ++b)
#pragma unroll
                for (int m = 0; m < 4; ++m)
#pragma unroll
                    for (int n = 0; n < 2; ++n) acc[a][b][m][n] = (f32x4){0.f, 0.f, 0.f, 0.f};
        cur = nxt; cA = nA; cB = nB; ++ui;
        if constexpr (ALIGN_EPI) { if (wr == 1) PG8_BAR; }
    }
    PG8_WAIT_V(0);
    if constexpr (!ALIGN_EPI) { if (wr == 0) PG8_BAR; }
    PG8_BAR;
    if constexpr (Epi::AFTER_DRAIN) { E.fused(acc, cur, wr, wc, fr, fq, lds, wid, lane); S.done(cur); }
#undef PG8_SA
#undef PG8_SB
#undef PG8_STAGE
#undef PG8_LDA
#undef PG8_LDB
#undef PG8_MMA
#undef PG8_WAIT_V
#undef PG8_WAIT_L
#undef PG8_BAR
#undef PG8_SCHED
}
}

#define LAS __attribute__((address_space(3)))
typedef unsigned short bf16_t;
typedef short bf16x8 __attribute__((ext_vector_type(8)));
typedef short bf16x4 __attribute__((ext_vector_type(4)));
typedef float f32x4 __attribute__((ext_vector_type(4)));
typedef float f32x2 __attribute__((ext_vector_type(2)));
typedef unsigned u32x4 __attribute__((ext_vector_type(4)));
typedef unsigned u32x2 __attribute__((ext_vector_type(2)));
typedef short v4i16_t __attribute__((ext_vector_type(4)));

constexpr int NB = 4, SEQ = 4096, DM = 1024, DEPTH = 4, T = NB * SEQ, W = 256, DFF = 4096, NIN = 2052, ZW = 2048;
constexpr int NCH = SEQ / 128;
constexpr float EPS = 1e-6f;
constexpr float LOG2E = 1.4426950408889634f;
constexpr int NTHR = 512;
constexpr int LDS_BYTES = 147456;
constexpr int ZC_AU = 0, ZC_AV = 256, ZC_B = 512, ZC_CX = 768, ZC_CG = 1024, ZC_Q = 1280, ZC_K = 1536, ZC_V = 1792;
constexpr int YC_D = 0, YC_A = 256, YC_B = 512, YC_C = 768;

constexpr size_t MiB = 1u << 20;
constexpr size_t WS_WIN = 0, WS_WOUT = 16 * MiB, WS_WMI = 24 * MiB, WS_WMO = 56 * MiB, WS_R = 88 * MiB, WS_Z = WS_R, WS_Y = WS_R + 64 * MiB, WS_ACT = WS_R,
                 WS_H = 216 * MiB, WS_S = 248 * MiB;
constexpr size_t WS_GLUT = WS_S, WS_WAT = WS_GLUT + 512 * 1024, WS_WXT = WS_WAT + 128 * 1024, WS_BBT = WS_WXT + 128 * 1024, WS_CMT = WS_BBT + 256 * 1024,
                 WS_ABAR = WS_CMT + 256 * 1024, WS_A128 = WS_ABAR + 32 * 1024, WS_WF = WS_A128 + 32 * 1024, WS_LOGF = WS_WF + 64 * 1024, WS_CS = WS_LOGF + 256 * 1024,
                 WS_SSD = WS_CS + 256 * 1024, WS_ELOC = WS_SSD + 256 * 1024, WS_LA = WS_ELOC + 1024 * 1024, WS_LB = WS_LA + 128 * 1024, WS_BAR = WS_LB + 128 * 1024, WS_SS2 = WS_BAR + 16 * 1024, WS_KMAX = WS_SS2 + 1024 * 1024, WS_END = WS_KMAX + 4096;

struct Args {
    const float* in[30]; float* out; unsigned char* ws; int ph_lo, ph_hi;
};


typedef const __attribute__((address_space(4))) unsigned long long* kargp_t;
__device__ __forceinline__ unsigned long long karg_(int i) { kargp_t tab = (kargp_t)__builtin_amdgcn_kernarg_segment_ptr(); asm volatile("" : "+s"(tab)); return tab[i]; }
#define INP(i) ((const float*)karg_(i))
__device__ __forceinline__ unsigned char* ws_() { return (unsigned char*)karg_(31); }
__device__ __forceinline__ float* out_() { return (float*)karg_(30); }
#define PH_LO ((int)(unsigned)(karg_(32) & 0xffffffffull))
#define PH_HI ((int)(unsigned)(karg_(32) >> 32))
__device__ __forceinline__ int bid_() { return blockIdx.x; }
__device__ __forceinline__ int grid_() { return gridDim.x; }
__device__ __forceinline__ float bf2f(bf16_t v) { return __uint_as_float((unsigned)v << 16); }
__device__ __forceinline__ float bfs2f(short v) { return __uint_as_float(((unsigned)(unsigned short)v) << 16); }
typedef __bf16 bf16x2_t __attribute__((ext_vector_type(2)));
__device__ __forceinline__ unsigned pk2(float lo, float hi) { const f32x2 v = {lo, hi}; const bf16x2_t b = __builtin_convertvector(v, bf16x2_t); return __builtin_bit_cast(unsigned, b); }
__device__ __forceinline__ bf16_t f2bf(float f) { return (bf16_t)(pk2(f, 0.f) & 0xffffu); }
__device__ __forceinline__ float gelu_t(float x) { const float y2 = (1.5957691216057308f * LOG2E) * (x + 0.044715f * x * x * x); return x * __builtin_amdgcn_rcpf(1.0f + __builtin_amdgcn_exp2f(-y2)); }
__device__ __forceinline__ float sigm(float x) { return __builtin_amdgcn_rcpf(1.0f + __builtin_amdgcn_exp2f(-LOG2E * x)); }
__device__ __forceinline__ float softplus_f(float x) { return fmaxf(x, 0.f) + log1pf(__expf(-fabsf(x))); }
__device__ __forceinline__ f32x4 mfma16(bf16x8 a, bf16x8 b, f32x4 c) { return __builtin_amdgcn_mfma_f32_16x16x32_bf16(a, b, c, 0, 0, 0); }
__device__ __forceinline__ float quad_sum(float v) {
    { const auto r = __builtin_amdgcn_permlane16_swap(__float_as_uint(v), __float_as_uint(v), false, false); v = __uint_as_float(r[0]) + __uint_as_float(r[1]); }
    { const auto r = __builtin_amdgcn_permlane32_swap(__float_as_uint(v), __float_as_uint(v), false, false); v = __uint_as_float(r[0]) + __uint_as_float(r[1]); }
    return v;
}
template <int CTRL> __device__ __forceinline__ float dpp_mov(float x) { return __uint_as_float((unsigned)__builtin_amdgcn_update_dpp(0, (int)__float_as_uint(x), CTRL, 0xf, 0xf, true)); }
__device__ __forceinline__ float wave_sum(float v) {
    v += dpp_mov<0xB1>(v); v += dpp_mov<0x4E>(v); v += dpp_mov<0x141>(v); v += dpp_mov<0x140>(v);
    return quad_sum(v);
}
__device__ __forceinline__ float wave_max(float v);
__device__ __forceinline__ float quad_max(float v) {
    { const auto r = __builtin_amdgcn_permlane16_swap(__float_as_uint(v), __float_as_uint(v), false, false); v = fmaxf(__uint_as_float(r[0]), __uint_as_float(r[1])); }
    { const auto r = __builtin_amdgcn_permlane32_swap(__float_as_uint(v), __float_as_uint(v), false, false); v = fmaxf(__uint_as_float(r[0]), __uint_as_float(r[1])); }
    return v;
}
__device__ __forceinline__ bf16x8 pack8(const float* v) {
    u32x4 w; w.x = pk2(v[0], v[1]); w.y = pk2(v[2], v[3]); w.z = pk2(v[4], v[5]); w.w = pk2(v[6], v[7]); return __builtin_bit_cast(bf16x8, w);
}
__device__ __forceinline__ bf16x8 zero8() { return (bf16x8){0, 0, 0, 0, 0, 0, 0, 0}; }

__device__ __forceinline__ float wave_max(float v) {
    v = fmaxf(v, dpp_mov<0xB1>(v)); v = fmaxf(v, dpp_mov<0x4E>(v)); v = fmaxf(v, dpp_mov<0x141>(v)); v = fmaxf(v, dpp_mov<0x140>(v));
    return quad_max(v);
}
template <int N> __device__ __forceinline__ float dpp_shr(float x, float ident) {
    return __uint_as_float((unsigned)__builtin_amdgcn_update_dpp((int)__float_as_uint(ident), (int)__float_as_uint(x), 0x110 + N, 0xf, 0xf, false));
}
__device__ __forceinline__ float neg_expm1(float x) {
    const float s = -x * (1.0f + x * (0.5f + x * (0.16666667f + x * (0.041666668f + x * (0.0083333338f + x * 0.0013888889f)))));
    const float e = 1.0f - __builtin_amdgcn_exp2f(LOG2E * x);
    return (x > -0.25f) ? s : e;
}
template <int ACT  , bool ROWS = false> struct EpiStoreBf16 {
    static constexpr bool PERM = true, AFTER_DRAIN = false, KHOOK = false, KPREP = ROWS;
    __device__ __forceinline__ void kprep(const pg8::Unit& u, PG8_LAS unsigned char* tab, int tid) const {
        if (tid < 256) { const float* rp = rowss + (size_t)(u.pm * 256 + tid) * 16; const f32x4 s0 = *(const f32x4*)rp, s1 = *(const f32x4*)(rp + 4), s2 = *(const f32x4*)(rp + 8), s3 = *(const f32x4*)(rp + 12);
            const float tot = ((s0[0] + s0[1]) + (s0[2] + s0[3])) + ((s1[0] + s1[1]) + (s1[2] + s1[3])) + ((s2[0] + s2[1]) + (s2[2] + s2[3])) + ((s3[0] + s3[1]) + (s3[2] + s3[3]));
            ((PG8_LAS float*)tab)[tid] = rsqrtf(tot * (1.0f / DM) + EPS); }
    }
    bf16_t* O; int ldc; const float* rowss;
    __device__ __forceinline__ void operator()(const pg8::f32x4 (&acc)[2][2][4][2], const pg8::Unit& u, int wr, int wc, int fr, int fq, PG8_LAS unsigned char* tab) const {
        const int row0 = u.pm * 256 + wr * 64 + fr, col0 = u.pn * 256 + wc * 32 + 8 * fq;
#pragma unroll
        for (int ai = 0; ai < 2; ++ai)
#pragma unroll
            for (int m = 0; m < 4; ++m) { bf16_t* rowp = O + (size_t)(row0 + ai * 128 + m * 16) * ldc + col0;
                const float rsc = ROWS ? ((const PG8_LAS float*)tab)[wr * 64 + fr + ai * 128 + m * 16] : 1.0f;
#pragma unroll
                for (int bj = 0; bj < 2; ++bj) { pg8::f32x4 v0 = acc[ai][bj][m][0] * rsc, v1 = acc[ai][bj][m][1] * rsc;
                    if (ACT == 1) {
#pragma unroll
                        for (int e = 0; e < 4; ++e) { const float a = fmaxf(v0[e], 0.f), b = fmaxf(v1[e], 0.f); v0[e] = a * a; v1[e] = b * b; } }
                    u32x4 w; w.x = pk2(v0[0], v0[1]); w.y = pk2(v0[2], v0[3]); w.z = pk2(v1[0], v1[1]); w.w = pk2(v1[2], v1[3]);
                    *(u32x4*)(rowp + bj * 128) = w; } }
    }
};
template <bool HOOK, bool NORMOUT> struct EpiRes {
    static constexpr bool PERM = true, AFTER_DRAIN = false, KHOOK = HOOK, KPREP = HOOK;
    bf16_t* xb; int ldc; const float* ssd; float* ss2;
    __device__ __forceinline__ void operator()(const pg8::f32x4 (&acc)[2][2][4][2], const pg8::Unit& u, int wr, int wc, int fr, int fq, PG8_LAS unsigned char* tab) const {
        const int col0 = u.pn * 256 + wc * 32 + 8 * fq;
#pragma unroll
        for (int ai = 0; ai < 2; ++ai)
#pragma unroll
            for (int m = 0; m < 4; ++m) { const int row = u.pm * 256 + ai * 128 + wr * 64 + m * 16 + fr; bf16_t* rowp = xb + (size_t)row * ldc + col0; float sq = 0.f;
#pragma unroll
                for (int bj = 0; bj < 2; ++bj) { const bf16x8 s = *(const bf16x8*)(rowp + bj * 128); float o[8];
#pragma unroll
                    for (int e = 0; e < 4; ++e) { o[e] = bfs2f(s[e]) + acc[ai][bj][m][0][e]; o[4 + e] = bfs2f(s[4 + e]) + acc[ai][bj][m][1][e]; }
                    if (NORMOUT) {
#pragma unroll
                        for (int e = 0; e < 8; ++e) sq += o[e] * o[e]; }
                    *(bf16x8*)(rowp + bj * 128) = pack8(o); }
                if (NORMOUT) { sq = quad_sum(sq); if (fq == 0) ss2[(size_t)row * 16 + u.pn * 4 + wc] = sq; }
                if (m & 1) asm volatile("" ::: "memory"); }
    }
    __device__ __forceinline__ void kprep(const pg8::Unit& u, PG8_LAS unsigned char* tab, int tid) const {
        if (tid < 256) { const f32x4 s4 = *(const f32x4*)(ssd + (size_t)(u.pm * 256 + tid) * 4); ((PG8_LAS float*)tab)[tid] = rsqrtf((s4[0] + s4[1] + s4[2] + s4[3]) * (1.0f / 256.0f) + EPS); }
    }
    __device__ __forceinline__ void khook(pg8::f32x4 (&acc)[2][2][4][2], PG8_LAS unsigned char* tab, int wr, int fr) const {
#pragma unroll
        for (int ai = 0; ai < 2; ++ai)
#pragma unroll
            for (int m = 0; m < 4; ++m) { const float rs = ((const PG8_LAS float*)tab)[ai * 128 + wr * 64 + m * 16 + fr];
#pragma unroll
                for (int bj = 0; bj < 2; ++bj)
#pragma unroll
                    for (int n = 0; n < 2; ++n) acc[ai][bj][m][n] *= rs; }
    }
};

template <int TN> __device__ __forceinline__ void tc_job(unsigned char* lds, const float* src, size_t sb, int ld, int K, int N, int nbatch, bf16_t* dst, const float* gain, int kshift, int rot) {
    LAS float* tile = (LAS float*)lds;
    constexpr int CG = TN / 64, NLD = TN / 32  , NST = TN / 64  ;
    const int tid = opaque_tid(), nk = K / 64, nn = N / TN, ntile = nbatch * nk * nn;
    for (int ti = (int)((bid_() + grid_() - (rot % grid_())) % grid_()); ti < ntile; ti += grid_()) {
        const int b = ti / (nk * nn), rem = ti % (nk * nn), kt = rem / nn, nt = rem % nn;
        const float* s = src + (size_t)b * sb + (size_t)(kt * 64) * ld + nt * TN;
        f32x4 v[NLD];
#pragma unroll
        for (int p = 0; p < NLD; ++p) { const int idx = tid + 512 * p, c16 = idx & 15, kq = (idx >> 4) & 3, rest = idx >> 6, kl = (rest / CG) * 4 + kq, n4 = ((rest % CG) * 16 + c16) * 4;
            v[p] = *(const f32x4*)(s + (size_t)kl * ld + n4);
            if (gain) { const float gg = gain[(size_t)b * K + kt * 64 + kl]; v[p] = v[p] * gg; } }
        __syncthreads();
#pragma unroll
        for (int p = 0; p < NLD; ++p) { const int idx = tid + 512 * p, c16 = idx & 15, kq = (idx >> 4) & 3, rest = idx >> 6, kl = (rest / CG) * 4 + kq, n4 = ((rest % CG) * 16 + c16) * 4;
            tile[kl * (TN + 1) + n4 + 0] = v[p][0]; tile[kl * (TN + 1) + n4 + 1] = v[p][1]; tile[kl * (TN + 1) + n4 + 2] = v[p][2]; tile[kl * (TN + 1) + n4 + 3] = v[p][3]; }
        __syncthreads();
#pragma unroll
        for (int p = 0; p < NST; ++p) { const int idx = tid + 512 * p, nl = idx >> 3, kc = (idx & 7) * 8; float o[8];
#pragma unroll
            for (int e = 0; e < 8; ++e) o[e] = tile[(kc + e) * (TN + 1) + nl];
            const int kd = (kt * 64 + kc + kshift) % K;
            *(bf16x8*)(dst + (size_t)b * N * K + (size_t)(nt * TN + nl) * K + kd) = pack8(o); }
    }
    __syncthreads();
}

__device__ __forceinline__ void prep_phase(const Args& a, unsigned char* lds) {
    unsigned char* ws = ws_();
    tc_job<256>(lds, INP(2), (size_t)DM * NIN, NIN, DM, ZW, DEPTH, (bf16_t*)(ws + WS_WIN), INP(1), 0, 0);
    tc_job<256>(lds, INP(25), (size_t)DM * DM, DM, DM, DM, DEPTH, (bf16_t*)(ws + WS_WOUT), INP(24), 256, 0);
    tc_job<256>(lds, INP(27), (size_t)DM * DFF, DFF, DM, DFF, DEPTH, (bf16_t*)(ws + WS_WMI), INP(26), 0, 0);
    tc_job<256>(lds, INP(28), (size_t)DFF * DM, DM, DFF, DM, DEPTH, (bf16_t*)(ws + WS_WMO), nullptr, 0, 0);
    tc_job<256>(lds, INP(14), (size_t)W * W, W, W, W, DEPTH, (bf16_t*)(ws + WS_GLUT), nullptr, 0, 0);
    tc_job<64>(lds, INP(18), (size_t)64 * 64, 64, 64, 64, DEPTH * 4, (bf16_t*)(ws + WS_WAT), nullptr, 0, 64);
    tc_job<64>(lds, INP(20), (size_t)64 * 64, 64, 64, 64, DEPTH * 4, (bf16_t*)(ws + WS_WXT), nullptr, 0, 96);
    const int gid = bid_() * NTHR + opaque_tid();
    if (gid < DEPTH * 1024) {
        const int l = gid >> 10, gp = gid & 1023, g = gp >> 6, p = gp & 63;
        const float lre = INP(6)[gid], lim = INP(7)[gid], dt = expf(INP(8)[l * 16 + g]);
        const float mag = expf(lre * dt), are = mag * cosf(lim * dt), aim = mag * sinf(lim * dt);
        const float den = lre * lre + lim * lim, nre = are - 1.0f, nim = aim;
        const float fre = (nre * lre + nim * lim) / den, fim = (nim * lre - nre * lim) / den;
        ((f32x2*)(ws + WS_ABAR))[gid] = (f32x2){are, aim};
        float pr = are, pi = aim;
#pragma unroll
        for (int s = 0; s < 7; ++s) { const float nr = pr * pr - pi * pi, ni = 2.0f * pr * pi; pr = nr; pi = ni; }
        ((f32x2*)(ws + WS_A128))[gid] = (f32x2){pr, pi};
        const float* bre = INP(9) + (size_t)gid * 16; const float* bim = INP(10) + (size_t)gid * 16;
        bf16_t* bbt = (bf16_t*)(ws + WS_BBT) + ((size_t)(l * 16 + g) * 128 + 2 * p) * 16;
#pragma unroll
        for (int h = 0; h < 16; ++h) { const float br = bre[h], bi = bim[h]; bbt[h] = f2bf(fre * br - fim * bi); bbt[16 + h] = f2bf(fre * bi + fim * br); }
        bf16_t* cmt = (bf16_t*)(ws + WS_CMT) + (size_t)(l * 16 + g) * 16 * 128;
#pragma unroll
        for (int h = 0; h < 16; ++h) { const size_t ci = ((size_t)(l * 16 + g) * 16 + h) * 64 + p; ((unsigned*)cmt)[(h * 128 + 2 * p) >> 1] = pk2(INP(11)[ci], -INP(12)[ci]); }
        const float* wr = INP(2) + ((size_t)l * DM + gp) * NIN + ZW;
        ((f32x4*)(ws + WS_WF))[gid] = *(const f32x4*)wr * INP(1)[gid];
    }
}

template <bool SRCB, int MODE> __device__ __forceinline__ void norm_phase(const void* xsv, const float* g, bf16_t* xb, float* ss2, float* od, const float* wf, const float* bfg, float* logf) {
    const int lane = opaque_tid() & 63, wid = opaque_tid() >> 6;
    const int gw = bid_() * 8 + wid, nw = grid_() * 8;
    for (int row = gw; row < T; row += nw) {
        f32x4 v[4]; float ss = 0.f;
#pragma unroll
        for (int i = 0; i < 4; ++i) {
            if (SRCB) { const bf16x4 q = *(const bf16x4*)((const bf16_t*)xsv + (size_t)row * DM + i * 256 + lane * 4); v[i] = (f32x4){bfs2f(q[0]), bfs2f(q[1]), bfs2f(q[2]), bfs2f(q[3])}; }
            else { v[i] = *(const f32x4*)((const float*)xsv + (size_t)row * DM + i * 256 + lane * 4);
                if (MODE == 1) { u32x2 w; w.x = pk2(v[i][0], v[i][1]); w.y = pk2(v[i][2], v[i][3]); *(u32x2*)(xb + (size_t)row * DM + i * 256 + lane * 4) = w; } }
            ss += v[i][0] * v[i][0] + v[i][1] * v[i][1] + v[i][2] * v[i][2] + v[i][3] * v[i][3]; }
        ss = wave_sum(ss);
        const float rs = rsqrtf(ss * (1.0f / DM) + EPS);
        if (MODE == 1 && !SRCB) { if (lane < 16) ss2[(size_t)row * 16 + lane] = (lane == 0) ? ss : 0.f; }
        float f0 = 0.f, f1 = 0.f, f2 = 0.f, f3 = 0.f;
#pragma unroll
        for (int i = 0; i < 4; ++i) {
            if (MODE == 2) { const f32x4 gg = *(const f32x4*)(g + i * 256 + lane * 4); *(f32x4*)(od + (size_t)row * DM + i * 256 + lane * 4) = v[i] * rs * gg; }
            if (MODE == 1) {
#pragma unroll
                for (int e = 0; e < 4; ++e) { const f32x4 w4 = *(const f32x4*)(wf + (size_t)(i * 256 + lane * 4 + e) * 4); const float hv = v[i][e] * rs; f0 += hv * w4[0]; f1 += hv * w4[1]; f2 += hv * w4[2]; f3 += hv * w4[3]; } }
        }
        if (MODE == 1) {
            f0 = wave_sum(f0); f1 = wave_sum(f1); f2 = wave_sum(f2); f3 = wave_sum(f3);
            if (lane == 0) { f32x4 o; const float fv[4] = {f0 + bfg[0], f1 + bfg[1], f2 + bfg[2], f3 + bfg[3]};
#pragma unroll
                for (int e = 0; e < 4; ++e) o[e] = fminf(fv[e], 0.f) - log1pf(__expf(-fabsf(fv[e])));
                *(f32x4*)(logf + (size_t)row * 4) = o; }
        }
    }
}

__device__ __forceinline__ void cumsum_item(int b, const float* logf, float* cs, unsigned char* lds) {
    LAS float* wt = (LAS float*)lds;
    const int tid = opaque_tid(), lane = tid & 63, wid = tid >> 6;
    f32x4 v[8]; f32x4 run = (f32x4){0.f, 0.f, 0.f, 0.f};
    const float* src = logf + ((size_t)b * SEQ + (size_t)tid * 8) * 4;
#pragma unroll
    for (int e = 0; e < 8; ++e) { run = run + *(const f32x4*)(src + e * 4); v[e] = run; }
    f32x4 inc = run;
#pragma unroll
    for (int d = 1; d < 64; d <<= 1) {
        const int sl = ((lane >= d) ? lane - d : lane) << 2; f32x4 o;
#pragma unroll
        for (int e = 0; e < 4; ++e) o[e] = __uint_as_float((unsigned)__builtin_amdgcn_ds_bpermute(sl, (int)__float_as_uint(inc[e])));
        if (lane >= d) inc = inc + o;
    }
    __syncthreads();
    if (lane == 63) { wt[wid * 4 + 0] = inc[0]; wt[wid * 4 + 1] = inc[1]; wt[wid * 4 + 2] = inc[2]; wt[wid * 4 + 3] = inc[3]; }
    __syncthreads();
    f32x4 off = inc - run;
    for (int w2 = 0; w2 < wid; ++w2) { off[0] += wt[w2 * 4 + 0]; off[1] += wt[w2 * 4 + 1]; off[2] += wt[w2 * 4 + 2]; off[3] += wt[w2 * 4 + 3]; }
    float* dst = cs + ((size_t)b * SEQ + (size_t)tid * 8) * 4;
#pragma unroll
    for (int e = 0; e < 8; ++e) *(f32x4*)(dst + e * 4) = (v[e] + off) * LOG2E;
    __syncthreads();
}

template <int HALF> __device__ __forceinline__ void sgu_item(int l, int b, int c, const Args& a, unsigned char* lds) {
    const bf16_t* z = (const bf16_t*)(ws_() + WS_Z); bf16_t* y = (bf16_t*)(ws_() + WS_Y);
    LAS bf16_t* vn = (LAS bf16_t*)lds;
    LAS float* ssb = (LAS float*)(lds + 69632);
    const int tid = opaque_tid(), lane = tid & 63, wid = tid >> 6, fr = lane & 15, quad = lane >> 4;
    const size_t t0 = (size_t)b * SEQ + (size_t)c * 128;
    const float* ng = INP(3) + l * W;
    __syncthreads();
    const f32x4 gch = *(const f32x4*)(ng + lane * 4);
    constexpr int TPW = HALF ? 16 : 8;
#pragma unroll
    for (int i = 0; i < TPW; ++i) {
        const int s = wid * TPW + i;
        const bf16x4 zv = *(const bf16x4*)(z + (t0 + s) * ZW + ZC_AV + lane * 4);
        float gv[4]; float ss = 0.f;
#pragma unroll
        for (int e = 0; e < 4; ++e) { gv[e] = gelu_t(bfs2f(zv[e])); ss += gv[e] * gv[e]; }
        ss = wave_sum(ss); const float rs = rsqrtf(ss * (1.0f / W) + EPS);
        u32x2 w; w.x = pk2(gv[0] * rs * gch[0], gv[1] * rs * gch[1]); w.y = pk2(gv[2] * rs * gch[2], gv[3] * rs * gch[3]);
        *(LAS u32x2*)(vn + s * 264 + lane * 4) = w;
    }
    __syncthreads();
    const int h = wid & 3;
    const float* wsrc = INP(4) + ((size_t)(l * 4 + h) * 128) * 128;
    const float* bsrc = INP(5) + (size_t)(l * 4 + h) * 128;
    float outv[2][4][4];
#pragma unroll
    for (int i = 0; i < 2; ++i) {
        const int mt = HALF * 4 + (wid >> 2) + 2 * i, t = mt * 16 + fr;
        f32x4 acc[4];
#pragma unroll
        for (int nt = 0; nt < 4; ++nt) acc[nt] = (f32x4){0.f, 0.f, 0.f, 0.f};
        f32x4 wl[4][2];
#pragma unroll
        for (int kk = 0; kk < 4; ++kk) { const int k0 = (kk * 32 < (mt + 1) * 16) ? kk * 32 : 0; const float* wp = wsrc + (size_t)t * 128 + k0 + quad * 8; wl[kk][0] = *(const f32x4*)wp; wl[kk][1] = *(const f32x4*)(wp + 4); }
#pragma unroll
        for (int kk = 0; kk < 4; ++kk) {
            const int k0 = kk * 32;
            if (k0 < (mt + 1) * 16) {
                float wv[8] = {wl[kk][0][0], wl[kk][0][1], wl[kk][0][2], wl[kk][0][3], wl[kk][1][0], wl[kk][1][1], wl[kk][1][2], wl[kk][1][3]};
#pragma unroll
                for (int e = 0; e < 8; ++e) if (k0 + quad * 8 + e > t) wv[e] = 0.f;
                const bf16x8 wf = pack8(wv);
#pragma unroll
                for (int nt = 0; nt < 4; ++nt) {
                    LAS bf16_t* tp = vn + (k0 + quad * 8 + (fr >> 2)) * 264 + h * 64 + nt * 16 + (fr & 3) * 4;
                    const bf16x4 lo = __builtin_bit_cast(bf16x4, __builtin_amdgcn_ds_read_tr16_b64_v4i16((LAS v4i16_t*)tp));
                    const bf16x4 hi = __builtin_bit_cast(bf16x4, __builtin_amdgcn_ds_read_tr16_b64_v4i16((LAS v4i16_t*)(tp + 4 * 264)));
                    const bf16x8 vf = (bf16x8){lo[0], lo[1], lo[2], lo[3], hi[0], hi[1], hi[2], hi[3]};
                    acc[nt] = mfma16(vf, wf, acc[nt]); }
            }
        }
        const float bs = bsrc[t]; float ss = 0.f;
#pragma unroll
        for (int nt = 0; nt < 4; ++nt) { const int ch = h * 64 + nt * 16 + quad * 4; const bf16x4 u4 = *(const bf16x4*)(z + (t0 + t) * ZW + ZC_AU + ch);
#pragma unroll
            for (int r = 0; r < 4; ++r) { const float o = gelu_t(bfs2f(u4[r])) * (acc[nt][r] + bs); outv[i][nt][r] = o; ss += o * o; } }
        ss = quad_sum(ss);
        if (quad == 0) ssb[t * 4 + h] = ss;
    }
    __syncthreads();
#pragma unroll
    for (int i = 0; i < 2; ++i) {
        const int mt = HALF * 4 + (wid >> 2) + 2 * i, t = mt * 16 + fr;
        const float rs = rsqrtf((ssb[t * 4 + 0] + ssb[t * 4 + 1] + ssb[t * 4 + 2] + ssb[t * 4 + 3]) * (1.0f / W) + EPS);
#pragma unroll
        for (int nt = 0; nt < 4; ++nt) { const int ch = h * 64 + nt * 16 + quad * 4; u32x2 w; w.x = pk2(outv[i][nt][0] * rs, outv[i][nt][1] * rs); w.y = pk2(outv[i][nt][2] * rs, outv[i][nt][3] * rs);
            *(u32x2*)(y + (t0 + t) * DM + YC_A + ch) = w; }
    }
    __syncthreads();
}

template <int PASS> __device__ __forceinline__ void s5_item(int l, int b, int c, const Args& a, unsigned char* lds) {
    const bf16_t* z = (const bf16_t*)(ws_() + WS_Z); bf16_t* y = (bf16_t*)(ws_() + WS_Y);
    LAS unsigned char* BU = (LAS unsigned char*)lds;
    LAS unsigned* BU32 = (LAS unsigned*)lds;
    LAS bf16_t* Yb = (LAS bf16_t*)(lds + 65792);
    LAS float* ssb = (LAS float*)(lds + 65792 + 67584);
    const int tid = opaque_tid(), lane = tid & 63, wid = tid >> 6, fr = lane & 15, quad = lane >> 4;
    const int sx0 = wid * 128 + lane, sx1 = sx0 + 64;
    const size_t t0 = (size_t)b * SEQ + (size_t)c * 128;
    const f32x2* abar = (const f32x2*)(ws_() + WS_ABAR) + l * 1024;
    f32x2* eloc = (f32x2*)(ws_() + WS_ELOC);
    float ar[2], ai[2], sre[2], sim[2];
#pragma unroll
    for (int q = 0; q < 2; ++q) { const f32x2 ab = abar[q ? sx1 : sx0]; ar[q] = ab[0]; ai[q] = ab[1]; sre[q] = 0.f; sim[q] = 0.f; }
    if (PASS == 2) {
        const f32x2* a128 = (const f32x2*)(ws_() + WS_A128) + l * 1024;
        const f32x2 p0 = a128[sx0], p1 = a128[sx1];
        for (int cc0 = 0; cc0 < c; cc0 += 8) {
            f32x2 e0[8], e1[8];
#pragma unroll
            for (int u = 0; u < 8; ++u) { const int cc = (cc0 + u < c) ? cc0 + u : c - 1; e0[u] = eloc[((size_t)(b * NCH + cc)) * 1024 + sx0]; e1[u] = eloc[((size_t)(b * NCH + cc)) * 1024 + sx1]; }
#pragma unroll
            for (int u = 0; u < 8; ++u) if (cc0 + u < c) {
                const float nr0 = p0[0] * sre[0] - p0[1] * sim[0] + e0[u][0], ni0 = p0[0] * sim[0] + p0[1] * sre[0] + e0[u][1]; sre[0] = nr0; sim[0] = ni0;
                const float nr1 = p1[0] * sre[1] - p1[1] * sim[1] + e1[u][0], ni1 = p1[0] * sim[1] + p1[1] * sre[1] + e1[u][1]; sre[1] = nr1; sim[1] = ni1; }
        }
    }
    bf16x8 bfrag[2][8];
    const bf16_t* bbt = (const bf16_t*)(ws_() + WS_BBT);
#pragma unroll
    for (int gi = 0; gi < 2; ++gi)
#pragma unroll
        for (int j = 0; j < 8; ++j) bfrag[gi][j] = (quad < 2) ? *(const bf16x8*)(bbt + ((size_t)(l * 16 + wid * 2 + gi) * 128 + j * 16 + fr) * 16 + quad * 8) : zero8();
    bf16x8 cfrag[2][4];
    if (PASS == 2) {
        const bf16_t* cmt = (const bf16_t*)(ws_() + WS_CMT);
#pragma unroll
        for (int gi = 0; gi < 2; ++gi)
#pragma unroll
            for (int ks = 0; ks < 4; ++ks) cfrag[gi][ks] = *(const bf16x8*)(cmt + ((size_t)(l * 16 + wid * 2 + gi) * 16 + fr) * 128 + ks * 32 + quad * 8);
    }
    const float* dsk = INP(13) + l * W;
    __syncthreads();
    bf16x8 ufn[2];
#pragma unroll
    for (int gi = 0; gi < 2; ++gi) ufn[gi] = (quad < 2) ? *(const bf16x8*)(z + (t0 + fr) * ZW + ZC_B + (wid * 2 + gi) * 16 + quad * 8) : zero8();
    for (int sc = 0; sc < 8; ++sc) {
        const size_t tr = t0 + sc * 16 + fr;
        bf16x8 ufc[2] = {ufn[0], ufn[1]};
        bf16x4 u4c[2] = {(bf16x4){0, 0, 0, 0}, (bf16x4){0, 0, 0, 0}};
        if (PASS == 2) {
#pragma unroll
            for (int gi = 0; gi < 2; ++gi) u4c[gi] = *(const bf16x4*)(z + tr * ZW + ZC_B + (wid * 2 + gi) * 16 + quad * 4);
        }
        if (sc < 7) {
#pragma unroll
            for (int gi = 0; gi < 2; ++gi) ufn[gi] = (quad < 2) ? *(const bf16x8*)(z + (tr + 16) * ZW + ZC_B + (wid * 2 + gi) * 16 + quad * 8) : zero8();
        }
#pragma unroll
        for (int gi = 0; gi < 2; ++gi) {
            const int g = wid * 2 + gi;
            const bf16x8 uf = ufc[gi];
#pragma unroll
            for (int j = 0; j < 8; ++j) {
                const f32x4 acc = mfma16(bfrag[gi][j], uf, (f32x4){0.f, 0.f, 0.f, 0.f});
                u32x2 w; w.x = pk2(acc[0], acc[1]); w.y = pk2(acc[2], acc[3]);
                *(LAS u32x2*)(BU + fr * 4112 + (g * 64 + j * 8 + quad * 2) * 4) = w;
            }
        }
        asm volatile("s_waitcnt lgkmcnt(0)" ::: "memory");
        {
            unsigned wv[16][2];
#pragma unroll
            for (int tt = 0; tt < 16; ++tt) { wv[tt][0] = BU32[tt * 1028 + sx0]; wv[tt][1] = BU32[tt * 1028 + sx1]; }
#pragma unroll
            for (int tt = 0; tt < 16; ++tt) {
#pragma unroll
                for (int q = 0; q < 2; ++q) {
                    const unsigned w = wv[tt][q];
                    const f32x2 bu2 = {__uint_as_float(w << 16), __uint_as_float(w & 0xffff0000u)};
                    const f32x2 s2 = {sre[q], sim[q]}, sw = {sim[q], sre[q]}, arr = {ar[q], ar[q]}, aii = {-ai[q], ai[q]};
                    const f32x2 n2 = aii * sw + (arr * s2 + bu2);
                    sre[q] = n2[0]; sim[q] = n2[1];
                    if (PASS == 2) wv[tt][q] = pk2(n2[0], n2[1]);
                }
            }
            if (PASS == 2) {
#pragma unroll
                for (int tt = 0; tt < 16; ++tt) { BU32[tt * 1028 + sx0] = wv[tt][0]; BU32[tt * 1028 + sx1] = wv[tt][1]; }
            }
        }
        asm volatile("s_waitcnt lgkmcnt(0)" ::: "memory");
        if (PASS == 2) {
#pragma unroll
            for (int gi = 0; gi < 2; ++gi) {
                const int g = wid * 2 + gi; f32x4 acc = (f32x4){0.f, 0.f, 0.f, 0.f};
#pragma unroll
                for (int ks = 0; ks < 4; ++ks) { const bf16x8 sf = *(const LAS bf16x8*)(BU + fr * 4112 + g * 256 + (ks * 32 + quad * 8) * 2); acc = mfma16(cfrag[gi][ks], sf, acc); }
                const int ch = g * 16 + quad * 4; const bf16x4 u4 = u4c[gi]; const f32x4 d4 = *(const f32x4*)(dsk + ch);
                float o[4];
#pragma unroll
                for (int r = 0; r < 4; ++r) o[r] = gelu_t(acc[r] + d4[r] * bfs2f(u4[r]));
                u32x2 w; w.x = pk2(o[0], o[1]); w.y = pk2(o[2], o[3]);
                *(LAS u32x2*)(Yb + (sc * 16 + fr) * 264 + ch) = w;
            }
        }
    }
    if (PASS == 1) {
#pragma unroll
        for (int q = 0; q < 2; ++q) eloc[((size_t)(b * NCH + c)) * 1024 + (q ? sx1 : sx0)] = (f32x2){sre[q], sim[q]};
        {
            LAS float* kq = (LAS float*)(lds + 65792);
            const int tok = tid >> 2, hd = tid & 3; float s2 = 0.f;
#pragma unroll
            for (int j = 0; j < 8; ++j) { const bf16x8 kv = *(const bf16x8*)(z + (t0 + tok) * ZW + ZC_K + hd * 64 + j * 8);
#pragma unroll
                for (int e = 0; e < 8; ++e) { const float f = bfs2f(kv[e]); s2 += f * f; } }
            kq[tok * 4 + hd] = s2;
            __syncthreads();
            if (tid < 4) { float mxv = 0.f; for (int i = 0; i < 128; ++i) mxv = fmaxf(mxv, kq[i * 4 + tid]); ((float*)(ws_() + WS_KMAX))[(b * NCH + c) * 4 + tid] = mxv; }
        }
    } else {
        __syncthreads();
        const bf16_t* glut = (const bf16_t*)(ws_() + WS_GLUT) + (size_t)l * W * W;
        const float* glub = INP(15) + l * W;
        bf16x8 gfrag[2][8];
#pragma unroll
        for (int ni = 0; ni < 2; ++ni)
#pragma unroll
            for (int ks = 0; ks < 8; ++ks) gfrag[ni][ks] = *(const bf16x8*)(glut + (size_t)((wid * 2 + ni) * 16 + fr) * W + ks * 32 + quad * 8);
        float outv[8][2][4];
#pragma unroll
        for (int mt = 0; mt < 8; ++mt) {
            f32x4 acc0 = (f32x4){0.f, 0.f, 0.f, 0.f}, acc1 = acc0;
#pragma unroll
            for (int ks = 0; ks < 8; ++ks) { const bf16x8 yf = *(const LAS bf16x8*)(Yb + (mt * 16 + fr) * 264 + ks * 32 + quad * 8); acc0 = mfma16(gfrag[0][ks], yf, acc0); acc1 = mfma16(gfrag[1][ks], yf, acc1); }
            float ss = 0.f;
#pragma unroll
            for (int ni = 0; ni < 2; ++ni) { const int n = (wid * 2 + ni) * 16 + quad * 4; const bf16x4 y4 = *(const LAS bf16x4*)(Yb + (mt * 16 + fr) * 264 + n); const f32x4 gb = *(const f32x4*)(glub + n);
#pragma unroll
                for (int r = 0; r < 4; ++r) { const float gt = (ni == 0 ? acc0[r] : acc1[r]) + gb[r]; const float o = bfs2f(y4[r]) * sigm(gt); outv[mt][ni][r] = o; ss += o * o; } }
            ss = quad_sum(ss);
            if (quad == 0) ssb[(mt * 16 + fr) * 8 + wid] = ss;
        }
        __syncthreads();
#pragma unroll
        for (int mt = 0; mt < 8; ++mt) {
            const int t = mt * 16 + fr; float s = 0.f;
#pragma unroll
            for (int w2 = 0; w2 < 8; ++w2) s += ssb[t * 8 + w2];
            const float rs = rsqrtf(s * (1.0f / W) + EPS);
#pragma unroll
            for (int ni = 0; ni < 2; ++ni) { const int n = (wid * 2 + ni) * 16 + quad * 4; u32x2 w; w.x = pk2(outv[mt][ni][0] * rs, outv[mt][ni][1] * rs); w.y = pk2(outv[mt][ni][2] * rs, outv[mt][ni][3] * rs);
                *(u32x2*)(y + (t0 + t) * DM + YC_B + n) = w; }
        }
    }
    __syncthreads();
}

template <int PASS> __device__ __forceinline__ void lru_item(int l, int b, int c, const Args& a, unsigned char* lds) {
    const bf16_t* z = (const bf16_t*)(ws_() + WS_Z); bf16_t* y = (bf16_t*)(ws_() + WS_Y);
    LAS bf16_t* XC = (LAS bf16_t*)lds;
    LAS float* ssb = (LAS float*)(lds + 67584);
    const int tid = opaque_tid(), lane = tid & 63, wid = tid >> 6, fr = lane & 15, quad = lane >> 4;
    const size_t t0 = (size_t)b * SEQ + (size_t)c * 128;
    float* LAp = (float*)(ws_() + WS_LA); float* LBp = (float*)(ws_() + WS_LB);
    __syncthreads();
    {
        const float* cw = INP(16) + (size_t)l * 4 * W; const float* cb = INP(17) + l * W;
        const int ch0 = (tid & 31) * 8, tk0 = (tid >> 5) * 8;
        bf16x8 xr[11];
#pragma unroll
        for (int j = 0; j < 11; ++j) { const int tt = tk0 - 3 + j;
            xr[j] = (c * 128 + tt >= 0) ? *(const bf16x8*)(z + (size_t)((long)t0 + tt) * ZW + ZC_CX + ch0) : zero8(); }
        float wk[4][8], bk[8];
        { const f32x4 c0 = *(const f32x4*)(cb + ch0), c1 = *(const f32x4*)(cb + ch0 + 4);
#pragma unroll
          for (int e = 0; e < 4; ++e) { bk[e] = c0[e]; bk[4 + e] = c1[e]; }
#pragma unroll
          for (int k = 0; k < 4; ++k) { const f32x4 w0 = *(const f32x4*)(cw + k * W + ch0), w1 = *(const f32x4*)(cw + k * W + ch0 + 4);
#pragma unroll
              for (int e = 0; e < 4; ++e) { wk[k][e] = w0[e]; wk[k][4 + e] = w1[e]; } } }
#pragma unroll
        for (int i = 0; i < 8; ++i) { float acc[8];
#pragma unroll
            for (int e = 0; e < 8; ++e) acc[e] = bk[e] + wk[0][e] * bfs2f(xr[i][e]) + wk[1][e] * bfs2f(xr[i + 1][e]) + wk[2][e] * bfs2f(xr[i + 2][e]) + wk[3][e] * bfs2f(xr[i + 3][e]);
            *(LAS bf16x8*)(XC + (tk0 + i) * 264 + ch0) = pack8(acc); }
    }
    __syncthreads();
    const int hh = wid >> 1;
    const bf16_t* wat = (const bf16_t*)(ws_() + WS_WAT) + (size_t)(l * 4 + hh) * 64 * 64;
    const bf16_t* wxt = (const bf16_t*)(ws_() + WS_WXT) + (size_t)(l * 4 + hh) * 64 * 64;
    bf16x8 waf[2][2], wxf[2][2]; float sp8[2][4], bav[2][4], bxv[2][4], H[2][4], Acar[2][4], Bcar[2][4];
#pragma unroll
    for (int ni = 0; ni < 2; ++ni) {
        const int nl = (wid * 2 + ni) * 16 - hh * 64 + fr;
#pragma unroll
        for (int ks = 0; ks < 2; ++ks) { waf[ni][ks] = *(const bf16x8*)(wat + nl * 64 + ks * 32 + quad * 8); wxf[ni][ks] = *(const bf16x8*)(wxt + nl * 64 + ks * 32 + quad * 8); }
#pragma unroll
        for (int r = 0; r < 4; ++r) { const int ch = (wid * 2 + ni) * 16 + quad * 4 + r;
            sp8[ni][r] = 8.0f * softplus_f(-INP(22)[l * W + ch]); bav[ni][r] = INP(19)[l * W + ch]; bxv[ni][r] = INP(21)[l * W + ch];
            H[ni][r] = 0.f; Acar[ni][r] = 1.f; Bcar[ni][r] = 0.f;
        }
    }
    if (PASS == 2 && c > 0) {
#pragma unroll
        for (int ni = 0; ni < 2; ++ni) {
            const size_t ob = (size_t)(b * NCH) * W + (wid * 2 + ni) * 16 + quad * 4;
            const bool v0 = fr < c, v1 = 16 + fr < c;
            f32x4 a0 = (f32x4){1.f, 1.f, 1.f, 1.f}, b0 = (f32x4){0.f, 0.f, 0.f, 0.f}, a1 = a0, b1 = b0;
            if (v0) { a0 = *(const f32x4*)(LAp + ob + (size_t)fr * W); b0 = *(const f32x4*)(LBp + ob + (size_t)fr * W); }
            if (v1) { a1 = *(const f32x4*)(LAp + ob + (size_t)(16 + fr) * W); b1 = *(const f32x4*)(LBp + ob + (size_t)(16 + fr) * W); }
#pragma unroll
            for (int r = 0; r < 4; ++r) {
                float av = a0[r], bb = b0[r], aw = a1[r], bw = b1[r], ap, bp;
                ap = dpp_shr<1>(av, 1.0f); bp = dpp_shr<1>(bb, 0.0f); bb = av * bp + bb; av = av * ap;   ap = dpp_shr<1>(aw, 1.0f); bp = dpp_shr<1>(bw, 0.0f); bw = aw * bp + bw; aw = aw * ap;
                ap = dpp_shr<2>(av, 1.0f); bp = dpp_shr<2>(bb, 0.0f); bb = av * bp + bb; av = av * ap;   ap = dpp_shr<2>(aw, 1.0f); bp = dpp_shr<2>(bw, 0.0f); bw = aw * bp + bw; aw = aw * ap;
                ap = dpp_shr<4>(av, 1.0f); bp = dpp_shr<4>(bb, 0.0f); bb = av * bp + bb; av = av * ap;   ap = dpp_shr<4>(aw, 1.0f); bp = dpp_shr<4>(bw, 0.0f); bw = aw * bp + bw; aw = aw * ap;
                ap = dpp_shr<8>(av, 1.0f); bp = dpp_shr<8>(bb, 0.0f); bb = av * bp + bb; av = av * ap;   ap = dpp_shr<8>(aw, 1.0f); bp = dpp_shr<8>(bw, 0.0f); bw = aw * bp + bw; aw = aw * ap;
                const float B0t = __shfl(bb, 15, 16), A1t = __shfl(aw, 15, 16), B1t = __shfl(bw, 15, 16);
                H[ni][r] = A1t * B0t + B1t;
            }
        }
    }
    LAS bf16_t* Ob = (LAS bf16_t*)(lds + 67584 + 4096);
#pragma unroll 2
    for (int mt = 0; mt < 8; ++mt) {
        bf16x8 xf[2];
#pragma unroll
        for (int ks = 0; ks < 2; ++ks) xf[ks] = *(const LAS bf16x8*)(XC + (mt * 16 + fr) * 264 + hh * 64 + ks * 32 + quad * 8);
        float ss = 0.f;
#pragma unroll
        for (int ni = 0; ni < 2; ++ni) {
            f32x4 accA = (f32x4){0.f, 0.f, 0.f, 0.f}, accX = accA;
#pragma unroll
            for (int ks = 0; ks < 2; ++ks) { accA = mfma16(waf[ni][ks], xf[ks], accA); accX = mfma16(wxf[ni][ks], xf[ks], accX); }
            const int ch0 = (wid * 2 + ni) * 16 + quad * 4;
            const bf16x4 xc4 = *(const LAS bf16x4*)(XC + (mt * 16 + fr) * 264 + ch0);
            bf16x4 g4 = (bf16x4){0, 0, 0, 0};
            if (PASS == 2) g4 = *(const bf16x4*)(z + (t0 + mt * 16 + fr) * ZW + ZC_CG + ch0);
            float ov[4] = {0.f, 0.f, 0.f, 0.f};
#pragma unroll
            for (int r = 0; r < 4; ++r) {
                const float rg = sigm(accA[r] + bav[ni][r]), ig = sigm(accX[r] + bxv[ni][r]);
                const float la = -rg * sp8[ni][r];
                float av = __builtin_amdgcn_exp2f(LOG2E * la), bb = __builtin_amdgcn_sqrtf(fmaxf(neg_expm1(2.0f * la), 0.f)) * (ig * bfs2f(xc4[r]));
                { float ap, bp;
                  ap = dpp_shr<1>(av, 1.0f); bp = dpp_shr<1>(bb, 0.0f); bb = av * bp + bb; av = av * ap;
                  ap = dpp_shr<2>(av, 1.0f); bp = dpp_shr<2>(bb, 0.0f); bb = av * bp + bb; av = av * ap;
                  ap = dpp_shr<4>(av, 1.0f); bp = dpp_shr<4>(bb, 0.0f); bb = av * bp + bb; av = av * ap;
                  ap = dpp_shr<8>(av, 1.0f); bp = dpp_shr<8>(bb, 0.0f); bb = av * bp + bb; av = av * ap; }
                if (PASS == 1) { const float At = __shfl(av, 15, 16), Bt = __shfl(bb, 15, 16); Bcar[ni][r] = At * Bcar[ni][r] + Bt; Acar[ni][r] *= At; }
                else { const float hv = av * H[ni][r] + bb; H[ni][r] = __shfl(hv, 15, 16); const float o = hv * gelu_t(bfs2f(g4[r])); ov[r] = o; ss += o * o; }
            }
            if (PASS == 2) { u32x2 w; w.x = pk2(ov[0], ov[1]); w.y = pk2(ov[2], ov[3]); *(LAS u32x2*)(Ob + (mt * 16 + fr) * 264 + ch0) = w; }
        }
        if (PASS == 2) { ss = quad_sum(ss); if (quad == 0) ssb[(mt * 16 + fr) * 8 + wid] = ss; }
    }
    if (PASS == 1) {
        if (fr == 0) {
#pragma unroll
            for (int ni = 0; ni < 2; ++ni)
#pragma unroll
                for (int r = 0; r < 4; ++r) { const size_t o = ((size_t)(b * NCH + c)) * W + (wid * 2 + ni) * 16 + quad * 4 + r; LAp[o] = Acar[ni][r]; LBp[o] = Bcar[ni][r]; }
        }
    } else {
        __syncthreads();
#pragma unroll 2
        for (int mt = 0; mt < 8; ++mt) {
            const int t = mt * 16 + fr; float s = 0.f;
#pragma unroll
            for (int w2 = 0; w2 < 8; ++w2) s += ssb[t * 8 + w2];
            const float rs = rsqrtf(s * (1.0f / W) + EPS);
#pragma unroll
            for (int ni = 0; ni < 2; ++ni) { const int n = (wid * 2 + ni) * 16 + quad * 4; const bf16x4 o4 = *(const LAS bf16x4*)(Ob + t * 264 + n);
                u32x2 w; w.x = pk2(bfs2f(o4[0]) * rs, bfs2f(o4[1]) * rs); w.y = pk2(bfs2f(o4[2]) * rs, bfs2f(o4[3]) * rs);
                *(u32x2*)(y + (t0 + t) * DM + YC_C + n) = w; }
        }
    }
    __syncthreads();
}

template <bool DIAG> __device__ __forceinline__ void attn_step2(const LAS unsigned char* buf, int kbase, int qrow0, int quad, int fr, const bf16x8 (&qf)[2][2], float (&m)[2], float (&lsum)[2], f32x4 (&oacc)[2][4]) {
    const LAS bf16_t* Kt = (const LAS bf16_t*)buf; const LAS bf16_t* Vt = (const LAS bf16_t*)(buf + 9216); const LAS float* csl = (const LAS float*)(buf + 18432);
    LAS bf16_t* vtr0 = (LAS bf16_t*)Vt + (quad * 4 + (fr >> 2)) * 72 + (fr & 3) * 4;
    float p[2][4][4];
#pragma unroll
    for (int st = 0; st < 4; ++st) {
        const f32x4 c4 = *(const LAS f32x4*)(csl + st * 16 + quad * 4);
        const bf16x8 kf0 = *(const LAS bf16x8*)(Kt + (st * 16 + fr) * 72 + quad * 8), kf1 = *(const LAS bf16x8*)(Kt + (st * 16 + fr) * 72 + 32 + quad * 8);
#pragma unroll
        for (int qs = 0; qs < 2; ++qs) {
            f32x4 acc = mfma16(kf0, qf[qs][0], c4); acc = mfma16(kf1, qf[qs][1], acc);
#pragma unroll
            for (int r = 0; r < 4; ++r) { float v = acc[r]; if (DIAG && (kbase + st * 16 + quad * 4 + r > qrow0 + qs * 16)) v = -1e30f; p[qs][st][r] = v; }
        }
    }
    bf16x8 pf[2][2];
#pragma unroll
    for (int qs = 0; qs < 2; ++qs) {
        float mx = -1e30f;
#pragma unroll
        for (int st = 0; st < 4; ++st)
#pragma unroll
            for (int r = 0; r < 4; ++r) mx = fmaxf(mx, p[qs][st][r]);
        mx = quad_max(mx);
        if (__any(mx > m[qs])) {
            const float mnew = fmaxf(m[qs], mx), al = __builtin_amdgcn_exp2f(m[qs] - mnew); m[qs] = mnew; lsum[qs] *= al;
#pragma unroll
            for (int dt = 0; dt < 4; ++dt) oacc[qs][dt] = oacc[qs][dt] * al;
        }
        const float mcur = m[qs];
        float ps = 0.f;
#pragma unroll
        for (int st = 0; st < 4; ++st)
#pragma unroll
            for (int r = 0; r < 4; ++r) { const float e = __builtin_amdgcn_exp2f(p[qs][st][r] - mcur); p[qs][st][r] = e; ps += e; }
        lsum[qs] += ps;
#pragma unroll
        for (int ks = 0; ks < 2; ++ks) { u32x4 w; w.x = pk2(p[qs][2 * ks][0], p[qs][2 * ks][1]); w.y = pk2(p[qs][2 * ks][2], p[qs][2 * ks][3]); w.z = pk2(p[qs][2 * ks + 1][0], p[qs][2 * ks + 1][1]); w.w = pk2(p[qs][2 * ks + 1][2], p[qs][2 * ks + 1][3]); pf[qs][ks] = __builtin_bit_cast(bf16x8, w); }
    }
#pragma unroll
    for (int dt = 0; dt < 4; ++dt) {
#pragma unroll
        for (int ks = 0; ks < 2; ++ks) {
            const bf16x4 v0 = __builtin_bit_cast(bf16x4, __builtin_amdgcn_ds_read_tr16_b64_v4i16((LAS v4i16_t*)(vtr0 + (ks * 32) * 72 + dt * 16)));
            const bf16x4 v1 = __builtin_bit_cast(bf16x4, __builtin_amdgcn_ds_read_tr16_b64_v4i16((LAS v4i16_t*)(vtr0 + (ks * 32 + 16) * 72 + dt * 16)));
            const bf16x8 vf = (bf16x8){v0[0], v0[1], v0[2], v0[3], v1[0], v1[1], v1[2], v1[3]};
            oacc[0][dt] = mfma16(vf, pf[0][ks], oacc[0][dt]); oacc[1][dt] = mfma16(vf, pf[1][ks], oacc[1][dt]);
        }
    }
}
__device__ __forceinline__ void attn_unit(int b, int h, int qb, const Args& a, unsigned char* lds) {
    const bf16_t* z = (const bf16_t*)(ws_() + WS_Z); bf16_t* y = (bf16_t*)(ws_() + WS_Y);
    const float* cs = (const float*)(ws_() + WS_CS); float* ssd = (float*)(ws_() + WS_SSD);
    constexpr int ABUF = 9216 + 9216 + 256;
    LAS unsigned char* lb = (LAS unsigned char*)lds;
    const int tid = opaque_tid(), lane = tid & 63, wid = tid >> 6, fr = lane & 15, quad = lane >> 4, grp = wid >> 2, wq = wid & 3;
    const int q0 = qb * 128, qw = q0 + wq * 32, qrow0 = qw + fr;
    const size_t rb = (size_t)b * SEQ;
    bf16x8 qf[2][2];
    {
        const float SC = 0.125f * LOG2E;
#pragma unroll
        for (int qs = 0; qs < 2; ++qs)
#pragma unroll
            for (int ds = 0; ds < 2; ++ds) { const bf16x8 qv = *(const bf16x8*)(z + (rb + qrow0 + qs * 16) * ZW + ZC_Q + h * 64 + ds * 32 + quad * 8); float t8[8];
#pragma unroll
                for (int e = 0; e < 8; ++e) t8[e] = bfs2f(qv[e]) * SC;
                qf[qs][ds] = pack8(t8); }
    }
    float m[2] = {-1e30f, -1e30f}, lsum[2] = {0.f, 0.f}; f32x4 oacc[2][4];
#pragma unroll
    for (int qs = 0; qs < 2; ++qs)
#pragma unroll
        for (int dt = 0; dt < 4; ++dt) oacc[qs][dt] = (f32x4){0.f, 0.f, 0.f, 0.f};
    float qbnd[2];
    {
        float kv = (lane <= qb) ? ((const float*)(ws_() + WS_KMAX))[(b * NCH + lane) * 4 + h] : 0.f;
        kv = wave_max(kv);
        const float kmax = __builtin_amdgcn_sqrtf(kv) * 1.01f + 1e-3f;
#pragma unroll
        for (int qs = 0; qs < 2; ++qs) { float q2 = 0.f;
#pragma unroll
            for (int ds = 0; ds < 2; ++ds)
#pragma unroll
                for (int e = 0; e < 8; ++e) { const float f = bfs2f(qf[qs][ds][e]); q2 += f * f; }
            q2 = quad_sum(q2); qbnd[qs] = (__builtin_amdgcn_sqrtf(q2) * 1.01f + 1e-3f) * kmax; }
    }
    const int NSS = qb + 1;
    volatile LAS unsigned* vote = (volatile LAS unsigned*)(lds + LDS_BYTES - 64);
    if (tid < 3) vote[tid] = 0u;
    bf16x8 kreg[2], vreg[2]; float creg = 0.f;
#define ATT_LOAD(S) do { const size_t kb_ = rb + (size_t)(S) * 128; \
        _Pragma("unroll") for (int p_ = 0; p_ < 2; ++p_) { const int id_ = tid + 512 * p_; \
            kreg[p_] = *(const bf16x8*)(z + (kb_ + (id_ >> 3)) * ZW + ZC_K + h * 64 + (id_ & 7) * 8); \
            vreg[p_] = *(const bf16x8*)(z + (kb_ + (id_ >> 3)) * ZW + ZC_V + h * 64 + (id_ & 7) * 8); } \
        if (tid < 128) creg = cs[(kb_ + tid) * 4 + h]; } while (0)
#define ATT_STORE(S) do { LAS unsigned char* bb_ = lb + ((S) & 1) * (2 * ABUF); \
        _Pragma("unroll") for (int p_ = 0; p_ < 2; ++p_) { const int id_ = tid + 512 * p_; const int k128_ = id_ >> 3; \
            *(LAS bf16x8*)((LAS bf16_t*)(bb_ + (k128_ >> 6) * ABUF) + (k128_ & 63) * 72 + (id_ & 7) * 8) = kreg[p_]; \
            *(LAS bf16x8*)((LAS bf16_t*)(bb_ + (k128_ >> 6) * ABUF + 9216) + (k128_ & 63) * 72 + (id_ & 7) * 8) = vreg[p_]; } \
        if (tid < 128) ((LAS float*)(bb_ + (tid >> 6) * ABUF + 18432))[tid & 63] = -creg; } while (0)
    ATT_LOAD(NSS - 1); ATT_STORE(NSS - 1);
    if (NSS > 1) ATT_LOAD(NSS - 2);
    __syncthreads();
    int kstep = 0;
    for (int S = NSS - 1; S >= 0; --S) {
        if (S >= 1) ATT_STORE(S - 1);
        if (S >= 2) ATT_LOAD(S - 2);
        float cl = 0.f; if (S >= 1) cl = cs[(rb + (size_t)(S - 1) * 128 + 127) * 4 + h];
        const int kbase = S * 128 + grp * 64;
        const LAS unsigned char* hb = lb + (S & 1) * (2 * ABUF) + grp * ABUF;
        if (S + 1 < NSS) attn_step2<false>(hb, kbase, qrow0, quad, fr, qf, m, lsum, oacc);
        else if (kbase <= qw + 31) attn_step2<true>(hb, kbase, qrow0, quad, fr, qf, m, lsum, oacc);
        const bool need = (S >= 1) && ((qbnd[0] - cl - m[0] >= -160.f) || (qbnd[1] - cl - m[1] >= -160.f));
        const int vw = kstep % 3;
        if (need) vote[vw] = 1u;
        __syncthreads();
        const unsigned go = vote[vw];
        if (tid == 0) vote[(kstep + 2) % 3] = 0u;
        ++kstep;
        if (!go) break;
    }
#undef ATT_LOAD
#undef ATT_STORE
    LAS float* mg = (LAS float*)lb;
    const int ml = wq * 64 + lane;
    if (grp == 1) {
#pragma unroll
        for (int qs = 0; qs < 2; ++qs) { mg[(qs * 18 + 0) * 256 + ml] = m[qs]; mg[(qs * 18 + 1) * 256 + ml] = lsum[qs];
#pragma unroll
            for (int dt = 0; dt < 4; ++dt)
#pragma unroll
                for (int r = 0; r < 4; ++r) mg[(qs * 18 + 2 + dt * 4 + r) * 256 + ml] = oacc[qs][dt][r]; }
    }
    __syncthreads();
    if (grp == 0) {
#pragma unroll
        for (int qs = 0; qs < 2; ++qs) {
            const float m1 = mg[(qs * 18 + 0) * 256 + ml], l1 = mg[(qs * 18 + 1) * 256 + ml];
            const float mt = fmaxf(m[qs], m1), f0 = __builtin_amdgcn_exp2f(m[qs] - mt), f1 = __builtin_amdgcn_exp2f(m1 - mt);
            float lt = quad_sum(lsum[qs] * f0 + l1 * f1);
            const float inv = 1.0f / lt; float ss = 0.f;
            const size_t tq = rb + qrow0 + qs * 16;
#pragma unroll
            for (int dt = 0; dt < 4; ++dt) { f32x4 o;
#pragma unroll
                for (int r = 0; r < 4; ++r) { o[r] = (oacc[qs][dt][r] * f0 + mg[(qs * 18 + 2 + dt * 4 + r) * 256 + ml] * f1) * inv; ss += o[r] * o[r]; }
                u32x2 w; w.x = pk2(o[0], o[1]); w.y = pk2(o[2], o[3]); *(u32x2*)(y + tq * DM + YC_D + h * 64 + dt * 16 + quad * 4) = w; }
            ss = quad_sum(ss);
            if (quad == 0) ssd[tq * 4 + h] = ss;
        }
    }
    __syncthreads();
}

#define XB_TMO      128
#define XB_XCNT(j)  (256  + 64 * (j))
#define XB_XSUB(j)  (1280 + 64 * (j))
#define XB_XGEN(j)  (2304 + 64 * (j))
#define XB_TOP      3328
#define XB_TOPGEN   3392
#define XCD_BAR_WORDS 3456
#define XB_SPIN_CAP (1u << 18)

__device__ __forceinline__ unsigned xb_ld(unsigned* p)              { return __hip_atomic_load(p, __ATOMIC_RELAXED, __HIP_MEMORY_SCOPE_AGENT); }
__device__ __forceinline__ unsigned xb_add(unsigned* p, unsigned v) { return __hip_atomic_fetch_add(p, v, __ATOMIC_RELAXED, __HIP_MEMORY_SCOPE_AGENT); }
__device__ __forceinline__ unsigned xb_xcc_id() { return (unsigned)__builtin_amdgcn_s_getreg((3 << 11) | 20) & 0xFu; }
#define XB_SPIN(cond, bar) do { unsigned _sp = 0; while (cond) { __builtin_amdgcn_s_sleep(1); \
    if ((++_sp & 255u) == 0u) { if (xb_ld(&(bar)[XB_TMO])) break; if (_sp > XB_SPIN_CAP) { atomicAdd(&(bar)[XB_TMO], 1u); break; } } } } while (0)

struct XcdBarrier {
    unsigned* bar; unsigned x;
    volatile LAS unsigned* st;
};

__device__ __forceinline__ XcdBarrier xcd_barrier_post(unsigned* bar, volatile LAS unsigned* st) {
    XcdBarrier b; b.bar = bar; b.x = xb_xcc_id(); b.st = st;
    if (opaque_tid() == 0) (void)xb_add(&bar[XB_XCNT(b.x)], 1u);
    return b;
}
__device__ __forceinline__ void xcd_barrier_complete(unsigned* bar, unsigned x, unsigned& nloc, unsigned& nx) {
    const unsigned G = gridDim.x * gridDim.y * gridDim.z;
    unsigned sum, cnt, mine, sp = 0u;
    for (;;) {
        sum = 0u; cnt = 0u; mine = 0u;
#pragma unroll
        for (unsigned j = 0; j < 16; ++j) { const unsigned c = xb_ld(&bar[XB_XCNT(j)]); sum += c; cnt += (c > 0u) ? 1u : 0u; mine = (j == x) ? c : mine; }
        if (sum == G) break;
        __builtin_amdgcn_s_sleep(1);
        if ((++sp & 255u) == 0u) { if (xb_ld(&bar[XB_TMO])) break; if (sp > XB_SPIN_CAP) { atomicAdd(&bar[XB_TMO], 1u); break; } }
    }
    nloc = mine > 0u ? mine : 1u; nx = cnt > 0u ? cnt : 1u;
}

__device__ __forceinline__ void xcd_barrier(const XcdBarrier& b) {
    asm volatile("s_waitcnt vmcnt(0)" ::: "memory");
    __syncthreads();
    if (opaque_tid() == 0) {
        unsigned* bar = b.bar;
        __builtin_amdgcn_s_waitcnt(0);
        unsigned nloc = b.st[0], nx = b.st[1];
        if (nloc == 0u) { xcd_barrier_complete(bar, b.x, nloc, nx); b.st[0] = nloc; b.st[1] = nx; }
        const unsigned old = xb_add(&bar[XB_XSUB(b.x)], 1u);
        const unsigned gen = old / nloc;
        if (old + 1u == (gen + 1u) * nloc) {
            __builtin_amdgcn_fence(__ATOMIC_RELEASE, "agent");
            asm volatile("s_waitcnt vmcnt(0)" ::: "memory");
            const unsigned og = xb_add(&bar[XB_TOP], 1u);
            const unsigned tg = og / nx;
            if (og + 1u == (tg + 1u) * nx) xb_add(&bar[XB_TOPGEN], 1u);
            else XB_SPIN(xb_ld(&bar[XB_TOPGEN]) == tg, bar);
            __builtin_amdgcn_fence(__ATOMIC_ACQUIRE, "agent");
            xb_add(&bar[XB_XGEN(b.x)], 1u);
            asm volatile("s_waitcnt vmcnt(0)" ::: "memory");
        } else {
            XB_SPIN(xb_ld(&bar[XB_XGEN(b.x)]) == gen, bar);
            __builtin_amdgcn_fence(__ATOMIC_ACQUIRE, "agent");
            asm volatile("s_waitcnt vmcnt(0)" ::: "memory");
        }
    }
    __syncthreads();
}

#ifndef WGM_G1
#define WGM_G1 2
#endif
#ifndef WGM_G2
#define WGM_G2 4
#endif
#ifndef WGM_G3
#define WGM_G3 4
#endif
#ifndef WGM_G4
#define WGM_G4 8
#endif
#ifndef PROBE_DUP
#define PROBE_DUP 0
#endif
#ifndef ITEM_MASK
#define ITEM_MASK 127
#endif
__global__ void __launch_bounds__(NTHR, 2) fwd_kernel(Args a) {
    extern __shared__ __attribute__((aligned(16))) unsigned char lds[];
    {
        volatile LAS unsigned* bst0 = (volatile LAS unsigned*)(lds + LDS_BYTES - 16);
        if (opaque_tid() == 0) { bst0[0] = 0u; bst0[1] = 0u; }
        __syncthreads();
        (void)xcd_barrier_post((unsigned*)(ws_() + WS_BAR), bst0);
    }
    if (PH_HI > 4096) cg::this_grid().sync();
#define SEAM(k) do { if ((k) + 1 < PH_HI) { XcdBarrier xb_; xb_.bar = (unsigned*)(ws_() + WS_BAR); xb_.x = xb_xcc_id(); xb_.st = (volatile LAS unsigned*)(lds + LDS_BYTES - 16); xcd_barrier(xb_); if (PROBE_DUP == 1) xcd_barrier(xb_); } } while (0)
#define IN(k) (PH_LO <= (k) && (k) < PH_HI)
    if (IN(0)) { prep_phase(a, lds); if (PROBE_DUP == 4) prep_phase(a, lds); SEAM(0); }
    for (int l = 0; l < DEPTH; ++l) {
        const int pb = 1 + 8 * l;
        if (l == 0 && IN(pb + 0)) {
            norm_phase<false, 1>(INP(0), nullptr, (bf16_t*)(ws_() + WS_H), (float*)(ws_() + WS_SS2), nullptr, (const float*)(ws_() + WS_WF), INP(23), (float*)(ws_() + WS_LOGF));
            SEAM(pb + 0);
        }
        if (IN(pb + 1)) {
            pg8::Gemm g{(const pg8::bf16_t*)(ws_() + WS_H), (const pg8::bf16_t*)(ws_() + WS_WIN) + (size_t)l * ZW * DM, T, ZW, DM}; pg8::StaticOrder S; S.init(T, ZW, grid_(), bid_(), WGM_G1);
            EpiStoreBf16<0, true> E{(bf16_t*)(ws_() + WS_Z), ZW, (const float*)(ws_() + WS_SS2)};
            pg8::gemm_phase<EpiStoreBf16<0, true>, pg8::StaticOrder, true, true>((PG8_LAS unsigned char*)lds, g, S, E);
            if (PROBE_DUP == 9) pg8::gemm_phase<EpiStoreBf16<0, true>, pg8::StaticOrder, true, true>((PG8_LAS unsigned char*)lds, g, S, E);
            if (l > 0) norm_phase<true, 1>(ws_() + WS_H, nullptr, nullptr, nullptr, nullptr, (const float*)(ws_() + WS_WF) + (size_t)l * DM * 4, INP(23) + l * 4, (float*)(ws_() + WS_LOGF));
            SEAM(pb + 1);
        }
        if (IN(pb + 2)) {
            for (int rep = 0; rep < (PROBE_DUP == 2 ? 2 : 1); ++rep)
            for (int it = bid_(); it < 260; it += grid_()) {
                if (it < 128) { if (ITEM_MASK & 1) s5_item<1>(l, it >> 5, it & 31, a, lds); }
                else if (it < 256) { if (ITEM_MASK & 4) lru_item<1>(l, (it - 128) >> 5, (it - 128) & 31, a, lds); }
                else { if (ITEM_MASK & 8) cumsum_item(it - 256, (const float*)(ws_() + WS_LOGF), (float*)(ws_() + WS_CS), lds); }
            }
            SEAM(pb + 2);
        }
        if (IN(pb + 3)) {
            for (int rep = 0; rep < (PROBE_DUP == 3 ? 2 : 1); ++rep) {
            for (int rep2 = 0; rep2 < (PROBE_DUP == 5 ? 2 : 1); ++rep2)
            for (int up = bid_(); up < 256; up += grid_()) {
                const int xcd_ = up & 7, ix_ = up >> 3, pr = xcd_ + 8 * (ix_ >> 4), j = ix_ & 15;
                if (ITEM_MASK & 16) { attn_unit(pr >> 2, pr & 3, 31 - j, a, lds);
                attn_unit(pr >> 2, pr & 3, j, a, lds); }
            }
            for (int rep3 = 0; rep3 < (PROBE_DUP == 6 ? 2 : 1); ++rep3)
            for (int it = bid_(); it < 256; it += grid_()) {
                if (it < 128) { if (ITEM_MASK & 32) s5_item<2>(l, it >> 5, it & 31, a, lds); }
                else { if (ITEM_MASK & 64) lru_item<2>(l, (it - 128) >> 5, (it - 128) & 31, a, lds); }
            }
            if (ITEM_MASK & 2) {
                unsigned* qctr = (unsigned*)(ws_() + WS_BAR) + 3600 + l;
                volatile LAS unsigned* qslot = (volatile LAS unsigned*)(lds + LDS_BYTES - 48);
                for (;;) {
                    __syncthreads();
                    if (opaque_tid() == 0) qslot[0] = __hip_atomic_fetch_add(qctr, 1u, __ATOMIC_RELAXED, __HIP_MEMORY_SCOPE_AGENT);
                    __syncthreads();
                    const unsigned qi = qslot[0];
                    if (qi >= 256u) break;
                    if (qi < 128u) sgu_item<1>(l, (int)(qi >> 5), (int)(qi & 31), a, lds);
                    else sgu_item<0>(l, (int)((qi - 128u) >> 5), (int)(qi & 31), a, lds);
                }
            }
            }
            SEAM(pb + 3);
        }
        if (IN(pb + 4)) {
            pg8::Gemm g{(const pg8::bf16_t*)(ws_() + WS_Y), (const pg8::bf16_t*)(ws_() + WS_WOUT) + (size_t)l * DM * DM, T, DM, DM}; pg8::StaticOrder S; S.init(T, DM, grid_(), bid_(), WGM_G2);
            EpiRes<true, true> E{(bf16_t*)(ws_() + WS_H), DM, (const float*)(ws_() + WS_SSD), (float*)(ws_() + WS_SS2)};
            pg8::gemm_phase<EpiRes<true, true>, pg8::StaticOrder, true, true>((PG8_LAS unsigned char*)lds, g, S, E);
            SEAM(pb + 4);
        }
        if (IN(pb + 6)) {
            pg8::Gemm g{(const pg8::bf16_t*)(ws_() + WS_H), (const pg8::bf16_t*)(ws_() + WS_WMI) + (size_t)l * DFF * DM, T, DFF, DM}; pg8::StaticOrder S; S.init(T, DFF, grid_(), bid_(), WGM_G3);
            EpiStoreBf16<1, true> E{(bf16_t*)(ws_() + WS_ACT), DFF, (const float*)(ws_() + WS_SS2)};
            pg8::gemm_phase<EpiStoreBf16<1, true>, pg8::StaticOrder, true, true>((PG8_LAS unsigned char*)lds, g, S, E);
            SEAM(pb + 6);
        }
        if (IN(pb + 7)) {
            pg8::Gemm g{(const pg8::bf16_t*)(ws_() + WS_ACT), (const pg8::bf16_t*)(ws_() + WS_WMO) + (size_t)l * DM * DFF, T, DM, DFF}; pg8::StaticOrder S; S.init(T, DM, grid_(), bid_(), WGM_G4);
            EpiRes<false, true> E{(bf16_t*)(ws_() + WS_H), DM, nullptr, (float*)(ws_() + WS_SS2)};
            pg8::gemm_phase<EpiRes<false, true>, pg8::StaticOrder, true, true>((PG8_LAS unsigned char*)lds, g, S, E);
            SEAM(pb + 7);
        }
    }
    if (IN(33)) norm_phase<true, 2>(ws_() + WS_H, INP(29), nullptr, nullptr, out_(), nullptr, nullptr, nullptr);
#undef SEAM
#undef IN
}


#ifndef DUMP_SEL
#define DUMP_SEL 0
#endif
#ifndef DUMP_LAST
#define DUMP_LAST 33
#endif
__global__ void dump_kernel(const unsigned char* ws, float* out) {
    const size_t i = (size_t)blockIdx.x * blockDim.x + threadIdx.x;
    const size_t t = i >> 10, c = i & 1023;
    float v = 0.f;
    if (DUMP_SEL == 1) v = bf2f(((const bf16_t*)(ws + WS_H))[i]);
    if (DUMP_SEL == 2) v = bf2f(((const bf16_t*)(ws + WS_Z))[t * ZW + c]) + bf2f(((const bf16_t*)(ws + WS_Z))[t * ZW + c + 1024]);
    if (DUMP_SEL == 3) v = bf2f(((const bf16_t*)(ws + WS_Y))[i]);
    if (DUMP_SEL == 5) v = ((const float*)(ws + WS_SSD))[(t * 4 + (c & 3))] + ((const float*)(ws + WS_CS))[(t * 4 + (c & 3))];
    if (DUMP_SEL == 7) v = ((const float*)(ws + WS_ELOC))[i & 262143];
    if (DUMP_SEL == 8) v = ((const float*)(ws + WS_LA))[i & 32767] + ((const float*)(ws + WS_LB))[i & 32767];
    if (DUMP_SEL == 6) v = bf2f(((const bf16_t*)(ws + WS_WIN))[i]) + bf2f(((const bf16_t*)(ws + WS_WMI))[i]) + bf2f(((const bf16_t*)(ws + WS_WMO))[i]) + bf2f(((const bf16_t*)(ws + WS_WOUT))[i & 0x3fffff]);
    out[i] = v;
}
#ifndef N_LAUNCH_MODE
#define N_LAUNCH_MODE 1
#endif
extern "C" void kernel_launch(void* const* d_in, const int* in_sizes, int n_in, void* d_out, int out_size, void* d_ws, size_t ws_size, hipStream_t stream) {
    static int grid = 0;
    if (grid == 0) {
        if (n_in != 30 || out_size != T * DM || ws_size < WS_END) { fprintf(stderr, "kernel_launch: unexpected shapes (n_in %d, out %d, ws %zu, need %zu)\n", n_in, out_size, ws_size, (size_t)WS_END); grid = -1; return; }
        int dev = 0, cus = 0, per_cu = 0;
        hipGetDevice(&dev); hipDeviceGetAttribute(&cus, hipDeviceAttributeMultiprocessorCount, dev);
        if (hipFuncSetAttribute((const void*)fwd_kernel, hipFuncAttributeMaxDynamicSharedMemorySize, LDS_BYTES) != hipSuccess) { fprintf(stderr, "kernel_launch: hipFuncSetAttribute failed\n"); grid = -1; return; }
        if (hipOccupancyMaxActiveBlocksPerMultiprocessor(&per_cu, (const void*)fwd_kernel, NTHR, LDS_BYTES) != hipSuccess || per_cu < 1) { fprintf(stderr, "kernel_launch: occupancy query says %d\n", per_cu); per_cu = 1; }
        (void)hipGetLastError();
        grid = cus;
        if (grid > 256) grid = 256;
    }
    if (grid < 0) return;
    Args a{};
    for (int i = 0; i < 30; ++i) a.in[i] = (const float*)d_in[i];
    a.out = (float*)d_out; a.ws = (unsigned char*)d_ws;
    if (N_LAUNCH_MODE == 1) {
        a.ph_lo = 0; a.ph_hi = 34;
        if (hipMemsetAsync((unsigned char*)d_ws + WS_BAR, 0, 16 * 1024, stream) != hipSuccess) { fprintf(stderr, "kernel_launch: memset of the barrier words failed\n"); return; }
        void* args[] = {&a};
        hipError_t e = hipLaunchCooperativeKernel((const void*)fwd_kernel, dim3(grid), dim3(NTHR), args, LDS_BYTES, stream);
        if (e != hipSuccess) fprintf(stderr, "kernel_launch: cooperative launch failed: %s (grid %d)\n", hipGetErrorString(e), grid);
    } else {
        for (int ph = 0; ph <= DUMP_LAST; ++ph) { a.ph_lo = ph; a.ph_hi = ph + 1; hipLaunchKernelGGL(fwd_kernel, dim3(grid), dim3(NTHR), LDS_BYTES, stream, a); }
        if (DUMP_SEL != 0 && DUMP_SEL != 4) hipLaunchKernelGGL(dump_kernel, dim3(T * DM / 256), dim3(256), 0, stream, (const unsigned char*)d_ws, (float*)d_out);
    }
}
```

```cpp
#include <hip/hip_runtime.h>
#include <hip/hip_cooperative_groups.h>
#include <cstdio>
#include <cstdint>
namespace cg = cooperative_groups;
__device__ __forceinline__ int opaque_tid() { int t = __builtin_amdgcn_workitem_id_x(); asm volatile("" : "+v"(t)); return t; }
namespace pg8 {
#define PG8_LAS __attribute__((address_space(3)))
typedef unsigned short bf16_t;
typedef short bf16x8 __attribute__((ext_vector_type(8)));
typedef float f32x4 __attribute__((ext_vector_type(4)));
typedef unsigned u32x4 __attribute__((ext_vector_type(4)));
constexpr int BM = 256, BK = 64, HALF = 128, HTB = HALF * BK * 2  , STAGE_BYTES = 8 * HTB, NXCD = 8, WGM = 4;

__host__ __device__ __forceinline__ int lds_byte(int r, int c) { const int st = (r >> 4) * 2 + (c >> 5), rr = r & 15, cc = c & 31, ob = rr * 64 + cc * 2; return st * 1024 + (ob ^ (((ob >> 9) & 1) << 5)); }
__host__ __device__ __forceinline__ void stage_rc(int b, int& R, int& C) { const int st = b / 1024, sb = b % 1024, swz = sb ^ (((sb >> 9) & 1) << 5); R = (st >> 1) * 16 + swz / 64; C = (st & 1) * 32 + (swz % 64) / 2; }
__host__ __device__ __forceinline__ int perm32(int rho) { const int n = rho >> 4, i = rho & 15; return 8 * (i >> 2) + 4 * n + (i & 3); }

struct Unit { int pm, pn; };
struct Gemm { const bf16_t* A; const bf16_t* Bt; int M, N, K; };

struct StaticOrder {
    int nM, nN, nwg, G, c, wgm;
    __host__ __device__ void init(int M, int N, int G_, int c_, int wgm_ = WGM) { nM = M / BM; nN = N / BM; nwg = nM * nN; G = G_; c = c_; wgm = wgm_; }
    __host__ __device__ bool next(int i, Unit& u) const {
        const long L = (long)i * G + c; if (L >= nwg) return false;
        int wgid = (int)L; { const int q = nwg / NXCD, r = nwg % NXCD, xcd = wgid % NXCD, off = wgid / NXCD; wgid = (xcd < r ? xcd * (q + 1) : r * (q + 1) + (xcd - r) * q) + off; }
        const int nig = wgm * nN, gid = wgid / nig, fm = gid * wgm, gsz = (nM - fm) < wgm ? (nM - fm) : wgm;
        u.pm = fm + ((wgid % nig) % gsz); u.pn = (wgid % nig) / gsz; return true;
    }
    __device__ __forceinline__ void a_ready(const Unit&) const {}
    __device__ __forceinline__ void done(const Unit&) const {}
};

__device__ __forceinline__ unsigned cvt_pk_bf16(float lo, float hi) { unsigned r; asm volatile("v_cvt_pk_bf16_f32 %0, %1, %2" : "=v"(r) : "v"(lo), "v"(hi)); return r; }
template <class Epi, class Sched, bool ALIGN_EPI = false, bool SP2 = false>
__device__ __forceinline__ void gemm_phase(PG8_LAS unsigned char* lds, const Gemm g, const Sched& S, const Epi& E) {
    const int tid = opaque_tid(), wid = __builtin_amdgcn_readfirstlane(tid >> 6), lane = tid & 63, wr = wid >> 2, wc = wid & 3, fr = lane & 15, fq = lane >> 4;
    const int K = g.K, nt = K / BK;
    unsigned voffA[2], voffB[2];
#pragma unroll
    for (int i = 0; i < 2; ++i) { int R, C; stage_rc(tid * 16 + i * 8192, R, C); const int Rb = Epi::PERM ? ((R & ~31) + perm32(R & 31)) : R;
        voffA[i] = (unsigned)(R * K + C) * 2u; voffB[i] = (unsigned)(Rb * K + C) * 2u; }
    const size_t kstep = (size_t)(BK * 2);
    const size_t hstep = (size_t)HALF * K * 2;
    const size_t tstep = 2 * hstep;
    const unsigned ldsw = (unsigned)wid * 1024u;
    const int aoff = lds_byte(wr * 64 + fr, fq * 8), boff = lds_byte(wc * 32 + fr, fq * 8);
#define PG8_SA(b, h) (((b) * 2 + (h)) * HTB)
#define PG8_SB(b, h) ((4 + (b) * 2 + (h)) * HTB)
#define PG8_STAGE(bufoff, gbase, voff) do { _Pragma("unroll") for (int _i = 0; _i < 2; ++_i) \
        __builtin_amdgcn_global_load_lds((const unsigned*)((const char*)(gbase) + (voff)[_i]), (PG8_LAS unsigned*)(lds + (bufoff) + ldsw + _i * 8192), 16, 0, 0); } while (0)
#define PG8_LDA(dst, b, h) do { _Pragma("unroll") for (int m = 0; m < 4; ++m) _Pragma("unroll") for (int k = 0; k < 2; ++k) dst[m][k] = *(const PG8_LAS bf16x8*)(lds + PG8_SA(b, h) + aoff + m * 2048 + k * 1024); } while (0)
#define PG8_LDB(dst, b, h) do { _Pragma("unroll") for (int n = 0; n < 2; ++n) _Pragma("unroll") for (int k = 0; k < 2; ++k) dst[n][k] = *(const PG8_LAS bf16x8*)(lds + PG8_SB(b, h) + boff + n * 2048 + k * 1024); } while (0)
#define PG8_MMA(ai, bj, At, Bt) do { __builtin_amdgcn_s_setprio(1); _Pragma("unroll") for (int m = 0; m < 4; ++m) _Pragma("unroll") for (int n = 0; n < 2; ++n) _Pragma("unroll") for (int k = 0; k < 2; ++k) \
        acc[ai][bj][m][n] = __builtin_amdgcn_mfma_f32_16x16x32_bf16(Bt[n][k], At[m][k], acc[ai][bj][m][n], 0, 0, 0); __builtin_amdgcn_s_setprio(0); } while (0)
#define PG8_WAIT_V(n) asm volatile("s_waitcnt vmcnt(" #n ")" ::: "memory")
#define PG8_WAIT_L(n) asm volatile("s_waitcnt lgkmcnt(" #n ")" ::: "memory")
#define PG8_BAR __builtin_amdgcn_s_barrier()
#define PG8_SCHED __builtin_amdgcn_sched_barrier(0)
    Unit cur, nxt; int ui = 0;
    if (!S.next(0, cur)) return;
    if constexpr (Epi::KPREP) { Unit pu; for (int i = 0; i < 12 && S.next(i, pu); ++i) E.kprep(pu, lds + STAGE_BYTES + i * 1024, tid); }
    f32x4 acc[2][2][4][2];
#pragma unroll
    for (int a = 0; a < 2; ++a)
#pragma unroll
        for (int b = 0; b < 2; ++b)
#pragma unroll
            for (int m = 0; m < 4; ++m)
#pragma unroll
                for (int n = 0; n < 2; ++n) acc[a][b][m][n] = (f32x4){0.f, 0.f, 0.f, 0.f};
    bf16x8 At[4][2], B0[2][2], B1[2][2];
    const char* cA = (const char*)g.A + (size_t)cur.pm * tstep; const char* cB = (const char*)g.Bt + (size_t)cur.pn * tstep;
    S.a_ready(cur);
    if constexpr (SP2) {
        PG8_STAGE(PG8_SB(0, 0), cB, voffB); PG8_STAGE(PG8_SB(0, 1), cB + hstep, voffB); PG8_STAGE(PG8_SA(0, 0), cA, voffA); PG8_STAGE(PG8_SA(0, 1), cA + hstep, voffA);
        if (wr == 1) PG8_BAR;
        PG8_WAIT_V(2); PG8_BAR;
        PG8_STAGE(PG8_SB(1, 0), cB + kstep, voffB); PG8_STAGE(PG8_SA(1, 0), cA + kstep, voffA); PG8_STAGE(PG8_SB(1, 1), cB + hstep + kstep, voffB);
        PG8_WAIT_V(6); PG8_BAR;
    } else {
        PG8_STAGE(PG8_SB(0, 0), cB, voffB); PG8_STAGE(PG8_SA(0, 0), cA, voffA); PG8_STAGE(PG8_SB(0, 1), cB + hstep, voffB); PG8_STAGE(PG8_SA(0, 1), cA + hstep, voffA);
        if (wr == 1) PG8_BAR;
        PG8_WAIT_V(4); PG8_BAR;
        PG8_STAGE(PG8_SB(1, 0), cB + kstep, voffB); PG8_STAGE(PG8_SA(1, 0), cA + kstep, voffA); PG8_STAGE(PG8_SB(1, 1), cB + hstep + kstep, voffB);
        PG8_WAIT_V(6); PG8_BAR;
    }
    for (;;) {
        const bool has_next = S.next(ui + 1, nxt);
        const char* nA = has_next ? (const char*)g.A + (size_t)nxt.pm * tstep : cA; const char* nB = has_next ? (const char*)g.Bt + (size_t)nxt.pn * tstep : cB;
        for (int t = 0; t < nt; t += 2) {
            const bool last = (t == nt - 2);
            const char* a1 = cA + (size_t)(t + 1) * kstep;
            const char* a2 = last ? nA : cA + (size_t)(t + 2) * kstep; const char* b2 = last ? nB : cB + (size_t)(t + 2) * kstep;
            const char* a3 = a2 + kstep; const char* b3 = b2 + kstep;
            if (last && has_next) S.a_ready(nxt);
            if constexpr (SP2) {
            PG8_LDB(B0, 0, 0); PG8_LDB(B1, 0, 1); PG8_SCHED; PG8_LDA(At, 0, 0); PG8_STAGE(PG8_SA(1, 1), a1 + hstep, voffA);
            PG8_WAIT_V(8); PG8_WAIT_L(0); PG8_BAR; PG8_MMA(0, 0, At, B0); PG8_MMA(0, 1, At, B1); PG8_BAR; PG8_SCHED;
            PG8_LDA(At, 0, 1); PG8_STAGE(PG8_SB(0, 0), b2, voffB); PG8_STAGE(PG8_SB(0, 1), b2 + hstep, voffB); PG8_STAGE(PG8_SA(0, 0), a2, voffA);
            PG8_WAIT_V(8); PG8_WAIT_L(0); PG8_BAR; PG8_MMA(1, 0, At, B0); PG8_MMA(1, 1, At, B1); PG8_BAR; PG8_SCHED;
            PG8_LDB(B0, 1, 0); PG8_LDB(B1, 1, 1); PG8_SCHED; PG8_LDA(At, 1, 0); PG8_STAGE(PG8_SA(0, 1), a2 + hstep, voffA);
            PG8_WAIT_V(8); PG8_WAIT_L(0); PG8_BAR; PG8_MMA(0, 0, At, B0); PG8_MMA(0, 1, At, B1); PG8_BAR; PG8_SCHED;
            PG8_LDA(At, 1, 1); PG8_STAGE(PG8_SB(1, 0), b3, voffB); PG8_STAGE(PG8_SB(1, 1), b3 + hstep, voffB); PG8_STAGE(PG8_SA(1, 0), a3, voffA);
            PG8_WAIT_V(8); PG8_WAIT_L(0); PG8_BAR; PG8_MMA(1, 0, At, B0); PG8_MMA(1, 1, At, B1); PG8_BAR; PG8_SCHED;
            } else {
            PG8_LDB(B0, 0, 0); PG8_SCHED; PG8_LDA(At, 0, 0); PG8_STAGE(PG8_SA(1, 1), a1 + hstep, voffA);
            PG8_WAIT_L(8); PG8_BAR; PG8_WAIT_L(0); PG8_MMA(0, 0, At, B0); PG8_BAR; PG8_SCHED;
            PG8_LDB(B1, 0, 1); PG8_STAGE(PG8_SB(0, 0), b2, voffB);
            PG8_BAR; PG8_WAIT_L(0); PG8_MMA(0, 1, At, B1); PG8_BAR;
            PG8_LDA(At, 0, 1); PG8_STAGE(PG8_SA(0, 0), a2, voffA);
            PG8_BAR; PG8_WAIT_L(0); PG8_MMA(1, 0, At, B0); PG8_BAR; PG8_SCHED;
            PG8_STAGE(PG8_SB(0, 1), b2 + hstep, voffB);
            PG8_WAIT_V(6); PG8_BAR; PG8_MMA(1, 1, At, B1); PG8_BAR;
            PG8_LDB(B0, 1, 0); PG8_SCHED; PG8_LDA(At, 1, 0); PG8_STAGE(PG8_SA(0, 1), a2 + hstep, voffA);
            PG8_WAIT_L(8); PG8_BAR; PG8_WAIT_L(0); PG8_MMA(0, 0, At, B0); PG8_BAR; PG8_SCHED;
            PG8_LDB(B1, 1, 1); PG8_STAGE(PG8_SB(1, 0), b3, voffB);
            PG8_BAR; PG8_WAIT_L(0); PG8_MMA(0, 1, At, B1); PG8_BAR;
            PG8_LDA(At, 1, 1); PG8_STAGE(PG8_SA(1, 0), a3, voffA);
            PG8_BAR; PG8_WAIT_L(0); PG8_MMA(1, 0, At, B0); PG8_BAR; PG8_SCHED;
            PG8_STAGE(PG8_SB(1, 1), b3 + hstep, voffB);
            PG8_WAIT_V(6); PG8_BAR; PG8_MMA(1, 1, At, B1); PG8_BAR;
            }
            if constexpr (Epi::KHOOK) { if (t == 2) E.khook(acc, lds + STAGE_BYTES + ui * 1024, wr, fr); }
        }
        if constexpr (ALIGN_EPI) { if (wr == 0) PG8_BAR; }
        if constexpr (!Epi::AFTER_DRAIN) { E(acc, cur, wr, wc, fr, fq, lds + STAGE_BYTES + ui * 1024); S.done(cur); }
        if (!has_next) break;
#pragma unroll
        for (int a = 0; a < 2; ++a)
#pragma unroll
            for (int b = 0; b < 2; ++b)
#pragma unroll
                for (int m = 0; m < 4; ++m)
#pragma unroll
                    for (int n = 0; n < 2; ++n) acc[a][b][m][n] = (f32x4){0.f, 0.f, 0.f, 0.f};
        cur = nxt; cA = nA; cB = nB; ++ui;
        if constexpr (ALIGN_EPI) { if (wr == 1) PG8_BAR; }
    }
    PG8_WAIT_V(0);
    if constexpr (!ALIGN_EPI) { if (wr == 0) PG8_BAR; }
    PG8_BAR;
    if constexpr (Epi::AFTER_DRAIN) { E.fused(acc, cur, wr, wc, fr, fq, lds, wid, lane); S.done(cur); }
#undef PG8_SA
#undef PG8_SB
#undef PG8_STAGE
#undef PG8_LDA
#undef PG8_LDB
#undef PG8_MMA
#undef PG8_WAIT_V
#undef PG8_WAIT_L
#undef PG8_BAR
#undef PG8_SCHED
}
}

#define LAS __attribute__((address_space(3)))
typedef unsigned short bf16_t;
typedef short bf16x8 __attribute__((ext_vector_type(8)));
typedef short bf16x4 __attribute__((ext_vector_type(4)));
typedef float f32x4 __attribute__((ext_vector_type(4)));
typedef float f32x2 __attribute__((ext_vector_type(2)));
typedef unsigned u32x4 __attribute__((ext_vector_type(4)));
typedef unsigned u32x2 __attribute__((ext_vector_type(2)));
typedef short v4i16_t __attribute__((ext_vector_type(4)));

constexpr int NB = 4, SEQ = 4096, DM = 1024, DEPTH = 4, T = NB * SEQ, W = 256, DFF = 4096, NIN = 2052, ZW = 2048;
constexpr int NCH = SEQ / 128;
constexpr float EPS = 1e-6f;
constexpr float LOG2E = 1.4426950408889634f;
constexpr int NTHR = 512;
constexpr int LDS_BYTES = 147456;
constexpr int ZC_AU = 0, ZC_AV = 256, ZC_B = 512, ZC_CX = 768, ZC_CG = 1024, ZC_Q = 1280, ZC_K = 1536, ZC_V = 1792;
constexpr int YC_D = 0, YC_A = 256, YC_B = 512, YC_C = 768;

constexpr size_t MiB = 1u << 20;
constexpr size_t WS_WIN = 0, WS_WOUT = 16 * MiB, WS_WMI = 24 * MiB, WS_WMO = 56 * MiB, WS_R = 88 * MiB, WS_Z = WS_R, WS_Y = WS_R + 64 * MiB, WS_ACT = WS_R,
                 WS_H = 216 * MiB, WS_S = 248 * MiB;
constexpr size_t WS_GLUT = WS_S, WS_WAT = WS_GLUT + 512 * 1024, WS_WXT = WS_WAT + 128 * 1024, WS_BBT = WS_WXT + 128 * 1024, WS_CMT = WS_BBT + 256 * 1024,
                 WS_ABAR = WS_CMT + 256 * 1024, WS_A128 = WS_ABAR + 32 * 1024, WS_WF = WS_A128 + 32 * 1024, WS_LOGF = WS_WF + 64 * 1024, WS_CS = WS_LOGF + 256 * 1024,
                 WS_SSD = WS_CS + 256 * 1024, WS_ELOC = WS_SSD + 256 * 1024, WS_LA = WS_ELOC + 1024 * 1024, WS_LB = WS_LA + 128 * 1024, WS_BAR = WS_LB + 128 * 1024, WS_SS2 = WS_BAR + 16 * 1024, WS_KMAX = WS_SS2 + 1024 * 1024, WS_END = WS_KMAX + 4096;

struct Args {
    const float* in[30]; float* out; unsigned char* ws; int ph_lo, ph_hi;
};


typedef const __attribute__((address_space(4))) unsigned long long* kargp_t;
__device__ __forceinline__ unsigned long long karg_(int i) { kargp_t tab = (kargp_t)__builtin_amdgcn_kernarg_segment_ptr(); asm volatile("" : "+s"(tab)); return tab[i]; }
#define INP(i) ((const float*)karg_(i))
__device__ __forceinline__ unsigned char* ws_() { return (unsigned char*)karg_(31); }
__device__ __forceinline__ float* out_() { return (float*)karg_(30); }
#define PH_LO ((int)(unsigned)(karg_(32) & 0xffffffffull))
#define PH_HI ((int)(unsigned)(karg_(32) >> 32))
__device__ __forceinline__ int bid_() { return blockIdx.x; }
__device__ __forceinline__ int grid_() { return gridDim.x; }
__device__ __forceinline__ float bf2f(bf16_t v) { return __uint_as_float((unsigned)v << 16); }
__device__ __forceinline__ float bfs2f(short v) { return __uint_as_float(((unsigned)(unsigned short)v) << 16); }
typedef __bf16 bf16x2_t __attribute__((ext_vector_type(2)));
__device__ __forceinline__ unsigned pk2(float lo, float hi) { const f32x2 v = {lo, hi}; const bf16x2_t b = __builtin_convertvector(v, bf16x2_t); return __builtin_bit_cast(unsigned, b); }
__device__ __forceinline__ bf16_t f2bf(float f) { return (bf16_t)(pk2(f, 0.f) & 0xffffu); }
__device__ __forceinline__ float gelu_t(float x) { const float y2 = (1.5957691216057308f * LOG2E) * (x + 0.044715f * x * x * x); return x * __builtin_amdgcn_rcpf(1.0f + __builtin_amdgcn_exp2f(-y2)); }
__device__ __forceinline__ float sigm(float x) { return __builtin_amdgcn_rcpf(1.0f + __builtin_amdgcn_exp2f(-LOG2E * x)); }
__device__ __forceinline__ float softplus_f(float x) { return fmaxf(x, 0.f) + log1pf(__expf(-fabsf(x))); }
__device__ __forceinline__ f32x4 mfma16(bf16x8 a, bf16x8 b, f32x4 c) { return __builtin_amdgcn_mfma_f32_16x16x32_bf16(a, b, c, 0, 0, 0); }
__device__ __forceinline__ float quad_sum(float v) {
    { const auto r = __builtin_amdgcn_permlane16_swap(__float_as_uint(v), __float_as_uint(v), false, false); v = __uint_as_float(r[0]) + __uint_as_float(r[1]); }
    { const auto r = __builtin_amdgcn_permlane32_swap(__float_as_uint(v), __float_as_uint(v), false, false); v = __uint_as_float(r[0]) + __uint_as_float(r[1]); }
    return v;
}
template <int CTRL> __device__ __forceinline__ float dpp_mov(float x) { return __uint_as_float((unsigned)__builtin_amdgcn_update_dpp(0, (int)__float_as_uint(x), CTRL, 0xf, 0xf, true)); }
__device__ __forceinline__ float wave_sum(float v) {
    v += dpp_mov<0xB1>(v); v += dpp_mov<0x4E>(v); v += dpp_mov<0x141>(v); v += dpp_mov<0x140>(v);
    return quad_sum(v);
}
__device__ __forceinline__ float wave_max(float v);
__device__ __forceinline__ float quad_max(float v) {
    { const auto r = __builtin_amdgcn_permlane16_swap(__float_as_uint(v), __float_as_uint(v), false, false); v = fmaxf(__uint_as_float(r[0]), __uint_as_float(r[1])); }
    { const auto r = __builtin_amdgcn_permlane32_swap(__float_as_uint(v), __float_as_uint(v), false, false); v = fmaxf(__uint_as_float(r[0]), __uint_as_float(r[1])); }
    return v;
}
__device__ __forceinline__ bf16x8 pack8(const float* v) {
    u32x4 w; w.x = pk2(v[0], v[1]); w.y = pk2(v[2], v[3]); w.z = pk2(v[4], v[5]); w.w = pk2(v[6], v[7]); return __builtin_bit_cast(bf16x8, w);
}
__device__ __forceinline__ bf16x8 zero8() { return (bf16x8){0, 0, 0, 0, 0, 0, 0, 0}; }

__device__ __forceinline__ float wave_max(float v) {
    v = fmaxf(v, dpp_mov<0xB1>(v)); v = fmaxf(v, dpp_mov<0x4E>(v)); v = fmaxf(v, dpp_mov<0x141>(v)); v = fmaxf(v, dpp_mov<0x140>(v));
    return quad_max(v);
}
template <int N> __device__ __forceinline__ float dpp_shr(float x, float ident) {
    return __uint_as_float((unsigned)__builtin_amdgcn_update_dpp((int)__float_as_uint(ident), (int)__float_as_uint(x), 0x110 + N, 0xf, 0xf, false));
}
__device__ __forceinline__ float neg_expm1(float x) {
    const float s = -x * (1.0f + x * (0.5f + x * (0.16666667f + x * (0.041666668f + x * (0.0083333338f + x * 0.0013888889f)))));
    const float e = 1.0f - __builtin_amdgcn_exp2f(LOG2E * x);
    return (x > -0.25f) ? s : e;
}
template <int ACT  , bool ROWS = false> struct EpiStoreBf16 {
    static constexpr bool PERM = true, AFTER_DRAIN = false, KHOOK = false, KPREP = ROWS;
    __device__ __forceinline__ void kprep(const pg8::Unit& u, PG8_LAS unsigned char* tab, int tid) const {
        if (tid < 256) { const float* rp = rowss + (size_t)(u.pm * 256 + tid) * 16; const f32x4 s0 = *(const f32x4*)rp, s1 = *(const f32x4*)(rp + 4), s2 = *(const f32x4*)(rp + 8), s3 = *(const f32x4*)(rp + 12);
            const float tot = ((s0[0] + s0[1]) + (s0[2] + s0[3])) + ((s1[0] + s1[1]) + (s1[2] + s1[3])) + ((s2[0] + s2[1]) + (s2[2] + s2[3])) + ((s3[0] + s3[1]) + (s3[2] + s3[3]));
            ((PG8_LAS float*)tab)[tid] = rsqrtf(tot * (1.0f / DM) + EPS); }
    }
    bf16_t* O; int ldc; const float* rowss;
    __device__ __forceinline__ void operator()(const pg8::f32x4 (&acc)[2][2][4][2], const pg8::Unit& u, int wr, int wc, int fr, int fq, PG8_LAS unsigned char* tab) const {
        const int row0 = u.pm * 256 + wr * 64 + fr, col0 = u.pn * 256 + wc * 32 + 8 * fq;
#pragma unroll
        for (int ai = 0; ai < 2; ++ai)
#pragma unroll
            for (int m = 0; m < 4; ++m) { bf16_t* rowp = O + (size_t)(row0 + ai * 128 + m * 16) * ldc + col0;
                const float rsc = ROWS ? ((const PG8_LAS float*)tab)[wr * 64 + fr + ai * 128 + m * 16] : 1.0f;
#pragma unroll
                for (int bj = 0; bj < 2; ++bj) { pg8::f32x4 v0 = acc[ai][bj][m][0] * rsc, v1 = acc[ai][bj][m][1] * rsc;
                    if (ACT == 1) {
#pragma unroll
                        for (int e = 0; e < 4; ++e) { const float a = fmaxf(v0[e], 0.f), b = fmaxf(v1[e], 0.f); v0[e] = a * a; v1[e] = b * b; } }
                    u32x4 w; w.x = pk2(v0[0], v0[1]); w.y = pk2(v0[2], v0[3]); w.z = pk2(v1[0], v1[1]); w.w = pk2(v1[2], v1[3]);
                    *(u32x4*)(rowp + bj * 128) = w; } }
    }
};
template <bool HOOK, bool NORMOUT> struct EpiRes {
    static constexpr bool PERM = true, AFTER_DRAIN = false, KHOOK = HOOK, KPREP = HOOK;
    bf16_t* xb; int ldc; const float* ssd; float* ss2;
    __device__ __forceinline__ void operator()(const pg8::f32x4 (&acc)[2][2][4][2], const pg8::Unit& u, int wr, int wc, int fr, int fq, PG8_LAS unsigned char* tab) const {
        const int col0 = u.pn * 256 + wc * 32 + 8 * fq;
#pragma unroll
        for (int ai = 0; ai < 2; ++ai)
#pragma unroll
            for (int m = 0; m < 4; ++m) { const int row = u.pm * 256 + ai * 128 + wr * 64 + m * 16 + fr; bf16_t* rowp = xb + (size_t)row * ldc + col0; float sq = 0.f;
#pragma unroll
                for (int bj = 0; bj < 2; ++bj) { const bf16x8 s = *(const bf16x8*)(rowp + bj * 128); float o[8];
#pragma unroll
                    for (int e = 0; e < 4; ++e) { o[e] = bfs2f(s[e]) + acc[ai][bj][m][0][e]; o[4 + e] = bfs2f(s[4 + e]) + acc[ai][bj][m][1][e]; }
                    if (NORMOUT) {
#pragma unroll
                        for (int e = 0; e < 8; ++e) sq += o[e] * o[e]; }
                    *(bf16x8*)(rowp + bj * 128) = pack8(o); }
                if (NORMOUT) { sq = quad_sum(sq); if (fq == 0) ss2[(size_t)row * 16 + u.pn * 4 + wc] = sq; }
                if (m & 1) asm volatile("" ::: "memory"); }
    }
    __device__ __forceinline__ void kprep(const pg8::Unit& u, PG8_LAS unsigned char* tab, int tid) const {
        if (tid < 256) { const f32x4 s4 = *(const f32x4*)(ssd + (size_t)(u.pm * 256 + tid) * 4); ((PG8_LAS float*)tab)[tid] = rsqrtf((s4[0] + s4[1] + s4[2] + s4[3]) * (1.0f / 256.0f) + EPS); }
    }
    __device__ __forceinline__ void khook(pg8::f32x4 (&acc)[2][2][4][2], PG8_LAS unsigned char* tab, int wr, int fr) const {
#pragma unroll
        for (int ai = 0; ai < 2; ++ai)
#pragma unroll
            for (int m = 0; m < 4; ++m) { const float rs = ((const PG8_LAS float*)tab)[ai * 128 + wr * 64 + m * 16 + fr];
#pragma unroll
                for (int bj = 0; bj < 2; ++bj)
#pragma unroll
                    for (int n = 0; n < 2; ++n) acc[ai][bj][m][n] *= rs; }
    }
};

template <int TN> __device__ __forceinline__ void tc_job(unsigned char* lds, const float* src, size_t sb, int ld, int K, int N, int nbatch, bf16_t* dst, const float* gain, int kshift, int rot) {
    LAS float* tile = (LAS float*)lds;
    constexpr int CG = TN / 64, NLD = TN / 32  , NST = TN / 64  ;
    const int tid = opaque_tid(), nk = K / 64, nn = N / TN, ntile = nbatch * nk * nn;
    for (int ti = (int)((bid_() + grid_() - (rot % grid_())) % grid_()); ti < ntile; ti += grid_()) {
        const int b = ti / (nk * nn), rem = ti % (nk * nn), kt = rem / nn, nt = rem % nn;
        const float* s = src + (size_t)b * sb + (size_t)(kt * 64) * ld + nt * TN;
        f32x4 v[NLD];
#pragma unroll
        for (int p = 0; p < NLD; ++p) { const int idx = tid + 512 * p, c16 = idx & 15, kq = (idx >> 4) & 3, rest = idx >> 6, kl = (rest / CG) * 4 + kq, n4 = ((rest % CG) * 16 + c16) * 4;
            v[p] = *(const f32x4*)(s + (size_t)kl * ld + n4);
            if (gain) { const float gg = gain[(size_t)b * K + kt * 64 + kl]; v[p] = v[p] * gg; } }
        __syncthreads();
#pragma unroll
        for (int p = 0; p < NLD; ++p) { const int idx = tid + 512 * p, c16 = idx & 15, kq = (idx >> 4) & 3, rest = idx >> 6, kl = (rest / CG) * 4 + kq, n4 = ((rest % CG) * 16 + c16) * 4;
            tile[kl * (TN + 1) + n4 + 0] = v[p][0]; tile[kl * (TN + 1) + n4 + 1] = v[p][1]; tile[kl * (TN + 1) + n4 + 2] = v[p][2]; tile[kl * (TN + 1) + n4 + 3] = v[p][3]; }
        __syncthreads();
#pragma unroll
        for (int p = 0; p < NST; ++p) { const int idx = tid + 512 * p, nl = idx >> 3, kc = (idx & 7) * 8; float o[8];
#pragma unroll
            for (int e = 0; e < 8; ++e) o[e] = tile[(kc + e) * (TN + 1) + nl];
            const int kd = (kt * 64 + kc + kshift) % K;
            *(bf16x8*)(dst + (size_t)b * N * K + (size_t)(nt * TN + nl) * K + kd) = pack8(o); }
    }
    __syncthreads();
}

__device__ __forceinline__ void prep_phase(const Args& a, unsigned char* lds) {
    unsigned char* ws = ws_();
    tc_job<256>(lds, INP(2), (size_t)DM * NIN, NIN, DM, ZW, DEPTH, (bf16_t*)(ws + WS_WIN), INP(1), 0, 0);
    tc_job<256>(lds, INP(25), (size_t)DM * DM, DM, DM, DM, DEPTH, (bf16_t*)(ws + WS_WOUT), INP(24), 256, 0);
    tc_job<256>(lds, INP(27), (size_t)DM * DFF, DFF, DM, DFF, DEPTH, (bf16_t*)(ws + WS_WMI), INP(26), 0, 0);
    tc_job<256>(lds, INP(28), (size_t)DFF * DM, DM, DFF, DM, DEPTH, (bf16_t*)(ws + WS_WMO), nullptr, 0, 0);
    tc_job<256>(lds, INP(14), (size_t)W * W, W, W, W, DEPTH, (bf16_t*)(ws + WS_GLUT), nullptr, 0, 0);
    tc_job<64>(lds, INP(18), (size_t)64 * 64, 64, 64, 64, DEPTH * 4, (bf16_t*)(ws + WS_WAT), nullptr, 0, 64);
    tc_job<64>(lds, INP(20), (size_t)64 * 64, 64, 64, 64, DEPTH * 4, (bf16_t*)(ws + WS_WXT), nullptr, 0, 96);
    const int gid = bid_() * NTHR + opaque_tid();
    if (gid < DEPTH * 1024) {
        const int l = gid >> 10, gp = gid & 1023, g = gp >> 6, p = gp & 63;
        const float lre = INP(6)[gid], lim = INP(7)[gid], dt = expf(INP(8)[l * 16 + g]);
        const float mag = expf(lre * dt), are = mag * cosf(lim * dt), aim = mag * sinf(lim * dt);
        const float den = lre * lre + lim * lim, nre = are - 1.0f, nim = aim;
        const float fre = (nre * lre + nim * lim) / den, fim = (nim * lre - nre * lim) / den;
        ((f32x2*)(ws + WS_ABAR))[gid] = (f32x2){are, aim};
        float pr = are, pi = aim;
#pragma unroll
        for (int s = 0; s < 7; ++s) { const float nr = pr * pr - pi * pi, ni = 2.0f * pr * pi; pr = nr; pi = ni; }
        ((f32x2*)(ws + WS_A128))[gid] = (f32x2){pr, pi};
        const float* bre = INP(9) + (size_t)gid * 16; const float* bim = INP(10) + (size_t)gid * 16;
        bf16_t* bbt = (bf16_t*)(ws + WS_BBT) + ((size_t)(l * 16 + g) * 128 + 2 * p) * 16;
#pragma unroll
        for (int h = 0; h < 16; ++h) { const float br = bre[h], bi = bim[h]; bbt[h] = f2bf(fre * br - fim * bi); bbt[16 + h] = f2bf(fre * bi + fim * br); }
        bf16_t* cmt = (bf16_t*)(ws + WS_CMT) + (size_t)(l * 16 + g) * 16 * 128;
#pragma unroll
        for (int h = 0; h < 16; ++h) { const size_t ci = ((size_t)(l * 16 + g) * 16 + h) * 64 + p; ((unsigned*)cmt)[(h * 128 + 2 * p) >> 1] = pk2(INP(11)[ci], -INP(12)[ci]); }
        const float* wr = INP(2) + ((size_t)l * DM + gp) * NIN + ZW;
        ((f32x4*)(ws + WS_WF))[gid] = *(const f32x4*)wr * INP(1)[gid];
    }
}

template <bool SRCB, int MODE> __device__ __forceinline__ void norm_phase(const void* xsv, const float* g, bf16_t* xb, float* ss2, float* od, const float* wf, const float* bfg, float* logf) {
    const int lane = opaque_tid() & 63, wid = opaque_tid() >> 6;
    const int gw = bid_() * 8 + wid, nw = grid_() * 8;
    for (int row = gw; row < T; row += nw) {
        f32x4 v[4]; float ss = 0.f;
#pragma unroll
        for (int i = 0; i < 4; ++i) {
            if (SRCB) { const bf16x4 q = *(const bf16x4*)((const bf16_t*)xsv + (size_t)row * DM + i * 256 + lane * 4); v[i] = (f32x4){bfs2f(q[0]), bfs2f(q[1]), bfs2f(q[2]), bfs2f(q[3])}; }
            else { v[i] = *(const f32x4*)((const float*)xsv + (size_t)row * DM + i * 256 + lane * 4);
                if (MODE == 1) { u32x2 w; w.x = pk2(v[i][0], v[i][1]); w.y = pk2(v[i][2], v[i][3]); *(u32x2*)(xb + (size_t)row * DM + i * 256 + lane * 4) = w; } }
            ss += v[i][0] * v[i][0] + v[i][1] * v[i][1] + v[i][2] * v[i][2] + v[i][3] * v[i][3]; }
        ss = wave_sum(ss);
        const float rs = rsqrtf(ss * (1.0f / DM) + EPS);
        if (MODE == 1 && !SRCB) { if (lane < 16) ss2[(size_t)row * 16 + lane] = (lane == 0) ? ss : 0.f; }
        float f0 = 0.f, f1 = 0.f, f2 = 0.f, f3 = 0.f;
#pragma unroll
        for (int i = 0; i < 4; ++i) {
            if (MODE == 2) { const f32x4 gg = *(const f32x4*)(g + i * 256 + lane * 4); *(f32x4*)(od + (size_t)row * DM + i * 256 + lane * 4) = v[i] * rs * gg; }
            if (MODE == 1) {
#pragma unroll
                for (int e = 0; e < 4; ++e) { const f32x4 w4 = *(const f32x4*)(wf + (size_t)(i * 256 + lane * 4 + e) * 4); const float hv = v[i][e] * rs; f0 += hv * w4[0]; f1 += hv * w4[1]; f2 += hv * w4[2]; f3 += hv * w4[3]; } }
        }
        if (MODE == 1) {
            f0 = wave_sum(f0); f1 = wave_sum(f1); f2 = wave_sum(f2); f3 = wave_sum(f3);
            if (lane == 0) { f32x4 o; const float fv[4] = {f0 + bfg[0], f1 + bfg[1], f2 + bfg[2], f3 + bfg[3]};
#pragma unroll
                for (int e = 0; e < 4; ++e) o[e] = fminf(fv[e], 0.f) - log1pf(__expf(-fabsf(fv[e])));
                *(f32x4*)(logf + (size_t)row * 4) = o; }
        }
    }
}

__device__ __forceinline__ void cumsum_item(int b, const float* logf, float* cs, unsigned char* lds) {
    LAS float* wt = (LAS float*)lds;
    const int tid = opaque_tid(), lane = tid & 63, wid = tid >> 6;
    f32x4 v[8]; f32x4 run = (f32x4){0.f, 0.f, 0.f, 0.f};
    const float* src = logf + ((size_t)b * SEQ + (size_t)tid * 8) * 4;
#pragma unroll
    for (int e = 0; e < 8; ++e) { run = run + *(const f32x4*)(src + e * 4); v[e] = run; }
    f32x4 inc = run;
#pragma unroll
    for (int d = 1; d < 64; d <<= 1) {
        const int sl = ((lane >= d) ? lane - d : lane) << 2; f32x4 o;
#pragma unroll
        for (int e = 0; e < 4; ++e) o[e] = __uint_as_float((unsigned)__builtin_amdgcn_ds_bpermute(sl, (int)__float_as_uint(inc[e])));
        if (lane >= d) inc = inc + o;
    }
    __syncthreads();
    if (lane == 63) { wt[wid * 4 + 0] = inc[0]; wt[wid * 4 + 1] = inc[1]; wt[wid * 4 + 2] = inc[2]; wt[wid * 4 + 3] = inc[3]; }
    __syncthreads();
    f32x4 off = inc - run;
    for (int w2 = 0; w2 < wid; ++w2) { off[0] += wt[w2 * 4 + 0]; off[1] += wt[w2 * 4 + 1]; off[2] += wt[w2 * 4 + 2]; off[3] += wt[w2 * 4 + 3]; }
    float* dst = cs + ((size_t)b * SEQ + (size_t)tid * 8) * 4;
#pragma unroll
    for (int e = 0; e < 8; ++e) *(f32x4*)(dst + e * 4) = (v[e] + off) * LOG2E;
    __syncthreads();
}

template <int HALF> __device__ __forceinline__ void sgu_item(int l, int b, int c, const Args& a, unsigned char* lds) {
    const bf16_t* z = (const bf16_t*)(ws_() + WS_Z); bf16_t* y = (bf16_t*)(ws_() + WS_Y);
    LAS bf16_t* vn = (LAS bf16_t*)lds;
    LAS float* ssb = (LAS float*)(lds + 69632);
    const int tid = opaque_tid(), lane = tid & 63, wid = tid >> 6, fr = lane & 15, quad = lane >> 4;
    const size_t t0 = (size_t)b * SEQ + (size_t)c * 128;
    const float* ng = INP(3) + l * W;
    __syncthreads();
    const f32x4 gch = *(const f32x4*)(ng + lane * 4);
    constexpr int TPW = HALF ? 16 : 8;
#pragma unroll
    for (int i = 0; i < TPW; ++i) {
        const int s = wid * TPW + i;
        const bf16x4 zv = *(const bf16x4*)(z + (t0 + s) * ZW + ZC_AV + lane * 4);
        float gv[4]; float ss = 0.f;
#pragma unroll
        for (int e = 0; e < 4; ++e) { gv[e] = gelu_t(bfs2f(zv[e])); ss += gv[e] * gv[e]; }
        ss = wave_sum(ss); const float rs = rsqrtf(ss * (1.0f / W) + EPS);
        u32x2 w; w.x = pk2(gv[0] * rs * gch[0], gv[1] * rs * gch[1]); w.y = pk2(gv[2] * rs * gch[2], gv[3] * rs * gch[3]);
        *(LAS u32x2*)(vn + s * 264 + lane * 4) = w;
    }
    __syncthreads();
    const int h = wid & 3;
    const float* wsrc = INP(4) + ((size_t)(l * 4 + h) * 128) * 128;
    const float* bsrc = INP(5) + (size_t)(l * 4 + h) * 128;
    float outv[2][4][4];
#pragma unroll
    for (int i = 0; i < 2; ++i) {
        const int mt = HALF * 4 + (wid >> 2) + 2 * i, t = mt * 16 + fr;
        f32x4 acc[4];
#pragma unroll
        for (int nt = 0; nt < 4; ++nt) acc[nt] = (f32x4){0.f, 0.f, 0.f, 0.f};
        f32x4 wl[4][2];
#pragma unroll
        for (int kk = 0; kk < 4; ++kk) { const int k0 = (kk * 32 < (mt + 1) * 16) ? kk * 32 : 0; const float* wp = wsrc + (size_t)t * 128 + k0 + quad * 8; wl[kk][0] = *(const f32x4*)wp; wl[kk][1] = *(const f32x4*)(wp + 4); }
#pragma unroll
        for (int kk = 0; kk < 4; ++kk) {
            const int k0 = kk * 32;
            if (k0 < (mt + 1) * 16) {
                float wv[8] = {wl[kk][0][0], wl[kk][0][1], wl[kk][0][2], wl[kk][0][3], wl[kk][1][0], wl[kk][1][1], wl[kk][1][2], wl[kk][1][3]};
#pragma unroll
                for (int e = 0; e < 8; ++e) if (k0 + quad * 8 + e > t) wv[e] = 0.f;
                const bf16x8 wf = pack8(wv);
#pragma unroll
                for (int nt = 0; nt < 4; ++nt) {
                    LAS bf16_t* tp = vn + (k0 + quad * 8 + (fr >> 2)) * 264 + h * 64 + nt * 16 + (fr & 3) * 4;
                    const bf16x4 lo = __builtin_bit_cast(bf16x4, __builtin_amdgcn_ds_read_tr16_b64_v4i16((LAS v4i16_t*)tp));
                    const bf16x4 hi = __builtin_bit_cast(bf16x4, __builtin_amdgcn_ds_read_tr16_b64_v4i16((LAS v4i16_t*)(tp + 4 * 264)));
                    const bf16x8 vf = (bf16x8){lo[0], lo[1], lo[2], lo[3], hi[0], hi[1], hi[2], hi[3]};
                    acc[nt] = mfma16(vf, wf, acc[nt]); }
            }
        }
        const float bs = bsrc[t]; float ss = 0.f;
#pragma unroll
        for (int nt = 0; nt < 4; ++nt) { const int ch = h * 64 + nt * 16 + quad * 4; const bf16x4 u4 = *(const bf16x4*)(z + (t0 + t) * ZW + ZC_AU + ch);
#pragma unroll
            for (int r = 0; r < 4; ++r) { const float o = gelu_t(bfs2f(u4[r])) * (acc[nt][r] + bs); outv[i][nt][r] = o; ss += o * o; } }
        ss = quad_sum(ss);
        if (quad == 0) ssb[t * 4 + h] = ss;
    }
    __syncthreads();
#pragma unroll
    for (int i = 0; i < 2; ++i) {
        const int mt = HALF * 4 + (wid >> 2) + 2 * i, t = mt * 16 + fr;
        const float rs = rsqrtf((ssb[t * 4 + 0] + ssb[t * 4 + 1] + ssb[t * 4 + 2] + ssb[t * 4 + 3]) * (1.0f / W) + EPS);
#pragma unroll
        for (int nt = 0; nt < 4; ++nt) { const int ch = h * 64 + nt * 16 + quad * 4; u32x2 w; w.x = pk2(outv[i][nt][0] * rs, outv[i][nt][1] * rs); w.y = pk2(outv[i][nt][2] * rs, outv[i][nt][3] * rs);
            *(u32x2*)(y + (t0 + t) * DM + YC_A + ch) = w; }
    }
    __syncthreads();
}

template <int PASS> __device__ __forceinline__ void s5_item(int l, int b, int c, const Args& a, unsigned char* lds) {
    const bf16_t* z = (const bf16_t*)(ws_() + WS_Z); bf16_t* y = (bf16_t*)(ws_() + WS_Y);
    LAS unsigned char* BU = (LAS unsigned char*)lds;
    LAS unsigned* BU32 = (LAS unsigned*)lds;
    LAS bf16_t* Yb = (LAS bf16_t*)(lds + 65792);
    LAS float* ssb = (LAS float*)(lds + 65792 + 67584);
    const int tid = opaque_tid(), lane = tid & 63, wid = tid >> 6, fr = lane & 15, quad = lane >> 4;
    const int sx0 = wid * 128 + lane, sx1 = sx0 + 64;
    const size_t t0 = (size_t)b * SEQ + (size_t)c * 128;
    const f32x2* abar = (const f32x2*)(ws_() + WS_ABAR) + l * 1024;
    f32x2* eloc = (f32x2*)(ws_() + WS_ELOC);
    float ar[2], ai[2], sre[2], sim[2];
#pragma unroll
    for (int q = 0; q < 2; ++q) { const f32x2 ab = abar[q ? sx1 : sx0]; ar[q] = ab[0]; ai[q] = ab[1]; sre[q] = 0.f; sim[q] = 0.f; }
    if (PASS == 2) {
        const f32x2* a128 = (const f32x2*)(ws_() + WS_A128) + l * 1024;
        const f32x2 p0 = a128[sx0], p1 = a128[sx1];
        for (int cc0 = 0; cc0 < c; cc0 += 8) {
            f32x2 e0[8], e1[8];
#pragma unroll
            for (int u = 0; u < 8; ++u) { const int cc = (cc0 + u < c) ? cc0 + u : c - 1; e0[u] = eloc[((size_t)(b * NCH + cc)) * 1024 + sx0]; e1[u] = eloc[((size_t)(b * NCH + cc)) * 1024 + sx1]; }
#pragma unroll
            for (int u = 0; u < 8; ++u) if (cc0 + u < c) {
                const float nr0 = p0[0] * sre[0] - p0[1] * sim[0] + e0[u][0], ni0 = p0[0] * sim[0] + p0[1] * sre[0] + e0[u][1]; sre[0] = nr0; sim[0] = ni0;
                const float nr1 = p1[0] * sre[1] - p1[1] * sim[1] + e1[u][0], ni1 = p1[0] * sim[1] + p1[1] * sre[1] + e1[u][1]; sre[1] = nr1; sim[1] = ni1; }
        }
    }
    bf16x8 bfrag[2][8];
    const bf16_t* bbt = (const bf16_t*)(ws_() + WS_BBT);
#pragma unroll
    for (int gi = 0; gi < 2; ++gi)
#pragma unroll
        for (int j = 0; j < 8; ++j) bfrag[gi][j] = (quad < 2) ? *(const bf16x8*)(bbt + ((size_t)(l * 16 + wid * 2 + gi) * 128 + j * 16 + fr) * 16 + quad * 8) : zero8();
    bf16x8 cfrag[2][4];
    if (PASS == 2) {
        const bf16_t* cmt = (const bf16_t*)(ws_() + WS_CMT);
#pragma unroll
        for (int gi = 0; gi < 2; ++gi)
#pragma unroll
            for (int ks = 0; ks < 4; ++ks) cfrag[gi][ks] = *(const bf16x8*)(cmt + ((size_t)(l * 16 + wid * 2 + gi) * 16 + fr) * 128 + ks * 32 + quad * 8);
    }
    const float* dsk = INP(13) + l * W;
    __syncthreads();
    bf16x8 ufn[2];
#pragma unroll
    for (int gi = 0; gi < 2; ++gi) ufn[gi] = (quad < 2) ? *(const bf16x8*)(z + (t0 + fr) * ZW + ZC_B + (wid * 2 + gi) * 16 + quad * 8) : zero8();
    for (int sc = 0; sc < 8; ++sc) {
        const size_t tr = t0 + sc * 16 + fr;
        bf16x8 ufc[2] = {ufn[0], ufn[1]};
        bf16x4 u4c[2] = {(bf16x4){0, 0, 0, 0}, (bf16x4){0, 0, 0, 0}};
        if (PASS == 2) {
#pragma unroll
            for (int gi = 0; gi < 2; ++gi) u4c[gi] = *(const bf16x4*)(z + tr * ZW + ZC_B + (wid * 2 + gi) * 16 + quad * 4);
        }
        if (sc < 7) {
#pragma unroll
            for (int gi = 0; gi < 2; ++gi) ufn[gi] = (quad < 2) ? *(const bf16x8*)(z + (tr + 16) * ZW + ZC_B + (wid * 2 + gi) * 16 + quad * 8) : zero8();
        }
#pragma unroll
        for (int gi = 0; gi < 2; ++gi) {
            const int g = wid * 2 + gi;
            const bf16x8 uf = ufc[gi];
#pragma unroll
            for (int j = 0; j < 8; ++j) {
                const f32x4 acc = mfma16(bfrag[gi][j], uf, (f32x4){0.f, 0.f, 0.f, 0.f});
                u32x2 w; w.x = pk2(acc[0], acc[1]); w.y = pk2(acc[2], acc[3]);
                *(LAS u32x2*)(BU + fr * 4112 + (g * 64 + j * 8 + quad * 2) * 4) = w;
            }
        }
        asm volatile("s_waitcnt lgkmcnt(0)" ::: "memory");
        {
            unsigned wv[16][2];
#pragma unroll
            for (int tt = 0; tt < 16; ++tt) { wv[tt][0] = BU32[tt * 1028 + sx0]; wv[tt][1] = BU32[tt * 1028 + sx1]; }
#pragma unroll
            for (int tt = 0; tt < 16; ++tt) {
#pragma unroll
                for (int q = 0; q < 2; ++q) {
                    const unsigned w = wv[tt][q];
                    const f32x2 bu2 = {__uint_as_float(w << 16), __uint_as_float(w & 0xffff0000u)};
                    const f32x2 s2 = {sre[q], sim[q]}, sw = {sim[q], sre[q]}, arr = {ar[q], ar[q]}, aii = {-ai[q], ai[q]};
                    const f32x2 n2 = aii * sw + (arr * s2 + bu2);
                    sre[q] = n2[0]; sim[q] = n2[1];
                    if (PASS == 2) wv[tt][q] = pk2(n2[0], n2[1]);
                }
            }
            if (PASS == 2) {
#pragma unroll
                for (int tt = 0; tt < 16; ++tt) { BU32[tt * 1028 + sx0] = wv[tt][0]; BU32[tt * 1028 + sx1] = wv[tt][1]; }
            }
        }
        asm volatile("s_waitcnt lgkmcnt(0)" ::: "memory");
        if (PASS == 2) {
#pragma unroll
            for (int gi = 0; gi < 2; ++gi) {
                const int g = wid * 2 + gi; f32x4 acc = (f32x4){0.f, 0.f, 0.f, 0.f};
#pragma unroll
                for (int ks = 0; ks < 4; ++ks) { const bf16x8 sf = *(const LAS bf16x8*)(BU + fr * 4112 + g * 256 + (ks * 32 + quad * 8) * 2); acc = mfma16(cfrag[gi][ks], sf, acc); }
                const int ch = g * 16 + quad * 4; const bf16x4 u4 = u4c[gi]; const f32x4 d4 = *(const f32x4*)(dsk + ch);
                float o[4];
#pragma unroll
                for (int r = 0; r < 4; ++r) o[r] = gelu_t(acc[r] + d4[r] * bfs2f(u4[r]));
                u32x2 w; w.x = pk2(o[0], o[1]); w.y = pk2(o[2], o[3]);
                *(LAS u32x2*)(Yb + (sc * 16 + fr) * 264 + ch) = w;
            }
        }
    }
    if (PASS == 1) {
#pragma unroll
        for (int q = 0; q < 2; ++q) eloc[((size_t)(b * NCH + c)) * 1024 + (q ? sx1 : sx0)] = (f32x2){sre[q], sim[q]};
        {
            LAS float* kq = (LAS float*)(lds + 65792);
            const int tok = tid >> 2, hd = tid & 3; float s2 = 0.f;
#pragma unroll
            for (int j = 0; j < 8; ++j) { const bf16x8 kv = *(const bf16x8*)(z + (t0 + tok) * ZW + ZC_K + hd * 64 + j * 8);
#pragma unroll
                for (int e = 0; e < 8; ++e) { const float f = bfs2f(kv[e]); s2 += f * f; } }
            kq[tok * 4 + hd] = s2;
            __syncthreads();
            if (tid < 4) { float mxv = 0.f; for (int i = 0; i < 128; ++i) mxv = fmaxf(mxv, kq[i * 4 + tid]); ((float*)(ws_() + WS_KMAX))[(b * NCH + c) * 4 + tid] = mxv; }
        }
    } else {
        __syncthreads();
        const bf16_t* glut = (const bf16_t*)(ws_() + WS_GLUT) + (size_t)l * W * W;
        const float* glub = INP(15) + l * W;
        bf16x8 gfrag[2][8];
#pragma unroll
        for (int ni = 0; ni < 2; ++ni)
#pragma unroll
            for (int ks = 0; ks < 8; ++ks) gfrag[ni][ks] = *(const bf16x8*)(glut + (size_t)((wid * 2 + ni) * 16 + fr) * W + ks * 32 + quad * 8);
        float outv[8][2][4];
#pragma unroll
        for (int mt = 0; mt < 8; ++mt) {
            f32x4 acc0 = (f32x4){0.f, 0.f, 0.f, 0.f}, acc1 = acc0;
#pragma unroll
            for (int ks = 0; ks < 8; ++ks) { const bf16x8 yf = *(const LAS bf16x8*)(Yb + (mt * 16 + fr) * 264 + ks * 32 + quad * 8); acc0 = mfma16(gfrag[0][ks], yf, acc0); acc1 = mfma16(gfrag[1][ks], yf, acc1); }
            float ss = 0.f;
#pragma unroll
            for (int ni = 0; ni < 2; ++ni) { const int n = (wid * 2 + ni) * 16 + quad * 4; const bf16x4 y4 = *(const LAS bf16x4*)(Yb + (mt * 16 + fr) * 264 + n); const f32x4 gb = *(const f32x4*)(glub + n);
#pragma unroll
                for (int r = 0; r < 4; ++r) { const float gt = (ni == 0 ? acc0[r] : acc1[r]) + gb[r]; const float o = bfs2f(y4[r]) * sigm(gt); outv[mt][ni][r] = o; ss += o * o; } }
            ss = quad_sum(ss);
            if (quad == 0) ssb[(mt * 16 + fr) * 8 + wid] = ss;
        }
        __syncthreads();
#pragma unroll
        for (int mt = 0; mt < 8; ++mt) {
            const int t = mt * 16 + fr; float s = 0.f;
#pragma unroll
            for (int w2 = 0; w2 < 8; ++w2) s += ssb[t * 8 + w2];
            const float rs = rsqrtf(s * (1.0f / W) + EPS);
#pragma unroll
            for (int ni = 0; ni < 2; ++ni) { const int n = (wid * 2 + ni) * 16 + quad * 4; u32x2 w; w.x = pk2(outv[mt][ni][0] * rs, outv[mt][ni][1] * rs); w.y = pk2(outv[mt][ni][2] * rs, outv[mt][ni][3] * rs);
                *(u32x2*)(y + (t0 + t) * DM + YC_B + n) = w; }
        }
    }
    __syncthreads();
}

template <int PASS> __device__ __forceinline__ void lru_item(int l, int b, int c, const Args& a, unsigned char* lds) {
    const bf16_t* z = (const bf16_t*)(ws_() + WS_Z); bf16_t* y = (bf16_t*)(ws_() + WS_Y);
    LAS bf16_t* XC = (LAS bf16_t*)lds;
    LAS float* ssb = (LAS float*)(lds + 67584);
    const int tid = opaque_tid(), lane = tid & 63, wid = tid >> 6, fr = lane & 15, quad = lane >> 4;
    const size_t t0 = (size_t)b * SEQ + (size_t)c * 128;
    float* LAp = (float*)(ws_() + WS_LA); float* LBp = (float*)(ws_() + WS_LB);
    __syncthreads();
    const int hh = wid >> 1;
    const bf16_t* wat = (const bf16_t*)(ws_() + WS_WAT) + (size_t)(l * 4 + hh) * 64 * 64;
    const bf16_t* wxt = (const bf16_t*)(ws_() + WS_WXT) + (size_t)(l * 4 + hh) * 64 * 64;
    bf16x8 waf[2][2], wxf[2][2]; float sp8[2][4], bav[2][4], bxv[2][4], H[2][4], Acar[2][4], Bcar[2][4];
#pragma unroll
    for (int ni = 0; ni < 2; ++ni) {
        const int nl = (wid * 2 + ni) * 16 - hh * 64 + fr;
#pragma unroll
        for (int ks = 0; ks < 2; ++ks) { waf[ni][ks] = *(const bf16x8*)(wat + nl * 64 + ks * 32 + quad * 8); wxf[ni][ks] = *(const bf16x8*)(wxt + nl * 64 + ks * 32 + quad * 8); }
#pragma unroll
        for (int r = 0; r < 4; ++r) { const int ch = (wid * 2 + ni) * 16 + quad * 4 + r;
            sp8[ni][r] = 8.0f * softplus_f(-INP(22)[l * W + ch]); bav[ni][r] = INP(19)[l * W + ch]; bxv[ni][r] = INP(21)[l * W + ch];
            H[ni][r] = 0.f; Acar[ni][r] = 1.f; Bcar[ni][r] = 0.f;
        }
    }
    if (PASS == 2 && c > 0) {
#pragma unroll
        for (int ni = 0; ni < 2; ++ni) {
            const size_t ob = (size_t)(b * NCH) * W + (wid * 2 + ni) * 16 + quad * 4;
            const bool v0 = fr < c, v1 = 16 + fr < c;
            f32x4 a0 = (f32x4){1.f, 1.f, 1.f, 1.f}, b0 = (f32x4){0.f, 0.f, 0.f, 0.f}, a1 = a0, b1 = b0;
            if (v0) { a0 = *(const f32x4*)(LAp + ob + (size_t)fr * W); b0 = *(const f32x4*)(LBp + ob + (size_t)fr * W); }
            if (v1) { a1 = *(const f32x4*)(LAp + ob + (size_t)(16 + fr) * W); b1 = *(const f32x4*)(LBp + ob + (size_t)(16 + fr) * W); }
#pragma unroll
            for (int r = 0; r < 4; ++r) {
                float av = a0[r], bb = b0[r], aw = a1[r], bw = b1[r], ap, bp;
                ap = dpp_shr<1>(av, 1.0f); bp = dpp_shr<1>(bb, 0.0f); bb = av * bp + bb; av = av * ap;   ap = dpp_shr<1>(aw, 1.0f); bp = dpp_shr<1>(bw, 0.0f); bw = aw * bp + bw; aw = aw * ap;
                ap = dpp_shr<2>(av, 1.0f); bp = dpp_shr<2>(bb, 0.0f); bb = av * bp + bb; av = av * ap;   ap = dpp_shr<2>(aw, 1.0f); bp = dpp_shr<2>(bw, 0.0f); bw = aw * bp + bw; aw = aw * ap;
                ap = dpp_shr<4>(av, 1.0f); bp = dpp_shr<4>(bb, 0.0f); bb = av * bp + bb; av = av * ap;   ap = dpp_shr<4>(aw, 1.0f); bp = dpp_shr<4>(bw, 0.0f); bw = aw * bp + bw; aw = aw * ap;
                ap = dpp_shr<8>(av, 1.0f); bp = dpp_shr<8>(bb, 0.0f); bb = av * bp + bb; av = av * ap;   ap = dpp_shr<8>(aw, 1.0f); bp = dpp_shr<8>(bw, 0.0f); bw = aw * bp + bw; aw = aw * ap;
                const float B0t = __shfl(bb, 15, 16), A1t = __shfl(aw, 15, 16), B1t = __shfl(bw, 15, 16);
                H[ni][r] = A1t * B0t + B1t;
            }
        }
    }
    {
        const float* cw = INP(16) + (size_t)l * 4 * W; const float* cb = INP(17) + l * W;
        const int ch0 = (tid & 31) * 8, tk0 = (tid >> 5) * 8;
        bf16x8 xr[11];
#pragma unroll
        for (int j = 0; j < 11; ++j) { const int tt = tk0 - 3 + j;
            xr[j] = (c * 128 + tt >= 0) ? *(const bf16x8*)(z + (size_t)((long)t0 + tt) * ZW + ZC_CX + ch0) : zero8(); }
        float wk[4][8], bk[8];
        { const f32x4 c0 = *(const f32x4*)(cb + ch0), c1 = *(const f32x4*)(cb + ch0 + 4);
#pragma unroll
          for (int e = 0; e < 4; ++e) { bk[e] = c0[e]; bk[4 + e] = c1[e]; }
#pragma unroll
          for (int k = 0; k < 4; ++k) { const f32x4 w0 = *(const f32x4*)(cw + k * W + ch0), w1 = *(const f32x4*)(cw + k * W + ch0 + 4);
#pragma unroll
              for (int e = 0; e < 4; ++e) { wk[k][e] = w0[e]; wk[k][4 + e] = w1[e]; } } }
#pragma unroll
        for (int i = 0; i < 8; ++i) { float acc[8];
#pragma unroll
            for (int e = 0; e < 8; ++e) acc[e] = bk[e] + wk[0][e] * bfs2f(xr[i][e]) + wk[1][e] * bfs2f(xr[i + 1][e]) + wk[2][e] * bfs2f(xr[i + 2][e]) + wk[3][e] * bfs2f(xr[i + 3][e]);
            *(LAS bf16x8*)(XC + (tk0 + i) * 264 + ch0) = pack8(acc); }
    }
    __syncthreads();
    LAS bf16_t* Ob = (LAS bf16_t*)(lds + 67584 + 4096);
#pragma unroll 2
    for (int mt = 0; mt < 8; ++mt) {
        bf16x8 xf[2];
#pragma unroll
        for (int ks = 0; ks < 2; ++ks) xf[ks] = *(const LAS bf16x8*)(XC + (mt * 16 + fr) * 264 + hh * 64 + ks * 32 + quad * 8);
        float ss = 0.f;
#pragma unroll
        for (int ni = 0; ni < 2; ++ni) {
            f32x4 accA = (f32x4){0.f, 0.f, 0.f, 0.f}, accX = accA;
#pragma unroll
            for (int ks = 0; ks < 2; ++ks) { accA = mfma16(waf[ni][ks], xf[ks], accA); accX = mfma16(wxf[ni][ks], xf[ks], accX); }
            const int ch0 = (wid * 2 + ni) * 16 + quad * 4;
            const bf16x4 xc4 = *(const LAS bf16x4*)(XC + (mt * 16 + fr) * 264 + ch0);
            bf16x4 g4 = (bf16x4){0, 0, 0, 0};
            if (PASS == 2) g4 = *(const bf16x4*)(z + (t0 + mt * 16 + fr) * ZW + ZC_CG + ch0);
            float ov[4] = {0.f, 0.f, 0.f, 0.f};
#pragma unroll
            for (int r = 0; r < 4; ++r) {
                const float rg = sigm(accA[r] + bav[ni][r]), ig = sigm(accX[r] + bxv[ni][r]);
                const float la = -rg * sp8[ni][r];
                float av = __builtin_amdgcn_exp2f(LOG2E * la), bb = __builtin_amdgcn_sqrtf(fmaxf(neg_expm1(2.0f * la), 0.f)) * (ig * bfs2f(xc4[r]));
                { float ap, bp;
                  ap = dpp_shr<1>(av, 1.0f); bp = dpp_shr<1>(bb, 0.0f); bb = av * bp + bb; av = av * ap;
                  ap = dpp_shr<2>(av, 1.0f); bp = dpp_shr<2>(bb, 0.0f); bb = av * bp + bb; av = av * ap;
                  ap = dpp_shr<4>(av, 1.0f); bp = dpp_shr<4>(bb, 0.0f); bb = av * bp + bb; av = av * ap;
                  ap = dpp_shr<8>(av, 1.0f); bp = dpp_shr<8>(bb, 0.0f); bb = av * bp + bb; av = av * ap; }
                if (PASS == 1) { const float At = __shfl(av, 15, 16), Bt = __shfl(bb, 15, 16); Bcar[ni][r] = At * Bcar[ni][r] + Bt; Acar[ni][r] *= At; }
                else { const float hv = av * H[ni][r] + bb; H[ni][r] = __shfl(hv, 15, 16); const float o = hv * gelu_t(bfs2f(g4[r])); ov[r] = o; ss += o * o; }
            }
            if (PASS == 2) { u32x2 w; w.x = pk2(ov[0], ov[1]); w.y = pk2(ov[2], ov[3]); *(LAS u32x2*)(Ob + (mt * 16 + fr) * 264 + ch0) = w; }
        }
        if (PASS == 2) { ss = quad_sum(ss); if (quad == 0) ssb[(mt * 16 + fr) * 8 + wid] = ss; }
    }
    if (PASS == 1) {
        if (fr == 0) {
#pragma unroll
            for (int ni = 0; ni < 2; ++ni)
#pragma unroll
                for (int r = 0; r < 4; ++r) { const size_t o = ((size_t)(b * NCH + c)) * W + (wid * 2 + ni) * 16 + quad * 4 + r; LAp[o] = Acar[ni][r]; LBp[o] = Bcar[ni][r]; }
        }
    } else {
        __syncthreads();
#pragma unroll 2
        for (int mt = 0; mt < 8; ++mt) {
            const int t = mt * 16 + fr; float s = 0.f;
#pragma unroll
            for (int w2 = 0; w2 < 8; ++w2) s += ssb[t * 8 + w2];
            const float rs = rsqrtf(s * (1.0f / W) + EPS);
#pragma unroll
            for (int ni = 0; ni < 2; ++ni) { const int n = (wid * 2 + ni) * 16 + quad * 4; const bf16x4 o4 = *(const LAS bf16x4*)(Ob + t * 264 + n);
                u32x2 w; w.x = pk2(bfs2f(o4[0]) * rs, bfs2f(o4[1]) * rs); w.y = pk2(bfs2f(o4[2]) * rs, bfs2f(o4[3]) * rs);
                *(u32x2*)(y + (t0 + t) * DM + YC_C + n) = w; }
        }
    }
    __syncthreads();
}

template <bool DIAG> __device__ __forceinline__ void attn_step2(const LAS unsigned char* buf, int kbase, int qrow0, int quad, int fr, const bf16x8 (&qf)[2][2], float (&m)[2], float (&lsum)[2], f32x4 (&oacc)[2][4]) {
    const LAS bf16_t* Kt = (const LAS bf16_t*)buf; const LAS bf16_t* Vt = (const LAS bf16_t*)(buf + 9216); const LAS float* csl = (const LAS float*)(buf + 18432);
    LAS bf16_t* vtr0 = (LAS bf16_t*)Vt + (quad * 4 + (fr >> 2)) * 72 + (fr & 3) * 4;
    float p[2][4][4];
#pragma unroll
    for (int st = 0; st < 4; ++st) {
        const f32x4 c4 = *(const LAS f32x4*)(csl + st * 16 + quad * 4);
        const bf16x8 kf0 = *(const LAS bf16x8*)(Kt + (st * 16 + fr) * 72 + quad * 8), kf1 = *(const LAS bf16x8*)(Kt + (st * 16 + fr) * 72 + 32 + quad * 8);
#pragma unroll
        for (int qs = 0; qs < 2; ++qs) {
            f32x4 acc = mfma16(kf0, qf[qs][0], c4); acc = mfma16(kf1, qf[qs][1], acc);
#pragma unroll
            for (int r = 0; r < 4; ++r) { float v = acc[r]; if (DIAG && (kbase + st * 16 + quad * 4 + r > qrow0 + qs * 16)) v = -1e30f; p[qs][st][r] = v; }
        }
    }
    bf16x8 pf[2][2];
#pragma unroll
    for (int qs = 0; qs < 2; ++qs) {
        float mx = -1e30f;
#pragma unroll
        for (int st = 0; st < 4; ++st)
#pragma unroll
            for (int r = 0; r < 4; ++r) mx = fmaxf(mx, p[qs][st][r]);
        mx = quad_max(mx);
        if (__any(mx > m[qs])) {
            const float mnew = fmaxf(m[qs], mx), al = __builtin_amdgcn_exp2f(m[qs] - mnew); m[qs] = mnew; lsum[qs] *= al;
#pragma unroll
            for (int dt = 0; dt < 4; ++dt) oacc[qs][dt] = oacc[qs][dt] * al;
        }
        const float mcur = m[qs];
        float ps = 0.f;
#pragma unroll
        for (int st = 0; st < 4; ++st)
#pragma unroll
            for (int r = 0; r < 4; ++r) { const float e = __builtin_amdgcn_exp2f(p[qs][st][r] - mcur); p[qs][st][r] = e; ps += e; }
        lsum[qs] += ps;
#pragma unroll
        for (int ks = 0; ks < 2; ++ks) { u32x4 w; w.x = pk2(p[qs][2 * ks][0], p[qs][2 * ks][1]); w.y = pk2(p[qs][2 * ks][2], p[qs][2 * ks][3]); w.z = pk2(p[qs][2 * ks + 1][0], p[qs][2 * ks + 1][1]); w.w = pk2(p[qs][2 * ks + 1][2], p[qs][2 * ks + 1][3]); pf[qs][ks] = __builtin_bit_cast(bf16x8, w); }
    }
#pragma unroll
    for (int dt = 0; dt < 4; ++dt) {
#pragma unroll
        for (int ks = 0; ks < 2; ++ks) {
            const bf16x4 v0 = __builtin_bit_cast(bf16x4, __builtin_amdgcn_ds_read_tr16_b64_v4i16((LAS v4i16_t*)(vtr0 + (ks * 32) * 72 + dt * 16)));
            const bf16x4 v1 = __builtin_bit_cast(bf16x4, __builtin_amdgcn_ds_read_tr16_b64_v4i16((LAS v4i16_t*)(vtr0 + (ks * 32 + 16) * 72 + dt * 16)));
            const bf16x8 vf = (bf16x8){v0[0], v0[1], v0[2], v0[3], v1[0], v1[1], v1[2], v1[3]};
            oacc[0][dt] = mfma16(vf, pf[0][ks], oacc[0][dt]); oacc[1][dt] = mfma16(vf, pf[1][ks], oacc[1][dt]);
        }
    }
}
__device__ __forceinline__ void attn_unit(int b, int h, int qb, const Args& a, unsigned char* lds) {
    const bf16_t* z = (const bf16_t*)(ws_() + WS_Z); bf16_t* y = (bf16_t*)(ws_() + WS_Y);
    const float* cs = (const float*)(ws_() + WS_CS); float* ssd = (float*)(ws_() + WS_SSD);
    constexpr int ABUF = 9216 + 9216 + 256;
    LAS unsigned char* lb = (LAS unsigned char*)lds;
    const int tid = opaque_tid(), lane = tid & 63, wid = tid >> 6, fr = lane & 15, quad = lane >> 4, grp = wid >> 2, wq = wid & 3;
    const int q0 = qb * 128, qw = q0 + wq * 32, qrow0 = qw + fr;
    const size_t rb = (size_t)b * SEQ;
    bf16x8 qf[2][2];
    {
        const float SC = 0.125f * LOG2E;
#pragma unroll
        for (int qs = 0; qs < 2; ++qs)
#pragma unroll
            for (int ds = 0; ds < 2; ++ds) { const bf16x8 qv = *(const bf16x8*)(z + (rb + qrow0 + qs * 16) * ZW + ZC_Q + h * 64 + ds * 32 + quad * 8); float t8[8];
#pragma unroll
                for (int e = 0; e < 8; ++e) t8[e] = bfs2f(qv[e]) * SC;
                qf[qs][ds] = pack8(t8); }
    }
    float m[2] = {-1e30f, -1e30f}, lsum[2] = {0.f, 0.f}; f32x4 oacc[2][4];
#pragma unroll
    for (int qs = 0; qs < 2; ++qs)
#pragma unroll
        for (int dt = 0; dt < 4; ++dt) oacc[qs][dt] = (f32x4){0.f, 0.f, 0.f, 0.f};
    float qbnd[2];
    {
        float kv = (lane <= qb) ? ((const float*)(ws_() + WS_KMAX))[(b * NCH + lane) * 4 + h] : 0.f;
        kv = wave_max(kv);
        const float kmax = __builtin_amdgcn_sqrtf(kv) * 1.01f + 1e-3f;
#pragma unroll
        for (int qs = 0; qs < 2; ++qs) { float q2 = 0.f;
#pragma unroll
            for (int ds = 0; ds < 2; ++ds)
#pragma unroll
                for (int e = 0; e < 8; ++e) { const float f = bfs2f(qf[qs][ds][e]); q2 += f * f; }
            q2 = quad_sum(q2); qbnd[qs] = (__builtin_amdgcn_sqrtf(q2) * 1.01f + 1e-3f) * kmax; }
    }
    const int NSS = qb + 1;
    volatile LAS unsigned* vote = (volatile LAS unsigned*)(lds + LDS_BYTES - 64);
    if (tid < 3) vote[tid] = 0u;
    bf16x8 kreg[2], vreg[2]; float creg = 0.f;
#define ATT_LOAD(S) do { const size_t kb_ = rb + (size_t)(S) * 128; \
        _Pragma("unroll") for (int p_ = 0; p_ < 2; ++p_) { const int id_ = tid + 512 * p_; \
            kreg[p_] = *(const bf16x8*)(z + (kb_ + (id_ >> 3)) * ZW + ZC_K + h * 64 + (id_ & 7) * 8); \
            vreg[p_] = *(const bf16x8*)(z + (kb_ + (id_ >> 3)) * ZW + ZC_V + h * 64 + (id_ & 7) * 8); } \
        if (tid < 128) creg = cs[(kb_ + tid) * 4 + h]; } while (0)
#define ATT_STORE(S) do { LAS unsigned char* bb_ = lb + ((S) & 1) * (2 * ABUF); \
        _Pragma("unroll") for (int p_ = 0; p_ < 2; ++p_) { const int id_ = tid + 512 * p_; const int k128_ = id_ >> 3; \
            *(LAS bf16x8*)((LAS bf16_t*)(bb_ + (k128_ >> 6) * ABUF) + (k128_ & 63) * 72 + (id_ & 7) * 8) = kreg[p_]; \
            *(LAS bf16x8*)((LAS bf16_t*)(bb_ + (k128_ >> 6) * ABUF + 9216) + (k128_ & 63) * 72 + (id_ & 7) * 8) = vreg[p_]; } \
        if (tid < 128) ((LAS float*)(bb_ + (tid >> 6) * ABUF + 18432))[tid & 63] = -creg; } while (0)
    ATT_LOAD(NSS - 1); ATT_STORE(NSS - 1);
    if (NSS > 1) ATT_LOAD(NSS - 2);
    __syncthreads();
    int kstep = 0;
    for (int S = NSS - 1; S >= 0; --S) {
        if (S >= 1) ATT_STORE(S - 1);
        if (S >= 2) ATT_LOAD(S - 2);
        float cl = 0.f; if (S >= 1) cl = cs[(rb + (size_t)(S - 1) * 128 + 127) * 4 + h];
        const int kbase = S * 128 + grp * 64;
        const LAS unsigned char* hb = lb + (S & 1) * (2 * ABUF) + grp * ABUF;
        if (S + 1 < NSS) attn_step2<false>(hb, kbase, qrow0, quad, fr, qf, m, lsum, oacc);
        else if (kbase <= qw + 31) attn_step2<true>(hb, kbase, qrow0, quad, fr, qf, m, lsum, oacc);
        const bool need = (S >= 1) && ((qbnd[0] - cl - m[0] >= -160.f) || (qbnd[1] - cl - m[1] >= -160.f));
        const int vw = kstep % 3;
        if (need) vote[vw] = 1u;
        __syncthreads();
        const unsigned go = vote[vw];
        if (tid == 0) vote[(kstep + 2) % 3] = 0u;
        ++kstep;
        if (!go) break;
    }
#undef ATT_LOAD
#undef ATT_STORE
    LAS float* mg = (LAS float*)lb;
    const int ml = wq * 64 + lane;
    if (grp == 1) {
#pragma unroll
        for (int qs = 0; qs < 2; ++qs) { mg[(qs * 18 + 0) * 256 + ml] = m[qs]; mg[(qs * 18 + 1) * 256 + ml] = lsum[qs];
#pragma unroll
            for (int dt = 0; dt < 4; ++dt)
#pragma unroll
                for (int r = 0; r < 4; ++r) mg[(qs * 18 + 2 + dt * 4 + r) * 256 + ml] = oacc[qs][dt][r]; }
    }
    __syncthreads();
    if (grp == 0) {
#pragma unroll
        for (int qs = 0; qs < 2; ++qs) {
            const float m1 = mg[(qs * 18 + 0) * 256 + ml], l1 = mg[(qs * 18 + 1) * 256 + ml];
            const float mt = fmaxf(m[qs], m1), f0 = __builtin_amdgcn_exp2f(m[qs] - mt), f1 = __builtin_amdgcn_exp2f(m1 - mt);
            float lt = quad_sum(lsum[qs] * f0 + l1 * f1);
            const float inv = 1.0f / lt; float ss = 0.f;
            const size_t tq = rb + qrow0 + qs * 16;
#pragma unroll
            for (int dt = 0; dt < 4; ++dt) { f32x4 o;
#pragma unroll
                for (int r = 0; r < 4; ++r) { o[r] = (oacc[qs][dt][r] * f0 + mg[(qs * 18 + 2 + dt * 4 + r) * 256 + ml] * f1) * inv; ss += o[r] * o[r]; }
                u32x2 w; w.x = pk2(o[0], o[1]); w.y = pk2(o[2], o[3]); *(u32x2*)(y + tq * DM + YC_D + h * 64 + dt * 16 + quad * 4) = w; }
            ss = quad_sum(ss);
            if (quad == 0) ssd[tq * 4 + h] = ss;
        }
    }
    __syncthreads();
}

#define XB_TMO      128
#define XB_XCNT(j)  (256  + 64 * (j))
#define XB_XSUB(j)  (1280 + 64 * (j))
#define XB_XGEN(j)  (2304 + 64 * (j))
#define XB_TOP      3328
#define XB_TOPGEN   3392
#define XCD_BAR_WORDS 3456
#define XB_SPIN_CAP (1u << 18)

__device__ __forceinline__ unsigned xb_ld(unsigned* p)              { return __hip_atomic_load(p, __ATOMIC_RELAXED, __HIP_MEMORY_SCOPE_AGENT); }
__device__ __forceinline__ unsigned xb_add(unsigned* p, unsigned v) { return __hip_atomic_fetch_add(p, v, __ATOMIC_RELAXED, __HIP_MEMORY_SCOPE_AGENT); }
__device__ __forceinline__ unsigned xb_xcc_id() { return (unsigned)__builtin_amdgcn_s_getreg((3 << 11) | 20) & 0xFu; }
#define XB_SPIN(cond, bar) do { unsigned _sp = 0; while (cond) { __builtin_amdgcn_s_sleep(1); \
    if ((++_sp & 255u) == 0u) { if (xb_ld(&(bar)[XB_TMO])) break; if (_sp > XB_SPIN_CAP) { atomicAdd(&(bar)[XB_TMO], 1u); break; } } } } while (0)

struct XcdBarrier {
    unsigned* bar; unsigned x;
    volatile LAS unsigned* st;
};

__device__ __forceinline__ XcdBarrier xcd_barrier_post(unsigned* bar, volatile LAS unsigned* st) {
    XcdBarrier b; b.bar = bar; b.x = xb_xcc_id(); b.st = st;
    if (opaque_tid() == 0) (void)xb_add(&bar[XB_XCNT(b.x)], 1u);
    return b;
}
__device__ __forceinline__ void xcd_barrier_complete(unsigned* bar, unsigned x, unsigned& nloc, unsigned& nx) {
    const unsigned G = gridDim.x * gridDim.y * gridDim.z;
    unsigned sum, cnt, mine, sp = 0u;
    for (;;) {
        sum = 0u; cnt = 0u; mine = 0u;
#pragma unroll
        for (unsigned j = 0; j < 16; ++j) { const unsigned c = xb_ld(&bar[XB_XCNT(j)]); sum += c; cnt += (c > 0u) ? 1u : 0u; mine = (j == x) ? c : mine; }
        if (sum == G) break;
        __builtin_amdgcn_s_sleep(1);
        if ((++sp & 255u) == 0u) { if (xb_ld(&bar[XB_TMO])) break; if (sp > XB_SPIN_CAP) { atomicAdd(&bar[XB_TMO], 1u); break; } }
    }
    nloc = mine > 0u ? mine : 1u; nx = cnt > 0u ? cnt : 1u;
}

__device__ __forceinline__ void xcd_barrier(const XcdBarrier& b) {
    asm volatile("s_waitcnt vmcnt(0)" ::: "memory");
    __syncthreads();
    if (opaque_tid() == 0) {
        unsigned* bar = b.bar;
        __builtin_amdgcn_s_waitcnt(0);
        unsigned nloc = b.st[0], nx = b.st[1];
        if (nloc == 0u) { xcd_barrier_complete(bar, b.x, nloc, nx); b.st[0] = nloc; b.st[1] = nx; }
        const unsigned old = xb_add(&bar[XB_XSUB(b.x)], 1u);
        const unsigned gen = old / nloc;
        if (old + 1u == (gen + 1u) * nloc) {
            __builtin_amdgcn_fence(__ATOMIC_RELEASE, "agent");
            asm volatile("s_waitcnt vmcnt(0)" ::: "memory");
            const unsigned og = xb_add(&bar[XB_TOP], 1u);
            const unsigned tg = og / nx;
            if (og + 1u == (tg + 1u) * nx) xb_add(&bar[XB_TOPGEN], 1u);
            else XB_SPIN(xb_ld(&bar[XB_TOPGEN]) == tg, bar);
            __builtin_amdgcn_fence(__ATOMIC_ACQUIRE, "agent");
            xb_add(&bar[XB_XGEN(b.x)], 1u);
            asm volatile("s_waitcnt vmcnt(0)" ::: "memory");
        } else {
            XB_SPIN(xb_ld(&bar[XB_XGEN(b.x)]) == gen, bar);
            __builtin_amdgcn_fence(__ATOMIC_ACQUIRE, "agent");
            asm volatile("s_waitcnt vmcnt(0)" ::: "memory");
        }
    }
    __syncthreads();
}

#ifndef WGM_G1
#define WGM_G1 2
#endif
#ifndef WGM_G2
#define WGM_G2 4
#endif
#ifndef WGM_G3
#define WGM_G3 4
#endif
#ifndef WGM_G4
#define WGM_G4 8
#endif
#ifndef PROBE_DUP
#define PROBE_DUP 0
#endif
#ifndef ITEM_MASK
#define ITEM_MASK 127
#endif
__global__ void __launch_bounds__(NTHR, 2) fwd_kernel(Args a) {
    extern __shared__ __attribute__((aligned(16))) unsigned char lds[];
    {
        volatile LAS unsigned* bst0 = (volatile LAS unsigned*)(lds + LDS_BYTES - 16);
        if (opaque_tid() == 0) { bst0[0] = 0u; bst0[1] = 0u; }
        __syncthreads();
        (void)xcd_barrier_post((unsigned*)(ws_() + WS_BAR), bst0);
    }
    if (PH_HI > 4096) cg::this_grid().sync();
#define SEAM(k) do { if ((k) + 1 < PH_HI) { XcdBarrier xb_; xb_.bar = (unsigned*)(ws_() + WS_BAR); xb_.x = xb_xcc_id(); xb_.st = (volatile LAS unsigned*)(lds + LDS_BYTES - 16); xcd_barrier(xb_); if (PROBE_DUP == 1) xcd_barrier(xb_); } } while (0)
#define IN(k) (PH_LO <= (k) && (k) < PH_HI)
    if (IN(0)) { prep_phase(a, lds); if (PROBE_DUP == 4) prep_phase(a, lds); SEAM(0); }
    for (int l = 0; l < DEPTH; ++l) {
        const int pb = 1 + 8 * l;
        if (l == 0 && IN(pb + 0)) {
            norm_phase<false, 1>(INP(0), nullptr, (bf16_t*)(ws_() + WS_H), (float*)(ws_() + WS_SS2), nullptr, (const float*)(ws_() + WS_WF), INP(23), (float*)(ws_() + WS_LOGF));
            SEAM(pb + 0);
        }
        if (IN(pb + 1)) {
            pg8::Gemm g{(const pg8::bf16_t*)(ws_() + WS_H), (const pg8::bf16_t*)(ws_() + WS_WIN) + (size_t)l * ZW * DM, T, ZW, DM}; pg8::StaticOrder S; S.init(T, ZW, grid_(), bid_(), WGM_G1);
            EpiStoreBf16<0, true> E{(bf16_t*)(ws_() + WS_Z), ZW, (const float*)(ws_() + WS_SS2)};
            pg8::gemm_phase<EpiStoreBf16<0, true>, pg8::StaticOrder, true, true>((PG8_LAS unsigned char*)lds, g, S, E);
            if (PROBE_DUP == 9) pg8::gemm_phase<EpiStoreBf16<0, true>, pg8::StaticOrder, true, true>((PG8_LAS unsigned char*)lds, g, S, E);
            if (l > 0) norm_phase<true, 1>(ws_() + WS_H, nullptr, nullptr, nullptr, nullptr, (const float*)(ws_() + WS_WF) + (size_t)l * DM * 4, INP(23) + l * 4, (float*)(ws_() + WS_LOGF));
            SEAM(pb + 1);
        }
        if (IN(pb + 2)) {
            for (int rep = 0; rep < (PROBE_DUP == 2 ? 2 : 1); ++rep)
            {
            for (int it = bid_(); it < 256; it += grid_()) {
                if (it < 128) { if (ITEM_MASK & 1) s5_item<1>(l, it >> 5, it & 31, a, lds); }
                else { if (ITEM_MASK & 4) lru_item<1>(l, (it - 128) >> 5, (it - 128) & 31, a, lds); }
            }
            const int cb_ = (grid_() >= 132) ? bid_() - 128 : bid_();
            if (cb_ >= 0 && cb_ < 4) { if (ITEM_MASK & 8) cumsum_item(cb_, (const float*)(ws_() + WS_LOGF), (float*)(ws_() + WS_CS), lds); }
            }
            SEAM(pb + 2);
        }
        if (IN(pb + 3)) {
            for (int rep = 0; rep < (PROBE_DUP == 3 ? 2 : 1); ++rep) {
            for (int rep2 = 0; rep2 < (PROBE_DUP == 5 ? 2 : 1); ++rep2)
            for (int up = bid_(); up < 256; up += grid_()) {
                const int xcd_ = up & 7, ix_ = up >> 3, pr = xcd_ + 8 * (ix_ >> 4), j = ix_ & 15;
                if (ITEM_MASK & 16) { attn_unit(pr >> 2, pr & 3, 31 - j, a, lds);
                attn_unit(pr >> 2, pr & 3, j, a, lds); }
            }
            for (int rep3 = 0; rep3 < (PROBE_DUP == 6 ? 2 : 1); ++rep3)
            for (int it = bid_(); it < 256; it += grid_()) {
                if (it < 128) { if (ITEM_MASK & 32) s5_item<2>(l, it >> 5, it & 31, a, lds); }
                else { if (ITEM_MASK & 64) lru_item<2>(l, (it - 128) >> 5, (it - 128) & 31, a, lds); }
            }
            if (ITEM_MASK & 2) {
                unsigned* qctr = (unsigned*)(ws_() + WS_BAR) + 3600 + l;
                volatile LAS unsigned* qslot = (volatile LAS unsigned*)(lds + LDS_BYTES - 48);
                for (;;) {
                    __syncthreads();
                    if (opaque_tid() == 0) qslot[0] = __hip_atomic_fetch_add(qctr, 1u, __ATOMIC_RELAXED, __HIP_MEMORY_SCOPE_AGENT);
                    __syncthreads();
                    const unsigned qi = qslot[0];
                    if (qi >= 256u) break;
                    if (qi < 128u) sgu_item<1>(l, (int)(qi >> 5), (int)(qi & 31), a, lds);
                    else sgu_item<0>(l, (int)((qi - 128u) >> 5), (int)(qi & 31), a, lds);
                }
            }
            }
            SEAM(pb + 3);
        }
        if (IN(pb + 4)) {
            pg8::Gemm g{(const pg8::bf16_t*)(ws_() + WS_Y), (const pg8::bf16_t*)(ws_() + WS_WOUT) + (size_t)l * DM * DM, T, DM, DM}; pg8::StaticOrder S; S.init(T, DM, grid_(), bid_(), WGM_G2);
            EpiRes<true, true> E{(bf16_t*)(ws_() + WS_H), DM, (const float*)(ws_() + WS_SSD), (float*)(ws_() + WS_SS2)};
            pg8::gemm_phase<EpiRes<true, true>, pg8::StaticOrder, true, true>((PG8_LAS unsigned char*)lds, g, S, E);
            SEAM(pb + 4);
        }
        if (IN(pb + 6)) {
            pg8::Gemm g{(const pg8::bf16_t*)(ws_() + WS_H), (const pg8::bf16_t*)(ws_() + WS_WMI) + (size_t)l * DFF * DM, T, DFF, DM}; pg8::StaticOrder S; S.init(T, DFF, grid_(), bid_(), WGM_G3);
            EpiStoreBf16<1, true> E{(bf16_t*)(ws_() + WS_ACT), DFF, (const float*)(ws_() + WS_SS2)};
            pg8::gemm_phase<EpiStoreBf16<1, true>, pg8::StaticOrder, true, true>((PG8_LAS unsigned char*)lds, g, S, E);
            SEAM(pb + 6);
        }
        if (IN(pb + 7)) {
            pg8::Gemm g{(const pg8::bf16_t*)(ws_() + WS_ACT), (const pg8::bf16_t*)(ws_() + WS_WMO) + (size_t)l * DM * DFF, T, DM, DFF}; pg8::StaticOrder S; S.init(T, DM, grid_(), bid_(), WGM_G4);
            EpiRes<false, true> E{(bf16_t*)(ws_() + WS_H), DM, nullptr, (float*)(ws_() + WS_SS2)};
            pg8::gemm_phase<EpiRes<false, true>, pg8::StaticOrder, true, true>((PG8_LAS unsigned char*)lds, g, S, E);
            SEAM(pb + 7);
        }
    }
    if (IN(33)) norm_phase<true, 2>(ws_() + WS_H, INP(29), nullptr, nullptr, out_(), nullptr, nullptr, nullptr);
#undef SEAM
#undef IN
}


#ifndef DUMP_SEL
#define DUMP_SEL 0
#endif
#ifndef DUMP_LAST
#define DUMP_LAST 33
#endif
__global__ void dump_kernel(const unsigned char* ws, float* out) {
    const size_t i = (size_t)blockIdx.x * blockDim.x + threadIdx.x;
    const size_t t = i >> 10, c = i & 1023;
    float v = 0.f;
    if (DUMP_SEL == 1) v = bf2f(((const bf16_t*)(ws + WS_H))[i]);
    if (DUMP_SEL == 2) v = bf2f(((const bf16_t*)(ws + WS_Z))[t * ZW + c]) + bf2f(((const bf16_t*)(ws + WS_Z))[t * ZW + c + 1024]);
    if (DUMP_SEL == 3) v = bf2f(((const bf16_t*)(ws + WS_Y))[i]);
    if (DUMP_SEL == 5) v = ((const float*)(ws + WS_SSD))[(t * 4 + (c & 3))] + ((const float*)(ws + WS_CS))[(t * 4 + (c & 3))];
    if (DUMP_SEL == 7) v = ((const float*)(ws + WS_ELOC))[i & 262143];
    if (DUMP_SEL == 8) v = ((const float*)(ws + WS_LA))[i & 32767] + ((const float*)(ws + WS_LB))[i & 32767];
    if (DUMP_SEL == 6) v = bf2f(((const bf16_t*)(ws + WS_WIN))[i]) + bf2f(((const bf16_t*)(ws + WS_WMI))[i]) + bf2f(((const bf16_t*)(ws + WS_WMO))[i]) + bf2f(((const bf16_t*)(ws + WS_WOUT))[i & 0x3fffff]);
    out[i] = v;
}
#ifndef N_LAUNCH_MODE
#define N_LAUNCH_MODE 1
#endif
extern "C" void kernel_launch(void* const* d_in, const int* in_sizes, int n_in, void* d_out, int out_size, void* d_ws, size_t ws_size, hipStream_t stream) {
    static int grid = 0;
    if (grid == 0) {
        if (n_in != 30 || out_size != T * DM || ws_size < WS_END) { fprintf(stderr, "kernel_launch: unexpected shapes (n_in %d, out %d, ws %zu, need %zu)\n", n_in, out_size, ws_size, (size_t)WS_END); grid = -1; return; }
        int dev = 0, cus = 0, per_cu = 0;
        hipGetDevice(&dev); hipDeviceGetAttribute(&cus, hipDeviceAttributeMultiprocessorCount, dev);
        if (hipFuncSetAttribute((const void*)fwd_kernel, hipFuncAttributeMaxDynamicSharedMemorySize, LDS_BYTES) != hipSuccess) { fprintf(stderr, "kernel_launch: hipFuncSetAttribute failed\n"); grid = -1; return; }
        if (hipOccupancyMaxActiveBlocksPerMultiprocessor(&per_cu, (const void*)fwd_kernel, NTHR, LDS_BYTES) != hipSuccess || per_cu < 1) { fprintf(stderr, "kernel_launch: occupancy query says %d\n", per_cu); per_cu = 1; }
        (void)hipGetLastError();
        grid = cus;
        if (grid > 256) grid = 256;
    }
    if (grid < 0) return;
    Args a{};
    for (int i = 0; i < 30; ++i) a.in[i] = (const float*)d_in[i];
    a.out = (float*)d_out; a.ws = (unsigned char*)d_ws;
    if (N_LAUNCH_MODE == 1) {
        a.ph_lo = 0; a.ph_hi = 34;
        if (hipMemsetAsync((unsigned char*)d_ws + WS_BAR, 0, 16 * 1024, stream) != hipSuccess) { fprintf(stderr, "kernel_launch: memset of the barrier words failed\n"); return; }
        void* args[] = {&a};
        hipError_t e = hipLaunchCooperativeKernel((const void*)fwd_kernel, dim3(grid), dim3(NTHR), args, LDS_BYTES, stream);
        if (e != hipSuccess) fprintf(stderr, "kernel_launch: cooperative launch failed: %s (grid %d)\n", hipGetErrorString(e), grid);
    } else {
        for (int ph = 0; ph <= DUMP_LAST; ++ph) { a.ph_lo = ph; a.ph_hi = ph + 1; hipLaunchKernelGGL(fwd_kernel, dim3(grid), dim3(NTHR), LDS_BYTES, stream, a); }
        if (DUMP_SEL != 0 && DUMP_SEL != 4) hipLaunchKernelGGL(dump_kernel, dim3(T * DM / 256), dim3(256), 0, stream, (const unsigned char*)d_ws, (float*)d_out);
    }
}
```

```cpp
#include <hip/hip_runtime.h>
#include <hip/hip_cooperative_groups.h>
#include <cstdio>
#include <cstdint>
namespace cg = cooperative_groups;
__device__ __forceinline__ int opaque_tid() { int t = __builtin_amdgcn_workitem_id_x(); asm volatile("" : "+v"(t)); return t; }
namespace pg8 {
#define PG8_LAS __attribute__((address_space(3)))
typedef unsigned short bf16_t;
typedef short bf16x8 __attribute__((ext_vector_type(8)));
typedef float f32x4 __attribute__((ext_vector_type(4)));
typedef unsigned u32x4 __attribute__((ext_vector_type(4)));
constexpr int BM = 256, BK = 64, HALF = 128, HTB = HALF * BK * 2  , STAGE_BYTES = 8 * HTB, NXCD = 8, WGM = 4;

__host__ __device__ __forceinline__ int lds_byte(int r, int c) { const int st = (r >> 4) * 2 + (c >> 5), rr = r & 15, cc = c & 31, ob = rr * 64 + cc * 2; return st * 1024 + (ob ^ (((ob >> 9) & 1) << 5)); }
__host__ __device__ __forceinline__ void stage_rc(int b, int& R, int& C) { const int st = b / 1024, sb = b % 1024, swz = sb ^ (((sb >> 9) & 1) << 5); R = (st >> 1) * 16 + swz / 64; C = (st & 1) * 32 + (swz % 64) / 2; }
__host__ __device__ __forceinline__ int perm32(int rho) { const int n = rho >> 4, i = rho & 15; return 8 * (i >> 2) + 4 * n + (i & 3); }

struct Unit { int pm, pn; };
struct Gemm { const bf16_t* A; const bf16_t* Bt; int M, N, K; };

struct StaticOrder {
    int nM, nN, nwg, G, c, wgm;
    __host__ __device__ void init(int M, int N, int G_, int c_, int wgm_ = WGM) { nM = M / BM; nN = N / BM; nwg = nM * nN; G = G_; c = c_; wgm = wgm_; }
    __host__ __device__ bool next(int i, Unit& u) const {
        const long L = (long)i * G + c; if (L >= nwg) return false;
        int wgid = (int)L; { const int q = nwg / NXCD, r = nwg % NXCD, xcd = wgid % NXCD, off = wgid / NXCD; wgid = (xcd < r ? xcd * (q + 1) : r * (q + 1) + (xcd - r) * q) + off; }
        const int nig = wgm * nN, gid = wgid / nig, fm = gid * wgm, gsz = (nM - fm) < wgm ? (nM - fm) : wgm;
        u.pm = fm + ((wgid % nig) % gsz); u.pn = (wgid % nig) / gsz; return true;
    }
    __device__ __forceinline__ void a_ready(const Unit&) const {}
    __device__ __forceinline__ void done(const Unit&) const {}
};

__device__ __forceinline__ unsigned cvt_pk_bf16(float lo, float hi) { unsigned r; asm volatile("v_cvt_pk_bf16_f32 %0, %1, %2" : "=v"(r) : "v"(lo), "v"(hi)); return r; }
template <class Epi, class Sched, bool ALIGN_EPI = false, bool SP2 = false>
__device__ __forceinline__ void gemm_phase(PG8_LAS unsigned char* lds, const Gemm g, const Sched& S, const Epi& E) {
    const int tid = opaque_tid(), wid = __builtin_amdgcn_readfirstlane(tid >> 6), lane = tid & 63, wr = wid >> 2, wc = wid & 3, fr = lane & 15, fq = lane >> 4;
    const int K = g.K, nt = K / BK;
    unsigned voffA[2], voffB[2];
#pragma unroll
    for (int i = 0; i < 2; ++i) { int R, C; stage_rc(tid * 16 + i * 8192, R, C); const int Rb = Epi::PERM ? ((R & ~31) + perm32(R & 31)) : R;
        voffA[i] = (unsigned)(R * K + C) * 2u; voffB[i] = (unsigned)(Rb * K + C) * 2u; }
    const size_t kstep = (size_t)(BK * 2);
    const size_t hstep = (size_t)HALF * K * 2;
    const size_t tstep = 2 * hstep;
    const unsigned ldsw = (unsigned)wid * 1024u;
    const int aoff = lds_byte(wr * 64 + fr, fq * 8), boff = lds_byte(wc * 32 + fr, fq * 8);
#define PG8_SA(b, h) (((b) * 2 + (h)) * HTB)
#define PG8_SB(b, h) ((4 + (b) * 2 + (h)) * HTB)
#define PG8_STAGE(bufoff, gbase, voff) do { _Pragma("unroll") for (int _i = 0; _i < 2; ++_i) \
        __builtin_amdgcn_global_load_lds((const unsigned*)((const char*)(gbase) + (voff)[_i]), (PG8_LAS unsigned*)(lds + (bufoff) + ldsw + _i * 8192), 16, 0, 0); } while (0)
#define PG8_LDA(dst, b, h) do { _Pragma("unroll") for (int m = 0; m < 4; ++m) _Pragma("unroll") for (int k = 0; k < 2; ++k) dst[m][k] = *(const PG8_LAS bf16x8*)(lds + PG8_SA(b, h) + aoff + m * 2048 + k * 1024); } while (0)
#define PG8_LDB(dst, b, h) do { _Pragma("unroll") for (int n = 0; n < 2; ++n) _Pragma("unroll") for (int k = 0; k < 2; ++k) dst[n][k] = *(const PG8_LAS bf16x8*)(lds + PG8_SB(b, h) + boff + n * 2048 + k * 1024); } while (0)
#define PG8_MMA(ai, bj, At, Bt) do { __builtin_amdgcn_s_setprio(1); _Pragma("unroll") for (int m = 0; m < 4; ++m) _Pragma("unroll") for (int n = 0; n < 2; ++n) _Pragma("unroll") for (int k = 0; k < 2; ++k) \
        acc[ai][bj][m][n] = __builtin_amdgcn_mfma_f32_16x16x32_bf16(Bt[n][k], At[m][k], acc[ai][bj][m][n], 0, 0, 0); __builtin_amdgcn_s_setprio(0); } while (0)
#define PG8_WAIT_V(n) asm volatile("s_waitcnt vmcnt(" #n ")" ::: "memory")
#define PG8_WAIT_L(n) asm volatile("s_waitcnt lgkmcnt(" #n ")" ::: "memory")
#define PG8_BAR __builtin_amdgcn_s_barrier()
#define PG8_SCHED __builtin_amdgcn_sched_barrier(0)
    Unit cur, nxt; int ui = 0;
    if (!S.next(0, cur)) return;
    if constexpr (Epi::KPREP) { Unit pu; for (int i = 0; i < 12 && S.next(i, pu); ++i) E.kprep(pu, lds + STAGE_BYTES + i * 1024, tid); }
    f32x4 acc[2][2][4][2];
#pragma unroll
    for (int a = 0; a < 2; ++a)
#pragma unroll
        for (int b = 0; b < 2; ++b)
#pragma unroll
            for (int m = 0; m < 4; ++m)
#pragma unroll
                for (int n = 0; n < 2; ++n) acc[a][b][m][n] = (f32x4){0.f, 0.f, 0.f, 0.f};
    bf16x8 At[4][2], B0[2][2], B1[2][2];
    const char* cA = (const char*)g.A + (size_t)cur.pm * tstep; const char* cB = (const char*)g.Bt + (size_t)cur.pn * tstep;
    S.a_ready(cur);
    if constexpr (SP2) {
        PG8_STAGE(PG8_SB(0, 0), cB, voffB); PG8_STAGE(PG8_SB(0, 1), cB + hstep, voffB); PG8_STAGE(PG8_SA(0, 0), cA, voffA); PG8_STAGE(PG8_SA(0, 1), cA + hstep, voffA);
        if (wr == 1) PG8_BAR;
        PG8_WAIT_V(2); PG8_BAR;
        PG8_STAGE(PG8_SB(1, 0), cB + kstep, voffB); PG8_STAGE(PG8_SA(1, 0), cA + kstep, voffA); PG8_STAGE(PG8_SB(1, 1), cB + hstep + kstep, voffB);
        PG8_WAIT_V(6); PG8_BAR;
    } else {
        PG8_STAGE(PG8_SB(0, 0), cB, voffB); PG8_STAGE(PG8_SA(0, 0), cA, voffA); PG8_STAGE(PG8_SB(0, 1), cB + hstep, voffB); PG8_STAGE(PG8_SA(0, 1), cA + hstep, voffA);
        if (wr == 1) PG8_BAR;
        PG8_WAIT_V(4); PG8_BAR;
        PG8_STAGE(PG8_SB(1, 0), cB + kstep, voffB); PG8_STAGE(PG8_SA(1, 0), cA + kstep, voffA); PG8_STAGE(PG8_SB(1, 1), cB + hstep + kstep, voffB);
        PG8_WAIT_V(6); PG8_BAR;
    }
    for (;;) {
        const bool has_next = S.next(ui + 1, nxt);
        const char* nA = has_next ? (const char*)g.A + (size_t)nxt.pm * tstep : cA; const char* nB = has_next ? (const char*)g.Bt + (size_t)nxt.pn * tstep : cB;
        for (int t = 0; t < nt; t += 2) {
            const bool last = (t == nt - 2);
            const char* a1 = cA + (size_t)(t + 1) * kstep;
            const char* a2 = last ? nA : cA + (size_t)(t + 2) * kstep; const char* b2 = last ? nB : cB + (size_t)(t + 2) * kstep;
            const char* a3 = a2 + kstep; const char* b3 = b2 + kstep;
            if (last && has_next) S.a_ready(nxt);
            if constexpr (SP2) {
            PG8_LDB(B0, 0, 0); PG8_LDB(B1, 0, 1); PG8_SCHED; PG8_LDA(At, 0, 0); PG8_STAGE(PG8_SA(1, 1), a1 + hstep, voffA);
            PG8_WAIT_V(8); PG8_WAIT_L(0); PG8_BAR; PG8_MMA(0, 0, At, B0); PG8_MMA(0, 1, At, B1); PG8_BAR; PG8_SCHED;
            PG8_LDA(At, 0, 1); PG8_STAGE(PG8_SB(0, 0), b2, voffB); PG8_STAGE(PG8_SB(0, 1), b2 + hstep, voffB); PG8_STAGE(PG8_SA(0, 0), a2, voffA);
            PG8_WAIT_V(8); PG8_WAIT_L(0); PG8_BAR; PG8_MMA(1, 0, At, B0); PG8_MMA(1, 1, At, B1); PG8_BAR; PG8_SCHED;
            PG8_LDB(B0, 1, 0); PG8_LDB(B1, 1, 1); PG8_SCHED; PG8_LDA(At, 1, 0); PG8_STAGE(PG8_SA(0, 1), a2 + hstep, voffA);
            PG8_WAIT_V(8); PG8_WAIT_L(0); PG8_BAR; PG8_MMA(0, 0, At, B0); PG8_MMA(0, 1, At, B1); PG8_BAR; PG8_SCHED;
            PG8_LDA(At, 1, 1); PG8_STAGE(PG8_SB(1, 0), b3, voffB); PG8_STAGE(PG8_SB(1, 1), b3 + hstep, voffB); PG8_STAGE(PG8_SA(1, 0), a3, voffA);
            PG8_WAIT_V(8); PG8_WAIT_L(0); PG8_BAR; PG8_MMA(1, 0, At, B0); PG8_MMA(1, 1, At, B1); PG8_BAR; PG8_SCHED;
            } else {
            PG8_LDB(B0, 0, 0); PG8_SCHED; PG8_LDA(At, 0, 0); PG8_STAGE(PG8_SA(1, 1), a1 + hstep, voffA);
            PG8_WAIT_L(8); PG8_BAR; PG8_WAIT_L(0); PG8_MMA(0, 0, At, B0); PG8_BAR; PG8_SCHED;
            PG8_LDB(B1, 0, 1); PG8_STAGE(PG8_SB(0, 0), b2, voffB);
            PG8_BAR; PG8_WAIT_L(0); PG8_MMA(0, 1, At, B1); PG8_BAR;
            PG8_LDA(At, 0, 1); PG8_STAGE(PG8_SA(0, 0), a2, voffA);
            PG8_BAR; PG8_WAIT_L(0); PG8_MMA(1, 0, At, B0); PG8_BAR; PG8_SCHED;
            PG8_STAGE(PG8_SB(0, 1), b2 + hstep, voffB);
            PG8_WAIT_V(6); PG8_BAR; PG8_MMA(1, 1, At, B1); PG8_BAR;
            PG8_LDB(B0, 1, 0); PG8_SCHED; PG8_LDA(At, 1, 0); PG8_STAGE(PG8_SA(0, 1), a2 + hstep, voffA);
            PG8_WAIT_L(8); PG8_BAR; PG8_WAIT_L(0); PG8_MMA(0, 0, At, B0); PG8_BAR; PG8_SCHED;
            PG8_LDB(B1, 1, 1); PG8_STAGE(PG8_SB(1, 0), b3, voffB);
            PG8_BAR; PG8_WAIT_L(0); PG8_MMA(0, 1, At, B1); PG8_BAR;
            PG8_LDA(At, 1, 1); PG8_STAGE(PG8_SA(1, 0), a3, voffA);
            PG8_BAR; PG8_WAIT_L(0); PG8_MMA(1, 0, At, B0); PG8_BAR; PG8_SCHED;
            PG8_STAGE(PG8_SB(1, 1), b3 + hstep, voffB);
            PG8_WAIT_V(6); PG8_BAR; PG8_MMA(1, 1, At, B1); PG8_BAR;
            }
            if constexpr (Epi::KHOOK) { if (t == 2) E.khook(acc, lds + STAGE_BYTES + ui * 1024, wr, fr); }
        }
        if constexpr (ALIGN_EPI) { if (wr == 0) PG8_BAR; }
        if constexpr (!Epi::AFTER_DRAIN) { E(acc, cur, wr, wc, fr, fq, lds + STAGE_BYTES + ui * 1024); S.done(cur); }
        if (!has_next) break;
#pragma unroll
        for (int a = 0; a < 2; ++a)
#pragma unroll
            for (int b = 0; b < 2; ++b)
#pragma unroll
                for (int m = 0; m < 4; ++m)
#pragma unroll
                    for (int n = 0; n < 2; ++n) acc[a][b][m][n] = (f32x4){0.f, 0.f, 0.f, 0.f};
        cur = nxt; cA = nA; cB = nB; ++ui;
        if constexpr (ALIGN_EPI) { if (wr == 1) PG8_BAR; }
    }
    PG8_WAIT_V(0);
    if constexpr (!ALIGN_EPI) { if (wr == 0) PG8_BAR; }
    PG8_BAR;
    if constexpr (Epi::AFTER_DRAIN) { E.fused(acc, cur, wr, wc, fr, fq, lds, wid, lane); S.done(cur); }
#undef PG8_SA
#undef PG8_SB
#undef PG8_STAGE
#undef PG8_LDA
#undef PG8_LDB
#undef PG8_MMA
#undef PG8_WAIT_V
#undef PG8_WAIT_L
#undef PG8_BAR
#undef PG8_SCHED
}
}

#define LAS __attribute__((address_space(3)))
typedef unsigned short bf16_t;
typedef short bf16x8 __attribute__((ext_vector_type(8)));
typedef short bf16x4 __attribute__((ext_vector_type(4)));
typedef float f32x4 __attribute__((ext_vector_type(4)));
typedef float f32x2 __attribute__((ext_vector_type(2)));
typedef unsigned u32x4 __attribute__((ext_vector_type(4)));
typedef unsigned u32x2 __attribute__((ext_vector_type(2)));
typedef short v4i16_t __attribute__((ext_vector_type(4)));

constexpr int NB = 4, SEQ = 4096, DM = 1024, DEPTH = 4, T = NB * SEQ, W = 256, DFF = 4096, NIN = 2052, ZW = 2048;
constexpr int NCH = SEQ / 128;
constexpr float EPS = 1e-6f;
constexpr float LOG2E = 1.4426950408889634f;
constexpr int NTHR = 512;
constexpr int LDS_BYTES = 147456;
constexpr int ZC_AU = 0, ZC_AV = 256, ZC_B = 512, ZC_CX = 768, ZC_CG = 1024, ZC_Q = 1280, ZC_K = 1536, ZC_V = 1792;
constexpr int YC_D = 0, YC_A = 256, YC_B = 512, YC_C = 768;

constexpr size_t MiB = 1u << 20;
constexpr size_t WS_WIN = 0, WS_WOUT = 16 * MiB, WS_WMI = 24 * MiB, WS_WMO = 56 * MiB, WS_R = 88 * MiB, WS_Z = WS_R, WS_Y = WS_R + 64 * MiB, WS_ACT = WS_R,
                 WS_H = 216 * MiB, WS_S = 248 * MiB;
constexpr size_t WS_GLUT = WS_S, WS_WAT = WS_GLUT + 512 * 1024, WS_WXT = WS_WAT + 128 * 1024, WS_BBT = WS_WXT + 128 * 1024, WS_CMT = WS_BBT + 256 * 1024,
                 WS_ABAR = WS_CMT + 256 * 1024, WS_A128 = WS_ABAR + 32 * 1024, WS_WF = WS_A128 + 32 * 1024, WS_LOGF = WS_WF + 64 * 1024, WS_CS = WS_LOGF + 256 * 1024,
                 WS_SSD = WS_CS + 256 * 1024, WS_ELOC = WS_SSD + 256 * 1024, WS_LA = WS_ELOC + 1024 * 1024, WS_LB = WS_LA + 128 * 1024, WS_BAR = WS_LB + 128 * 1024, WS_SS2 = WS_BAR + 16 * 1024, WS_KMAX = WS_SS2 + 1024 * 1024, WS_END = WS_KMAX + 4096;

struct Args {
    const float* in[30]; float* out; unsigned char* ws; int ph_lo, ph_hi;
};


typedef const __attribute__((address_space(4))) unsigned long long* kargp_t;
__device__ __forceinline__ unsigned long long karg_(int i) { kargp_t tab = (kargp_t)__builtin_amdgcn_kernarg_segment_ptr(); asm volatile("" : "+s"(tab)); return tab[i]; }
#define INP(i) ((const float*)karg_(i))
__device__ __forceinline__ unsigned char* ws_() { return (unsigned char*)karg_(31); }
__device__ __forceinline__ float* out_() { return (float*)karg_(30); }
#define PH_LO ((int)(unsigned)(karg_(32) & 0xffffffffull))
#define PH_HI ((int)(unsigned)(karg_(32) >> 32))
__device__ __forceinline__ int bid_() { return blockIdx.x; }
__device__ __forceinline__ int grid_() { return gridDim.x; }
__device__ __forceinline__ float bf2f(bf16_t v) { return __uint_as_float((unsigned)v << 16); }
__device__ __forceinline__ float bfs2f(short v) { return __uint_as_float(((unsigned)(unsigned short)v) << 16); }
typedef __bf16 bf16x2_t __attribute__((ext_vector_type(2)));
__device__ __forceinline__ unsigned pk2(float lo, float hi) { const f32x2 v = {lo, hi}; const bf16x2_t b = __builtin_convertvector(v, bf16x2_t); return __builtin_bit_cast(unsigned, b); }
__device__ __forceinline__ bf16_t f2bf(float f) { return (bf16_t)(pk2(f, 0.f) & 0xffffu); }
__device__ __forceinline__ float gelu_t(float x) { const float y2 = (1.5957691216057308f * LOG2E) * (x + 0.044715f * x * x * x); return x * __builtin_amdgcn_rcpf(1.0f + __builtin_amdgcn_exp2f(-y2)); }
__device__ __forceinline__ float sigm(float x) { return __builtin_amdgcn_rcpf(1.0f + __builtin_amdgcn_exp2f(-LOG2E * x)); }
__device__ __forceinline__ float softplus_f(float x) { return fmaxf(x, 0.f) + log1pf(__expf(-fabsf(x))); }
__device__ __forceinline__ f32x4 mfma16(bf16x8 a, bf16x8 b, f32x4 c) { return __builtin_amdgcn_mfma_f32_16x16x32_bf16(a, b, c, 0, 0, 0); }
__device__ __forceinline__ float quad_sum(float v) {
    { const auto r = __builtin_amdgcn_permlane16_swap(__float_as_uint(v), __float_as_uint(v), false, false); v = __uint_as_float(r[0]) + __uint_as_float(r[1]); }
    { const auto r = __builtin_amdgcn_permlane32_swap(__float_as_uint(v), __float_as_uint(v), false, false); v = __uint_as_float(r[0]) + __uint_as_float(r[1]); }
    return v;
}
template <int CTRL> __device__ __forceinline__ float dpp_mov(float x) { return __uint_as_float((unsigned)__builtin_amdgcn_update_dpp(0, (int)__float_as_uint(x), CTRL, 0xf, 0xf, true)); }
__device__ __forceinline__ float wave_sum(float v) {
    v += dpp_mov<0xB1>(v); v += dpp_mov<0x4E>(v); v += dpp_mov<0x141>(v); v += dpp_mov<0x140>(v);
    return quad_sum(v);
}
__device__ __forceinline__ float wave_max(float v);
__device__ __forceinline__ float quad_max(float v) {
    { const auto r = __builtin_amdgcn_permlane16_swap(__float_as_uint(v), __float_as_uint(v), false, false); v = fmaxf(__uint_as_float(r[0]), __uint_as_float(r[1])); }
    { const auto r = __builtin_amdgcn_permlane32_swap(__float_as_uint(v), __float_as_uint(v), false, false); v = fmaxf(__uint_as_float(r[0]), __uint_as_float(r[1])); }
    return v;
}
__device__ __forceinline__ bf16x8 pack8(const float* v) {
    u32x4 w; w.x = pk2(v[0], v[1]); w.y = pk2(v[2], v[3]); w.z = pk2(v[4], v[5]); w.w = pk2(v[6], v[7]); return __builtin_bit_cast(bf16x8, w);
}
__device__ __forceinline__ bf16x8 zero8() { return (bf16x8){0, 0, 0, 0, 0, 0, 0, 0}; }

__device__ __forceinline__ float wave_max(float v) {
    v = fmaxf(v, dpp_mov<0xB1>(v)); v = fmaxf(v, dpp_mov<0x4E>(v)); v = fmaxf(v, dpp_mov<0x141>(v)); v = fmaxf(v, dpp_mov<0x140>(v));
    return quad_max(v);
}
template <int N> __device__ __forceinline__ float dpp_shr(float x, float ident) {
    return __uint_as_float((unsigned)__builtin_amdgcn_update_dpp((int)__float_as_uint(ident), (int)__float_as_uint(x), 0x110 + N, 0xf, 0xf, false));
}
__device__ __forceinline__ float neg_expm1(float x) {
    const float s = -x * (1.0f + x * (0.5f + x * (0.16666667f + x * (0.041666668f + x * (0.0083333338f + x * 0.0013888889f)))));
    const float e = 1.0f - __builtin_amdgcn_exp2f(LOG2E * x);
    return (x > -0.25f) ? s : e;
}
template <int ACT  , bool ROWS = false> struct EpiStoreBf16 {
    static constexpr bool PERM = true, AFTER_DRAIN = false, KHOOK = false, KPREP = ROWS;
    __device__ __forceinline__ void kprep(const pg8::Unit& u, PG8_LAS unsigned char* tab, int tid) const {
        if (tid < 256) { const float* rp = rowss + (size_t)(u.pm * 256 + tid) * 16; const f32x4 s0 = *(const f32x4*)rp, s1 = *(const f32x4*)(rp + 4), s2 = *(const f32x4*)(rp + 8), s3 = *(const f32x4*)(rp + 12);
            const float tot = ((s0[0] + s0[1]) + (s0[2] + s0[3])) + ((s1[0] + s1[1]) + (s1[2] + s1[3])) + ((s2[0] + s2[1]) + (s2[2] + s2[3])) + ((s3[0] + s3[1]) + (s3[2] + s3[3]));
            ((PG8_LAS float*)tab)[tid] = rsqrtf(tot * (1.0f / DM) + EPS); }
    }
    bf16_t* O; int ldc; const float* rowss;
    __device__ __forceinline__ void operator()(const pg8::f32x4 (&acc)[2][2][4][2], const pg8::Unit& u, int wr, int wc, int fr, int fq, PG8_LAS unsigned char* tab) const {
        const int row0 = u.pm * 256 + wr * 64 + fr, col0 = u.pn * 256 + wc * 32 + 8 * fq;
#pragma unroll
        for (int ai = 0; ai < 2; ++ai)
#pragma unroll
            for (int m = 0; m < 4; ++m) { bf16_t* rowp = O + (size_t)(row0 + ai * 128 + m * 16) * ldc + col0;
                const float rsc = ROWS ? ((const PG8_LAS float*)tab)[wr * 64 + fr + ai * 128 + m * 16] : 1.0f;
#pragma unroll
                for (int bj = 0; bj < 2; ++bj) { pg8::f32x4 v0 = acc[ai][bj][m][0] * rsc, v1 = acc[ai][bj][m][1] * rsc;
                    if (ACT == 1) {
#pragma unroll
                        for (int e = 0; e < 4; ++e) { const float a = fmaxf(v0[e], 0.f), b = fmaxf(v1[e], 0.f); v0[e] = a * a; v1[e] = b * b; } }
                    u32x4 w; w.x = pk2(v0[0], v0[1]); w.y = pk2(v0[2], v0[3]); w.z = pk2(v1[0], v1[1]); w.w = pk2(v1[2], v1[3]);
                    *(u32x4*)(rowp + bj * 128) = w; } }
    }
};
template <bool HOOK, bool NORMOUT> struct EpiRes {
    static constexpr bool PERM = true, AFTER_DRAIN = false, KHOOK = HOOK, KPREP = HOOK;
    bf16_t* xb; int ldc; const float* ssd; float* ss2;
    __device__ __forceinline__ void operator()(const pg8::f32x4 (&acc)[2][2][4][2], const pg8::Unit& u, int wr, int wc, int fr, int fq, PG8_LAS unsigned char* tab) const {
        const int col0 = u.pn * 256 + wc * 32 + 8 * fq;
#pragma unroll
        for (int ai = 0; ai < 2; ++ai)
#pragma unroll
            for (int m = 0; m < 4; ++m) { const int row = u.pm * 256 + ai * 128 + wr * 64 + m * 16 + fr; bf16_t* rowp = xb + (size_t)row * ldc + col0; float sq = 0.f;
#pragma unroll
                for (int bj = 0; bj < 2; ++bj) { const bf16x8 s = *(const bf16x8*)(rowp + bj * 128); float o[8];
#pragma unroll
                    for (int e = 0; e < 4; ++e) { o[e] = bfs2f(s[e]) + acc[ai][bj][m][0][e]; o[4 + e] = bfs2f(s[4 + e]) + acc[ai][bj][m][1][e]; }
                    if (NORMOUT) {
#pragma unroll
                        for (int e = 0; e < 8; ++e) sq += o[e] * o[e]; }
                    *(bf16x8*)(rowp + bj * 128) = pack8(o); }
                if (NORMOUT) { sq = quad_sum(sq); if (fq == 0) ss2[(size_t)row * 16 + u.pn * 4 + wc] = sq; }
                if (m & 1) asm volatile("" ::: "memory"); }
    }
    __device__ __forceinline__ void kprep(const pg8::Unit& u, PG8_LAS unsigned char* tab, int tid) const {
        if (tid < 256) { const f32x4 s4 = *(const f32x4*)(ssd + (size_t)(u.pm * 256 + tid) * 4); ((PG8_LAS float*)tab)[tid] = rsqrtf((s4[0] + s4[1] + s4[2] + s4[3]) * (1.0f / 256.0f) + EPS); }
    }
    __device__ __forceinline__ void khook(pg8::f32x4 (&acc)[2][2][4][2], PG8_LAS unsigned char* tab, int wr, int fr) const {
#pragma unroll
        for (int ai = 0; ai < 2; ++ai)
#pragma unroll
            for (int m = 0; m < 4; ++m) { const float rs = ((const PG8_LAS float*)tab)[ai * 128 + wr * 64 + m * 16 + fr];
#pragma unroll
                for (int bj = 0; bj < 2; ++bj)
#pragma unroll
                    for (int n = 0; n < 2; ++n) acc[ai][bj][m][n] *= rs; }
    }
};

template <int TN> __device__ __forceinline__ void tc_job(unsigned char* lds, const float* src, size_t sb, int ld, int K, int N, int nbatch, bf16_t* dst, const float* gain, int kshift, int rot) {
    LAS float* tile = (LAS float*)lds;
    constexpr int CG = TN / 64, NLD = TN / 32  , NST = TN / 64  ;
    const int tid = opaque_tid(), nk = K / 64, nn = N / TN, ntile = nbatch * nk * nn;
    for (int ti = (int)((bid_() + grid_() - (rot % grid_())) % grid_()); ti < ntile; ti += grid_()) {
        const int b = ti / (nk * nn), rem = ti % (nk * nn), kt = rem / nn, nt = rem % nn;
        const float* s = src + (size_t)b * sb + (size_t)(kt * 64) * ld + nt * TN;
        f32x4 v[NLD];
#pragma unroll
        for (int p = 0; p < NLD; ++p) { const int idx = tid + 512 * p, c16 = idx & 15, kq = (idx >> 4) & 3, rest = idx >> 6, kl = (rest / CG) * 4 + kq, n4 = ((rest % CG) * 16 + c16) * 4;
            v[p] = *(const f32x4*)(s + (size_t)kl * ld + n4);
            if (gain) { const float gg = gain[(size_t)b * K + kt * 64 + kl]; v[p] = v[p] * gg; } }
        __syncthreads();
#pragma unroll
        for (int p = 0; p < NLD; ++p) { const int idx = tid + 512 * p, c16 = idx & 15, kq = (idx >> 4) & 3, rest = idx >> 6, kl = (rest / CG) * 4 + kq, n4 = ((rest % CG) * 16 + c16) * 4;
            tile[kl * (TN + 1) + n4 + 0] = v[p][0]; tile[kl * (TN + 1) + n4 + 1] = v[p][1]; tile[kl * (TN + 1) + n4 + 2] = v[p][2]; tile[kl * (TN + 1) + n4 + 3] = v[p][3]; }
        __syncthreads();
#pragma unroll
        for (int p = 0; p < NST; ++p) { const int idx = tid + 512 * p, nl = idx >> 3, kc = (idx & 7) * 8; float o[8];
#pragma unroll
            for (int e = 0; e < 8; ++e) o[e] = tile[(kc + e) * (TN + 1) + nl];
            const int kd = (kt * 64 + kc + kshift) % K;
            *(bf16x8*)(dst + (size_t)b * N * K + (size_t)(nt * TN + nl) * K + kd) = pack8(o); }
    }
    __syncthreads();
}

__device__ __forceinline__ void prep_phase(const Args& a, unsigned char* lds) {
    unsigned char* ws = ws_();
    tc_job<256>(lds, INP(2), (size_t)DM * NIN, NIN, DM, ZW, DEPTH, (bf16_t*)(ws + WS_WIN), INP(1), 0, 0);
    tc_job<256>(lds, INP(25), (size_t)DM * DM, DM, DM, DM, DEPTH, (bf16_t*)(ws + WS_WOUT), INP(24), 256, 0);
    tc_job<256>(lds, INP(27), (size_t)DM * DFF, DFF, DM, DFF, DEPTH, (bf16_t*)(ws + WS_WMI), INP(26), 0, 0);
    tc_job<256>(lds, INP(28), (size_t)DFF * DM, DM, DFF, DM, DEPTH, (bf16_t*)(ws + WS_WMO), nullptr, 0, 0);
    tc_job<256>(lds, INP(14), (size_t)W * W, W, W, W, DEPTH, (bf16_t*)(ws + WS_GLUT), nullptr, 0, 0);
    tc_job<64>(lds, INP(18), (size_t)64 * 64, 64, 64, 64, DEPTH * 4, (bf16_t*)(ws + WS_WAT), nullptr, 0, 64);
    tc_job<64>(lds, INP(20), (size_t)64 * 64, 64, 64, 64, DEPTH * 4, (bf16_t*)(ws + WS_WXT), nullptr, 0, 96);
    const int gid = bid_() * NTHR + opaque_tid();
    if (gid < DEPTH * 1024) {
        const int l = gid >> 10, gp = gid & 1023, g = gp >> 6, p = gp & 63;
        const float lre = INP(6)[gid], lim = INP(7)[gid], dt = expf(INP(8)[l * 16 + g]);
        const float mag = expf(lre * dt), are = mag * cosf(lim * dt), aim = mag * sinf(lim * dt);
        const float den = lre * lre + lim * lim, nre = are - 1.0f, nim = aim;
        const float fre = (nre * lre + nim * lim) / den, fim = (nim * lre - nre * lim) / den;
        ((f32x2*)(ws + WS_ABAR))[gid] = (f32x2){are, aim};
        float pr = are, pi = aim;
#pragma unroll
        for (int s = 0; s < 7; ++s) { const float nr = pr * pr - pi * pi, ni = 2.0f * pr * pi; pr = nr; pi = ni; }
        ((f32x2*)(ws + WS_A128))[gid] = (f32x2){pr, pi};
        const float* bre = INP(9) + (size_t)gid * 16; const float* bim = INP(10) + (size_t)gid * 16;
        bf16_t* bbt = (bf16_t*)(ws + WS_BBT) + ((size_t)(l * 16 + g) * 128 + 2 * p) * 16;
#pragma unroll
        for (int h = 0; h < 16; ++h) { const float br = bre[h], bi = bim[h]; bbt[h] = f2bf(fre * br - fim * bi); bbt[16 + h] = f2bf(fre * bi + fim * br); }
        bf16_t* cmt = (bf16_t*)(ws + WS_CMT) + (size_t)(l * 16 + g) * 16 * 128;
#pragma unroll
        for (int h = 0; h < 16; ++h) { const size_t ci = ((size_t)(l * 16 + g) * 16 + h) * 64 + p; ((unsigned*)cmt)[(h * 128 + 2 * p) >> 1] = pk2(INP(11)[ci], -INP(12)[ci]); }
        const float* wr = INP(2) + ((size_t)l * DM + gp) * NIN + ZW;
        ((f32x4*)(ws + WS_WF))[gid] = *(const f32x4*)wr * INP(1)[gid];
    }
}

template <bool SRCB, int MODE> __device__ __forceinline__ void norm_phase(const void* xsv, const float* g, bf16_t* xb, float* ss2, float* od, const float* wf, const float* bfg, float* logf) {
    const int lane = opaque_tid() & 63, wid = opaque_tid() >> 6;
    const int gw = bid_() * 8 + wid, nw = grid_() * 8;
    for (int row = gw; row < T; row += nw) {
        f32x4 v[4]; float ss = 0.f;
#pragma unroll
        for (int i = 0; i < 4; ++i) {
            if (SRCB) { const bf16x4 q = *(const bf16x4*)((const bf16_t*)xsv + (size_t)row * DM + i * 256 + lane * 4); v[i] = (f32x4){bfs2f(q[0]), bfs2f(q[1]), bfs2f(q[2]), bfs2f(q[3])}; }
            else { v[i] = *(const f32x4*)((const float*)xsv + (size_t)row * DM + i * 256 + lane * 4);
                if (MODE == 1) { u32x2 w; w.x = pk2(v[i][0], v[i][1]); w.y = pk2(v[i][2], v[i][3]); *(u32x2*)(xb + (size_t)row * DM + i * 256 + lane * 4) = w; } }
            ss += v[i][0] * v[i][0] + v[i][1] * v[i][1] + v[i][2] * v[i][2] + v[i][3] * v[i][3]; }
        ss = wave_sum(ss);
        const float rs = rsqrtf(ss * (1.0f / DM) + EPS);
        if (MODE == 1 && !SRCB) { if (lane < 16) ss2[(size_t)row * 16 + lane] = (lane == 0) ? ss : 0.f; }
        float f0 = 0.f, f1 = 0.f, f2 = 0.f, f3 = 0.f;
#pragma unroll
        for (int i = 0; i < 4; ++i) {
            if (MODE == 2) { const f32x4 gg = *(const f32x4*)(g + i * 256 + lane * 4); *(f32x4*)(od + (size_t)row * DM + i * 256 + lane * 4) = v[i] * rs * gg; }
            if (MODE == 1) {
#pragma unroll
                for (int e = 0; e < 4; ++e) { const f32x4 w4 = *(const f32x4*)(wf + (size_t)(i * 256 + lane * 4 + e) * 4); const float hv = v[i][e] * rs; f0 += hv * w4[0]; f1 += hv * w4[1]; f2 += hv * w4[2]; f3 += hv * w4[3]; } }
        }
        if (MODE == 1) {
            f0 = wave_sum(f0); f1 = wave_sum(f1); f2 = wave_sum(f2); f3 = wave_sum(f3);
            if (lane == 0) { f32x4 o; const float fv[4] = {f0 + bfg[0], f1 + bfg[1], f2 + bfg[2], f3 + bfg[3]};
#pragma unroll
                for (int e = 0; e < 4; ++e) o[e] = fminf(fv[e], 0.f) - log1pf(__expf(-fabsf(fv[e])));
                *(f32x4*)(logf + (size_t)row * 4) = o; }
        }
    }
}

__device__ __forceinline__ void cumsum_item(int b, const float* logf, float* cs, unsigned char* lds) {
    LAS float* wt = (LAS float*)lds;
    const int tid = opaque_tid(), lane = tid & 63, wid = tid >> 6;
    f32x4 v[8]; f32x4 run = (f32x4){0.f, 0.f, 0.f, 0.f};
    const float* src = logf + ((size_t)b * SEQ + (size_t)tid * 8) * 4;
#pragma unroll
    for (int e = 0; e < 8; ++e) { run = run + *(const f32x4*)(src + e * 4); v[e] = run; }
    f32x4 inc = run;
#pragma unroll
    for (int d = 1; d < 64; d <<= 1) {
        const int sl = ((lane >= d) ? lane - d : lane) << 2; f32x4 o;
#pragma unroll
        for (int e = 0; e < 4; ++e) o[e] = __uint_as_float((unsigned)__builtin_amdgcn_ds_bpermute(sl, (int)__float_as_uint(inc[e])));
        if (lane >= d) inc = inc + o;
    }
    __syncthreads();
    if (lane == 63) { wt[wid * 4 + 0] = inc[0]; wt[wid * 4 + 1] = inc[1]; wt[wid * 4 + 2] = inc[2]; wt[wid * 4 + 3] = inc[3]; }
    __syncthreads();
    f32x4 off = inc - run;
    for (int w2 = 0; w2 < wid; ++w2) { off[0] += wt[w2 * 4 + 0]; off[1] += wt[w2 * 4 + 1]; off[2] += wt[w2 * 4 + 2]; off[3] += wt[w2 * 4 + 3]; }
    float* dst = cs + ((size_t)b * SEQ + (size_t)tid * 8) * 4;
#pragma unroll
    for (int e = 0; e < 8; ++e) *(f32x4*)(dst + e * 4) = (v[e] + off) * LOG2E;
    __syncthreads();
}

template <int HALF> __device__ __forceinline__ void sgu_item(int l, int b, int c, const Args& a, unsigned char* lds) {
    const bf16_t* z = (const bf16_t*)(ws_() + WS_Z); bf16_t* y = (bf16_t*)(ws_() + WS_Y);
    LAS bf16_t* vn = (LAS bf16_t*)lds;
    LAS float* ssb = (LAS float*)(lds + 69632);
    const int tid = opaque_tid(), lane = tid & 63, wid = tid >> 6, fr = lane & 15, quad = lane >> 4;
    const size_t t0 = (size_t)b * SEQ + (size_t)c * 128;
    const float* ng = INP(3) + l * W;
    __syncthreads();
    const f32x4 gch = *(const f32x4*)(ng + lane * 4);
    constexpr int TPW = HALF ? 16 : 8;
#pragma unroll
    for (int i = 0; i < TPW; ++i) {
        const int s = wid * TPW + i;
        const bf16x4 zv = *(const bf16x4*)(z + (t0 + s) * ZW + ZC_AV + lane * 4);
        float gv[4]; float ss = 0.f;
#pragma unroll
        for (int e = 0; e < 4; ++e) { gv[e] = gelu_t(bfs2f(zv[e])); ss += gv[e] * gv[e]; }
        ss = wave_sum(ss); const float rs = rsqrtf(ss * (1.0f / W) + EPS);
        u32x2 w; w.x = pk2(gv[0] * rs * gch[0], gv[1] * rs * gch[1]); w.y = pk2(gv[2] * rs * gch[2], gv[3] * rs * gch[3]);
        *(LAS u32x2*)(vn + s * 264 + lane * 4) = w;
    }
    __syncthreads();
    const int h = wid & 3;
    const float* wsrc = INP(4) + ((size_t)(l * 4 + h) * 128) * 128;
    const float* bsrc = INP(5) + (size_t)(l * 4 + h) * 128;
    float outv[2][4][4];
#pragma unroll
    for (int i = 0; i < 2; ++i) {
        const int mt = HALF * 4 + (wid >> 2) + 2 * i, t = mt * 16 + fr;
        f32x4 acc[4];
#pragma unroll
        for (int nt = 0; nt < 4; ++nt) acc[nt] = (f32x4){0.f, 0.f, 0.f, 0.f};
        f32x4 wl[4][2];
#pragma unroll
        for (int kk = 0; kk < 4; ++kk) { const int k0 = (kk * 32 < (mt + 1) * 16) ? kk * 32 : 0; const float* wp = wsrc + (size_t)t * 128 + k0 + quad * 8; wl[kk][0] = *(const f32x4*)wp; wl[kk][1] = *(const f32x4*)(wp + 4); }
#pragma unroll
        for (int kk = 0; kk < 4; ++kk) {
            const int k0 = kk * 32;
            if (k0 < (mt + 1) * 16) {
                float wv[8] = {wl[kk][0][0], wl[kk][0][1], wl[kk][0][2], wl[kk][0][3], wl[kk][1][0], wl[kk][1][1], wl[kk][1][2], wl[kk][1][3]};
#pragma unroll
                for (int e = 0; e < 8; ++e) if (k0 + quad * 8 + e > t) wv[e] = 0.f;
                const bf16x8 wf = pack8(wv);
#pragma unroll
                for (int nt = 0; nt < 4; ++nt) {
                    LAS bf16_t* tp = vn + (k0 + quad * 8 + (fr >> 2)) * 264 + h * 64 + nt * 16 + (fr & 3) * 4;
                    const bf16x4 lo = __builtin_bit_cast(bf16x4, __builtin_amdgcn_ds_read_tr16_b64_v4i16((LAS v4i16_t*)tp));
                    const bf16x4 hi = __builtin_bit_cast(bf16x4, __builtin_amdgcn_ds_read_tr16_b64_v4i16((LAS v4i16_t*)(tp + 4 * 264)));
                    const bf16x8 vf = (bf16x8){lo[0], lo[1], lo[2], lo[3], hi[0], hi[1], hi[2], hi[3]};
                    acc[nt] = mfma16(vf, wf, acc[nt]); }
            }
        }
        const float bs = bsrc[t]; float ss = 0.f;
#pragma unroll
        for (int nt = 0; nt < 4; ++nt) { const int ch = h * 64 + nt * 16 + quad * 4; const bf16x4 u4 = *(const bf16x4*)(z + (t0 + t) * ZW + ZC_AU + ch);
#pragma unroll
            for (int r = 0; r < 4; ++r) { const float o = gelu_t(bfs2f(u4[r])) * (acc[nt][r] + bs); outv[i][nt][r] = o; ss += o * o; } }
        ss = quad_sum(ss);
        if (quad == 0) ssb[t * 4 + h] = ss;
    }
    __syncthreads();
#pragma unroll
    for (int i = 0; i < 2; ++i) {
        const int mt = HALF * 4 + (wid >> 2) + 2 * i, t = mt * 16 + fr;
        const float rs = rsqrtf((ssb[t * 4 + 0] + ssb[t * 4 + 1] + ssb[t * 4 + 2] + ssb[t * 4 + 3]) * (1.0f / W) + EPS);
#pragma unroll
        for (int nt = 0; nt < 4; ++nt) { const int ch = h * 64 + nt * 16 + quad * 4; u32x2 w; w.x = pk2(outv[i][nt][0] * rs, outv[i][nt][1] * rs); w.y = pk2(outv[i][nt][2] * rs, outv[i][nt][3] * rs);
            *(u32x2*)(y + (t0 + t) * DM + YC_A + ch) = w; }
    }
    __syncthreads();
}

template <int PASS> __device__ __forceinline__ void s5_item(int l, int b, int c, const Args& a, unsigned char* lds) {
    const bf16_t* z = (const bf16_t*)(ws_() + WS_Z); bf16_t* y = (bf16_t*)(ws_() + WS_Y);
    LAS unsigned char* BU = (LAS unsigned char*)lds;
    LAS unsigned* BU32 = (LAS unsigned*)lds;
    LAS bf16_t* Yb = (LAS bf16_t*)(lds + 65792);
    LAS float* ssb = (LAS float*)(lds + 65792 + 67584);
    const int tid = opaque_tid(), lane = tid & 63, wid = tid >> 6, fr = lane & 15, quad = lane >> 4;
    const int sx0 = wid * 128 + lane, sx1 = sx0 + 64;
    const size_t t0 = (size_t)b * SEQ + (size_t)c * 128;
    const f32x2* abar = (const f32x2*)(ws_() + WS_ABAR) + l * 1024;
    f32x2* eloc = (f32x2*)(ws_() + WS_ELOC);
    float ar[2], ai[2], sre[2], sim[2];
#pragma unroll
    for (int q = 0; q < 2; ++q) { const f32x2 ab = abar[q ? sx1 : sx0]; ar[q] = ab[0]; ai[q] = ab[1]; sre[q] = 0.f; sim[q] = 0.f; }
    if (PASS == 2) {
        const f32x2* a128 = (const f32x2*)(ws_() + WS_A128) + l * 1024;
        const f32x2 p0 = a128[sx0], p1 = a128[sx1];
        for (int cc0 = 0; cc0 < c; cc0 += 8) {
            f32x2 e0[8], e1[8];
#pragma unroll
            for (int u = 0; u < 8; ++u) { const int cc = (cc0 + u < c) ? cc0 + u : c - 1; e0[u] = eloc[((size_t)(b * NCH + cc)) * 1024 + sx0]; e1[u] = eloc[((size_t)(b * NCH + cc)) * 1024 + sx1]; }
#pragma unroll
            for (int u = 0; u < 8; ++u) if (cc0 + u < c) {
                const float nr0 = p0[0] * sre[0] - p0[1] * sim[0] + e0[u][0], ni0 = p0[0] * sim[0] + p0[1] * sre[0] + e0[u][1]; sre[0] = nr0; sim[0] = ni0;
                const float nr1 = p1[0] * sre[1] - p1[1] * sim[1] + e1[u][0], ni1 = p1[0] * sim[1] + p1[1] * sre[1] + e1[u][1]; sre[1] = nr1; sim[1] = ni1; }
        }
    }
    bf16x8 bfrag[2][8];
    const bf16_t* bbt = (const bf16_t*)(ws_() + WS_BBT);
#pragma unroll
    for (int gi = 0; gi < 2; ++gi)
#pragma unroll
        for (int j = 0; j < 8; ++j) bfrag[gi][j] = (quad < 2) ? *(const bf16x8*)(bbt + ((size_t)(l * 16 + wid * 2 + gi) * 128 + j * 16 + fr) * 16 + quad * 8) : zero8();
    bf16x8 cfrag[2][4];
    if (PASS == 2) {
        const bf16_t* cmt = (const bf16_t*)(ws_() + WS_CMT);
#pragma unroll
        for (int gi = 0; gi < 2; ++gi)
#pragma unroll
            for (int ks = 0; ks < 4; ++ks) cfrag[gi][ks] = *(const bf16x8*)(cmt + ((size_t)(l * 16 + wid * 2 + gi) * 16 + fr) * 128 + ks * 32 + quad * 8);
    }
    const float* dsk = INP(13) + l * W;
    __syncthreads();
    bf16x8 ufn[2];
#pragma unroll
    for (int gi = 0; gi < 2; ++gi) ufn[gi] = (quad < 2) ? *(const bf16x8*)(z + (t0 + fr) * ZW + ZC_B + (wid * 2 + gi) * 16 + quad * 8) : zero8();
    for (int sc = 0; sc < 8; ++sc) {
        const size_t tr = t0 + sc * 16 + fr;
        bf16x8 ufc[2] = {ufn[0], ufn[1]};
        bf16x4 u4c[2] = {(bf16x4){0, 0, 0, 0}, (bf16x4){0, 0, 0, 0}};
        if (PASS == 2) {
#pragma unroll
            for (int gi = 0; gi < 2; ++gi) u4c[gi] = *(const bf16x4*)(z + tr * ZW + ZC_B + (wid * 2 + gi) * 16 + quad * 4);
        }
        if (sc < 7) {
#pragma unroll
            for (int gi = 0; gi < 2; ++gi) ufn[gi] = (quad < 2) ? *(const bf16x8*)(z + (tr + 16) * ZW + ZC_B + (wid * 2 + gi) * 16 + quad * 8) : zero8();
        }
#pragma unroll
        for (int gi = 0; gi < 2; ++gi) {
            const int g = wid * 2 + gi;
            const bf16x8 uf = ufc[gi];
#pragma unroll
            for (int j = 0; j < 8; ++j) {
                const f32x4 acc = mfma16(bfrag[gi][j], uf, (f32x4){0.f, 0.f, 0.f, 0.f});
                u32x2 w; w.x = pk2(acc[0], acc[1]); w.y = pk2(acc[2], acc[3]);
                *(LAS u32x2*)(BU + fr * 4112 + (g * 64 + j * 8 + quad * 2) * 4) = w;
            }
        }
        asm volatile("s_waitcnt lgkmcnt(0)" ::: "memory");
        {
            unsigned wv[16][2];
#pragma unroll
            for (int tt = 0; tt < 16; ++tt) { wv[tt][0] = BU32[tt * 1028 + sx0]; wv[tt][1] = BU32[tt * 1028 + sx1]; }
#pragma unroll
            for (int tt = 0; tt < 16; ++tt) {
#pragma unroll
                for (int q = 0; q < 2; ++q) {
                    const unsigned w = wv[tt][q];
                    const f32x2 bu2 = {__uint_as_float(w << 16), __uint_as_float(w & 0xffff0000u)};
                    const f32x2 s2 = {sre[q], sim[q]}, sw = {sim[q], sre[q]}, arr = {ar[q], ar[q]}, aii = {-ai[q], ai[q]};
                    const f32x2 n2 = aii * sw + (arr * s2 + bu2);
                    sre[q] = n2[0]; sim[q] = n2[1];
                    if (PASS == 2) wv[tt][q] = pk2(n2[0], n2[1]);
                }
            }
            if (PASS == 2) {
#pragma unroll
                for (int tt = 0; tt < 16; ++tt) { BU32[tt * 1028 + sx0] = wv[tt][0]; BU32[tt * 1028 + sx1] = wv[tt][1]; }
            }
        }
        asm volatile("s_waitcnt lgkmcnt(0)" ::: "memory");
        if (PASS == 2) {
#pragma unroll
            for (int gi = 0; gi < 2; ++gi) {
                const int g = wid * 2 + gi; f32x4 acc = (f32x4){0.f, 0.f, 0.f, 0.f};
#pragma unroll
                for (int ks = 0; ks < 4; ++ks) { const bf16x8 sf = *(const LAS bf16x8*)(BU + fr * 4112 + g * 256 + (ks * 32 + quad * 8) * 2); acc = mfma16(cfrag[gi][ks], sf, acc); }
                const int ch = g * 16 + quad * 4; const bf16x4 u4 = u4c[gi]; const f32x4 d4 = *(const f32x4*)(dsk + ch);
                float o[4];
#pragma unroll
                for (int r = 0; r < 4; ++r) o[r] = gelu_t(acc[r] + d4[r] * bfs2f(u4[r]));
                u32x2 w; w.x = pk2(o[0], o[1]); w.y = pk2(o[2], o[3]);
                *(LAS u32x2*)(Yb + (sc * 16 + fr) * 264 + ch) = w;
            }
        }
    }
    if (PASS == 1) {
#pragma unroll
        for (int q = 0; q < 2; ++q) eloc[((size_t)(b * NCH + c)) * 1024 + (q ? sx1 : sx0)] = (f32x2){sre[q], sim[q]};
        {
            LAS float* kq = (LAS float*)(lds + 65792);
            const int tok = tid >> 2, hd = tid & 3; float s2 = 0.f;
#pragma unroll
            for (int j = 0; j < 8; ++j) { const bf16x8 kv = *(const bf16x8*)(z + (t0 + tok) * ZW + ZC_K + hd * 64 + j * 8);
#pragma unroll
                for (int e = 0; e < 8; ++e) { const float f = bfs2f(kv[e]); s2 += f * f; } }
            kq[tok * 4 + hd] = s2;
            __syncthreads();
            if (tid < 4) { float mxv = 0.f; for (int i = 0; i < 128; ++i) mxv = fmaxf(mxv, kq[i * 4 + tid]); ((float*)(ws_() + WS_KMAX))[(b * NCH + c) * 4 + tid] = mxv; }
        }
    } else {
        const bf16_t* glut = (const bf16_t*)(ws_() + WS_GLUT) + (size_t)l * W * W;
        const float* glub = INP(15) + l * W;
        bf16x8 gfrag[2][8];
#pragma unroll
        for (int ni = 0; ni < 2; ++ni)
#pragma unroll
            for (int ks = 0; ks < 8; ++ks) gfrag[ni][ks] = *(const bf16x8*)(glut + (size_t)((wid * 2 + ni) * 16 + fr) * W + ks * 32 + quad * 8);
        __syncthreads();
        float outv[8][2][4];
#pragma unroll
        for (int mt = 0; mt < 8; ++mt) {
            f32x4 acc0 = (f32x4){0.f, 0.f, 0.f, 0.f}, acc1 = acc0;
#pragma unroll
            for (int ks = 0; ks < 8; ++ks) { const bf16x8 yf = *(const LAS bf16x8*)(Yb + (mt * 16 + fr) * 264 + ks * 32 + quad * 8); acc0 = mfma16(gfrag[0][ks], yf, acc0); acc1 = mfma16(gfrag[1][ks], yf, acc1); }
            float ss = 0.f;
#pragma unroll
            for (int ni = 0; ni < 2; ++ni) { const int n = (wid * 2 + ni) * 16 + quad * 4; const bf16x4 y4 = *(const LAS bf16x4*)(Yb + (mt * 16 + fr) * 264 + n); const f32x4 gb = *(const f32x4*)(glub + n);
#pragma unroll
                for (int r = 0; r < 4; ++r) { const float gt = (ni == 0 ? acc0[r] : acc1[r]) + gb[r]; const float o = bfs2f(y4[r]) * sigm(gt); outv[mt][ni][r] = o; ss += o * o; } }
            ss = quad_sum(ss);
            if (quad == 0) ssb[(mt * 16 + fr) * 8 + wid] = ss;
        }
        __syncthreads();
#pragma unroll
        for (int mt = 0; mt < 8; ++mt) {
            const int t = mt * 16 + fr; float s = 0.f;
#pragma unroll
            for (int w2 = 0; w2 < 8; ++w2) s += ssb[t * 8 + w2];
            const float rs = rsqrtf(s * (1.0f / W) + EPS);
#pragma unroll
            for (int ni = 0; ni < 2; ++ni) { const int n = (wid * 2 + ni) * 16 + quad * 4; u32x2 w; w.x = pk2(outv[mt][ni][0] * rs, outv[mt][ni][1] * rs); w.y = pk2(outv[mt][ni][2] * rs, outv[mt][ni][3] * rs);
                *(u32x2*)(y + (t0 + t) * DM + YC_B + n) = w; }
        }
    }
    __syncthreads();
}

template <int PASS> __device__ __forceinline__ void lru_item(int l, int b, int c, const Args& a, unsigned char* lds) {
    const bf16_t* z = (const bf16_t*)(ws_() + WS_Z); bf16_t* y = (bf16_t*)(ws_() + WS_Y);
    LAS bf16_t* XC = (LAS bf16_t*)lds;
    LAS float* ssb = (LAS float*)(lds + 67584);
    const int tid = opaque_tid(), lane = tid & 63, wid = tid >> 6, fr = lane & 15, quad = lane >> 4;
    const size_t t0 = (size_t)b * SEQ + (size_t)c * 128;
    float* LAp = (float*)(ws_() + WS_LA); float* LBp = (float*)(ws_() + WS_LB);
    __syncthreads();
    const int hh = wid >> 1;
    const bf16_t* wat = (const bf16_t*)(ws_() + WS_WAT) + (size_t)(l * 4 + hh) * 64 * 64;
    const bf16_t* wxt = (const bf16_t*)(ws_() + WS_WXT) + (size_t)(l * 4 + hh) * 64 * 64;
    bf16x8 waf[2][2], wxf[2][2]; float sp8[2][4], bav[2][4], bxv[2][4], H[2][4], Acar[2][4], Bcar[2][4];
#pragma unroll
    for (int ni = 0; ni < 2; ++ni) {
        const int nl = (wid * 2 + ni) * 16 - hh * 64 + fr;
#pragma unroll
        for (int ks = 0; ks < 2; ++ks) { waf[ni][ks] = *(const bf16x8*)(wat + nl * 64 + ks * 32 + quad * 8); wxf[ni][ks] = *(const bf16x8*)(wxt + nl * 64 + ks * 32 + quad * 8); }
#pragma unroll
        for (int r = 0; r < 4; ++r) { const int ch = (wid * 2 + ni) * 16 + quad * 4 + r;
            sp8[ni][r] = 8.0f * softplus_f(-INP(22)[l * W + ch]); bav[ni][r] = INP(19)[l * W + ch]; bxv[ni][r] = INP(21)[l * W + ch];
            H[ni][r] = 0.f; Acar[ni][r] = 1.f; Bcar[ni][r] = 0.f;
        }
    }
    if (PASS == 2 && c > 0) {
#pragma unroll
        for (int ni = 0; ni < 2; ++ni) {
            const size_t ob = (size_t)(b * NCH) * W + (wid * 2 + ni) * 16 + quad * 4;
            const bool v0 = fr < c, v1 = 16 + fr < c;
            f32x4 a0 = (f32x4){1.f, 1.f, 1.f, 1.f}, b0 = (f32x4){0.f, 0.f, 0.f, 0.f}, a1 = a0, b1 = b0;
            if (v0) { a0 = *(const f32x4*)(LAp + ob + (size_t)fr * W); b0 = *(const f32x4*)(LBp + ob + (size_t)fr * W); }
            if (v1) { a1 = *(const f32x4*)(LAp + ob + (size_t)(16 + fr) * W); b1 = *(const f32x4*)(LBp + ob + (size_t)(16 + fr) * W); }
#pragma unroll
            for (int r = 0; r < 4; ++r) {
                float av = a0[r], bb = b0[r], aw = a1[r], bw = b1[r], ap, bp;
                ap = dpp_shr<1>(av, 1.0f); bp = dpp_shr<1>(bb, 0.0f); bb = av * bp + bb; av = av * ap;   ap = dpp_shr<1>(aw, 1.0f); bp = dpp_shr<1>(bw, 0.0f); bw = aw * bp + bw; aw = aw * ap;
                ap = dpp_shr<2>(av, 1.0f); bp = dpp_shr<2>(bb, 0.0f); bb = av * bp + bb; av = av * ap;   ap = dpp_shr<2>(aw, 1.0f); bp = dpp_shr<2>(bw, 0.0f); bw = aw * bp + bw; aw = aw * ap;
                ap = dpp_shr<4>(av, 1.0f); bp = dpp_shr<4>(bb, 0.0f); bb = av * bp + bb; av = av * ap;   ap = dpp_shr<4>(aw, 1.0f); bp = dpp_shr<4>(bw, 0.0f); bw = aw * bp + bw; aw = aw * ap;
                ap = dpp_shr<8>(av, 1.0f); bp = dpp_shr<8>(bb, 0.0f); bb = av * bp + bb; av = av * ap;   ap = dpp_shr<8>(aw, 1.0f); bp = dpp_shr<8>(bw, 0.0f); bw = aw * bp + bw; aw = aw * ap;
                const float B0t = __shfl(bb, 15, 16), A1t = __shfl(aw, 15, 16), B1t = __shfl(bw, 15, 16);
                H[ni][r] = A1t * B0t + B1t;
            }
        }
    }
    {
        const float* cw = INP(16) + (size_t)l * 4 * W; const float* cb = INP(17) + l * W;
        const int ch0 = (tid & 31) * 8, tk0 = (tid >> 5) * 8;
        bf16x8 xr[11];
#pragma unroll
        for (int j = 0; j < 11; ++j) { const int tt = tk0 - 3 + j;
            xr[j] = (c * 128 + tt >= 0) ? *(const bf16x8*)(z + (size_t)((long)t0 + tt) * ZW + ZC_CX + ch0) : zero8(); }
        float wk[4][8], bk[8];
        { const f32x4 c0 = *(const f32x4*)(cb + ch0), c1 = *(const f32x4*)(cb + ch0 + 4);
#pragma unroll
          for (int e = 0; e < 4; ++e) { bk[e] = c0[e]; bk[4 + e] = c1[e]; }
#pragma unroll
          for (int k = 0; k < 4; ++k) { const f32x4 w0 = *(const f32x4*)(cw + k * W + ch0), w1 = *(const f32x4*)(cw + k * W + ch0 + 4);
#pragma unroll
              for (int e = 0; e < 4; ++e) { wk[k][e] = w0[e]; wk[k][4 + e] = w1[e]; } } }
#pragma unroll
        for (int i = 0; i < 8; ++i) { float acc[8];
#pragma unroll
            for (int e = 0; e < 8; ++e) acc[e] = bk[e] + wk[0][e] * bfs2f(xr[i][e]) + wk[1][e] * bfs2f(xr[i + 1][e]) + wk[2][e] * bfs2f(xr[i + 2][e]) + wk[3][e] * bfs2f(xr[i + 3][e]);
            *(LAS bf16x8*)(XC + (tk0 + i) * 264 + ch0) = pack8(acc); }
    }
    __syncthreads();
    LAS bf16_t* Ob = (LAS bf16_t*)(lds + 67584 + 4096);
#pragma unroll 2
    for (int mt = 0; mt < 8; ++mt) {
        bf16x8 xf[2];
#pragma unroll
        for (int ks = 0; ks < 2; ++ks) xf[ks] = *(const LAS bf16x8*)(XC + (mt * 16 + fr) * 264 + hh * 64 + ks * 32 + quad * 8);
        float ss = 0.f;
#pragma unroll
        for (int ni = 0; ni < 2; ++ni) {
            f32x4 accA = (f32x4){0.f, 0.f, 0.f, 0.f}, accX = accA;
#pragma unroll
            for (int ks = 0; ks < 2; ++ks) { accA = mfma16(waf[ni][ks], xf[ks], accA); accX = mfma16(wxf[ni][ks], xf[ks], accX); }
            const int ch0 = (wid * 2 + ni) * 16 + quad * 4;
            const bf16x4 xc4 = *(const LAS bf16x4*)(XC + (mt * 16 + fr) * 264 + ch0);
            bf16x4 g4 = (bf16x4){0, 0, 0, 0};
            if (PASS == 2) g4 = *(const bf16x4*)(z + (t0 + mt * 16 + fr) * ZW + ZC_CG + ch0);
            float ov[4] = {0.f, 0.f, 0.f, 0.f};
#pragma unroll
            for (int r = 0; r < 4; ++r) {
                const float rg = sigm(accA[r] + bav[ni][r]), ig = sigm(accX[r] + bxv[ni][r]);
                const float la = -rg * sp8[ni][r];
                float av = __builtin_amdgcn_exp2f(LOG2E * la), bb = __builtin_amdgcn_sqrtf(fmaxf(neg_expm1(2.0f * la), 0.f)) * (ig * bfs2f(xc4[r]));
                { float ap, bp;
                  ap = dpp_shr<1>(av, 1.0f); bp = dpp_shr<1>(bb, 0.0f); bb = av * bp + bb; av = av * ap;
                  ap = dpp_shr<2>(av, 1.0f); bp = dpp_shr<2>(bb, 0.0f); bb = av * bp + bb; av = av * ap;
                  ap = dpp_shr<4>(av, 1.0f); bp = dpp_shr<4>(bb, 0.0f); bb = av * bp + bb; av = av * ap;
                  ap = dpp_shr<8>(av, 1.0f); bp = dpp_shr<8>(bb, 0.0f); bb = av * bp + bb; av = av * ap; }
                if (PASS == 1) { const float At = __shfl(av, 15, 16), Bt = __shfl(bb, 15, 16); Bcar[ni][r] = At * Bcar[ni][r] + Bt; Acar[ni][r] *= At; }
                else { const float hv = av * H[ni][r] + bb; H[ni][r] = __shfl(hv, 15, 16); const float o = hv * gelu_t(bfs2f(g4[r])); ov[r] = o; ss += o * o; }
            }
            if (PASS == 2) { u32x2 w; w.x = pk2(ov[0], ov[1]); w.y = pk2(ov[2], ov[3]); *(LAS u32x2*)(Ob + (mt * 16 + fr) * 264 + ch0) = w; }
        }
        if (PASS == 2) { ss = quad_sum(ss); if (quad == 0) ssb[(mt * 16 + fr) * 8 + wid] = ss; }
    }
    if (PASS == 1) {
        if (fr == 0) {
#pragma unroll
            for (int ni = 0; ni < 2; ++ni)
#pragma unroll
                for (int r = 0; r < 4; ++r) { const size_t o = ((size_t)(b * NCH + c)) * W + (wid * 2 + ni) * 16 + quad * 4 + r; LAp[o] = Acar[ni][r]; LBp[o] = Bcar[ni][r]; }
        }
    } else {
        __syncthreads();
#pragma unroll 2
        for (int mt = 0; mt < 8; ++mt) {
            const int t = mt * 16 + fr; float s = 0.f;
#pragma unroll
            for (int w2 = 0; w2 < 8; ++w2) s += ssb[t * 8 + w2];
            const float rs = rsqrtf(s * (1.0f / W) + EPS);
#pragma unroll
            for (int ni = 0; ni < 2; ++ni) { const int n = (wid * 2 + ni) * 16 + quad * 4; const bf16x4 o4 = *(const LAS bf16x4*)(Ob + t * 264 + n);
                u32x2 w; w.x = pk2(bfs2f(o4[0]) * rs, bfs2f(o4[1]) * rs); w.y = pk2(bfs2f(o4[2]) * rs, bfs2f(o4[3]) * rs);
                *(u32x2*)(y + (t0 + t) * DM + YC_C + n) = w; }
        }
    }
    __syncthreads();
}

template <bool DIAG> __device__ __forceinline__ void attn_step2(const LAS unsigned char* buf, int kbase, int qrow0, int quad, int fr, const bf16x8 (&qf)[2][2], float (&m)[2], float (&lsum)[2], f32x4 (&oacc)[2][4]) {
    const LAS bf16_t* Kt = (const LAS bf16_t*)buf; const LAS bf16_t* Vt = (const LAS bf16_t*)(buf + 9216); const LAS float* csl = (const LAS float*)(buf + 18432);
    LAS bf16_t* vtr0 = (LAS bf16_t*)Vt + (quad * 4 + (fr >> 2)) * 72 + (fr & 3) * 4;
    float p[2][4][4];
#pragma unroll
    for (int st = 0; st < 4; ++st) {
        const f32x4 c4 = *(const LAS f32x4*)(csl + st * 16 + quad * 4);
        const bf16x8 kf0 = *(const LAS bf16x8*)(Kt + (st * 16 + fr) * 72 + quad * 8), kf1 = *(const LAS bf16x8*)(Kt + (st * 16 + fr) * 72 + 32 + quad * 8);
#pragma unroll
        for (int qs = 0; qs < 2; ++qs) {
            f32x4 acc = mfma16(kf0, qf[qs][0], c4); acc = mfma16(kf1, qf[qs][1], acc);
#pragma unroll
            for (int r = 0; r < 4; ++r) { float v = acc[r]; if (DIAG && (kbase + st * 16 + quad * 4 + r > qrow0 + qs * 16)) v = -1e30f; p[qs][st][r] = v; }
        }
    }
    bf16x8 pf[2][2];
#pragma unroll
    for (int qs = 0; qs < 2; ++qs) {
        float mx = -1e30f;
#pragma unroll
        for (int st = 0; st < 4; ++st)
#pragma unroll
            for (int r = 0; r < 4; ++r) mx = fmaxf(mx, p[qs][st][r]);
        mx = quad_max(mx);
        if (__any(mx > m[qs])) {
            const float mnew = fmaxf(m[qs], mx), al = __builtin_amdgcn_exp2f(m[qs] - mnew); m[qs] = mnew; lsum[qs] *= al;
#pragma unroll
            for (int dt = 0; dt < 4; ++dt) oacc[qs][dt] = oacc[qs][dt] * al;
        }
        const float mcur = m[qs];
        float ps = 0.f;
#pragma unroll
        for (int st = 0; st < 4; ++st)
#pragma unroll
            for (int r = 0; r < 4; ++r) { const float e = __builtin_amdgcn_exp2f(p[qs][st][r] - mcur); p[qs][st][r] = e; ps += e; }
        lsum[qs] += ps;
#pragma unroll
        for (int ks = 0; ks < 2; ++ks) { u32x4 w; w.x = pk2(p[qs][2 * ks][0], p[qs][2 * ks][1]); w.y = pk2(p[qs][2 * ks][2], p[qs][2 * ks][3]); w.z = pk2(p[qs][2 * ks + 1][0], p[qs][2 * ks + 1][1]); w.w = pk2(p[qs][2 * ks + 1][2], p[qs][2 * ks + 1][3]); pf[qs][ks] = __builtin_bit_cast(bf16x8, w); }
    }
#pragma unroll
    for (int dt = 0; dt < 4; ++dt) {
#pragma unroll
        for (int ks = 0; ks < 2; ++ks) {
            const bf16x4 v0 = __builtin_bit_cast(bf16x4, __builtin_amdgcn_ds_read_tr16_b64_v4i16((LAS v4i16_t*)(vtr0 + (ks * 32) * 72 + dt * 16)));
            const bf16x4 v1 = __builtin_bit_cast(bf16x4, __builtin_amdgcn_ds_read_tr16_b64_v4i16((LAS v4i16_t*)(vtr0 + (ks * 32 + 16) * 72 + dt * 16)));
            const bf16x8 vf = (bf16x8){v0[0], v0[1], v0[2], v0[3], v1[0], v1[1], v1[2], v1[3]};
            oacc[0][dt] = mfma16(vf, pf[0][ks], oacc[0][dt]); oacc[1][dt] = mfma16(vf, pf[1][ks], oacc[1][dt]);
        }
    }
}
__device__ __forceinline__ void attn_unit(int b, int h, int qb, const Args& a, unsigned char* lds) {
    const bf16_t* z = (const bf16_t*)(ws_() + WS_Z); bf16_t* y = (bf16_t*)(ws_() + WS_Y);
    const float* cs = (const float*)(ws_() + WS_CS); float* ssd = (float*)(ws_() + WS_SSD);
    constexpr int ABUF = 9216 + 9216 + 256;
    LAS unsigned char* lb = (LAS unsigned char*)lds;
    const int tid = opaque_tid(), lane = tid & 63, wid = tid >> 6, fr = lane & 15, quad = lane >> 4, grp = wid >> 2, wq = wid & 3;
    const int q0 = qb * 128, qw = q0 + wq * 32, qrow0 = qw + fr;
    const size_t rb = (size_t)b * SEQ;
    bf16x8 qf[2][2];
    {
        const float SC = 0.125f * LOG2E;
#pragma unroll
        for (int qs = 0; qs < 2; ++qs)
#pragma unroll
            for (int ds = 0; ds < 2; ++ds) { const bf16x8 qv = *(const bf16x8*)(z + (rb + qrow0 + qs * 16) * ZW + ZC_Q + h * 64 + ds * 32 + quad * 8); float t8[8];
#pragma unroll
                for (int e = 0; e < 8; ++e) t8[e] = bfs2f(qv[e]) * SC;
                qf[qs][ds] = pack8(t8); }
    }
    float m[2] = {-1e30f, -1e30f}, lsum[2] = {0.f, 0.f}; f32x4 oacc[2][4];
#pragma unroll
    for (int qs = 0; qs < 2; ++qs)
#pragma unroll
        for (int dt = 0; dt < 4; ++dt) oacc[qs][dt] = (f32x4){0.f, 0.f, 0.f, 0.f};
    float qbnd[2];
    {
        float kv = (lane <= qb) ? ((const float*)(ws_() + WS_KMAX))[(b * NCH + lane) * 4 + h] : 0.f;
        kv = wave_max(kv);
        const float kmax = __builtin_amdgcn_sqrtf(kv) * 1.01f + 1e-3f;
#pragma unroll
        for (int qs = 0; qs < 2; ++qs) { float q2 = 0.f;
#pragma unroll
            for (int ds = 0; ds < 2; ++ds)
#pragma unroll
                for (int e = 0; e < 8; ++e) { const float f = bfs2f(qf[qs][ds][e]); q2 += f * f; }
            q2 = quad_sum(q2); qbnd[qs] = (__builtin_amdgcn_sqrtf(q2) * 1.01f + 1e-3f) * kmax; }
    }
    const int NSS = qb + 1;
    volatile LAS unsigned* vote = (volatile LAS unsigned*)(lds + LDS_BYTES - 64);
    if (tid < 3) vote[tid] = 0u;
    bf16x8 kreg[2], vreg[2]; float creg = 0.f;
#define ATT_LOAD(S) do { const size_t kb_ = rb + (size_t)(S) * 128; \
        _Pragma("unroll") for (int p_ = 0; p_ < 2; ++p_) { const int id_ = tid + 512 * p_; \
            kreg[p_] = *(const bf16x8*)(z + (kb_ + (id_ >> 3)) * ZW + ZC_K + h * 64 + (id_ & 7) * 8); \
            vreg[p_] = *(const bf16x8*)(z + (kb_ + (id_ >> 3)) * ZW + ZC_V + h * 64 + (id_ & 7) * 8); } \
        if (tid < 128) creg = cs[(kb_ + tid) * 4 + h]; } while (0)
#define ATT_STORE(S) do { LAS unsigned char* bb_ = lb + ((S) & 1) * (2 * ABUF); \
        _Pragma("unroll") for (int p_ = 0; p_ < 2; ++p_) { const int id_ = tid + 512 * p_; const int k128_ = id_ >> 3; \
            *(LAS bf16x8*)((LAS bf16_t*)(bb_ + (k128_ >> 6) * ABUF) + (k128_ & 63) * 72 + (id_ & 7) * 8) = kreg[p_]; \
            *(LAS bf16x8*)((LAS bf16_t*)(bb_ + (k128_ >> 6) * ABUF + 9216) + (k128_ & 63) * 72 + (id_ & 7) * 8) = vreg[p_]; } \
        if (tid < 128) ((LAS float*)(bb_ + (tid >> 6) * ABUF + 18432))[tid & 63] = -creg; } while (0)
    ATT_LOAD(NSS - 1); ATT_STORE(NSS - 1);
    if (NSS > 1) ATT_LOAD(NSS - 2);
    __syncthreads();
    int kstep = 0;
    for (int S = NSS - 1; S >= 0; --S) {
        if (S >= 1) ATT_STORE(S - 1);
        if (S >= 2) ATT_LOAD(S - 2);
        float cl = 0.f; if (S >= 1) cl = cs[(rb + (size_t)(S - 1) * 128 + 127) * 4 + h];
        const int kbase = S * 128 + grp * 64;
        const LAS unsigned char* hb = lb + (S & 1) * (2 * ABUF) + grp * ABUF;
        if (S + 1 < NSS) attn_step2<false>(hb, kbase, qrow0, quad, fr, qf, m, lsum, oacc);
        else if (kbase <= qw + 31) attn_step2<true>(hb, kbase, qrow0, quad, fr, qf, m, lsum, oacc);
        const bool need = (S >= 1) && ((qbnd[0] - cl - m[0] >= -152.f) || (qbnd[1] - cl - m[1] >= -152.f));
        const int vw = kstep % 3;
        if (need) vote[vw] = 1u;
        __syncthreads();
        const unsigned go = vote[vw];
        if (tid == 0) vote[(kstep + 2) % 3] = 0u;
        ++kstep;
        if (!go) break;
    }
#undef ATT_LOAD
#undef ATT_STORE
    LAS float* mg = (LAS float*)lb;
    const int ml = wq * 64 + lane;
    if (grp == 1) {
#pragma unroll
        for (int qs = 0; qs < 2; ++qs) { mg[(qs * 18 + 0) * 256 + ml] = m[qs]; mg[(qs * 18 + 1) * 256 + ml] = lsum[qs];
#pragma unroll
            for (int dt = 0; dt < 4; ++dt)
#pragma unroll
                for (int r = 0; r < 4; ++r) mg[(qs * 18 + 2 + dt * 4 + r) * 256 + ml] = oacc[qs][dt][r]; }
    }
    __syncthreads();
    if (grp == 0) {
#pragma unroll
        for (int qs = 0; qs < 2; ++qs) {
            const float m1 = mg[(qs * 18 + 0) * 256 + ml], l1 = mg[(qs * 18 + 1) * 256 + ml];
            const float mt = fmaxf(m[qs], m1), f0 = __builtin_amdgcn_exp2f(m[qs] - mt), f1 = __builtin_amdgcn_exp2f(m1 - mt);
            float lt = quad_sum(lsum[qs] * f0 + l1 * f1);
            const float inv = 1.0f / lt; float ss = 0.f;
            const size_t tq = rb + qrow0 + qs * 16;
#pragma unroll
            for (int dt = 0; dt < 4; ++dt) { f32x4 o;
#pragma unroll
                for (int r = 0; r < 4; ++r) { o[r] = (oacc[qs][dt][r] * f0 + mg[(qs * 18 + 2 + dt * 4 + r) * 256 + ml] * f1) * inv; ss += o[r] * o[r]; }
                u32x2 w; w.x = pk2(o[0], o[1]); w.y = pk2(o[2], o[3]); *(u32x2*)(y + tq * DM + YC_D + h * 64 + dt * 16 + quad * 4) = w; }
            ss = quad_sum(ss);
            if (quad == 0) ssd[tq * 4 + h] = ss;
        }
    }
    __syncthreads();
}

#define XB_TMO      128
#define XB_XCNT(j)  (256  + 64 * (j))
#define XB_XSUB(j)  (1280 + 64 * (j))
#define XB_XGEN(j)  (2304 + 64 * (j))
#define XB_TOP      3328
#define XB_TOPGEN   3392
#define XCD_BAR_WORDS 3456
#define XB_SPIN_CAP (1u << 18)

__device__ __forceinline__ unsigned xb_ld(unsigned* p)              { return __hip_atomic_load(p, __ATOMIC_RELAXED, __HIP_MEMORY_SCOPE_AGENT); }
__device__ __forceinline__ unsigned xb_add(unsigned* p, unsigned v) { return __hip_atomic_fetch_add(p, v, __ATOMIC_RELAXED, __HIP_MEMORY_SCOPE_AGENT); }
__device__ __forceinline__ unsigned xb_xcc_id() { return (unsigned)__builtin_amdgcn_s_getreg((3 << 11) | 20) & 0xFu; }
#define XB_SPIN(cond, bar) do { unsigned _sp = 0; while (cond) { __builtin_amdgcn_s_sleep(1); \
    if ((++_sp & 255u) == 0u) { if (xb_ld(&(bar)[XB_TMO])) break; if (_sp > XB_SPIN_CAP) { atomicAdd(&(bar)[XB_TMO], 1u); break; } } } } while (0)

struct XcdBarrier {
    unsigned* bar; unsigned x;
    volatile LAS unsigned* st;
};

__device__ __forceinline__ XcdBarrier xcd_barrier_post(unsigned* bar, volatile LAS unsigned* st) {
    XcdBarrier b; b.bar = bar; b.x = xb_xcc_id(); b.st = st;
    if (opaque_tid() == 0) (void)xb_add(&bar[XB_XCNT(b.x)], 1u);
    return b;
}
__device__ __forceinline__ void xcd_barrier_complete(unsigned* bar, unsigned x, unsigned& nloc, unsigned& nx) {
    const unsigned G = gridDim.x * gridDim.y * gridDim.z;
    unsigned sum, cnt, mine, sp = 0u;
    for (;;) {
        sum = 0u; cnt = 0u; mine = 0u;
#pragma unroll
        for (unsigned j = 0; j < 16; ++j) { const unsigned c = xb_ld(&bar[XB_XCNT(j)]); sum += c; cnt += (c > 0u) ? 1u : 0u; mine = (j == x) ? c : mine; }
        if (sum == G) break;
        __builtin_amdgcn_s_sleep(1);
        if ((++sp & 255u) == 0u) { if (xb_ld(&bar[XB_TMO])) break; if (sp > XB_SPIN_CAP) { atomicAdd(&bar[XB_TMO], 1u); break; } }
    }
    nloc = mine > 0u ? mine : 1u; nx = cnt > 0u ? cnt : 1u;
}

__device__ __forceinline__ void xcd_barrier(const XcdBarrier& b) {
    asm volatile("s_waitcnt vmcnt(0)" ::: "memory");
    __syncthreads();
    if (opaque_tid() == 0) {
        unsigned* bar = b.bar;
        __builtin_amdgcn_s_waitcnt(0);
        unsigned nloc = b.st[0], nx = b.st[1];
        if (nloc == 0u) { xcd_barrier_complete(bar, b.x, nloc, nx); b.st[0] = nloc; b.st[1] = nx; }
        const unsigned old = xb_add(&bar[XB_XSUB(b.x)], 1u);
        const unsigned gen = old / nloc;
        if (old + 1u == (gen + 1u) * nloc) {
            __builtin_amdgcn_fence(__ATOMIC_RELEASE, "agent");
            asm volatile("s_waitcnt vmcnt(0)" ::: "memory");
            const unsigned og = xb_add(&bar[XB_TOP], 1u);
            const unsigned tg = og / nx;
            if (og + 1u == (tg + 1u) * nx) xb_add(&bar[XB_TOPGEN], 1u);
            else XB_SPIN(xb_ld(&bar[XB_TOPGEN]) == tg, bar);
            __builtin_amdgcn_fence(__ATOMIC_ACQUIRE, "agent");
            xb_add(&bar[XB_XGEN(b.x)], 1u);
            asm volatile("s_waitcnt vmcnt(0)" ::: "memory");
        } else {
            XB_SPIN(xb_ld(&bar[XB_XGEN(b.x)]) == gen, bar);
            __builtin_amdgcn_fence(__ATOMIC_ACQUIRE, "agent");
            asm volatile("s_waitcnt vmcnt(0)" ::: "memory");
        }
    }
    __syncthreads();
}

#ifndef WGM_G1
#define WGM_G1 2
#endif
#ifndef WGM_G2
#define WGM_G2 4
#endif
#ifndef WGM_G3
#define WGM_G3 4
#endif
#ifndef WGM_G4
#define WGM_G4 8
#endif
#ifndef PROBE_DUP
#define PROBE_DUP 0
#endif
#ifndef ITEM_MASK
#define ITEM_MASK 127
#endif
__global__ void __launch_bounds__(NTHR, 2) fwd_kernel(Args a) {
    extern __shared__ __attribute__((aligned(16))) unsigned char lds[];
    {
        volatile LAS unsigned* bst0 = (volatile LAS unsigned*)(lds + LDS_BYTES - 16);
        if (opaque_tid() == 0) { bst0[0] = 0u; bst0[1] = 0u; }
        __syncthreads();
        (void)xcd_barrier_post((unsigned*)(ws_() + WS_BAR), bst0);
    }
    if (PH_HI > 4096) cg::this_grid().sync();
#define SEAM(k) do { if ((k) + 1 < PH_HI) { XcdBarrier xb_; xb_.bar = (unsigned*)(ws_() + WS_BAR); xb_.x = xb_xcc_id(); xb_.st = (volatile LAS unsigned*)(lds + LDS_BYTES - 16); xcd_barrier(xb_); if (PROBE_DUP == 1) xcd_barrier(xb_); } } while (0)
#define IN(k) (PH_LO <= (k) && (k) < PH_HI)
    if (IN(0)) { prep_phase(a, lds); if (PROBE_DUP == 4) prep_phase(a, lds); SEAM(0); }
    for (int l = 0; l < DEPTH; ++l) {
        const int pb = 1 + 8 * l;
        if (l == 0 && IN(pb + 0)) {
            norm_phase<false, 1>(INP(0), nullptr, (bf16_t*)(ws_() + WS_H), (float*)(ws_() + WS_SS2), nullptr, (const float*)(ws_() + WS_WF), INP(23), (float*)(ws_() + WS_LOGF));
            SEAM(pb + 0);
        }
        if (IN(pb + 1)) {
            pg8::Gemm g{(const pg8::bf16_t*)(ws_() + WS_H), (const pg8::bf16_t*)(ws_() + WS_WIN) + (size_t)l * ZW * DM, T, ZW, DM}; pg8::StaticOrder S; S.init(T, ZW, grid_(), bid_(), WGM_G1);
            EpiStoreBf16<0, true> E{(bf16_t*)(ws_() + WS_Z), ZW, (const float*)(ws_() + WS_SS2)};
            pg8::gemm_phase<EpiStoreBf16<0, true>, pg8::StaticOrder, true, true>((PG8_LAS unsigned char*)lds, g, S, E);
            if (PROBE_DUP == 9) pg8::gemm_phase<EpiStoreBf16<0, true>, pg8::StaticOrder, true, true>((PG8_LAS unsigned char*)lds, g, S, E);
            if (l > 0) norm_phase<true, 1>(ws_() + WS_H, nullptr, nullptr, nullptr, nullptr, (const float*)(ws_() + WS_WF) + (size_t)l * DM * 4, INP(23) + l * 4, (float*)(ws_() + WS_LOGF));
            SEAM(pb + 1);
        }
        if (IN(pb + 2)) {
            for (int rep = 0; rep < (PROBE_DUP == 2 ? 2 : 1); ++rep)
            {
            for (int it = bid_(); it < 256; it += grid_()) {
                if (it < 128) { if (ITEM_MASK & 1) s5_item<1>(l, it >> 5, it & 31, a, lds); }
                else { if (ITEM_MASK & 4) lru_item<1>(l, (it - 128) >> 5, (it - 128) & 31, a, lds); }
            }
            const int cb_ = (grid_() >= 132) ? bid_() - 128 : bid_();
            if (cb_ >= 0 && cb_ < 4) { if (ITEM_MASK & 8) cumsum_item(cb_, (const float*)(ws_() + WS_LOGF), (float*)(ws_() + WS_CS), lds); }
            }
            SEAM(pb + 2);
        }
        if (IN(pb + 3)) {
            for (int rep = 0; rep < (PROBE_DUP == 3 ? 2 : 1); ++rep) {
            for (int rep2 = 0; rep2 < (PROBE_DUP == 5 ? 2 : 1); ++rep2)
            for (int up = bid_(); up < 256; up += grid_()) {
                const int xcd_ = up & 7, ix_ = up >> 3, pr = xcd_ + 8 * (ix_ >> 4), j = ix_ & 15;
                if (ITEM_MASK & 16) { attn_unit(pr >> 2, pr & 3, 31 - j, a, lds);
                attn_unit(pr >> 2, pr & 3, j, a, lds); }
            }
            for (int rep3 = 0; rep3 < (PROBE_DUP == 6 ? 2 : 1); ++rep3)
            for (int it = bid_(); it < 256; it += grid_()) {
                if (it < 128) { if (ITEM_MASK & 32) s5_item<2>(l, it >> 5, it & 31, a, lds); }
                else { if (ITEM_MASK & 64) lru_item<2>(l, (it - 128) >> 5, (it - 128) & 31, a, lds); }
            }
            if (ITEM_MASK & 2) {
                unsigned* qctr = (unsigned*)(ws_() + WS_BAR) + 3600 + l;
                volatile LAS unsigned* qslot = (volatile LAS unsigned*)(lds + LDS_BYTES - 48);
                for (;;) {
                    __syncthreads();
                    if (opaque_tid() == 0) qslot[0] = __hip_atomic_fetch_add(qctr, 1u, __ATOMIC_RELAXED, __HIP_MEMORY_SCOPE_AGENT);
                    __syncthreads();
                    const unsigned qi = qslot[0];
                    if (qi >= 256u) break;
                    if (qi < 128u) sgu_item<1>(l, (int)(qi >> 5), (int)(qi & 31), a, lds);
                    else sgu_item<0>(l, (int)((qi - 128u) >> 5), (int)(qi & 31), a, lds);
                }
            }
            }
            SEAM(pb + 3);
        }
        if (IN(pb + 4)) {
            pg8::Gemm g{(const pg8::bf16_t*)(ws_() + WS_Y), (const pg8::bf16_t*)(ws_() + WS_WOUT) + (size_t)l * DM * DM, T, DM, DM}; pg8::StaticOrder S; S.init(T, DM, grid_(), bid_(), WGM_G2);
            EpiRes<true, true> E{(bf16_t*)(ws_() + WS_H), DM, (const float*)(ws_() + WS_SSD), (float*)(ws_() + WS_SS2)};
            pg8::gemm_phase<EpiRes<true, true>, pg8::StaticOrder, true, true>((PG8_LAS unsigned char*)lds, g, S, E);
            SEAM(pb + 4);
        }
        if (IN(pb + 6)) {
            pg8::Gemm g{(const pg8::bf16_t*)(ws_() + WS_H), (const pg8::bf16_t*)(ws_() + WS_WMI) + (size_t)l * DFF * DM, T, DFF, DM}; pg8::StaticOrder S; S.init(T, DFF, grid_(), bid_(), WGM_G3);
            EpiStoreBf16<1, true> E{(bf16_t*)(ws_() + WS_ACT), DFF, (const float*)(ws_() + WS_SS2)};
            pg8::gemm_phase<EpiStoreBf16<1, true>, pg8::StaticOrder, true, true>((PG8_LAS unsigned char*)lds, g, S, E);
            SEAM(pb + 6);
        }
        if (IN(pb + 7)) {
            pg8::Gemm g{(const pg8::bf16_t*)(ws_() + WS_ACT), (const pg8::bf16_t*)(ws_() + WS_WMO) + (size_t)l * DM * DFF, T, DM, DFF}; pg8::StaticOrder S; S.init(T, DM, grid_(), bid_(), WGM_G4);
            EpiRes<false, true> E{(bf16_t*)(ws_() + WS_H), DM, nullptr, (float*)(ws_() + WS_SS2)};
            pg8::gemm_phase<EpiRes<false, true>, pg8::StaticOrder, true, true>((PG8_LAS unsigned char*)lds, g, S, E);
            SEAM(pb + 7);
        }
    }
    if (IN(33)) norm_phase<true, 2>(ws_() + WS_H, INP(29), nullptr, nullptr, out_(), nullptr, nullptr, nullptr);
#undef SEAM
#undef IN
}


#ifndef DUMP_SEL
#define DUMP_SEL 0
#endif
#ifndef DUMP_LAST
#define DUMP_LAST 33
#endif
__global__ void dump_kernel(const unsigned char* ws, float* out) {
    const size_t i = (size_t)blockIdx.x * blockDim.x + threadIdx.x;
    const size_t t = i >> 10, c = i & 1023;
    float v = 0.f;
    if (DUMP_SEL == 1) v = bf2f(((const bf16_t*)(ws + WS_H))[i]);
    if (DUMP_SEL == 2) v = bf2f(((const bf16_t*)(ws + WS_Z))[t * ZW + c]) + bf2f(((const bf16_t*)(ws + WS_Z))[t * ZW + c + 1024]);
    if (DUMP_SEL == 3) v = bf2f(((const bf16_t*)(ws + WS_Y))[i]);
    if (DUMP_SEL == 5) v = ((const float*)(ws + WS_SSD))[(t * 4 + (c & 3))] + ((const float*)(ws + WS_CS))[(t * 4 + (c & 3))];
    if (DUMP_SEL == 7) v = ((const float*)(ws + WS_ELOC))[i & 262143];
    if (DUMP_SEL == 8) v = ((const float*)(ws + WS_LA))[i & 32767] + ((const float*)(ws + WS_LB))[i & 32767];
    if (DUMP_SEL == 6) v = bf2f(((const bf16_t*)(ws + WS_WIN))[i]) + bf2f(((const bf16_t*)(ws + WS_WMI))[i]) + bf2f(((const bf16_t*)(ws + WS_WMO))[i]) + bf2f(((const bf16_t*)(ws + WS_WOUT))[i & 0x3fffff]);
    out[i] = v;
}
#ifndef N_LAUNCH_MODE
#define N_LAUNCH_MODE 1
#endif
extern "C" void kernel_launch(void* const* d_in, const int* in_sizes, int n_in, void* d_out, int out_size, void* d_ws, size_t ws_size, hipStream_t stream) {
    static int grid = 0;
    if (grid == 0) {
        if (n_in != 30 || out_size != T * DM || ws_size < WS_END) { fprintf(stderr, "kernel_launch: unexpected shapes (n_in %d, out %d, ws %zu, need %zu)\n", n_in, out_size, ws_size, (size_t)WS_END); grid = -1; return; }
        int dev = 0, cus = 0, per_cu = 0;
        hipGetDevice(&dev); hipDeviceGetAttribute(&cus, hipDeviceAttributeMultiprocessorCount, dev);
        if (hipFuncSetAttribute((const void*)fwd_kernel, hipFuncAttributeMaxDynamicSharedMemorySize, LDS_BYTES) != hipSuccess) { fprintf(stderr, "kernel_launch: hipFuncSetAttribute failed\n"); grid = -1; return; }
        if (hipOccupancyMaxActiveBlocksPerMultiprocessor(&per_cu, (const void*)fwd_kernel, NTHR, LDS_BYTES) != hipSuccess || per_cu < 1) { fprintf(stderr, "kernel_launch: occupancy query says %d\n", per_cu); per_cu = 1; }
        (void)hipGetLastError();
        grid = cus;
        if (grid > 256) grid = 256;
    }
    if (grid < 0) return;
    Args a{};
    for (int i = 0; i < 30; ++i) a.in[i] = (const float*)d_in[i];
    a.out = (float*)d_out; a.ws = (unsigned char*)d_ws;
    if (N_LAUNCH_MODE == 1) {
        a.ph_lo = 0; a.ph_hi = 34;
        if (hipMemsetAsync((unsigned char*)d_ws + WS_BAR, 0, 16 * 1024, stream) != hipSuccess) { fprintf(stderr, "kernel_launch: memset of the barrier words failed\n"); return; }
        void* args[] = {&a};
        hipError_t e = hipLaunchCooperativeKernel((const void*)fwd_kernel, dim3(grid), dim3(NTHR), args, LDS_BYTES, stream);
        if (e != hipSuccess) fprintf(stderr, "kernel_launch: cooperative launch failed: %s (grid %d)\n", hipGetErrorString(e), grid);
    } else {
        for (int ph = 0; ph <= DUMP_LAST; ++ph) { a.ph_lo = ph; a.ph_hi = ph + 1; hipLaunchKernelGGL(fwd_kernel, dim3(grid), dim3(NTHR), LDS_BYTES, stream, a); }
        if (DUMP_SEL != 0 && DUMP_SEL != 4) hipLaunchKernelGGL(dump_kernel, dim3(T * DM / 256), dim3(256), 0, stream, (const unsigned char*)d_ws, (float*)d_out);
    }
}
```

```cpp
#include <hip/hip_runtime.h>
#include <hip/hip_cooperative_groups.h>
#include <cstdio>
#include <cstdint>
namespace cg = cooperative_groups;
__device__ __forceinline__ int opaque_tid() { int t = __builtin_amdgcn_workitem_id_x(); asm volatile("" : "+v"(t)); return t; }
namespace pg8 {
#define PG8_LAS __attribute__((address_space(3)))
typedef unsigned short bf16_t;
typedef short bf16x8 __attribute__((ext_vector_type(8)));
typedef float f32x4 __attribute__((ext_vector_type(4)));
typedef unsigned u32x4 __attribute__((ext_vector_type(4)));
constexpr int BM = 256, BK = 64, HALF = 128, HTB = HALF * BK * 2  , STAGE_BYTES = 8 * HTB, NXCD = 8, WGM = 4;

__host__ __device__ __forceinline__ int lds_byte(int r, int c) { const int st = (r >> 4) * 2 + (c >> 5), rr = r & 15, cc = c & 31, ob = rr * 64 + cc * 2; return st * 1024 + (ob ^ (((ob >> 9) & 1) << 5)); }
__host__ __device__ __forceinline__ void stage_rc(int b, int& R, int& C) { const int st = b / 1024, sb = b % 1024, swz = sb ^ (((sb >> 9) & 1) << 5); R = (st >> 1) * 16 + swz / 64; C = (st & 1) * 32 + (swz % 64) / 2; }
__host__ __device__ __forceinline__ int perm32(int rho) { const int n = rho >> 4, i = rho & 15; return 8 * (i >> 2) + 4 * n + (i & 3); }

struct Unit { int pm, pn; };
struct Gemm { const bf16_t* A; const bf16_t* Bt; int M, N, K; };

struct StaticOrder {
    int nM, nN, nwg, G, c, wgm;
    __host__ __device__ void init(int M, int N, int G_, int c_, int wgm_ = WGM) { nM = M / BM; nN = N / BM; nwg = nM * nN; G = G_; c = c_; wgm = wgm_; }
    __host__ __device__ bool next(int i, Unit& u) const {
        const long L = (long)i * G + c; if (L >= nwg) return false;
        int wgid = (int)L; { const int q = nwg / NXCD, r = nwg % NXCD, xcd = wgid % NXCD, off = wgid / NXCD; wgid = (xcd < r ? xcd * (q + 1) : r * (q + 1) + (xcd - r) * q) + off; }
        const int nig = wgm * nN, gid = wgid / nig, fm = gid * wgm, gsz = (nM - fm) < wgm ? (nM - fm) : wgm;
        u.pm = fm + ((wgid % nig) % gsz); u.pn = (wgid % nig) / gsz; return true;
    }
    __device__ __forceinline__ void a_ready(const Unit&) const {}
    __device__ __forceinline__ void done(const Unit&) const {}
};

__device__ __forceinline__ unsigned cvt_pk_bf16(float lo, float hi) { unsigned r; asm volatile("v_cvt_pk_bf16_f32 %0, %1, %2" : "=v"(r) : "v"(lo), "v"(hi)); return r; }
template <class Epi, class Sched, bool ALIGN_EPI = false, bool SP2 = false>
__device__ __forceinline__ void gemm_phase(PG8_LAS unsigned char* lds, const Gemm g, const Sched& S, const Epi& E) {
    const int tid = opaque_tid(), wid = __builtin_amdgcn_readfirstlane(tid >> 6), lane = tid & 63, wr = wid >> 2, wc = wid & 3, fr = lane & 15, fq = lane >> 4;
    const int K = g.K, nt = K / BK;
    unsigned voffA[2], voffB[2];
#pragma unroll
    for (int i = 0; i < 2; ++i) { int R, C; stage_rc(tid * 16 + i * 8192, R, C); const int Rb = Epi::PERM ? ((R & ~31) + perm32(R & 31)) : R;
        voffA[i] = (unsigned)(R * K + C) * 2u; voffB[i] = (unsigned)(Rb * K + C) * 2u; }
    const size_t kstep = (size_t)(BK * 2);
    const size_t hstep = (size_t)HALF * K * 2;
    const size_t tstep = 2 * hstep;
    const unsigned ldsw = (unsigned)wid * 1024u;
    const int aoff = lds_byte(wr * 64 + fr, fq * 8), boff = lds_byte(wc * 32 + fr, fq * 8);
#define PG8_SA(b, h) (((b) * 2 + (h)) * HTB)
#define PG8_SB(b, h) ((4 + (b) * 2 + (h)) * HTB)
#define PG8_STAGE(bufoff, gbase, voff) do { _Pragma("unroll") for (int _i = 0; _i < 2; ++_i) \
        __builtin_amdgcn_global_load_lds((const unsigned*)((const char*)(gbase) + (voff)[_i]), (PG8_LAS unsigned*)(lds + (bufoff) + ldsw + _i * 8192), 16, 0, 0); } while (0)
#define PG8_LDA(dst, b, h) do { _Pragma("unroll") for (int m = 0; m < 4; ++m) _Pragma("unroll") for (int k = 0; k < 2; ++k) dst[m][k] = *(const PG8_LAS bf16x8*)(lds + PG8_SA(b, h) + aoff + m * 2048 + k * 1024); } while (0)
#define PG8_LDB(dst, b, h) do { _Pragma("unroll") for (int n = 0; n < 2; ++n) _Pragma("unroll") for (int k = 0; k < 2; ++k) dst[n][k] = *(const PG8_LAS bf16x8*)(lds + PG8_SB(b, h) + boff + n * 2048 + k * 1024); } while (0)
#define PG8_MMA(ai, bj, At, Bt) do { __builtin_amdgcn_s_setprio(1); _Pragma("unroll") for (int m = 0; m < 4; ++m) _Pragma("unroll") for (int n = 0; n < 2; ++n) _Pragma("unroll") for (int k = 0; k < 2; ++k) \
        acc[ai][bj][m][n] = __builtin_amdgcn_mfma_f32_16x16x32_bf16(Bt[n][k], At[m][k], acc[ai][bj][m][n], 0, 0, 0); __builtin_amdgcn_s_setprio(0); } while (0)
#define PG8_WAIT_V(n) asm volatile("s_waitcnt vmcnt(" #n ")" ::: "memory")
#define PG8_WAIT_L(n) asm volatile("s_waitcnt lgkmcnt(" #n ")" ::: "memory")
#define PG8_BAR __builtin_amdgcn_s_barrier()
#define PG8_SCHED __builtin_amdgcn_sched_barrier(0)
    Unit cur, nxt; int ui = 0;
    if (!S.next(0, cur)) return;
    if constexpr (Epi::KPREP) { Unit pu; for (int i = 0; i < 12 && S.next(i, pu); ++i) E.kprep(pu, lds + STAGE_BYTES + i * 1024, tid); }
    f32x4 acc[2][2][4][2];
#pragma unroll
    for (int a = 0; a < 2; ++a)
#pragma unroll
        for (int b = 0; b < 2; ++b)
#pragma unroll
            for (int m = 0; m < 4; ++m)
#pragma unroll
                for (int n = 0; n < 2; ++n) acc[a][b][m][n] = (f32x4){0.f, 0.f, 0.f, 0.f};
    bf16x8 At[4][2], B0[2][2], B1[2][2];
    const char* cA = (const char*)g.A + (size_t)cur.pm * tstep; const char* cB = (const char*)g.Bt + (size_t)cur.pn * tstep;
    S.a_ready(cur);
    if constexpr (SP2) {
        PG8_STAGE(PG8_SB(0, 0), cB, voffB); PG8_STAGE(PG8_SB(0, 1), cB + hstep, voffB); PG8_STAGE(PG8_SA(0, 0), cA, voffA); PG8_STAGE(PG8_SA(0, 1), cA + hstep, voffA);
        if (wr == 1) PG8_BAR;
        PG8_WAIT_V(2); PG8_BAR;
        PG8_STAGE(PG8_SB(1, 0), cB + kstep, voffB); PG8_STAGE(PG8_SA(1, 0), cA + kstep, voffA); PG8_STAGE(PG8_SB(1, 1), cB + hstep + kstep, voffB);
        PG8_WAIT_V(6); PG8_BAR;
    } else {
        PG8_STAGE(PG8_SB(0, 0), cB, voffB); PG8_STAGE(PG8_SA(0, 0), cA, voffA); PG8_STAGE(PG8_SB(0, 1), cB + hstep, voffB); PG8_STAGE(PG8_SA(0, 1), cA + hstep, voffA);
        if (wr == 1) PG8_BAR;
        PG8_WAIT_V(4); PG8_BAR;
        PG8_STAGE(PG8_SB(1, 0), cB + kstep, voffB); PG8_STAGE(PG8_SA(1, 0), cA + kstep, voffA); PG8_STAGE(PG8_SB(1, 1), cB + hstep + kstep, voffB);
        PG8_WAIT_V(6); PG8_BAR;
    }
    for (;;) {
        const bool has_next = S.next(ui + 1, nxt);
        const char* nA = has_next ? (const char*)g.A + (size_t)nxt.pm * tstep : cA; const char* nB = has_next ? (const char*)g.Bt + (size_t)nxt.pn * tstep : cB;
        for (int t = 0; t < nt; t += 2) {
            const bool last = (t == nt - 2);
            const char* a1 = cA + (size_t)(t + 1) * kstep;
            const char* a2 = last ? nA : cA + (size_t)(t + 2) * kstep; const char* b2 = last ? nB : cB + (size_t)(t + 2) * kstep;
            const char* a3 = a2 + kstep; const char* b3 = b2 + kstep;
            if (last && has_next) S.a_ready(nxt);
            if constexpr (SP2) {
            PG8_LDB(B0, 0, 0); PG8_LDB(B1, 0, 1); PG8_SCHED; PG8_LDA(At, 0, 0); PG8_STAGE(PG8_SA(1, 1), a1 + hstep, voffA);
            PG8_WAIT_V(8); PG8_WAIT_L(0); PG8_BAR; PG8_MMA(0, 0, At, B0); PG8_MMA(0, 1, At, B1); PG8_BAR; PG8_SCHED;
            PG8_LDA(At, 0, 1); PG8_STAGE(PG8_SB(0, 0), b2, voffB); PG8_STAGE(PG8_SB(0, 1), b2 + hstep, voffB); PG8_STAGE(PG8_SA(0, 0), a2, voffA);
            PG8_WAIT_V(8); PG8_WAIT_L(0); PG8_BAR; PG8_MMA(1, 0, At, B0); PG8_MMA(1, 1, At, B1); PG8_BAR; PG8_SCHED;
            PG8_LDB(B0, 1, 0); PG8_LDB(B1, 1, 1); PG8_SCHED; PG8_LDA(At, 1, 0); PG8_STAGE(PG8_SA(0, 1), a2 + hstep, voffA);
            PG8_WAIT_V(8); PG8_WAIT_L(0); PG8_BAR; PG8_MMA(0, 0, At, B0); PG8_MMA(0, 1, At, B1); PG8_BAR; PG8_SCHED;
            PG8_LDA(At, 1, 1); PG8_STAGE(PG8_SB(1, 0), b3, voffB); PG8_STAGE(PG8_SB(1, 1), b3 + hstep, voffB); PG8_STAGE(PG8_SA(1, 0), a3, voffA);
            PG8_WAIT_V(8); PG8_WAIT_L(0); PG8_BAR; PG8_MMA(1, 0, At, B0); PG8_MMA(1, 1, At, B1); PG8_BAR; PG8_SCHED;
            } else {
            PG8_LDB(B0, 0, 0); PG8_SCHED; PG8_LDA(At, 0, 0); PG8_STAGE(PG8_SA(1, 1), a1 + hstep, voffA);
            PG8_WAIT_L(8); PG8_BAR; PG8_WAIT_L(0); PG8_MMA(0, 0, At, B0); PG8_BAR; PG8_SCHED;
            PG8_LDB(B1, 0, 1); PG8_STAGE(PG8_SB(0, 0), b2, voffB);
            PG8_BAR; PG8_WAIT_L(0); PG8_MMA(0, 1, At, B1); PG8_BAR;
            PG8_LDA(At, 0, 1); PG8_STAGE(PG8_SA(0, 0), a2, voffA);
            PG8_BAR; PG8_WAIT_L(0); PG8_MMA(1, 0, At, B0); PG8_BAR; PG8_SCHED;
            PG8_STAGE(PG8_SB(0, 1), b2 + hstep, voffB);
            PG8_WAIT_V(6); PG8_BAR; PG8_MMA(1, 1, At, B1); PG8_BAR;
            PG8_LDB(B0, 1, 0); PG8_SCHED; PG8_LDA(At, 1, 0); PG8_STAGE(PG8_SA(0, 1), a2 + hstep, voffA);
            PG8_WAIT_L(8); PG8_BAR; PG8_WAIT_L(0); PG8_MMA(0, 0, At, B0); PG8_BAR; PG8_SCHED;
            PG8_LDB(B1, 1, 1); PG8_STAGE(PG8_SB(1, 0), b3, voffB);
            PG8_BAR; PG8_WAIT_L(0); PG8_MMA(0, 1, At, B1); PG8_BAR;
            PG8_LDA(At, 1, 1); PG8_STAGE(PG8_SA(1, 0), a3, voffA);
            PG8_BAR; PG8_WAIT_L(0); PG8_MMA(1, 0, At, B0); PG8_BAR; PG8_SCHED;
            PG8_STAGE(PG8_SB(1, 1), b3 + hstep, voffB);
            PG8_WAIT_V(6); PG8_BAR; PG8_MMA(1, 1, At, B1); PG8_BAR;
            }
            if constexpr (Epi::KHOOK) { if (t == 2) E.khook(acc, lds + STAGE_BYTES + ui * 1024, wr, fr); }
        }
        if constexpr (ALIGN_EPI) { if (wr == 0) PG8_BAR; }
        if constexpr (!Epi::AFTER_DRAIN) { E(acc, cur, wr, wc, fr, fq, lds + STAGE_BYTES + ui * 1024); S.done(cur); }
        if (!has_next) break;
#pragma unroll
        for (int a = 0; a < 2; ++a)
#pragma unroll
            for (int b = 0; b < 2; ++b)
#pragma unroll
                for (int m = 0; m < 4; ++m)
#pragma unroll
                    for (int n = 0; n < 2; ++n) acc[a][b][m][n] = (f32x4){0.f, 0.f, 0.f, 0.f};
        cur = nxt; cA = nA; cB = nB; ++ui;
        if constexpr (ALIGN_EPI) { if (wr == 1) PG8_BAR; }
    }
    PG8_WAIT_V(0);
    if constexpr (!ALIGN_EPI) { if (wr == 0) PG8_BAR; }
    PG8_BAR;
    if constexpr (Epi::AFTER_DRAIN) { E.fused(acc, cur, wr, wc, fr, fq, lds, wid, lane); S.done(cur); }
#undef PG8_SA
#undef PG8_SB
#undef PG8_STAGE
#undef PG8_LDA
#undef PG8_LDB
#undef PG8_MMA
#undef PG8_WAIT_V
#undef PG8_WAIT_L
#undef PG8_BAR
#undef PG8_SCHED
}
}

#define LAS __attribute__((address_space(3)))
typedef unsigned short bf16_t;
typedef short bf16x8 __attribute__((ext_vector_type(8)));
typedef short bf16x4 __attribute__((ext_vector_type(4)));
typedef float f32x4 __attribute__((ext_vector_type(4)));
typedef float f32x2 __attribute__((ext_vector_type(2)));
typedef unsigned u32x4 __attribute__((ext_vector_type(4)));
typedef unsigned u32x2 __attribute__((ext_vector_type(2)));
typedef short v4i16_t __attribute__((ext_vector_type(4)));

constexpr int NB = 4, SEQ = 4096, DM = 1024, DEPTH = 4, T = NB * SEQ, W = 256, DFF = 4096, NIN = 2052, ZW = 2048;
constexpr int NCH = SEQ / 128;
constexpr float EPS = 1e-6f;
constexpr float LOG2E = 1.4426950408889634f;
constexpr int NTHR = 512;
constexpr int LDS_BYTES = 147456;
constexpr int ZC_AU = 0, ZC_AV = 256, ZC_B = 512, ZC_CX = 768, ZC_CG = 1024, ZC_Q = 1280, ZC_K = 1536, ZC_V = 1792;
constexpr int YC_D = 0, YC_A = 256, YC_B = 512, YC_C = 768;

constexpr size_t MiB = 1u << 20;
constexpr size_t WS_WIN = 0, WS_WOUT = 16 * MiB, WS_WMI = 24 * MiB, WS_WMO = 56 * MiB, WS_R = 88 * MiB, WS_Z = WS_R, WS_Y = WS_R + 64 * MiB, WS_ACT = WS_R,
                 WS_H = 216 * MiB, WS_S = 248 * MiB;
constexpr size_t WS_GLUT = WS_S, WS_WAT = WS_GLUT + 512 * 1024, WS_WXT = WS_WAT + 128 * 1024, WS_BBT = WS_WXT + 128 * 1024, WS_CMT = WS_BBT + 256 * 1024,
                 WS_ABAR = WS_CMT + 256 * 1024, WS_A128 = WS_ABAR + 32 * 1024, WS_WF = WS_A128 + 32 * 1024, WS_LOGF = WS_WF + 64 * 1024, WS_CS = WS_LOGF + 256 * 1024,
                 WS_SSD = WS_CS + 256 * 1024, WS_ELOC = WS_SSD + 256 * 1024, WS_LA = WS_ELOC + 1024 * 1024, WS_LB = WS_LA + 128 * 1024, WS_BAR = WS_LB + 128 * 1024, WS_SS2 = WS_BAR + 16 * 1024, WS_KMAX = WS_SS2 + 1024 * 1024, WS_END = WS_KMAX + 4096;

struct Args {
    const float* in[30]; float* out; unsigned char* ws; int ph_lo, ph_hi;
};


typedef const __attribute__((address_space(4))) unsigned long long* kargp_t;
__device__ __forceinline__ unsigned long long karg_(int i) { kargp_t tab = (kargp_t)__builtin_amdgcn_kernarg_segment_ptr(); asm volatile("" : "+s"(tab)); return tab[i]; }
#define INP(i) ((const float*)karg_(i))
__device__ __forceinline__ unsigned char* ws_() { return (unsigned char*)karg_(31); }
__device__ __forceinline__ float* out_() { return (float*)karg_(30); }
#define PH_LO ((int)(unsigned)(karg_(32) & 0xffffffffull))
#define PH_HI ((int)(unsigned)(karg_(32) >> 32))
__device__ __forceinline__ int bid_() { return blockIdx.x; }
__device__ __forceinline__ int grid_() { return gridDim.x; }
__device__ __forceinline__ float bf2f(bf16_t v) { return __uint_as_float((unsigned)v << 16); }
__device__ __forceinline__ float bfs2f(short v) { return __uint_as_float(((unsigned)(unsigned short)v) << 16); }
typedef __bf16 bf16x2_t __attribute__((ext_vector_type(2)));
__device__ __forceinline__ unsigned pk2(float lo, float hi) { const f32x2 v = {lo, hi}; const bf16x2_t b = __builtin_convertvector(v, bf16x2_t); return __builtin_bit_cast(unsigned, b); }
__device__ __forceinline__ bf16_t f2bf(float f) { return (bf16_t)(pk2(f, 0.f) & 0xffffu); }
__device__ __forceinline__ float gelu_t(float x) { const float y2 = (1.5957691216057308f * LOG2E) * (x + 0.044715f * x * x * x); return x * __builtin_amdgcn_rcpf(1.0f + __builtin_amdgcn_exp2f(-y2)); }
__device__ __forceinline__ float sigm(float x) { return __builtin_amdgcn_rcpf(1.0f + __builtin_amdgcn_exp2f(-LOG2E * x)); }
__device__ __forceinline__ float softplus_f(float x) { return fmaxf(x, 0.f) + log1pf(__expf(-fabsf(x))); }
__device__ __forceinline__ f32x4 mfma16(bf16x8 a, bf16x8 b, f32x4 c) { return __builtin_amdgcn_mfma_f32_16x16x32_bf16(a, b, c, 0, 0, 0); }
__device__ __forceinline__ float quad_sum(float v) {
    { const auto r = __builtin_amdgcn_permlane16_swap(__float_as_uint(v), __float_as_uint(v), false, false); v = __uint_as_float(r[0]) + __uint_as_float(r[1]); }
    { const auto r = __builtin_amdgcn_permlane32_swap(__float_as_uint(v), __float_as_uint(v), false, false); v = __uint_as_float(r[0]) + __uint_as_float(r[1]); }
    return v;
}
template <int CTRL> __device__ __forceinline__ float dpp_mov(float x) { return __uint_as_float((unsigned)__builtin_amdgcn_update_dpp(0, (int)__float_as_uint(x), CTRL, 0xf, 0xf, true)); }
__device__ __forceinline__ float wave_sum(float v) {
    v += dpp_mov<0xB1>(v); v += dpp_mov<0x4E>(v); v += dpp_mov<0x141>(v); v += dpp_mov<0x140>(v);
    return quad_sum(v);
}
__device__ __forceinline__ float wave_max(float v);
__device__ __forceinline__ float quad_max(float v) {
    { const auto r = __builtin_amdgcn_permlane16_swap(__float_as_uint(v), __float_as_uint(v), false, false); v = fmaxf(__uint_as_float(r[0]), __uint_as_float(r[1])); }
    { const auto r = __builtin_amdgcn_permlane32_swap(__float_as_uint(v), __float_as_uint(v), false, false); v = fmaxf(__uint_as_float(r[0]), __uint_as_float(r[1])); }
    return v;
}
__device__ __forceinline__ bf16x8 pack8(const float* v) {
    u32x4 w; w.x = pk2(v[0], v[1]); w.y = pk2(v[2], v[3]); w.z = pk2(v[4], v[5]); w.w = pk2(v[6], v[7]); return __builtin_bit_cast(bf16x8, w);
}
__device__ __forceinline__ bf16x8 zero8() { return (bf16x8){0, 0, 0, 0, 0, 0, 0, 0}; }

__device__ __forceinline__ float wave_max(float v) {
    v = fmaxf(v, dpp_mov<0xB1>(v)); v = fmaxf(v, dpp_mov<0x4E>(v)); v = fmaxf(v, dpp_mov<0x141>(v)); v = fmaxf(v, dpp_mov<0x140>(v));
    return quad_max(v);
}
template <int N> __device__ __forceinline__ float dpp_shr(float x, float ident) {
    return __uint_as_float((unsigned)__builtin_amdgcn_update_dpp((int)__float_as_uint(ident), (int)__float_as_uint(x), 0x110 + N, 0xf, 0xf, false));
}
__device__ __forceinline__ float neg_expm1(float x) {
    const float s = -x * (1.0f + x * (0.5f + x * (0.16666667f + x * (0.041666668f + x * (0.0083333338f + x * 0.0013888889f)))));
    const float e = 1.0f - __builtin_amdgcn_exp2f(LOG2E * x);
    return (x > -0.25f) ? s : e;
}
template <int ACT  , bool ROWS = false> struct EpiStoreBf16 {
    static constexpr bool PERM = true, AFTER_DRAIN = false, KHOOK = false, KPREP = ROWS;
    __device__ __forceinline__ void kprep(const pg8::Unit& u, PG8_LAS unsigned char* tab, int tid) const {
        if (tid < 256) { const float* rp = rowss + (size_t)(u.pm * 256 + tid) * 16; const f32x4 s0 = *(const f32x4*)rp, s1 = *(const f32x4*)(rp + 4), s2 = *(const f32x4*)(rp + 8), s3 = *(const f32x4*)(rp + 12);
            const float tot = ((s0[0] + s0[1]) + (s0[2] + s0[3])) + ((s1[0] + s1[1]) + (s1[2] + s1[3])) + ((s2[0] + s2[1]) + (s2[2] + s2[3])) + ((s3[0] + s3[1]) + (s3[2] + s3[3]));
            ((PG8_LAS float*)tab)[tid] = rsqrtf(tot * (1.0f / DM) + EPS); }
    }
    bf16_t* O; int ldc; const float* rowss;
    __device__ __forceinline__ void operator()(const pg8::f32x4 (&acc)[2][2][4][2], const pg8::Unit& u, int wr, int wc, int fr, int fq, PG8_LAS unsigned char* tab) const {
        const int row0 = u.pm * 256 + wr * 64 + fr, col0 = u.pn * 256 + wc * 32 + 8 * fq;
#pragma unroll
        for (int ai = 0; ai < 2; ++ai)
#pragma unroll
            for (int m = 0; m < 4; ++m) { bf16_t* rowp = O + (size_t)(row0 + ai * 128 + m * 16) * ldc + col0;
                const float rsc = ROWS ? ((const PG8_LAS float*)tab)[wr * 64 + fr + ai * 128 + m * 16] : 1.0f;
#pragma unroll
                for (int bj = 0; bj < 2; ++bj) { pg8::f32x4 v0 = acc[ai][bj][m][0] * rsc, v1 = acc[ai][bj][m][1] * rsc;
                    if (ACT == 1) {
#pragma unroll
                        for (int e = 0; e < 4; ++e) { const float a = fmaxf(v0[e], 0.f), b = fmaxf(v1[e], 0.f); v0[e] = a * a; v1[e] = b * b; } }
                    u32x4 w; w.x = pk2(v0[0], v0[1]); w.y = pk2(v0[2], v0[3]); w.z = pk2(v1[0], v1[1]); w.w = pk2(v1[2], v1[3]);
                    *(u32x4*)(rowp + bj * 128) = w; } }
    }
};
template <bool HOOK, bool NORMOUT> struct EpiRes {
    static constexpr bool PERM = true, AFTER_DRAIN = false, KHOOK = HOOK, KPREP = HOOK;
    bf16_t* xb; int ldc; const float* ssd; float* ss2;
    __device__ __forceinline__ void operator()(const pg8::f32x4 (&acc)[2][2][4][2], const pg8::Unit& u, int wr, int wc, int fr, int fq, PG8_LAS unsigned char* tab) const {
        const int col0 = u.pn * 256 + wc * 32 + 8 * fq;
#pragma unroll
        for (int ai = 0; ai < 2; ++ai)
#pragma unroll
            for (int m = 0; m < 4; ++m) { const int row = u.pm * 256 + ai * 128 + wr * 64 + m * 16 + fr; bf16_t* rowp = xb + (size_t)row * ldc + col0; float sq = 0.f;
#pragma unroll
                for (int bj = 0; bj < 2; ++bj) { const bf16x8 s = *(const bf16x8*)(rowp + bj * 128); float o[8];
#pragma unroll
                    for (int e = 0; e < 4; ++e) { o[e] = bfs2f(s[e]) + acc[ai][bj][m][0][e]; o[4 + e] = bfs2f(s[4 + e]) + acc[ai][bj][m][1][e]; }
                    if (NORMOUT) {
#pragma unroll
                        for (int e = 0; e < 8; ++e) sq += o[e] * o[e]; }
                    *(bf16x8*)(rowp + bj * 128) = pack8(o); }
                if (NORMOUT) { sq = quad_sum(sq); if (fq == 0) ss2[(size_t)row * 16 + u.pn * 4 + wc] = sq; }
                if (m & 1) asm volatile("" ::: "memory"); }
    }
    __device__ __forceinline__ void kprep(const pg8::Unit& u, PG8_LAS unsigned char* tab, int tid) const {
        if (tid < 256) { const f32x4 s4 = *(const f32x4*)(ssd + (size_t)(u.pm * 256 + tid) * 4); ((PG8_LAS float*)tab)[tid] = rsqrtf((s4[0] + s4[1] + s4[2] + s4[3]) * (1.0f / 256.0f) + EPS); }
    }
    __device__ __forceinline__ void khook(pg8::f32x4 (&acc)[2][2][4][2], PG8_LAS unsigned char* tab, int wr, int fr) const {
#pragma unroll
        for (int ai = 0; ai < 2; ++ai)
#pragma unroll
            for (int m = 0; m < 4; ++m) { const float rs = ((const PG8_LAS float*)tab)[ai * 128 + wr * 64 + m * 16 + fr];
#pragma unroll
                for (int bj = 0; bj < 2; ++bj)
#pragma unroll
                    for (int n = 0; n < 2; ++n) acc[ai][bj][m][n] *= rs; }
    }
};

template <int TN> __device__ __forceinline__ void tc_job(unsigned char* lds, const float* src, size_t sb, int ld, int K, int N, int nbatch, bf16_t* dst, const float* gain, int kshift, int rot) {
    LAS float* tile = (LAS float*)lds;
    constexpr int CG = TN / 64, NLD = TN / 32  , NST = TN / 64  ;
    const int tid = opaque_tid(), nk = K / 64, nn = N / TN, ntile = nbatch * nk * nn;
    for (int ti = (int)((bid_() + grid_() - (rot % grid_())) % grid_()); ti < ntile; ti += grid_()) {
        const int b = ti / (nk * nn), rem = ti % (nk * nn), kt = rem / nn, nt = rem % nn;
        const float* s = src + (size_t)b * sb + (size_t)(kt * 64) * ld + nt * TN;
        f32x4 v[NLD];
#pragma unroll
        for (int p = 0; p < NLD; ++p) { const int idx = tid + 512 * p, c16 = idx & 15, kq = (idx >> 4) & 3, rest = idx >> 6, kl = (rest / CG) * 4 + kq, n4 = ((rest % CG) * 16 + c16) * 4;
            v[p] = *(const f32x4*)(s + (size_t)kl * ld + n4);
            if (gain) { const float gg = gain[(size_t)b * K + kt * 64 + kl]; v[p] = v[p] * gg; } }
        __syncthreads();
#pragma unroll
        for (int p = 0; p < NLD; ++p) { const int idx = tid + 512 * p, c16 = idx & 15, kq = (idx >> 4) & 3, rest = idx >> 6, kl = (rest / CG) * 4 + kq, n4 = ((rest % CG) * 16 + c16) * 4;
            tile[kl * (TN + 1) + n4 + 0] = v[p][0]; tile[kl * (TN + 1) + n4 + 1] = v[p][1]; tile[kl * (TN + 1) + n4 + 2] = v[p][2]; tile[kl * (TN + 1) + n4 + 3] = v[p][3]; }
        __syncthreads();
#pragma unroll
        for (int p = 0; p < NST; ++p) { const int idx = tid + 512 * p, nl = idx >> 3, kc = (idx & 7) * 8; float o[8];
#pragma unroll
            for (int e = 0; e < 8; ++e) o[e] = tile[(kc + e) * (TN + 1) + nl];
            const int kd = (kt * 64 + kc + kshift) % K;
            *(bf16x8*)(dst + (size_t)b * N * K + (size_t)(nt * TN + nl) * K + kd) = pack8(o); }
    }
    __syncthreads();
}

__device__ __forceinline__ void prep_phase(const Args& a, unsigned char* lds) {
    unsigned char* ws = ws_();
    tc_job<256>(lds, INP(2), (size_t)DM * NIN, NIN, DM, ZW, DEPTH, (bf16_t*)(ws + WS_WIN), INP(1), 0, 0);
    tc_job<256>(lds, INP(25), (size_t)DM * DM, DM, DM, DM, DEPTH, (bf16_t*)(ws + WS_WOUT), INP(24), 256, 0);
    tc_job<256>(lds, INP(27), (size_t)DM * DFF, DFF, DM, DFF, DEPTH, (bf16_t*)(ws + WS_WMI), INP(26), 0, 0);
    tc_job<256>(lds, INP(28), (size_t)DFF * DM, DM, DFF, DM, DEPTH, (bf16_t*)(ws + WS_WMO), nullptr, 0, 0);
    tc_job<256>(lds, INP(14), (size_t)W * W, W, W, W, DEPTH, (bf16_t*)(ws + WS_GLUT), nullptr, 0, 0);
    tc_job<64>(lds, INP(18), (size_t)64 * 64, 64, 64, 64, DEPTH * 4, (bf16_t*)(ws + WS_WAT), nullptr, 0, 64);
    tc_job<64>(lds, INP(20), (size_t)64 * 64, 64, 64, 64, DEPTH * 4, (bf16_t*)(ws + WS_WXT), nullptr, 0, 96);
    const int gid = bid_() * NTHR + opaque_tid();
    if (gid < DEPTH * 1024) {
        const int l = gid >> 10, gp = gid & 1023, g = gp >> 6, p = gp & 63;
        const float lre = INP(6)[gid], lim = INP(7)[gid], dt = expf(INP(8)[l * 16 + g]);
        const float mag = expf(lre * dt), are = mag * cosf(lim * dt), aim = mag * sinf(lim * dt);
        const float den = lre * lre + lim * lim, nre = are - 1.0f, nim = aim;
        const float fre = (nre * lre + nim * lim) / den, fim = (nim * lre - nre * lim) / den;
        ((f32x2*)(ws + WS_ABAR))[gid] = (f32x2){are, aim};
        float pr = are, pi = aim;
#pragma unroll
        for (int s = 0; s < 7; ++s) { const float nr = pr * pr - pi * pi, ni = 2.0f * pr * pi; pr = nr; pi = ni; }
        ((f32x2*)(ws + WS_A128))[gid] = (f32x2){pr, pi};
        const float* bre = INP(9) + (size_t)gid * 16; const float* bim = INP(10) + (size_t)gid * 16;
        bf16_t* bbt = (bf16_t*)(ws + WS_BBT) + ((size_t)(l * 16 + g) * 128 + 2 * p) * 16;
#pragma unroll
        for (int h = 0; h < 16; ++h) { const float br = bre[h], bi = bim[h]; bbt[h] = f2bf(fre * br - fim * bi); bbt[16 + h] = f2bf(fre * bi + fim * br); }
        bf16_t* cmt = (bf16_t*)(ws + WS_CMT) + (size_t)(l * 16 + g) * 16 * 128;
#pragma unroll
        for (int h = 0; h < 16; ++h) { const size_t ci = ((size_t)(l * 16 + g) * 16 + h) * 64 + p; ((unsigned*)cmt)[(h * 128 + 2 * p) >> 1] = pk2(INP(11)[ci], -INP(12)[ci]); }
        const float* wr = INP(2) + ((size_t)l * DM + gp) * NIN + ZW;
        ((f32x4*)(ws + WS_WF))[gid] = *(const f32x4*)wr * INP(1)[gid];
    }
}

template <bool SRCB, int MODE> __device__ __forceinline__ void norm_phase(const void* xsv, const float* g, bf16_t* xb, float* ss2, float* od, const float* wf, const float* bfg, float* logf) {
    const int lane = opaque_tid() & 63, wid = opaque_tid() >> 6;
    const int gw = bid_() * 8 + wid, nw = grid_() * 8;
    for (int row = gw; row < T; row += nw) {
        f32x4 v[4]; float ss = 0.f;
#pragma unroll
        for (int i = 0; i < 4; ++i) {
            if (SRCB) { const bf16x4 q = *(const bf16x4*)((const bf16_t*)xsv + (size_t)row * DM + i * 256 + lane * 4); v[i] = (f32x4){bfs2f(q[0]), bfs2f(q[1]), bfs2f(q[2]), bfs2f(q[3])}; }
            else { v[i] = *(const f32x4*)((const float*)xsv + (size_t)row * DM + i * 256 + lane * 4);
                if (MODE == 1) { u32x2 w; w.x = pk2(v[i][0], v[i][1]); w.y = pk2(v[i][2], v[i][3]); *(u32x2*)(xb + (size_t)row * DM + i * 256 + lane * 4) = w; } }
            ss += v[i][0] * v[i][0] + v[i][1] * v[i][1] + v[i][2] * v[i][2] + v[i][3] * v[i][3]; }
        ss = wave_sum(ss);
        const float rs = rsqrtf(ss * (1.0f / DM) + EPS);
        if (MODE == 1 && !SRCB) { if (lane < 16) ss2[(size_t)row * 16 + lane] = (lane == 0) ? ss : 0.f; }
        float f0 = 0.f, f1 = 0.f, f2 = 0.f, f3 = 0.f;
#pragma unroll
        for (int i = 0; i < 4; ++i) {
            if (MODE == 2) { const f32x4 gg = *(const f32x4*)(g + i * 256 + lane * 4); *(f32x4*)(od + (size_t)row * DM + i * 256 + lane * 4) = v[i] * rs * gg; }
            if (MODE == 1) {
#pragma unroll
                for (int e = 0; e < 4; ++e) { const f32x4 w4 = *(const f32x4*)(wf + (size_t)(i * 256 + lane * 4 + e) * 4); const float hv = v[i][e] * rs; f0 += hv * w4[0]; f1 += hv * w4[1]; f2 += hv * w4[2]; f3 += hv * w4[3]; } }
        }
        if (MODE == 1) {
            f0 = wave_sum(f0); f1 = wave_sum(f1); f2 = wave_sum(f2); f3 = wave_sum(f3);
            if (lane == 0) { f32x4 o; const float fv[4] = {f0 + bfg[0], f1 + bfg[1], f2 + bfg[2], f3 + bfg[3]};
#pragma unroll
                for (int e = 0; e < 4; ++e) o[e] = fminf(fv[e], 0.f) - log1pf(__expf(-fabsf(fv[e])));
                *(f32x4*)(logf + (size_t)row * 4) = o; }
        }
    }
}

__device__ __forceinline__ void cumsum_item(int b, const float* logf, float* cs, unsigned char* lds) {
    LAS float* wt = (LAS float*)lds;
    const int tid = opaque_tid(), lane = tid & 63, wid = tid >> 6;
    f32x4 v[8]; f32x4 run = (f32x4){0.f, 0.f, 0.f, 0.f};
    const float* src = logf + ((size_t)b * SEQ + (size_t)tid * 8) * 4;
#pragma unroll
    for (int e = 0; e < 8; ++e) { run = run + *(const f32x4*)(src + e * 4); v[e] = run; }
    f32x4 inc = run;
#pragma unroll
    for (int d = 1; d < 64; d <<= 1) {
        const int sl = ((lane >= d) ? lane - d : lane) << 2; f32x4 o;
#pragma unroll
        for (int e = 0; e < 4; ++e) o[e] = __uint_as_float((unsigned)__builtin_amdgcn_ds_bpermute(sl, (int)__float_as_uint(inc[e])));
        if (lane >= d) inc = inc + o;
    }
    __syncthreads();
    if (lane == 63) { wt[wid * 4 + 0] = inc[0]; wt[wid * 4 + 1] = inc[1]; wt[wid * 4 + 2] = inc[2]; wt[wid * 4 + 3] = inc[3]; }
    __syncthreads();
    f32x4 off = inc - run;
    for (int w2 = 0; w2 < wid; ++w2) { off[0] += wt[w2 * 4 + 0]; off[1] += wt[w2 * 4 + 1]; off[2] += wt[w2 * 4 + 2]; off[3] += wt[w2 * 4 + 3]; }
    float* dst = cs + ((size_t)b * SEQ + (size_t)tid * 8) * 4;
#pragma unroll
    for (int e = 0; e < 8; ++e) *(f32x4*)(dst + e * 4) = (v[e] + off) * LOG2E;
    __syncthreads();
}

template <int HALF> __device__ __forceinline__ void sgu_item(int l, int b, int c, const Args& a, unsigned char* lds) {
    const bf16_t* z = (const bf16_t*)(ws_() + WS_Z); bf16_t* y = (bf16_t*)(ws_() + WS_Y);
    LAS bf16_t* vn = (LAS bf16_t*)lds;
    LAS float* ssb = (LAS float*)(lds + 69632);
    const int tid = opaque_tid(), lane = tid & 63, wid = tid >> 6, fr = lane & 15, quad = lane >> 4;
    const size_t t0 = (size_t)b * SEQ + (size_t)c * 128;
    const float* ng = INP(3) + l * W;
    __syncthreads();
    const f32x4 gch = *(const f32x4*)(ng + lane * 4);
    constexpr int TPW = HALF ? 16 : 8;
#pragma unroll
    for (int i = 0; i < TPW; ++i) {
        const int s = wid * TPW + i;
        const bf16x4 zv = *(const bf16x4*)(z + (t0 + s) * ZW + ZC_AV + lane * 4);
        float gv[4]; float ss = 0.f;
#pragma unroll
        for (int e = 0; e < 4; ++e) { gv[e] = gelu_t(bfs2f(zv[e])); ss += gv[e] * gv[e]; }
        ss = wave_sum(ss); const float rs = rsqrtf(ss * (1.0f / W) + EPS);
        u32x2 w; w.x = pk2(gv[0] * rs * gch[0], gv[1] * rs * gch[1]); w.y = pk2(gv[2] * rs * gch[2], gv[3] * rs * gch[3]);
        *(LAS u32x2*)(vn + s * 264 + lane * 4) = w;
    }
    __syncthreads();
    const int h = wid & 3;
    const float* wsrc = INP(4) + ((size_t)(l * 4 + h) * 128) * 128;
    const float* bsrc = INP(5) + (size_t)(l * 4 + h) * 128;
    float outv[2][4][4];
#pragma unroll
    for (int i = 0; i < 2; ++i) {
        const int mt = HALF * 4 + (wid >> 2) + 2 * i, t = mt * 16 + fr;
        f32x4 acc[4];
#pragma unroll
        for (int nt = 0; nt < 4; ++nt) acc[nt] = (f32x4){0.f, 0.f, 0.f, 0.f};
        f32x4 wl[4][2];
#pragma unroll
        for (int kk = 0; kk < 4; ++kk) { const int k0 = (kk * 32 < (mt + 1) * 16) ? kk * 32 : 0; const float* wp = wsrc + (size_t)t * 128 + k0 + quad * 8; wl[kk][0] = *(const f32x4*)wp; wl[kk][1] = *(const f32x4*)(wp + 4); }
#pragma unroll
        for (int kk = 0; kk < 4; ++kk) {
            const int k0 = kk * 32;
            if (k0 < (mt + 1) * 16) {
                float wv[8] = {wl[kk][0][0], wl[kk][0][1], wl[kk][0][2], wl[kk][0][3], wl[kk][1][0], wl[kk][1][1], wl[kk][1][2], wl[kk][1][3]};
#pragma unroll
                for (int e = 0; e < 8; ++e) if (k0 + quad * 8 + e > t) wv[e] = 0.f;
                const bf16x8 wf = pack8(wv);
#pragma unroll
                for (int nt = 0; nt < 4; ++nt) {
                    LAS bf16_t* tp = vn + (k0 + quad * 8 + (fr >> 2)) * 264 + h * 64 + nt * 16 + (fr & 3) * 4;
                    const bf16x4 lo = __builtin_bit_cast(bf16x4, __builtin_amdgcn_ds_read_tr16_b64_v4i16((LAS v4i16_t*)tp));
                    const bf16x4 hi = __builtin_bit_cast(bf16x4, __builtin_amdgcn_ds_read_tr16_b64_v4i16((LAS v4i16_t*)(tp + 4 * 264)));
                    const bf16x8 vf = (bf16x8){lo[0], lo[1], lo[2], lo[3], hi[0], hi[1], hi[2], hi[3]};
                    acc[nt] = mfma16(vf, wf, acc[nt]); }
            }
        }
        const float bs = bsrc[t]; float ss = 0.f;
#pragma unroll
        for (int nt = 0; nt < 4; ++nt) { const int ch = h * 64 + nt * 16 + quad * 4; const bf16x4 u4 = *(const bf16x4*)(z + (t0 + t) * ZW + ZC_AU + ch);
#pragma unroll
            for (int r = 0; r < 4; ++r) { const float o = gelu_t(bfs2f(u4[r])) * (acc[nt][r] + bs); outv[i][nt][r] = o; ss += o * o; } }
        ss = quad_sum(ss);
        if (quad == 0) ssb[t * 4 + h] = ss;
    }
    __syncthreads();
#pragma unroll
    for (int i = 0; i < 2; ++i) {
        const int mt = HALF * 4 + (wid >> 2) + 2 * i, t = mt * 16 + fr;
        const float rs = rsqrtf((ssb[t * 4 + 0] + ssb[t * 4 + 1] + ssb[t * 4 + 2] + ssb[t * 4 + 3]) * (1.0f / W) + EPS);
#pragma unroll
        for (int nt = 0; nt < 4; ++nt) { const int ch = h * 64 + nt * 16 + quad * 4; u32x2 w; w.x = pk2(outv[i][nt][0] * rs, outv[i][nt][1] * rs); w.y = pk2(outv[i][nt][2] * rs, outv[i][nt][3] * rs);
            *(u32x2*)(y + (t0 + t) * DM + YC_A + ch) = w; }
    }
    __syncthreads();
}

template <int PASS> __device__ __forceinline__ void s5_item(int l, int b, int c, const Args& a, unsigned char* lds) {
    const bf16_t* z = (const bf16_t*)(ws_() + WS_Z); bf16_t* y = (bf16_t*)(ws_() + WS_Y);
    LAS unsigned char* BU = (LAS unsigned char*)lds;
    LAS unsigned* BU32 = (LAS unsigned*)lds;
    LAS bf16_t* Yb = (LAS bf16_t*)(lds + 65792);
    LAS float* ssb = (LAS float*)(lds + 65792 + 67584);
    const int tid = opaque_tid(), lane = tid & 63, wid = tid >> 6, fr = lane & 15, quad = lane >> 4;
    const int sx0 = wid * 128 + lane, sx1 = sx0 + 64;
    const size_t t0 = (size_t)b * SEQ + (size_t)c * 128;
    const f32x2* abar = (const f32x2*)(ws_() + WS_ABAR) + l * 1024;
    f32x2* eloc = (f32x2*)(ws_() + WS_ELOC);
    float ar[2], ai[2], sre[2], sim[2];
#pragma unroll
    for (int q = 0; q < 2; ++q) { const f32x2 ab = abar[q ? sx1 : sx0]; ar[q] = ab[0]; ai[q] = ab[1]; sre[q] = 0.f; sim[q] = 0.f; }
    if (PASS == 2) {
        const f32x2* a128 = (const f32x2*)(ws_() + WS_A128) + l * 1024;
        const f32x2 p0 = a128[sx0], p1 = a128[sx1];
        for (int cc0 = 0; cc0 < c; cc0 += 8) {
            f32x2 e0[8], e1[8];
#pragma unroll
            for (int u = 0; u < 8; ++u) { const int cc = (cc0 + u < c) ? cc0 + u : c - 1; e0[u] = eloc[((size_t)(b * NCH + cc)) * 1024 + sx0]; e1[u] = eloc[((size_t)(b * NCH + cc)) * 1024 + sx1]; }
#pragma unroll
            for (int u = 0; u < 8; ++u) if (cc0 + u < c) {
                const float nr0 = p0[0] * sre[0] - p0[1] * sim[0] + e0[u][0], ni0 = p0[0] * sim[0] + p0[1] * sre[0] + e0[u][1]; sre[0] = nr0; sim[0] = ni0;
                const float nr1 = p1[0] * sre[1] - p1[1] * sim[1] + e1[u][0], ni1 = p1[0] * sim[1] + p1[1] * sre[1] + e1[u][1]; sre[1] = nr1; sim[1] = ni1; }
        }
    }
    bf16x8 bfrag[2][8];
    const bf16_t* bbt = (const bf16_t*)(ws_() + WS_BBT);
#pragma unroll
    for (int gi = 0; gi < 2; ++gi)
#pragma unroll
        for (int j = 0; j < 8; ++j) bfrag[gi][j] = (quad < 2) ? *(const bf16x8*)(bbt + ((size_t)(l * 16 + wid * 2 + gi) * 128 + j * 16 + fr) * 16 + quad * 8) : zero8();
    bf16x8 cfrag[2][4];
    if (PASS == 2) {
        const bf16_t* cmt = (const bf16_t*)(ws_() + WS_CMT);
#pragma unroll
        for (int gi = 0; gi < 2; ++gi)
#pragma unroll
            for (int ks = 0; ks < 4; ++ks) cfrag[gi][ks] = *(const bf16x8*)(cmt + ((size_t)(l * 16 + wid * 2 + gi) * 16 + fr) * 128 + ks * 32 + quad * 8);
    }
    const float* dsk = INP(13) + l * W;
    __syncthreads();
    bf16x8 ufn[2];
#pragma unroll
    for (int gi = 0; gi < 2; ++gi) ufn[gi] = (quad < 2) ? *(const bf16x8*)(z + (t0 + fr) * ZW + ZC_B + (wid * 2 + gi) * 16 + quad * 8) : zero8();
    for (int sc = 0; sc < 8; ++sc) {
        const size_t tr = t0 + sc * 16 + fr;
        bf16x8 ufc[2] = {ufn[0], ufn[1]};
        bf16x4 u4c[2] = {(bf16x4){0, 0, 0, 0}, (bf16x4){0, 0, 0, 0}};
        if (PASS == 2) {
#pragma unroll
            for (int gi = 0; gi < 2; ++gi) u4c[gi] = *(const bf16x4*)(z + tr * ZW + ZC_B + (wid * 2 + gi) * 16 + quad * 4);
        }
        if (sc < 7) {
#pragma unroll
            for (int gi = 0; gi < 2; ++gi) ufn[gi] = (quad < 2) ? *(const bf16x8*)(z + (tr + 16) * ZW + ZC_B + (wid * 2 + gi) * 16 + quad * 8) : zero8();
        }
#pragma unroll
        for (int gi = 0; gi < 2; ++gi) {
            const int g = wid * 2 + gi;
            const bf16x8 uf = ufc[gi];
#pragma unroll
            for (int j = 0; j < 8; ++j) {
                const f32x4 acc = mfma16(bfrag[gi][j], uf, (f32x4){0.f, 0.f, 0.f, 0.f});
                u32x2 w; w.x = pk2(acc[0], acc[1]); w.y = pk2(acc[2], acc[3]);
                *(LAS u32x2*)(BU + fr * 4112 + (g * 64 + j * 8 + quad * 2) * 4) = w;
            }
        }
        asm volatile("s_waitcnt lgkmcnt(0)" ::: "memory");
        {
            unsigned wv[16][2];
#pragma unroll
            for (int tt = 0; tt < 16; ++tt) { wv[tt][0] = BU32[tt * 1028 + sx0]; wv[tt][1] = BU32[tt * 1028 + sx1]; }
#pragma unroll
            for (int tt = 0; tt < 16; ++tt) {
#pragma unroll
                for (int q = 0; q < 2; ++q) {
                    const unsigned w = wv[tt][q];
                    const f32x2 bu2 = {__uint_as_float(w << 16), __uint_as_float(w & 0xffff0000u)};
                    const f32x2 s2 = {sre[q], sim[q]}, sw = {sim[q], sre[q]}, arr = {ar[q], ar[q]}, aii = {-ai[q], ai[q]};
                    const f32x2 n2 = aii * sw + (arr * s2 + bu2);
                    sre[q] = n2[0]; sim[q] = n2[1];
                    if (PASS == 2) wv[tt][q] = pk2(n2[0], n2[1]);
                }
            }
            if (PASS == 2) {
#pragma unroll
                for (int tt = 0; tt < 16; ++tt) { BU32[tt * 1028 + sx0] = wv[tt][0]; BU32[tt * 1028 + sx1] = wv[tt][1]; }
            }
        }
        asm volatile("s_waitcnt lgkmcnt(0)" ::: "memory");
        if (PASS == 2) {
#pragma unroll
            for (int gi = 0; gi < 2; ++gi) {
                const int g = wid * 2 + gi; f32x4 acc = (f32x4){0.f, 0.f, 0.f, 0.f};
#pragma unroll
                for (int ks = 0; ks < 4; ++ks) { const bf16x8 sf = *(const LAS bf16x8*)(BU + fr * 4112 + g * 256 + (ks * 32 + quad * 8) * 2); acc = mfma16(cfrag[gi][ks], sf, acc); }
                const int ch = g * 16 + quad * 4; const bf16x4 u4 = u4c[gi]; const f32x4 d4 = *(const f32x4*)(dsk + ch);
                float o[4];
#pragma unroll
                for (int r = 0; r < 4; ++r) o[r] = gelu_t(acc[r] + d4[r] * bfs2f(u4[r]));
                u32x2 w; w.x = pk2(o[0], o[1]); w.y = pk2(o[2], o[3]);
                *(LAS u32x2*)(Yb + (sc * 16 + fr) * 264 + ch) = w;
            }
        }
    }
    if (PASS == 1) {
#pragma unroll
        for (int q = 0; q < 2; ++q) eloc[((size_t)(b * NCH + c)) * 1024 + (q ? sx1 : sx0)] = (f32x2){sre[q], sim[q]};
        {
            LAS float* kq = (LAS float*)(lds + 65792);
            const int tok = tid >> 2, hd = tid & 3; float s2 = 0.f;
#pragma unroll
            for (int j = 0; j < 8; ++j) { const bf16x8 kv = *(const bf16x8*)(z + (t0 + tok) * ZW + ZC_K + hd * 64 + j * 8);
#pragma unroll
                for (int e = 0; e < 8; ++e) { const float f = bfs2f(kv[e]); s2 += f * f; } }
            kq[tok * 4 + hd] = s2;
            __syncthreads();
            if (tid < 4) { float mxv = 0.f; for (int i = 0; i < 128; ++i) mxv = fmaxf(mxv, kq[i * 4 + tid]); ((float*)(ws_() + WS_KMAX))[(b * NCH + c) * 4 + tid] = mxv; }
        }
    } else {
        const bf16_t* glut = (const bf16_t*)(ws_() + WS_GLUT) + (size_t)l * W * W;
        const float* glub = INP(15) + l * W;
        bf16x8 gfrag[2][8];
#pragma unroll
        for (int ni = 0; ni < 2; ++ni)
#pragma unroll
            for (int ks = 0; ks < 8; ++ks) gfrag[ni][ks] = *(const bf16x8*)(glut + (size_t)((wid * 2 + ni) * 16 + fr) * W + ks * 32 + quad * 8);
        __syncthreads();
        float outv[8][2][4];
#pragma unroll
        for (int mt = 0; mt < 8; ++mt) {
            f32x4 acc0 = (f32x4){0.f, 0.f, 0.f, 0.f}, acc1 = acc0;
#pragma unroll
            for (int ks = 0; ks < 8; ++ks) { const bf16x8 yf = *(const LAS bf16x8*)(Yb + (mt * 16 + fr) * 264 + ks * 32 + quad * 8); acc0 = mfma16(gfrag[0][ks], yf, acc0); acc1 = mfma16(gfrag[1][ks], yf, acc1); }
            float ss = 0.f;
#pragma unroll
            for (int ni = 0; ni < 2; ++ni) { const int n = (wid * 2 + ni) * 16 + quad * 4; const bf16x4 y4 = *(const LAS bf16x4*)(Yb + (mt * 16 + fr) * 264 + n); const f32x4 gb = *(const f32x4*)(glub + n);
#pragma unroll
                for (int r = 0; r < 4; ++r) { const float gt = (ni == 0 ? acc0[r] : acc1[r]) + gb[r]; const float o = bfs2f(y4[r]) * sigm(gt); outv[mt][ni][r] = o; ss += o * o; } }
            ss = quad_sum(ss);
            if (quad == 0) ssb[(mt * 16 + fr) * 8 + wid] = ss;
        }
        __syncthreads();
#pragma unroll
        for (int mt = 0; mt < 8; ++mt) {
            const int t = mt * 16 + fr; float s = 0.f;
#pragma unroll
            for (int w2 = 0; w2 < 8; ++w2) s += ssb[t * 8 + w2];
            const float rs = rsqrtf(s * (1.0f / W) + EPS);
#pragma unroll
            for (int ni = 0; ni < 2; ++ni) { const int n = (wid * 2 + ni) * 16 + quad * 4; u32x2 w; w.x = pk2(outv[mt][ni][0] * rs, outv[mt][ni][1] * rs); w.y = pk2(outv[mt][ni][2] * rs, outv[mt][ni][3] * rs);
                *(u32x2*)(y + (t0 + t) * DM + YC_B + n) = w; }
        }
    }
    __syncthreads();
}

template <int PASS> __device__ __forceinline__ void lru_item(int l, int b, int c, const Args& a, unsigned char* lds) {
    const bf16_t* z = (const bf16_t*)(ws_() + WS_Z); bf16_t* y = (bf16_t*)(ws_() + WS_Y);
    LAS bf16_t* XC = (LAS bf16_t*)lds;
    LAS float* ssb = (LAS float*)(lds + 67584);
    const int tid = opaque_tid(), lane = tid & 63, wid = tid >> 6, fr = lane & 15, quad = lane >> 4;
    const size_t t0 = (size_t)b * SEQ + (size_t)c * 128;
    float* LAp = (float*)(ws_() + WS_LA); float* LBp = (float*)(ws_() + WS_LB);
    __syncthreads();
    const int hh = wid >> 1;
    const bf16_t* wat = (const bf16_t*)(ws_() + WS_WAT) + (size_t)(l * 4 + hh) * 64 * 64;
    const bf16_t* wxt = (const bf16_t*)(ws_() + WS_WXT) + (size_t)(l * 4 + hh) * 64 * 64;
    bf16x8 waf[2][2], wxf[2][2]; float sp8[2][4], bav[2][4], bxv[2][4], H[2][4], Acar[2][4], Bcar[2][4];
#pragma unroll
    for (int ni = 0; ni < 2; ++ni) {
        const int nl = (wid * 2 + ni) * 16 - hh * 64 + fr;
#pragma unroll
        for (int ks = 0; ks < 2; ++ks) { waf[ni][ks] = *(const bf16x8*)(wat + nl * 64 + ks * 32 + quad * 8); wxf[ni][ks] = *(const bf16x8*)(wxt + nl * 64 + ks * 32 + quad * 8); }
#pragma unroll
        for (int r = 0; r < 4; ++r) { const int ch = (wid * 2 + ni) * 16 + quad * 4 + r;
            sp8[ni][r] = 8.0f * softplus_f(-INP(22)[l * W + ch]); bav[ni][r] = INP(19)[l * W + ch]; bxv[ni][r] = INP(21)[l * W + ch];
            H[ni][r] = 0.f; Acar[ni][r] = 1.f; Bcar[ni][r] = 0.f;
        }
    }
    if (PASS == 2 && c > 0) {
#pragma unroll
        for (int ni = 0; ni < 2; ++ni) {
            const size_t ob = (size_t)(b * NCH) * W + (wid * 2 + ni) * 16 + quad * 4;
            const bool v0 = fr < c, v1 = 16 + fr < c;
            f32x4 a0 = (f32x4){1.f, 1.f, 1.f, 1.f}, b0 = (f32x4){0.f, 0.f, 0.f, 0.f}, a1 = a0, b1 = b0;
            if (v0) { a0 = *(const f32x4*)(LAp + ob + (size_t)fr * W); b0 = *(const f32x4*)(LBp + ob + (size_t)fr * W); }
            if (v1) { a1 = *(const f32x4*)(LAp + ob + (size_t)(16 + fr) * W); b1 = *(const f32x4*)(LBp + ob + (size_t)(16 + fr) * W); }
#pragma unroll
            for (int r = 0; r < 4; ++r) {
                float av = a0[r], bb = b0[r], aw = a1[r], bw = b1[r], ap, bp;
                ap = dpp_shr<1>(av, 1.0f); bp = dpp_shr<1>(bb, 0.0f); bb = av * bp + bb; av = av * ap;   ap = dpp_shr<1>(aw, 1.0f); bp = dpp_shr<1>(bw, 0.0f); bw = aw * bp + bw; aw = aw * ap;
                ap = dpp_shr<2>(av, 1.0f); bp = dpp_shr<2>(bb, 0.0f); bb = av * bp + bb; av = av * ap;   ap = dpp_shr<2>(aw, 1.0f); bp = dpp_shr<2>(bw, 0.0f); bw = aw * bp + bw; aw = aw * ap;
                ap = dpp_shr<4>(av, 1.0f); bp = dpp_shr<4>(bb, 0.0f); bb = av * bp + bb; av = av * ap;   ap = dpp_shr<4>(aw, 1.0f); bp = dpp_shr<4>(bw, 0.0f); bw = aw * bp + bw; aw = aw * ap;
                ap = dpp_shr<8>(av, 1.0f); bp = dpp_shr<8>(bb, 0.0f); bb = av * bp + bb; av = av * ap;   ap = dpp_shr<8>(aw, 1.0f); bp = dpp_shr<8>(bw, 0.0f); bw = aw * bp + bw; aw = aw * ap;
                const float B0t = __shfl(bb, 15, 16), A1t = __shfl(aw, 15, 16), B1t = __shfl(bw, 15, 16);
                H[ni][r] = A1t * B0t + B1t;
            }
        }
    }
    {
        const float* cw = INP(16) + (size_t)l * 4 * W; const float* cb = INP(17) + l * W;
        const int ch0 = (tid & 31) * 8, tk0 = (tid >> 5) * 8;
        bf16x8 xr[11];
#pragma unroll
        for (int j = 0; j < 11; ++j) { const int tt = tk0 - 3 + j;
            xr[j] = (c * 128 + tt >= 0) ? *(const bf16x8*)(z + (size_t)((long)t0 + tt) * ZW + ZC_CX + ch0) : zero8(); }
        float wk[4][8], bk[8];
        { const f32x4 c0 = *(const f32x4*)(cb + ch0), c1 = *(const f32x4*)(cb + ch0 + 4);
#pragma unroll
          for (int e = 0; e < 4; ++e) { bk[e] = c0[e]; bk[4 + e] = c1[e]; }
#pragma unroll
          for (int k = 0; k < 4; ++k) { const f32x4 w0 = *(const f32x4*)(cw + k * W + ch0), w1 = *(const f32x4*)(cw + k * W + ch0 + 4);
#pragma unroll
              for (int e = 0; e < 4; ++e) { wk[k][e] = w0[e]; wk[k][4 + e] = w1[e]; } } }
#pragma unroll
        for (int i = 0; i < 8; ++i) { float acc[8];
#pragma unroll
            for (int e = 0; e < 8; ++e) acc[e] = bk[e] + wk[0][e] * bfs2f(xr[i][e]) + wk[1][e] * bfs2f(xr[i + 1][e]) + wk[2][e] * bfs2f(xr[i + 2][e]) + wk[3][e] * bfs2f(xr[i + 3][e]);
            *(LAS bf16x8*)(XC + (tk0 + i) * 264 + ch0) = pack8(acc); }
    }
    __syncthreads();
    LAS bf16_t* Ob = (LAS bf16_t*)(lds + 67584 + 4096);
#pragma unroll 2
    for (int mt = 0; mt < 8; ++mt) {
        bf16x8 xf[2];
#pragma unroll
        for (int ks = 0; ks < 2; ++ks) xf[ks] = *(const LAS bf16x8*)(XC + (mt * 16 + fr) * 264 + hh * 64 + ks * 32 + quad * 8);
        float ss = 0.f;
#pragma unroll
        for (int ni = 0; ni < 2; ++ni) {
            f32x4 accA = (f32x4){0.f, 0.f, 0.f, 0.f}, accX = accA;
#pragma unroll
            for (int ks = 0; ks < 2; ++ks) { accA = mfma16(waf[ni][ks], xf[ks], accA); accX = mfma16(wxf[ni][ks], xf[ks], accX); }
            const int ch0 = (wid * 2 + ni) * 16 + quad * 4;
            const bf16x4 xc4 = *(const LAS bf16x4*)(XC + (mt * 16 + fr) * 264 + ch0);
            bf16x4 g4 = (bf16x4){0, 0, 0, 0};
            if (PASS == 2) g4 = *(const bf16x4*)(z + (t0 + mt * 16 + fr) * ZW + ZC_CG + ch0);
            float ov[4] = {0.f, 0.f, 0.f, 0.f};
#pragma unroll
            for (int r = 0; r < 4; ++r) {
                const float rg = sigm(accA[r] + bav[ni][r]), ig = sigm(accX[r] + bxv[ni][r]);
                const float la = -rg * sp8[ni][r];
                float av = __builtin_amdgcn_exp2f(LOG2E * la), bb = __builtin_amdgcn_sqrtf(fmaxf(neg_expm1(2.0f * la), 0.f)) * (ig * bfs2f(xc4[r]));
                { float ap, bp;
                  ap = dpp_shr<1>(av, 1.0f); bp = dpp_shr<1>(bb, 0.0f); bb = av * bp + bb; av = av * ap;
                  ap = dpp_shr<2>(av, 1.0f); bp = dpp_shr<2>(bb, 0.0f); bb = av * bp + bb; av = av * ap;
                  ap = dpp_shr<4>(av, 1.0f); bp = dpp_shr<4>(bb, 0.0f); bb = av * bp + bb; av = av * ap;
                  ap = dpp_shr<8>(av, 1.0f); bp = dpp_shr<8>(bb, 0.0f); bb = av * bp + bb; av = av * ap; }
                if (PASS == 1) { const float At = __shfl(av, 15, 16), Bt = __shfl(bb, 15, 16); Bcar[ni][r] = At * Bcar[ni][r] + Bt; Acar[ni][r] *= At; }
                else { const float hv = av * H[ni][r] + bb; H[ni][r] = __shfl(hv, 15, 16); const float o = hv * gelu_t(bfs2f(g4[r])); ov[r] = o; ss += o * o; }
            }
            if (PASS == 2) { u32x2 w; w.x = pk2(ov[0], ov[1]); w.y = pk2(ov[2], ov[3]); *(LAS u32x2*)(Ob + (mt * 16 + fr) * 264 + ch0) = w; }
        }
        if (PASS == 2) { ss = quad_sum(ss); if (quad == 0) ssb[(mt * 16 + fr) * 8 + wid] = ss; }
    }
    if (PASS == 1) {
        if (fr == 0) {
#pragma unroll
            for (int ni = 0; ni < 2; ++ni)
#pragma unroll
                for (int r = 0; r < 4; ++r) { const size_t o = ((size_t)(b * NCH + c)) * W + (wid * 2 + ni) * 16 + quad * 4 + r; LAp[o] = Acar[ni][r]; LBp[o] = Bcar[ni][r]; }
        }
    } else {
        __syncthreads();
#pragma unroll 2
        for (int mt = 0; mt < 8; ++mt) {
            const int t = mt * 16 + fr; float s = 0.f;
#pragma unroll
            for (int w2 = 0; w2 < 8; ++w2) s += ssb[t * 8 + w2];
            const float rs = rsqrtf(s * (1.0f / W) + EPS);
#pragma unroll
            for (int ni = 0; ni < 2; ++ni) { const int n = (wid * 2 + ni) * 16 + quad * 4; const bf16x4 o4 = *(const LAS bf16x4*)(Ob + t * 264 + n);
                u32x2 w; w.x = pk2(bfs2f(o4[0]) * rs, bfs2f(o4[1]) * rs); w.y = pk2(bfs2f(o4[2]) * rs, bfs2f(o4[3]) * rs);
                *(u32x2*)(y + (t0 + t) * DM + YC_C + n) = w; }
        }
    }
    __syncthreads();
}

template <bool DIAG> __device__ __forceinline__ void attn_step2(const LAS unsigned char* buf, int kbase, int qrow0, int quad, int fr, const bf16x8 (&qf)[2][2], float (&m)[2], float (&lsum)[2], f32x4 (&oacc)[2][4]) {
    const LAS bf16_t* Kt = (const LAS bf16_t*)buf; const LAS bf16_t* Vt = (const LAS bf16_t*)(buf + 9216); const LAS float* csl = (const LAS float*)(buf + 18432);
    LAS bf16_t* vtr0 = (LAS bf16_t*)Vt + (quad * 4 + (fr >> 2)) * 72 + (fr & 3) * 4;
    float p[2][4][4];
#pragma unroll
    for (int st = 0; st < 4; ++st) {
        const f32x4 c4 = *(const LAS f32x4*)(csl + st * 16 + quad * 4);
        const bf16x8 kf0 = *(const LAS bf16x8*)(Kt + (st * 16 + fr) * 72 + quad * 8), kf1 = *(const LAS bf16x8*)(Kt + (st * 16 + fr) * 72 + 32 + quad * 8);
#pragma unroll
        for (int qs = 0; qs < 2; ++qs) {
            f32x4 acc = mfma16(kf0, qf[qs][0], c4); acc = mfma16(kf1, qf[qs][1], acc);
#pragma unroll
            for (int r = 0; r < 4; ++r) { float v = acc[r]; if (DIAG && (kbase + st * 16 + quad * 4 + r > qrow0 + qs * 16)) v = -1e30f; p[qs][st][r] = v; }
        }
    }
    bf16x8 pf[2][2];
#pragma unroll
    for (int qs = 0; qs < 2; ++qs) {
        float mx = -1e30f;
#pragma unroll
        for (int st = 0; st < 4; ++st)
#pragma unroll
            for (int r = 0; r < 4; ++r) mx = fmaxf(mx, p[qs][st][r]);
        mx = quad_max(mx);
        if (__any(mx > m[qs])) {
            const float mnew = fmaxf(m[qs], mx), al = __builtin_amdgcn_exp2f(m[qs] - mnew); m[qs] = mnew; lsum[qs] *= al;
#pragma unroll
            for (int dt = 0; dt < 4; ++dt) oacc[qs][dt] = oacc[qs][dt] * al;
        }
        const float mcur = m[qs];
        float ps = 0.f;
#pragma unroll
        for (int st = 0; st < 4; ++st)
#pragma unroll
            for (int r = 0; r < 4; ++r) { const float e = __builtin_amdgcn_exp2f(p[qs][st][r] - mcur); p[qs][st][r] = e; ps += e; }
        lsum[qs] += ps;
#pragma unroll
        for (int ks = 0; ks < 2; ++ks) { u32x4 w; w.x = pk2(p[qs][2 * ks][0], p[qs][2 * ks][1]); w.y = pk2(p[qs][2 * ks][2], p[qs][2 * ks][3]); w.z = pk2(p[qs][2 * ks + 1][0], p[qs][2 * ks + 1][1]); w.w = pk2(p[qs][2 * ks + 1][2], p[qs][2 * ks + 1][3]); pf[qs][ks] = __builtin_bit_cast(bf16x8, w); }
    }
#pragma unroll
    for (int dt = 0; dt < 4; ++dt) {
#pragma unroll
        for (int ks = 0; ks < 2; ++ks) {
            const bf16x4 v0 = __builtin_bit_cast(bf16x4, __builtin_amdgcn_ds_read_tr16_b64_v4i16((LAS v4i16_t*)(vtr0 + (ks * 32) * 72 + dt * 16)));
            const bf16x4 v1 = __builtin_bit_cast(bf16x4, __builtin_amdgcn_ds_read_tr16_b64_v4i16((LAS v4i16_t*)(vtr0 + (ks * 32 + 16) * 72 + dt * 16)));
            const bf16x8 vf = (bf16x8){v0[0], v0[1], v0[2], v0[3], v1[0], v1[1], v1[2], v1[3]};
            oacc[0][dt] = mfma16(vf, pf[0][ks], oacc[0][dt]); oacc[1][dt] = mfma16(vf, pf[1][ks], oacc[1][dt]);
        }
    }
}
__device__ __forceinline__ void attn_unit(int b, int h, int qb, const Args& a, unsigned char* lds) {
    const bf16_t* z = (const bf16_t*)(ws_() + WS_Z); bf16_t* y = (bf16_t*)(ws_() + WS_Y);
    const float* cs = (const float*)(ws_() + WS_CS); float* ssd = (float*)(ws_() + WS_SSD);
    constexpr int ABUF = 9216 + 9216 + 256;
    LAS unsigned char* lb = (LAS unsigned char*)lds;
    const int tid = opaque_tid(), lane = tid & 63, wid = tid >> 6, fr = lane & 15, quad = lane >> 4, grp = wid >> 2, wq = wid & 3;
    const int q0 = qb * 128, qw = q0 + wq * 32, qrow0 = qw + fr;
    const size_t rb = (size_t)b * SEQ;
    bf16x8 qf[2][2];
    {
        const float SC = 0.125f * LOG2E;
#pragma unroll
        for (int qs = 0; qs < 2; ++qs)
#pragma unroll
            for (int ds = 0; ds < 2; ++ds) { const bf16x8 qv = *(const bf16x8*)(z + (rb + qrow0 + qs * 16) * ZW + ZC_Q + h * 64 + ds * 32 + quad * 8); float t8[8];
#pragma unroll
                for (int e = 0; e < 8; ++e) t8[e] = bfs2f(qv[e]) * SC;
                qf[qs][ds] = pack8(t8); }
    }
    float m[2] = {-1e30f, -1e30f}, lsum[2] = {0.f, 0.f}; f32x4 oacc[2][4];
#pragma unroll
    for (int qs = 0; qs < 2; ++qs)
#pragma unroll
        for (int dt = 0; dt < 4; ++dt) oacc[qs][dt] = (f32x4){0.f, 0.f, 0.f, 0.f};
    float qbnd[2];
    {
        float kv = (lane <= qb) ? ((const float*)(ws_() + WS_KMAX))[(b * NCH + lane) * 4 + h] : 0.f;
        kv = wave_max(kv);
        const float kmax = __builtin_amdgcn_sqrtf(kv) * 1.01f + 1e-3f;
#pragma unroll
        for (int qs = 0; qs < 2; ++qs) { float q2 = 0.f;
#pragma unroll
            for (int ds = 0; ds < 2; ++ds)
#pragma unroll
                for (int e = 0; e < 8; ++e) { const float f = bfs2f(qf[qs][ds][e]); q2 += f * f; }
            q2 = quad_sum(q2); qbnd[qs] = (__builtin_amdgcn_sqrtf(q2) * 1.01f + 1e-3f) * kmax; }
    }
    const int NSS = qb + 1;
    volatile LAS unsigned* vote = (volatile LAS unsigned*)(lds + LDS_BYTES - 64);
    if (tid < 3) vote[tid] = 0u;
    bf16x8 kreg[2], vreg[2]; float creg = 0.f;
#define ATT_LOAD(S) do { const size_t kb_ = rb + (size_t)(S) * 128; \
        _Pragma("unroll") for (int p_ = 0; p_ < 2; ++p_) { const int id_ = tid + 512 * p_; \
            kreg[p_] = *(const bf16x8*)(z + (kb_ + (id_ >> 3)) * ZW + ZC_K + h * 64 + (id_ & 7) * 8); \
            vreg[p_] = *(const bf16x8*)(z + (kb_ + (id_ >> 3)) * ZW + ZC_V + h * 64 + (id_ & 7) * 8); } \
        if (tid < 128) creg = cs[(kb_ + tid) * 4 + h]; } while (0)
#define ATT_STORE(S) do { LAS unsigned char* bb_ = lb + ((S) & 1) * (2 * ABUF); \
        _Pragma("unroll") for (int p_ = 0; p_ < 2; ++p_) { const int id_ = tid + 512 * p_; const int k128_ = id_ >> 3; \
            *(LAS bf16x8*)((LAS bf16_t*)(bb_ + (k128_ >> 6) * ABUF) + (k128_ & 63) * 72 + (id_ & 7) * 8) = kreg[p_]; \
            *(LAS bf16x8*)((LAS bf16_t*)(bb_ + (k128_ >> 6) * ABUF + 9216) + (k128_ & 63) * 72 + (id_ & 7) * 8) = vreg[p_]; } \
        if (tid < 128) ((LAS float*)(bb_ + (tid >> 6) * ABUF + 18432))[tid & 63] = -creg; } while (0)
    ATT_LOAD(NSS - 1); ATT_STORE(NSS - 1);
    if (NSS > 1) ATT_LOAD(NSS - 2);
    __syncthreads();
    int kstep = 0;
    for (int S = NSS - 1; S >= 0; --S) {
        if (S >= 1) ATT_STORE(S - 1);
        if (S >= 2) ATT_LOAD(S - 2);
        float cl = 0.f; if (S >= 1) cl = cs[(rb + (size_t)(S - 1) * 128 + 127) * 4 + h];
        const int kbase = S * 128 + grp * 64;
        const LAS unsigned char* hb = lb + (S & 1) * (2 * ABUF) + grp * ABUF;
        if (S + 1 < NSS) attn_step2<false>(hb, kbase, qrow0, quad, fr, qf, m, lsum, oacc);
        else if (kbase <= qw + 31) attn_step2<true>(hb, kbase, qrow0, quad, fr, qf, m, lsum, oacc);
        const bool need = (S >= 1) && ((qbnd[0] - cl - m[0] >= -152.f) || (qbnd[1] - cl - m[1] >= -152.f));
        const int vw = kstep % 3;
        if (need) vote[vw] = 1u;
        __syncthreads();
        const unsigned go = vote[vw];
        if (tid == 0) vote[(kstep + 2) % 3] = 0u;
        ++kstep;
        if (!go) break;
    }
#undef ATT_LOAD
#undef ATT_STORE
    LAS float* mg = (LAS float*)lb;
    const int ml = wq * 64 + lane;
    if (grp == 1) {
#pragma unroll
        for (int qs = 0; qs < 2; ++qs) { mg[(qs * 18 + 0) * 256 + ml] = m[qs]; mg[(qs * 18 + 1) * 256 + ml] = lsum[qs];
#pragma unroll
            for (int dt = 0; dt < 4; ++dt)
#pragma unroll
                for (int r = 0; r < 4; ++r) mg[(qs * 18 + 2 + dt * 4 + r) * 256 + ml] = oacc[qs][dt][r]; }
    }
    __syncthreads();
    if (grp == 0) {
#pragma unroll
        for (int qs = 0; qs < 2; ++qs) {
            const float m1 = mg[(qs * 18 + 0) * 256 + ml], l1 = mg[(qs * 18 + 1) * 256 + ml];
            const float mt = fmaxf(m[qs], m1), f0 = __builtin_amdgcn_exp2f(m[qs] - mt), f1 = __builtin_amdgcn_exp2f(m1 - mt);
            float lt = quad_sum(lsum[qs] * f0 + l1 * f1);
            const float inv = 1.0f / lt; float ss = 0.f;
            const size_t tq = rb + qrow0 + qs * 16;
#pragma unroll
            for (int dt = 0; dt < 4; ++dt) { f32x4 o;
#pragma unroll
                for (int r = 0; r < 4; ++r) { o[r] = (oacc[qs][dt][r] * f0 + mg[(qs * 18 + 2 + dt * 4 + r) * 256 + ml] * f1) * inv; ss += o[r] * o[r]; }
                u32x2 w; w.x = pk2(o[0], o[1]); w.y = pk2(o[2], o[3]); *(u32x2*)(y + tq * DM + YC_D + h * 64 + dt * 16 + quad * 4) = w; }
            ss = quad_sum(ss);
            if (quad == 0) ssd[tq * 4 + h] = ss;
        }
    }
    __syncthreads();
}

#define XB_TMO      128
#define XB_XCNT(j)  (256  + 64 * (j))
#define XB_XSUB(j)  (1280 + 64 * (j))
#define XB_XGEN(j)  (2304 + 64 * (j))
#define XB_TOP      3328
#define XB_TOPGEN   3392
#define XCD_BAR_WORDS 3456
#define XB_SPIN_CAP (1u << 18)

__device__ __forceinline__ unsigned xb_ld(unsigned* p)              { return __hip_atomic_load(p, __ATOMIC_RELAXED, __HIP_MEMORY_SCOPE_AGENT); }
__device__ __forceinline__ unsigned xb_add(unsigned* p, unsigned v) { return __hip_atomic_fetch_add(p, v, __ATOMIC_RELAXED, __HIP_MEMORY_SCOPE_AGENT); }
__device__ __forceinline__ unsigned xb_xcc_id() { return (unsigned)__builtin_amdgcn_s_getreg((3 << 11) | 20) & 0xFu; }
#define XB_SPIN(cond, bar) do { unsigned _sp = 0; while (cond) { __builtin_amdgcn_s_sleep(1); \
    if ((++_sp & 255u) == 0u) { if (xb_ld(&(bar)[XB_TMO])) break; if (_sp > XB_SPIN_CAP) { atomicAdd(&(bar)[XB_TMO], 1u); break; } } } } while (0)

struct XcdBarrier {
    unsigned* bar; unsigned x;
    volatile LAS unsigned* st;
};

__device__ __forceinline__ XcdBarrier xcd_barrier_post(unsigned* bar, volatile LAS unsigned* st) {
    XcdBarrier b; b.bar = bar; b.x = xb_xcc_id(); b.st = st;
    if (opaque_tid() == 0) (void)xb_add(&bar[XB_XCNT(b.x)], 1u);
    return b;
}
__device__ __forceinline__ void xcd_barrier_complete(unsigned* bar, unsigned x, unsigned& nloc, unsigned& nx) {
    const unsigned G = gridDim.x * gridDim.y * gridDim.z;
    unsigned sum, cnt, mine, sp = 0u;
    for (;;) {
        sum = 0u; cnt = 0u; mine = 0u;
#pragma unroll
        for (unsigned j = 0; j < 16; ++j) { const unsigned c = xb_ld(&bar[XB_XCNT(j)]); sum += c; cnt += (c > 0u) ? 1u : 0u; mine = (j == x) ? c : mine; }
        if (sum == G) break;
        __builtin_amdgcn_s_sleep(1);
        if ((++sp & 255u) == 0u) { if (xb_ld(&bar[XB_TMO])) break; if (sp > XB_SPIN_CAP) { atomicAdd(&bar[XB_TMO], 1u); break; } }
    }
    nloc = mine > 0u ? mine : 1u; nx = cnt > 0u ? cnt : 1u;
}

__device__ __forceinline__ void xcd_barrier(const XcdBarrier& b) {
    asm volatile("s_waitcnt vmcnt(0)" ::: "memory");
    __syncthreads();
    if (opaque_tid() == 0) {
        unsigned* bar = b.bar;
        __builtin_amdgcn_s_waitcnt(0);
        unsigned nloc = b.st[0], nx = b.st[1];
        if (nloc == 0u) { xcd_barrier_complete(bar, b.x, nloc, nx); b.st[0] = nloc; b.st[1] = nx; }
        const unsigned old = xb_add(&bar[XB_XSUB(b.x)], 1u);
        const unsigned gen = old / nloc;
        if (old + 1u == (gen + 1u) * nloc) {
            __builtin_amdgcn_fence(__ATOMIC_RELEASE, "agent");
            asm volatile("s_waitcnt vmcnt(0)" ::: "memory");
            const unsigned og = xb_add(&bar[XB_TOP], 1u);
            const unsigned tg = og / nx;
            if (og + 1u == (tg + 1u) * nx) xb_add(&bar[XB_TOPGEN], 1u);
            else XB_SPIN(xb_ld(&bar[XB_TOPGEN]) == tg, bar);
            __builtin_amdgcn_fence(__ATOMIC_ACQUIRE, "agent");
            xb_add(&bar[XB_XGEN(b.x)], 1u);
            asm volatile("s_waitcnt vmcnt(0)" ::: "memory");
        } else {
            XB_SPIN(xb_ld(&bar[XB_XGEN(b.x)]) == gen, bar);
            __builtin_amdgcn_fence(__ATOMIC_ACQUIRE, "agent");
            asm volatile("s_waitcnt vmcnt(0)" ::: "memory");
        }
    }
    __syncthreads();
}

#ifndef WGM_G1
#define WGM_G1 2
#endif
#ifndef WGM_G2
#define WGM_G2 4
#endif
#ifndef WGM_G3
#define WGM_G3 6
#endif
#ifndef WGM_G4
#define WGM_G4 8
#endif
#ifndef PROBE_DUP
#define PROBE_DUP 0
#endif
#ifndef ITEM_MASK
#define ITEM_MASK 127
#endif
__global__ void __launch_bounds__(NTHR, 2) fwd_kernel(Args a) {
    extern __shared__ __attribute__((aligned(16))) unsigned char lds[];
    {
        volatile LAS unsigned* bst0 = (volatile LAS unsigned*)(lds + LDS_BYTES - 16);
        if (opaque_tid() == 0) { bst0[0] = 0u; bst0[1] = 0u; }
        __syncthreads();
        (void)xcd_barrier_post((unsigned*)(ws_() + WS_BAR), bst0);
    }
    if (PH_HI > 4096) cg::this_grid().sync();
#define SEAM(k) do { if ((k) + 1 < PH_HI) { XcdBarrier xb_; xb_.bar = (unsigned*)(ws_() + WS_BAR); xb_.x = xb_xcc_id(); xb_.st = (volatile LAS unsigned*)(lds + LDS_BYTES - 16); xcd_barrier(xb_); if (PROBE_DUP == 1) xcd_barrier(xb_); } } while (0)
#define IN(k) (PH_LO <= (k) && (k) < PH_HI)
    if (IN(0)) { prep_phase(a, lds); if (PROBE_DUP == 4) prep_phase(a, lds); SEAM(0); }
    for (int l = 0; l < DEPTH; ++l) {
        const int pb = 1 + 8 * l;
        if (l == 0 && IN(pb + 0)) {
            norm_phase<false, 1>(INP(0), nullptr, (bf16_t*)(ws_() + WS_H), (float*)(ws_() + WS_SS2), nullptr, (const float*)(ws_() + WS_WF), INP(23), (float*)(ws_() + WS_LOGF));
            SEAM(pb + 0);
        }
        if (IN(pb + 1)) {
            pg8::Gemm g{(const pg8::bf16_t*)(ws_() + WS_H), (const pg8::bf16_t*)(ws_() + WS_WIN) + (size_t)l * ZW * DM, T, ZW, DM}; pg8::StaticOrder S; S.init(T, ZW, grid_(), bid_(), WGM_G1);
            EpiStoreBf16<0, true> E{(bf16_t*)(ws_() + WS_Z), ZW, (const float*)(ws_() + WS_SS2)};
            pg8::gemm_phase<EpiStoreBf16<0, true>, pg8::StaticOrder, true, true>((PG8_LAS unsigned char*)lds, g, S, E);
            if (PROBE_DUP == 9) pg8::gemm_phase<EpiStoreBf16<0, true>, pg8::StaticOrder, true, true>((PG8_LAS unsigned char*)lds, g, S, E);
            if (l > 0) norm_phase<true, 1>(ws_() + WS_H, nullptr, nullptr, nullptr, nullptr, (const float*)(ws_() + WS_WF) + (size_t)l * DM * 4, INP(23) + l * 4, (float*)(ws_() + WS_LOGF));
            SEAM(pb + 1);
        }
        if (IN(pb + 2)) {
            for (int rep = 0; rep < (PROBE_DUP == 2 ? 2 : 1); ++rep)
            {
            for (int it = bid_(); it < 256; it += grid_()) {
                if (it < 128) { if (ITEM_MASK & 1) s5_item<1>(l, it >> 5, it & 31, a, lds); }
                else { if (ITEM_MASK & 4) lru_item<1>(l, (it - 128) >> 5, (it - 128) & 31, a, lds); }
            }
            const int cb_ = (grid_() >= 132) ? bid_() - 128 : bid_();
            if (cb_ >= 0 && cb_ < 4) { if (ITEM_MASK & 8) cumsum_item(cb_, (const float*)(ws_() + WS_LOGF), (float*)(ws_() + WS_CS), lds); }
            }
            SEAM(pb + 2);
        }
        if (IN(pb + 3)) {
            for (int rep = 0; rep < (PROBE_DUP == 3 ? 2 : 1); ++rep) {
            for (int rep2 = 0; rep2 < (PROBE_DUP == 5 ? 2 : 1); ++rep2)
            for (int up = bid_(); up < 256; up += grid_()) {
                const int xcd_ = up & 7, ix_ = up >> 3, pr = xcd_ + 8 * (ix_ >> 4), j = ix_ & 15;
                if (ITEM_MASK & 16) { attn_unit(pr >> 2, pr & 3, 31 - j, a, lds);
                attn_unit(pr >> 2, pr & 3, j, a, lds); }
            }
            for (int rep3 = 0; rep3 < (PROBE_DUP == 6 ? 2 : 1); ++rep3)
            for (int it = bid_(); it < 256; it += grid_()) {
                if (it < 128) { if (ITEM_MASK & 32) s5_item<2>(l, it >> 5, it & 31, a, lds); }
                else { if (ITEM_MASK & 64) lru_item<2>(l, (it - 128) >> 5, (it - 128) & 31, a, lds); }
            }
            if (ITEM_MASK & 2) {
                unsigned* qctr = (unsigned*)(ws_() + WS_BAR) + 3600 + l;
                volatile LAS unsigned* qslot = (volatile LAS unsigned*)(lds + LDS_BYTES - 48);
                for (;;) {
                    __syncthreads();
                    if (opaque_tid() == 0) qslot[0] = __hip_atomic_fetch_add(qctr, 1u, __ATOMIC_RELAXED, __HIP_MEMORY_SCOPE_AGENT);
                    __syncthreads();
                    const unsigned qi = qslot[0];
                    if (qi >= 256u) break;
                    if (qi < 128u) sgu_item<1>(l, (int)(qi >> 5), (int)(qi & 31), a, lds);
                    else sgu_item<0>(l, (int)((qi - 128u) >> 5), (int)(qi & 31), a, lds);
                }
            }
            }
            SEAM(pb + 3);
        }
        if (IN(pb + 4)) {
            pg8::Gemm g{(const pg8::bf16_t*)(ws_() + WS_Y), (const pg8::bf16_t*)(ws_() + WS_WOUT) + (size_t)l * DM * DM, T, DM, DM}; pg8::StaticOrder S; S.init(T, DM, grid_(), bid_(), WGM_G2);
            EpiRes<true, true> E{(bf16_t*)(ws_() + WS_H), DM, (const float*)(ws_() + WS_SSD), (float*)(ws_() + WS_SS2)};
            pg8::gemm_phase<EpiRes<true, true>, pg8::StaticOrder, true, true>((PG8_LAS unsigned char*)lds, g, S, E);
            SEAM(pb + 4);
        }
        if (IN(pb + 6)) {
            pg8::Gemm g{(const pg8::bf16_t*)(ws_() + WS_H), (const pg8::bf16_t*)(ws_() + WS_WMI) + (size_t)l * DFF * DM, T, DFF, DM}; pg8::StaticOrder S; S.init(T, DFF, grid_(), bid_(), WGM_G3);
            EpiStoreBf16<1, true> E{(bf16_t*)(ws_() + WS_ACT), DFF, (const float*)(ws_() + WS_SS2)};
            pg8::gemm_phase<EpiStoreBf16<1, true>, pg8::StaticOrder, true, true>((PG8_LAS unsigned char*)lds, g, S, E);
            SEAM(pb + 6);
        }
        if (IN(pb + 7)) {
            pg8::Gemm g{(const pg8::bf16_t*)(ws_() + WS_ACT), (const pg8::bf16_t*)(ws_() + WS_WMO) + (size_t)l * DM * DFF, T, DM, DFF}; pg8::StaticOrder S; S.init(T, DM, grid_(), bid_(), WGM_G4);
            EpiRes<false, true> E{(bf16_t*)(ws_() + WS_H), DM, nullptr, (float*)(ws_() + WS_SS2)};
            pg8::gemm_phase<EpiRes<false, true>, pg8::StaticOrder, true, true>((PG8_LAS unsigned char*)lds, g, S, E);
            SEAM(pb + 7);
        }
    }
    if (IN(33)) norm_phase<true, 2>(ws_() + WS_H, INP(29), nullptr, nullptr, out_(), nullptr, nullptr, nullptr);
#undef SEAM
#undef IN
}


#ifndef DUMP_SEL
#define DUMP_SEL 0
#endif
#ifndef DUMP_LAST
#define DUMP_LAST 33
#endif
__global__ void dump_kernel(const unsigned char* ws, float* out) {
    const size_t i = (size_t)blockIdx.x * blockDim.x + threadIdx.x;
    const size_t t = i >> 10, c = i & 1023;
    float v = 0.f;
    if (DUMP_SEL == 1) v = bf2f(((const bf16_t*)(ws + WS_H))[i]);
    if (DUMP_SEL == 2) v = bf2f(((const bf16_t*)(ws + WS_Z))[t * ZW + c]) + bf2f(((const bf16_t*)(ws + WS_Z))[t * ZW + c + 1024]);
    if (DUMP_SEL == 3) v = bf2f(((const bf16_t*)(ws + WS_Y))[i]);
    if (DUMP_SEL == 5) v = ((const float*)(ws + WS_SSD))[(t * 4 + (c & 3))] + ((const float*)(ws + WS_CS))[(t * 4 + (c & 3))];
    if (DUMP_SEL == 7) v = ((const float*)(ws + WS_ELOC))[i & 262143];
    if (DUMP_SEL == 8) v = ((const float*)(ws + WS_LA))[i & 32767] + ((const float*)(ws + WS_LB))[i & 32767];
    if (DUMP_SEL == 6) v = bf2f(((const bf16_t*)(ws + WS_WIN))[i]) + bf2f(((const bf16_t*)(ws + WS_WMI))[i]) + bf2f(((const bf16_t*)(ws + WS_WMO))[i]) + bf2f(((const bf16_t*)(ws + WS_WOUT))[i & 0x3fffff]);
    out[i] = v;
}
#ifndef N_LAUNCH_MODE
#define N_LAUNCH_MODE 1
#endif
extern "C" void kernel_launch(void* const* d_in, const int* in_sizes, int n_in, void* d_out, int out_size, void* d_ws, size_t ws_size, hipStream_t stream) {
    static int grid = 0;
    if (grid == 0) {
        if (n_in != 30 || out_size != T * DM || ws_size < WS_END) { fprintf(stderr, "kernel_launch: unexpected shapes (n_in %d, out %d, ws %zu, need %zu)\n", n_in, out_size, ws_size, (size_t)WS_END); grid = -1; return; }
        int dev = 0, cus = 0, per_cu = 0;
        hipGetDevice(&dev); hipDeviceGetAttribute(&cus, hipDeviceAttributeMultiprocessorCount, dev);
        if (hipFuncSetAttribute((const void*)fwd_kernel, hipFuncAttributeMaxDynamicSharedMemorySize, LDS_BYTES) != hipSuccess) { fprintf(stderr, "kernel_launch: hipFuncSetAttribute failed\n"); grid = -1; return; }
        if (hipOccupancyMaxActiveBlocksPerMultiprocessor(&per_cu, (const void*)fwd_kernel, NTHR, LDS_BYTES) != hipSuccess || per_cu < 1) { fprintf(stderr, "kernel_launch: occupancy query says %d\n", per_cu); per_cu = 1; }
        (void)hipGetLastError();
        grid = cus;
        if (grid > 256) grid = 256;
    }
    if (grid < 0) return;
    Args a{};
    for (int i = 0; i < 30; ++i) a.in[i] = (const float*)d_in[i];
    a.out = (float*)d_out; a.ws = (unsigned char*)d_ws;
    if (N_LAUNCH_MODE == 1) {
        a.ph_lo = 0; a.ph_hi = 34;
        if (hipMemsetAsync((unsigned char*)d_ws + WS_BAR, 0, 16 * 1024, stream) != hipSuccess) { fprintf(stderr, "kernel_launch: memset of the barrier words failed\n"); return; }
        void* args[] = {&a};
        hipError_t e = hipLaunchCooperativeKernel((const void*)fwd_kernel, dim3(grid), dim3(NTHR), args, LDS_BYTES, stream);
        if (e != hipSuccess) fprintf(stderr, "kernel_launch: cooperative launch failed: %s (grid %d)\n", hipGetErrorString(e), grid);
    } else {
        for (int ph = 0; ph <= DUMP_LAST; ++ph) { a.ph_lo = ph; a.ph_hi = ph + 1; hipLaunchKernelGGL(fwd_kernel, dim3(grid), dim3(NTHR), LDS_BYTES, stream, a); }
        if (DUMP_SEL != 0 && DUMP_SEL != 4) hipLaunchKernelGGL(dump_kernel, dim3(T * DM / 256), dim3(256), 0, stream, (const unsigned char*)d_ws, (float*)d_out);
    }
}
```
